# Optimizing an MI355X kernel written in HIP

```python
import math
import jax, jax.numpy as jnp
from jax import lax
import numpy as np

D_MODEL = 1024
BATCH = 8
SEQ = 2048
DEPTH = 4

HEAD_DIM = 64
N_HEADS = D_MODEL // HEAD_DIM
MIX_WIDTH = N_HEADS * HEAD_DIM
NSA_HEADS = N_HEADS // 2
NSA_KV = 2
NSA_GROUP = NSA_HEADS // NSA_KV
FOX_HEADS = N_HEADS // 4
SB_HEADS = N_HEADS - NSA_HEADS - FOX_HEADS
ROPE_DIM = HEAD_DIM // 4
ROPE_THETA = 500000.0
CMP_LEN = 32
CMP_STRIDE = 16
CMP_HIDDEN = 2 * HEAD_DIM
SEL_LEN = 64
SEL_TOPN = 16
WINDOW = 512
FORCE_SCORE = 1.0e4
Q_BLOCK = 128
SEL_Q_BLOCK = 64
N_GROUPS = 4
EXPERTS_PER_GROUP = 8
N_EXPERTS = N_GROUPS * EXPERTS_PER_GROUP
EXPERT_TOPK = 2
D_EXPERT = D_MODEL // 2
MOE_CHUNK = 256
EPS = 1e-6
NEG = -1e30

KV_W = NSA_KV * HEAD_DIM
IN_SIZES = (NSA_HEADS * HEAD_DIM, KV_W, KV_W, KV_W, KV_W, KV_W, KV_W, NSA_HEADS * 3,
            FOX_HEADS * HEAD_DIM, FOX_HEADS * HEAD_DIM, FOX_HEADS * HEAD_DIM, FOX_HEADS,
            SB_HEADS * HEAD_DIM, SB_HEADS * HEAD_DIM, SB_HEADS * HEAD_DIM)
D_IN = sum(IN_SIZES)

kernel_name = 'hybrid_nsa_fox_stickbreak_hmoe_adaln'


def rmsnorm(x, g):
    xf = x.astype(jnp.float32)
    y = xf * lax.rsqrt(jnp.mean(xf * xf, axis=-1, keepdims=True) + EPS)
    return (y * g.astype(jnp.float32)).astype(x.dtype)


def rope_partial(x, pos):
    half = ROPE_DIM // 2
    inv = jnp.exp(jnp.arange(half, dtype=jnp.float32) * (-2.0 * math.log(ROPE_THETA) / ROPE_DIM))
    ang = pos.astype(jnp.float32)[:, None] * inv[None, :]
    shp = (pos.shape[0],) + (1,) * (x.ndim - 3) + (half,)
    cos = jnp.cos(ang).reshape(shp).astype(x.dtype)
    sin = jnp.sin(ang).reshape(shp).astype(x.dtype)
    x1 = x[..., :half]
    x2 = x[..., half:ROPE_DIM]
    return jnp.concatenate([x1 * cos - x2 * sin, x2 * cos + x1 * sin, x[..., ROPE_DIM:]], axis=-1)


def masked_softmax(s, m):
    return jax.nn.softmax(jnp.where(m, s, NEG), axis=-1)


def sweep_blocks(fn, n_blocks):
    out = lax.map(fn, jnp.arange(n_blocks))
    out = jnp.moveaxis(out, 0, 1)
    return out.reshape(out.shape[:1] + (-1,) + out.shape[3:])


def compress_blocks(k, blk_idx, pe, w1, w2):
    b, _, g, dh = k.shape
    n = blk_idx.shape[0]
    blk = k[:, blk_idx] + pe[:, None, :]
    flat = jnp.moveaxis(blk, 3, 2).reshape(b, n, g, CMP_LEN * dh)
    return jax.nn.silu(flat @ w1) @ w2


def nsa_mixer(q, kc, vc, ks, vs, kw, vw, gates, pos_k, w1_k, w2_k, pos_v, w1_v, w2_v):
    b, s_len, _ = q.shape
    scale = HEAD_DIM ** -0.5
    pos = jnp.arange(s_len)
    kv_shape = (b, s_len, NSA_KV, HEAD_DIM)
    q = rope_partial(q.reshape(b, s_len, NSA_KV, NSA_GROUP, HEAD_DIM), pos)
    kc, vc, vs, vw = [t.reshape(kv_shape) for t in (kc, vc, vs, vw)]
    ks = rope_partial(ks.reshape(kv_shape), pos)
    kw = rope_partial(kw.reshape(kv_shape), pos)

    n_cmp = (s_len - CMP_LEN) // CMP_STRIDE + 1
    cmp_start = jnp.arange(n_cmp) * CMP_STRIDE
    cmp_end = cmp_start + CMP_LEN - 1
    blk_idx = cmp_start[:, None] + jnp.arange(CMP_LEN)[None, :]
    ck = rope_partial(compress_blocks(kc, blk_idx, pos_k, w1_k, w2_k), cmp_end)
    cv = compress_blocks(vc, blk_idx, pos_v, w1_v, w2_v)
    s_cmp = jnp.einsum('bqghd,bngd->bqghn', q, ck).astype(jnp.float32) * scale
    valid = (cmp_end[None, :] <= pos[:, None])[None, :, None, None, :]
    p_cmp = masked_softmax(s_cmp, valid) * valid
    o_cmp = jnp.einsum('bqghn,bngd->bqghd', p_cmp.astype(cv.dtype), cv)

    n_sel = s_len // SEL_LEN
    sel_start = jnp.arange(n_sel) * SEL_LEN
    cover = ((cmp_start[:, None] < sel_start[None, :] + SEL_LEN) &
             (cmp_start[:, None] + CMP_LEN > sel_start[None, :])).astype(jnp.float32)
    imp = jnp.einsum('bqghn,nj->bqgj', p_cmp, cover)
    cur = pos // SEL_LEN
    jj = jnp.arange(n_sel)
    forced = (jj[None, :] == 0) | (jj[None, :] == cur[:, None]) | (jj[None, :] == cur[:, None] - 1)
    causal_blk = sel_start[None, :] <= pos[:, None]
    score = jnp.where(forced[None, :, None, :], FORCE_SCORE,
                      jnp.where(causal_blk[None, :, None, :], imp, -1.0))
    n_top = min(SEL_TOPN, n_sel)
    _, sel_idx = lax.top_k(score, n_top)
    ksb = ks.reshape(b, n_sel, SEL_LEN, NSA_KV, HEAD_DIM).transpose(0, 3, 1, 2, 4)
    vsb = vs.reshape(b, n_sel, SEL_LEN, NSA_KV, HEAD_DIM).transpose(0, 3, 1, 2, 4)
    b_ix = jnp.arange(b)[:, None, None, None]
    g_ix = jnp.arange(NSA_KV)[None, None, :, None]

    def sel_block(i):
        t0 = i * SEL_Q_BLOCK
        qi = lax.dynamic_slice_in_dim(q, t0, SEL_Q_BLOCK, axis=1)
        ii = lax.dynamic_slice_in_dim(sel_idx, t0, SEL_Q_BLOCK, axis=1)
        kg = ksb[b_ix, g_ix, ii]
        vg = vsb[b_ix, g_ix, ii]
        s = jnp.einsum('bqghd,bqgnld->bqghnl', qi, kg).astype(jnp.float32) * scale
        tq = t0 + jnp.arange(SEL_Q_BLOCK)
        kpos = ii[..., None] * SEL_LEN + jnp.arange(SEL_LEN)
        m = (kpos <= tq[None, :, None, None, None])[:, :, :, None]
        p = masked_softmax(s.reshape(s.shape[:4] + (-1,)), m.reshape(m.shape[:4] + (-1,))).reshape(s.shape)
        return jnp.einsum('bqghnl,bqgnld->bqghd', p.astype(vg.dtype), vg)

    o_sel = sweep_blocks(sel_block, s_len // SEL_Q_BLOCK)

    span = WINDOW + Q_BLOCK
    kwp = jnp.pad(kw, ((0, 0), (WINDOW, 0), (0, 0), (0, 0)))
    vwp = jnp.pad(vw, ((0, 0), (WINDOW, 0), (0, 0), (0, 0)))

    def win_block(i):
        t0 = i * Q_BLOCK
        qi = lax.dynamic_slice_in_dim(q, t0, Q_BLOCK, axis=1)
        ki = lax.dynamic_slice_in_dim(kwp, t0, span, axis=1)
        vi = lax.dynamic_slice_in_dim(vwp, t0, span, axis=1)
        s = jnp.einsum('bqghd,bkgd->bqghk', qi, ki).astype(jnp.float32) * scale
        tq = t0 + jnp.arange(Q_BLOCK)
        tk = t0 - WINDOW + jnp.arange(span)
        m = (tk[None, :] <= tq[:, None]) & (tk[None, :] > tq[:, None] - WINDOW) & (tk[None, :] >= 0)
        p = masked_softmax(s, m[None, :, None, None, :])
        return jnp.einsum('bqghk,bkgd->bqghd', p.astype(vi.dtype), vi)

    o_win = sweep_blocks(win_block, s_len // Q_BLOCK)

    g = jax.nn.sigmoid(gates.astype(jnp.float32)).reshape(b, s_len, NSA_KV, NSA_GROUP, 3).astype(q.dtype)
    o = g[..., 0:1] * o_cmp + g[..., 1:2] * o_sel + g[..., 2:3] * o_win
    return o.reshape(b, s_len, NSA_HEADS * HEAD_DIM)


def fox_mixer(q, k, v, f_logit, b_forget):
    b, s_len, _ = q.shape
    scale = HEAD_DIM ** -0.5
    hs = (b, s_len, FOX_HEADS, HEAD_DIM)
    q, k, v = q.reshape(hs), k.reshape(hs), v.reshape(hs)
    cumf = jnp.cumsum(jax.nn.log_sigmoid(f_logit.astype(jnp.float32) + b_forget.astype(jnp.float32)),
                      axis=1).transpose(0, 2, 1)
    tk = jnp.arange(s_len)

    def blk(i):
        t0 = i * Q_BLOCK
        qi = lax.dynamic_slice_in_dim(q, t0, Q_BLOCK, axis=1)
        ci = lax.dynamic_slice_in_dim(cumf, t0, Q_BLOCK, axis=2)
        s = (jnp.einsum('bqhd,bkhd->bhqk', qi, k).astype(jnp.float32) * scale
             + ci[..., :, None] - cumf[:, :, None, :])
        tq = t0 + jnp.arange(Q_BLOCK)
        p = masked_softmax(s, tk[None, :] <= tq[:, None])
        return jnp.einsum('bhqk,bkhd->bqhd', p.astype(v.dtype), v)

    o = sweep_blocks(blk, s_len // Q_BLOCK)
    return o.reshape(b, s_len, FOX_HEADS * HEAD_DIM)


def stick_breaking_mixer(q, k, v):
    b, s_len, _ = q.shape
    scale = HEAD_DIM ** -0.5
    hs = (b, s_len, SB_HEADS, HEAD_DIM)
    q, k, v = q.reshape(hs), k.reshape(hs), v.reshape(hs)
    tk = jnp.arange(s_len)

    def blk(i):
        t0 = i * Q_BLOCK
        qi = lax.dynamic_slice_in_dim(q, t0, Q_BLOCK, axis=1)
        z = jnp.einsum('bqhd,bkhd->bhqk', qi, k).astype(jnp.float32) * scale
        tq = t0 + jnp.arange(Q_BLOCK)
        m = tk[None, :] < tq[:, None]
        l = jnp.where(m, jax.nn.log_sigmoid(-z), 0.0)
        rest = lax.cumsum(l, axis=3, reverse=True) - l
        a = jnp.where(m, jnp.exp(jax.nn.log_sigmoid(z) + rest), 0.0)
        return jnp.einsum('bhqk,bkhd->bqhd', a.astype(v.dtype), v)

    o = sweep_blocks(blk, s_len // Q_BLOCK)
    return o.reshape(b, s_len, SB_HEADS * HEAD_DIM)


def hybrid_mixer(h, w_in, b_forget, cmp_pos_k, cmp_w1_k, cmp_w2_k, cmp_pos_v, cmp_w1_v, cmp_w2_v,
                 out_norm_g, w_out):
    b, s_len, _ = h.shape
    u = h @ w_in
    pts = []
    acc = 0
    for sz in IN_SIZES[:-1]:
        acc += sz
        pts.append(acc)
    (qa, kca, vca, ksa, vsa, kwa, vwa, ga, qb, kb, vb, fb, qc, kcc, vcc) = jnp.split(u, pts, axis=-1)
    o_a = nsa_mixer(qa, kca, vca, ksa, vsa, kwa, vwa, ga,
                    cmp_pos_k, cmp_w1_k, cmp_w2_k, cmp_pos_v, cmp_w1_v, cmp_w2_v)
    o_b = fox_mixer(qb, kb, vb, fb, b_forget)
    o_c = stick_breaking_mixer(qc, kcc, vcc)
    o = jnp.concatenate([o_a, o_b, o_c], axis=-1).reshape(b, s_len, N_HEADS, HEAD_DIM)
    o = rmsnorm(o, out_norm_g.reshape(N_HEADS, HEAD_DIM))
    return o.reshape(b, s_len, MIX_WIDTH) @ w_out


def hier_moe(h, wg, bg, we, be, w1, w3, w2):
    b, s_len, d = h.shape
    t = b * s_len
    xt = h.reshape(t, d)
    gp = jax.nn.softmax((xt @ wg).astype(jnp.float32) + bg.astype(jnp.float32), axis=-1)
    pg, gi = lax.top_k(gp, 1)
    el = ((xt @ we).astype(jnp.float32) + be.astype(jnp.float32)).reshape(t, N_GROUPS, EXPERTS_PER_GROUP)
    el_sel = el[jnp.arange(t), gi[:, 0]]
    pe, ei = lax.top_k(jax.nn.softmax(el_sel, axis=-1), EXPERT_TOPK)
    pe = pe / jnp.sum(pe, axis=-1, keepdims=True)
    wts = (pg * pe).reshape(-1)
    eid = (gi * EXPERTS_PER_GROUP + ei).reshape(-1)
    tok = jnp.repeat(jnp.arange(t, dtype=jnp.int32), EXPERT_TOPK)
    n_assign = t * EXPERT_TOPK
    order = jnp.argsort(eid)
    e_sorted = eid[order]
    counts = jnp.zeros((N_EXPERTS,), jnp.int32).at[eid].add(1)
    starts = jnp.cumsum(counts) - counts
    padded = ((counts + MOE_CHUNK - 1) // MOE_CHUNK) * MOE_CHUNK
    pends = jnp.cumsum(padded)
    pstarts = pends - padded
    dest = pstarts[e_sorted] + (jnp.arange(n_assign) - starts[e_sorted])
    n_chunks = -(-(n_assign + N_EXPERTS * (MOE_CHUNK - 1)) // MOE_CHUNK)
    p_rows = n_chunks * MOE_CHUNK
    buf_tok = jnp.full((p_rows,), t, jnp.int32).at[dest].set(tok[order])
    buf_w = jnp.zeros((p_rows,), jnp.float32).at[dest].set(wts[order])
    chunk_e = jnp.clip(jnp.searchsorted(pends, jnp.arange(n_chunks, dtype=jnp.int32) * MOE_CHUNK,
                                        side='right'), 0, N_EXPERTS - 1)
    xpad = jnp.concatenate([xt, jnp.zeros((1, d), xt.dtype)], axis=0)
    xs = xpad[buf_tok].reshape(n_chunks, MOE_CHUNK, d)

    def expert_chunk(args):
        xc, e = args
        return (jax.nn.silu(xc @ w1[e]) * (xc @ w3[e])) @ w2[e]

    ys = lax.map(expert_chunk, (xs, chunk_e)).reshape(p_rows, d)
    out = jnp.zeros((t + 1, d), ys.dtype).at[buf_tok].add(ys * buf_w[:, None].astype(ys.dtype))
    return out[:t].reshape(b, s_len, d)


def setup_inputs(seed: int = 0) -> dict:
    key = jax.random.key(seed)
    ks = jax.random.split(key, 24)
    L, D = DEPTH, D_MODEL

    def nrm(k, shape, s):
        return s * jax.random.normal(k, shape, jnp.float32)

    return {
        'x': nrm(ks[0], (BATCH, SEQ, D), 1.0),
        'c': nrm(ks[1], (BATCH, D), 1.0),
        'norm1_g': 1.0 + nrm(ks[2], (L, D), 0.02),
        'norm2_g': 1.0 + nrm(ks[3], (L, D), 0.02),
        'ada_w': nrm(ks[4], (L, D, 6 * D), 0.5 * D ** -0.5),
        'ada_b': nrm(ks[5], (L, 6 * D), 0.02),
        'w_in': nrm(ks[6], (L, D, D_IN), D ** -0.5),
        'b_forget': 2.0 + nrm(ks[7], (L, FOX_HEADS), 0.1),
        'cmp_pos_k': nrm(ks[8], (L, CMP_LEN, HEAD_DIM), 0.1),
        'cmp_w1_k': nrm(ks[9], (L, CMP_LEN * HEAD_DIM, CMP_HIDDEN), (CMP_LEN * HEAD_DIM) ** -0.5),
        'cmp_w2_k': nrm(ks[10], (L, CMP_HIDDEN, HEAD_DIM), CMP_HIDDEN ** -0.5),
        'cmp_pos_v': nrm(ks[11], (L, CMP_LEN, HEAD_DIM), 0.1),
        'cmp_w1_v': nrm(ks[12], (L, CMP_LEN * HEAD_DIM, CMP_HIDDEN), (CMP_LEN * HEAD_DIM) ** -0.5),
        'cmp_w2_v': nrm(ks[13], (L, CMP_HIDDEN, HEAD_DIM), CMP_HIDDEN ** -0.5),
        'out_norm_g': 1.0 + nrm(ks[14], (L, MIX_WIDTH), 0.02),
        'w_out': nrm(ks[15], (L, MIX_WIDTH, D), MIX_WIDTH ** -0.5),
        'router_group_w': nrm(ks[16], (L, D, N_GROUPS), D ** -0.5),
        'router_group_b': nrm(ks[17], (L, N_GROUPS), 0.01),
        'router_expert_w': nrm(ks[18], (L, D, N_EXPERTS), D ** -0.5),
        'router_expert_b': nrm(ks[19], (L, N_EXPERTS), 0.01),
        'expert_w1': nrm(ks[20], (L, N_EXPERTS, D, D_EXPERT), D ** -0.5),
        'expert_w3': nrm(ks[21], (L, N_EXPERTS, D, D_EXPERT), D ** -0.5),
        'expert_w2': nrm(ks[22], (L, N_EXPERTS, D_EXPERT, D), D_EXPERT ** -0.5),
        'final_g': 1.0 + nrm(ks[23], (D,), 0.02),
    }


def reference(x, c, norm1_g, norm2_g, ada_w, ada_b, w_in, b_forget, cmp_pos_k, cmp_w1_k, cmp_w2_k,
              cmp_pos_v, cmp_w1_v, cmp_w2_v, out_norm_g, w_out, router_group_w, router_group_b,
              router_expert_w, router_expert_b, expert_w1, expert_w3, expert_w2, final_g):
    cond = jax.nn.silu(c)
    for l in range(DEPTH):
        mod = cond @ ada_w[l] + ada_b[l]
        sh1, sc1, g1, sh2, sc2, g2 = jnp.split(mod[:, None, :], 6, axis=-1)
        h = rmsnorm(x, norm1_g[l]) * (1.0 + sc1) + sh1
        x = x + g1 * hybrid_mixer(h, w_in[l], b_forget[l], cmp_pos_k[l], cmp_w1_k[l], cmp_w2_k[l],
                                  cmp_pos_v[l], cmp_w1_v[l], cmp_w2_v[l], out_norm_g[l], w_out[l])
        h = rmsnorm(x, norm2_g[l]) * (1.0 + sc2) + sh2
        x = x + g2 * hier_moe(h, router_group_w[l], router_group_b[l], router_expert_w[l],
                              router_expert_b[l], expert_w1[l], expert_w3[l], expert_w2[l])
    return rmsnorm(x, final_g)
```

```cpp
#include <hip/hip_runtime.h>
#include <hip/hip_cooperative_groups.h>
#include <cstdio>
#include <cstdint>

#define LAS __attribute__((address_space(3)))
#define DEV __device__ __forceinline__

constexpr int T = 16384, S = 2048, NB = 8, D = 1024, DIN = 2844, NP = 2880, DEPTH = 4;
constexpr int NCMP = 127;
constexpr float EPS = 1e-6f;
constexpr float SCALE = 0.125f;
constexpr int C_QA = 0, C_KC = 512, C_VC = 640, C_KS = 768, C_VS = 896, C_KW = 1024, C_VW = 1152;
constexpr int C_QB = 1280, C_KB = 1536, C_VB = 1792, C_QC = 2048, C_KCC = 2304, C_VCC = 2560;

constexpr size_t MiB = 1u << 20;
constexpr size_t WS_CTL = 0, CTL_BYTES = 64 * 1024;
constexpr size_t WS_MOD = 1 * MiB, WS_ROPE = 2 * MiB, WS_CUMF = 3 * MiB, WS_CK = 4 * MiB, WS_CV = 5 * MiB, WS_IMP = 6 * MiB;
constexpr size_t WS_SEL = 10 * MiB, WS_EID = 11 * MiB, WS_WTS = 12 * MiB, WS_LIST = 13 * MiB, WS_GF = 16 * MiB;
constexpr size_t WS_H = 32 * MiB, WS_U = 64 * MiB, WS_O = 160 * MiB, WS_HID = 192 * MiB, WS_Y = 224 * MiB, WS_OB = 352 * MiB, WS_ORAW = 448 * MiB;
constexpr size_t WS_END = 973 * MiB;
constexpr size_t WS_VT = 936 * MiB;
constexpr size_t WS_CVT = 962 * MiB;
constexpr size_t WS_CUMF2 = 963 * MiB;
constexpr int CW_Q = 8192 + 256;
constexpr size_t WS_CW1 = 964 * MiB;
constexpr size_t WS_CW2 = 968 * MiB;
constexpr size_t WS_CPB = 969 * MiB;
constexpr size_t WS_LSF = 970 * MiB;
constexpr size_t WS_WR = 971 * MiB;
constexpr int CW_CNT = 8192;

typedef unsigned short bf16_t;
typedef float f32x4v __attribute__((ext_vector_type(4)));
DEV int vt_row(int n) { return n < 1024 ? n - 896 : (n < 1280 ? 128 + n - 1152 : (n < 2048 ? 256 + n - 1792 : 512 + n - 2560)); }
DEV bool is_vcol(int n) { return (n >= C_VS && n < C_KW) || (n >= C_VW && n < C_QB) || (n >= C_VB && n < C_QC) || (n >= C_VCC && n < 2816); }
DEV float bf2f(bf16_t v) { return __uint_as_float((unsigned)v << 16); }
DEV bf16_t f2bf(float f) { unsigned u = __float_as_uint(f); return (bf16_t)((u + 0x7fffu + ((u >> 16) & 1u)) >> 16); }
DEV float4 ld_bf4(const bf16_t* p) { const ushort4 u = *(const ushort4*)p; return make_float4(bf2f(u.x), bf2f(u.y), bf2f(u.z), bf2f(u.w)); }
typedef float f32x2_t __attribute__((ext_vector_type(2)));
typedef __bf16 bf16x2_t __attribute__((ext_vector_type(2)));
DEV unsigned cvtpk(float lo, float hi) { f32x2_t v = {lo, hi}; bf16x2_t b = __builtin_convertvector(v, bf16x2_t); return __builtin_bit_cast(unsigned, b); }
DEV float sigmoidf_(float x) { return 1.f / (1.f + expf(-x)); }
DEV float logsigmoidf_(float x) { return fminf(x, 0.f) - log1pf(expf(-fabsf(x))); }
DEV float wave_sum(float v) {
#pragma unroll
    for (int o = 1; o < 64; o <<= 1) v += __shfl_xor(v, o);
    return v;
}

#define XB_TMO      128
#define XB_XCNT(j)  (256  + 64 * (j))
#define XB_XSUB(j)  (1280 + 64 * (j))
#define XB_XGEN(j)  (2304 + 64 * (j))
#define XB_TOP      3328
#define XB_TOPGEN   3392
#define XCD_BAR_WORDS 3456
#define XB_SPIN_CAP (1u << 23)
DEV unsigned xb_ld(unsigned* p)              { return __hip_atomic_load(p, __ATOMIC_RELAXED, __HIP_MEMORY_SCOPE_AGENT); }
DEV unsigned xb_add(unsigned* p, unsigned v) { return __hip_atomic_fetch_add(p, v, __ATOMIC_RELAXED, __HIP_MEMORY_SCOPE_AGENT); }
DEV unsigned xb_xcc_id() { return (unsigned)__builtin_amdgcn_s_getreg((3 << 11) | 20) & 0xFu; }
#define XB_SPIN(cond, bar) do { unsigned _sp = 0; while (cond) { __builtin_amdgcn_s_sleep(1); \
    if ((++_sp & 255u) == 0u) { if (xb_ld(&(bar)[XB_TMO])) break; if (_sp > XB_SPIN_CAP) { atomicAdd(&(bar)[XB_TMO], 1u); break; } } } } while (0)
struct XcdBarrier { unsigned* bar; unsigned x; volatile LAS unsigned* st; };
DEV XcdBarrier xcd_barrier_post(unsigned* bar, volatile LAS unsigned* st) {
    XcdBarrier b; b.bar = bar; b.x = xb_xcc_id(); b.st = st;
    if (threadIdx.x == 0) (void)xb_add(&bar[XB_XCNT(b.x)], 1u);
    return b;
}
DEV void xcd_barrier_complete(unsigned* bar, unsigned x, unsigned& nloc, unsigned& nx) {
    const unsigned G = gridDim.x * gridDim.y * gridDim.z;
    unsigned sum, cnt, mine, sp = 0u;
    for (;;) {
        sum = 0u; cnt = 0u; mine = 0u;
#pragma unroll
        for (unsigned j = 0; j < 16; ++j) { const unsigned c = xb_ld(&bar[XB_XCNT(j)]); sum += c; cnt += (c > 0u) ? 1u : 0u; mine = (j == x) ? c : mine; }
        if (sum == G) break;
        __builtin_amdgcn_s_sleep(1);
        if ((++sp & 255u) == 0u) { if (xb_ld(&bar[XB_TMO])) break; if (sp > XB_SPIN_CAP) { atomicAdd(&bar[XB_TMO], 1u); break; } }
    }
    nloc = mine > 0u ? mine : 1u; nx = cnt > 0u ? cnt : 1u;
}
DEV void xcd_barrier(const XcdBarrier& b) {
    asm volatile("s_waitcnt vmcnt(0)" ::: "memory");
    __syncthreads();
    if (threadIdx.x == 0) {
        unsigned* bar = b.bar;
        __builtin_amdgcn_s_waitcnt(0);
        unsigned nloc = b.st[0], nx = b.st[1];
        if (nloc == 0u) { xcd_barrier_complete(bar, b.x, nloc, nx); b.st[0] = nloc; b.st[1] = nx; }
        const unsigned old = xb_add(&bar[XB_XSUB(b.x)], 1u);
        const unsigned gen = old / nloc;
        if (old + 1u == (gen + 1u) * nloc) {
            __builtin_amdgcn_fence(__ATOMIC_RELEASE, "agent");
            asm volatile("s_waitcnt vmcnt(0)" ::: "memory");
            const unsigned og = xb_add(&bar[XB_TOP], 1u);
            const unsigned tg = og / nx;
            if (og + 1u == (tg + 1u) * nx) xb_add(&bar[XB_TOPGEN], 1u);
            else XB_SPIN(xb_ld(&bar[XB_TOPGEN]) == tg, bar);
            __builtin_amdgcn_fence(__ATOMIC_ACQUIRE, "agent");
            xb_add(&bar[XB_XGEN(b.x)], 1u);
            asm volatile("s_waitcnt vmcnt(0)" ::: "memory");
        } else {
            XB_SPIN(xb_ld(&bar[XB_XGEN(b.x)]) == gen, bar);
            __builtin_amdgcn_fence(__ATOMIC_ACQUIRE, "agent");
            asm volatile("s_waitcnt vmcnt(0)" ::: "memory");
        }
    }
    __syncthreads();
}

struct P {
    const float *x, *c, *norm1_g, *norm2_g, *ada_w, *ada_b, *w_in, *b_forget, *cmp_pos_k, *cmp_w1_k, *cmp_w2_k,
        *cmp_pos_v, *cmp_w1_v, *cmp_w2_v, *out_norm_g, *w_out, *rg_w, *rg_b, *re_w, *re_b, *e_w1, *e_w3, *e_w2, *final_g;
    float* out; unsigned char* ws;
};
struct V {
    unsigned* ctl; float* mod; float* rcos; float* rsin; float* cumf; bf16_t* ck; bf16_t* cv; float* imp; unsigned* sel;
    int* eid; float* wts; int* list; float* gf; bf16_t* H; bf16_t* U; bf16_t* O; bf16_t* HID; bf16_t* Y; float* OB; float* ORAW; float* X;
};
DEV int otid() { int t = threadIdx.x; asm volatile("" : "+v"(t)); return t; }
DEV int obid() { int t = blockIdx.x; asm volatile("" : "+s"(t)); return t; }
DEV V make_views(const P& p) {
    V v; unsigned char* w = p.ws; asm volatile("" : "+s"(w));
    v.ctl = (unsigned*)(w + WS_CTL); v.mod = (float*)(w + WS_MOD); v.rcos = (float*)(w + WS_ROPE); v.rsin = v.rcos + S * 8;
    v.cumf = (float*)(w + WS_CUMF); v.ck = (bf16_t*)(w + WS_CK); v.cv = (bf16_t*)(w + WS_CV); v.imp = (float*)(w + WS_IMP);
    v.sel = (unsigned*)(w + WS_SEL); v.eid = (int*)(w + WS_EID); v.wts = (float*)(w + WS_WTS); v.list = (int*)(w + WS_LIST);
    v.gf = (float*)(w + WS_GF); v.H = (bf16_t*)(w + WS_H); v.U = (bf16_t*)(w + WS_U); v.O = (bf16_t*)(w + WS_O);
    v.HID = (bf16_t*)(w + WS_HID); v.Y = (bf16_t*)(w + WS_Y); v.OB = (float*)(w + WS_OB); v.ORAW = (float*)(w + WS_ORAW); v.X = p.out;
    return v;
}

DEV void ph_prologue(const P& p, float* lds) {
    const V v = make_views(p); const int TIDX = otid(), BIDX = obid();
    const int tid = TIDX;
    for (int i = tid; i < NB * D; i += 256) { const float c = p.c[i]; lds[i] = c / (1.f + expf(-c)); }
    __syncthreads();
    float* red = lds + NB * D;
    const int c4 = tid & 15, ks = tid >> 4;
    for (int unit = BIDX; unit < DEPTH * 96; unit += gridDim.x) {
        const int l = unit / 96, n0 = (unit % 96) * 64;
        const float* W = p.ada_w + (size_t)l * D * 6144 + n0 + 4 * c4;
        float acc[8][4];
#pragma unroll
        for (int b = 0; b < 8; ++b)
#pragma unroll
            for (int q = 0; q < 4; ++q) acc[b][q] = 0.f;
#pragma unroll 1
        for (int i0 = 0; i0 < 64; i0 += 8) {
            f32x4v w[8];
#pragma unroll
            for (int i = 0; i < 8; ++i) w[i] = __builtin_nontemporal_load((const f32x4v*)(W + (size_t)(ks + 16 * (i0 + i)) * 6144));
#pragma unroll
            for (int i = 0; i < 8; ++i) {
                const int k = ks + 16 * (i0 + i);
#pragma unroll
                for (int b = 0; b < 8; ++b) {
                    const float cv = lds[b * D + k];
                    acc[b][0] += cv * w[i].x; acc[b][1] += cv * w[i].y; acc[b][2] += cv * w[i].z; acc[b][3] += cv * w[i].w;
                }
            }
        }
#pragma unroll
        for (int b = 0; b < 8; ++b) *(float4*)(red + (ks * 8 + b) * 64 + 4 * c4) = make_float4(acc[b][0], acc[b][1], acc[b][2], acc[b][3]);
        __syncthreads();
        for (int o = tid; o < 512; o += 256) {
            const int c2 = o & 63, b = o >> 6;
            float sm = p.ada_b[l * 6144 + n0 + c2];
#pragma unroll
            for (int q = 0; q < 16; ++q) sm += red[(q * 8 + b) * 64 + c2];
            v.mod[(size_t)(l * 8 + b) * 6144 + n0 + c2] = sm;
        }
        __syncthreads();
    }
    const float cst = -2.0f * 13.122363377404328f / 16.0f;
    for (int i = BIDX * 256 + tid; i < S * 8; i += gridDim.x * 256) {
        const int s = i >> 3, j = i & 7;
        const float inv = expf((float)j * cst);
        const float ang = (float)s * inv;
        v.rcos[i] = cosf(ang); v.rsin[i] = sinf(ang);
    }
}

DEV void ph_norm1(const P& p, int l, int mode) {
    const V v = make_views(p); const int TIDX = otid(), BIDX = obid();
    const int lane = TIDX & 63;
    const int gw = (BIDX * 256 + TIDX) >> 6, nw = gridDim.x * 4;
    for (int m0 = gw; m0 < T; m0 += 2 * nw) {
        float4 xv[2][4];
        if (mode == 0) {
#pragma unroll
            for (int rr = 0; rr < 2; ++rr)
#pragma unroll
                for (int j = 0; j < 4; ++j) xv[rr][j] = *(const float4*)(p.x + (size_t)(m0 + rr * nw) * D + 4 * lane + 256 * j);
        } else {
            float4 xa[2][4]; ushort4 ya[2][4], yb[2][4];
#pragma unroll
            for (int rr = 0; rr < 2; ++rr)
#pragma unroll
                for (int j = 0; j < 4; ++j) {
                    const int m = m0 + rr * nw, c = 4 * lane + 256 * j;
                    xa[rr][j] = *(const float4*)(v.X + (size_t)m * D + c);
                    ya[rr][j] = *(const ushort4*)(v.Y + (size_t)(2 * m) * D + c); yb[rr][j] = *(const ushort4*)(v.Y + (size_t)(2 * m + 1) * D + c);
                }
#pragma unroll
            for (int rr = 0; rr < 2; ++rr) {
                const float* g2 = v.mod + (size_t)((l - 1) * 8 + ((m0 + rr * nw) >> 11)) * 6144 + 5 * D;
#pragma unroll
                for (int j = 0; j < 4; ++j) {
                    const float4 g = *(const float4*)(g2 + 4 * lane + 256 * j);
                    float4 a = xa[rr][j];
                    a.x += g.x * (bf2f(ya[rr][j].x) + bf2f(yb[rr][j].x)); a.y += g.y * (bf2f(ya[rr][j].y) + bf2f(yb[rr][j].y));
                    a.z += g.z * (bf2f(ya[rr][j].z) + bf2f(yb[rr][j].z)); a.w += g.w * (bf2f(ya[rr][j].w) + bf2f(yb[rr][j].w));
                    xv[rr][j] = a;
                }
            }
        }
        float ss[2];
#pragma unroll
        for (int rr = 0; rr < 2; ++rr) {
            ss[rr] = 0.f;
#pragma unroll
            for (int j = 0; j < 4; ++j) ss[rr] += xv[rr][j].x * xv[rr][j].x + xv[rr][j].y * xv[rr][j].y + xv[rr][j].z * xv[rr][j].z + xv[rr][j].w * xv[rr][j].w;
        }
#pragma unroll
        for (int o = 1; o < 64; o <<= 1) { ss[0] += __shfl_xor(ss[0], o); ss[1] += __shfl_xor(ss[1], o); }
#pragma unroll
        for (int rr = 0; rr < 2; ++rr) {
            const int m = m0 + rr * nw, b = m >> 11;
            const float r = rsqrtf(ss[rr] * (1.f / D) + EPS);
            if (mode == 2) {
#pragma unroll
                for (int j = 0; j < 4; ++j) {
                    const int c = 4 * lane + 256 * j;
                    const float4 g = *(const float4*)(p.final_g + c);
                    float4 o; o.x = xv[rr][j].x * r * g.x; o.y = xv[rr][j].y * r * g.y; o.z = xv[rr][j].z * r * g.z; o.w = xv[rr][j].w * r * g.w;
                    *(float4*)(v.X + (size_t)m * D + c) = o;
                }
            } else {
                const float* md = v.mod + (size_t)(l * 8 + b) * 6144;
#pragma unroll
                for (int j = 0; j < 4; ++j) {
                    const int c = 4 * lane + 256 * j;
                    *(float4*)(v.X + (size_t)m * D + c) = xv[rr][j];
                    const float4 g = *(const float4*)(p.norm1_g + l * D + c), sh = *(const float4*)(md + c), sc = *(const float4*)(md + D + c);
                    uint2 o;
                    o.x = cvtpk(xv[rr][j].x * r * g.x * (1.f + sc.x) + sh.x, xv[rr][j].y * r * g.y * (1.f + sc.y) + sh.y);
                    o.y = cvtpk(xv[rr][j].z * r * g.z * (1.f + sc.z) + sh.z, xv[rr][j].w * r * g.w * (1.f + sc.w) + sh.w);
                    *(uint2*)(v.H + (size_t)m * D + c) = o;
                }
            }
        }
    }
}

typedef short bf16x8 __attribute__((ext_vector_type(8)));
typedef float f32x16 __attribute__((ext_vector_type(16)));
typedef unsigned u32x4 __attribute__((ext_vector_type(4)));
constexpr size_t WS_WIN = 512 * MiB, WS_WOT = 544 * MiB, WS_W13 = 552 * MiB, WS_W2 = 808 * MiB;
constexpr int NPW = 2944;
DEV int tile_off(int row, int chunk) { return row * 128 + ((chunk ^ ((row >> 1) & 7)) << 4); }
template <class RM>
DEV void conv_patch(const float* src, int N, int K, bf16_t* dst, int k0, int n0, RM rowmap, int lane) {
    const int kg = lane >> 3, n = n0 + 4 * (lane & 7);
    if (n >= N) return;
    const float* sp = src + (size_t)(k0 + 8 * kg) * N + n;
    f32x4v x[8];
#pragma unroll
    for (int j = 0; j < 8; ++j) x[j] = __builtin_nontemporal_load((const f32x4v*)(sp + (size_t)j * N));
    bf16_t* dp = dst + k0 + 8 * kg;
    u32x4 o;
    o.x = cvtpk(x[0].x, x[1].x); o.y = cvtpk(x[2].x, x[3].x); o.z = cvtpk(x[4].x, x[5].x); o.w = cvtpk(x[6].x, x[7].x);
    *(u32x4*)(dp + (size_t)rowmap(n) * K) = o;
    o.x = cvtpk(x[0].y, x[1].y); o.y = cvtpk(x[2].y, x[3].y); o.z = cvtpk(x[4].y, x[5].y); o.w = cvtpk(x[6].y, x[7].y);
    *(u32x4*)(dp + (size_t)rowmap(n + 1) * K) = o;
    o.x = cvtpk(x[0].z, x[1].z); o.y = cvtpk(x[2].z, x[3].z); o.z = cvtpk(x[4].z, x[5].z); o.w = cvtpk(x[6].z, x[7].z);
    *(u32x4*)(dp + (size_t)rowmap(n + 2) * K) = o;
    o.x = cvtpk(x[0].w, x[1].w); o.y = cvtpk(x[2].w, x[3].w); o.z = cvtpk(x[4].w, x[5].w); o.w = cvtpk(x[6].w, x[7].w);
    *(u32x4*)(dp + (size_t)rowmap(n + 3) * K) = o;
}

DEV void conv8(const float* s0, const float* s1, bf16_t* dst) {
    f32x4v a = {0.f, 0.f, 0.f, 0.f}, b = {0.f, 0.f, 0.f, 0.f};
    if (s0) a = __builtin_nontemporal_load((const f32x4v*)s0);
    if (s1) b = __builtin_nontemporal_load((const f32x4v*)s1);
    u32x4 o; o.x = cvtpk(a[0], a[1]); o.y = cvtpk(a[2], a[3]); o.z = cvtpk(b[0], b[1]); o.w = cvtpk(b[2], b[3]);
    *(u32x4*)dst = o;
}
DEV void ph_convert_dense(const P& p, int l, int which) {
    const int TIDX = otid(), BIDX = obid();
    unsigned char* w = p.ws; asm volatile("" : "+s"(w));
    const size_t gtid = (size_t)BIDX * 256 + TIDX, gsz = (size_t)gridDim.x * 256;
    if (which == 0) {
        bf16_t* win = (bf16_t*)(w + WS_WIN);
        for (size_t i = gtid; i < (size_t)D * 368; i += gsz) {
            const int g8 = (int)(i % 368); const size_t lk = (size_t)l * D + i / 368;
            const int n = g8 * 8;
            const float* row = p.w_in + lk * DIN;
            const float *s0, *s1;
            if (n < 2816) { const int oc = n + (n >= 2048 ? 28 : (n >= 1280 ? 24 : 0)); s0 = row + oc; s1 = row + oc + 4; }
            else if (n < 2840) { s0 = row + 1280 + (n - 2816); s1 = s0 + 4; }
            else if (n == 2840) { s0 = row + 2072; s1 = nullptr; }
            else { s0 = nullptr; s1 = nullptr; }
            conv8(s0, s1, win + lk * NPW + n);
        }
    } else {
        bf16_t* wot = (bf16_t*)(w + WS_WOT);
        const size_t oo = (size_t)l * D * D;
        for (size_t i = gtid; i < (size_t)D * D / 8; i += gsz) conv8(p.w_out + oo + i * 8, p.w_out + oo + i * 8 + 4, wot + oo + i * 8);
        for (size_t i = gtid; i < (size_t)2 * 2048 * 128 / 8; i += gsz) {
            const size_t per = (size_t)2048 * 128 / 8; const int kv = (int)(i / per), lk = l * 2 + kv; const size_t off = (i % per) * 8;
            const float* src = (kv ? p.cmp_w1_v : p.cmp_w1_k) + (size_t)l * 2048 * 128 + off;
            conv8(src, src + 4, (bf16_t*)(w + WS_CW1) + (size_t)lk * 2048 * 128 + off);
        }
    }
}
DEV void ph_convert_experts(const P& p, int l) {
    const int TIDX = otid(), BIDX = obid();
    unsigned char* w = p.ws; asm volatile("" : "+s"(w));
    bf16_t* w13 = (bf16_t*)(w + WS_W13); bf16_t* w2t = (bf16_t*)(w + WS_W2);
    const size_t gtid = (size_t)BIDX * 256 + TIDX, gsz = (size_t)gridDim.x * 256;
    for (size_t i = gtid; i < (size_t)32 * D * 128; i += gsz) {
        const int g8 = (int)(i & 127); const size_t lek = (size_t)l * 32 * D + (i >> 7);
        const int n = g8 * 8, which = (n >> 5) & 1, c = 32 * (n >> 6) + (n & 31);
        const float* src = (which ? p.e_w3 : p.e_w1) + lek * 512 + c;
        conv8(src, src + 4, w13 + lek * 1024 + n);
    }
    const size_t o2 = (size_t)l * 32 * 512 * D;
    for (size_t i = gtid; i < (size_t)32 * 512 * D / 8; i += gsz) conv8(p.e_w2 + o2 + i * 8, p.e_w2 + o2 + i * 8 + 4, w2t + o2 + i * 8);
}
DEV void ph_convert(const P& p, float* lds) {
    const int TIDX = otid(), BIDX = obid();
    unsigned char* w = p.ws; asm volatile("" : "+s"(w));
    const int lane = TIDX & 63;
    for (int unit = BIDX * 4 + (TIDX >> 6); unit < DEPTH * 2 * 4; unit += gridDim.x * 4) {
        const int lk = unit >> 2, t = unit & 3, l = lk >> 1, kv = lk & 1;
        conv_patch((kv ? p.cmp_w2_v : p.cmp_w2_k) + (size_t)l * 128 * 64, 64, 128, (bf16_t*)(w + WS_CW2) + (size_t)lk * 64 * 128, (t >> 1) * 64, (t & 1) * 32, [](int n) { return n; }, lane);
    }
    for (int o = BIDX * 256 + TIDX; o < DEPTH * 64 * D; o += gridDim.x * 256) {
        const int k = o & (D - 1), n = (o >> 10) & 63, l = o >> 16;
        const float val = n < 4 ? p.rg_w[((size_t)l * D + k) * 4 + n] : (n < 36 ? p.re_w[((size_t)l * D + k) * 32 + n - 4] : 0.f);
        const bf16_t hi = f2bf(val); const bf16_t lo = f2bf(val - bf2f(hi));
        bf16_t* wr = (bf16_t*)(w + WS_WR) + (size_t)l * 2 * 64 * D;
        wr[n * D + k] = hi; wr[64 * D + n * D + k] = lo;
    }
    for (int o = BIDX * 256 + TIDX; o < DEPTH * 2 * 128 * 16; o += gridDim.x * 256) {
        const int part = o & 15, j = (o >> 4) & 127, lk = o >> 11, l = lk >> 1, kv = lk & 1;
        const float* pe = (kv ? p.cmp_pos_v : p.cmp_pos_k) + (size_t)l * 2048;
        const float* w1 = (kv ? p.cmp_w1_v : p.cmp_w1_k) + (size_t)l * 2048 * 128;
        float a = 0.f;
        for (int k = part * 128; k < part * 128 + 128; ++k) a += pe[k] * w1[(size_t)k * 128 + j];
        a += __shfl_xor(a, 1); a += __shfl_xor(a, 2); a += __shfl_xor(a, 4); a += __shfl_xor(a, 8);
        if (part == 0) ((float*)(w + WS_CPB))[lk * 128 + j] = a;
    }
}

typedef short v4i16_t __attribute__((ext_vector_type(4)));
DEV void gemm_issue0(unsigned char* lds, const bf16_t* const (&arow)[4], const bf16_t* Bsrc, const size_t ldb, const int TIDX) {
    const int lane = TIDX & 63, wave = TIDX >> 6;
    const int gsw = ((TIDX & 7) ^ ((TIDX >> 4) & 7)) * 8;
    const bf16_t* bg = Bsrc + (size_t)(4 * wave + (lane >> 4)) * ldb + ((lane & 15) ^ (((lane >> 4) << 2) | (wave & 3))) * 8;
    LAS unsigned char* l3 = (LAS unsigned char*)lds + __builtin_amdgcn_readfirstlane(wave) * 1024;
#pragma unroll
    for (int i = 0; i < 4; ++i) {
        __builtin_amdgcn_global_load_lds((const unsigned*)(arow[i] + gsw), (LAS unsigned*)(l3 + i * 4096), 16, 0, 0);
        __builtin_amdgcn_global_load_lds((const unsigned*)(bg + (size_t)(16 * i) * ldb), (LAS unsigned*)(l3 + 16384 + i * 4096), 16, 0, 0);
    }
}
template <bool SWAP, bool PRE = false>
DEV void gemm128(unsigned char* lds, const bf16_t* const (&arow)[4], const bf16_t* Bsrc, const size_t ldb, int K, f32x16 (&acc)[2][2], const int TIDX, const int astride = 64) {
    const int lane = TIDX & 63, wave = TIDX >> 6, wm = wave >> 1, wn = wave & 1, r = lane & 31, h = lane >> 5;
#pragma unroll
    for (int j = 0; j < 2; ++j)
#pragma unroll
        for (int i = 0; i < 2; ++i)
#pragma unroll
            for (int q = 0; q < 16; ++q) acc[j][i][q] = 0.f;
    const int gsw = ((TIDX & 7) ^ ((TIDX >> 4) & 7)) * 8;
    const bf16_t* ag[4];
#pragma unroll
    for (int i = 0; i < 4; ++i) ag[i] = arow[i] + gsw;
    const int brow = 4 * wave + (lane >> 4), bch = ((lane & 15) ^ (((lane >> 4) << 2) | (wave & 3))) * 8;
    const bf16_t* bg = Bsrc + (size_t)brow * ldb + bch;
    LAS unsigned char* l3 = (LAS unsigned char*)lds + __builtin_amdgcn_readfirstlane(wave) * 1024;
    LAS unsigned char* tb[2][2];
    {
        const int blk = (lane >> 4) & 1, q = (lane & 15) >> 2, pp = lane & 3;
#pragma unroll
        for (int j = 0; j < 2; ++j)
#pragma unroll
            for (int t = 0; t < 2; ++t) {
                const int row = 4 * t + 8 * h + q, ch = 4 * (2 * wn + j) + 2 * blk + (pp >> 1);
                tb[j][t] = (LAS unsigned char*)lds + 16384 + 256 * row + 16 * (ch ^ (((row & 3) << 2) | ((row >> 2) & 3))) + 8 * (pp & 1);
            }
    }
#define G_DMA(st_, kt_) do { _Pragma("unroll") for (int i = 0; i < 4; ++i) { \
        __builtin_amdgcn_global_load_lds((const unsigned*)(ag[i] + (size_t)(kt_) * astride), (LAS unsigned*)(l3 + (st_) + i * 4096), 16, 0, 0); \
        __builtin_amdgcn_global_load_lds((const unsigned*)(bg + ((size_t)(kt_) * 64 + 16 * i) * ldb), (LAS unsigned*)(l3 + (st_) + 16384 + i * 4096), 16, 0, 0); } } while (0)
    const int KT = K >> 6;
    if (!PRE) {
        __syncthreads();
        G_DMA(0, 0);
    }
    for (int kt = 0; kt < KT; ++kt) {
        asm volatile("s_waitcnt vmcnt(0) lgkmcnt(0)" ::: "memory");
        __builtin_amdgcn_s_barrier();
        asm volatile("" ::: "memory");
        if (kt + 1 < KT) G_DMA(((kt + 1) & 1) * 32768, kt + 1);
        const int so = (kt & 1) * 32768;
        const unsigned char* cur = lds + so;
#pragma unroll
        for (int kk = 0; kk < 4; ++kk) {
            bf16x8 af[2], wf[2];
#pragma unroll
            for (int i = 0; i < 2; ++i) af[i] = *(const bf16x8*)(cur + tile_off(64 * wm + 32 * i + r, 2 * kk + h));
#pragma unroll
            for (int j = 0; j < 2; ++j) {
                const v4i16_t lo = __builtin_amdgcn_ds_read_tr16_b64_v4i16((LAS v4i16_t*)(tb[j][0] + so + 4096 * kk));
                const v4i16_t hi = __builtin_amdgcn_ds_read_tr16_b64_v4i16((LAS v4i16_t*)(tb[j][1] + so + 4096 * kk));
                wf[j] = (bf16x8){lo[0], lo[1], lo[2], lo[3], hi[0], hi[1], hi[2], hi[3]};
            }
#pragma unroll
            for (int j = 0; j < 2; ++j)
#pragma unroll
                for (int i = 0; i < 2; ++i) acc[j][i] = SWAP ? __builtin_amdgcn_mfma_f32_32x32x16_bf16(af[i], wf[j], acc[j][i], 0, 0, 0)
                                                             : __builtin_amdgcn_mfma_f32_32x32x16_bf16(wf[j], af[i], acc[j][i], 0, 0, 0);
        }
    }
    __syncthreads();
#undef G_DMA
}

constexpr int CST = 272;
DEV void ctile_put(unsigned char* lds, int row, int col, float a, float b, float c, float d) {
    uint2 u; u.x = cvtpk(a, b); u.y = cvtpk(c, d);
    *(uint2*)(lds + row * CST + col * 2) = u;
}
template <int COLS, class RP>
DEV void ctile_flush(unsigned char* lds, const int TIDX, RP rowptr) {
    asm volatile("s_waitcnt lgkmcnt(0)" ::: "memory");
    __builtin_amdgcn_s_barrier();
    asm volatile("" ::: "memory");
    constexpr int CPR = COLS / 8, RPI = 256 / CPR;
#pragma unroll
    for (int it = 0; it < 128 / RPI; ++it) {
        const int row = it * RPI + TIDX / CPR, c16 = TIDX % CPR;
        bf16_t* dst = rowptr(row, it);
        const u32x4 val = *(const u32x4*)(lds + row * CST + c16 * 16);
        if (dst) *(u32x4*)(dst + c16 * 8) = val;
    }
}

DEV void ph_inproj_fast(const P& p, int l, unsigned char* lds) {
    const V v = make_views(p); const int TIDX = otid(), BIDX = obid();
    const bf16_t* W = (const bf16_t*)(p.ws + WS_WIN) + (size_t)l * D * NPW;
    const int lane = TIDX & 63, wave = TIDX >> 6, wm = wave >> 1, wn = wave & 1, r = lane & 31, h = lane >> 5;
    const bool xo = gridDim.x == 512;
    unsigned char* ct = lds + 32768;
    auto decode = [&](int it, int& mt, int& nt) -> int {
        if (xo) { if (it >= 6) return -1; const int lb = BIDX >> 3; nt = 8 * (it % 3) + (lb >> 3); mt = 16 * (BIDX & 7) + 8 * (it / 3) + (lb & 7); return nt < 23 ? 1 : 0; }
        const int unit = BIDX + it * (int)gridDim.x; if (unit >= 128 * 23) return -1; nt = unit / 128; mt = unit % 128; return 1;
    };
    auto issue = [&](int mt, int nt) {
        const bf16_t* ar[4];
#pragma unroll
        for (int i = 0; i < 4; ++i) ar[i] = v.H + (size_t)(mt * 128 + (TIDX >> 3) + 32 * i) * D;
        gemm_issue0(lds, ar, W + nt * 128, NPW, TIDX);
    };
    bool pre = false;
    for (int it = 0;; ++it) {
        int nt, mt;
        const int dv = decode(it, mt, nt);
        if (dv < 0) break;
        if (dv == 0) continue;
        const int m0 = mt * 128, n0 = nt * 128;
        const bf16_t* arow[4];
#pragma unroll
        for (int i = 0; i < 4; ++i) arow[i] = v.H + (size_t)(m0 + (TIDX >> 3) + 32 * i) * D;
        if (!pre) { __syncthreads(); issue(mt, nt); pre = true; }
        int itn = it + 1, mtn = 0, ntn = 0, dn;
        while ((dn = decode(itn, mtn, ntn)) == 0) ++itn;
        f32x16 acc[2][2];
        if (is_vcol(n0)) {
            gemm128<true, true>(lds, arow, W + n0, NPW, D, acc, TIDX);
            if (dn > 0) issue(mtn, ntn); else pre = false;
#pragma unroll
            for (int j = 0; j < 2; ++j)
#pragma unroll
                for (int i = 0; i < 2; ++i)
#pragma unroll
                    for (int g = 0; g < 4; ++g)
                        ctile_put(ct, 64 * wn + 32 * j + r, 64 * wm + 32 * i + 8 * g + 4 * h, acc[j][i][4 * g], acc[j][i][4 * g + 1], acc[j][i][4 * g + 2], acc[j][i][4 * g + 3]);
            bf16_t* vt = (bf16_t*)(p.ws + WS_VT) + ((size_t)(m0 >> 11) * 768 + vt_row(n0)) * S + (m0 & (S - 1));
            ctile_flush<128>(ct, TIDX, [&](int row, int) { return vt + (size_t)row * S; });
            continue;
        }
        const bool rope_tile = n0 < 512 || n0 == C_KS || n0 == C_KW;
        f32x4v rcs[2], rsn[2];
        if (rope_tile) {
#pragma unroll
            for (int i = 0; i < 2; ++i) {
                const int sp = (m0 + 64 * wm + 32 * i + r) & (S - 1);
                rcs[i] = *(const f32x4v*)(v.rcos + sp * 8 + 4 * h); rsn[i] = *(const f32x4v*)(v.rsin + sp * 8 + 4 * h);
            }
        }
        gemm128<false, true>(lds, arow, W + n0, NPW, D, acc, TIDX);
        if (dn > 0) issue(mtn, ntn); else pre = false;
        if (n0 == 2816) {
            if (wn == 0) {
#pragma unroll
                for (int i = 0; i < 2; ++i) {
                    const int m = m0 + 64 * wm + 32 * i + r;
#pragma unroll
                    for (int q = 0; q < 16; ++q) {
                        const int cc = (q & 3) + 8 * (q >> 2) + 4 * h;
                        if (cc < 24) v.gf[(size_t)m * 32 + cc] = acc[0][i][q];
                        else if (cc < 28) ((float*)(p.ws + WS_LSF))[(size_t)((m >> 11) * 4 + cc - 24) * S + (m & (S - 1))] = logsigmoidf_(acc[0][i][q] + p.b_forget[l * 4 + cc - 24]);
                    }
                }
            }
            continue;
        }
#pragma unroll
        for (int j = 0; j < 2; ++j) {
            const int nb = n0 + 64 * wn + 32 * j;
            const bool rope = ((nb & 63) == 0) && (nb < 512 || (nb >= C_KS && nb < C_VS) || (nb >= C_KW && nb < C_VW));
#pragma unroll
            for (int i = 0; i < 2; ++i) {
                f32x16 a = acc[j][i];
                if (rope) {
#pragma unroll
                    for (int q = 0; q < 4; ++q) { const float x1 = a[q], x2 = a[q + 4]; a[q] = x1 * rcs[i][q] - x2 * rsn[i][q]; a[q + 4] = x2 * rcs[i][q] + x1 * rsn[i][q]; }
                }
#pragma unroll
                for (int g = 0; g < 4; ++g) ctile_put(ct, 64 * wm + 32 * i + r, 64 * wn + 32 * j + 8 * g + 4 * h, a[4 * g], a[4 * g + 1], a[4 * g + 2], a[4 * g + 3]);
            }
        }
        bf16_t* ub = v.U + (size_t)m0 * NP + n0;
        ctile_flush<128>(ct, TIDX, [&](int row, int) { return ub + (size_t)row * NP; });
    }
}

DEV void ph_outproj_fast(const P& p, int l, unsigned char* lds) {
    const V v = make_views(p); const int TIDX = otid(), BIDX = obid();
    const bf16_t* W = (const bf16_t*)(p.ws + WS_WOT) + (size_t)l * D * D;
    const int lane = TIDX & 63, wave = TIDX >> 6, wm = wave >> 1, wn = wave & 1, r = lane & 31, h = lane >> 5;
    const bool xo = gridDim.x == 512;
    auto decode = [&](int it, int& mt, int& nt) -> bool {
        if (xo) { if (it >= 2) return false; const int lb = BIDX >> 3; nt = lb >> 3; mt = 16 * (BIDX & 7) + 8 * it + (lb & 7); return true; }
        const int unit = BIDX + it * (int)gridDim.x; if (unit >= 128 * 8) return false; nt = unit / 128; mt = unit % 128; return true;
    };
    auto issue = [&](int mt, int nt) {
        const bf16_t* ar[4];
#pragma unroll
        for (int i = 0; i < 4; ++i) ar[i] = v.O + (size_t)(mt * 128 + (TIDX >> 3) + 32 * i) * D;
        gemm_issue0(lds, ar, W + nt * 128, D, TIDX);
    };
    for (int it = 0;; ++it) {
        int nt, mt, ntn = 0, mtn = 0;
        if (!decode(it, mt, nt)) break;
        const bool hasn = decode(it + 1, mtn, ntn);
        const int m0 = mt * 128, n0 = nt * 128;
        const bf16_t* arow[4];
#pragma unroll
        for (int i = 0; i < 4; ++i) arow[i] = v.O + (size_t)(m0 + (TIDX >> 3) + 32 * i) * D;
        if (it == 0) { __syncthreads(); issue(mt, nt); }
        f32x4v xin[2][2][4];
#pragma unroll
        for (int j = 0; j < 2; ++j)
#pragma unroll
            for (int i = 0; i < 2; ++i)
#pragma unroll
                for (int g = 0; g < 4; ++g) xin[j][i][g] = *(const f32x4v*)(v.X + (size_t)(m0 + 64 * wm + 32 * i + r) * D + n0 + 64 * wn + 32 * j + 4 * h + 8 * g);
        f32x16 acc[2][2];
        gemm128<false, true>(lds, arow, W + n0, D, D, acc, TIDX);
        if (hasn) issue(mtn, ntn);
        const float* g1 = v.mod + (size_t)(l * 8 + (m0 >> 11)) * 6144 + 2 * D;
#pragma unroll
        for (int j = 0; j < 2; ++j)
#pragma unroll
            for (int i = 0; i < 2; ++i) {
                const int m = m0 + 64 * wm + 32 * i + r, nb = n0 + 64 * wn + 32 * j + 4 * h;
#pragma unroll
                for (int g = 0; g < 4; ++g) {
                    const float4 gg = *(const float4*)(g1 + nb + 8 * g);
                    f32x4v xo = xin[j][i][g];
                    xo[0] += gg.x * acc[j][i][4 * g]; xo[1] += gg.y * acc[j][i][4 * g + 1]; xo[2] += gg.z * acc[j][i][4 * g + 2]; xo[3] += gg.w * acc[j][i][4 * g + 3];
                    *(f32x4v*)(v.X + (size_t)m * D + nb + 8 * g) = xo;
                }
            }
    }
}

DEV void ph_moe_up_fast(const P& p, int l, unsigned char* lds) {
    const V v = make_views(p); const int TIDX = otid(), BIDX = obid();
    const int lane = TIDX & 63, wave = TIDX >> 6, wm = wave >> 1, wn = wave & 1, r = lane & 31, h = lane >> 5;
    const unsigned* cnt = v.ctl + CW_CNT + l * 32;
    int* tp = (int*)(lds + 67584); int* rb = tp + 40;
    __syncthreads();
    if (TIDX < 64) {
        const int c = TIDX < 32 ? (int)cnt[TIDX] : 0;
        int nu = ((c + 127) >> 7) * 8, cc = c;
#pragma unroll
        for (int o = 1; o < 32; o <<= 1) { const int a = __shfl_up(nu, o), b2 = __shfl_up(cc, o); if ((TIDX & 31) >= o) { nu += a; cc += b2; } }
        if (TIDX < 32) { tp[TIDX + 1] = nu; rb[TIDX + 1] = cc; if (TIDX == 0) { tp[0] = 0; rb[0] = 0; } }
    }
    __syncthreads();
    const int total = tp[32];
    unsigned char* ct = lds + 32768;
    struct UU { int e, base, nt, mt, nrow; const int* lst; const bf16_t* B; const bf16_t* ar[4]; };
    auto setup = [&](int unit, UU& u) {
        int e = 0;
#pragma unroll
        for (int st = 16; st > 0; st >>= 1) if (tp[e + st] <= unit) e += st;
        const int rem = unit - tp[e];
        u.e = e; u.base = rb[e]; u.nt = rem & 7; u.mt = rem >> 3;
        const int ce = rb[e + 1] - u.base;
        u.lst = v.list + (size_t)e * T + u.mt * 128;
        u.nrow = ce - u.mt * 128 < 128 ? ce - u.mt * 128 : 128;
        u.B = (const bf16_t*)(p.ws + WS_W13) + ((size_t)l * 32 + e) * 1024 * D + u.nt * 128;
#pragma unroll
        for (int i = 0; i < 4; ++i) { const int rr = (TIDX >> 3) + 32 * i; u.ar[i] = v.H + (size_t)(u.lst[rr < u.nrow ? rr : 0] >> 1) * D; }
    };
    int unit = BIDX;
    if (unit >= total) return;
    UU cu, nu;
    setup(unit, cu);
    __syncthreads();
    gemm_issue0(lds, cu.ar, cu.B, 1024, TIDX);
    for (;;) {
        const int un = unit + (int)gridDim.x;
        f32x16 acc[2][2];
        gemm128<false, true>(lds, cu.ar, cu.B, 1024, D, acc, TIDX);
        if (un < total) { setup(un, nu); gemm_issue0(lds, nu.ar, nu.B, 1024, TIDX); }
#pragma unroll
        for (int i = 0; i < 2; ++i)
#pragma unroll
            for (int g = 0; g < 4; ++g) {
                float o[4];
#pragma unroll
                for (int q = 0; q < 4; ++q) { const float a1 = acc[0][i][4 * g + q], a3 = acc[1][i][4 * g + q]; o[q] = a1 / (1.f + __expf(-a1)) * a3; }
                ctile_put(ct, 64 * wm + 32 * i + r, 32 * wn + 8 * g + 4 * h, o[0], o[1], o[2], o[3]);
            }
        bf16_t* hb = v.HID + (size_t)(cu.base + cu.mt * 128) * 512 + 64 * cu.nt;
        const int nrow = cu.nrow;
        ctile_flush<64>(ct, TIDX, [&](int row, int) { return row < nrow ? hb + (size_t)row * 512 : (bf16_t*)nullptr; });
        if (un >= total) break;
        unit = un; cu = nu;
    }
}
DEV void ph_moe_down_fast(const P& p, int l, unsigned char* lds) {
    const V v = make_views(p); const int TIDX = otid(), BIDX = obid();
    const int lane = TIDX & 63, wave = TIDX >> 6, wm = wave >> 1, wn = wave & 1, r = lane & 31, h = lane >> 5;
    const unsigned* cnt = v.ctl + CW_CNT + l * 32;
    int* tp = (int*)(lds + 67584); int* rb = tp + 40;
    __syncthreads();
    if (TIDX < 64) {
        const int c = TIDX < 32 ? (int)cnt[TIDX] : 0;
        int nu = ((c + 127) >> 7) * 8, cc = c;
#pragma unroll
        for (int o = 1; o < 32; o <<= 1) { const int a = __shfl_up(nu, o), b2 = __shfl_up(cc, o); if ((TIDX & 31) >= o) { nu += a; cc += b2; } }
        if (TIDX < 32) { tp[TIDX + 1] = nu; rb[TIDX + 1] = cc; if (TIDX == 0) { tp[0] = 0; rb[0] = 0; } }
    }
    __syncthreads();
    const int total = tp[32];
    unsigned char* ct = lds + 32768;
    struct UD { int n0, nrow; const bf16_t* B; const bf16_t* ar[4]; float wrow[2]; int fslot[8]; };
    auto setup = [&](int unit, UD& u) {
        int e = 0;
#pragma unroll
        for (int st = 16; st > 0; st >>= 1) if (tp[e + st] <= unit) e += st;
        const int rem = unit - tp[e], base = rb[e];
        const int ce = rb[e + 1] - base, nt = rem & 7, mt = rem >> 3;
        const int* lst = v.list + (size_t)e * T + mt * 128;
        u.n0 = nt * 128;
        u.nrow = ce - mt * 128 < 128 ? ce - mt * 128 : 128;
        u.B = (const bf16_t*)(p.ws + WS_W2) + ((size_t)l * 32 + e) * 512 * D + u.n0;
#pragma unroll
        for (int i = 0; i < 4; ++i) { const int rr = (TIDX >> 3) + 32 * i; u.ar[i] = v.HID + (size_t)(base + mt * 128 + (rr < u.nrow ? rr : 0)) * 512; }
#pragma unroll
        for (int i = 0; i < 2; ++i) { const int mr = 64 * wm + 32 * i + r; u.wrow[i] = mr < u.nrow ? v.wts[lst[mr]] : 0.f; }
#pragma unroll
        for (int it = 0; it < 8; ++it) { const int row = it * 16 + (TIDX >> 4); u.fslot[it] = row < u.nrow ? lst[row] : -1; }
    };
    int unit = BIDX;
    if (unit >= total) return;
    UD cu, nu;
    setup(unit, cu);
    __syncthreads();
    gemm_issue0(lds, cu.ar, cu.B, D, TIDX);
    for (;;) {
        const int un = unit + (int)gridDim.x;
        f32x16 acc[2][2];
        gemm128<false, true>(lds, cu.ar, cu.B, D, 512, acc, TIDX);
        if (un < total) { setup(un, nu); gemm_issue0(lds, nu.ar, nu.B, D, TIDX); }
#pragma unroll
        for (int i = 0; i < 2; ++i) {
            const int mr = 64 * wm + 32 * i + r;
            const float w = cu.wrow[i];
#pragma unroll
            for (int j = 0; j < 2; ++j)
#pragma unroll
                for (int g = 0; g < 4; ++g)
                    ctile_put(ct, mr, 64 * wn + 32 * j + 8 * g + 4 * h, w * acc[j][i][4 * g], w * acc[j][i][4 * g + 1], w * acc[j][i][4 * g + 2], w * acc[j][i][4 * g + 3]);
        }
        const int n0 = cu.n0;
        ctile_flush<128>(ct, TIDX, [&](int, int it) { const int sl = cu.fslot[it]; return sl >= 0 ? v.Y + (size_t)sl * D + n0 : (bf16_t*)nullptr; });
        if (un >= total) break;
        unit = un; cu = nu;
    }
}

constexpr float LOG2E = 1.4426950408889634f, C2 = 0.125f * 1.4426950408889634f, LN2 = 0.6931471805599453f;
DEV float fexp2(float x) { return __builtin_amdgcn_exp2f(x); }
DEV float flog2(float x) { return __builtin_amdgcn_logf(x); }
DEV int swap23(int r) { return (r & ~12) | ((r & 4) << 1) | ((r & 8) >> 1); }

struct KVT { const bf16_t* k; int ks; const bf16_t* v; int vs; };
DEV void kv_load(const KVT& s, int kv0, const int TIDX, u32x4 (&rg)[4]) {
    const int c = TIDX & 7, r0 = TIDX >> 3;
    rg[0] = *(const u32x4*)(s.k + (size_t)(kv0 + r0) * s.ks + c * 8);
    rg[1] = *(const u32x4*)(s.k + (size_t)(kv0 + r0 + 32) * s.ks + c * 8);
    rg[2] = *(const u32x4*)(s.v + (size_t)r0 * s.vs + kv0 + c * 8);
    rg[3] = *(const u32x4*)(s.v + (size_t)(r0 + 32) * s.vs + kv0 + c * 8);
}
DEV void kv_store(unsigned char* st, const int TIDX, const u32x4 (&rg)[4]) {
    const int c = TIDX & 7, r0 = TIDX >> 3;
    *(u32x4*)(st + tile_off(r0, c)) = rg[0]; *(u32x4*)(st + tile_off(r0 + 32, c)) = rg[1];
    *(u32x4*)(st + 8192 + tile_off(r0, c)) = rg[2]; *(u32x4*)(st + 8192 + tile_off(r0 + 32, c)) = rg[3];
}
DEV bf16x8 scale_frag(bf16x8 v, float sc) {
    u32x4 u = __builtin_bit_cast(u32x4, v);
#pragma unroll
    for (int i = 0; i < 4; ++i) u[i] = cvtpk(__uint_as_float(u[i] << 16) * sc, __uint_as_float(u[i] & 0xffff0000u) * sc);
    return __builtin_bit_cast(bf16x8, u);
}
DEV void score_tile(const unsigned char* Kt, const bf16x8 (&qf)[4], int r, int h, f32x16 (&p)[2]) {
    const int kr = swap23(r);
#pragma unroll
    for (int blk = 0; blk < 2; ++blk) {
#pragma unroll
        for (int q = 0; q < 16; ++q) p[blk][q] = 0.f;
#pragma unroll
        for (int s = 0; s < 4; ++s) {
            const bf16x8 kf = *(const bf16x8*)(Kt + tile_off(32 * blk + kr, 2 * s + h));
            p[blk] = __builtin_amdgcn_mfma_f32_32x32x16_bf16(kf, qf[s], p[blk], 0, 0, 0);
        }
    }
}
DEV void pv_tile(const unsigned char* Vt, const f32x16 (&p)[2], int r, int h, f32x16 (&o)[2]) {
#pragma unroll
    for (int blk = 0; blk < 2; ++blk)
#pragma unroll
        for (int s = 0; s < 2; ++s) {
            u32x4 pk;
            pk.x = cvtpk(p[blk][8 * s], p[blk][8 * s + 1]); pk.y = cvtpk(p[blk][8 * s + 2], p[blk][8 * s + 3]);
            pk.z = cvtpk(p[blk][8 * s + 4], p[blk][8 * s + 5]); pk.w = cvtpk(p[blk][8 * s + 6], p[blk][8 * s + 7]);
            const bf16x8 pb = __builtin_bit_cast(bf16x8, pk);
#pragma unroll
            for (int db = 0; db < 2; ++db) {
                const bf16x8 vf = *(const bf16x8*)(Vt + tile_off(32 * db + r, 2 * (2 * blk + s) + h));
                o[db] = __builtin_amdgcn_mfma_f32_32x32x16_bf16(vf, pb, o[db], 0, 0, 0);
            }
        }
}

template <int VAR>
DEV void attn_branch(unsigned char* lds, const KVT& src, const bf16x8 (&qf)[4], unsigned tmask, int wave_last, int t, int t_first,
                     unsigned selbits, const float* bias2, f32x16 (&o)[2], const int TIDX) {
    const int lane = TIDX & 63, r = lane & 31, h = lane >> 5;
    const float NEG_INF = -__builtin_inff();
    float mrun = -1e30f, lrun = 0.f, rest = VAR == 3 ? 1.f : 0.f;
#pragma unroll
    for (int db = 0; db < 2; ++db)
#pragma unroll
        for (int q = 0; q < 16; ++q) o[db][q] = 0.f;
    u32x4 rg[4];
    unsigned rem = tmask;
    int j = VAR == 3 ? 31 - __builtin_clz(rem) : __builtin_ctz(rem);
    rem &= ~(1u << j);
    kv_load(src, 64 * j, TIDX, rg);
    __syncthreads();
    kv_store(lds, TIDX, rg);
    __syncthreads();
    int stage = 0;
    for (;;) {
        int jn = -1;
        if (rem) { jn = VAR == 3 ? 31 - __builtin_clz(rem) : __builtin_ctz(rem); rem &= ~(1u << jn); kv_load(src, 64 * jn, TIDX, rg); }
        asm volatile("" ::: "memory"); __builtin_amdgcn_sched_barrier(0);
        if (j <= wave_last) {
            const unsigned char* Kt = lds + stage * 16384;
            f32x16 p[2];
            score_tile(Kt, qf, r, h, p);
            const int kvb = 64 * j + 8 * h;
            if (VAR == 3) {
                const bool diag = 64 * j + 63 >= t_first;
                float gt[2][2];
#pragma unroll
                for (int blk = 0; blk < 2; ++blk)
#pragma unroll
                    for (int s = 0; s < 2; ++s) {
                        float run = 1.f;
#pragma unroll
                        for (int q = 7; q >= 0; --q) {
                            const float z = fminf(fmaxf(p[blk][8 * s + q], -80.f), 80.f);
                            const float ez = fexp2(z * LOG2E);
                            float w = __builtin_amdgcn_rcpf(1.f + ez);
                            float beta = ez * w;
                            const bool valid = !diag || (kvb + 32 * blk + 16 * s + q < t);
                            w = valid ? w : 1.f; beta = valid ? beta : 0.f;
                            p[blk][8 * s + q] = beta * run;
                            run *= w;
                        }
                        gt[blk][s] = run;
                    }
                float og[2][2], pt[2][2];
#pragma unroll
                for (int blk = 0; blk < 2; ++blk)
#pragma unroll
                    for (int s = 0; s < 2; ++s) { og[blk][s] = __shfl_xor(gt[blk][s], 32); pt[blk][s] = gt[blk][s] * og[blk][s]; }
                float above = rest;
#pragma unroll
                for (int pi = 3; pi >= 0; --pi) {
                    const int blk = pi >> 1, s = pi & 1;
                    const float carry = above * (h == 0 ? og[blk][s] : 1.f);
#pragma unroll
                    for (int q = 0; q < 8; ++q) p[blk][8 * s + q] *= carry;
                    above *= pt[blk][s];
                }
                rest = above;
            } else {
                const bool need_causal = 64 * j + 63 > t_first;
                const bool need_win = VAR == 1 && (64 * j + 512 <= t_first + 31);
                const bool lane_on = VAR != 0 || ((selbits >> j) & 1u);
                if (VAR == 2) {
#pragma unroll
                    for (int blk = 0; blk < 2; ++blk)
#pragma unroll
                        for (int s = 0; s < 2; ++s) {
                            const float4 b0 = *(const float4*)(bias2 + kvb + 32 * blk + 16 * s), b1 = *(const float4*)(bias2 + kvb + 32 * blk + 16 * s + 4);
                            p[blk][8 * s] += b0.x; p[blk][8 * s + 1] += b0.y; p[blk][8 * s + 2] += b0.z; p[blk][8 * s + 3] += b0.w;
                            p[blk][8 * s + 4] += b1.x; p[blk][8 * s + 5] += b1.y; p[blk][8 * s + 6] += b1.z; p[blk][8 * s + 7] += b1.w;
                        }
                }
                if (need_causal) {
#pragma unroll
                    for (int blk = 0; blk < 2; ++blk)
#pragma unroll
                        for (int q = 0; q < 16; ++q) { const int kv = kvb + 32 * blk + 16 * (q >> 3) + (q & 7); p[blk][q] = kv <= t ? p[blk][q] : NEG_INF; }
                }
                if (need_win) {
#pragma unroll
                    for (int blk = 0; blk < 2; ++blk)
#pragma unroll
                        for (int q = 0; q < 16; ++q) { const int kv = kvb + 32 * blk + 16 * (q >> 3) + (q & 7); p[blk][q] = kv + 512 > t ? p[blk][q] : NEG_INF; }
                }
                float tmax = p[0][0];
#pragma unroll
                for (int q = 1; q < 16; ++q) tmax = fmaxf(tmax, p[0][q]);
#pragma unroll
                for (int q = 0; q < 16; ++q) tmax = fmaxf(tmax, p[1][q]);
                tmax = lane_on ? tmax : NEG_INF;
                tmax = fmaxf(tmax, __shfl_xor(tmax, 32));
                const float mnew = fmaxf(mrun, tmax);
                const bool grew = mnew > mrun;
                const float alpha = fexp2(mrun - mnew);
                mrun = mnew;
                const float msub = lane_on ? mnew : __builtin_inff();
                const f32x2_t ms2 = {msub, msub};
                f32x2_t ls2 = {0.f, 0.f};
#pragma unroll
                for (int blk = 0; blk < 2; ++blk)
#pragma unroll
                    for (int q = 0; q < 16; q += 2) {
                        const f32x2_t d2 = (f32x2_t){p[blk][q], p[blk][q + 1]} - ms2;
                        f32x2_t e2; e2.x = fexp2(d2.x); e2.y = fexp2(d2.y);
                        p[blk][q] = e2.x; p[blk][q + 1] = e2.y; ls2 += e2;
                    }
                lrun = lrun * alpha + (ls2.x + ls2.y);
                if (__any(grew)) {
#pragma unroll
                    for (int db = 0; db < 2; ++db)
#pragma unroll
                        for (int q = 0; q < 16; ++q) o[db][q] *= alpha;
                }
            }
            pv_tile(Kt + 8192, p, r, h, o);
        }
        if (jn >= 0) kv_store(lds + (stage ^ 1) * 16384, TIDX, rg);
        __syncthreads();
        if (jn < 0) break;
        j = jn; stage ^= 1;
    }
    if (VAR != 3) {
        const float lt = lrun + __shfl_xor(lrun, 32);
        const float inv = lt > 0.f ? 1.f / lt : 0.f;
#pragma unroll
        for (int db = 0; db < 2; ++db)
#pragma unroll
            for (int q = 0; q < 16; ++q) o[db][q] *= inv;
    }
}

DEV void head_norm_store(const f32x16 (&o)[2], const float* gam, bf16_t* dst, int h) {
    float ss = 0.f;
#pragma unroll
    for (int db = 0; db < 2; ++db)
#pragma unroll
        for (int q = 0; q < 16; ++q) ss += o[db][q] * o[db][q];
    ss += __shfl_xor(ss, 32);
    const float rinv = rsqrtf(ss * (1.f / 64.f) + EPS);
#pragma unroll
    for (int db = 0; db < 2; ++db)
#pragma unroll
        for (int g = 0; g < 4; ++g) {
            const int d = 32 * db + 8 * g + 4 * h;
            const float4 gg = *(const float4*)(gam + d);
            uint2 u;
            u.x = cvtpk(o[db][4 * g] * rinv * gg.x, o[db][4 * g + 1] * rinv * gg.y);
            u.y = cvtpk(o[db][4 * g + 2] * rinv * gg.z, o[db][4 * g + 3] * rinv * gg.w);
            *(uint2*)(dst + d) = u;
        }
}

template <int VAR>
DEV void mha_unit(const P& p, int l, int unit, unsigned char* lds) {
    const V v = make_views(p); const int TIDX = otid();
    const int lane = TIDX & 63, wave = TIDX >> 6, r = lane & 31, h = lane >> 5;
    const int qb = 15 - (unit >> 5), bh = unit & 31, b = bh >> 2, hh = bh & 3;
    const int t0 = qb * 128, tw = t0 + 32 * wave, t = tw + r, m = b * S + t;
    const int qcol = VAR == 2 ? C_QB : C_QC, kcol = VAR == 2 ? C_KB : C_KCC, vrow = VAR == 2 ? 256 : 512, ocol = VAR == 2 ? 512 : 768;
    bf16x8 qf[4];
#pragma unroll
    for (int s = 0; s < 4; ++s) qf[s] = scale_frag(*(const bf16x8*)(v.U + (size_t)m * NP + qcol + hh * 64 + 16 * s + 8 * h), VAR == 3 ? SCALE : C2);
    KVT src;
    src.k = v.U + (size_t)b * S * NP + kcol + hh * 64; src.ks = NP;
    src.v = (const bf16_t*)(p.ws + WS_VT) + (size_t)(b * 768 + vrow + hh * 64) * S; src.vs = S;
    const int last = (t0 + 127) >> 6;
    const unsigned tmask = last == 31 ? 0xffffffffu : ((1u << (last + 1)) - 1u);
    const float* bias2 = (const float*)(lds + 32768);
    if (VAR == 2) {
        float* cf = (float*)(lds + 32768);
        float* wt = (float*)(lds + 32768 + 8192);
        const float* lsf = (const float*)(p.ws + WS_LSF) + (size_t)(b * 4 + hh) * S;
        const int nel = t0 + 128;
        float x[8];
        if (8 * TIDX < nel) {
            const float4 a0 = *(const float4*)(lsf + 8 * TIDX), a1 = *(const float4*)(lsf + 8 * TIDX + 4);
            x[0] = a0.x; x[1] = x[0] + a0.y; x[2] = x[1] + a0.z; x[3] = x[2] + a0.w; x[4] = x[3] + a1.x; x[5] = x[4] + a1.y; x[6] = x[5] + a1.z; x[7] = x[6] + a1.w;
        } else {
#pragma unroll
            for (int q = 0; q < 8; ++q) x[q] = 0.f;
        }
        float inc = x[7];
#pragma unroll
        for (int o = 1; o < 64; o <<= 1) { const float tt = __shfl_up(inc, o); if (lane >= o) inc += tt; }
        __syncthreads();
        if (lane == 63) wt[wave] = inc;
        __syncthreads();
        float off = inc - x[7];
#pragma unroll
        for (int w = 0; w < 3; ++w) off += (w < wave) ? wt[w] : 0.f;
        if (8 * TIDX < nel) {
#pragma unroll
            for (int q = 0; q < 8; ++q) cf[8 * TIDX + q] = -(x[q] + off) * LOG2E;
        }
        __syncthreads();
    }
    f32x16 o[2];
    attn_branch<VAR>(lds, src, qf, tmask, (tw + 31) >> 6, t, tw, 0u, bias2, o, TIDX);
    head_norm_store(o, p.out_norm_g + (size_t)l * D + ocol + hh * 64, v.O + (size_t)m * D + ocol + hh * 64, h);
}

DEV void nsa_unit(const P& p, int l, int unit, unsigned char* lds) {
    const V v = make_views(p); const int TIDX = otid();
    const int lane = TIDX & 63, wave = TIDX >> 6, r = lane & 31, h = lane >> 5;
    const int qblk = 63 - (unit >> 4), bg = unit & 15, b = bg >> 1, g = bg & 1;
    const int t0 = qblk * 32, t = t0 + r, m = b * S + t, head = g * 4 + wave, cur = t0 >> 6;
    const float NEG_INF = -__builtin_inff();
    bf16x8 qf[4];
#pragma unroll
    for (int s = 0; s < 4; ++s) qf[s] = scale_frag(*(const bf16x8*)(v.U + (size_t)m * NP + C_QA + head * 64 + 16 * s + 8 * h), C2);
    const float g0 = sigmoidf_(v.gf[(size_t)m * 32 + head * 3]), g1 = sigmoidf_(v.gf[(size_t)m * 32 + head * 3 + 1]), g2 = sigmoidf_(v.gf[(size_t)m * 32 + head * 3 + 2]);
    f32x16 otot[2];
    float* PA = (float*)(lds + 32768);
    float* PB = (float*)(lds + 49152);
    float* SC = (float*)lds;
    unsigned* MASK = (unsigned*)(lds + 8192);
    {
        const bf16_t* ck = v.ck + (size_t)(b * 2 + g) * 128 * 64;
        const bf16_t* cvt = (const bf16_t*)(p.ws + WS_CVT) + (size_t)(b * 2 + g) * 64 * 128;
        const int c = TIDX & 7, r0 = TIDX >> 3;
        u32x4 rk[4], rv[4];
#pragma unroll
        for (int i = 0; i < 4; ++i) rk[i] = *(const u32x4*)(ck + (size_t)(r0 + 32 * i) * 64 + c * 8);
#pragma unroll
        for (int i = 0; i < 4; ++i) rv[i] = *(const u32x4*)(cvt + (size_t)(r0 + 32 * (i & 1)) * 128 + 64 * (i >> 1) + c * 8);
        __syncthreads();
#pragma unroll
        for (int i = 0; i < 4; ++i) *(u32x4*)(lds + tile_off(r0 + 32 * i, c)) = rk[i];
#pragma unroll
        for (int i = 0; i < 4; ++i) *(u32x4*)(lds + 16384 + 8192 * (i >> 1) + tile_off(r0 + 32 * (i & 1), c)) = rv[i];
        __syncthreads();
        f32x16 ps[2][2];
        score_tile(lds, qf, r, h, ps[0]);
        score_tile(lds + 8192, qf, r, h, ps[1]);
        const int nvalid = t >= 31 ? (t - 31) / 16 + 1 : 0;
        float mx = NEG_INF;
#pragma unroll
        for (int tt = 0; tt < 2; ++tt)
#pragma unroll
            for (int blk = 0; blk < 2; ++blk)
#pragma unroll
                for (int q = 0; q < 16; ++q) {
                    const int n = 64 * tt + 32 * blk + 16 * (q >> 3) + 8 * h + (q & 7);
                    const float x = n < nvalid ? ps[tt][blk][q] : NEG_INF;
                    ps[tt][blk][q] = x; mx = fmaxf(mx, x);
                }
        mx = fmaxf(mx, __shfl_xor(mx, 32));
        const float mxs = nvalid > 0 ? mx : 0.f;
        float ls = 0.f;
#pragma unroll
        for (int tt = 0; tt < 2; ++tt)
#pragma unroll
            for (int blk = 0; blk < 2; ++blk)
#pragma unroll
                for (int q = 0; q < 16; ++q) { const float e = fexp2(ps[tt][blk][q] - mxs); ps[tt][blk][q] = e; ls += e; }
        const float lt = ls + __shfl_xor(ls, 32);
        const float inv = lt > 0.f ? 1.f / lt : 0.f;
#pragma unroll
        for (int tt = 0; tt < 2; ++tt)
#pragma unroll
            for (int blk = 0; blk < 2; ++blk) {
#pragma unroll
                for (int q = 0; q < 16; ++q) ps[tt][blk][q] *= inv;
#pragma unroll
                for (int s = 0; s < 2; ++s) {
                    const int G0 = 16 * tt + 8 * blk + 4 * s + 2 * h;
                    const float a0 = (ps[tt][blk][8 * s] + ps[tt][blk][8 * s + 1]) + (ps[tt][blk][8 * s + 2] + ps[tt][blk][8 * s + 3]);
                    const float a1 = (ps[tt][blk][8 * s + 4] + ps[tt][blk][8 * s + 5]) + (ps[tt][blk][8 * s + 6] + ps[tt][blk][8 * s + 7]);
                    PA[(wave * 32 + G0) * 32 + r] = a0; PA[(wave * 32 + G0 + 1) * 32 + r] = a1;
                    PB[(wave * 32 + G0 + 1) * 32 + r] = ps[tt][blk][8 * s + 3];
                    if (G0 + 2 < 32) PB[(wave * 32 + G0 + 2) * 32 + r] = ps[tt][blk][8 * s + 7];
                }
            }
        f32x16 oc[2];
#pragma unroll
        for (int db = 0; db < 2; ++db)
#pragma unroll
            for (int q = 0; q < 16; ++q) oc[db][q] = 0.f;
        pv_tile(lds + 16384, ps[0], r, h, oc);
        pv_tile(lds + 24576, ps[1], r, h, oc);
#pragma unroll
        for (int db = 0; db < 2; ++db)
#pragma unroll
            for (int q = 0; q < 16; ++q) otot[db][q] = g0 * oc[db][q];
    }
    __syncthreads();
    {
        const int q = TIDX & 31, j0 = (TIDX >> 5) * 4;
#pragma unroll
        for (int jj = 0; jj < 4; ++jj) {
            const int j = j0 + jj;
            float sc = 0.f;
#pragma unroll
            for (int w = 0; w < 4; ++w) sc += PA[(w * 32 + j) * 32 + q];
            if (j > 0) {
#pragma unroll
                for (int w = 0; w < 4; ++w) sc += PB[(w * 32 + j) * 32 + q];
            }
            const bool forced = (j == 0) || (j == cur) || (j == cur - 1);
            SC[q * 33 + j] = forced ? 1.0e4f : (j <= cur ? sc : -1.0f);
        }
        if (TIDX < 32) MASK[TIDX] = 0u;
        __syncthreads();
        unsigned bits = 0u;
#pragma unroll
        for (int jj = 0; jj < 4; ++jj) {
            const int j = j0 + jj;
            const float vj = SC[q * 33 + j];
            int rank = 0;
#pragma unroll
            for (int i = 0; i < 32; ++i) { const float vi = SC[q * 33 + i]; rank += (vi > vj || (vi == vj && i < j)) ? 1 : 0; }
            if (rank < 16) bits |= 1u << j;
        }
        atomicOr(&MASK[q], bits);
        __syncthreads();
    }
    const unsigned mybits = MASK[r];
    unsigned um = 0u;
#pragma unroll
    for (int i = 0; i < 32; ++i) um |= MASK[i];
    um = (unsigned)__builtin_amdgcn_readfirstlane((int)um);
    const unsigned upto = (2u << cur) - 1u;
    {
        KVT src; src.k = v.U + (size_t)b * S * NP + C_KS + g * 64; src.ks = NP;
        src.v = (const bf16_t*)(p.ws + WS_VT) + (size_t)(b * 768 + g * 64) * S; src.vs = S;
        f32x16 o[2];
        attn_branch<0>(lds, src, qf, um & upto, cur, t, t0, mybits, nullptr, o, TIDX);
#pragma unroll
        for (int db = 0; db < 2; ++db)
#pragma unroll
            for (int q = 0; q < 16; ++q) otot[db][q] += g1 * o[db][q];
    }
    {
        KVT src; src.k = v.U + (size_t)b * S * NP + C_KW + g * 64; src.ks = NP;
        src.v = (const bf16_t*)(p.ws + WS_VT) + (size_t)(b * 768 + 128 + g * 64) * S; src.vs = S;
        const int f = (t0 - 511 > 0 ? t0 - 511 : 0) >> 6;
        const unsigned wmask = upto & ~((1u << f) - 1u);
        f32x16 o[2];
        attn_branch<1>(lds, src, qf, wmask, cur, t, t0, 0u, nullptr, o, TIDX);
#pragma unroll
        for (int db = 0; db < 2; ++db)
#pragma unroll
            for (int q = 0; q < 16; ++q) otot[db][q] += g2 * o[db][q];
    }
    head_norm_store(otot, p.out_norm_g + (size_t)l * D + head * 64, v.O + (size_t)m * D + head * 64, h);
}

DEV void cmp_unit(const P& p, int l, int unit, unsigned char* lds) {
    const V v = make_views(p); const int TIDX = otid();
    const int lane = TIDX & 63, wave = TIDX >> 6, wm = wave >> 1, wn = wave & 1, r = lane & 31, h = lane >> 5;
    const int kv = unit & 1, bg = unit >> 1, b = bg >> 1, g = bg & 1, lk = l * 2 + kv;
    const int col = (kv ? C_VC : C_KC) + g * 64;
    const bf16_t* arow[4];
#pragma unroll
    for (int i = 0; i < 4; ++i) { const int n = (TIDX >> 3) + 32 * i; arow[i] = v.U + (size_t)(b * S + 16 * (n < 127 ? n : 126)) * NP + col; }
    f32x16 acc[2][2];
    gemm128<false>(lds, arow, (const bf16_t*)(p.ws + WS_CW1) + (size_t)lk * 2048 * 128, 128, 2048, acc, TIDX, NP);
    const float* pb = (const float*)(p.ws + WS_CPB) + lk * 128;
#pragma unroll
    for (int j = 0; j < 2; ++j)
#pragma unroll
        for (int i = 0; i < 2; ++i) {
            const int mrow = 64 * wm + 32 * i + r;
#pragma unroll
            for (int g4 = 0; g4 < 4; ++g4) {
                const float4 bb = *(const float4*)(pb + 64 * wn + 32 * j + 8 * g4 + 4 * h);
                float x0 = acc[j][i][4 * g4] + bb.x, x1 = acc[j][i][4 * g4 + 1] + bb.y, x2 = acc[j][i][4 * g4 + 2] + bb.z, x3 = acc[j][i][4 * g4 + 3] + bb.w;
                x0 = x0 / (1.f + __expf(-x0)); x1 = x1 / (1.f + __expf(-x1)); x2 = x2 / (1.f + __expf(-x2)); x3 = x3 / (1.f + __expf(-x3));
                uint2 u; u.x = cvtpk(x0, x1); u.y = cvtpk(x2, x3);
                *(uint2*)(lds + wn * 16384 + tile_off(mrow, 4 * j + g4) + 8 * h) = u;
            }
        }
    {
        const bf16_t* w2 = (const bf16_t*)(p.ws + WS_CW2) + (size_t)lk * 64 * 128;
        const int c = TIDX & 7, r0 = TIDX >> 3;
#pragma unroll
        for (int i = 0; i < 4; ++i) {
            const int row = r0 + 32 * (i & 1), kt = i >> 1;
            *(u32x4*)(lds + 32768 + kt * 8192 + tile_off(row, c)) = *(const u32x4*)(w2 + (size_t)row * 128 + kt * 64 + c * 8);
        }
    }
    __syncthreads();
    f32x16 a2[2];
#pragma unroll
    for (int db = 0; db < 2; ++db)
#pragma unroll
        for (int q = 0; q < 16; ++q) a2[db][q] = 0.f;
#pragma unroll
    for (int kt = 0; kt < 2; ++kt)
#pragma unroll
        for (int s = 0; s < 4; ++s) {
            const bf16x8 hf = *(const bf16x8*)(lds + kt * 16384 + tile_off(32 * wave + r, 2 * s + h));
#pragma unroll
            for (int db = 0; db < 2; ++db) {
                const bf16x8 wf = *(const bf16x8*)(lds + 32768 + kt * 8192 + tile_off(32 * db + r, 2 * s + h));
                a2[db] = __builtin_amdgcn_mfma_f32_32x32x16_bf16(wf, hf, a2[db], 0, 0, 0);
            }
        }
    const int n = 32 * wave + r;
    if (kv == 0 && n < 127) {
        const int pos = 16 * n + 31;
#pragma unroll
        for (int q = 0; q < 4; ++q) {
            const float cs = v.rcos[pos * 8 + q + 4 * h], sn = v.rsin[pos * 8 + q + 4 * h];
            const float x1 = a2[0][q], x2 = a2[0][q + 4];
            a2[0][q] = x1 * cs - x2 * sn; a2[0][q + 4] = x2 * cs + x1 * sn;
        }
    }
    bf16_t* dst = (kv ? v.cv : v.ck) + ((size_t)bg * 128 + n) * 64;
    bf16_t* dt = (bf16_t*)(p.ws + WS_CVT) + (size_t)bg * 64 * 128 + n;
#pragma unroll
    for (int db = 0; db < 2; ++db)
#pragma unroll
        for (int g4 = 0; g4 < 4; ++g4) {
            const int d = 32 * db + 8 * g4 + 4 * h;
            float x0 = a2[db][4 * g4], x1 = a2[db][4 * g4 + 1], x2 = a2[db][4 * g4 + 2], x3 = a2[db][4 * g4 + 3];
            if (n >= 127) { x0 = 0.f; x1 = 0.f; x2 = 0.f; x3 = 0.f; }
            uint2 u; u.x = cvtpk(x0, x1); u.y = cvtpk(x2, x3);
            *(uint2*)(dst + d) = u;
            if (kv) { dt[(size_t)d * 128] = (bf16_t)(u.x & 0xffffu); dt[(size_t)(d + 1) * 128] = (bf16_t)(u.x >> 16); dt[(size_t)(d + 2) * 128] = (bf16_t)(u.y & 0xffffu); dt[(size_t)(d + 3) * 128] = (bf16_t)(u.y >> 16); }
        }
    __syncthreads();
}

typedef float f32x4m __attribute__((ext_vector_type(4)));
DEV void ph_norm2_router_fast(const P& p, int l, unsigned char* lds) {
    const V v = make_views(p); const int TIDX = otid(), BIDX = obid();
    const int lane = TIDX & 63, wave = TIDX >> 6;
    const bf16_t* wr = (const bf16_t*)(p.ws + WS_WR) + (size_t)l * 2 * 64 * D;
    float* LG = (float*)(lds + 65536);
    for (int blk = BIDX; blk < T / 16; blk += gridDim.x) {
        const int m0 = blk * 16, b = m0 >> 11;
        const float* md = v.mod + (size_t)(l * 8 + b) * 6144;
        float4 xv[4][4]; float ssq[4];
#pragma unroll
        for (int rr = 0; rr < 4; ++rr)
#pragma unroll
            for (int j = 0; j < 4; ++j) xv[rr][j] = *(const float4*)(v.X + (size_t)(m0 + wave * 4 + rr) * D + 4 * lane + 256 * j);
#pragma unroll
        for (int rr = 0; rr < 4; ++rr) {
            ssq[rr] = 0.f;
#pragma unroll
            for (int j = 0; j < 4; ++j) ssq[rr] += xv[rr][j].x * xv[rr][j].x + xv[rr][j].y * xv[rr][j].y + xv[rr][j].z * xv[rr][j].z + xv[rr][j].w * xv[rr][j].w;
        }
#pragma unroll
        for (int o = 1; o < 64; o <<= 1) {
#pragma unroll
            for (int rr = 0; rr < 4; ++rr) ssq[rr] += __shfl_xor(ssq[rr], o);
        }
#pragma unroll
        for (int rr = 0; rr < 4; ++rr) {
            const int row = wave * 4 + rr, m = m0 + row;
            const float rs = rsqrtf(ssq[rr] * (1.f / D) + EPS);
#pragma unroll
            for (int j = 0; j < 4; ++j) {
                const int c = 4 * lane + 256 * j;
                const float4 g = *(const float4*)(p.norm2_g + l * D + c), sh = *(const float4*)(md + 3 * D + c), sc = *(const float4*)(md + 4 * D + c);
                const float h0 = xv[rr][j].x * rs * g.x * (1.f + sc.x) + sh.x, h1 = xv[rr][j].y * rs * g.y * (1.f + sc.y) + sh.y;
                const float h2 = xv[rr][j].z * rs * g.z * (1.f + sc.z) + sh.z, h3 = xv[rr][j].w * rs * g.w * (1.f + sc.w) + sh.w;
                uint2 hi; hi.x = cvtpk(h0, h1); hi.y = cvtpk(h2, h3);
                uint2 lo;
                lo.x = cvtpk(h0 - __uint_as_float(hi.x << 16), h1 - __uint_as_float(hi.x & 0xffff0000u));
                lo.y = cvtpk(h2 - __uint_as_float(hi.y << 16), h3 - __uint_as_float(hi.y & 0xffff0000u));
                *(uint2*)(v.H + (size_t)m * D + c) = hi;
                const int off = row * 2048 + ((((c >> 3) ^ row) & 127) << 4) + (c & 7) * 2;
                *(uint2*)(lds + off) = hi; *(uint2*)(lds + 32768 + off) = lo;
            }
        }
        __syncthreads();
        {
            const int r16 = lane & 15, kq = lane >> 4;
            f32x4m acc = {0.f, 0.f, 0.f, 0.f};
            const bf16_t* wh = wr + (size_t)(16 * wave + r16) * D + 8 * kq;
#pragma unroll 8
            for (int s = 0; s < 32; ++s) {
                const int off = r16 * 2048 + ((((4 * s + kq) ^ r16) & 127) << 4);
                const bf16x8 ah = *(const bf16x8*)(lds + off), al = *(const bf16x8*)(lds + 32768 + off);
                const bf16x8 bh = *(const bf16x8*)(wh + 32 * s), bl = *(const bf16x8*)(wh + 64 * D + 32 * s);
                acc = __builtin_amdgcn_mfma_f32_16x16x32_bf16(ah, bh, acc, 0, 0, 0);
                acc = __builtin_amdgcn_mfma_f32_16x16x32_bf16(al, bh, acc, 0, 0, 0);
                acc = __builtin_amdgcn_mfma_f32_16x16x32_bf16(ah, bl, acc, 0, 0, 0);
            }
#pragma unroll
            for (int q = 0; q < 4; ++q) LG[(4 * kq + q) * 64 + 16 * wave + r16] = acc[q];
        }
        __syncthreads();
        if (TIDX < 16) {
            const int m = m0 + TIDX;
            const float* lgp = LG + TIDX * 64;
            float lg[4], le[32];
#pragma unroll
            for (int i = 0; i < 4; ++i) lg[i] = lgp[i] + p.rg_b[l * 4 + i];
#pragma unroll
            for (int i = 0; i < 32; ++i) le[i] = lgp[4 + i] + p.re_b[l * 32 + i];
            int gi = 0; float gm = lg[0];
#pragma unroll
            for (int i = 1; i < 4; ++i) if (lg[i] > gm) { gm = lg[i]; gi = i; }
            float gs = 0.f;
#pragma unroll
            for (int i = 0; i < 4; ++i) gs += expf(lg[i] - gm);
            const float pg = 1.f / gs;
            float el[8];
#pragma unroll
            for (int i = 0; i < 8; ++i) el[i] = gi == 0 ? le[i] : (gi == 1 ? le[8 + i] : (gi == 2 ? le[16 + i] : le[24 + i]));
            int e1 = 0; float m1 = el[0];
#pragma unroll
            for (int i = 1; i < 8; ++i) if (el[i] > m1) { m1 = el[i]; e1 = i; }
            int e2 = -1; float m2 = -3.0e38f;
#pragma unroll
            for (int i = 0; i < 8; ++i) if (i != e1 && el[i] > m2) { m2 = el[i]; e2 = i; }
            const float p2 = expf(m2 - m1);
            const float w1 = pg / (1.f + p2), w2 = pg * p2 / (1.f + p2);
            const int ea = gi * 8 + e1, eb = gi * 8 + e2;
            const unsigned pa = atomicAdd(v.ctl + CW_CNT + l * 32 + ea, 1u);
            const unsigned pb = atomicAdd(v.ctl + CW_CNT + l * 32 + eb, 1u);
            v.list[(size_t)ea * T + pa] = 2 * m;
            v.list[(size_t)eb * T + pb] = 2 * m + 1;
            v.wts[2 * m] = w1; v.wts[2 * m + 1] = w2;
        }
        __syncthreads();
    }
}

constexpr int CW_MQ = 8192 + 512;
DEV void ph_mix(const P& p, int l, unsigned char* lds, volatile LAS unsigned* qslot, int rep) {
    const int TIDX = otid(), BIDX = obid();
    unsigned* ctl = (unsigned*)(p.ws + WS_CTL) + CW_MQ + l * 256;
    unsigned acq = 0u;
    for (int hop = 0; hop < 8; ++hop) {
        const int b = (BIDX + hop) & 7;
        unsigned* qc = ctl + b * 16;
        unsigned* done = ctl + 128 + b * 16;
        for (;;) {
            __syncthreads();
            if (TIDX == 0) *qslot = atomicAdd(qc, 1u);
            __syncthreads();
            const int v = (int)*qslot;
            if (v >= 260) break;
            if (v < 4) {
                cmp_unit(p, l, b * 4 + v, lds);
                asm volatile("s_waitcnt vmcnt(0)" ::: "memory");
                __syncthreads();
                if (TIDX == 0) {
                    __builtin_amdgcn_fence(__ATOMIC_RELEASE, "agent");
                    asm volatile("s_waitcnt vmcnt(0)" ::: "memory");
                    __hip_atomic_fetch_add(done, 1u, __ATOMIC_RELAXED, __HIP_MEMORY_SCOPE_AGENT);
                }
                continue;
            }
            int slot = -1, nsa = -1;
            if (v < 68) slot = v - 4;
            else { const int w2 = v - 68, k = w2 % 3, i = w2 / 3; if (k < 2) nsa = 2 * i + k; else slot = 64 + i; }
            if (slot >= 0) {
                const int idx = slot >> 1, u = ((idx >> 2) << 5) | (b * 4 + (idx & 3));
                if (slot & 1) mha_unit<3>(p, l, u, lds); else mha_unit<2>(p, l, u, lds);
            } else {
                if (!((acq >> b) & 1u)) {
                    if (TIDX == 0) {
                        unsigned sp = 0;
                        while (__hip_atomic_load(done, __ATOMIC_RELAXED, __HIP_MEMORY_SCOPE_AGENT) < 4u) { __builtin_amdgcn_s_sleep(2); if (++sp > (1u << 22)) break; }
                        __builtin_amdgcn_fence(__ATOMIC_ACQUIRE, "agent");
                        asm volatile("s_waitcnt vmcnt(0)" ::: "memory");
                    }
                    __syncthreads();
                    acq |= 1u << b;
                }
                nsa_unit(p, l, ((nsa >> 1) << 4) | (b * 2 + (nsa & 1)), lds);
            }
        }
    }
}

#ifndef REP_PHASE
#define REP_PHASE 0
#endif
#ifndef REF_HEADS
#define REF_HEADS 0x0000u
#endif
__global__ void __launch_bounds__(256, 2) fwd_kernel(P p) {
    __shared__ __attribute__((aligned(16))) float lds[17408];
    __shared__ __attribute__((aligned(16))) unsigned lds_ctl[4];
    if (threadIdx.x < 4) lds_ctl[threadIdx.x] = 0u;
    __syncthreads();
    const XcdBarrier xb = xcd_barrier_post((unsigned*)(p.ws + WS_CTL), (volatile LAS unsigned*)lds_ctl);
#define GRID_BAR() do { xcd_barrier(xb); if (REP_PHASE == 7) xcd_barrier(xb); } while (0)
    volatile LAS unsigned* qslot = (volatile LAS unsigned*)(lds_ctl + 2);
    for (int rep = 0; rep < (REP_PHASE == 1 ? 2 : 1); ++rep) {
        ph_prologue(p, lds);
        ph_convert(p, lds);
        GRID_BAR();
    }
    for (int l = 0; l < DEPTH; ++l) {
        ph_convert_dense(p, l, 0);
        ph_norm1(p, l, l == 0 ? 0 : 1);
        GRID_BAR();
        for (int rep = 0; rep < (REP_PHASE == 2 ? 2 : 1); ++rep) {
            if (rep == 0) ph_convert_dense(p, l, 1);
            ph_inproj_fast(p, l, (unsigned char*)lds);
            GRID_BAR();
        }
        for (int rep = 0; rep < (REP_PHASE == 3 ? 2 : 1); ++rep) {
            ph_mix(p, l, (unsigned char*)lds, qslot, rep);
            GRID_BAR();
        }
        ph_outproj_fast(p, l, (unsigned char*)lds);
        GRID_BAR();
        if (blockIdx.x & 8) { ph_convert_experts(p, l); ph_norm2_router_fast(p, l, (unsigned char*)lds); }
        else { ph_norm2_router_fast(p, l, (unsigned char*)lds); ph_convert_experts(p, l); }
        GRID_BAR();
        for (int rep = 0; rep < (REP_PHASE == 5 ? 2 : 1); ++rep) {
            ph_moe_up_fast(p, l, (unsigned char*)lds);
            GRID_BAR();
        }
        for (int rep = 0; rep < (REP_PHASE == 6 ? 2 : 1); ++rep) {
            ph_moe_down_fast(p, l, (unsigned char*)lds);
            GRID_BAR();
        }
    }
    ph_norm1(p, DEPTH, 2);
}

extern "C" void kernel_launch(void* const* d_in, const int* in_sizes, int n_in,
                              void* d_out, int out_size, void* d_ws, size_t ws_size,
                              hipStream_t stream) {
    static int grid_blocks = 0;
    if (!grid_blocks) {
        int dev = 0, cus = 0, per_cu = 0;
        (void)hipGetDevice(&dev);
        (void)hipDeviceGetAttribute(&cus, hipDeviceAttributeMultiprocessorCount, dev);
        (void)hipOccupancyMaxActiveBlocksPerMultiprocessor(&per_cu, fwd_kernel, 256, 0);
        if (per_cu > 2) per_cu = 2;
        if (per_cu < 1) per_cu = 1;
        grid_blocks = cus * per_cu;
        if (n_in != 24 || ws_size < WS_END || out_size != T * D) { fprintf(stderr, "kernel_launch: unexpected shapes (n_in %d ws %zu out %d)\n", n_in, ws_size, out_size); grid_blocks = -1; }
    }
    if (grid_blocks < 0) return;
    (void)hipMemsetAsync(d_ws, 0, CTL_BYTES, stream);
    P p{};
    const float** pp = (const float**)&p;
    for (int i = 0; i < 24; ++i) pp[i] = (const float*)d_in[i];
    p.out = (float*)d_out; p.ws = (unsigned char*)d_ws;
    void* args[] = {&p};
    hipError_t e = hipLaunchCooperativeKernel((void*)fwd_kernel, dim3(grid_blocks), dim3(256), args, 0, stream);
    if (e != hipSuccess) fprintf(stderr, "cooperative launch failed: %s (grid %d)\n", hipGetErrorString(e), grid_blocks);
}
```

```cpp
#include <hip/hip_runtime.h>
#include <hip/hip_cooperative_groups.h>
#include <cstdio>
#include <cstdint>

#define LAS __attribute__((address_space(3)))
#define DEV __device__ __forceinline__

constexpr int T = 16384, S = 2048, NB = 8, D = 1024, DIN = 2844, NP = 2880, DEPTH = 4;
constexpr int NCMP = 127;
constexpr float EPS = 1e-6f;
constexpr float SCALE = 0.125f;
constexpr int C_QA = 0, C_KC = 512, C_VC = 640, C_KS = 768, C_VS = 896, C_KW = 1024, C_VW = 1152;
constexpr int C_QB = 1280, C_KB = 1536, C_VB = 1792, C_QC = 2048, C_KCC = 2304, C_VCC = 2560;

constexpr size_t MiB = 1u << 20;
constexpr size_t WS_CTL = 0, CTL_BYTES = 64 * 1024;
constexpr size_t WS_MOD = 1 * MiB, WS_ROPE = 2 * MiB, WS_CUMF = 3 * MiB, WS_CK = 4 * MiB, WS_CV = 5 * MiB, WS_IMP = 6 * MiB;
constexpr size_t WS_SEL = 10 * MiB, WS_EID = 11 * MiB, WS_WTS = 12 * MiB, WS_LIST = 13 * MiB, WS_GF = 16 * MiB;
constexpr size_t WS_H = 32 * MiB, WS_U = 64 * MiB, WS_O = 160 * MiB, WS_HID = 192 * MiB, WS_Y = 224 * MiB, WS_OB = 352 * MiB, WS_ORAW = 448 * MiB;
constexpr size_t WS_END = 973 * MiB;
constexpr size_t WS_VT = 936 * MiB;
constexpr size_t WS_CVT = 962 * MiB;
constexpr size_t WS_CUMF2 = 963 * MiB;
constexpr int CW_Q = 8192 + 256;
constexpr size_t WS_CW1 = 964 * MiB;
constexpr size_t WS_CW2 = 968 * MiB;
constexpr size_t WS_CPB = 969 * MiB;
constexpr size_t WS_LSF = 970 * MiB;
constexpr size_t WS_WR = 971 * MiB;
constexpr int CW_CNT = 8192;

typedef unsigned short bf16_t;
typedef float f32x4v __attribute__((ext_vector_type(4)));
DEV int vt_row(int n) { return n < 1024 ? n - 896 : (n < 1280 ? 128 + n - 1152 : (n < 2048 ? 256 + n - 1792 : 512 + n - 2560)); }
DEV bool is_vcol(int n) { return (n >= C_VS && n < C_KW) || (n >= C_VW && n < C_QB) || (n >= C_VB && n < C_QC) || (n >= C_VCC && n < 2816); }
DEV float bf2f(bf16_t v) { return __uint_as_float((unsigned)v << 16); }
DEV bf16_t f2bf(float f) { unsigned u = __float_as_uint(f); return (bf16_t)((u + 0x7fffu + ((u >> 16) & 1u)) >> 16); }
DEV float4 ld_bf4(const bf16_t* p) { const ushort4 u = *(const ushort4*)p; return make_float4(bf2f(u.x), bf2f(u.y), bf2f(u.z), bf2f(u.w)); }
typedef float f32x2_t __attribute__((ext_vector_type(2)));
typedef __bf16 bf16x2_t __attribute__((ext_vector_type(2)));
DEV unsigned cvtpk(float lo, float hi) { f32x2_t v = {lo, hi}; bf16x2_t b = __builtin_convertvector(v, bf16x2_t); return __builtin_bit_cast(unsigned, b); }
DEV float sigmoidf_(float x) { return 1.f / (1.f + expf(-x)); }
DEV float logsigmoidf_(float x) { return fminf(x, 0.f) - log1pf(expf(-fabsf(x))); }
DEV float wave_sum(float v) {
#pragma unroll
    for (int o = 1; o < 64; o <<= 1) v += __shfl_xor(v, o);
    return v;
}

#define XB_TMO      128
#define XB_XCNT(j)  (256  + 64 * (j))
#define XB_XSUB(j)  (1280 + 64 * (j))
#define XB_XGEN(j)  (2304 + 64 * (j))
#define XB_TOP      3328
#define XB_TOPGEN   3392
#define XCD_BAR_WORDS 3456
#define XB_SPIN_CAP (1u << 23)
DEV unsigned xb_ld(unsigned* p)              { return __hip_atomic_load(p, __ATOMIC_RELAXED, __HIP_MEMORY_SCOPE_AGENT); }
DEV unsigned xb_add(unsigned* p, unsigned v) { return __hip_atomic_fetch_add(p, v, __ATOMIC_RELAXED, __HIP_MEMORY_SCOPE_AGENT); }
DEV unsigned xb_xcc_id() { return (unsigned)__builtin_amdgcn_s_getreg((3 << 11) | 20) & 0xFu; }
#define XB_SPIN(cond, bar) do { unsigned _sp = 0; while (cond) { __builtin_amdgcn_s_sleep(1); \
    if ((++_sp & 255u) == 0u) { if (xb_ld(&(bar)[XB_TMO])) break; if (_sp > XB_SPIN_CAP) { atomicAdd(&(bar)[XB_TMO], 1u); break; } } } } while (0)
struct XcdBarrier { unsigned* bar; unsigned x; volatile LAS unsigned* st; };
DEV XcdBarrier xcd_barrier_post(unsigned* bar, volatile LAS unsigned* st) {
    XcdBarrier b; b.bar = bar; b.x = xb_xcc_id(); b.st = st;
    if (threadIdx.x == 0) (void)xb_add(&bar[XB_XCNT(b.x)], 1u);
    return b;
}
DEV void xcd_barrier_complete(unsigned* bar, unsigned x, unsigned& nloc, unsigned& nx) {
    const unsigned G = gridDim.x * gridDim.y * gridDim.z;
    unsigned sum, cnt, mine, sp = 0u;
    for (;;) {
        sum = 0u; cnt = 0u; mine = 0u;
#pragma unroll
        for (unsigned j = 0; j < 16; ++j) { const unsigned c = xb_ld(&bar[XB_XCNT(j)]); sum += c; cnt += (c > 0u) ? 1u : 0u; mine = (j == x) ? c : mine; }
        if (sum == G) break;
        __builtin_amdgcn_s_sleep(1);
        if ((++sp & 255u) == 0u) { if (xb_ld(&bar[XB_TMO])) break; if (sp > XB_SPIN_CAP) { atomicAdd(&bar[XB_TMO], 1u); break; } }
    }
    nloc = mine > 0u ? mine : 1u; nx = cnt > 0u ? cnt : 1u;
}
DEV void xcd_barrier(const XcdBarrier& b) {
    asm volatile("s_waitcnt vmcnt(0)" ::: "memory");
    __syncthreads();
    if (threadIdx.x == 0) {
        unsigned* bar = b.bar;
        __builtin_amdgcn_s_waitcnt(0);
        unsigned nloc = b.st[0], nx = b.st[1];
        if (nloc == 0u) { xcd_barrier_complete(bar, b.x, nloc, nx); b.st[0] = nloc; b.st[1] = nx; }
        const unsigned old = xb_add(&bar[XB_XSUB(b.x)], 1u);
        const unsigned gen = old / nloc;
        if (old + 1u == (gen + 1u) * nloc) {
            __builtin_amdgcn_fence(__ATOMIC_RELEASE, "agent");
            asm volatile("s_waitcnt vmcnt(0)" ::: "memory");
            const unsigned og = xb_add(&bar[XB_TOP], 1u);
            const unsigned tg = og / nx;
            if (og + 1u == (tg + 1u) * nx) xb_add(&bar[XB_TOPGEN], 1u);
            else XB_SPIN(xb_ld(&bar[XB_TOPGEN]) == tg, bar);
            __builtin_amdgcn_fence(__ATOMIC_ACQUIRE, "agent");
            xb_add(&bar[XB_XGEN(b.x)], 1u);
            asm volatile("s_waitcnt vmcnt(0)" ::: "memory");
        } else {
            XB_SPIN(xb_ld(&bar[XB_XGEN(b.x)]) == gen, bar);
            __builtin_amdgcn_fence(__ATOMIC_ACQUIRE, "agent");
            asm volatile("s_waitcnt vmcnt(0)" ::: "memory");
        }
    }
    __syncthreads();
}

struct P {
    const float *x, *c, *norm1_g, *norm2_g, *ada_w, *ada_b, *w_in, *b_forget, *cmp_pos_k, *cmp_w1_k, *cmp_w2_k,
        *cmp_pos_v, *cmp_w1_v, *cmp_w2_v, *out_norm_g, *w_out, *rg_w, *rg_b, *re_w, *re_b, *e_w1, *e_w3, *e_w2, *final_g;
    float* out; unsigned char* ws;
};
struct V {
    unsigned* ctl; float* mod; float* rcos; float* rsin; float* cumf; bf16_t* ck; bf16_t* cv; float* imp; unsigned* sel;
    int* eid; float* wts; int* list; float* gf; bf16_t* H; bf16_t* U; bf16_t* O; bf16_t* HID; bf16_t* Y; float* OB; float* ORAW; float* X;
};
DEV int otid() { int t = threadIdx.x; asm volatile("" : "+v"(t)); return t; }
DEV int obid() { int t = blockIdx.x; asm volatile("" : "+s"(t)); return t; }
DEV V make_views(const P& p) {
    V v; size_t woff = 0; asm volatile("" : "+s"(woff)); unsigned char* w = p.ws + woff;
    v.ctl = (unsigned*)(w + WS_CTL); v.mod = (float*)(w + WS_MOD); v.rcos = (float*)(w + WS_ROPE); v.rsin = v.rcos + S * 8;
    v.cumf = (float*)(w + WS_CUMF); v.ck = (bf16_t*)(w + WS_CK); v.cv = (bf16_t*)(w + WS_CV); v.imp = (float*)(w + WS_IMP);
    v.sel = (unsigned*)(w + WS_SEL); v.eid = (int*)(w + WS_EID); v.wts = (float*)(w + WS_WTS); v.list = (int*)(w + WS_LIST);
    v.gf = (float*)(w + WS_GF); v.H = (bf16_t*)(w + WS_H); v.U = (bf16_t*)(w + WS_U); v.O = (bf16_t*)(w + WS_O);
    v.HID = (bf16_t*)(w + WS_HID); v.Y = (bf16_t*)(w + WS_Y); v.OB = (float*)(w + WS_OB); v.ORAW = (float*)(w + WS_ORAW); v.X = p.out;
    return v;
}

DEV void ph_prologue(const P& p, float* lds) {
    const V v = make_views(p); const int TIDX = otid(), BIDX = obid();
    const int tid = TIDX;
    for (int i = tid; i < NB * D; i += 256) { const float c = p.c[i]; lds[i] = c / (1.f + expf(-c)); }
    __syncthreads();
    float* red = lds + NB * D;
    const int c4 = tid & 15, ks = tid >> 4;
    for (int unit = BIDX; unit < DEPTH * 96; unit += gridDim.x) {
        const int l = unit / 96, n0 = (unit % 96) * 64;
        const float* W = p.ada_w + (size_t)l * D * 6144 + n0 + 4 * c4;
        float acc[8][4];
#pragma unroll
        for (int b = 0; b < 8; ++b)
#pragma unroll
            for (int q = 0; q < 4; ++q) acc[b][q] = 0.f;
#pragma unroll 1
        for (int i0 = 0; i0 < 64; i0 += 8) {
            f32x4v w[8];
#pragma unroll
            for (int i = 0; i < 8; ++i) w[i] = __builtin_nontemporal_load((const f32x4v*)(W + (size_t)(ks + 16 * (i0 + i)) * 6144));
#pragma unroll
            for (int i = 0; i < 8; ++i) {
                const int k = ks + 16 * (i0 + i);
#pragma unroll
                for (int b = 0; b < 8; ++b) {
                    const float cv = lds[b * D + k];
                    acc[b][0] += cv * w[i].x; acc[b][1] += cv * w[i].y; acc[b][2] += cv * w[i].z; acc[b][3] += cv * w[i].w;
                }
            }
        }
#pragma unroll
        for (int b = 0; b < 8; ++b) *(float4*)(red + (ks * 8 + b) * 64 + 4 * c4) = make_float4(acc[b][0], acc[b][1], acc[b][2], acc[b][3]);
        __syncthreads();
        for (int o = tid; o < 512; o += 256) {
            const int c2 = o & 63, b = o >> 6;
            float sm = p.ada_b[l * 6144 + n0 + c2];
#pragma unroll
            for (int q = 0; q < 16; ++q) sm += red[(q * 8 + b) * 64 + c2];
            v.mod[(size_t)(l * 8 + b) * 6144 + n0 + c2] = sm;
        }
        __syncthreads();
    }
    const float cst = -2.0f * 13.122363377404328f / 16.0f;
    for (int i = BIDX * 256 + tid; i < S * 8; i += gridDim.x * 256) {
        const int s = i >> 3, j = i & 7;
        const float inv = expf((float)j * cst);
        const float ang = (float)s * inv;
        v.rcos[i] = cosf(ang); v.rsin[i] = sinf(ang);
    }
}

DEV void ph_norm1(const P& p, int l, int mode) {
    const V v = make_views(p); const int TIDX = otid(), BIDX = obid();
    const int lane = TIDX & 63;
    const int gw = (BIDX * 256 + TIDX) >> 6, nw = gridDim.x * 4;
    for (int m0 = gw; m0 < T; m0 += 2 * nw) {
        float4 xv[2][4];
        if (mode == 0) {
#pragma unroll
            for (int rr = 0; rr < 2; ++rr)
#pragma unroll
                for (int j = 0; j < 4; ++j) xv[rr][j] = *(const float4*)(p.x + (size_t)(m0 + rr * nw) * D + 4 * lane + 256 * j);
        } else {
            float4 xa[2][4]; ushort4 ya[2][4], yb[2][4];
#pragma unroll
            for (int rr = 0; rr < 2; ++rr)
#pragma unroll
                for (int j = 0; j < 4; ++j) {
                    const int m = m0 + rr * nw, c = 4 * lane + 256 * j;
                    xa[rr][j] = *(const float4*)(v.X + (size_t)m * D + c);
                    ya[rr][j] = *(const ushort4*)(v.Y + (size_t)(2 * m) * D + c); yb[rr][j] = *(const ushort4*)(v.Y + (size_t)(2 * m + 1) * D + c);
                }
#pragma unroll
            for (int rr = 0; rr < 2; ++rr) {
                const float* g2 = v.mod + (size_t)((l - 1) * 8 + ((m0 + rr * nw) >> 11)) * 6144 + 5 * D;
#pragma unroll
                for (int j = 0; j < 4; ++j) {
                    const float4 g = *(const float4*)(g2 + 4 * lane + 256 * j);
                    float4 a = xa[rr][j];
                    a.x += g.x * (bf2f(ya[rr][j].x) + bf2f(yb[rr][j].x)); a.y += g.y * (bf2f(ya[rr][j].y) + bf2f(yb[rr][j].y));
                    a.z += g.z * (bf2f(ya[rr][j].z) + bf2f(yb[rr][j].z)); a.w += g.w * (bf2f(ya[rr][j].w) + bf2f(yb[rr][j].w));
                    xv[rr][j] = a;
                }
            }
        }
        float ss[2];
#pragma unroll
        for (int rr = 0; rr < 2; ++rr) {
            ss[rr] = 0.f;
#pragma unroll
            for (int j = 0; j < 4; ++j) ss[rr] += xv[rr][j].x * xv[rr][j].x + xv[rr][j].y * xv[rr][j].y + xv[rr][j].z * xv[rr][j].z + xv[rr][j].w * xv[rr][j].w;
        }
#pragma unroll
        for (int o = 1; o < 64; o <<= 1) { ss[0] += __shfl_xor(ss[0], o); ss[1] += __shfl_xor(ss[1], o); }
#pragma unroll
        for (int rr = 0; rr < 2; ++rr) {
            const int m = m0 + rr * nw, b = m >> 11;
            const float r = rsqrtf(ss[rr] * (1.f / D) + EPS);
            if (mode == 2) {
#pragma unroll
                for (int j = 0; j < 4; ++j) {
                    const int c = 4 * lane + 256 * j;
                    const float4 g = *(const float4*)(p.final_g + c);
                    float4 o; o.x = xv[rr][j].x * r * g.x; o.y = xv[rr][j].y * r * g.y; o.z = xv[rr][j].z * r * g.z; o.w = xv[rr][j].w * r * g.w;
                    *(float4*)(v.X + (size_t)m * D + c) = o;
                }
            } else {
                const float* md = v.mod + (size_t)(l * 8 + b) * 6144;
#pragma unroll
                for (int j = 0; j < 4; ++j) {
                    const int c = 4 * lane + 256 * j;
                    *(float4*)(v.X + (size_t)m * D + c) = xv[rr][j];
                    const float4 g = *(const float4*)(p.norm1_g + l * D + c), sh = *(const float4*)(md + c), sc = *(const float4*)(md + D + c);
                    uint2 o;
                    o.x = cvtpk(xv[rr][j].x * r * g.x * (1.f + sc.x) + sh.x, xv[rr][j].y * r * g.y * (1.f + sc.y) + sh.y);
                    o.y = cvtpk(xv[rr][j].z * r * g.z * (1.f + sc.z) + sh.z, xv[rr][j].w * r * g.w * (1.f + sc.w) + sh.w);
                    *(uint2*)(v.H + (size_t)m * D + c) = o;
                }
            }
        }
    }
}

typedef short bf16x8 __attribute__((ext_vector_type(8)));
typedef float f32x16 __attribute__((ext_vector_type(16)));
typedef unsigned u32x4 __attribute__((ext_vector_type(4)));
constexpr size_t WS_WIN = 512 * MiB, WS_WOT = 544 * MiB, WS_W13 = 552 * MiB, WS_W2 = 808 * MiB;
constexpr int NPW = 2944;
DEV int tile_off(int row, int chunk) { return row * 128 + ((chunk ^ ((row >> 1) & 7)) << 4); }
template <class RM>
DEV void conv_patch(const float* src, int N, int K, bf16_t* dst, int k0, int n0, RM rowmap, int lane) {
    const int kg = lane >> 3, n = n0 + 4 * (lane & 7);
    if (n >= N) return;
    const float* sp = src + (size_t)(k0 + 8 * kg) * N + n;
    f32x4v x[8];
#pragma unroll
    for (int j = 0; j < 8; ++j) x[j] = __builtin_nontemporal_load((const f32x4v*)(sp + (size_t)j * N));
    bf16_t* dp = dst + k0 + 8 * kg;
    u32x4 o;
    o.x = cvtpk(x[0].x, x[1].x); o.y = cvtpk(x[2].x, x[3].x); o.z = cvtpk(x[4].x, x[5].x); o.w = cvtpk(x[6].x, x[7].x);
    *(u32x4*)(dp + (size_t)rowmap(n) * K) = o;
    o.x = cvtpk(x[0].y, x[1].y); o.y = cvtpk(x[2].y, x[3].y); o.z = cvtpk(x[4].y, x[5].y); o.w = cvtpk(x[6].y, x[7].y);
    *(u32x4*)(dp + (size_t)rowmap(n + 1) * K) = o;
    o.x = cvtpk(x[0].z, x[1].z); o.y = cvtpk(x[2].z, x[3].z); o.z = cvtpk(x[4].z, x[5].z); o.w = cvtpk(x[6].z, x[7].z);
    *(u32x4*)(dp + (size_t)rowmap(n + 2) * K) = o;
    o.x = cvtpk(x[0].w, x[1].w); o.y = cvtpk(x[2].w, x[3].w); o.z = cvtpk(x[4].w, x[5].w); o.w = cvtpk(x[6].w, x[7].w);
    *(u32x4*)(dp + (size_t)rowmap(n + 3) * K) = o;
}

DEV void conv8(const float* s0, const float* s1, bf16_t* dst) {
    f32x4v a = {0.f, 0.f, 0.f, 0.f}, b = {0.f, 0.f, 0.f, 0.f};
    if (s0) a = __builtin_nontemporal_load((const f32x4v*)s0);
    if (s1) b = __builtin_nontemporal_load((const f32x4v*)s1);
    u32x4 o; o.x = cvtpk(a[0], a[1]); o.y = cvtpk(a[2], a[3]); o.z = cvtpk(b[0], b[1]); o.w = cvtpk(b[2], b[3]);
    *(u32x4*)dst = o;
}
DEV void ph_convert_dense(const P& p, int l, int which) {
    const int TIDX = otid(), BIDX = obid();
    size_t woff = 0; asm volatile("" : "+s"(woff)); unsigned char* w = p.ws + woff;
    const size_t gtid = (size_t)BIDX * 256 + TIDX, gsz = (size_t)gridDim.x * 256;
    if (which == 0) {
        bf16_t* win = (bf16_t*)(w + WS_WIN);
        for (size_t i = gtid; i < (size_t)D * 368; i += gsz) {
            const int g8 = (int)(i % 368); const size_t lk = (size_t)l * D + i / 368;
            const int n = g8 * 8;
            const float* row = p.w_in + lk * DIN;
            const float *s0, *s1;
            if (n < 2816) { const int oc = n + (n >= 2048 ? 28 : (n >= 1280 ? 24 : 0)); s0 = row + oc; s1 = row + oc + 4; }
            else if (n < 2840) { s0 = row + 1280 + (n - 2816); s1 = s0 + 4; }
            else if (n == 2840) { s0 = row + 2072; s1 = nullptr; }
            else { s0 = nullptr; s1 = nullptr; }
            conv8(s0, s1, win + lk * NPW + n);
        }
    } else {
        bf16_t* wot = (bf16_t*)(w + WS_WOT);
        const size_t oo = (size_t)l * D * D;
        for (size_t i = gtid; i < (size_t)D * D / 8; i += gsz) conv8(p.w_out + oo + i * 8, p.w_out + oo + i * 8 + 4, wot + oo + i * 8);
        for (size_t i = gtid; i < (size_t)2 * 2048 * 128 / 8; i += gsz) {
            const size_t per = (size_t)2048 * 128 / 8; const int kv = (int)(i / per), lk = l * 2 + kv; const size_t off = (i % per) * 8;
            const float* src = (kv ? p.cmp_w1_v : p.cmp_w1_k) + (size_t)l * 2048 * 128 + off;
            conv8(src, src + 4, (bf16_t*)(w + WS_CW1) + (size_t)lk * 2048 * 128 + off);
        }
    }
}
DEV void ph_convert_experts(const P& p, int l) {
    const int TIDX = otid(), BIDX = obid();
    size_t woff = 0; asm volatile("" : "+s"(woff)); unsigned char* w = p.ws + woff;
    bf16_t* w13 = (bf16_t*)(w + WS_W13); bf16_t* w2t = (bf16_t*)(w + WS_W2);
    const size_t gtid = (size_t)BIDX * 256 + TIDX, gsz = (size_t)gridDim.x * 256;
    for (size_t i = gtid; i < (size_t)32 * D * 128; i += gsz) {
        const int g8 = (int)(i & 127); const size_t lek = (size_t)l * 32 * D + (i >> 7);
        const int n = g8 * 8, which = (n >> 5) & 1, c = 32 * (n >> 6) + (n & 31);
        const float* src = (which ? p.e_w3 : p.e_w1) + lek * 512 + c;
        conv8(src, src + 4, w13 + lek * 1024 + n);
    }
    const size_t o2 = (size_t)l * 32 * 512 * D;
    for (size_t i = gtid; i < (size_t)32 * 512 * D / 8; i += gsz) conv8(p.e_w2 + o2 + i * 8, p.e_w2 + o2 + i * 8 + 4, w2t + o2 + i * 8);
}
DEV void ph_convert(const P& p, float* lds) {
    const int TIDX = otid(), BIDX = obid();
    size_t woff = 0; asm volatile("" : "+s"(woff)); unsigned char* w = p.ws + woff;
    const int lane = TIDX & 63;
    for (int unit = BIDX * 4 + (TIDX >> 6); unit < DEPTH * 2 * 4; unit += gridDim.x * 4) {
        const int lk = unit >> 2, t = unit & 3, l = lk >> 1, kv = lk & 1;
        conv_patch((kv ? p.cmp_w2_v : p.cmp_w2_k) + (size_t)l * 128 * 64, 64, 128, (bf16_t*)(w + WS_CW2) + (size_t)lk * 64 * 128, (t >> 1) * 64, (t & 1) * 32, [](int n) { return n; }, lane);
    }
    for (int o = BIDX * 256 + TIDX; o < DEPTH * 64 * D; o += gridDim.x * 256) {
        const int k = o & (D - 1), n = (o >> 10) & 63, l = o >> 16;
        const float val = n < 4 ? p.rg_w[((size_t)l * D + k) * 4 + n] : (n < 36 ? p.re_w[((size_t)l * D + k) * 32 + n - 4] : 0.f);
        const bf16_t hi = f2bf(val); const bf16_t lo = f2bf(val - bf2f(hi));
        bf16_t* wr = (bf16_t*)(w + WS_WR) + (size_t)l * 2 * 64 * D;
        wr[n * D + k] = hi; wr[64 * D + n * D + k] = lo;
    }
    for (int o = BIDX * 256 + TIDX; o < DEPTH * 2 * 128 * 16; o += gridDim.x * 256) {
        const int part = o & 15, j = (o >> 4) & 127, lk = o >> 11, l = lk >> 1, kv = lk & 1;
        const float* pe = (kv ? p.cmp_pos_v : p.cmp_pos_k) + (size_t)l * 2048;
        const float* w1 = (kv ? p.cmp_w1_v : p.cmp_w1_k) + (size_t)l * 2048 * 128;
        float a = 0.f;
        for (int k = part * 128; k < part * 128 + 128; ++k) a += pe[k] * w1[(size_t)k * 128 + j];
        a += __shfl_xor(a, 1); a += __shfl_xor(a, 2); a += __shfl_xor(a, 4); a += __shfl_xor(a, 8);
        if (part == 0) ((float*)(w + WS_CPB))[lk * 128 + j] = a;
    }
}

typedef short v4i16_t __attribute__((ext_vector_type(4)));
DEV void gemm_issue0(unsigned char* lds, const bf16_t* const (&arow)[4], const bf16_t* Bsrc, const size_t ldb, const int TIDX) {
    const int lane = TIDX & 63, wave = TIDX >> 6;
    const int gsw = ((TIDX & 7) ^ ((TIDX >> 4) & 7)) * 8;
    const bf16_t* bg = Bsrc + (size_t)(4 * wave + (lane >> 4)) * ldb + ((lane & 15) ^ (((lane >> 4) << 2) | (wave & 3))) * 8;
    LAS unsigned char* l3 = (LAS unsigned char*)lds + __builtin_amdgcn_readfirstlane(wave) * 1024;
#pragma unroll
    for (int i = 0; i < 4; ++i) {
        __builtin_amdgcn_global_load_lds((const unsigned*)(arow[i] + gsw), (LAS unsigned*)(l3 + i * 4096), 16, 0, 0);
        __builtin_amdgcn_global_load_lds((const unsigned*)(bg + (size_t)(16 * i) * ldb), (LAS unsigned*)(l3 + 16384 + i * 4096), 16, 0, 0);
    }
}
template <bool SWAP, bool PRE = false>
DEV void gemm128(unsigned char* lds, const bf16_t* const (&arow)[4], const bf16_t* Bsrc, const size_t ldb, int K, f32x16 (&acc)[2][2], const int TIDX, const int astride = 64) {
    const int lane = TIDX & 63, wave = TIDX >> 6, wm = wave >> 1, wn = wave & 1, r = lane & 31, h = lane >> 5;
#pragma unroll
    for (int j = 0; j < 2; ++j)
#pragma unroll
        for (int i = 0; i < 2; ++i)
#pragma unroll
            for (int q = 0; q < 16; ++q) acc[j][i][q] = 0.f;
    const int gsw = ((TIDX & 7) ^ ((TIDX >> 4) & 7)) * 8;
    const bf16_t* ag[4];
#pragma unroll
    for (int i = 0; i < 4; ++i) ag[i] = arow[i] + gsw;
    const int brow = 4 * wave + (lane >> 4), bch = ((lane & 15) ^ (((lane >> 4) << 2) | (wave & 3))) * 8;
    const bf16_t* bg = Bsrc + (size_t)brow * ldb + bch;
    LAS unsigned char* l3 = (LAS unsigned char*)lds + __builtin_amdgcn_readfirstlane(wave) * 1024;
    LAS unsigned char* tb[2][2];
    {
        const int blk = (lane >> 4) & 1, q = (lane & 15) >> 2, pp = lane & 3;
#pragma unroll
        for (int j = 0; j < 2; ++j)
#pragma unroll
            for (int t = 0; t < 2; ++t) {
                const int row = 4 * t + 8 * h + q, ch = 4 * (2 * wn + j) + 2 * blk + (pp >> 1);
                tb[j][t] = (LAS unsigned char*)lds + 16384 + 256 * row + 16 * (ch ^ (((row & 3) << 2) | ((row >> 2) & 3))) + 8 * (pp & 1);
            }
    }
#define G_DMA(st_, kt_) do { _Pragma("unroll") for (int i = 0; i < 4; ++i) { \
        __builtin_amdgcn_global_load_lds((const unsigned*)(ag[i] + (size_t)(kt_) * astride), (LAS unsigned*)(l3 + (st_) + i * 4096), 16, 0, 0); \
        __builtin_amdgcn_global_load_lds((const unsigned*)(bg + ((size_t)(kt_) * 64 + 16 * i) * ldb), (LAS unsigned*)(l3 + (st_) + 16384 + i * 4096), 16, 0, 0); } } while (0)
    const int KT = K >> 6;
    if (!PRE) {
        __syncthreads();
        G_DMA(0, 0);
    }
    for (int kt = 0; kt < KT; ++kt) {
        asm volatile("s_waitcnt vmcnt(0) lgkmcnt(0)" ::: "memory");
        __builtin_amdgcn_s_barrier();
        asm volatile("" ::: "memory");
        if (kt + 1 < KT) G_DMA(((kt + 1) & 1) * 32768, kt + 1);
        const int so = (kt & 1) * 32768;
        const unsigned char* cur = lds + so;
#pragma unroll
        for (int kk = 0; kk < 4; ++kk) {
            bf16x8 af[2], wf[2];
#pragma unroll
            for (int i = 0; i < 2; ++i) af[i] = *(const bf16x8*)(cur + tile_off(64 * wm + 32 * i + r, 2 * kk + h));
#pragma unroll
            for (int j = 0; j < 2; ++j) {
                const v4i16_t lo = __builtin_amdgcn_ds_read_tr16_b64_v4i16((LAS v4i16_t*)(tb[j][0] + so + 4096 * kk));
                const v4i16_t hi = __builtin_amdgcn_ds_read_tr16_b64_v4i16((LAS v4i16_t*)(tb[j][1] + so + 4096 * kk));
                wf[j] = (bf16x8){lo[0], lo[1], lo[2], lo[3], hi[0], hi[1], hi[2], hi[3]};
            }
#pragma unroll
            for (int j = 0; j < 2; ++j)
#pragma unroll
                for (int i = 0; i < 2; ++i) acc[j][i] = SWAP ? __builtin_amdgcn_mfma_f32_32x32x16_bf16(af[i], wf[j], acc[j][i], 0, 0, 0)
                                                             : __builtin_amdgcn_mfma_f32_32x32x16_bf16(wf[j], af[i], acc[j][i], 0, 0, 0);
        }
    }
    __syncthreads();
#undef G_DMA
}

constexpr int CST = 272;
DEV void ctile_put(unsigned char* lds, int row, int col, float a, float b, float c, float d) {
    uint2 u; u.x = cvtpk(a, b); u.y = cvtpk(c, d);
    *(uint2*)(lds + row * CST + col * 2) = u;
}
template <int COLS, class RP>
DEV void ctile_flush(unsigned char* lds, const int TIDX, RP rowptr) {
    asm volatile("s_waitcnt lgkmcnt(0)" ::: "memory");
    __builtin_amdgcn_s_barrier();
    asm volatile("" ::: "memory");
    constexpr int CPR = COLS / 8, RPI = 256 / CPR;
#pragma unroll
    for (int it = 0; it < 128 / RPI; ++it) {
        const int row = it * RPI + TIDX / CPR, c16 = TIDX % CPR;
        bf16_t* dst = rowptr(row, it);
        const u32x4 val = *(const u32x4*)(lds + row * CST + c16 * 16);
        if (dst) *(u32x4*)(dst + c16 * 8) = val;
    }
}

DEV void ph_inproj_fast(const P& p, int l, unsigned char* lds) {
    const V v = make_views(p); const int TIDX = otid(), BIDX = obid();
    const bf16_t* W = (const bf16_t*)(p.ws + WS_WIN) + (size_t)l * D * NPW;
    const int lane = TIDX & 63, wave = TIDX >> 6, wm = wave >> 1, wn = wave & 1, r = lane & 31, h = lane >> 5;
    const bool xo = gridDim.x == 512;
    unsigned char* ct = lds + 32768;
    auto decode = [&](int it, int& mt, int& nt) -> int {
        if (xo) { if (it >= 6) return -1; const int lb = BIDX >> 3; nt = 8 * (it % 3) + (lb >> 3); mt = 16 * (BIDX & 7) + 8 * (it / 3) + (lb & 7); return nt < 23 ? 1 : 0; }
        const int unit = BIDX + it * (int)gridDim.x; if (unit >= 128 * 23) return -1; nt = unit / 128; mt = unit % 128; return 1;
    };
    auto issue = [&](int mt, int nt) {
        const bf16_t* ar[4];
#pragma unroll
        for (int i = 0; i < 4; ++i) ar[i] = v.H + (size_t)(mt * 128 + (TIDX >> 3) + 32 * i) * D;
        gemm_issue0(lds, ar, W + nt * 128, NPW, TIDX);
    };
    bool pre = false;
    for (int it = 0;; ++it) {
        int nt, mt;
        const int dv = decode(it, mt, nt);
        if (dv < 0) break;
        if (dv == 0) continue;
        const int m0 = mt * 128, n0 = nt * 128;
        const bf16_t* arow[4];
#pragma unroll
        for (int i = 0; i < 4; ++i) arow[i] = v.H + (size_t)(m0 + (TIDX >> 3) + 32 * i) * D;
        if (!pre) { __syncthreads(); issue(mt, nt); pre = true; }
        int itn = it + 1, mtn = 0, ntn = 0, dn;
        while ((dn = decode(itn, mtn, ntn)) == 0) ++itn;
        f32x16 acc[2][2];
        if (is_vcol(n0)) {
            gemm128<true, true>(lds, arow, W + n0, NPW, D, acc, TIDX);
            if (dn > 0) issue(mtn, ntn); else pre = false;
#pragma unroll
            for (int j = 0; j < 2; ++j)
#pragma unroll
                for (int i = 0; i < 2; ++i)
#pragma unroll
                    for (int g = 0; g < 4; ++g)
                        ctile_put(ct, 64 * wn + 32 * j + r, 64 * wm + 32 * i + 8 * g + 4 * h, acc[j][i][4 * g], acc[j][i][4 * g + 1], acc[j][i][4 * g + 2], acc[j][i][4 * g + 3]);
            bf16_t* vt = (bf16_t*)(p.ws + WS_VT) + ((size_t)(m0 >> 11) * 768 + vt_row(n0)) * S + (m0 & (S - 1));
            ctile_flush<128>(ct, TIDX, [&](int row, int) { return vt + (size_t)row * S; });
            continue;
        }
        const bool rope_tile = n0 < 512 || n0 == C_KS || n0 == C_KW;
        f32x4v rcs[2], rsn[2];
        if (rope_tile) {
#pragma unroll
            for (int i = 0; i < 2; ++i) {
                const int sp = (m0 + 64 * wm + 32 * i + r) & (S - 1);
                rcs[i] = *(const f32x4v*)(v.rcos + sp * 8 + 4 * h); rsn[i] = *(const f32x4v*)(v.rsin + sp * 8 + 4 * h);
            }
        }
        gemm128<false, true>(lds, arow, W + n0, NPW, D, acc, TIDX);
        if (dn > 0) issue(mtn, ntn); else pre = false;
        if (n0 == 2816) {
            if (wn == 0) {
#pragma unroll
                for (int i = 0; i < 2; ++i) {
                    const int m = m0 + 64 * wm + 32 * i + r;
#pragma unroll
                    for (int q = 0; q < 16; ++q) {
                        const int cc = (q & 3) + 8 * (q >> 2) + 4 * h;
                        if (cc < 24) v.gf[(size_t)m * 32 + cc] = acc[0][i][q];
                        else if (cc < 28) ((float*)(p.ws + WS_LSF))[(size_t)((m >> 11) * 4 + cc - 24) * S + (m & (S - 1))] = logsigmoidf_(acc[0][i][q] + p.b_forget[l * 4 + cc - 24]);
                    }
                }
            }
            continue;
        }
#pragma unroll
        for (int j = 0; j < 2; ++j) {
            const int nb = n0 + 64 * wn + 32 * j;
            const bool rope = ((nb & 63) == 0) && (nb < 512 || (nb >= C_KS && nb < C_VS) || (nb >= C_KW && nb < C_VW));
#pragma unroll
            for (int i = 0; i < 2; ++i) {
                f32x16 a = acc[j][i];
                if (rope) {
#pragma unroll
                    for (int q = 0; q < 4; ++q) { const float x1 = a[q], x2 = a[q + 4]; a[q] = x1 * rcs[i][q] - x2 * rsn[i][q]; a[q + 4] = x2 * rcs[i][q] + x1 * rsn[i][q]; }
                }
#pragma unroll
                for (int g = 0; g < 4; ++g) ctile_put(ct, 64 * wm + 32 * i + r, 64 * wn + 32 * j + 8 * g + 4 * h, a[4 * g], a[4 * g + 1], a[4 * g + 2], a[4 * g + 3]);
            }
        }
        bf16_t* ub = v.U + (size_t)m0 * NP + n0;
        ctile_flush<128>(ct, TIDX, [&](int row, int) { return ub + (size_t)row * NP; });
    }
}

DEV void ph_outproj_fast(const P& p, int l, unsigned char* lds) {
    const V v = make_views(p); const int TIDX = otid(), BIDX = obid();
    const bf16_t* W = (const bf16_t*)(p.ws + WS_WOT) + (size_t)l * D * D;
    const int lane = TIDX & 63, wave = TIDX >> 6, wm = wave >> 1, wn = wave & 1, r = lane & 31, h = lane >> 5;
    const bool xo = gridDim.x == 512;
    auto decode = [&](int it, int& mt, int& nt) -> bool {
        if (xo) { if (it >= 2) return false; const int lb = BIDX >> 3; nt = lb >> 3; mt = 16 * (BIDX & 7) + 8 * it + (lb & 7); return true; }
        const int unit = BIDX + it * (int)gridDim.x; if (unit >= 128 * 8) return false; nt = unit / 128; mt = unit % 128; return true;
    };
    auto issue = [&](int mt, int nt) {
        const bf16_t* ar[4];
#pragma unroll
        for (int i = 0; i < 4; ++i) ar[i] = v.O + (size_t)(mt * 128 + (TIDX >> 3) + 32 * i) * D;
        gemm_issue0(lds, ar, W + nt * 128, D, TIDX);
    };
    for (int it = 0;; ++it) {
        int nt, mt, ntn = 0, mtn = 0;
        if (!decode(it, mt, nt)) break;
        const bool hasn = decode(it + 1, mtn, ntn);
        const int m0 = mt * 128, n0 = nt * 128;
        const bf16_t* arow[4];
#pragma unroll
        for (int i = 0; i < 4; ++i) arow[i] = v.O + (size_t)(m0 + (TIDX >> 3) + 32 * i) * D;
        if (it == 0) { __syncthreads(); issue(mt, nt); }
        f32x4v xin[2][2][4];
#pragma unroll
        for (int j = 0; j < 2; ++j)
#pragma unroll
            for (int i = 0; i < 2; ++i)
#pragma unroll
                for (int g = 0; g < 4; ++g) xin[j][i][g] = *(const f32x4v*)(v.X + (size_t)(m0 + 64 * wm + 32 * i + r) * D + n0 + 64 * wn + 32 * j + 4 * h + 8 * g);
        f32x16 acc[2][2];
        gemm128<false, true>(lds, arow, W + n0, D, D, acc, TIDX);
        if (hasn) issue(mtn, ntn);
        const float* g1 = v.mod + (size_t)(l * 8 + (m0 >> 11)) * 6144 + 2 * D;
#pragma unroll
        for (int j = 0; j < 2; ++j)
#pragma unroll
            for (int i = 0; i < 2; ++i) {
                const int m = m0 + 64 * wm + 32 * i + r, nb = n0 + 64 * wn + 32 * j + 4 * h;
#pragma unroll
                for (int g = 0; g < 4; ++g) {
                    const float4 gg = *(const float4*)(g1 + nb + 8 * g);
                    f32x4v xo = xin[j][i][g];
                    xo[0] += gg.x * acc[j][i][4 * g]; xo[1] += gg.y * acc[j][i][4 * g + 1]; xo[2] += gg.z * acc[j][i][4 * g + 2]; xo[3] += gg.w * acc[j][i][4 * g + 3];
                    *(f32x4v*)(v.X + (size_t)m * D + nb + 8 * g) = xo;
                }
            }
    }
}

DEV void ph_moe_up_fast(const P& p, int l, unsigned char* lds) {
    const V v = make_views(p); const int TIDX = otid(), BIDX = obid();
    const int lane = TIDX & 63, wave = TIDX >> 6, wm = wave >> 1, wn = wave & 1, r = lane & 31, h = lane >> 5;
    const unsigned* cnt = v.ctl + CW_CNT + l * 32;
    int* tp = (int*)(lds + 67584); int* rb = tp + 40;
    __syncthreads();
    if (TIDX < 64) {
        const int c = TIDX < 32 ? (int)cnt[TIDX] : 0;
        int nu = ((c + 127) >> 7) * 8, cc = c;
#pragma unroll
        for (int o = 1; o < 32; o <<= 1) { const int a = __shfl_up(nu, o), b2 = __shfl_up(cc, o); if ((TIDX & 31) >= o) { nu += a; cc += b2; } }
        if (TIDX < 32) { tp[TIDX + 1] = nu; rb[TIDX + 1] = cc; if (TIDX == 0) { tp[0] = 0; rb[0] = 0; } }
    }
    __syncthreads();
    const int total = tp[32];
    unsigned char* ct = lds + 32768;
    struct UU { int e, base, nt, mt, nrow; const int* lst; const bf16_t* B; const bf16_t* ar[4]; };
    auto setup = [&](int unit, UU& u) {
        int e = 0;
#pragma unroll
        for (int st = 16; st > 0; st >>= 1) if (tp[e + st] <= unit) e += st;
        const int rem = unit - tp[e];
        u.e = e; u.base = rb[e]; u.nt = rem & 7; u.mt = rem >> 3;
        const int ce = rb[e + 1] - u.base;
        u.lst = v.list + (size_t)e * T + u.mt * 128;
        u.nrow = ce - u.mt * 128 < 128 ? ce - u.mt * 128 : 128;
        u.B = (const bf16_t*)(p.ws + WS_W13) + ((size_t)l * 32 + e) * 1024 * D + u.nt * 128;
#pragma unroll
        for (int i = 0; i < 4; ++i) { const int rr = (TIDX >> 3) + 32 * i; u.ar[i] = v.H + (size_t)(u.lst[rr < u.nrow ? rr : 0] >> 1) * D; }
    };
    int unit = BIDX;
    if (unit >= total) return;
    UU cu, nu;
    setup(unit, cu);
    __syncthreads();
    gemm_issue0(lds, cu.ar, cu.B, 1024, TIDX);
    for (;;) {
        const int un = unit + (int)gridDim.x;
        f32x16 acc[2][2];
        gemm128<false, true>(lds, cu.ar, cu.B, 1024, D, acc, TIDX);
        if (un < total) { setup(un, nu); gemm_issue0(lds, nu.ar, nu.B, 1024, TIDX); }
#pragma unroll
        for (int i = 0; i < 2; ++i)
#pragma unroll
            for (int g = 0; g < 4; ++g) {
                float o[4];
#pragma unroll
                for (int q = 0; q < 4; ++q) { const float a1 = acc[0][i][4 * g + q], a3 = acc[1][i][4 * g + q]; o[q] = a1 / (1.f + __expf(-a1)) * a3; }
                ctile_put(ct, 64 * wm + 32 * i + r, 32 * wn + 8 * g + 4 * h, o[0], o[1], o[2], o[3]);
            }
        bf16_t* hb = v.HID + (size_t)(cu.base + cu.mt * 128) * 512 + 64 * cu.nt;
        const int nrow = cu.nrow;
        ctile_flush<64>(ct, TIDX, [&](int row, int) { return row < nrow ? hb + (size_t)row * 512 : (bf16_t*)nullptr; });
        if (un >= total) break;
        unit = un; cu = nu;
    }
}
DEV void ph_moe_down_fast(const P& p, int l, unsigned char* lds) {
    const V v = make_views(p); const int TIDX = otid(), BIDX = obid();
    const int lane = TIDX & 63, wave = TIDX >> 6, wm = wave >> 1, wn = wave & 1, r = lane & 31, h = lane >> 5;
    const unsigned* cnt = v.ctl + CW_CNT + l * 32;
    int* tp = (int*)(lds + 67584); int* rb = tp + 40;
    __syncthreads();
    if (TIDX < 64) {
        const int c = TIDX < 32 ? (int)cnt[TIDX] : 0;
        int nu = ((c + 127) >> 7) * 8, cc = c;
#pragma unroll
        for (int o = 1; o < 32; o <<= 1) { const int a = __shfl_up(nu, o), b2 = __shfl_up(cc, o); if ((TIDX & 31) >= o) { nu += a; cc += b2; } }
        if (TIDX < 32) { tp[TIDX + 1] = nu; rb[TIDX + 1] = cc; if (TIDX == 0) { tp[0] = 0; rb[0] = 0; } }
    }
    __syncthreads();
    const int total = tp[32];
    unsigned char* ct = lds + 32768;
    struct UD { int n0, nrow; const bf16_t* B; const bf16_t* ar[4]; float wrow[2]; int fslot[8]; };
    auto setup = [&](int unit, UD& u) {
        int e = 0;
#pragma unroll
        for (int st = 16; st > 0; st >>= 1) if (tp[e + st] <= unit) e += st;
        const int rem = unit - tp[e], base = rb[e];
        const int ce = rb[e + 1] - base, nt = rem & 7, mt = rem >> 3;
        const int* lst = v.list + (size_t)e * T + mt * 128;
        u.n0 = nt * 128;
        u.nrow = ce - mt * 128 < 128 ? ce - mt * 128 : 128;
        u.B = (const bf16_t*)(p.ws + WS_W2) + ((size_t)l * 32 + e) * 512 * D + u.n0;
#pragma unroll
        for (int i = 0; i < 4; ++i) { const int rr = (TIDX >> 3) + 32 * i; u.ar[i] = v.HID + (size_t)(base + mt * 128 + (rr < u.nrow ? rr : 0)) * 512; }
#pragma unroll
        for (int i = 0; i < 2; ++i) { const int mr = 64 * wm + 32 * i + r; u.wrow[i] = mr < u.nrow ? v.wts[lst[mr]] : 0.f; }
#pragma unroll
        for (int it = 0; it < 8; ++it) { const int row = it * 16 + (TIDX >> 4); u.fslot[it] = row < u.nrow ? lst[row] : -1; }
    };
    int unit = BIDX;
    if (unit >= total) return;
    UD cu, nu;
    setup(unit, cu);
    __syncthreads();
    gemm_issue0(lds, cu.ar, cu.B, D, TIDX);
    for (;;) {
        const int un = unit + (int)gridDim.x;
        f32x16 acc[2][2];
        gemm128<false, true>(lds, cu.ar, cu.B, D, 512, acc, TIDX);
        if (un < total) { setup(un, nu); gemm_issue0(lds, nu.ar, nu.B, D, TIDX); }
#pragma unroll
        for (int i = 0; i < 2; ++i) {
            const int mr = 64 * wm + 32 * i + r;
            const float w = cu.wrow[i];
#pragma unroll
            for (int j = 0; j < 2; ++j)
#pragma unroll
                for (int g = 0; g < 4; ++g)
                    ctile_put(ct, mr, 64 * wn + 32 * j + 8 * g + 4 * h, w * acc[j][i][4 * g], w * acc[j][i][4 * g + 1], w * acc[j][i][4 * g + 2], w * acc[j][i][4 * g + 3]);
        }
        const int n0 = cu.n0;
        ctile_flush<128>(ct, TIDX, [&](int, int it) { const int sl = cu.fslot[it]; return sl >= 0 ? v.Y + (size_t)sl * D + n0 : (bf16_t*)nullptr; });
        if (un >= total) break;
        unit = un; cu = nu;
    }
}

constexpr float LOG2E = 1.4426950408889634f, C2 = 0.125f * 1.4426950408889634f, LN2 = 0.6931471805599453f;
DEV float fexp2(float x) { return __builtin_amdgcn_exp2f(x); }
DEV float flog2(float x) { return __builtin_amdgcn_logf(x); }
DEV int swap23(int r) { return (r & ~12) | ((r & 4) << 1) | ((r & 8) >> 1); }

struct KVT { const bf16_t* k; int ks; const bf16_t* v; int vs; };
DEV void kv_load(const KVT& s, int kv0, const int TIDX, u32x4 (&rg)[4]) {
    const int c = TIDX & 7, r0 = TIDX >> 3;
    rg[0] = *(const u32x4*)(s.k + (size_t)(kv0 + r0) * s.ks + c * 8);
    rg[1] = *(const u32x4*)(s.k + (size_t)(kv0 + r0 + 32) * s.ks + c * 8);
    rg[2] = *(const u32x4*)(s.v + (size_t)r0 * s.vs + kv0 + c * 8);
    rg[3] = *(const u32x4*)(s.v + (size_t)(r0 + 32) * s.vs + kv0 + c * 8);
}
DEV void kv_store(unsigned char* st, const int TIDX, const u32x4 (&rg)[4]) {
    const int c = TIDX & 7, r0 = TIDX >> 3;
    *(u32x4*)(st + tile_off(r0, c)) = rg[0]; *(u32x4*)(st + tile_off(r0 + 32, c)) = rg[1];
    *(u32x4*)(st + 8192 + tile_off(r0, c)) = rg[2]; *(u32x4*)(st + 8192 + tile_off(r0 + 32, c)) = rg[3];
}
DEV bf16x8 scale_frag(bf16x8 v, float sc) {
    u32x4 u = __builtin_bit_cast(u32x4, v);
#pragma unroll
    for (int i = 0; i < 4; ++i) u[i] = cvtpk(__uint_as_float(u[i] << 16) * sc, __uint_as_float(u[i] & 0xffff0000u) * sc);
    return __builtin_bit_cast(bf16x8, u);
}
DEV void score_tile(const unsigned char* Kt, const bf16x8 (&qf)[4], int r, int h, f32x16 (&p)[2]) {
    const int kr = swap23(r);
#pragma unroll
    for (int blk = 0; blk < 2; ++blk) {
#pragma unroll
        for (int q = 0; q < 16; ++q) p[blk][q] = 0.f;
#pragma unroll
        for (int s = 0; s < 4; ++s) {
            const bf16x8 kf = *(const bf16x8*)(Kt + tile_off(32 * blk + kr, 2 * s + h));
            p[blk] = __builtin_amdgcn_mfma_f32_32x32x16_bf16(kf, qf[s], p[blk], 0, 0, 0);
        }
    }
}
DEV void pv_tile(const unsigned char* Vt, const f32x16 (&p)[2], int r, int h, f32x16 (&o)[2]) {
#pragma unroll
    for (int blk = 0; blk < 2; ++blk)
#pragma unroll
        for (int s = 0; s < 2; ++s) {
            u32x4 pk;
            pk.x = cvtpk(p[blk][8 * s], p[blk][8 * s + 1]); pk.y = cvtpk(p[blk][8 * s + 2], p[blk][8 * s + 3]);
            pk.z = cvtpk(p[blk][8 * s + 4], p[blk][8 * s + 5]); pk.w = cvtpk(p[blk][8 * s + 6], p[blk][8 * s + 7]);
            const bf16x8 pb = __builtin_bit_cast(bf16x8, pk);
#pragma unroll
            for (int db = 0; db < 2; ++db) {
                const bf16x8 vf = *(const bf16x8*)(Vt + tile_off(32 * db + r, 2 * (2 * blk + s) + h));
                o[db] = __builtin_amdgcn_mfma_f32_32x32x16_bf16(vf, pb, o[db], 0, 0, 0);
            }
        }
}

template <int VAR>
DEV void attn_branch(unsigned char* lds, const KVT& src, const bf16x8 (&qf)[4], unsigned tmask, int wave_last, int t, int t_first,
                     unsigned selbits, const float* bias2, f32x16 (&o)[2], const int TIDX) {
    const int lane = TIDX & 63, r = lane & 31, h = lane >> 5;
    const float NEG_INF = -__builtin_inff();
    float mrun = -1e30f, lrun = 0.f, rest = VAR == 3 ? 1.f : 0.f;
#pragma unroll
    for (int db = 0; db < 2; ++db)
#pragma unroll
        for (int q = 0; q < 16; ++q) o[db][q] = 0.f;
    u32x4 rg[4];
    unsigned rem = tmask;
    int j = VAR == 3 ? 31 - __builtin_clz(rem) : __builtin_ctz(rem);
    rem &= ~(1u << j);
    kv_load(src, 64 * j, TIDX, rg);
    __syncthreads();
    kv_store(lds, TIDX, rg);
    __syncthreads();
    int stage = 0;
    for (;;) {
        int jn = -1;
        if (rem) { jn = VAR == 3 ? 31 - __builtin_clz(rem) : __builtin_ctz(rem); rem &= ~(1u << jn); kv_load(src, 64 * jn, TIDX, rg); }
        asm volatile("" ::: "memory"); __builtin_amdgcn_sched_barrier(0);
        if (j <= wave_last) {
            const unsigned char* Kt = lds + stage * 16384;
            f32x16 p[2];
            score_tile(Kt, qf, r, h, p);
            const int kvb = 64 * j + 8 * h;
            if (VAR == 3) {
                const bool diag = 64 * j + 63 >= t_first;
                float gt[2][2];
                if (diag) {
#pragma unroll
                    for (int blk = 0; blk < 2; ++blk)
#pragma unroll
                        for (int s = 0; s < 2; ++s) {
                            float run = 1.f;
#pragma unroll
                            for (int q = 7; q >= 0; --q) {
                                const float ez = fexp2(p[blk][8 * s + q]);
                                float w = __builtin_amdgcn_rcpf(1.f + ez);
                                float beta = 1.f - w;
                                const bool valid = kvb + 32 * blk + 16 * s + q < t;
                                w = valid ? w : 1.f; beta = valid ? beta : 0.f;
                                p[blk][8 * s + q] = beta * run;
                                run *= w;
                            }
                            gt[blk][s] = run;
                        }
                } else {
#pragma unroll
                    for (int blk = 0; blk < 2; ++blk)
#pragma unroll
                        for (int s = 0; s < 2; ++s) {
                            float run = 1.f;
#pragma unroll
                            for (int q = 7; q >= 0; --q) {
                                const float rn = run * __builtin_amdgcn_rcpf(1.f + fexp2(p[blk][8 * s + q]));
                                p[blk][8 * s + q] = run - rn;
                                run = rn;
                            }
                            gt[blk][s] = run;
                        }
                }
                float og[2][2], pt[2][2];
#pragma unroll
                for (int blk = 0; blk < 2; ++blk)
#pragma unroll
                    for (int s = 0; s < 2; ++s) { og[blk][s] = __shfl_xor(gt[blk][s], 32); pt[blk][s] = gt[blk][s] * og[blk][s]; }
                float above = rest;
#pragma unroll
                for (int pi = 3; pi >= 0; --pi) {
                    const int blk = pi >> 1, s = pi & 1;
                    const float carry = above * (h == 0 ? og[blk][s] : 1.f);
#pragma unroll
                    for (int q = 0; q < 8; ++q) p[blk][8 * s + q] *= carry;
                    above *= pt[blk][s];
                }
                rest = above;
            } else {
                const bool need_causal = 64 * j + 63 > t_first;
                const bool need_win = VAR == 1 && (64 * j + 512 <= t_first + 31);
                const bool lane_on = VAR != 0 || ((selbits >> j) & 1u);
                if (VAR == 2) {
#pragma unroll
                    for (int blk = 0; blk < 2; ++blk)
#pragma unroll
                        for (int s = 0; s < 2; ++s) {
                            const float4 b0 = *(const float4*)(bias2 + kvb + 32 * blk + 16 * s), b1 = *(const float4*)(bias2 + kvb + 32 * blk + 16 * s + 4);
                            p[blk][8 * s] += b0.x; p[blk][8 * s + 1] += b0.y; p[blk][8 * s + 2] += b0.z; p[blk][8 * s + 3] += b0.w;
                            p[blk][8 * s + 4] += b1.x; p[blk][8 * s + 5] += b1.y; p[blk][8 * s + 6] += b1.z; p[blk][8 * s + 7] += b1.w;
                        }
                }
                if (need_causal) {
#pragma unroll
                    for (int blk = 0; blk < 2; ++blk)
#pragma unroll
                        for (int q = 0; q < 16; ++q) { const int kv = kvb + 32 * blk + 16 * (q >> 3) + (q & 7); p[blk][q] = kv <= t ? p[blk][q] : NEG_INF; }
                }
                if (need_win) {
#pragma unroll
                    for (int blk = 0; blk < 2; ++blk)
#pragma unroll
                        for (int q = 0; q < 16; ++q) { const int kv = kvb + 32 * blk + 16 * (q >> 3) + (q & 7); p[blk][q] = kv + 512 > t ? p[blk][q] : NEG_INF; }
                }
                float tmax = p[0][0];
#pragma unroll
                for (int q = 1; q < 16; ++q) tmax = fmaxf(tmax, p[0][q]);
#pragma unroll
                for (int q = 0; q < 16; ++q) tmax = fmaxf(tmax, p[1][q]);
                tmax = lane_on ? tmax : NEG_INF;
                tmax = fmaxf(tmax, __shfl_xor(tmax, 32));
                const float mnew = fmaxf(mrun, tmax);
                const bool grew = mnew > mrun;
                const float alpha = fexp2(mrun - mnew);
                mrun = mnew;
                const float msub = lane_on ? mnew : __builtin_inff();
                const f32x2_t ms2 = {msub, msub};
                f32x2_t ls2 = {0.f, 0.f};
#pragma unroll
                for (int blk = 0; blk < 2; ++blk)
#pragma unroll
                    for (int q = 0; q < 16; q += 2) {
                        const f32x2_t d2 = (f32x2_t){p[blk][q], p[blk][q + 1]} - ms2;
                        f32x2_t e2; e2.x = fexp2(d2.x); e2.y = fexp2(d2.y);
                        p[blk][q] = e2.x; p[blk][q + 1] = e2.y; ls2 += e2;
                    }
                lrun = lrun * alpha + (ls2.x + ls2.y);
                if (__any(grew)) {
#pragma unroll
                    for (int db = 0; db < 2; ++db)
#pragma unroll
                        for (int q = 0; q < 16; ++q) o[db][q] *= alpha;
                }
            }
            pv_tile(Kt + 8192, p, r, h, o);
        }
        if (jn >= 0) kv_store(lds + (stage ^ 1) * 16384, TIDX, rg);
        __syncthreads();
        if (jn < 0) break;
        j = jn; stage ^= 1;
    }
    if (VAR != 3) {
        const float lt = lrun + __shfl_xor(lrun, 32);
        const float inv = lt > 0.f ? 1.f / lt : 0.f;
#pragma unroll
        for (int db = 0; db < 2; ++db)
#pragma unroll
            for (int q = 0; q < 16; ++q) o[db][q] *= inv;
    }
}

DEV void head_norm_store(const f32x16 (&o)[2], const float* gam, bf16_t* dst, int h) {
    float ss = 0.f;
#pragma unroll
    for (int db = 0; db < 2; ++db)
#pragma unroll
        for (int q = 0; q < 16; ++q) ss += o[db][q] * o[db][q];
    ss += __shfl_xor(ss, 32);
    const float rinv = rsqrtf(ss * (1.f / 64.f) + EPS);
#pragma unroll
    for (int db = 0; db < 2; ++db)
#pragma unroll
        for (int g = 0; g < 4; ++g) {
            const int d = 32 * db + 8 * g + 4 * h;
            const float4 gg = *(const float4*)(gam + d);
            uint2 u;
            u.x = cvtpk(o[db][4 * g] * rinv * gg.x, o[db][4 * g + 1] * rinv * gg.y);
            u.y = cvtpk(o[db][4 * g + 2] * rinv * gg.z, o[db][4 * g + 3] * rinv * gg.w);
            *(uint2*)(dst + d) = u;
        }
}

template <int VAR>
DEV void mha_unit(const P& p, int l, int unit, unsigned char* lds) {
    const V v = make_views(p); const int TIDX = otid();
    const int lane = TIDX & 63, wave = TIDX >> 6, r = lane & 31, h = lane >> 5;
    const int qb = 15 - (unit >> 5), bh = unit & 31, b = bh >> 2, hh = bh & 3;
    const int t0 = qb * 128, tw = t0 + 32 * wave, t = tw + r, m = b * S + t;
    const int qcol = VAR == 2 ? C_QB : C_QC, kcol = VAR == 2 ? C_KB : C_KCC, vrow = VAR == 2 ? 256 : 512, ocol = VAR == 2 ? 512 : 768;
    bf16x8 qf[4];
#pragma unroll
    for (int s = 0; s < 4; ++s) qf[s] = scale_frag(*(const bf16x8*)(v.U + (size_t)m * NP + qcol + hh * 64 + 16 * s + 8 * h), C2);
    KVT src;
    src.k = v.U + (size_t)b * S * NP + kcol + hh * 64; src.ks = NP;
    src.v = (const bf16_t*)(p.ws + WS_VT) + (size_t)(b * 768 + vrow + hh * 64) * S; src.vs = S;
    const int last = (t0 + 127) >> 6;
    const unsigned tmask = last == 31 ? 0xffffffffu : ((1u << (last + 1)) - 1u);
    const float* bias2 = (const float*)(lds + 32768);
    if (VAR == 2) {
        float* cf = (float*)(lds + 32768);
        float* wt = (float*)(lds + 32768 + 8192);
        const float* lsf = (const float*)(p.ws + WS_LSF) + (size_t)(b * 4 + hh) * S;
        const int nel = t0 + 128;
        float x[8];
        if (8 * TIDX < nel) {
            const float4 a0 = *(const float4*)(lsf + 8 * TIDX), a1 = *(const float4*)(lsf + 8 * TIDX + 4);
            x[0] = a0.x; x[1] = x[0] + a0.y; x[2] = x[1] + a0.z; x[3] = x[2] + a0.w; x[4] = x[3] + a1.x; x[5] = x[4] + a1.y; x[6] = x[5] + a1.z; x[7] = x[6] + a1.w;
        } else {
#pragma unroll
            for (int q = 0; q < 8; ++q) x[q] = 0.f;
        }
        float inc = x[7];
#pragma unroll
        for (int o = 1; o < 64; o <<= 1) { const float tt = __shfl_up(inc, o); if (lane >= o) inc += tt; }
        __syncthreads();
        if (lane == 63) wt[wave] = inc;
        __syncthreads();
        float off = inc - x[7];
#pragma unroll
        for (int w = 0; w < 3; ++w) off += (w < wave) ? wt[w] : 0.f;
        if (8 * TIDX < nel) {
#pragma unroll
            for (int q = 0; q < 8; ++q) cf[8 * TIDX + q] = -(x[q] + off) * LOG2E;
        }
        __syncthreads();
    }
    f32x16 o[2];
    attn_branch<VAR>(lds, src, qf, tmask, (tw + 31) >> 6, t, tw, 0u, bias2, o, TIDX);
    head_norm_store(o, p.out_norm_g + (size_t)l * D + ocol + hh * 64, v.O + (size_t)m * D + ocol + hh * 64, h);
}

DEV void nsa_unit(const P& p, int l, int unit, unsigned char* lds) {
    const V v = make_views(p); const int TIDX = otid();
    const int lane = TIDX & 63, wave = TIDX >> 6, r = lane & 31, h = lane >> 5;
    const int qblk = 63 - (unit >> 4), bg = unit & 15, b = bg >> 1, g = bg & 1;
    const int t0 = qblk * 32, t = t0 + r, m = b * S + t, head = g * 4 + wave, cur = t0 >> 6;
    const float NEG_INF = -__builtin_inff();
    bf16x8 qf[4];
#pragma unroll
    for (int s = 0; s < 4; ++s) qf[s] = scale_frag(*(const bf16x8*)(v.U + (size_t)m * NP + C_QA + head * 64 + 16 * s + 8 * h), C2);
    const float g0 = sigmoidf_(v.gf[(size_t)m * 32 + head * 3]), g1 = sigmoidf_(v.gf[(size_t)m * 32 + head * 3 + 1]), g2 = sigmoidf_(v.gf[(size_t)m * 32 + head * 3 + 2]);
    f32x16 otot[2];
    float* PA = (float*)(lds + 32768);
    float* PB = (float*)(lds + 49152);
    float* SC = (float*)lds;
    unsigned* MASK = (unsigned*)(lds + 8192);
    {
        const bf16_t* ck = v.ck + (size_t)(b * 2 + g) * 128 * 64;
        const bf16_t* cvt = (const bf16_t*)(p.ws + WS_CVT) + (size_t)(b * 2 + g) * 64 * 128;
        const int c = TIDX & 7, r0 = TIDX >> 3;
        u32x4 rk[4], rv[4];
#pragma unroll
        for (int i = 0; i < 4; ++i) rk[i] = *(const u32x4*)(ck + (size_t)(r0 + 32 * i) * 64 + c * 8);
#pragma unroll
        for (int i = 0; i < 4; ++i) rv[i] = *(const u32x4*)(cvt + (size_t)(r0 + 32 * (i & 1)) * 128 + 64 * (i >> 1) + c * 8);
        __syncthreads();
#pragma unroll
        for (int i = 0; i < 4; ++i) *(u32x4*)(lds + tile_off(r0 + 32 * i, c)) = rk[i];
#pragma unroll
        for (int i = 0; i < 4; ++i) *(u32x4*)(lds + 16384 + 8192 * (i >> 1) + tile_off(r0 + 32 * (i & 1), c)) = rv[i];
        __syncthreads();
        f32x16 ps[2][2];
        score_tile(lds, qf, r, h, ps[0]);
        score_tile(lds + 8192, qf, r, h, ps[1]);
        const int nvalid = t >= 31 ? (t - 31) / 16 + 1 : 0;
        float mx = NEG_INF;
#pragma unroll
        for (int tt = 0; tt < 2; ++tt)
#pragma unroll
            for (int blk = 0; blk < 2; ++blk)
#pragma unroll
                for (int q = 0; q < 16; ++q) {
                    const int n = 64 * tt + 32 * blk + 16 * (q >> 3) + 8 * h + (q & 7);
                    const float x = n < nvalid ? ps[tt][blk][q] : NEG_INF;
                    ps[tt][blk][q] = x; mx = fmaxf(mx, x);
                }
        mx = fmaxf(mx, __shfl_xor(mx, 32));
        const float mxs = nvalid > 0 ? mx : 0.f;
        float ls = 0.f;
#pragma unroll
        for (int tt = 0; tt < 2; ++tt)
#pragma unroll
            for (int blk = 0; blk < 2; ++blk)
#pragma unroll
                for (int q = 0; q < 16; ++q) { const float e = fexp2(ps[tt][blk][q] - mxs); ps[tt][blk][q] = e; ls += e; }
        const float lt = ls + __shfl_xor(ls, 32);
        const float inv = lt > 0.f ? 1.f / lt : 0.f;
#pragma unroll
        for (int tt = 0; tt < 2; ++tt)
#pragma unroll
            for (int blk = 0; blk < 2; ++blk) {
#pragma unroll
                for (int q = 0; q < 16; ++q) ps[tt][blk][q] *= inv;
#pragma unroll
                for (int s = 0; s < 2; ++s) {
                    const int G0 = 16 * tt + 8 * blk + 4 * s + 2 * h;
                    const float a0 = (ps[tt][blk][8 * s] + ps[tt][blk][8 * s + 1]) + (ps[tt][blk][8 * s + 2] + ps[tt][blk][8 * s + 3]);
                    const float a1 = (ps[tt][blk][8 * s + 4] + ps[tt][blk][8 * s + 5]) + (ps[tt][blk][8 * s + 6] + ps[tt][blk][8 * s + 7]);
                    PA[(wave * 32 + G0) * 32 + r] = a0; PA[(wave * 32 + G0 + 1) * 32 + r] = a1;
                    PB[(wave * 32 + G0 + 1) * 32 + r] = ps[tt][blk][8 * s + 3];
                    if (G0 + 2 < 32) PB[(wave * 32 + G0 + 2) * 32 + r] = ps[tt][blk][8 * s + 7];
                }
            }
        f32x16 oc[2];
#pragma unroll
        for (int db = 0; db < 2; ++db)
#pragma unroll
            for (int q = 0; q < 16; ++q) oc[db][q] = 0.f;
        pv_tile(lds + 16384, ps[0], r, h, oc);
        pv_tile(lds + 24576, ps[1], r, h, oc);
#pragma unroll
        for (int db = 0; db < 2; ++db)
#pragma unroll
            for (int q = 0; q < 16; ++q) otot[db][q] = g0 * oc[db][q];
    }
    __syncthreads();
    {
        const int q = TIDX & 31, j0 = (TIDX >> 5) * 4;
#pragma unroll
        for (int jj = 0; jj < 4; ++jj) {
            const int j = j0 + jj;
            float sc = 0.f;
#pragma unroll
            for (int w = 0; w < 4; ++w) sc += PA[(w * 32 + j) * 32 + q];
            if (j > 0) {
#pragma unroll
                for (int w = 0; w < 4; ++w) sc += PB[(w * 32 + j) * 32 + q];
            }
            const bool forced = (j == 0) || (j == cur) || (j == cur - 1);
            SC[q * 33 + j] = forced ? 1.0e4f : (j <= cur ? sc : -1.0f);
        }
        if (TIDX < 32) MASK[TIDX] = 0u;
        __syncthreads();
        unsigned bits = 0u;
#pragma unroll
        for (int jj = 0; jj < 4; ++jj) {
            const int j = j0 + jj;
            const float vj = SC[q * 33 + j];
            int rank = 0;
#pragma unroll
            for (int i = 0; i < 32; ++i) { const float vi = SC[q * 33 + i]; rank += (vi > vj || (vi == vj && i < j)) ? 1 : 0; }
            if (rank < 16) bits |= 1u << j;
        }
        atomicOr(&MASK[q], bits);
        __syncthreads();
    }
    const unsigned mybits = MASK[r];
    unsigned um = 0u;
#pragma unroll
    for (int i = 0; i < 32; ++i) um |= MASK[i];
    um = (unsigned)__builtin_amdgcn_readfirstlane((int)um);
    const unsigned upto = (2u << cur) - 1u;
    {
        KVT src; src.k = v.U + (size_t)b * S * NP + C_KS + g * 64; src.ks = NP;
        src.v = (const bf16_t*)(p.ws + WS_VT) + (size_t)(b * 768 + g * 64) * S; src.vs = S;
        f32x16 o[2];
        attn_branch<0>(lds, src, qf, um & upto, cur, t, t0, mybits, nullptr, o, TIDX);
#pragma unroll
        for (int db = 0; db < 2; ++db)
#pragma unroll
            for (int q = 0; q < 16; ++q) otot[db][q] += g1 * o[db][q];
    }
    {
        KVT src; src.k = v.U + (size_t)b * S * NP + C_KW + g * 64; src.ks = NP;
        src.v = (const bf16_t*)(p.ws + WS_VT) + (size_t)(b * 768 + 128 + g * 64) * S; src.vs = S;
        const int f = (t0 - 511 > 0 ? t0 - 511 : 0) >> 6;
        const unsigned wmask = upto & ~((1u << f) - 1u);
        f32x16 o[2];
        attn_branch<1>(lds, src, qf, wmask, cur, t, t0, 0u, nullptr, o, TIDX);
#pragma unroll
        for (int db = 0; db < 2; ++db)
#pragma unroll
            for (int q = 0; q < 16; ++q) otot[db][q] += g2 * o[db][q];
    }
    head_norm_store(otot, p.out_norm_g + (size_t)l * D + head * 64, v.O + (size_t)m * D + head * 64, h);
}

DEV void cmp_unit(const P& p, int l, int unit, unsigned char* lds) {
    const V v = make_views(p); const int TIDX = otid();
    const int lane = TIDX & 63, wave = TIDX >> 6, wm = wave >> 1, wn = wave & 1, r = lane & 31, h = lane >> 5;
    const int kv = unit & 1, bg = unit >> 1, b = bg >> 1, g = bg & 1, lk = l * 2 + kv;
    const int col = (kv ? C_VC : C_KC) + g * 64;
    const bf16_t* arow[4];
#pragma unroll
    for (int i = 0; i < 4; ++i) { const int n = (TIDX >> 3) + 32 * i; arow[i] = v.U + (size_t)(b * S + 16 * (n < 127 ? n : 126)) * NP + col; }
    f32x16 acc[2][2];
    gemm128<false>(lds, arow, (const bf16_t*)(p.ws + WS_CW1) + (size_t)lk * 2048 * 128, 128, 2048, acc, TIDX, NP);
    const float* pb = (const float*)(p.ws + WS_CPB) + lk * 128;
#pragma unroll
    for (int j = 0; j < 2; ++j)
#pragma unroll
        for (int i = 0; i < 2; ++i) {
            const int mrow = 64 * wm + 32 * i + r;
#pragma unroll
            for (int g4 = 0; g4 < 4; ++g4) {
                const float4 bb = *(const float4*)(pb + 64 * wn + 32 * j + 8 * g4 + 4 * h);
                float x0 = acc[j][i][4 * g4] + bb.x, x1 = acc[j][i][4 * g4 + 1] + bb.y, x2 = acc[j][i][4 * g4 + 2] + bb.z, x3 = acc[j][i][4 * g4 + 3] + bb.w;
                x0 = x0 / (1.f + __expf(-x0)); x1 = x1 / (1.f + __expf(-x1)); x2 = x2 / (1.f + __expf(-x2)); x3 = x3 / (1.f + __expf(-x3));
                uint2 u; u.x = cvtpk(x0, x1); u.y = cvtpk(x2, x3);
                *(uint2*)(lds + wn * 16384 + tile_off(mrow, 4 * j + g4) + 8 * h) = u;
            }
        }
    {
        const bf16_t* w2 = (const bf16_t*)(p.ws + WS_CW2) + (size_t)lk * 64 * 128;
        const int c = TIDX & 7, r0 = TIDX >> 3;
#pragma unroll
        for (int i = 0; i < 4; ++i) {
            const int row = r0 + 32 * (i & 1), kt = i >> 1;
            *(u32x4*)(lds + 32768 + kt * 8192 + tile_off(row, c)) = *(const u32x4*)(w2 + (size_t)row * 128 + kt * 64 + c * 8);
        }
    }
    __syncthreads();
    f32x16 a2[2];
#pragma unroll
    for (int db = 0; db < 2; ++db)
#pragma unroll
        for (int q = 0; q < 16; ++q) a2[db][q] = 0.f;
#pragma unroll
    for (int kt = 0; kt < 2; ++kt)
#pragma unroll
        for (int s = 0; s < 4; ++s) {
            const bf16x8 hf = *(const bf16x8*)(lds + kt * 16384 + tile_off(32 * wave + r, 2 * s + h));
#pragma unroll
            for (int db = 0; db < 2; ++db) {
                const bf16x8 wf = *(const bf16x8*)(lds + 32768 + kt * 8192 + tile_off(32 * db + r, 2 * s + h));
                a2[db] = __builtin_amdgcn_mfma_f32_32x32x16_bf16(wf, hf, a2[db], 0, 0, 0);
            }
        }
    const int n = 32 * wave + r;
    if (kv == 0 && n < 127) {
        const int pos = 16 * n + 31;
#pragma unroll
        for (int q = 0; q < 4; ++q) {
            const float cs = v.rcos[pos * 8 + q + 4 * h], sn = v.rsin[pos * 8 + q + 4 * h];
            const float x1 = a2[0][q], x2 = a2[0][q + 4];
            a2[0][q] = x1 * cs - x2 * sn; a2[0][q + 4] = x2 * cs + x1 * sn;
        }
    }
    bf16_t* dst = (kv ? v.cv : v.ck) + ((size_t)bg * 128 + n) * 64;
    bf16_t* dt = (bf16_t*)(p.ws + WS_CVT) + (size_t)bg * 64 * 128 + n;
#pragma unroll
    for (int db = 0; db < 2; ++db)
#pragma unroll
        for (int g4 = 0; g4 < 4; ++g4) {
            const int d = 32 * db + 8 * g4 + 4 * h;
            float x0 = a2[db][4 * g4], x1 = a2[db][4 * g4 + 1], x2 = a2[db][4 * g4 + 2], x3 = a2[db][4 * g4 + 3];
            if (n >= 127) { x0 = 0.f; x1 = 0.f; x2 = 0.f; x3 = 0.f; }
            uint2 u; u.x = cvtpk(x0, x1); u.y = cvtpk(x2, x3);
            *(uint2*)(dst + d) = u;
            if (kv) { dt[(size_t)d * 128] = (bf16_t)(u.x & 0xffffu); dt[(size_t)(d + 1) * 128] = (bf16_t)(u.x >> 16); dt[(size_t)(d + 2) * 128] = (bf16_t)(u.y & 0xffffu); dt[(size_t)(d + 3) * 128] = (bf16_t)(u.y >> 16); }
        }
    __syncthreads();
}

typedef float f32x4m __attribute__((ext_vector_type(4)));
DEV void ph_norm2_router_fast(const P& p, int l, unsigned char* lds) {
    const V v = make_views(p); const int TIDX = otid(), BIDX = obid();
    const int lane = TIDX & 63, wave = TIDX >> 6;
    const bf16_t* wr = (const bf16_t*)(p.ws + WS_WR) + (size_t)l * 2 * 64 * D;
    float* LG = (float*)(lds + 65536);
    for (int blk = BIDX; blk < T / 16; blk += gridDim.x) {
        const int m0 = blk * 16, b = m0 >> 11;
        const float* md = v.mod + (size_t)(l * 8 + b) * 6144;
        float4 xv[4][4]; float ssq[4];
#pragma unroll
        for (int rr = 0; rr < 4; ++rr)
#pragma unroll
            for (int j = 0; j < 4; ++j) xv[rr][j] = *(const float4*)(v.X + (size_t)(m0 + wave * 4 + rr) * D + 4 * lane + 256 * j);
#pragma unroll
        for (int rr = 0; rr < 4; ++rr) {
            ssq[rr] = 0.f;
#pragma unroll
            for (int j = 0; j < 4; ++j) ssq[rr] += xv[rr][j].x * xv[rr][j].x + xv[rr][j].y * xv[rr][j].y + xv[rr][j].z * xv[rr][j].z + xv[rr][j].w * xv[rr][j].w;
        }
#pragma unroll
        for (int o = 1; o < 64; o <<= 1) {
#pragma unroll
            for (int rr = 0; rr < 4; ++rr) ssq[rr] += __shfl_xor(ssq[rr], o);
        }
#pragma unroll
        for (int rr = 0; rr < 4; ++rr) {
            const int row = wave * 4 + rr, m = m0 + row;
            const float rs = rsqrtf(ssq[rr] * (1.f / D) + EPS);
#pragma unroll
            for (int j = 0; j < 4; ++j) {
                const int c = 4 * lane + 256 * j;
                const float4 g = *(const float4*)(p.norm2_g + l * D + c), sh = *(const float4*)(md + 3 * D + c), sc = *(const float4*)(md + 4 * D + c);
                const float h0 = xv[rr][j].x * rs * g.x * (1.f + sc.x) + sh.x, h1 = xv[rr][j].y * rs * g.y * (1.f + sc.y) + sh.y;
                const float h2 = xv[rr][j].z * rs * g.z * (1.f + sc.z) + sh.z, h3 = xv[rr][j].w * rs * g.w * (1.f + sc.w) + sh.w;
                uint2 hi; hi.x = cvtpk(h0, h1); hi.y = cvtpk(h2, h3);
                uint2 lo;
                lo.x = cvtpk(h0 - __uint_as_float(hi.x << 16), h1 - __uint_as_float(hi.x & 0xffff0000u));
                lo.y = cvtpk(h2 - __uint_as_float(hi.y << 16), h3 - __uint_as_float(hi.y & 0xffff0000u));
                *(uint2*)(v.H + (size_t)m * D + c) = hi;
                const int off = row * 2048 + ((((c >> 3) ^ row) & 127) << 4) + (c & 7) * 2;
                *(uint2*)(lds + off) = hi; *(uint2*)(lds + 32768 + off) = lo;
            }
        }
        __syncthreads();
        {
            const int r16 = lane & 15, kq = lane >> 4;
            f32x4m acc = {0.f, 0.f, 0.f, 0.f};
            const bf16_t* wh = wr + (size_t)(16 * wave + r16) * D + 8 * kq;
#pragma unroll 8
            for (int s = 0; s < 32; ++s) {
                const int off = r16 * 2048 + ((((4 * s + kq) ^ r16) & 127) << 4);
                const bf16x8 ah = *(const bf16x8*)(lds + off), al = *(const bf16x8*)(lds + 32768 + off);
                const bf16x8 bh = *(const bf16x8*)(wh + 32 * s), bl = *(const bf16x8*)(wh + 64 * D + 32 * s);
                acc = __builtin_amdgcn_mfma_f32_16x16x32_bf16(ah, bh, acc, 0, 0, 0);
                acc = __builtin_amdgcn_mfma_f32_16x16x32_bf16(al, bh, acc, 0, 0, 0);
                acc = __builtin_amdgcn_mfma_f32_16x16x32_bf16(ah, bl, acc, 0, 0, 0);
            }
#pragma unroll
            for (int q = 0; q < 4; ++q) LG[(4 * kq + q) * 64 + 16 * wave + r16] = acc[q];
        }
        __syncthreads();
        if (TIDX < 16) {
            const int m = m0 + TIDX;
            const float* lgp = LG + TIDX * 64;
            float lg[4], le[32];
#pragma unroll
            for (int i = 0; i < 4; ++i) lg[i] = lgp[i] + p.rg_b[l * 4 + i];
#pragma unroll
            for (int i = 0; i < 32; ++i) le[i] = lgp[4 + i] + p.re_b[l * 32 + i];
            int gi = 0; float gm = lg[0];
#pragma unroll
            for (int i = 1; i < 4; ++i) if (lg[i] > gm) { gm = lg[i]; gi = i; }
            float gs = 0.f;
#pragma unroll
            for (int i = 0; i < 4; ++i) gs += expf(lg[i] - gm);
            const float pg = 1.f / gs;
            float el[8];
#pragma unroll
            for (int i = 0; i < 8; ++i) el[i] = gi == 0 ? le[i] : (gi == 1 ? le[8 + i] : (gi == 2 ? le[16 + i] : le[24 + i]));
            int e1 = 0; float m1 = el[0];
#pragma unroll
            for (int i = 1; i < 8; ++i) if (el[i] > m1) { m1 = el[i]; e1 = i; }
            int e2 = -1; float m2 = -3.0e38f;
#pragma unroll
            for (int i = 0; i < 8; ++i) if (i != e1 && el[i] > m2) { m2 = el[i]; e2 = i; }
            const float p2 = expf(m2 - m1);
            const float w1 = pg / (1.f + p2), w2 = pg * p2 / (1.f + p2);
            const int ea = gi * 8 + e1, eb = gi * 8 + e2;
            const unsigned pa = atomicAdd(v.ctl + CW_CNT + l * 32 + ea, 1u);
            const unsigned pb = atomicAdd(v.ctl + CW_CNT + l * 32 + eb, 1u);
            v.list[(size_t)ea * T + pa] = 2 * m;
            v.list[(size_t)eb * T + pb] = 2 * m + 1;
            v.wts[2 * m] = w1; v.wts[2 * m + 1] = w2;
        }
        __syncthreads();
    }
}

constexpr int CW_MQ = 8192 + 512;
DEV void ph_mix(const P& p, int l, unsigned char* lds, volatile LAS unsigned* qslot, int rep) {
    const int TIDX = otid(), BIDX = obid();
    unsigned* ctl = (unsigned*)(p.ws + WS_CTL) + CW_MQ + l * 256;
    unsigned acq = 0u;
    for (int hop = 0; hop < 8; ++hop) {
        const int b = (BIDX + hop) & 7;
        unsigned* qc = ctl + b * 16;
        unsigned* done = ctl + 128 + b * 16;
        for (;;) {
            __syncthreads();
            if (TIDX == 0) *qslot = atomicAdd(qc, 1u);
            __syncthreads();
            const int v = (int)*qslot;
            if (v >= 260) break;
            if (v < 4) {
                cmp_unit(p, l, b * 4 + v, lds);
                asm volatile("s_waitcnt vmcnt(0)" ::: "memory");
                __syncthreads();
                if (TIDX == 0) {
                    __builtin_amdgcn_fence(__ATOMIC_RELEASE, "agent");
                    asm volatile("s_waitcnt vmcnt(0)" ::: "memory");
                    __hip_atomic_fetch_add(done, 1u, __ATOMIC_RELAXED, __HIP_MEMORY_SCOPE_AGENT);
                }
                continue;
            }
            int slot = -1, nsa = -1;
            if (v < 68) slot = v - 4;
            else { const int w2 = v - 68, k = w2 % 3, i = w2 / 3; if (k < 2) nsa = 2 * i + k; else slot = 64 + i; }
            if (slot >= 0) {
                const int idx = slot >> 1, u = ((idx >> 2) << 5) | (b * 4 + (idx & 3));
                if (slot & 1) mha_unit<3>(p, l, u, lds); else mha_unit<2>(p, l, u, lds);
            } else {
                if (!((acq >> b) & 1u)) {
                    if (TIDX == 0) {
                        unsigned sp = 0;
                        while (__hip_atomic_load(done, __ATOMIC_RELAXED, __HIP_MEMORY_SCOPE_AGENT) < 4u) { __builtin_amdgcn_s_sleep(2); if (++sp > (1u << 22)) break; }
                        __builtin_amdgcn_fence(__ATOMIC_ACQUIRE, "agent");
                        asm volatile("s_waitcnt vmcnt(0)" ::: "memory");
                    }
                    __syncthreads();
                    acq |= 1u << b;
                }
                nsa_unit(p, l, ((nsa >> 1) << 4) | (b * 2 + (nsa & 1)), lds);
            }
        }
    }
}

#ifndef REP_PHASE
#define REP_PHASE 0
#endif
#ifndef REF_HEADS
#define REF_HEADS 0x0000u
#endif
__global__ void __launch_bounds__(256, 2) fwd_kernel(P p) {
    __shared__ __attribute__((aligned(16))) float lds[17408];
    __shared__ __attribute__((aligned(16))) unsigned lds_ctl[4];
    if (threadIdx.x < 4) lds_ctl[threadIdx.x] = 0u;
    __syncthreads();
    const XcdBarrier xb = xcd_barrier_post((unsigned*)(p.ws + WS_CTL), (volatile LAS unsigned*)lds_ctl);
#define GRID_BAR() do { xcd_barrier(xb); if (REP_PHASE == 7) xcd_barrier(xb); } while (0)
    volatile LAS unsigned* qslot = (volatile LAS unsigned*)(lds_ctl + 2);
    for (int rep = 0; rep < (REP_PHASE == 1 ? 2 : 1); ++rep) {
        ph_prologue(p, lds);
        ph_convert(p, lds);
        GRID_BAR();
    }
    for (int l = 0; l < DEPTH; ++l) {
        ph_convert_dense(p, l, 0);
        ph_norm1(p, l, l == 0 ? 0 : 1);
        GRID_BAR();
        for (int rep = 0; rep < (REP_PHASE == 2 ? 2 : 1); ++rep) {
            if (rep == 0) ph_convert_dense(p, l, 1);
            ph_inproj_fast(p, l, (unsigned char*)lds);
            GRID_BAR();
        }
        for (int rep = 0; rep < (REP_PHASE == 3 ? 2 : 1); ++rep) {
            ph_mix(p, l, (unsigned char*)lds, qslot, rep);
            GRID_BAR();
        }
        ph_outproj_fast(p, l, (unsigned char*)lds);
        GRID_BAR();
        if (blockIdx.x & 8) { ph_convert_experts(p, l); ph_norm2_router_fast(p, l, (unsigned char*)lds); }
        else { ph_norm2_router_fast(p, l, (unsigned char*)lds); ph_convert_experts(p, l); }
        GRID_BAR();
        for (int rep = 0; rep < (REP_PHASE == 5 ? 2 : 1); ++rep) {
            ph_moe_up_fast(p, l, (unsigned char*)lds);
            GRID_BAR();
        }
        for (int rep = 0; rep < (REP_PHASE == 6 ? 2 : 1); ++rep) {
            ph_moe_down_fast(p, l, (unsigned char*)lds);
            GRID_BAR();
        }
    }
    ph_norm1(p, DEPTH, 2);
}

extern "C" void kernel_launch(void* const* d_in, const int* in_sizes, int n_in,
                              void* d_out, int out_size, void* d_ws, size_t ws_size,
                              hipStream_t stream) {
    static int grid_blocks = 0;
    if (!grid_blocks) {
        int dev = 0, cus = 0, per_cu = 0;
        (void)hipGetDevice(&dev);
        (void)hipDeviceGetAttribute(&cus, hipDeviceAttributeMultiprocessorCount, dev);
        (void)hipOccupancyMaxActiveBlocksPerMultiprocessor(&per_cu, fwd_kernel, 256, 0);
        if (per_cu > 2) per_cu = 2;
        if (per_cu < 1) per_cu = 1;
        grid_blocks = cus * per_cu;
        if (n_in != 24 || ws_size < WS_END || out_size != T * D) { fprintf(stderr, "kernel_launch: unexpected shapes (n_in %d ws %zu out %d)\n", n_in, ws_size, out_size); grid_blocks = -1; }
    }
    if (grid_blocks < 0) return;
    (void)hipMemsetAsync(d_ws, 0, CTL_BYTES, stream);
    P p{};
    const float** pp = (const float**)&p;
    for (int i = 0; i < 24; ++i) pp[i] = (const float*)d_in[i];
    p.out = (float*)d_out; p.ws = (unsigned char*)d_ws;
    void* args[] = {&p};
    hipError_t e = hipLaunchCooperativeKernel((void*)fwd_kernel, dim3(grid_blocks), dim3(256), args, 0, stream);
    if (e != hipSuccess) fprintf(stderr, "cooperative launch failed: %s (grid %d)\n", hipGetErrorString(e), grid_blocks);
}
```

```cpp
#include <hip/hip_runtime.h>
#include <hip/hip_cooperative_groups.h>
#include <cstdio>
#include <cstdint>

#define LAS __attribute__((address_space(3)))
#define DEV __device__ __forceinline__

constexpr int T = 16384, S = 2048, NB = 8, D = 1024, DIN = 2844, NP = 2880, DEPTH = 4;
constexpr int NCMP = 127;
constexpr float EPS = 1e-6f;
constexpr float SCALE = 0.125f;
constexpr int C_QA = 0, C_KC = 512, C_VC = 640, C_KS = 768, C_VS = 896, C_KW = 1024, C_VW = 1152;
constexpr int C_QB = 1280, C_KB = 1536, C_VB = 1792, C_QC = 2048, C_KCC = 2304, C_VCC = 2560;

constexpr size_t MiB = 1u << 20;
constexpr size_t WS_CTL = 0, CTL_BYTES = 64 * 1024;
constexpr size_t WS_MOD = 1 * MiB, WS_ROPE = 2 * MiB, WS_CUMF = 3 * MiB, WS_CK = 4 * MiB, WS_CV = 5 * MiB, WS_IMP = 6 * MiB;
constexpr size_t WS_SEL = 10 * MiB, WS_EID = 11 * MiB, WS_WTS = 12 * MiB, WS_LIST = 13 * MiB, WS_GF = 16 * MiB;
constexpr size_t WS_H = 32 * MiB, WS_U = 64 * MiB, WS_O = 160 * MiB, WS_HID = 192 * MiB, WS_Y = 224 * MiB, WS_OB = 352 * MiB, WS_ORAW = 448 * MiB;
constexpr size_t WS_END = 973 * MiB;
constexpr size_t WS_VT = 936 * MiB;
constexpr size_t WS_CVT = 962 * MiB;
constexpr size_t WS_CUMF2 = 963 * MiB;
constexpr int CW_Q = 8192 + 256;
constexpr size_t WS_CW1 = 964 * MiB;
constexpr size_t WS_CW2 = 968 * MiB;
constexpr size_t WS_CPB = 969 * MiB;
constexpr size_t WS_LSF = 970 * MiB;
constexpr size_t WS_WR = 971 * MiB;
constexpr int CW_CNT = 8192;

typedef unsigned short bf16_t;
typedef float f32x4v __attribute__((ext_vector_type(4)));
DEV int vt_row(int n) { return n < 1024 ? n - 896 : (n < 1280 ? 128 + n - 1152 : (n < 2048 ? 256 + n - 1792 : 512 + n - 2560)); }
DEV bool is_vcol(int n) { return (n >= C_VS && n < C_KW) || (n >= C_VW && n < C_QB) || (n >= C_VB && n < C_QC) || (n >= C_VCC && n < 2816); }
DEV float bf2f(bf16_t v) { return __uint_as_float((unsigned)v << 16); }
DEV bf16_t f2bf(float f) { unsigned u = __float_as_uint(f); return (bf16_t)((u + 0x7fffu + ((u >> 16) & 1u)) >> 16); }
DEV float4 ld_bf4(const bf16_t* p) { const ushort4 u = *(const ushort4*)p; return make_float4(bf2f(u.x), bf2f(u.y), bf2f(u.z), bf2f(u.w)); }
typedef float f32x2_t __attribute__((ext_vector_type(2)));
typedef __bf16 bf16x2_t __attribute__((ext_vector_type(2)));
DEV unsigned cvtpk(float lo, float hi) { f32x2_t v = {lo, hi}; bf16x2_t b = __builtin_convertvector(v, bf16x2_t); return __builtin_bit_cast(unsigned, b); }
DEV float sigmoidf_(float x) { return 1.f / (1.f + expf(-x)); }
DEV float logsigmoidf_(float x) { return fminf(x, 0.f) - log1pf(expf(-fabsf(x))); }
DEV float wave_sum(float v) {
#pragma unroll
    for (int o = 1; o < 64; o <<= 1) v += __shfl_xor(v, o);
    return v;
}

#define XB_TMO      128
#define XB_XCNT(j)  (256  + 64 * (j))
#define XB_XSUB(j)  (1280 + 64 * (j))
#define XB_XGEN(j)  (2304 + 64 * (j))
#define XB_TOP      3328
#define XB_TOPGEN   3392
#define XCD_BAR_WORDS 3456
#define XB_SPIN_CAP (1u << 23)
DEV unsigned xb_ld(unsigned* p)              { return __hip_atomic_load(p, __ATOMIC_RELAXED, __HIP_MEMORY_SCOPE_AGENT); }
DEV unsigned xb_add(unsigned* p, unsigned v) { return __hip_atomic_fetch_add(p, v, __ATOMIC_RELAXED, __HIP_MEMORY_SCOPE_AGENT); }
DEV unsigned xb_xcc_id() { return (unsigned)__builtin_amdgcn_s_getreg((3 << 11) | 20) & 0xFu; }
#define XB_SPIN(cond, bar) do { unsigned _sp = 0; while (cond) { __builtin_amdgcn_s_sleep(1); \
    if ((++_sp & 255u) == 0u) { if (xb_ld(&(bar)[XB_TMO])) break; if (_sp > XB_SPIN_CAP) { atomicAdd(&(bar)[XB_TMO], 1u); break; } } } } while (0)
struct XcdBarrier { unsigned* bar; unsigned x; volatile LAS unsigned* st; };
DEV XcdBarrier xcd_barrier_post(unsigned* bar, volatile LAS unsigned* st) {
    XcdBarrier b; b.bar = bar; b.x = xb_xcc_id(); b.st = st;
    if (threadIdx.x == 0) (void)xb_add(&bar[XB_XCNT(b.x)], 1u);
    return b;
}
DEV void xcd_barrier_complete(unsigned* bar, unsigned x, unsigned& nloc, unsigned& nx) {
    const unsigned G = gridDim.x * gridDim.y * gridDim.z;
    unsigned sum, cnt, mine, sp = 0u;
    for (;;) {
        sum = 0u; cnt = 0u; mine = 0u;
#pragma unroll
        for (unsigned j = 0; j < 16; ++j) { const unsigned c = xb_ld(&bar[XB_XCNT(j)]); sum += c; cnt += (c > 0u) ? 1u : 0u; mine = (j == x) ? c : mine; }
        if (sum == G) break;
        __builtin_amdgcn_s_sleep(1);
        if ((++sp & 255u) == 0u) { if (xb_ld(&bar[XB_TMO])) break; if (sp > XB_SPIN_CAP) { atomicAdd(&bar[XB_TMO], 1u); break; } }
    }
    nloc = mine > 0u ? mine : 1u; nx = cnt > 0u ? cnt : 1u;
}
DEV void xcd_barrier(const XcdBarrier& b) {
    asm volatile("s_waitcnt vmcnt(0)" ::: "memory");
    __syncthreads();
    if (threadIdx.x == 0) {
        unsigned* bar = b.bar;
        __builtin_amdgcn_s_waitcnt(0);
        unsigned nloc = b.st[0], nx = b.st[1];
        if (nloc == 0u) { xcd_barrier_complete(bar, b.x, nloc, nx); b.st[0] = nloc; b.st[1] = nx; }
        const unsigned old = xb_add(&bar[XB_XSUB(b.x)], 1u);
        const unsigned gen = old / nloc;
        if (old + 1u == (gen + 1u) * nloc) {
            __builtin_amdgcn_fence(__ATOMIC_RELEASE, "agent");
            asm volatile("s_waitcnt vmcnt(0)" ::: "memory");
            const unsigned og = xb_add(&bar[XB_TOP], 1u);
            const unsigned tg = og / nx;
            if (og + 1u == (tg + 1u) * nx) xb_add(&bar[XB_TOPGEN], 1u);
            else XB_SPIN(xb_ld(&bar[XB_TOPGEN]) == tg, bar);
            __builtin_amdgcn_fence(__ATOMIC_ACQUIRE, "agent");
            xb_add(&bar[XB_XGEN(b.x)], 1u);
            asm volatile("s_waitcnt vmcnt(0)" ::: "memory");
        } else {
            XB_SPIN(xb_ld(&bar[XB_XGEN(b.x)]) == gen, bar);
            __builtin_amdgcn_fence(__ATOMIC_ACQUIRE, "agent");
            asm volatile("s_waitcnt vmcnt(0)" ::: "memory");
        }
    }
    __syncthreads();
}

struct P {
    const float *x, *c, *norm1_g, *norm2_g, *ada_w, *ada_b, *w_in, *b_forget, *cmp_pos_k, *cmp_w1_k, *cmp_w2_k,
        *cmp_pos_v, *cmp_w1_v, *cmp_w2_v, *out_norm_g, *w_out, *rg_w, *rg_b, *re_w, *re_b, *e_w1, *e_w3, *e_w2, *final_g;
    float* out; unsigned char* ws;
};
struct V {
    unsigned* ctl; float* mod; float* rcos; float* rsin; float* cumf; bf16_t* ck; bf16_t* cv; float* imp; unsigned* sel;
    int* eid; float* wts; int* list; float* gf; bf16_t* H; bf16_t* U; bf16_t* O; bf16_t* HID; bf16_t* Y; float* OB; float* ORAW; float* X;
};
DEV int otid() { int t = threadIdx.x; asm volatile("" : "+v"(t)); return t; }
DEV int obid() { int t = blockIdx.x; asm volatile("" : "+s"(t)); return t; }
DEV V make_views(const P& p) {
    V v; size_t woff = 0; asm volatile("" : "+s"(woff)); unsigned char* w = p.ws + woff;
    v.ctl = (unsigned*)(w + WS_CTL); v.mod = (float*)(w + WS_MOD); v.rcos = (float*)(w + WS_ROPE); v.rsin = v.rcos + S * 8;
    v.cumf = (float*)(w + WS_CUMF); v.ck = (bf16_t*)(w + WS_CK); v.cv = (bf16_t*)(w + WS_CV); v.imp = (float*)(w + WS_IMP);
    v.sel = (unsigned*)(w + WS_SEL); v.eid = (int*)(w + WS_EID); v.wts = (float*)(w + WS_WTS); v.list = (int*)(w + WS_LIST);
    v.gf = (float*)(w + WS_GF); v.H = (bf16_t*)(w + WS_H); v.U = (bf16_t*)(w + WS_U); v.O = (bf16_t*)(w + WS_O);
    v.HID = (bf16_t*)(w + WS_HID); v.Y = (bf16_t*)(w + WS_Y); v.OB = (float*)(w + WS_OB); v.ORAW = (float*)(w + WS_ORAW); v.X = p.out;
    return v;
}

DEV void ph_prologue(const P& p, float* lds) {
    const V v = make_views(p); const int TIDX = otid(), BIDX = obid();
    const int tid = TIDX;
    for (int i = tid; i < NB * D; i += 256) { const float c = p.c[i]; lds[i] = c / (1.f + expf(-c)); }
    __syncthreads();
    float* red = lds + NB * D;
    const int c4 = tid & 15, ks = tid >> 4;
    for (int unit = BIDX; unit < DEPTH * 96; unit += gridDim.x) {
        const int l = unit / 96, n0 = (unit % 96) * 64;
        const float* W = p.ada_w + (size_t)l * D * 6144 + n0 + 4 * c4;
        float acc[8][4];
#pragma unroll
        for (int b = 0; b < 8; ++b)
#pragma unroll
            for (int q = 0; q < 4; ++q) acc[b][q] = 0.f;
#pragma unroll 1
        for (int i0 = 0; i0 < 64; i0 += 8) {
            f32x4v w[8];
#pragma unroll
            for (int i = 0; i < 8; ++i) w[i] = __builtin_nontemporal_load((const f32x4v*)(W + (size_t)(ks + 16 * (i0 + i)) * 6144));
#pragma unroll
            for (int i = 0; i < 8; ++i) {
                const int k = ks + 16 * (i0 + i);
#pragma unroll
                for (int b = 0; b < 8; ++b) {
                    const float cv = lds[b * D + k];
                    acc[b][0] += cv * w[i].x; acc[b][1] += cv * w[i].y; acc[b][2] += cv * w[i].z; acc[b][3] += cv * w[i].w;
                }
            }
        }
#pragma unroll
        for (int b = 0; b < 8; ++b) *(float4*)(red + (ks * 8 + b) * 64 + 4 * c4) = make_float4(acc[b][0], acc[b][1], acc[b][2], acc[b][3]);
        __syncthreads();
        for (int o = tid; o < 512; o += 256) {
            const int c2 = o & 63, b = o >> 6;
            float sm = p.ada_b[l * 6144 + n0 + c2];
#pragma unroll
            for (int q = 0; q < 16; ++q) sm += red[(q * 8 + b) * 64 + c2];
            v.mod[(size_t)(l * 8 + b) * 6144 + n0 + c2] = sm;
        }
        __syncthreads();
    }
    const float cst = -2.0f * 13.122363377404328f / 16.0f;
    for (int i = BIDX * 256 + tid; i < S * 8; i += gridDim.x * 256) {
        const int s = i >> 3, j = i & 7;
        const float inv = expf((float)j * cst);
        const float ang = (float)s * inv;
        v.rcos[i] = cosf(ang); v.rsin[i] = sinf(ang);
    }
}

DEV void ph_norm1(const P& p, int l, int mode) {
    const V v = make_views(p); const int TIDX = otid(), BIDX = obid();
    const int lane = TIDX & 63;
    const int gw = (BIDX * 256 + TIDX) >> 6, nw = gridDim.x * 4;
    for (int m0 = gw; m0 < T; m0 += 2 * nw) {
        float4 xv[2][4];
        if (mode == 0) {
#pragma unroll
            for (int rr = 0; rr < 2; ++rr)
#pragma unroll
                for (int j = 0; j < 4; ++j) xv[rr][j] = *(const float4*)(p.x + (size_t)(m0 + rr * nw) * D + 4 * lane + 256 * j);
        } else {
            float4 xa[2][4]; ushort4 ya[2][4], yb[2][4];
#pragma unroll
            for (int rr = 0; rr < 2; ++rr)
#pragma unroll
                for (int j = 0; j < 4; ++j) {
                    const int m = m0 + rr * nw, c = 4 * lane + 256 * j;
                    xa[rr][j] = *(const float4*)(v.X + (size_t)m * D + c);
                    ya[rr][j] = *(const ushort4*)(v.Y + (size_t)(2 * m) * D + c); yb[rr][j] = *(const ushort4*)(v.Y + (size_t)(2 * m + 1) * D + c);
                }
#pragma unroll
            for (int rr = 0; rr < 2; ++rr) {
                const float* g2 = v.mod + (size_t)((l - 1) * 8 + ((m0 + rr * nw) >> 11)) * 6144 + 5 * D;
#pragma unroll
                for (int j = 0; j < 4; ++j) {
                    const float4 g = *(const float4*)(g2 + 4 * lane + 256 * j);
                    float4 a = xa[rr][j];
                    a.x += g.x * (bf2f(ya[rr][j].x) + bf2f(yb[rr][j].x)); a.y += g.y * (bf2f(ya[rr][j].y) + bf2f(yb[rr][j].y));
                    a.z += g.z * (bf2f(ya[rr][j].z) + bf2f(yb[rr][j].z)); a.w += g.w * (bf2f(ya[rr][j].w) + bf2f(yb[rr][j].w));
                    xv[rr][j] = a;
                }
            }
        }
        float ss[2];
#pragma unroll
        for (int rr = 0; rr < 2; ++rr) {
            ss[rr] = 0.f;
#pragma unroll
            for (int j = 0; j < 4; ++j) ss[rr] += xv[rr][j].x * xv[rr][j].x + xv[rr][j].y * xv[rr][j].y + xv[rr][j].z * xv[rr][j].z + xv[rr][j].w * xv[rr][j].w;
        }
#pragma unroll
        for (int o = 1; o < 64; o <<= 1) { ss[0] += __shfl_xor(ss[0], o); ss[1] += __shfl_xor(ss[1], o); }
#pragma unroll
        for (int rr = 0; rr < 2; ++rr) {
            const int m = m0 + rr * nw, b = m >> 11;
            const float r = rsqrtf(ss[rr] * (1.f / D) + EPS);
            if (mode == 2) {
#pragma unroll
                for (int j = 0; j < 4; ++j) {
                    const int c = 4 * lane + 256 * j;
                    const float4 g = *(const float4*)(p.final_g + c);
                    float4 o; o.x = xv[rr][j].x * r * g.x; o.y = xv[rr][j].y * r * g.y; o.z = xv[rr][j].z * r * g.z; o.w = xv[rr][j].w * r * g.w;
                    *(float4*)(v.X + (size_t)m * D + c) = o;
                }
            } else {
                const float* md = v.mod + (size_t)(l * 8 + b) * 6144;
#pragma unroll
                for (int j = 0; j < 4; ++j) {
                    const int c = 4 * lane + 256 * j;
                    *(float4*)(v.X + (size_t)m * D + c) = xv[rr][j];
                    const float4 g = *(const float4*)(p.norm1_g + l * D + c), sh = *(const float4*)(md + c), sc = *(const float4*)(md + D + c);
                    uint2 o;
                    o.x = cvtpk(xv[rr][j].x * r * g.x * (1.f + sc.x) + sh.x, xv[rr][j].y * r * g.y * (1.f + sc.y) + sh.y);
                    o.y = cvtpk(xv[rr][j].z * r * g.z * (1.f + sc.z) + sh.z, xv[rr][j].w * r * g.w * (1.f + sc.w) + sh.w);
                    *(uint2*)(v.H + (size_t)m * D + c) = o;
                }
            }
        }
    }
}

typedef short bf16x8 __attribute__((ext_vector_type(8)));
typedef float f32x16 __attribute__((ext_vector_type(16)));
typedef unsigned u32x4 __attribute__((ext_vector_type(4)));
constexpr size_t WS_WIN = 512 * MiB, WS_WOT = 544 * MiB, WS_W13 = 552 * MiB, WS_W2 = 808 * MiB;
constexpr int NPW = 2944;
DEV int tile_off(int row, int chunk) { return row * 128 + ((chunk ^ ((row >> 1) & 7)) << 4); }
template <class RM>
DEV void conv_patch(const float* src, int N, int K, bf16_t* dst, int k0, int n0, RM rowmap, int lane) {
    const int kg = lane >> 3, n = n0 + 4 * (lane & 7);
    if (n >= N) return;
    const float* sp = src + (size_t)(k0 + 8 * kg) * N + n;
    f32x4v x[8];
#pragma unroll
    for (int j = 0; j < 8; ++j) x[j] = __builtin_nontemporal_load((const f32x4v*)(sp + (size_t)j * N));
    bf16_t* dp = dst + k0 + 8 * kg;
    u32x4 o;
    o.x = cvtpk(x[0].x, x[1].x); o.y = cvtpk(x[2].x, x[3].x); o.z = cvtpk(x[4].x, x[5].x); o.w = cvtpk(x[6].x, x[7].x);
    *(u32x4*)(dp + (size_t)rowmap(n) * K) = o;
    o.x = cvtpk(x[0].y, x[1].y); o.y = cvtpk(x[2].y, x[3].y); o.z = cvtpk(x[4].y, x[5].y); o.w = cvtpk(x[6].y, x[7].y);
    *(u32x4*)(dp + (size_t)rowmap(n + 1) * K) = o;
    o.x = cvtpk(x[0].z, x[1].z); o.y = cvtpk(x[2].z, x[3].z); o.z = cvtpk(x[4].z, x[5].z); o.w = cvtpk(x[6].z, x[7].z);
    *(u32x4*)(dp + (size_t)rowmap(n + 2) * K) = o;
    o.x = cvtpk(x[0].w, x[1].w); o.y = cvtpk(x[2].w, x[3].w); o.z = cvtpk(x[4].w, x[5].w); o.w = cvtpk(x[6].w, x[7].w);
    *(u32x4*)(dp + (size_t)rowmap(n + 3) * K) = o;
}

DEV void conv8(const float* s0, const float* s1, bf16_t* dst) {
    f32x4v a = {0.f, 0.f, 0.f, 0.f}, b = {0.f, 0.f, 0.f, 0.f};
    if (s0) a = __builtin_nontemporal_load((const f32x4v*)s0);
    if (s1) b = __builtin_nontemporal_load((const f32x4v*)s1);
    u32x4 o; o.x = cvtpk(a[0], a[1]); o.y = cvtpk(a[2], a[3]); o.z = cvtpk(b[0], b[1]); o.w = cvtpk(b[2], b[3]);
    *(u32x4*)dst = o;
}
DEV void ph_convert_dense(const P& p, int l, int which) {
    const int TIDX = otid(), BIDX = obid();
    size_t woff = 0; asm volatile("" : "+s"(woff)); unsigned char* w = p.ws + woff;
    const size_t gtid = (size_t)BIDX * 256 + TIDX, gsz = (size_t)gridDim.x * 256;
    if (which == 0) {
        bf16_t* win = (bf16_t*)(w + WS_WIN);
        for (size_t i = gtid; i < (size_t)D * 368; i += gsz) {
            const int g8 = (int)(i % 368); const size_t lk = (size_t)l * D + i / 368;
            const int n = g8 * 8;
            const float* row = p.w_in + lk * DIN;
            const float *s0, *s1;
            if (n < 2816) { const int oc = n + (n >= 2048 ? 28 : (n >= 1280 ? 24 : 0)); s0 = row + oc; s1 = row + oc + 4; }
            else if (n < 2840) { s0 = row + 1280 + (n - 2816); s1 = s0 + 4; }
            else if (n == 2840) { s0 = row + 2072; s1 = nullptr; }
            else { s0 = nullptr; s1 = nullptr; }
            conv8(s0, s1, win + lk * NPW + n);
        }
    } else {
        bf16_t* wot = (bf16_t*)(w + WS_WOT);
        const size_t oo = (size_t)l * D * D;
        for (size_t i = gtid; i < (size_t)D * D / 8; i += gsz) conv8(p.w_out + oo + i * 8, p.w_out + oo + i * 8 + 4, wot + oo + i * 8);
        for (size_t i = gtid; i < (size_t)2 * 2048 * 128 / 8; i += gsz) {
            const size_t per = (size_t)2048 * 128 / 8; const int kv = (int)(i / per), lk = l * 2 + kv; const size_t off = (i % per) * 8;
            const float* src = (kv ? p.cmp_w1_v : p.cmp_w1_k) + (size_t)l * 2048 * 128 + off;
            conv8(src, src + 4, (bf16_t*)(w + WS_CW1) + (size_t)lk * 2048 * 128 + off);
        }
    }
}
DEV void ph_convert_experts(const P& p, int l) {
    const int TIDX = otid(), BIDX = obid();
    size_t woff = 0; asm volatile("" : "+s"(woff)); unsigned char* w = p.ws + woff;
    bf16_t* w13 = (bf16_t*)(w + WS_W13); bf16_t* w2t = (bf16_t*)(w + WS_W2);
    const size_t gtid = (size_t)BIDX * 256 + TIDX, gsz = (size_t)gridDim.x * 256;
    for (size_t i = gtid; i < (size_t)32 * D * 128; i += gsz) {
        const int g8 = (int)(i & 127); const size_t lek = (size_t)l * 32 * D + (i >> 7);
        const int n = g8 * 8, which = (n >> 5) & 1, c = 32 * (n >> 6) + (n & 31);
        const float* src = (which ? p.e_w3 : p.e_w1) + lek * 512 + c;
        conv8(src, src + 4, w13 + lek * 1024 + n);
    }
    const size_t o2 = (size_t)l * 32 * 512 * D;
    for (size_t i = gtid; i < (size_t)32 * 512 * D / 8; i += gsz) conv8(p.e_w2 + o2 + i * 8, p.e_w2 + o2 + i * 8 + 4, w2t + o2 + i * 8);
}
DEV void ph_convert(const P& p, float* lds) {
    const int TIDX = otid(), BIDX = obid();
    size_t woff = 0; asm volatile("" : "+s"(woff)); unsigned char* w = p.ws + woff;
    const int lane = TIDX & 63;
    for (int unit = BIDX * 4 + (TIDX >> 6); unit < DEPTH * 2 * 4; unit += gridDim.x * 4) {
        const int lk = unit >> 2, t = unit & 3, l = lk >> 1, kv = lk & 1;
        conv_patch((kv ? p.cmp_w2_v : p.cmp_w2_k) + (size_t)l * 128 * 64, 64, 128, (bf16_t*)(w + WS_CW2) + (size_t)lk * 64 * 128, (t >> 1) * 64, (t & 1) * 32, [](int n) { return n; }, lane);
    }
    for (int o = BIDX * 256 + TIDX; o < DEPTH * 64 * D; o += gridDim.x * 256) {
        const int k = o & (D - 1), n = (o >> 10) & 63, l = o >> 16;
        const float val = n < 4 ? p.rg_w[((size_t)l * D + k) * 4 + n] : (n < 36 ? p.re_w[((size_t)l * D + k) * 32 + n - 4] : 0.f);
        const bf16_t hi = f2bf(val); const bf16_t lo = f2bf(val - bf2f(hi));
        bf16_t* wr = (bf16_t*)(w + WS_WR) + (size_t)l * 2 * 64 * D;
        wr[n * D + k] = hi; wr[64 * D + n * D + k] = lo;
    }
    for (int unit = BIDX; unit < DEPTH * 2 * 8; unit += gridDim.x) {
        const int lk = unit >> 3, ch = unit & 7, l = lk >> 1, kv = lk & 1, j = TIDX & 127, hf = TIDX >> 7;
        const float* pe = (kv ? p.cmp_pos_v : p.cmp_pos_k) + (size_t)l * 2048 + ch * 256 + hf * 128;
        const float* w1 = (kv ? p.cmp_w1_v : p.cmp_w1_k) + (size_t)l * 2048 * 128 + (size_t)(ch * 256 + hf * 128) * 128 + j;
        float a0 = 0.f, a1 = 0.f, a2 = 0.f, a3 = 0.f;
#pragma unroll 4
        for (int k = 0; k < 128; k += 4) {
            a0 += pe[k] * w1[(size_t)k * 128]; a1 += pe[k + 1] * w1[(size_t)(k + 1) * 128];
            a2 += pe[k + 2] * w1[(size_t)(k + 2) * 128]; a3 += pe[k + 3] * w1[(size_t)(k + 3) * 128];
        }
        const float a = (a0 + a1) + (a2 + a3);
        __syncthreads();
        if (hf) lds[j] = a;
        __syncthreads();
        if (!hf) ((float*)(w + WS_CPB))[(lk * 8 + ch) * 128 + j] = a + lds[j];
    }
}

typedef short v4i16_t __attribute__((ext_vector_type(4)));
DEV void gemm_issue0(unsigned char* lds, const bf16_t* const (&arow)[4], const bf16_t* Bsrc, const size_t ldb, const int TIDX) {
    const int lane = TIDX & 63, wave = TIDX >> 6;
    const int gsw = ((TIDX & 7) ^ ((TIDX >> 4) & 7)) * 8;
    const bf16_t* bg = Bsrc + (size_t)(4 * wave + (lane >> 4)) * ldb + ((lane & 15) ^ (((lane >> 4) << 2) | (wave & 3))) * 8;
    LAS unsigned char* l3 = (LAS unsigned char*)lds + __builtin_amdgcn_readfirstlane(wave) * 1024;
#pragma unroll
    for (int i = 0; i < 4; ++i) {
        __builtin_amdgcn_global_load_lds((const unsigned*)(arow[i] + gsw), (LAS unsigned*)(l3 + i * 4096), 16, 0, 0);
        __builtin_amdgcn_global_load_lds((const unsigned*)(bg + (size_t)(16 * i) * ldb), (LAS unsigned*)(l3 + 16384 + i * 4096), 16, 0, 0);
    }
}
template <bool SWAP, bool PRE = false>
DEV void gemm128(unsigned char* lds, const bf16_t* const (&arow)[4], const bf16_t* Bsrc, const size_t ldb, int K, f32x16 (&acc)[2][2], const int TIDX, const int astride = 64) {
    const int lane = TIDX & 63, wave = TIDX >> 6, wm = wave >> 1, wn = wave & 1, r = lane & 31, h = lane >> 5;
#pragma unroll
    for (int j = 0; j < 2; ++j)
#pragma unroll
        for (int i = 0; i < 2; ++i)
#pragma unroll
            for (int q = 0; q < 16; ++q) acc[j][i][q] = 0.f;
    const int gsw = ((TIDX & 7) ^ ((TIDX >> 4) & 7)) * 8;
    const bf16_t* ag[4];
#pragma unroll
    for (int i = 0; i < 4; ++i) ag[i] = arow[i] + gsw;
    const int brow = 4 * wave + (lane >> 4), bch = ((lane & 15) ^ (((lane >> 4) << 2) | (wave & 3))) * 8;
    const bf16_t* bg = Bsrc + (size_t)brow * ldb + bch;
    LAS unsigned char* l3 = (LAS unsigned char*)lds + __builtin_amdgcn_readfirstlane(wave) * 1024;
    LAS unsigned char* tb[2][2];
    {
        const int blk = (lane >> 4) & 1, q = (lane & 15) >> 2, pp = lane & 3;
#pragma unroll
        for (int j = 0; j < 2; ++j)
#pragma unroll
            for (int t = 0; t < 2; ++t) {
                const int row = 4 * t + 8 * h + q, ch = 4 * (2 * wn + j) + 2 * blk + (pp >> 1);
                tb[j][t] = (LAS unsigned char*)lds + 16384 + 256 * row + 16 * (ch ^ (((row & 3) << 2) | ((row >> 2) & 3))) + 8 * (pp & 1);
            }
    }
#define G_DMA(st_, kt_) do { _Pragma("unroll") for (int i = 0; i < 4; ++i) { \
        __builtin_amdgcn_global_load_lds((const unsigned*)(ag[i] + (size_t)(kt_) * astride), (LAS unsigned*)(l3 + (st_) + i * 4096), 16, 0, 0); \
        __builtin_amdgcn_global_load_lds((const unsigned*)(bg + ((size_t)(kt_) * 64 + 16 * i) * ldb), (LAS unsigned*)(l3 + (st_) + 16384 + i * 4096), 16, 0, 0); } } while (0)
    const int KT = K >> 6;
    if (!PRE) {
        __syncthreads();
        G_DMA(0, 0);
    }
    for (int kt = 0; kt < KT; ++kt) {
        asm volatile("s_waitcnt vmcnt(0) lgkmcnt(0)" ::: "memory");
        __builtin_amdgcn_s_barrier();
        asm volatile("" ::: "memory");
        if (kt + 1 < KT) G_DMA(((kt + 1) & 1) * 32768, kt + 1);
        const int so = (kt & 1) * 32768;
        const unsigned char* cur = lds + so;
#pragma unroll
        for (int kk = 0; kk < 4; ++kk) {
            bf16x8 af[2], wf[2];
#pragma unroll
            for (int i = 0; i < 2; ++i) af[i] = *(const bf16x8*)(cur + tile_off(64 * wm + 32 * i + r, 2 * kk + h));
#pragma unroll
            for (int j = 0; j < 2; ++j) {
                const v4i16_t lo = __builtin_amdgcn_ds_read_tr16_b64_v4i16((LAS v4i16_t*)(tb[j][0] + so + 4096 * kk));
                const v4i16_t hi = __builtin_amdgcn_ds_read_tr16_b64_v4i16((LAS v4i16_t*)(tb[j][1] + so + 4096 * kk));
                wf[j] = (bf16x8){lo[0], lo[1], lo[2], lo[3], hi[0], hi[1], hi[2], hi[3]};
            }
#pragma unroll
            for (int j = 0; j < 2; ++j)
#pragma unroll
                for (int i = 0; i < 2; ++i) acc[j][i] = SWAP ? __builtin_amdgcn_mfma_f32_32x32x16_bf16(af[i], wf[j], acc[j][i], 0, 0, 0)
                                                             : __builtin_amdgcn_mfma_f32_32x32x16_bf16(wf[j], af[i], acc[j][i], 0, 0, 0);
        }
    }
    __syncthreads();
#undef G_DMA
}

constexpr int CST = 272;
DEV void ctile_put(unsigned char* lds, int row, int col, float a, float b, float c, float d) {
    uint2 u; u.x = cvtpk(a, b); u.y = cvtpk(c, d);
    *(uint2*)(lds + row * CST + col * 2) = u;
}
template <int COLS, class RP>
DEV void ctile_flush(unsigned char* lds, const int TIDX, RP rowptr) {
    asm volatile("s_waitcnt lgkmcnt(0)" ::: "memory");
    __builtin_amdgcn_s_barrier();
    asm volatile("" ::: "memory");
    constexpr int CPR = COLS / 8, RPI = 256 / CPR;
#pragma unroll
    for (int it = 0; it < 128 / RPI; ++it) {
        const int row = it * RPI + TIDX / CPR, c16 = TIDX % CPR;
        bf16_t* dst = rowptr(row, it);
        const u32x4 val = *(const u32x4*)(lds + row * CST + c16 * 16);
        if (dst) *(u32x4*)(dst + c16 * 8) = val;
    }
}

DEV void ph_inproj_fast(const P& p, int l, unsigned char* lds) {
    const V v = make_views(p); const int TIDX = otid(), BIDX = obid();
    const bf16_t* W = (const bf16_t*)(p.ws + WS_WIN) + (size_t)l * D * NPW;
    const int lane = TIDX & 63, wave = TIDX >> 6, wm = wave >> 1, wn = wave & 1, r = lane & 31, h = lane >> 5;
    const bool xo = gridDim.x == 512;
    unsigned char* ct = lds + 32768;
    auto decode = [&](int it, int& mt, int& nt) -> int {
        if (xo) { if (it >= 6) return -1; const int lb = BIDX >> 3; nt = 8 * (it % 3) + (lb >> 3); mt = 16 * (BIDX & 7) + 8 * (it / 3) + (lb & 7); return nt < 23 ? 1 : 0; }
        const int unit = BIDX + it * (int)gridDim.x; if (unit >= 128 * 23) return -1; nt = unit / 128; mt = unit % 128; return 1;
    };
    auto issue = [&](int mt, int nt) {
        const bf16_t* ar[4];
#pragma unroll
        for (int i = 0; i < 4; ++i) ar[i] = v.H + (size_t)(mt * 128 + (TIDX >> 3) + 32 * i) * D;
        gemm_issue0(lds, ar, W + nt * 128, NPW, TIDX);
    };
    bool pre = false;
    for (int it = 0;; ++it) {
        int nt, mt;
        const int dv = decode(it, mt, nt);
        if (dv < 0) break;
        if (dv == 0) continue;
        const int m0 = mt * 128, n0 = nt * 128;
        const bf16_t* arow[4];
#pragma unroll
        for (int i = 0; i < 4; ++i) arow[i] = v.H + (size_t)(m0 + (TIDX >> 3) + 32 * i) * D;
        if (!pre) { __syncthreads(); issue(mt, nt); pre = true; }
        int itn = it + 1, mtn = 0, ntn = 0, dn;
        while ((dn = decode(itn, mtn, ntn)) == 0) ++itn;
        f32x16 acc[2][2];
        if (is_vcol(n0)) {
            gemm128<true, true>(lds, arow, W + n0, NPW, D, acc, TIDX);
            if (dn > 0) issue(mtn, ntn); else pre = false;
#pragma unroll
            for (int j = 0; j < 2; ++j)
#pragma unroll
                for (int i = 0; i < 2; ++i)
#pragma unroll
                    for (int g = 0; g < 4; ++g)
                        ctile_put(ct, 64 * wn + 32 * j + r, 64 * wm + 32 * i + 8 * g + 4 * h, acc[j][i][4 * g], acc[j][i][4 * g + 1], acc[j][i][4 * g + 2], acc[j][i][4 * g + 3]);
            bf16_t* vt = (bf16_t*)(p.ws + WS_VT) + ((size_t)(m0 >> 11) * 768 + vt_row(n0)) * S + (m0 & (S - 1));
            ctile_flush<128>(ct, TIDX, [&](int row, int) { return vt + (size_t)row * S; });
            continue;
        }
        const bool rope_tile = n0 < 512 || n0 == C_KS || n0 == C_KW;
        f32x4v rcs[2], rsn[2];
        if (rope_tile) {
#pragma unroll
            for (int i = 0; i < 2; ++i) {
                const int sp = (m0 + 64 * wm + 32 * i + r) & (S - 1);
                rcs[i] = *(const f32x4v*)(v.rcos + sp * 8 + 4 * h); rsn[i] = *(const f32x4v*)(v.rsin + sp * 8 + 4 * h);
            }
        }
        gemm128<false, true>(lds, arow, W + n0, NPW, D, acc, TIDX);
        if (dn > 0) issue(mtn, ntn); else pre = false;
        if (n0 == 2816) {
            if (wn == 0) {
#pragma unroll
                for (int i = 0; i < 2; ++i) {
                    const int m = m0 + 64 * wm + 32 * i + r;
#pragma unroll
                    for (int q = 0; q < 16; ++q) {
                        const int cc = (q & 3) + 8 * (q >> 2) + 4 * h;
                        if (cc < 24) v.gf[(size_t)m * 32 + cc] = acc[0][i][q];
                        else if (cc < 28) ((float*)(p.ws + WS_LSF))[(size_t)((m >> 11) * 4 + cc - 24) * S + (m & (S - 1))] = logsigmoidf_(acc[0][i][q] + p.b_forget[l * 4 + cc - 24]);
                    }
                }
            }
            continue;
        }
#pragma unroll
        for (int j = 0; j < 2; ++j) {
            const int nb = n0 + 64 * wn + 32 * j;
            const bool rope = ((nb & 63) == 0) && (nb < 512 || (nb >= C_KS && nb < C_VS) || (nb >= C_KW && nb < C_VW));
#pragma unroll
            for (int i = 0; i < 2; ++i) {
                f32x16 a = acc[j][i];
                if (rope) {
#pragma unroll
                    for (int q = 0; q < 4; ++q) { const float x1 = a[q], x2 = a[q + 4]; a[q] = x1 * rcs[i][q] - x2 * rsn[i][q]; a[q + 4] = x2 * rcs[i][q] + x1 * rsn[i][q]; }
                }
#pragma unroll
                for (int g = 0; g < 4; ++g) ctile_put(ct, 64 * wm + 32 * i + r, 64 * wn + 32 * j + 8 * g + 4 * h, a[4 * g], a[4 * g + 1], a[4 * g + 2], a[4 * g + 3]);
            }
        }
        bf16_t* ub = v.U + (size_t)m0 * NP + n0;
        ctile_flush<128>(ct, TIDX, [&](int row, int) { return ub + (size_t)row * NP; });
    }
}

DEV void ph_outproj_fast(const P& p, int l, unsigned char* lds) {
    const V v = make_views(p); const int TIDX = otid(), BIDX = obid();
    const bf16_t* W = (const bf16_t*)(p.ws + WS_WOT) + (size_t)l * D * D;
    const int lane = TIDX & 63, wave = TIDX >> 6, wm = wave >> 1, wn = wave & 1, r = lane & 31, h = lane >> 5;
    const bool xo = gridDim.x == 512;
    auto decode = [&](int it, int& mt, int& nt) -> bool {
        if (xo) { if (it >= 2) return false; const int lb = BIDX >> 3; nt = lb >> 3; mt = 16 * (BIDX & 7) + 8 * it + (lb & 7); return true; }
        const int unit = BIDX + it * (int)gridDim.x; if (unit >= 128 * 8) return false; nt = unit / 128; mt = unit % 128; return true;
    };
    auto issue = [&](int mt, int nt) {
        const bf16_t* ar[4];
#pragma unroll
        for (int i = 0; i < 4; ++i) ar[i] = v.O + (size_t)(mt * 128 + (TIDX >> 3) + 32 * i) * D;
        gemm_issue0(lds, ar, W + nt * 128, D, TIDX);
    };
    for (int it = 0;; ++it) {
        int nt, mt, ntn = 0, mtn = 0;
        if (!decode(it, mt, nt)) break;
        const bool hasn = decode(it + 1, mtn, ntn);
        const int m0 = mt * 128, n0 = nt * 128;
        const bf16_t* arow[4];
#pragma unroll
        for (int i = 0; i < 4; ++i) arow[i] = v.O + (size_t)(m0 + (TIDX >> 3) + 32 * i) * D;
        if (it == 0) { __syncthreads(); issue(mt, nt); }
        f32x4v xin[2][2][4];
#pragma unroll
        for (int j = 0; j < 2; ++j)
#pragma unroll
            for (int i = 0; i < 2; ++i)
#pragma unroll
                for (int g = 0; g < 4; ++g) xin[j][i][g] = *(const f32x4v*)(v.X + (size_t)(m0 + 64 * wm + 32 * i + r) * D + n0 + 64 * wn + 32 * j + 4 * h + 8 * g);
        f32x16 acc[2][2];
        gemm128<false, true>(lds, arow, W + n0, D, D, acc, TIDX);
        if (hasn) issue(mtn, ntn);
        const float* g1 = v.mod + (size_t)(l * 8 + (m0 >> 11)) * 6144 + 2 * D;
#pragma unroll
        for (int j = 0; j < 2; ++j)
#pragma unroll
            for (int i = 0; i < 2; ++i) {
                const int m = m0 + 64 * wm + 32 * i + r, nb = n0 + 64 * wn + 32 * j + 4 * h;
#pragma unroll
                for (int g = 0; g < 4; ++g) {
                    const float4 gg = *(const float4*)(g1 + nb + 8 * g);
                    f32x4v xo = xin[j][i][g];
                    xo[0] += gg.x * acc[j][i][4 * g]; xo[1] += gg.y * acc[j][i][4 * g + 1]; xo[2] += gg.z * acc[j][i][4 * g + 2]; xo[3] += gg.w * acc[j][i][4 * g + 3];
                    *(f32x4v*)(v.X + (size_t)m * D + nb + 8 * g) = xo;
                }
            }
    }
}

DEV void ph_moe_up_fast(const P& p, int l, unsigned char* lds) {
    const V v = make_views(p); const int TIDX = otid(), BIDX = obid();
    const int lane = TIDX & 63, wave = TIDX >> 6, wm = wave >> 1, wn = wave & 1, r = lane & 31, h = lane >> 5;
    const unsigned* cnt = v.ctl + CW_CNT + l * 32;
    int* tp = (int*)(lds + 67584); int* rb = tp + 40;
    __syncthreads();
    if (TIDX < 64) {
        const int c = TIDX < 32 ? (int)cnt[TIDX] : 0;
        int nu = ((c + 127) >> 7) * 8, cc = c;
#pragma unroll
        for (int o = 1; o < 32; o <<= 1) { const int a = __shfl_up(nu, o), b2 = __shfl_up(cc, o); if ((TIDX & 31) >= o) { nu += a; cc += b2; } }
        if (TIDX < 32) { tp[TIDX + 1] = nu; rb[TIDX + 1] = cc; if (TIDX == 0) { tp[0] = 0; rb[0] = 0; } }
    }
    __syncthreads();
    const int total = tp[32];
    unsigned char* ct = lds + 32768;
    struct UU { int e, base, nt, mt, nrow; const int* lst; const bf16_t* B; const bf16_t* ar[4]; };
    auto setup = [&](int unit, UU& u) {
        int e = 0;
#pragma unroll
        for (int st = 16; st > 0; st >>= 1) if (tp[e + st] <= unit) e += st;
        const int rem = unit - tp[e];
        u.e = e; u.base = rb[e]; u.nt = rem & 7; u.mt = rem >> 3;
        const int ce = rb[e + 1] - u.base;
        u.lst = v.list + (size_t)e * T + u.mt * 128;
        u.nrow = ce - u.mt * 128 < 128 ? ce - u.mt * 128 : 128;
        u.B = (const bf16_t*)(p.ws + WS_W13) + ((size_t)l * 32 + e) * 1024 * D + u.nt * 128;
#pragma unroll
        for (int i = 0; i < 4; ++i) { const int rr = (TIDX >> 3) + 32 * i; u.ar[i] = v.H + (size_t)(u.lst[rr < u.nrow ? rr : 0] >> 1) * D; }
    };
    int unit = BIDX;
    if (unit >= total) return;
    UU cu, nu;
    setup(unit, cu);
    __syncthreads();
    gemm_issue0(lds, cu.ar, cu.B, 1024, TIDX);
    for (;;) {
        const int un = unit + (int)gridDim.x;
        f32x16 acc[2][2];
        gemm128<false, true>(lds, cu.ar, cu.B, 1024, D, acc, TIDX);
        if (un < total) { setup(un, nu); gemm_issue0(lds, nu.ar, nu.B, 1024, TIDX); }
#pragma unroll
        for (int i = 0; i < 2; ++i)
#pragma unroll
            for (int g = 0; g < 4; ++g) {
                float o[4];
#pragma unroll
                for (int q = 0; q < 4; ++q) { const float a1 = acc[0][i][4 * g + q], a3 = acc[1][i][4 * g + q]; o[q] = a1 / (1.f + __expf(-a1)) * a3; }
                ctile_put(ct, 64 * wm + 32 * i + r, 32 * wn + 8 * g + 4 * h, o[0], o[1], o[2], o[3]);
            }
        bf16_t* hb = v.HID + (size_t)(cu.base + cu.mt * 128) * 512 + 64 * cu.nt;
        const int nrow = cu.nrow;
        ctile_flush<64>(ct, TIDX, [&](int row, int) { return row < nrow ? hb + (size_t)row * 512 : (bf16_t*)nullptr; });
        if (un >= total) break;
        unit = un; cu = nu;
    }
}
DEV void ph_moe_down_fast(const P& p, int l, unsigned char* lds) {
    const V v = make_views(p); const int TIDX = otid(), BIDX = obid();
    const int lane = TIDX & 63, wave = TIDX >> 6, wm = wave >> 1, wn = wave & 1, r = lane & 31, h = lane >> 5;
    const unsigned* cnt = v.ctl + CW_CNT + l * 32;
    int* tp = (int*)(lds + 67584); int* rb = tp + 40;
    __syncthreads();
    if (TIDX < 64) {
        const int c = TIDX < 32 ? (int)cnt[TIDX] : 0;
        int nu = ((c + 127) >> 7) * 8, cc = c;
#pragma unroll
        for (int o = 1; o < 32; o <<= 1) { const int a = __shfl_up(nu, o), b2 = __shfl_up(cc, o); if ((TIDX & 31) >= o) { nu += a; cc += b2; } }
        if (TIDX < 32) { tp[TIDX + 1] = nu; rb[TIDX + 1] = cc; if (TIDX == 0) { tp[0] = 0; rb[0] = 0; } }
    }
    __syncthreads();
    const int total = tp[32];
    unsigned char* ct = lds + 32768;
    struct UD { int n0, nrow; const bf16_t* B; const bf16_t* ar[4]; float wrow[2]; int fslot[8]; };
    auto setup = [&](int unit, UD& u) {
        int e = 0;
#pragma unroll
        for (int st = 16; st > 0; st >>= 1) if (tp[e + st] <= unit) e += st;
        const int rem = unit - tp[e], base = rb[e];
        const int ce = rb[e + 1] - base, nt = rem & 7, mt = rem >> 3;
        const int* lst = v.list + (size_t)e * T + mt * 128;
        u.n0 = nt * 128;
        u.nrow = ce - mt * 128 < 128 ? ce - mt * 128 : 128;
        u.B = (const bf16_t*)(p.ws + WS_W2) + ((size_t)l * 32 + e) * 512 * D + u.n0;
#pragma unroll
        for (int i = 0; i < 4; ++i) { const int rr = (TIDX >> 3) + 32 * i; u.ar[i] = v.HID + (size_t)(base + mt * 128 + (rr < u.nrow ? rr : 0)) * 512; }
#pragma unroll
        for (int i = 0; i < 2; ++i) { const int mr = 64 * wm + 32 * i + r; u.wrow[i] = mr < u.nrow ? v.wts[lst[mr]] : 0.f; }
#pragma unroll
        for (int it = 0; it < 8; ++it) { const int row = it * 16 + (TIDX >> 4); u.fslot[it] = row < u.nrow ? lst[row] : -1; }
    };
    int unit = BIDX;
    if (unit >= total) return;
    UD cu, nu;
    setup(unit, cu);
    __syncthreads();
    gemm_issue0(lds, cu.ar, cu.B, D, TIDX);
    for (;;) {
        const int un = unit + (int)gridDim.x;
        f32x16 acc[2][2];
        gemm128<false, true>(lds, cu.ar, cu.B, D, 512, acc, TIDX);
        if (un < total) { setup(un, nu); gemm_issue0(lds, nu.ar, nu.B, D, TIDX); }
#pragma unroll
        for (int i = 0; i < 2; ++i) {
            const int mr = 64 * wm + 32 * i + r;
            const float w = cu.wrow[i];
#pragma unroll
            for (int j = 0; j < 2; ++j)
#pragma unroll
                for (int g = 0; g < 4; ++g)
                    ctile_put(ct, mr, 64 * wn + 32 * j + 8 * g + 4 * h, w * acc[j][i][4 * g], w * acc[j][i][4 * g + 1], w * acc[j][i][4 * g + 2], w * acc[j][i][4 * g + 3]);
        }
        const int n0 = cu.n0;
        ctile_flush<128>(ct, TIDX, [&](int, int it) { const int sl = cu.fslot[it]; return sl >= 0 ? v.Y + (size_t)sl * D + n0 : (bf16_t*)nullptr; });
        if (un >= total) break;
        unit = un; cu = nu;
    }
}

constexpr float LOG2E = 1.4426950408889634f, C2 = 0.125f * 1.4426950408889634f, LN2 = 0.6931471805599453f;
DEV float fexp2(float x) { return __builtin_amdgcn_exp2f(x); }
DEV float flog2(float x) { return __builtin_amdgcn_logf(x); }
DEV int swap23(int r) { return (r & ~12) | ((r & 4) << 1) | ((r & 8) >> 1); }

struct KVT { const bf16_t* k; int ks; const bf16_t* v; int vs; };
DEV void kv_load(const KVT& s, int kv0, const int TIDX, u32x4 (&rg)[4]) {
    const int c = TIDX & 7, r0 = TIDX >> 3;
    rg[0] = *(const u32x4*)(s.k + (size_t)(kv0 + r0) * s.ks + c * 8);
    rg[1] = *(const u32x4*)(s.k + (size_t)(kv0 + r0 + 32) * s.ks + c * 8);
    rg[2] = *(const u32x4*)(s.v + (size_t)r0 * s.vs + kv0 + c * 8);
    rg[3] = *(const u32x4*)(s.v + (size_t)(r0 + 32) * s.vs + kv0 + c * 8);
}
DEV void kv_store(unsigned char* st, const int TIDX, const u32x4 (&rg)[4]) {
    const int c = TIDX & 7, r0 = TIDX >> 3;
    *(u32x4*)(st + tile_off(r0, c)) = rg[0]; *(u32x4*)(st + tile_off(r0 + 32, c)) = rg[1];
    *(u32x4*)(st + 8192 + tile_off(r0, c)) = rg[2]; *(u32x4*)(st + 8192 + tile_off(r0 + 32, c)) = rg[3];
}
DEV bf16x8 scale_frag(bf16x8 v, float sc) {
    u32x4 u = __builtin_bit_cast(u32x4, v);
#pragma unroll
    for (int i = 0; i < 4; ++i) u[i] = cvtpk(__uint_as_float(u[i] << 16) * sc, __uint_as_float(u[i] & 0xffff0000u) * sc);
    return __builtin_bit_cast(bf16x8, u);
}
DEV void score_tile(const unsigned char* Kt, const bf16x8 (&qf)[4], int r, int h, f32x16 (&p)[2]) {
    const int kr = swap23(r);
#pragma unroll
    for (int blk = 0; blk < 2; ++blk) {
#pragma unroll
        for (int q = 0; q < 16; ++q) p[blk][q] = 0.f;
#pragma unroll
        for (int s = 0; s < 4; ++s) {
            const bf16x8 kf = *(const bf16x8*)(Kt + tile_off(32 * blk + kr, 2 * s + h));
            p[blk] = __builtin_amdgcn_mfma_f32_32x32x16_bf16(kf, qf[s], p[blk], 0, 0, 0);
        }
    }
}
DEV void pv_tile(const unsigned char* Vt, const f32x16 (&p)[2], int r, int h, f32x16 (&o)[2]) {
#pragma unroll
    for (int blk = 0; blk < 2; ++blk)
#pragma unroll
        for (int s = 0; s < 2; ++s) {
            u32x4 pk;
            pk.x = cvtpk(p[blk][8 * s], p[blk][8 * s + 1]); pk.y = cvtpk(p[blk][8 * s + 2], p[blk][8 * s + 3]);
            pk.z = cvtpk(p[blk][8 * s + 4], p[blk][8 * s + 5]); pk.w = cvtpk(p[blk][8 * s + 6], p[blk][8 * s + 7]);
            const bf16x8 pb = __builtin_bit_cast(bf16x8, pk);
#pragma unroll
            for (int db = 0; db < 2; ++db) {
                const bf16x8 vf = *(const bf16x8*)(Vt + tile_off(32 * db + r, 2 * (2 * blk + s) + h));
                o[db] = __builtin_amdgcn_mfma_f32_32x32x16_bf16(vf, pb, o[db], 0, 0, 0);
            }
        }
}

template <int VAR>
DEV void attn_branch(unsigned char* lds, const KVT& src, const bf16x8 (&qf)[4], unsigned tmask, int wave_last, int t, int t_first,
                     unsigned selbits, const float* bias2, f32x16 (&o)[2], const int TIDX) {
    const int lane = TIDX & 63, r = lane & 31, h = lane >> 5;
    const float NEG_INF = -__builtin_inff();
    float mrun = -1e30f, lrun = 0.f, rest = VAR == 3 ? 1.f : 0.f;
#pragma unroll
    for (int db = 0; db < 2; ++db)
#pragma unroll
        for (int q = 0; q < 16; ++q) o[db][q] = 0.f;
    u32x4 rg[4];
    unsigned rem = tmask;
    int j = VAR == 3 ? 31 - __builtin_clz(rem) : __builtin_ctz(rem);
    rem &= ~(1u << j);
    kv_load(src, 64 * j, TIDX, rg);
    __syncthreads();
    kv_store(lds, TIDX, rg);
    __syncthreads();
    int stage = 0;
    for (;;) {
        int jn = -1;
        if (rem) { jn = VAR == 3 ? 31 - __builtin_clz(rem) : __builtin_ctz(rem); rem &= ~(1u << jn); kv_load(src, 64 * jn, TIDX, rg); }
        asm volatile("" ::: "memory"); __builtin_amdgcn_sched_barrier(0);
        if (j <= wave_last) {
            const unsigned char* Kt = lds + stage * 16384;
            f32x16 p[2];
            score_tile(Kt, qf, r, h, p);
            const int kvb = 64 * j + 8 * h;
            if (VAR == 3) {
                const bool diag = 64 * j + 63 >= t_first;
                float gt[2][2];
                if (diag) {
#pragma unroll
                    for (int blk = 0; blk < 2; ++blk)
#pragma unroll
                        for (int s = 0; s < 2; ++s) {
                            float run = 1.f;
#pragma unroll
                            for (int q = 7; q >= 0; --q) {
                                const float ez = fexp2(p[blk][8 * s + q]);
                                float w = __builtin_amdgcn_rcpf(1.f + ez);
                                float beta = 1.f - w;
                                const bool valid = kvb + 32 * blk + 16 * s + q < t;
                                w = valid ? w : 1.f; beta = valid ? beta : 0.f;
                                p[blk][8 * s + q] = beta * run;
                                run *= w;
                            }
                            gt[blk][s] = run;
                        }
                } else {
#pragma unroll
                    for (int blk = 0; blk < 2; ++blk)
#pragma unroll
                        for (int s = 0; s < 2; ++s) {
                            float run = 1.f;
#pragma unroll
                            for (int q = 7; q >= 0; --q) {
                                const float rn = run * __builtin_amdgcn_rcpf(1.f + fexp2(p[blk][8 * s + q]));
                                p[blk][8 * s + q] = run - rn;
                                run = rn;
                            }
                            gt[blk][s] = run;
                        }
                }
                float og[2][2], pt[2][2];
#pragma unroll
                for (int blk = 0; blk < 2; ++blk)
#pragma unroll
                    for (int s = 0; s < 2; ++s) { og[blk][s] = __shfl_xor(gt[blk][s], 32); pt[blk][s] = gt[blk][s] * og[blk][s]; }
                float above = rest;
#pragma unroll
                for (int pi = 3; pi >= 0; --pi) {
                    const int blk = pi >> 1, s = pi & 1;
                    const float carry = above * (h == 0 ? og[blk][s] : 1.f);
#pragma unroll
                    for (int q = 0; q < 8; ++q) p[blk][8 * s + q] *= carry;
                    above *= pt[blk][s];
                }
                rest = above;
            } else {
                const bool need_causal = 64 * j + 63 > t_first;
                const bool need_win = VAR == 1 && (64 * j + 512 <= t_first + 31);
                const bool lane_on = VAR != 0 || ((selbits >> j) & 1u);
                if (VAR == 2) {
#pragma unroll
                    for (int blk = 0; blk < 2; ++blk)
#pragma unroll
                        for (int s = 0; s < 2; ++s) {
                            const float4 b0 = *(const float4*)(bias2 + kvb + 32 * blk + 16 * s), b1 = *(const float4*)(bias2 + kvb + 32 * blk + 16 * s + 4);
                            p[blk][8 * s] += b0.x; p[blk][8 * s + 1] += b0.y; p[blk][8 * s + 2] += b0.z; p[blk][8 * s + 3] += b0.w;
                            p[blk][8 * s + 4] += b1.x; p[blk][8 * s + 5] += b1.y; p[blk][8 * s + 6] += b1.z; p[blk][8 * s + 7] += b1.w;
                        }
                }
                if (need_causal) {
#pragma unroll
                    for (int blk = 0; blk < 2; ++blk)
#pragma unroll
                        for (int q = 0; q < 16; ++q) { const int kv = kvb + 32 * blk + 16 * (q >> 3) + (q & 7); p[blk][q] = kv <= t ? p[blk][q] : NEG_INF; }
                }
                if (need_win) {
#pragma unroll
                    for (int blk = 0; blk < 2; ++blk)
#pragma unroll
                        for (int q = 0; q < 16; ++q) { const int kv = kvb + 32 * blk + 16 * (q >> 3) + (q & 7); p[blk][q] = kv + 512 > t ? p[blk][q] : NEG_INF; }
                }
                float tmax = p[0][0];
#pragma unroll
                for (int q = 1; q < 16; ++q) tmax = fmaxf(tmax, p[0][q]);
#pragma unroll
                for (int q = 0; q < 16; ++q) tmax = fmaxf(tmax, p[1][q]);
                tmax = lane_on ? tmax : NEG_INF;
                tmax = fmaxf(tmax, __shfl_xor(tmax, 32));
                const float mnew = fmaxf(mrun, tmax);
                const bool grew = mnew > mrun;
                const float alpha = fexp2(mrun - mnew);
                mrun = mnew;
                const float msub = lane_on ? mnew : __builtin_inff();
                const f32x2_t ms2 = {msub, msub};
                f32x2_t ls2 = {0.f, 0.f};
#pragma unroll
                for (int blk = 0; blk < 2; ++blk)
#pragma unroll
                    for (int q = 0; q < 16; q += 2) {
                        const f32x2_t d2 = (f32x2_t){p[blk][q], p[blk][q + 1]} - ms2;
                        f32x2_t e2; e2.x = fexp2(d2.x); e2.y = fexp2(d2.y);
                        p[blk][q] = e2.x; p[blk][q + 1] = e2.y; ls2 += e2;
                    }
                lrun = lrun * alpha + (ls2.x + ls2.y);
                if (__any(grew)) {
#pragma unroll
                    for (int db = 0; db < 2; ++db)
#pragma unroll
                        for (int q = 0; q < 16; ++q) o[db][q] *= alpha;
                }
            }
            pv_tile(Kt + 8192, p, r, h, o);
        }
        if (jn >= 0) kv_store(lds + (stage ^ 1) * 16384, TIDX, rg);
        __syncthreads();
        if (jn < 0) break;
        j = jn; stage ^= 1;
    }
    if (VAR != 3) {
        const float lt = lrun + __shfl_xor(lrun, 32);
        const float inv = lt > 0.f ? 1.f / lt : 0.f;
#pragma unroll
        for (int db = 0; db < 2; ++db)
#pragma unroll
            for (int q = 0; q < 16; ++q) o[db][q] *= inv;
    }
}

DEV void head_norm_store(const f32x16 (&o)[2], const float* gam, bf16_t* dst, int h) {
    float ss = 0.f;
#pragma unroll
    for (int db = 0; db < 2; ++db)
#pragma unroll
        for (int q = 0; q < 16; ++q) ss += o[db][q] * o[db][q];
    ss += __shfl_xor(ss, 32);
    const float rinv = rsqrtf(ss * (1.f / 64.f) + EPS);
#pragma unroll
    for (int db = 0; db < 2; ++db)
#pragma unroll
        for (int g = 0; g < 4; ++g) {
            const int d = 32 * db + 8 * g + 4 * h;
            const float4 gg = *(const float4*)(gam + d);
            uint2 u;
            u.x = cvtpk(o[db][4 * g] * rinv * gg.x, o[db][4 * g + 1] * rinv * gg.y);
            u.y = cvtpk(o[db][4 * g + 2] * rinv * gg.z, o[db][4 * g + 3] * rinv * gg.w);
            *(uint2*)(dst + d) = u;
        }
}

template <int VAR>
DEV void mha_unit(const P& p, int l, int unit, unsigned char* lds) {
    const V v = make_views(p); const int TIDX = otid();
    const int lane = TIDX & 63, wave = TIDX >> 6, r = lane & 31, h = lane >> 5;
    const int qb = 15 - (unit >> 5), bh = unit & 31, b = bh >> 2, hh = bh & 3;
    const int t0 = qb * 128, tw = t0 + 32 * wave, t = tw + r, m = b * S + t;
    const int qcol = VAR == 2 ? C_QB : C_QC, kcol = VAR == 2 ? C_KB : C_KCC, vrow = VAR == 2 ? 256 : 512, ocol = VAR == 2 ? 512 : 768;
    bf16x8 qf[4];
#pragma unroll
    for (int s = 0; s < 4; ++s) qf[s] = scale_frag(*(const bf16x8*)(v.U + (size_t)m * NP + qcol + hh * 64 + 16 * s + 8 * h), C2);
    KVT src;
    src.k = v.U + (size_t)b * S * NP + kcol + hh * 64; src.ks = NP;
    src.v = (const bf16_t*)(p.ws + WS_VT) + (size_t)(b * 768 + vrow + hh * 64) * S; src.vs = S;
    const int last = (t0 + 127) >> 6;
    const unsigned tmask = last == 31 ? 0xffffffffu : ((1u << (last + 1)) - 1u);
    const float* bias2 = (const float*)(lds + 32768);
    if (VAR == 2) {
        float* cf = (float*)(lds + 32768);
        float* wt = (float*)(lds + 32768 + 8192);
        const float* lsf = (const float*)(p.ws + WS_LSF) + (size_t)(b * 4 + hh) * S;
        const int nel = t0 + 128;
        float x[8];
        if (8 * TIDX < nel) {
            const float4 a0 = *(const float4*)(lsf + 8 * TIDX), a1 = *(const float4*)(lsf + 8 * TIDX + 4);
            x[0] = a0.x; x[1] = x[0] + a0.y; x[2] = x[1] + a0.z; x[3] = x[2] + a0.w; x[4] = x[3] + a1.x; x[5] = x[4] + a1.y; x[6] = x[5] + a1.z; x[7] = x[6] + a1.w;
        } else {
#pragma unroll
            for (int q = 0; q < 8; ++q) x[q] = 0.f;
        }
        float inc = x[7];
#pragma unroll
        for (int o = 1; o < 64; o <<= 1) { const float tt = __shfl_up(inc, o); if (lane >= o) inc += tt; }
        __syncthreads();
        if (lane == 63) wt[wave] = inc;
        __syncthreads();
        float off = inc - x[7];
#pragma unroll
        for (int w = 0; w < 3; ++w) off += (w < wave) ? wt[w] : 0.f;
        if (8 * TIDX < nel) {
#pragma unroll
            for (int q = 0; q < 8; ++q) cf[8 * TIDX + q] = -(x[q] + off) * LOG2E;
        }
        __syncthreads();
    }
    f32x16 o[2];
    attn_branch<VAR>(lds, src, qf, tmask, (tw + 31) >> 6, t, tw, 0u, bias2, o, TIDX);
    head_norm_store(o, p.out_norm_g + (size_t)l * D + ocol + hh * 64, v.O + (size_t)m * D + ocol + hh * 64, h);
}

DEV void nsa_unit(const P& p, int l, int unit, unsigned char* lds) {
    const V v = make_views(p); const int TIDX = otid();
    const int lane = TIDX & 63, wave = TIDX >> 6, r = lane & 31, h = lane >> 5;
    const int qblk = 63 - (unit >> 4), bg = unit & 15, b = bg >> 1, g = bg & 1;
    const int t0 = qblk * 32, t = t0 + r, m = b * S + t, head = g * 4 + wave, cur = t0 >> 6;
    const float NEG_INF = -__builtin_inff();
    bf16x8 qf[4];
#pragma unroll
    for (int s = 0; s < 4; ++s) qf[s] = scale_frag(*(const bf16x8*)(v.U + (size_t)m * NP + C_QA + head * 64 + 16 * s + 8 * h), C2);
    const float g0 = sigmoidf_(v.gf[(size_t)m * 32 + head * 3]), g1 = sigmoidf_(v.gf[(size_t)m * 32 + head * 3 + 1]), g2 = sigmoidf_(v.gf[(size_t)m * 32 + head * 3 + 2]);
    f32x16 otot[2];
    float* PA = (float*)(lds + 32768);
    float* PB = (float*)(lds + 49152);
    float* SC = (float*)lds;
    unsigned* MASK = (unsigned*)(lds + 8192);
    {
        const bf16_t* ck = v.ck + (size_t)(b * 2 + g) * 128 * 64;
        const bf16_t* cvt = (const bf16_t*)(p.ws + WS_CVT) + (size_t)(b * 2 + g) * 64 * 128;
        const int c = TIDX & 7, r0 = TIDX >> 3;
        u32x4 rk[4], rv[4];
#pragma unroll
        for (int i = 0; i < 4; ++i) rk[i] = *(const u32x4*)(ck + (size_t)(r0 + 32 * i) * 64 + c * 8);
#pragma unroll
        for (int i = 0; i < 4; ++i) rv[i] = *(const u32x4*)(cvt + (size_t)(r0 + 32 * (i & 1)) * 128 + 64 * (i >> 1) + c * 8);
        __syncthreads();
#pragma unroll
        for (int i = 0; i < 4; ++i) *(u32x4*)(lds + tile_off(r0 + 32 * i, c)) = rk[i];
#pragma unroll
        for (int i = 0; i < 4; ++i) *(u32x4*)(lds + 16384 + 8192 * (i >> 1) + tile_off(r0 + 32 * (i & 1), c)) = rv[i];
        __syncthreads();
        f32x16 ps[2][2];
        score_tile(lds, qf, r, h, ps[0]);
        score_tile(lds + 8192, qf, r, h, ps[1]);
        const int nvalid = t >= 31 ? (t - 31) / 16 + 1 : 0;
        float mx = NEG_INF;
#pragma unroll
        for (int tt = 0; tt < 2; ++tt)
#pragma unroll
            for (int blk = 0; blk < 2; ++blk)
#pragma unroll
                for (int q = 0; q < 16; ++q) {
                    const int n = 64 * tt + 32 * blk + 16 * (q >> 3) + 8 * h + (q & 7);
                    const float x = n < nvalid ? ps[tt][blk][q] : NEG_INF;
                    ps[tt][blk][q] = x; mx = fmaxf(mx, x);
                }
        mx = fmaxf(mx, __shfl_xor(mx, 32));
        const float mxs = nvalid > 0 ? mx : 0.f;
        float ls = 0.f;
#pragma unroll
        for (int tt = 0; tt < 2; ++tt)
#pragma unroll
            for (int blk = 0; blk < 2; ++blk)
#pragma unroll
                for (int q = 0; q < 16; ++q) { const float e = fexp2(ps[tt][blk][q] - mxs); ps[tt][blk][q] = e; ls += e; }
        const float lt = ls + __shfl_xor(ls, 32);
        const float inv = lt > 0.f ? 1.f / lt : 0.f;
#pragma unroll
        for (int tt = 0; tt < 2; ++tt)
#pragma unroll
            for (int blk = 0; blk < 2; ++blk) {
#pragma unroll
                for (int q = 0; q < 16; ++q) ps[tt][blk][q] *= inv;
#pragma unroll
                for (int s = 0; s < 2; ++s) {
                    const int G0 = 16 * tt + 8 * blk + 4 * s + 2 * h;
                    const float a0 = (ps[tt][blk][8 * s] + ps[tt][blk][8 * s + 1]) + (ps[tt][blk][8 * s + 2] + ps[tt][blk][8 * s + 3]);
                    const float a1 = (ps[tt][blk][8 * s + 4] + ps[tt][blk][8 * s + 5]) + (ps[tt][blk][8 * s + 6] + ps[tt][blk][8 * s + 7]);
                    PA[(wave * 32 + G0) * 32 + r] = a0; PA[(wave * 32 + G0 + 1) * 32 + r] = a1;
                    PB[(wave * 32 + G0 + 1) * 32 + r] = ps[tt][blk][8 * s + 3];
                    if (G0 + 2 < 32) PB[(wave * 32 + G0 + 2) * 32 + r] = ps[tt][blk][8 * s + 7];
                }
            }
        f32x16 oc[2];
#pragma unroll
        for (int db = 0; db < 2; ++db)
#pragma unroll
            for (int q = 0; q < 16; ++q) oc[db][q] = 0.f;
        pv_tile(lds + 16384, ps[0], r, h, oc);
        pv_tile(lds + 24576, ps[1], r, h, oc);
#pragma unroll
        for (int db = 0; db < 2; ++db)
#pragma unroll
            for (int q = 0; q < 16; ++q) otot[db][q] = g0 * oc[db][q];
    }
    __syncthreads();
    {
        const int q = TIDX & 31, j0 = (TIDX >> 5) * 4;
#pragma unroll
        for (int jj = 0; jj < 4; ++jj) {
            const int j = j0 + jj;
            float sc = 0.f;
#pragma unroll
            for (int w = 0; w < 4; ++w) sc += PA[(w * 32 + j) * 32 + q];
            if (j > 0) {
#pragma unroll
                for (int w = 0; w < 4; ++w) sc += PB[(w * 32 + j) * 32 + q];
            }
            const bool forced = (j == 0) || (j == cur) || (j == cur - 1);
            SC[q * 33 + j] = forced ? 1.0e4f : (j <= cur ? sc : -1.0f);
        }
        if (TIDX < 32) MASK[TIDX] = 0u;
        __syncthreads();
        unsigned bits = 0u;
#pragma unroll
        for (int jj = 0; jj < 4; ++jj) {
            const int j = j0 + jj;
            const float vj = SC[q * 33 + j];
            int rank = 0;
#pragma unroll
            for (int i = 0; i < 32; ++i) { const float vi = SC[q * 33 + i]; rank += (vi > vj || (vi == vj && i < j)) ? 1 : 0; }
            if (rank < 16) bits |= 1u << j;
        }
        atomicOr(&MASK[q], bits);
        __syncthreads();
    }
    const unsigned mybits = MASK[r];
    unsigned um = 0u;
#pragma unroll
    for (int i = 0; i < 32; ++i) um |= MASK[i];
    um = (unsigned)__builtin_amdgcn_readfirstlane((int)um);
    const unsigned upto = (2u << cur) - 1u;
    {
        KVT src; src.k = v.U + (size_t)b * S * NP + C_KS + g * 64; src.ks = NP;
        src.v = (const bf16_t*)(p.ws + WS_VT) + (size_t)(b * 768 + g * 64) * S; src.vs = S;
        f32x16 o[2];
        attn_branch<0>(lds, src, qf, um & upto, cur, t, t0, mybits, nullptr, o, TIDX);
#pragma unroll
        for (int db = 0; db < 2; ++db)
#pragma unroll
            for (int q = 0; q < 16; ++q) otot[db][q] += g1 * o[db][q];
    }
    {
        KVT src; src.k = v.U + (size_t)b * S * NP + C_KW + g * 64; src.ks = NP;
        src.v = (const bf16_t*)(p.ws + WS_VT) + (size_t)(b * 768 + 128 + g * 64) * S; src.vs = S;
        const int f = (t0 - 511 > 0 ? t0 - 511 : 0) >> 6;
        const unsigned wmask = upto & ~((1u << f) - 1u);
        f32x16 o[2];
        attn_branch<1>(lds, src, qf, wmask, cur, t, t0, 0u, nullptr, o, TIDX);
#pragma unroll
        for (int db = 0; db < 2; ++db)
#pragma unroll
            for (int q = 0; q < 16; ++q) otot[db][q] += g2 * o[db][q];
    }
    head_norm_store(otot, p.out_norm_g + (size_t)l * D + head * 64, v.O + (size_t)m * D + head * 64, h);
}

DEV void cmp_unit(const P& p, int l, int unit, unsigned char* lds) {
    const V v = make_views(p); const int TIDX = otid();
    const int lane = TIDX & 63, wave = TIDX >> 6, wm = wave >> 1, wn = wave & 1, r = lane & 31, h = lane >> 5;
    const int kv = unit & 1, bg = unit >> 1, b = bg >> 1, g = bg & 1, lk = l * 2 + kv;
    const int col = (kv ? C_VC : C_KC) + g * 64;
    const bf16_t* arow[4];
#pragma unroll
    for (int i = 0; i < 4; ++i) { const int n = (TIDX >> 3) + 32 * i; arow[i] = v.U + (size_t)(b * S + 16 * (n < 127 ? n : 126)) * NP + col; }
    f32x16 acc[2][2];
    gemm128<false>(lds, arow, (const bf16_t*)(p.ws + WS_CW1) + (size_t)lk * 2048 * 128, 128, 2048, acc, TIDX, NP);
    const float* pb = (const float*)(p.ws + WS_CPB) + lk * 8 * 128;
#pragma unroll
    for (int j = 0; j < 2; ++j)
#pragma unroll
        for (int i = 0; i < 2; ++i) {
            const int mrow = 64 * wm + 32 * i + r;
#pragma unroll
            for (int g4 = 0; g4 < 4; ++g4) {
                float4 bb = *(const float4*)(pb + 64 * wn + 32 * j + 8 * g4 + 4 * h);
#pragma unroll
                for (int c8 = 1; c8 < 8; ++c8) { const float4 b2 = *(const float4*)(pb + c8 * 128 + 64 * wn + 32 * j + 8 * g4 + 4 * h); bb.x += b2.x; bb.y += b2.y; bb.z += b2.z; bb.w += b2.w; }
                float x0 = acc[j][i][4 * g4] + bb.x, x1 = acc[j][i][4 * g4 + 1] + bb.y, x2 = acc[j][i][4 * g4 + 2] + bb.z, x3 = acc[j][i][4 * g4 + 3] + bb.w;
                x0 = x0 / (1.f + __expf(-x0)); x1 = x1 / (1.f + __expf(-x1)); x2 = x2 / (1.f + __expf(-x2)); x3 = x3 / (1.f + __expf(-x3));
                uint2 u; u.x = cvtpk(x0, x1); u.y = cvtpk(x2, x3);
                *(uint2*)(lds + wn * 16384 + tile_off(mrow, 4 * j + g4) + 8 * h) = u;
            }
        }
    {
        const bf16_t* w2 = (const bf16_t*)(p.ws + WS_CW2) + (size_t)lk * 64 * 128;
        const int c = TIDX & 7, r0 = TIDX >> 3;
#pragma unroll
        for (int i = 0; i < 4; ++i) {
            const int row = r0 + 32 * (i & 1), kt = i >> 1;
            *(u32x4*)(lds + 32768 + kt * 8192 + tile_off(row, c)) = *(const u32x4*)(w2 + (size_t)row * 128 + kt * 64 + c * 8);
        }
    }
    __syncthreads();
    f32x16 a2[2];
#pragma unroll
    for (int db = 0; db < 2; ++db)
#pragma unroll
        for (int q = 0; q < 16; ++q) a2[db][q] = 0.f;
#pragma unroll
    for (int kt = 0; kt < 2; ++kt)
#pragma unroll
        for (int s = 0; s < 4; ++s) {
            const bf16x8 hf = *(const bf16x8*)(lds + kt * 16384 + tile_off(32 * wave + r, 2 * s + h));
#pragma unroll
            for (int db = 0; db < 2; ++db) {
                const bf16x8 wf = *(const bf16x8*)(lds + 32768 + kt * 8192 + tile_off(32 * db + r, 2 * s + h));
                a2[db] = __builtin_amdgcn_mfma_f32_32x32x16_bf16(wf, hf, a2[db], 0, 0, 0);
            }
        }
    const int n = 32 * wave + r;
    if (kv == 0 && n < 127) {
        const int pos = 16 * n + 31;
#pragma unroll
        for (int q = 0; q < 4; ++q) {
            const float cs = v.rcos[pos * 8 + q + 4 * h], sn = v.rsin[pos * 8 + q + 4 * h];
            const float x1 = a2[0][q], x2 = a2[0][q + 4];
            a2[0][q] = x1 * cs - x2 * sn; a2[0][q + 4] = x2 * cs + x1 * sn;
        }
    }
    bf16_t* dst = (kv ? v.cv : v.ck) + ((size_t)bg * 128 + n) * 64;
    bf16_t* dt = (bf16_t*)(p.ws + WS_CVT) + (size_t)bg * 64 * 128 + n;
#pragma unroll
    for (int db = 0; db < 2; ++db)
#pragma unroll
        for (int g4 = 0; g4 < 4; ++g4) {
            const int d = 32 * db + 8 * g4 + 4 * h;
            float x0 = a2[db][4 * g4], x1 = a2[db][4 * g4 + 1], x2 = a2[db][4 * g4 + 2], x3 = a2[db][4 * g4 + 3];
            if (n >= 127) { x0 = 0.f; x1 = 0.f; x2 = 0.f; x3 = 0.f; }
            uint2 u; u.x = cvtpk(x0, x1); u.y = cvtpk(x2, x3);
            *(uint2*)(dst + d) = u;
            if (kv) { dt[(size_t)d * 128] = (bf16_t)(u.x & 0xffffu); dt[(size_t)(d + 1) * 128] = (bf16_t)(u.x >> 16); dt[(size_t)(d + 2) * 128] = (bf16_t)(u.y & 0xffffu); dt[(size_t)(d + 3) * 128] = (bf16_t)(u.y >> 16); }
        }
    __syncthreads();
}

typedef float f32x4m __attribute__((ext_vector_type(4)));
DEV void ph_norm2_router_fast(const P& p, int l, unsigned char* lds) {
    const V v = make_views(p); const int TIDX = otid(), BIDX = obid();
    const int lane = TIDX & 63, wave = TIDX >> 6;
    const bf16_t* wr = (const bf16_t*)(p.ws + WS_WR) + (size_t)l * 2 * 64 * D;
    float* LG = (float*)(lds + 65536);
    for (int blk = BIDX; blk < T / 16; blk += gridDim.x) {
        const int m0 = blk * 16, b = m0 >> 11;
        const float* md = v.mod + (size_t)(l * 8 + b) * 6144;
        float4 xv[4][4]; float ssq[4];
#pragma unroll
        for (int rr = 0; rr < 4; ++rr)
#pragma unroll
            for (int j = 0; j < 4; ++j) xv[rr][j] = *(const float4*)(v.X + (size_t)(m0 + wave * 4 + rr) * D + 4 * lane + 256 * j);
#pragma unroll
        for (int rr = 0; rr < 4; ++rr) {
            ssq[rr] = 0.f;
#pragma unroll
            for (int j = 0; j < 4; ++j) ssq[rr] += xv[rr][j].x * xv[rr][j].x + xv[rr][j].y * xv[rr][j].y + xv[rr][j].z * xv[rr][j].z + xv[rr][j].w * xv[rr][j].w;
        }
#pragma unroll
        for (int o = 1; o < 64; o <<= 1) {
#pragma unroll
            for (int rr = 0; rr < 4; ++rr) ssq[rr] += __shfl_xor(ssq[rr], o);
        }
#pragma unroll
        for (int rr = 0; rr < 4; ++rr) {
            const int row = wave * 4 + rr, m = m0 + row;
            const float rs = rsqrtf(ssq[rr] * (1.f / D) + EPS);
#pragma unroll
            for (int j = 0; j < 4; ++j) {
                const int c = 4 * lane + 256 * j;
                const float4 g = *(const float4*)(p.norm2_g + l * D + c), sh = *(const float4*)(md + 3 * D + c), sc = *(const float4*)(md + 4 * D + c);
                const float h0 = xv[rr][j].x * rs * g.x * (1.f + sc.x) + sh.x, h1 = xv[rr][j].y * rs * g.y * (1.f + sc.y) + sh.y;
                const float h2 = xv[rr][j].z * rs * g.z * (1.f + sc.z) + sh.z, h3 = xv[rr][j].w * rs * g.w * (1.f + sc.w) + sh.w;
                uint2 hi; hi.x = cvtpk(h0, h1); hi.y = cvtpk(h2, h3);
                uint2 lo;
                lo.x = cvtpk(h0 - __uint_as_float(hi.x << 16), h1 - __uint_as_float(hi.x & 0xffff0000u));
                lo.y = cvtpk(h2 - __uint_as_float(hi.y << 16), h3 - __uint_as_float(hi.y & 0xffff0000u));
                *(uint2*)(v.H + (size_t)m * D + c) = hi;
                const int off = row * 2048 + ((((c >> 3) ^ row) & 127) << 4) + (c & 7) * 2;
                *(uint2*)(lds + off) = hi; *(uint2*)(lds + 32768 + off) = lo;
            }
        }
        __syncthreads();
        {
            const int r16 = lane & 15, kq = lane >> 4;
            f32x4m acc = {0.f, 0.f, 0.f, 0.f};
            const bf16_t* wh = wr + (size_t)(16 * wave + r16) * D + 8 * kq;
#pragma unroll 8
            for (int s = 0; s < 32; ++s) {
                const int off = r16 * 2048 + ((((4 * s + kq) ^ r16) & 127) << 4);
                const bf16x8 ah = *(const bf16x8*)(lds + off), al = *(const bf16x8*)(lds + 32768 + off);
                const bf16x8 bh = *(const bf16x8*)(wh + 32 * s), bl = *(const bf16x8*)(wh + 64 * D + 32 * s);
                acc = __builtin_amdgcn_mfma_f32_16x16x32_bf16(ah, bh, acc, 0, 0, 0);
                acc = __builtin_amdgcn_mfma_f32_16x16x32_bf16(al, bh, acc, 0, 0, 0);
                acc = __builtin_amdgcn_mfma_f32_16x16x32_bf16(ah, bl, acc, 0, 0, 0);
            }
#pragma unroll
            for (int q = 0; q < 4; ++q) LG[(4 * kq + q) * 64 + 16 * wave + r16] = acc[q];
        }
        __syncthreads();
        if (TIDX < 16) {
            const int m = m0 + TIDX;
            const float* lgp = LG + TIDX * 64;
            float lg[4], le[32];
#pragma unroll
            for (int i = 0; i < 4; ++i) lg[i] = lgp[i] + p.rg_b[l * 4 + i];
#pragma unroll
            for (int i = 0; i < 32; ++i) le[i] = lgp[4 + i] + p.re_b[l * 32 + i];
            int gi = 0; float gm = lg[0];
#pragma unroll
            for (int i = 1; i < 4; ++i) if (lg[i] > gm) { gm = lg[i]; gi = i; }
            float gs = 0.f;
#pragma unroll
            for (int i = 0; i < 4; ++i) gs += expf(lg[i] - gm);
            const float pg = 1.f / gs;
            float el[8];
#pragma unroll
            for (int i = 0; i < 8; ++i) el[i] = gi == 0 ? le[i] : (gi == 1 ? le[8 + i] : (gi == 2 ? le[16 + i] : le[24 + i]));
            int e1 = 0; float m1 = el[0];
#pragma unroll
            for (int i = 1; i < 8; ++i) if (el[i] > m1) { m1 = el[i]; e1 = i; }
            int e2 = -1; float m2 = -3.0e38f;
#pragma unroll
            for (int i = 0; i < 8; ++i) if (i != e1 && el[i] > m2) { m2 = el[i]; e2 = i; }
            const float p2 = expf(m2 - m1);
            const float w1 = pg / (1.f + p2), w2 = pg * p2 / (1.f + p2);
            const int ea = gi * 8 + e1, eb = gi * 8 + e2;
            const unsigned pa = atomicAdd(v.ctl + CW_CNT + l * 32 + ea, 1u);
            const unsigned pb = atomicAdd(v.ctl + CW_CNT + l * 32 + eb, 1u);
            v.list[(size_t)ea * T + pa] = 2 * m;
            v.list[(size_t)eb * T + pb] = 2 * m + 1;
            v.wts[2 * m] = w1; v.wts[2 * m + 1] = w2;
        }
        __syncthreads();
    }
}

constexpr int CW_MQ = 8192 + 512;
DEV void ph_mix(const P& p, int l, unsigned char* lds, volatile LAS unsigned* qslot, int rep) {
    const int TIDX = otid(), BIDX = obid();
    unsigned* ctl = (unsigned*)(p.ws + WS_CTL) + CW_MQ + l * 256;
    unsigned acq = 0u;
    for (int hop = 0; hop < 8; ++hop) {
        const int b = (BIDX + hop) & 7;
        unsigned* qc = ctl + b * 16;
        unsigned* done = ctl + 128 + b * 16;
        for (;;) {
            __syncthreads();
            if (TIDX == 0) *qslot = atomicAdd(qc, 1u);
            __syncthreads();
            const int v = (int)*qslot;
            if (v >= 260) break;
            if (v < 4) {
                cmp_unit(p, l, b * 4 + v, lds);
                asm volatile("s_waitcnt vmcnt(0)" ::: "memory");
                __syncthreads();
                if (TIDX == 0) {
                    __builtin_amdgcn_fence(__ATOMIC_RELEASE, "agent");
                    asm volatile("s_waitcnt vmcnt(0)" ::: "memory");
                    __hip_atomic_fetch_add(done, 1u, __ATOMIC_RELAXED, __HIP_MEMORY_SCOPE_AGENT);
                }
                continue;
            }
            int slot = -1, nsa = -1;
            if (v < 68) slot = v - 4;
            else { const int w2 = v - 68, k = w2 % 3, i = w2 / 3; if (k < 2) nsa = 2 * i + k; else slot = 64 + i; }
            if (slot >= 0) {
                const int idx = slot >> 1, u = ((idx >> 2) << 5) | (b * 4 + (idx & 3));
                if (slot & 1) mha_unit<3>(p, l, u, lds); else mha_unit<2>(p, l, u, lds);
            } else {
                if (!((acq >> b) & 1u)) {
                    if (TIDX == 0) {
                        unsigned sp = 0;
                        while (__hip_atomic_load(done, __ATOMIC_RELAXED, __HIP_MEMORY_SCOPE_AGENT) < 4u) { __builtin_amdgcn_s_sleep(2); if (++sp > (1u << 22)) break; }
                        __builtin_amdgcn_fence(__ATOMIC_ACQUIRE, "agent");
                        asm volatile("s_waitcnt vmcnt(0)" ::: "memory");
                    }
                    __syncthreads();
                    acq |= 1u << b;
                }
                nsa_unit(p, l, ((nsa >> 1) << 4) | (b * 2 + (nsa & 1)), lds);
            }
        }
    }
}

#ifndef REP_PHASE
#define REP_PHASE 0
#endif
#ifndef REF_HEADS
#define REF_HEADS 0x0000u
#endif
__global__ void __launch_bounds__(256, 2) fwd_kernel(P p) {
    __shared__ __attribute__((aligned(16))) float lds[17408];
    __shared__ __attribute__((aligned(16))) unsigned lds_ctl[4];
    if (threadIdx.x < 4) lds_ctl[threadIdx.x] = 0u;
    __syncthreads();
    const XcdBarrier xb = xcd_barrier_post((unsigned*)(p.ws + WS_CTL), (volatile LAS unsigned*)lds_ctl);
#define GRID_BAR() do { xcd_barrier(xb); if (REP_PHASE == 7) xcd_barrier(xb); } while (0)
    volatile LAS unsigned* qslot = (volatile LAS unsigned*)(lds_ctl + 2);
    for (int rep = 0; rep < (REP_PHASE == 1 ? 2 : 1); ++rep) {
        ph_prologue(p, lds);
        ph_convert(p, lds);
        GRID_BAR();
    }
    for (int l = 0; l < DEPTH; ++l) {
        ph_convert_dense(p, l, 0);
        ph_norm1(p, l, l == 0 ? 0 : 1);
        GRID_BAR();
        for (int rep = 0; rep < (REP_PHASE == 2 ? 2 : 1); ++rep) {
            if (rep == 0) ph_convert_dense(p, l, 1);
            ph_inproj_fast(p, l, (unsigned char*)lds);
            GRID_BAR();
        }
        for (int rep = 0; rep < (REP_PHASE == 3 ? 2 : 1); ++rep) {
            ph_mix(p, l, (unsigned char*)lds, qslot, rep);
            GRID_BAR();
        }
        ph_outproj_fast(p, l, (unsigned char*)lds);
        GRID_BAR();
        if (blockIdx.x & 8) { ph_convert_experts(p, l); ph_norm2_router_fast(p, l, (unsigned char*)lds); }
        else { ph_norm2_router_fast(p, l, (unsigned char*)lds); ph_convert_experts(p, l); }
        GRID_BAR();
        for (int rep = 0; rep < (REP_PHASE == 5 ? 2 : 1); ++rep) {
            ph_moe_up_fast(p, l, (unsigned char*)lds);
            GRID_BAR();
        }
        for (int rep = 0; rep < (REP_PHASE == 6 ? 2 : 1); ++rep) {
            ph_moe_down_fast(p, l, (unsigned char*)lds);
            GRID_BAR();
        }
    }
    ph_norm1(p, DEPTH, 2);
}

extern "C" void kernel_launch(void* const* d_in, const int* in_sizes, int n_in,
                              void* d_out, int out_size, void* d_ws, size_t ws_size,
                              hipStream_t stream) {
    static int grid_blocks = 0;
    if (!grid_blocks) {
        int dev = 0, cus = 0, per_cu = 0;
        (void)hipGetDevice(&dev);
        (void)hipDeviceGetAttribute(&cus, hipDeviceAttributeMultiprocessorCount, dev);
        (void)hipOccupancyMaxActiveBlocksPerMultiprocessor(&per_cu, fwd_kernel, 256, 0);
        if (per_cu > 2) per_cu = 2;
        if (per_cu < 1) per_cu = 1;
        grid_blocks = cus * per_cu;
        if (n_in != 24 || ws_size < WS_END || out_size != T * D) { fprintf(stderr, "kernel_launch: unexpected shapes (n_in %d ws %zu out %d)\n", n_in, ws_size, out_size); grid_blocks = -1; }
    }
    if (grid_blocks < 0) return;
    (void)hipMemsetAsync(d_ws, 0, CTL_BYTES, stream);
    P p{};
    const float** pp = (const float**)&p;
    for (int i = 0; i < 24; ++i) pp[i] = (const float*)d_in[i];
    p.out = (float*)d_out; p.ws = (unsigned char*)d_ws;
    void* args[] = {&p};
    hipError_t e = hipLaunchCooperativeKernel((void*)fwd_kernel, dim3(grid_blocks), dim3(256), args, 0, stream);
    if (e != hipSuccess) fprintf(stderr, "cooperative launch failed: %s (grid %d)\n", hipGetErrorString(e), grid_blocks);
}
```

```cpp
#include <hip/hip_runtime.h>
#include <hip/hip_cooperative_groups.h>
#include <cstdio>
#include <cstdint>

#define LAS __attribute__((address_space(3)))
#define DEV __device__ __forceinline__

constexpr int T = 16384, S = 2048, NB = 8, D = 1024, DIN = 2844, NP = 2880, DEPTH = 4;
constexpr int NCMP = 127;
constexpr float EPS = 1e-6f;
constexpr float SCALE = 0.125f;
constexpr int C_QA = 0, C_KC = 512, C_VC = 640, C_KS = 768, C_VS = 896, C_KW = 1024, C_VW = 1152;
constexpr int C_QB = 1280, C_KB = 1536, C_VB = 1792, C_QC = 2048, C_KCC = 2304, C_VCC = 2560;

constexpr size_t MiB = 1u << 20;
constexpr size_t WS_CTL = 0, CTL_BYTES = 64 * 1024;
constexpr size_t WS_MOD = 1 * MiB, WS_ROPE = 2 * MiB, WS_CUMF = 3 * MiB, WS_CK = 4 * MiB, WS_CV = 5 * MiB, WS_IMP = 6 * MiB;
constexpr size_t WS_SEL = 10 * MiB, WS_EID = 11 * MiB, WS_WTS = 12 * MiB, WS_LIST = 13 * MiB, WS_GF = 16 * MiB;
constexpr size_t WS_H = 32 * MiB, WS_U = 64 * MiB, WS_O = 160 * MiB, WS_HID = 192 * MiB, WS_Y = 224 * MiB, WS_OB = 352 * MiB, WS_ORAW = 448 * MiB;
constexpr size_t WS_END = 973 * MiB;
constexpr size_t WS_VT = 936 * MiB;
constexpr size_t WS_CVT = 962 * MiB;
constexpr size_t WS_CUMF2 = 963 * MiB;
constexpr int CW_Q = 8192 + 256;
constexpr size_t WS_CW1 = 964 * MiB;
constexpr size_t WS_CW2 = 968 * MiB;
constexpr size_t WS_CPB = 969 * MiB;
constexpr size_t WS_LSF = 970 * MiB;
constexpr size_t WS_WR = 971 * MiB;
constexpr int CW_CNT = 8192;

typedef unsigned short bf16_t;
typedef float f32x4v __attribute__((ext_vector_type(4)));
DEV int vt_row(int n) { return n < 1024 ? n - 896 : (n < 1280 ? 128 + n - 1152 : (n < 2048 ? 256 + n - 1792 : 512 + n - 2560)); }
DEV bool is_vcol(int n) { return (n >= C_VS && n < C_KW) || (n >= C_VW && n < C_QB) || (n >= C_VB && n < C_QC) || (n >= C_VCC && n < 2816); }
DEV float bf2f(bf16_t v) { return __uint_as_float((unsigned)v << 16); }
DEV bf16_t f2bf(float f) { unsigned u = __float_as_uint(f); return (bf16_t)((u + 0x7fffu + ((u >> 16) & 1u)) >> 16); }
DEV float4 ld_bf4(const bf16_t* p) { const ushort4 u = *(const ushort4*)p; return make_float4(bf2f(u.x), bf2f(u.y), bf2f(u.z), bf2f(u.w)); }
typedef float f32x2_t __attribute__((ext_vector_type(2)));
typedef __bf16 bf16x2_t __attribute__((ext_vector_type(2)));
DEV unsigned cvtpk(float lo, float hi) { f32x2_t v = {lo, hi}; bf16x2_t b = __builtin_convertvector(v, bf16x2_t); return __builtin_bit_cast(unsigned, b); }
DEV float sigmoidf_(float x) { return 1.f / (1.f + expf(-x)); }
DEV float logsigmoidf_(float x) { return fminf(x, 0.f) - log1pf(expf(-fabsf(x))); }
DEV float wave_sum(float v) {
#pragma unroll
    for (int o = 1; o < 64; o <<= 1) v += __shfl_xor(v, o);
    return v;
}

#define XB_TMO      128
#define XB_XCNT(j)  (256  + 64 * (j))
#define XB_XSUB(j)  (1280 + 64 * (j))
#define XB_XGEN(j)  (2304 + 64 * (j))
#define XB_TOP      3328
#define XB_TOPGEN   3392
#define XCD_BAR_WORDS 3456
#define XB_SPIN_CAP (1u << 23)
DEV unsigned xb_ld(unsigned* p)              { return __hip_atomic_load(p, __ATOMIC_RELAXED, __HIP_MEMORY_SCOPE_AGENT); }
DEV unsigned xb_add(unsigned* p, unsigned v) { return __hip_atomic_fetch_add(p, v, __ATOMIC_RELAXED, __HIP_MEMORY_SCOPE_AGENT); }
DEV unsigned xb_xcc_id() { return (unsigned)__builtin_amdgcn_s_getreg((3 << 11) | 20) & 0xFu; }
#define XB_SPIN(cond, bar) do { unsigned _sp = 0; while (cond) { __builtin_amdgcn_s_sleep(1); \
    if ((++_sp & 255u) == 0u) { if (xb_ld(&(bar)[XB_TMO])) break; if (_sp > XB_SPIN_CAP) { atomicAdd(&(bar)[XB_TMO], 1u); break; } } } } while (0)
struct XcdBarrier { unsigned* bar; unsigned x; volatile LAS unsigned* st; };
DEV XcdBarrier xcd_barrier_post(unsigned* bar, volatile LAS unsigned* st) {
    XcdBarrier b; b.bar = bar; b.x = xb_xcc_id(); b.st = st;
    if (threadIdx.x == 0) (void)xb_add(&bar[XB_XCNT(b.x)], 1u);
    return b;
}
DEV void xcd_barrier_complete(unsigned* bar, unsigned x, unsigned& nloc, unsigned& nx) {
    const unsigned G = gridDim.x * gridDim.y * gridDim.z;
    unsigned sum, cnt, mine, sp = 0u;
    for (;;) {
        sum = 0u; cnt = 0u; mine = 0u;
#pragma unroll
        for (unsigned j = 0; j < 16; ++j) { const unsigned c = xb_ld(&bar[XB_XCNT(j)]); sum += c; cnt += (c > 0u) ? 1u : 0u; mine = (j == x) ? c : mine; }
        if (sum == G) break;
        __builtin_amdgcn_s_sleep(1);
        if ((++sp & 255u) == 0u) { if (xb_ld(&bar[XB_TMO])) break; if (sp > XB_SPIN_CAP) { atomicAdd(&bar[XB_TMO], 1u); break; } }
    }
    nloc = mine > 0u ? mine : 1u; nx = cnt > 0u ? cnt : 1u;
}
DEV void xcd_barrier(const XcdBarrier& b) {
    asm volatile("s_waitcnt vmcnt(0)" ::: "memory");
    __syncthreads();
    if (threadIdx.x == 0) {
        unsigned* bar = b.bar;
        __builtin_amdgcn_s_waitcnt(0);
        unsigned nloc = b.st[0], nx = b.st[1];
        if (nloc == 0u) { xcd_barrier_complete(bar, b.x, nloc, nx); b.st[0] = nloc; b.st[1] = nx; }
        const unsigned old = xb_add(&bar[XB_XSUB(b.x)], 1u);
        const unsigned gen = old / nloc;
        if (old + 1u == (gen + 1u) * nloc) {
            __builtin_amdgcn_fence(__ATOMIC_RELEASE, "agent");
            asm volatile("s_waitcnt vmcnt(0)" ::: "memory");
            const unsigned og = xb_add(&bar[XB_TOP], 1u);
            const unsigned tg = og / nx;
            if (og + 1u == (tg + 1u) * nx) xb_add(&bar[XB_TOPGEN], 1u);
            else XB_SPIN(xb_ld(&bar[XB_TOPGEN]) == tg, bar);
            __builtin_amdgcn_fence(__ATOMIC_ACQUIRE, "agent");
            xb_add(&bar[XB_XGEN(b.x)], 1u);
            asm volatile("s_waitcnt vmcnt(0)" ::: "memory");
        } else {
            XB_SPIN(xb_ld(&bar[XB_XGEN(b.x)]) == gen, bar);
            __builtin_amdgcn_fence(__ATOMIC_ACQUIRE, "agent");
            asm volatile("s_waitcnt vmcnt(0)" ::: "memory");
        }
    }
    __syncthreads();
}

struct P {
    const float *x, *c, *norm1_g, *norm2_g, *ada_w, *ada_b, *w_in, *b_forget, *cmp_pos_k, *cmp_w1_k, *cmp_w2_k,
        *cmp_pos_v, *cmp_w1_v, *cmp_w2_v, *out_norm_g, *w_out, *rg_w, *rg_b, *re_w, *re_b, *e_w1, *e_w3, *e_w2, *final_g;
    float* out; unsigned char* ws;
};
struct V {
    unsigned* ctl; float* mod; float* rcos; float* rsin; float* cumf; bf16_t* ck; bf16_t* cv; float* imp; unsigned* sel;
    int* eid; float* wts; int* list; float* gf; bf16_t* H; bf16_t* U; bf16_t* O; bf16_t* HID; bf16_t* Y; float* OB; float* ORAW; float* X;
};
DEV int otid() { int t = threadIdx.x; asm volatile("" : "+v"(t)); return t; }
DEV int obid() { int t = blockIdx.x; asm volatile("" : "+s"(t)); return t; }
DEV V make_views(const P& p) {
    V v; size_t woff = 0; asm volatile("" : "+s"(woff)); unsigned char* w = p.ws + woff;
    v.ctl = (unsigned*)(w + WS_CTL); v.mod = (float*)(w + WS_MOD); v.rcos = (float*)(w + WS_ROPE); v.rsin = v.rcos + S * 8;
    v.cumf = (float*)(w + WS_CUMF); v.ck = (bf16_t*)(w + WS_CK); v.cv = (bf16_t*)(w + WS_CV); v.imp = (float*)(w + WS_IMP);
    v.sel = (unsigned*)(w + WS_SEL); v.eid = (int*)(w + WS_EID); v.wts = (float*)(w + WS_WTS); v.list = (int*)(w + WS_LIST);
    v.gf = (float*)(w + WS_GF); v.H = (bf16_t*)(w + WS_H); v.U = (bf16_t*)(w + WS_U); v.O = (bf16_t*)(w + WS_O);
    v.HID = (bf16_t*)(w + WS_HID); v.Y = (bf16_t*)(w + WS_Y); v.OB = (float*)(w + WS_OB); v.ORAW = (float*)(w + WS_ORAW); v.X = p.out;
    return v;
}

DEV void ph_prologue(const P& p, float* lds) {
    const V v = make_views(p); const int TIDX = otid(), BIDX = obid();
    const int tid = TIDX;
    for (int i = tid; i < NB * D; i += 256) { const float c = p.c[i]; lds[i] = c / (1.f + expf(-c)); }
    __syncthreads();
    float* red = lds + NB * D;
    const int c4 = tid & 15, ks = tid >> 4;
    for (int unit = BIDX; unit < DEPTH * 96; unit += gridDim.x) {
        const int l = unit / 96, n0 = (unit % 96) * 64;
        const float* W = p.ada_w + (size_t)l * D * 6144 + n0 + 4 * c4;
        float acc[8][4];
#pragma unroll
        for (int b = 0; b < 8; ++b)
#pragma unroll
            for (int q = 0; q < 4; ++q) acc[b][q] = 0.f;
#pragma unroll 1
        for (int i0 = 0; i0 < 64; i0 += 8) {
            f32x4v w[8];
#pragma unroll
            for (int i = 0; i < 8; ++i) w[i] = __builtin_nontemporal_load((const f32x4v*)(W + (size_t)(ks + 16 * (i0 + i)) * 6144));
#pragma unroll
            for (int i = 0; i < 8; ++i) {
                const int k = ks + 16 * (i0 + i);
#pragma unroll
                for (int b = 0; b < 8; ++b) {
                    const float cv = lds[b * D + k];
                    acc[b][0] += cv * w[i].x; acc[b][1] += cv * w[i].y; acc[b][2] += cv * w[i].z; acc[b][3] += cv * w[i].w;
                }
            }
        }
#pragma unroll
        for (int b = 0; b < 8; ++b) *(float4*)(red + (ks * 8 + b) * 64 + 4 * c4) = make_float4(acc[b][0], acc[b][1], acc[b][2], acc[b][3]);
        __syncthreads();
        for (int o = tid; o < 512; o += 256) {
            const int c2 = o & 63, b = o >> 6;
            float sm = p.ada_b[l * 6144 + n0 + c2];
#pragma unroll
            for (int q = 0; q < 16; ++q) sm += red[(q * 8 + b) * 64 + c2];
            v.mod[(size_t)(l * 8 + b) * 6144 + n0 + c2] = sm;
        }
        __syncthreads();
    }
    const float cst = -2.0f * 13.122363377404328f / 16.0f;
    for (int i = BIDX * 256 + tid; i < S * 8; i += gridDim.x * 256) {
        const int s = i >> 3, j = i & 7;
        const float inv = expf((float)j * cst);
        const float ang = (float)s * inv;
        v.rcos[i] = cosf(ang); v.rsin[i] = sinf(ang);
    }
}

DEV void ph_norm1(const P& p, int l, int mode) {
    const V v = make_views(p); const int TIDX = otid(), BIDX = obid();
    const int lane = TIDX & 63;
    const int gw = (BIDX * 256 + TIDX) >> 6, nw = gridDim.x * 4;
    for (int m0 = gw; m0 < T; m0 += 2 * nw) {
        float4 xv[2][4];
        if (mode == 0) {
#pragma unroll
            for (int rr = 0; rr < 2; ++rr)
#pragma unroll
                for (int j = 0; j < 4; ++j) xv[rr][j] = *(const float4*)(p.x + (size_t)(m0 + rr * nw) * D + 4 * lane + 256 * j);
        } else {
            float4 xa[2][4]; ushort4 ya[2][4], yb[2][4];
#pragma unroll
            for (int rr = 0; rr < 2; ++rr)
#pragma unroll
                for (int j = 0; j < 4; ++j) {
                    const int m = m0 + rr * nw, c = 4 * lane + 256 * j;
                    xa[rr][j] = *(const float4*)(v.X + (size_t)m * D + c);
                    ya[rr][j] = *(const ushort4*)(v.Y + (size_t)(2 * m) * D + c); yb[rr][j] = *(const ushort4*)(v.Y + (size_t)(2 * m + 1) * D + c);
                }
#pragma unroll
            for (int rr = 0; rr < 2; ++rr) {
                const float* g2 = v.mod + (size_t)((l - 1) * 8 + ((m0 + rr * nw) >> 11)) * 6144 + 5 * D;
#pragma unroll
                for (int j = 0; j < 4; ++j) {
                    const float4 g = *(const float4*)(g2 + 4 * lane + 256 * j);
                    float4 a = xa[rr][j];
                    a.x += g.x * (bf2f(ya[rr][j].x) + bf2f(yb[rr][j].x)); a.y += g.y * (bf2f(ya[rr][j].y) + bf2f(yb[rr][j].y));
                    a.z += g.z * (bf2f(ya[rr][j].z) + bf2f(yb[rr][j].z)); a.w += g.w * (bf2f(ya[rr][j].w) + bf2f(yb[rr][j].w));
                    xv[rr][j] = a;
                }
            }
        }
        float ss[2];
#pragma unroll
        for (int rr = 0; rr < 2; ++rr) {
            ss[rr] = 0.f;
#pragma unroll
            for (int j = 0; j < 4; ++j) ss[rr] += xv[rr][j].x * xv[rr][j].x + xv[rr][j].y * xv[rr][j].y + xv[rr][j].z * xv[rr][j].z + xv[rr][j].w * xv[rr][j].w;
        }
#pragma unroll
        for (int o = 1; o < 64; o <<= 1) { ss[0] += __shfl_xor(ss[0], o); ss[1] += __shfl_xor(ss[1], o); }
#pragma unroll
        for (int rr = 0; rr < 2; ++rr) {
            const int m = m0 + rr * nw, b = m >> 11;
            const float r = rsqrtf(ss[rr] * (1.f / D) + EPS);
            if (mode == 2) {
#pragma unroll
                for (int j = 0; j < 4; ++j) {
                    const int c = 4 * lane + 256 * j;
                    const float4 g = *(const float4*)(p.final_g + c);
                    float4 o; o.x = xv[rr][j].x * r * g.x; o.y = xv[rr][j].y * r * g.y; o.z = xv[rr][j].z * r * g.z; o.w = xv[rr][j].w * r * g.w;
                    *(float4*)(v.X + (size_t)m * D + c) = o;
                }
            } else {
                const float* md = v.mod + (size_t)(l * 8 + b) * 6144;
#pragma unroll
                for (int j = 0; j < 4; ++j) {
                    const int c = 4 * lane + 256 * j;
                    *(float4*)(v.X + (size_t)m * D + c) = xv[rr][j];
                    const float4 g = *(const float4*)(p.norm1_g + l * D + c), sh = *(const float4*)(md + c), sc = *(const float4*)(md + D + c);
                    uint2 o;
                    o.x = cvtpk(xv[rr][j].x * r * g.x * (1.f + sc.x) + sh.x, xv[rr][j].y * r * g.y * (1.f + sc.y) + sh.y);
                    o.y = cvtpk(xv[rr][j].z * r * g.z * (1.f + sc.z) + sh.z, xv[rr][j].w * r * g.w * (1.f + sc.w) + sh.w);
                    *(uint2*)(v.H + (size_t)m * D + c) = o;
                }
            }
        }
    }
}

typedef short bf16x8 __attribute__((ext_vector_type(8)));
typedef float f32x16 __attribute__((ext_vector_type(16)));
typedef unsigned u32x4 __attribute__((ext_vector_type(4)));
constexpr size_t WS_WIN = 512 * MiB, WS_WOT = 544 * MiB, WS_W13 = 552 * MiB, WS_W2 = 808 * MiB;
constexpr int NPW = 2944;
DEV int tile_off(int row, int chunk) { return row * 128 + ((chunk ^ ((row >> 1) & 7)) << 4); }
template <class RM>
DEV void conv_patch(const float* src, int N, int K, bf16_t* dst, int k0, int n0, RM rowmap, int lane) {
    const int kg = lane >> 3, n = n0 + 4 * (lane & 7);
    if (n >= N) return;
    const float* sp = src + (size_t)(k0 + 8 * kg) * N + n;
    f32x4v x[8];
#pragma unroll
    for (int j = 0; j < 8; ++j) x[j] = __builtin_nontemporal_load((const f32x4v*)(sp + (size_t)j * N));
    bf16_t* dp = dst + k0 + 8 * kg;
    u32x4 o;
    o.x = cvtpk(x[0].x, x[1].x); o.y = cvtpk(x[2].x, x[3].x); o.z = cvtpk(x[4].x, x[5].x); o.w = cvtpk(x[6].x, x[7].x);
    *(u32x4*)(dp + (size_t)rowmap(n) * K) = o;
    o.x = cvtpk(x[0].y, x[1].y); o.y = cvtpk(x[2].y, x[3].y); o.z = cvtpk(x[4].y, x[5].y); o.w = cvtpk(x[6].y, x[7].y);
    *(u32x4*)(dp + (size_t)rowmap(n + 1) * K) = o;
    o.x = cvtpk(x[0].z, x[1].z); o.y = cvtpk(x[2].z, x[3].z); o.z = cvtpk(x[4].z, x[5].z); o.w = cvtpk(x[6].z, x[7].z);
    *(u32x4*)(dp + (size_t)rowmap(n + 2) * K) = o;
    o.x = cvtpk(x[0].w, x[1].w); o.y = cvtpk(x[2].w, x[3].w); o.z = cvtpk(x[4].w, x[5].w); o.w = cvtpk(x[6].w, x[7].w);
    *(u32x4*)(dp + (size_t)rowmap(n + 3) * K) = o;
}

DEV void conv8(const float* s0, const float* s1, bf16_t* dst) {
    f32x4v a = {0.f, 0.f, 0.f, 0.f}, b = {0.f, 0.f, 0.f, 0.f};
    if (s0) a = __builtin_nontemporal_load((const f32x4v*)s0);
    if (s1) b = __builtin_nontemporal_load((const f32x4v*)s1);
    u32x4 o; o.x = cvtpk(a[0], a[1]); o.y = cvtpk(a[2], a[3]); o.z = cvtpk(b[0], b[1]); o.w = cvtpk(b[2], b[3]);
    *(u32x4*)dst = o;
}
DEV void ph_convert_dense(const P& p, int l, int which) {
    const int TIDX = otid(), BIDX = obid();
    size_t woff = 0; asm volatile("" : "+s"(woff)); unsigned char* w = p.ws + woff;
    const size_t gtid = (size_t)BIDX * 256 + TIDX, gsz = (size_t)gridDim.x * 256;
    if (which == 0) {
        bf16_t* win = (bf16_t*)(w + WS_WIN);
        for (size_t i = gtid; i < (size_t)D * 368; i += gsz) {
            const int g8 = (int)(i % 368); const size_t lk = (size_t)l * D + i / 368;
            const int n = g8 * 8;
            const float* row = p.w_in + lk * DIN;
            const float *s0, *s1;
            if (n < 2816) { const int oc = n + (n >= 2048 ? 28 : (n >= 1280 ? 24 : 0)); s0 = row + oc; s1 = row + oc + 4; }
            else if (n < 2840) { s0 = row + 1280 + (n - 2816); s1 = s0 + 4; }
            else if (n == 2840) { s0 = row + 2072; s1 = nullptr; }
            else { s0 = nullptr; s1 = nullptr; }
            conv8(s0, s1, win + lk * NPW + n);
        }
    } else {
        bf16_t* wot = (bf16_t*)(w + WS_WOT);
        const size_t oo = (size_t)l * D * D;
        for (size_t i = gtid; i < (size_t)D * D / 8; i += gsz) conv8(p.w_out + oo + i * 8, p.w_out + oo + i * 8 + 4, wot + oo + i * 8);
        for (size_t i = gtid; i < (size_t)2 * 2048 * 128 / 8; i += gsz) {
            const size_t per = (size_t)2048 * 128 / 8; const int kv = (int)(i / per), lk = l * 2 + kv; const size_t off = (i % per) * 8;
            const float* src = (kv ? p.cmp_w1_v : p.cmp_w1_k) + (size_t)l * 2048 * 128 + off;
            conv8(src, src + 4, (bf16_t*)(w + WS_CW1) + (size_t)lk * 2048 * 128 + off);
        }
    }
}
DEV void ph_convert_experts(const P& p, int l) {
    const int TIDX = otid(), BIDX = obid();
    size_t woff = 0; asm volatile("" : "+s"(woff)); unsigned char* w = p.ws + woff;
    bf16_t* w13 = (bf16_t*)(w + WS_W13); bf16_t* w2t = (bf16_t*)(w + WS_W2);
    const size_t gtid = (size_t)BIDX * 256 + TIDX, gsz = (size_t)gridDim.x * 256;
    for (size_t i = gtid; i < (size_t)32 * D * 128; i += gsz) {
        const int g8 = (int)(i & 127); const size_t lek = (size_t)l * 32 * D + (i >> 7);
        const int n = g8 * 8, which = (n >> 5) & 1, c = 32 * (n >> 6) + (n & 31);
        const float* src = (which ? p.e_w3 : p.e_w1) + lek * 512 + c;
        conv8(src, src + 4, w13 + lek * 1024 + n);
    }
    const size_t o2 = (size_t)l * 32 * 512 * D;
    for (size_t i = gtid; i < (size_t)32 * 512 * D / 8; i += gsz) conv8(p.e_w2 + o2 + i * 8, p.e_w2 + o2 + i * 8 + 4, w2t + o2 + i * 8);
}
DEV void ph_convert(const P& p, float* lds) {
    const int TIDX = otid(), BIDX = obid();
    size_t woff = 0; asm volatile("" : "+s"(woff)); unsigned char* w = p.ws + woff;
    const int lane = TIDX & 63;
    for (int unit = BIDX * 4 + (TIDX >> 6); unit < DEPTH * 2 * 4; unit += gridDim.x * 4) {
        const int lk = unit >> 2, t = unit & 3, l = lk >> 1, kv = lk & 1;
        conv_patch((kv ? p.cmp_w2_v : p.cmp_w2_k) + (size_t)l * 128 * 64, 64, 128, (bf16_t*)(w + WS_CW2) + (size_t)lk * 64 * 128, (t >> 1) * 64, (t & 1) * 32, [](int n) { return n; }, lane);
    }
    for (int o = BIDX * 256 + TIDX; o < DEPTH * 64 * D; o += gridDim.x * 256) {
        const int k = o & (D - 1), n = (o >> 10) & 63, l = o >> 16;
        const float val = n < 4 ? p.rg_w[((size_t)l * D + k) * 4 + n] : (n < 36 ? p.re_w[((size_t)l * D + k) * 32 + n - 4] : 0.f);
        const bf16_t hi = f2bf(val); const bf16_t lo = f2bf(val - bf2f(hi));
        bf16_t* wr = (bf16_t*)(w + WS_WR) + (size_t)l * 2 * 64 * D;
        wr[n * D + k] = hi; wr[64 * D + n * D + k] = lo;
    }
    for (int unit = BIDX; unit < DEPTH * 2 * 8; unit += gridDim.x) {
        const int lk = unit >> 3, ch = unit & 7, l = lk >> 1, kv = lk & 1, j = TIDX & 127, hf = TIDX >> 7;
        const float* pe = (kv ? p.cmp_pos_v : p.cmp_pos_k) + (size_t)l * 2048 + ch * 256 + hf * 128;
        const float* w1 = (kv ? p.cmp_w1_v : p.cmp_w1_k) + (size_t)l * 2048 * 128 + (size_t)(ch * 256 + hf * 128) * 128 + j;
        float a0 = 0.f, a1 = 0.f, a2 = 0.f, a3 = 0.f;
#pragma unroll 4
        for (int k = 0; k < 128; k += 4) {
            a0 += pe[k] * w1[(size_t)k * 128]; a1 += pe[k + 1] * w1[(size_t)(k + 1) * 128];
            a2 += pe[k + 2] * w1[(size_t)(k + 2) * 128]; a3 += pe[k + 3] * w1[(size_t)(k + 3) * 128];
        }
        const float a = (a0 + a1) + (a2 + a3);
        __syncthreads();
        if (hf) lds[j] = a;
        __syncthreads();
        if (!hf) ((float*)(w + WS_CPB))[(lk * 8 + ch) * 128 + j] = a + lds[j];
    }
}

typedef short v4i16_t __attribute__((ext_vector_type(4)));
DEV void gemm_issue0(unsigned char* lds, const bf16_t* const (&arow)[4], const bf16_t* Bsrc, const size_t ldb, const int TIDX) {
    const int lane = TIDX & 63, wave = TIDX >> 6;
    const int gsw = ((TIDX & 7) ^ ((TIDX >> 4) & 7)) * 8;
    const bf16_t* bg = Bsrc + (size_t)(4 * wave + (lane >> 4)) * ldb + ((lane & 15) ^ (((lane >> 4) << 2) | (wave & 3))) * 8;
    LAS unsigned char* l3 = (LAS unsigned char*)lds + __builtin_amdgcn_readfirstlane(wave) * 1024;
#pragma unroll
    for (int i = 0; i < 4; ++i) {
        __builtin_amdgcn_global_load_lds((const unsigned*)(arow[i] + gsw), (LAS unsigned*)(l3 + i * 4096), 16, 0, 0);
        __builtin_amdgcn_global_load_lds((const unsigned*)(bg + (size_t)(16 * i) * ldb), (LAS unsigned*)(l3 + 16384 + i * 4096), 16, 0, 0);
    }
}
template <bool SWAP, bool PRE = false>
DEV void gemm128(unsigned char* lds, const bf16_t* const (&arow)[4], const bf16_t* Bsrc, const size_t ldb, int K, f32x16 (&acc)[2][2], const int TIDX, const int astride = 64) {
    const int lane = TIDX & 63, wave = TIDX >> 6, wm = wave >> 1, wn = wave & 1, r = lane & 31, h = lane >> 5;
#pragma unroll
    for (int j = 0; j < 2; ++j)
#pragma unroll
        for (int i = 0; i < 2; ++i)
#pragma unroll
            for (int q = 0; q < 16; ++q) acc[j][i][q] = 0.f;
    const int gsw = ((TIDX & 7) ^ ((TIDX >> 4) & 7)) * 8;
    const bf16_t* ag[4];
#pragma unroll
    for (int i = 0; i < 4; ++i) ag[i] = arow[i] + gsw;
    const int brow = 4 * wave + (lane >> 4), bch = ((lane & 15) ^ (((lane >> 4) << 2) | (wave & 3))) * 8;
    const bf16_t* bg = Bsrc + (size_t)brow * ldb + bch;
    LAS unsigned char* l3 = (LAS unsigned char*)lds + __builtin_amdgcn_readfirstlane(wave) * 1024;
    LAS unsigned char* tb[2][2];
    {
        const int blk = (lane >> 4) & 1, q = (lane & 15) >> 2, pp = lane & 3;
#pragma unroll
        for (int j = 0; j < 2; ++j)
#pragma unroll
            for (int t = 0; t < 2; ++t) {
                const int row = 4 * t + 8 * h + q, ch = 4 * (2 * wn + j) + 2 * blk + (pp >> 1);
                tb[j][t] = (LAS unsigned char*)lds + 16384 + 256 * row + 16 * (ch ^ (((row & 3) << 2) | ((row >> 2) & 3))) + 8 * (pp & 1);
            }
    }
#define G_DMA(st_, kt_) do { _Pragma("unroll") for (int i = 0; i < 4; ++i) { \
        __builtin_amdgcn_global_load_lds((const unsigned*)(ag[i] + (size_t)(kt_) * astride), (LAS unsigned*)(l3 + (st_) + i * 4096), 16, 0, 0); \
        __builtin_amdgcn_global_load_lds((const unsigned*)(bg + ((size_t)(kt_) * 64 + 16 * i) * ldb), (LAS unsigned*)(l3 + (st_) + 16384 + i * 4096), 16, 0, 0); } } while (0)
    const int KT = K >> 6;
    if (!PRE) {
        __syncthreads();
        G_DMA(0, 0);
    }
    for (int kt = 0; kt < KT; ++kt) {
        asm volatile("s_waitcnt vmcnt(0) lgkmcnt(0)" ::: "memory");
        __builtin_amdgcn_s_barrier();
        asm volatile("" ::: "memory");
        if (kt + 1 < KT) G_DMA(((kt + 1) & 1) * 32768, kt + 1);
        const int so = (kt & 1) * 32768;
        const unsigned char* cur = lds + so;
#pragma unroll
        for (int kk = 0; kk < 4; ++kk) {
            bf16x8 af[2], wf[2];
#pragma unroll
            for (int i = 0; i < 2; ++i) af[i] = *(const bf16x8*)(cur + tile_off(64 * wm + 32 * i + r, 2 * kk + h));
#pragma unroll
            for (int j = 0; j < 2; ++j) {
                const v4i16_t lo = __builtin_amdgcn_ds_read_tr16_b64_v4i16((LAS v4i16_t*)(tb[j][0] + so + 4096 * kk));
                const v4i16_t hi = __builtin_amdgcn_ds_read_tr16_b64_v4i16((LAS v4i16_t*)(tb[j][1] + so + 4096 * kk));
                wf[j] = (bf16x8){lo[0], lo[1], lo[2], lo[3], hi[0], hi[1], hi[2], hi[3]};
            }
#pragma unroll
            for (int j = 0; j < 2; ++j)
#pragma unroll
                for (int i = 0; i < 2; ++i) acc[j][i] = SWAP ? __builtin_amdgcn_mfma_f32_32x32x16_bf16(af[i], wf[j], acc[j][i], 0, 0, 0)
                                                             : __builtin_amdgcn_mfma_f32_32x32x16_bf16(wf[j], af[i], acc[j][i], 0, 0, 0);
        }
    }
    __syncthreads();
#undef G_DMA
}

constexpr int CST = 272;
DEV void ctile_put(unsigned char* lds, int row, int col, float a, float b, float c, float d) {
    uint2 u; u.x = cvtpk(a, b); u.y = cvtpk(c, d);
    *(uint2*)(lds + row * CST + col * 2) = u;
}
template <int COLS, class RP>
DEV void ctile_flush(unsigned char* lds, const int TIDX, RP rowptr) {
    asm volatile("s_waitcnt lgkmcnt(0)" ::: "memory");
    __builtin_amdgcn_s_barrier();
    asm volatile("" ::: "memory");
    constexpr int CPR = COLS / 8, RPI = 256 / CPR;
#pragma unroll
    for (int it = 0; it < 128 / RPI; ++it) {
        const int row = it * RPI + TIDX / CPR, c16 = TIDX % CPR;
        bf16_t* dst = rowptr(row, it);
        const u32x4 val = *(const u32x4*)(lds + row * CST + c16 * 16);
        if (dst) *(u32x4*)(dst + c16 * 8) = val;
    }
}

DEV void ph_inproj_fast(const P& p, int l, unsigned char* lds) {
    const V v = make_views(p); const int TIDX = otid(), BIDX = obid();
    const bf16_t* W = (const bf16_t*)(p.ws + WS_WIN) + (size_t)l * D * NPW;
    const int lane = TIDX & 63, wave = TIDX >> 6, wm = wave >> 1, wn = wave & 1, r = lane & 31, h = lane >> 5;
    const bool xo = gridDim.x == 512;
    unsigned char* ct = lds + 32768;
    auto decode = [&](int it, int& mt, int& nt) -> int {
        if (xo) { if (it >= 6) return -1; const int lb = BIDX >> 3; nt = 8 * (it % 3) + (lb >> 3); mt = 16 * (BIDX & 7) + 8 * (it / 3) + (lb & 7); return nt < 23 ? 1 : 0; }
        const int unit = BIDX + it * (int)gridDim.x; if (unit >= 128 * 23) return -1; nt = unit / 128; mt = unit % 128; return 1;
    };
    auto issue = [&](int mt, int nt) {
        const bf16_t* ar[4];
#pragma unroll
        for (int i = 0; i < 4; ++i) ar[i] = v.H + (size_t)(mt * 128 + (TIDX >> 3) + 32 * i) * D;
        gemm_issue0(lds, ar, W + nt * 128, NPW, TIDX);
    };
    bool pre = false;
    for (int it = 0;; ++it) {
        int nt, mt;
        const int dv = decode(it, mt, nt);
        if (dv < 0) break;
        if (dv == 0) continue;
        const int m0 = mt * 128, n0 = nt * 128;
        const bf16_t* arow[4];
#pragma unroll
        for (int i = 0; i < 4; ++i) arow[i] = v.H + (size_t)(m0 + (TIDX >> 3) + 32 * i) * D;
        if (!pre) { __syncthreads(); issue(mt, nt); pre = true; }
        int itn = it + 1, mtn = 0, ntn = 0, dn;
        while ((dn = decode(itn, mtn, ntn)) == 0) ++itn;
        f32x16 acc[2][2];
        if (is_vcol(n0)) {
            gemm128<true, true>(lds, arow, W + n0, NPW, D, acc, TIDX);
            if (dn > 0) issue(mtn, ntn); else pre = false;
#pragma unroll
            for (int j = 0; j < 2; ++j)
#pragma unroll
                for (int i = 0; i < 2; ++i)
#pragma unroll
                    for (int g = 0; g < 4; ++g)
                        ctile_put(ct, 64 * wn + 32 * j + r, 64 * wm + 32 * i + 8 * g + 4 * h, acc[j][i][4 * g], acc[j][i][4 * g + 1], acc[j][i][4 * g + 2], acc[j][i][4 * g + 3]);
            bf16_t* vt = (bf16_t*)(p.ws + WS_VT) + ((size_t)(m0 >> 11) * 768 + vt_row(n0)) * S + (m0 & (S - 1));
            ctile_flush<128>(ct, TIDX, [&](int row, int) { return vt + (size_t)row * S; });
            continue;
        }
        const bool rope_tile = n0 < 512 || n0 == C_KS || n0 == C_KW;
        f32x4v rcs[2], rsn[2];
        if (rope_tile) {
#pragma unroll
            for (int i = 0; i < 2; ++i) {
                const int sp = (m0 + 64 * wm + 32 * i + r) & (S - 1);
                rcs[i] = *(const f32x4v*)(v.rcos + sp * 8 + 4 * h); rsn[i] = *(const f32x4v*)(v.rsin + sp * 8 + 4 * h);
            }
        }
        gemm128<false, true>(lds, arow, W + n0, NPW, D, acc, TIDX);
        if (dn > 0) issue(mtn, ntn); else pre = false;
        if (n0 == 2816) {
            if (wn == 0) {
#pragma unroll
                for (int i = 0; i < 2; ++i) {
                    const int m = m0 + 64 * wm + 32 * i + r;
#pragma unroll
                    for (int q = 0; q < 16; ++q) {
                        const int cc = (q & 3) + 8 * (q >> 2) + 4 * h;
                        if (cc < 24) v.gf[(size_t)m * 32 + cc] = acc[0][i][q];
                        else if (cc < 28) ((float*)(p.ws + WS_LSF))[(size_t)((m >> 11) * 4 + cc - 24) * S + (m & (S - 1))] = logsigmoidf_(acc[0][i][q] + p.b_forget[l * 4 + cc - 24]);
                    }
                }
            }
            continue;
        }
#pragma unroll
        for (int j = 0; j < 2; ++j) {
            const int nb = n0 + 64 * wn + 32 * j;
            const bool rope = ((nb & 63) == 0) && (nb < 512 || (nb >= C_KS && nb < C_VS) || (nb >= C_KW && nb < C_VW));
#pragma unroll
            for (int i = 0; i < 2; ++i) {
                f32x16 a = acc[j][i];
                if (rope) {
#pragma unroll
                    for (int q = 0; q < 4; ++q) { const float x1 = a[q], x2 = a[q + 4]; a[q] = x1 * rcs[i][q] - x2 * rsn[i][q]; a[q + 4] = x2 * rcs[i][q] + x1 * rsn[i][q]; }
                }
#pragma unroll
                for (int g = 0; g < 4; ++g) ctile_put(ct, 64 * wm + 32 * i + r, 64 * wn + 32 * j + 8 * g + 4 * h, a[4 * g], a[4 * g + 1], a[4 * g + 2], a[4 * g + 3]);
            }
        }
        bf16_t* ub = v.U + (size_t)m0 * NP + n0;
        ctile_flush<128>(ct, TIDX, [&](int row, int) { return ub + (size_t)row * NP; });
    }
}

DEV void ph_outproj_fast(const P& p, int l, unsigned char* lds) {
    const V v = make_views(p); const int TIDX = otid(), BIDX = obid();
    const bf16_t* W = (const bf16_t*)(p.ws + WS_WOT) + (size_t)l * D * D;
    const int lane = TIDX & 63, wave = TIDX >> 6, wm = wave >> 1, wn = wave & 1, r = lane & 31, h = lane >> 5;
    const bool xo = gridDim.x == 512;
    auto decode = [&](int it, int& mt, int& nt) -> bool {
        if (xo) { if (it >= 2) return false; const int lb = BIDX >> 3; nt = lb >> 3; mt = 16 * (BIDX & 7) + 8 * it + (lb & 7); return true; }
        const int unit = BIDX + it * (int)gridDim.x; if (unit >= 128 * 8) return false; nt = unit / 128; mt = unit % 128; return true;
    };
    auto issue = [&](int mt, int nt) {
        const bf16_t* ar[4];
#pragma unroll
        for (int i = 0; i < 4; ++i) ar[i] = v.O + (size_t)(mt * 128 + (TIDX >> 3) + 32 * i) * D;
        gemm_issue0(lds, ar, W + nt * 128, D, TIDX);
    };
    for (int it = 0;; ++it) {
        int nt, mt, ntn = 0, mtn = 0;
        if (!decode(it, mt, nt)) break;
        const bool hasn = decode(it + 1, mtn, ntn);
        const int m0 = mt * 128, n0 = nt * 128;
        const bf16_t* arow[4];
#pragma unroll
        for (int i = 0; i < 4; ++i) arow[i] = v.O + (size_t)(m0 + (TIDX >> 3) + 32 * i) * D;
        if (it == 0) { __syncthreads(); issue(mt, nt); }
        f32x4v xin[2][2][4];
#pragma unroll
        for (int j = 0; j < 2; ++j)
#pragma unroll
            for (int i = 0; i < 2; ++i)
#pragma unroll
                for (int g = 0; g < 4; ++g) xin[j][i][g] = *(const f32x4v*)(v.X + (size_t)(m0 + 64 * wm + 32 * i + r) * D + n0 + 64 * wn + 32 * j + 4 * h + 8 * g);
        f32x16 acc[2][2];
        gemm128<false, true>(lds, arow, W + n0, D, D, acc, TIDX);
        if (hasn) issue(mtn, ntn);
        const float* g1 = v.mod + (size_t)(l * 8 + (m0 >> 11)) * 6144 + 2 * D;
#pragma unroll
        for (int j = 0; j < 2; ++j)
#pragma unroll
            for (int i = 0; i < 2; ++i) {
                const int m = m0 + 64 * wm + 32 * i + r, nb = n0 + 64 * wn + 32 * j + 4 * h;
#pragma unroll
                for (int g = 0; g < 4; ++g) {
                    const float4 gg = *(const float4*)(g1 + nb + 8 * g);
                    f32x4v xo = xin[j][i][g];
                    xo[0] += gg.x * acc[j][i][4 * g]; xo[1] += gg.y * acc[j][i][4 * g + 1]; xo[2] += gg.z * acc[j][i][4 * g + 2]; xo[3] += gg.w * acc[j][i][4 * g + 3];
                    *(f32x4v*)(v.X + (size_t)m * D + nb + 8 * g) = xo;
                }
            }
    }
}

DEV void ph_moe_up_fast(const P& p, int l, unsigned char* lds) {
    const V v = make_views(p); const int TIDX = otid(), BIDX = obid();
    const int lane = TIDX & 63, wave = TIDX >> 6, wm = wave >> 1, wn = wave & 1, r = lane & 31, h = lane >> 5;
    const unsigned* cnt = v.ctl + CW_CNT + l * 32;
    int* tp = (int*)(lds + 67584); int* rb = tp + 40;
    __syncthreads();
    if (TIDX < 64) {
        const int c = TIDX < 32 ? (int)cnt[TIDX] : 0;
        int nu = ((c + 127) >> 7) * 8, cc = c;
#pragma unroll
        for (int o = 1; o < 32; o <<= 1) { const int a = __shfl_up(nu, o), b2 = __shfl_up(cc, o); if ((TIDX & 31) >= o) { nu += a; cc += b2; } }
        if (TIDX < 32) { tp[TIDX + 1] = nu; rb[TIDX + 1] = cc; if (TIDX == 0) { tp[0] = 0; rb[0] = 0; } }
    }
    __syncthreads();
    const int total = tp[32];
    unsigned char* ct = lds + 32768;
    struct UU { int e, base, nt, mt, nrow; const int* lst; const bf16_t* B; const bf16_t* ar[4]; };
    auto setup = [&](int unit, UU& u) {
        int e = 0;
#pragma unroll
        for (int st = 16; st > 0; st >>= 1) if (tp[e + st] <= unit) e += st;
        const int rem = unit - tp[e];
        u.e = e; u.base = rb[e]; u.nt = rem & 7; u.mt = rem >> 3;
        const int ce = rb[e + 1] - u.base;
        u.lst = v.list + (size_t)e * T + u.mt * 128;
        u.nrow = ce - u.mt * 128 < 128 ? ce - u.mt * 128 : 128;
        u.B = (const bf16_t*)(p.ws + WS_W13) + ((size_t)l * 32 + e) * 1024 * D + u.nt * 128;
#pragma unroll
        for (int i = 0; i < 4; ++i) { const int rr = (TIDX >> 3) + 32 * i; u.ar[i] = v.H + (size_t)(u.lst[rr < u.nrow ? rr : 0] >> 1) * D; }
    };
    int unit = BIDX;
    if (unit >= total) return;
    UU cu, nu;
    setup(unit, cu);
    __syncthreads();
    gemm_issue0(lds, cu.ar, cu.B, 1024, TIDX);
    for (;;) {
        const int un = unit + (int)gridDim.x;
        f32x16 acc[2][2];
        gemm128<false, true>(lds, cu.ar, cu.B, 1024, D, acc, TIDX);
        if (un < total) { setup(un, nu); gemm_issue0(lds, nu.ar, nu.B, 1024, TIDX); }
#pragma unroll
        for (int i = 0; i < 2; ++i)
#pragma unroll
            for (int g = 0; g < 4; ++g) {
                float o[4];
#pragma unroll
                for (int q = 0; q < 4; ++q) { const float a1 = acc[0][i][4 * g + q], a3 = acc[1][i][4 * g + q]; o[q] = a1 / (1.f + __expf(-a1)) * a3; }
                ctile_put(ct, 64 * wm + 32 * i + r, 32 * wn + 8 * g + 4 * h, o[0], o[1], o[2], o[3]);
            }
        bf16_t* hb = v.HID + (size_t)(cu.base + cu.mt * 128) * 512 + 64 * cu.nt;
        const int nrow = cu.nrow;
        ctile_flush<64>(ct, TIDX, [&](int row, int) { return row < nrow ? hb + (size_t)row * 512 : (bf16_t*)nullptr; });
        if (un >= total) break;
        unit = un; cu = nu;
    }
}
DEV void ph_moe_down_fast(const P& p, int l, unsigned char* lds) {
    const V v = make_views(p); const int TIDX = otid(), BIDX = obid();
    const int lane = TIDX & 63, wave = TIDX >> 6, wm = wave >> 1, wn = wave & 1, r = lane & 31, h = lane >> 5;
    const unsigned* cnt = v.ctl + CW_CNT + l * 32;
    int* tp = (int*)(lds + 67584); int* rb = tp + 40;
    __syncthreads();
    if (TIDX < 64) {
        const int c = TIDX < 32 ? (int)cnt[TIDX] : 0;
        int nu = ((c + 127) >> 7) * 8, cc = c;
#pragma unroll
        for (int o = 1; o < 32; o <<= 1) { const int a = __shfl_up(nu, o), b2 = __shfl_up(cc, o); if ((TIDX & 31) >= o) { nu += a; cc += b2; } }
        if (TIDX < 32) { tp[TIDX + 1] = nu; rb[TIDX + 1] = cc; if (TIDX == 0) { tp[0] = 0; rb[0] = 0; } }
    }
    __syncthreads();
    const int total = tp[32];
    unsigned char* ct = lds + 32768;
    struct UD { int n0, nrow; const bf16_t* B; const bf16_t* ar[4]; float wrow[2]; int fslot[8]; };
    auto setup = [&](int unit, UD& u) {
        int e = 0;
#pragma unroll
        for (int st = 16; st > 0; st >>= 1) if (tp[e + st] <= unit) e += st;
        const int rem = unit - tp[e], base = rb[e];
        const int ce = rb[e + 1] - base, nt = rem & 7, mt = rem >> 3;
        const int* lst = v.list + (size_t)e * T + mt * 128;
        u.n0 = nt * 128;
        u.nrow = ce - mt * 128 < 128 ? ce - mt * 128 : 128;
        u.B = (const bf16_t*)(p.ws + WS_W2) + ((size_t)l * 32 + e) * 512 * D + u.n0;
#pragma unroll
        for (int i = 0; i < 4; ++i) { const int rr = (TIDX >> 3) + 32 * i; u.ar[i] = v.HID + (size_t)(base + mt * 128 + (rr < u.nrow ? rr : 0)) * 512; }
#pragma unroll
        for (int i = 0; i < 2; ++i) { const int mr = 64 * wm + 32 * i + r; u.wrow[i] = mr < u.nrow ? v.wts[lst[mr]] : 0.f; }
#pragma unroll
        for (int it = 0; it < 8; ++it) { const int row = it * 16 + (TIDX >> 4); u.fslot[it] = row < u.nrow ? lst[row] : -1; }
    };
    int unit = BIDX;
    if (unit >= total) return;
    UD cu, nu;
    setup(unit, cu);
    __syncthreads();
    gemm_issue0(lds, cu.ar, cu.B, D, TIDX);
    for (;;) {
        const int un = unit + (int)gridDim.x;
        f32x16 acc[2][2];
        gemm128<false, true>(lds, cu.ar, cu.B, D, 512, acc, TIDX);
        if (un < total) { setup(un, nu); gemm_issue0(lds, nu.ar, nu.B, D, TIDX); }
#pragma unroll
        for (int i = 0; i < 2; ++i) {
            const int mr = 64 * wm + 32 * i + r;
            const float w = cu.wrow[i];
#pragma unroll
            for (int j = 0; j < 2; ++j)
#pragma unroll
                for (int g = 0; g < 4; ++g)
                    ctile_put(ct, mr, 64 * wn + 32 * j + 8 * g + 4 * h, w * acc[j][i][4 * g], w * acc[j][i][4 * g + 1], w * acc[j][i][4 * g + 2], w * acc[j][i][4 * g + 3]);
        }
        const int n0 = cu.n0;
        ctile_flush<128>(ct, TIDX, [&](int, int it) { const int sl = cu.fslot[it]; return sl >= 0 ? v.Y + (size_t)sl * D + n0 : (bf16_t*)nullptr; });
        if (un >= total) break;
        unit = un; cu = nu;
    }
}

constexpr float LOG2E = 1.4426950408889634f, C2 = 0.125f * 1.4426950408889634f, LN2 = 0.6931471805599453f;
DEV float fexp2(float x) { return __builtin_amdgcn_exp2f(x); }
DEV float flog2(float x) { return __builtin_amdgcn_logf(x); }
DEV int swap23(int r) { return (r & ~12) | ((r & 4) << 1) | ((r & 8) >> 1); }

struct KVT { const bf16_t* k; int ks; const bf16_t* v; int vs; };
DEV void kv_load(const KVT& s, int kv0, const int TIDX, u32x4 (&rg)[4]) {
    const int c = TIDX & 7, r0 = TIDX >> 3;
    rg[0] = *(const u32x4*)(s.k + (size_t)(kv0 + r0) * s.ks + c * 8);
    rg[1] = *(const u32x4*)(s.k + (size_t)(kv0 + r0 + 32) * s.ks + c * 8);
    rg[2] = *(const u32x4*)(s.v + (size_t)r0 * s.vs + kv0 + c * 8);
    rg[3] = *(const u32x4*)(s.v + (size_t)(r0 + 32) * s.vs + kv0 + c * 8);
}
DEV void kv_store(unsigned char* st, const int TIDX, const u32x4 (&rg)[4]) {
    const int c = TIDX & 7, r0 = TIDX >> 3;
    *(u32x4*)(st + tile_off(r0, c)) = rg[0]; *(u32x4*)(st + tile_off(r0 + 32, c)) = rg[1];
    *(u32x4*)(st + 8192 + tile_off(r0, c)) = rg[2]; *(u32x4*)(st + 8192 + tile_off(r0 + 32, c)) = rg[3];
}
DEV bf16x8 scale_frag(bf16x8 v, float sc) {
    u32x4 u = __builtin_bit_cast(u32x4, v);
#pragma unroll
    for (int i = 0; i < 4; ++i) u[i] = cvtpk(__uint_as_float(u[i] << 16) * sc, __uint_as_float(u[i] & 0xffff0000u) * sc);
    return __builtin_bit_cast(bf16x8, u);
}
DEV void score_tile(const unsigned char* Kt, const bf16x8 (&qf)[4], int r, int h, f32x16 (&p)[2]) {
    const int kr = swap23(r);
#pragma unroll
    for (int blk = 0; blk < 2; ++blk) {
#pragma unroll
        for (int q = 0; q < 16; ++q) p[blk][q] = 0.f;
#pragma unroll
        for (int s = 0; s < 4; ++s) {
            const bf16x8 kf = *(const bf16x8*)(Kt + tile_off(32 * blk + kr, 2 * s + h));
            p[blk] = __builtin_amdgcn_mfma_f32_32x32x16_bf16(kf, qf[s], p[blk], 0, 0, 0);
        }
    }
}
DEV void pv_tile(const unsigned char* Vt, const f32x16 (&p)[2], int r, int h, f32x16 (&o)[2]) {
#pragma unroll
    for (int blk = 0; blk < 2; ++blk)
#pragma unroll
        for (int s = 0; s < 2; ++s) {
            u32x4 pk;
            pk.x = cvtpk(p[blk][8 * s], p[blk][8 * s + 1]); pk.y = cvtpk(p[blk][8 * s + 2], p[blk][8 * s + 3]);
            pk.z = cvtpk(p[blk][8 * s + 4], p[blk][8 * s + 5]); pk.w = cvtpk(p[blk][8 * s + 6], p[blk][8 * s + 7]);
            const bf16x8 pb = __builtin_bit_cast(bf16x8, pk);
#pragma unroll
            for (int db = 0; db < 2; ++db) {
                const bf16x8 vf = *(const bf16x8*)(Vt + tile_off(32 * db + r, 2 * (2 * blk + s) + h));
                o[db] = __builtin_amdgcn_mfma_f32_32x32x16_bf16(vf, pb, o[db], 0, 0, 0);
            }
        }
}

template <int VAR>
DEV void attn_branch(unsigned char* lds, const KVT& src, const bf16x8 (&qf)[4], unsigned tmask, int wave_last, int t, int t_first,
                     unsigned selbits, const float* bias2, f32x16 (&o)[2], const int TIDX) {
    const int lane = TIDX & 63, r = lane & 31, h = lane >> 5;
    const float NEG_INF = -__builtin_inff();
    float mrun = -1e30f, lrun = 0.f, rest = VAR == 3 ? 1.f : 0.f;
#pragma unroll
    for (int db = 0; db < 2; ++db)
#pragma unroll
        for (int q = 0; q < 16; ++q) o[db][q] = 0.f;
    u32x4 rg[4];
    unsigned rem = tmask;
    int j = VAR == 3 ? 31 - __builtin_clz(rem) : __builtin_ctz(rem);
    rem &= ~(1u << j);
    kv_load(src, 64 * j, TIDX, rg);
    __syncthreads();
    kv_store(lds, TIDX, rg);
    __syncthreads();
    int stage = 0;
    for (;;) {
        int jn = -1;
        if (rem) { jn = VAR == 3 ? 31 - __builtin_clz(rem) : __builtin_ctz(rem); rem &= ~(1u << jn); kv_load(src, 64 * jn, TIDX, rg); }
        asm volatile("" ::: "memory"); __builtin_amdgcn_sched_barrier(0);
        if (j <= wave_last) {
            const unsigned char* Kt = lds + stage * 16384;
            f32x16 p[2];
            score_tile(Kt, qf, r, h, p);
            const int kvb = 64 * j + 8 * h;
            if (VAR == 3) {
                const bool diag = 64 * j + 63 >= t_first;
                float gt[2][2];
                if (diag) {
#pragma unroll
                    for (int blk = 0; blk < 2; ++blk)
#pragma unroll
                        for (int s = 0; s < 2; ++s) {
                            float run = 1.f;
#pragma unroll
                            for (int q = 7; q >= 0; --q) {
                                const float ez = fexp2(p[blk][8 * s + q]);
                                float w = __builtin_amdgcn_rcpf(1.f + ez);
                                float beta = 1.f - w;
                                const bool valid = kvb + 32 * blk + 16 * s + q < t;
                                w = valid ? w : 1.f; beta = valid ? beta : 0.f;
                                p[blk][8 * s + q] = beta * run;
                                run *= w;
                            }
                            gt[blk][s] = run;
                        }
                } else {
#pragma unroll
                    for (int blk = 0; blk < 2; ++blk)
#pragma unroll
                        for (int s = 0; s < 2; ++s) {
                            float run = 1.f;
#pragma unroll
                            for (int q = 7; q >= 0; --q) {
                                const float rn = run * __builtin_amdgcn_rcpf(1.f + fexp2(p[blk][8 * s + q]));
                                p[blk][8 * s + q] = run - rn;
                                run = rn;
                            }
                            gt[blk][s] = run;
                        }
                }
                float og[2][2], pt[2][2];
#pragma unroll
                for (int blk = 0; blk < 2; ++blk)
#pragma unroll
                    for (int s = 0; s < 2; ++s) { og[blk][s] = __shfl_xor(gt[blk][s], 32); pt[blk][s] = gt[blk][s] * og[blk][s]; }
                float above = rest;
#pragma unroll
                for (int pi = 3; pi >= 0; --pi) {
                    const int blk = pi >> 1, s = pi & 1;
                    const float carry = above * (h == 0 ? og[blk][s] : 1.f);
#pragma unroll
                    for (int q = 0; q < 8; ++q) p[blk][8 * s + q] *= carry;
                    above *= pt[blk][s];
                }
                rest = above;
            } else {
                const bool need_causal = 64 * j + 63 > t_first;
                const bool need_win = VAR == 1 && (64 * j + 512 <= t_first + 31);
                const bool lane_on = VAR != 0 || ((selbits >> j) & 1u);
                if (VAR == 2) {
#pragma unroll
                    for (int blk = 0; blk < 2; ++blk)
#pragma unroll
                        for (int s = 0; s < 2; ++s) {
                            const float4 b0 = *(const float4*)(bias2 + kvb + 32 * blk + 16 * s), b1 = *(const float4*)(bias2 + kvb + 32 * blk + 16 * s + 4);
                            p[blk][8 * s] += b0.x; p[blk][8 * s + 1] += b0.y; p[blk][8 * s + 2] += b0.z; p[blk][8 * s + 3] += b0.w;
                            p[blk][8 * s + 4] += b1.x; p[blk][8 * s + 5] += b1.y; p[blk][8 * s + 6] += b1.z; p[blk][8 * s + 7] += b1.w;
                        }
                }
                if (need_causal) {
#pragma unroll
                    for (int blk = 0; blk < 2; ++blk)
#pragma unroll
                        for (int q = 0; q < 16; ++q) { const int kv = kvb + 32 * blk + 16 * (q >> 3) + (q & 7); p[blk][q] = kv <= t ? p[blk][q] : NEG_INF; }
                }
                if (need_win) {
#pragma unroll
                    for (int blk = 0; blk < 2; ++blk)
#pragma unroll
                        for (int q = 0; q < 16; ++q) { const int kv = kvb + 32 * blk + 16 * (q >> 3) + (q & 7); p[blk][q] = kv + 512 > t ? p[blk][q] : NEG_INF; }
                }
                float tmax = p[0][0];
#pragma unroll
                for (int q = 1; q < 16; ++q) tmax = fmaxf(tmax, p[0][q]);
#pragma unroll
                for (int q = 0; q < 16; ++q) tmax = fmaxf(tmax, p[1][q]);
                tmax = lane_on ? tmax : NEG_INF;
                tmax = fmaxf(tmax, __shfl_xor(tmax, 32));
                const float mnew = fmaxf(mrun, tmax);
                const bool grew = mnew > mrun;
                const float alpha = fexp2(mrun - mnew);
                mrun = mnew;
                const float msub = lane_on ? mnew : __builtin_inff();
                const f32x2_t ms2 = {msub, msub};
                f32x2_t ls2 = {0.f, 0.f};
#pragma unroll
                for (int blk = 0; blk < 2; ++blk)
#pragma unroll
                    for (int q = 0; q < 16; q += 2) {
                        const f32x2_t d2 = (f32x2_t){p[blk][q], p[blk][q + 1]} - ms2;
                        f32x2_t e2; e2.x = fexp2(d2.x); e2.y = fexp2(d2.y);
                        p[blk][q] = e2.x; p[blk][q + 1] = e2.y; ls2 += e2;
                    }
                lrun = lrun * alpha + (ls2.x + ls2.y);
                if (__any(grew)) {
#pragma unroll
                    for (int db = 0; db < 2; ++db)
#pragma unroll
                        for (int q = 0; q < 16; ++q) o[db][q] *= alpha;
                }
            }
            pv_tile(Kt + 8192, p, r, h, o);
        }
        if (jn >= 0) kv_store(lds + (stage ^ 1) * 16384, TIDX, rg);
        __syncthreads();
        if (jn < 0) break;
        j = jn; stage ^= 1;
    }
    if (VAR != 3) {
        const float lt = lrun + __shfl_xor(lrun, 32);
        const float inv = lt > 0.f ? 1.f / lt : 0.f;
#pragma unroll
        for (int db = 0; db < 2; ++db)
#pragma unroll
            for (int q = 0; q < 16; ++q) o[db][q] *= inv;
    }
}

DEV void head_norm_store(const f32x16 (&o)[2], const float* gam, bf16_t* dst, int h) {
    float ss = 0.f;
#pragma unroll
    for (int db = 0; db < 2; ++db)
#pragma unroll
        for (int q = 0; q < 16; ++q) ss += o[db][q] * o[db][q];
    ss += __shfl_xor(ss, 32);
    const float rinv = rsqrtf(ss * (1.f / 64.f) + EPS);
#pragma unroll
    for (int db = 0; db < 2; ++db)
#pragma unroll
        for (int g = 0; g < 4; ++g) {
            const int d = 32 * db + 8 * g + 4 * h;
            const float4 gg = *(const float4*)(gam + d);
            uint2 u;
            u.x = cvtpk(o[db][4 * g] * rinv * gg.x, o[db][4 * g + 1] * rinv * gg.y);
            u.y = cvtpk(o[db][4 * g + 2] * rinv * gg.z, o[db][4 * g + 3] * rinv * gg.w);
            *(uint2*)(dst + d) = u;
        }
}

template <int VAR>
DEV void mha_unit(const P& p, int l, int unit, unsigned char* lds) {
    const V v = make_views(p); const int TIDX = otid();
    const int lane = TIDX & 63, wave = TIDX >> 6, r = lane & 31, h = lane >> 5;
    const int qb = 15 - (unit >> 5), bh = unit & 31, b = bh >> 2, hh = bh & 3;
    const int t0 = qb * 128, tw = t0 + 32 * wave, t = tw + r, m = b * S + t;
    const int qcol = VAR == 2 ? C_QB : C_QC, kcol = VAR == 2 ? C_KB : C_KCC, vrow = VAR == 2 ? 256 : 512, ocol = VAR == 2 ? 512 : 768;
    bf16x8 qf[4];
#pragma unroll
    for (int s = 0; s < 4; ++s) qf[s] = scale_frag(*(const bf16x8*)(v.U + (size_t)m * NP + qcol + hh * 64 + 16 * s + 8 * h), C2);
    KVT src;
    src.k = v.U + (size_t)b * S * NP + kcol + hh * 64; src.ks = NP;
    src.v = (const bf16_t*)(p.ws + WS_VT) + (size_t)(b * 768 + vrow + hh * 64) * S; src.vs = S;
    const int last = (t0 + 127) >> 6;
    const unsigned tmask = last == 31 ? 0xffffffffu : ((1u << (last + 1)) - 1u);
    const float* bias2 = (const float*)(lds + 32768);
    if (VAR == 2) {
        float* cf = (float*)(lds + 32768);
        float* wt = (float*)(lds + 32768 + 8192);
        const float* lsf = (const float*)(p.ws + WS_LSF) + (size_t)(b * 4 + hh) * S;
        const int nel = t0 + 128;
        float x[8];
        if (8 * TIDX < nel) {
            const float4 a0 = *(const float4*)(lsf + 8 * TIDX), a1 = *(const float4*)(lsf + 8 * TIDX + 4);
            x[0] = a0.x; x[1] = x[0] + a0.y; x[2] = x[1] + a0.z; x[3] = x[2] + a0.w; x[4] = x[3] + a1.x; x[5] = x[4] + a1.y; x[6] = x[5] + a1.z; x[7] = x[6] + a1.w;
        } else {
#pragma unroll
            for (int q = 0; q < 8; ++q) x[q] = 0.f;
        }
        float inc = x[7];
#pragma unroll
        for (int o = 1; o < 64; o <<= 1) { const float tt = __shfl_up(inc, o); if (lane >= o) inc += tt; }
        __syncthreads();
        if (lane == 63) wt[wave] = inc;
        __syncthreads();
        float off = inc - x[7];
#pragma unroll
        for (int w = 0; w < 3; ++w) off += (w < wave) ? wt[w] : 0.f;
        if (8 * TIDX < nel) {
#pragma unroll
            for (int q = 0; q < 8; ++q) cf[8 * TIDX + q] = -(x[q] + off) * LOG2E;
        }
        __syncthreads();
    }
    f32x16 o[2];
    attn_branch<VAR>(lds, src, qf, tmask, (tw + 31) >> 6, t, tw, 0u, bias2, o, TIDX);
    head_norm_store(o, p.out_norm_g + (size_t)l * D + ocol + hh * 64, v.O + (size_t)m * D + ocol + hh * 64, h);
}

DEV void nsa_unit(const P& p, int l, int unit, unsigned char* lds) {
    const V v = make_views(p); const int TIDX = otid();
    const int lane = TIDX & 63, wave = TIDX >> 6, r = lane & 31, h = lane >> 5;
    const int qblk = 63 - (unit >> 4), bg = unit & 15, b = bg >> 1, g = bg & 1;
    const int t0 = qblk * 32, t = t0 + r, m = b * S + t, head = g * 4 + wave, cur = t0 >> 6;
    const float NEG_INF = -__builtin_inff();
    bf16x8 qf[4];
#pragma unroll
    for (int s = 0; s < 4; ++s) qf[s] = scale_frag(*(const bf16x8*)(v.U + (size_t)m * NP + C_QA + head * 64 + 16 * s + 8 * h), C2);
    const float g0 = sigmoidf_(v.gf[(size_t)m * 32 + head * 3]), g1 = sigmoidf_(v.gf[(size_t)m * 32 + head * 3 + 1]), g2 = sigmoidf_(v.gf[(size_t)m * 32 + head * 3 + 2]);
    f32x16 otot[2];
    float* PA = (float*)(lds + 32768);
    float* PB = (float*)(lds + 49152);
    float* SC = (float*)lds;
    unsigned* MASK = (unsigned*)(lds + 8192);
    {
        const bf16_t* ck = v.ck + (size_t)(b * 2 + g) * 128 * 64;
        const bf16_t* cvt = (const bf16_t*)(p.ws + WS_CVT) + (size_t)(b * 2 + g) * 64 * 128;
        const int c = TIDX & 7, r0 = TIDX >> 3;
        u32x4 rk[4], rv[4];
#pragma unroll
        for (int i = 0; i < 4; ++i) rk[i] = *(const u32x4*)(ck + (size_t)(r0 + 32 * i) * 64 + c * 8);
#pragma unroll
        for (int i = 0; i < 4; ++i) rv[i] = *(const u32x4*)(cvt + (size_t)(r0 + 32 * (i & 1)) * 128 + 64 * (i >> 1) + c * 8);
        __syncthreads();
#pragma unroll
        for (int i = 0; i < 4; ++i) *(u32x4*)(lds + tile_off(r0 + 32 * i, c)) = rk[i];
#pragma unroll
        for (int i = 0; i < 4; ++i) *(u32x4*)(lds + 16384 + 8192 * (i >> 1) + tile_off(r0 + 32 * (i & 1), c)) = rv[i];
        __syncthreads();
        f32x16 ps[2][2];
        score_tile(lds, qf, r, h, ps[0]);
        score_tile(lds + 8192, qf, r, h, ps[1]);
        const int nvalid = t >= 31 ? (t - 31) / 16 + 1 : 0;
        float mx = NEG_INF;
#pragma unroll
        for (int tt = 0; tt < 2; ++tt)
#pragma unroll
            for (int blk = 0; blk < 2; ++blk)
#pragma unroll
                for (int q = 0; q < 16; ++q) {
                    const int n = 64 * tt + 32 * blk + 16 * (q >> 3) + 8 * h + (q & 7);
                    const float x = n < nvalid ? ps[tt][blk][q] : NEG_INF;
                    ps[tt][blk][q] = x; mx = fmaxf(mx, x);
                }
        mx = fmaxf(mx, __shfl_xor(mx, 32));
        const float mxs = nvalid > 0 ? mx : 0.f;
        float ls = 0.f;
#pragma unroll
        for (int tt = 0; tt < 2; ++tt)
#pragma unroll
            for (int blk = 0; blk < 2; ++blk)
#pragma unroll
                for (int q = 0; q < 16; ++q) { const float e = fexp2(ps[tt][blk][q] - mxs); ps[tt][blk][q] = e; ls += e; }
        const float lt = ls + __shfl_xor(ls, 32);
        const float inv = lt > 0.f ? 1.f / lt : 0.f;
#pragma unroll
        for (int tt = 0; tt < 2; ++tt)
#pragma unroll
            for (int blk = 0; blk < 2; ++blk) {
#pragma unroll
                for (int q = 0; q < 16; ++q) ps[tt][blk][q] *= inv;
#pragma unroll
                for (int s = 0; s < 2; ++s) {
                    const int G0 = 16 * tt + 8 * blk + 4 * s + 2 * h;
                    const float a0 = (ps[tt][blk][8 * s] + ps[tt][blk][8 * s + 1]) + (ps[tt][blk][8 * s + 2] + ps[tt][blk][8 * s + 3]);
                    const float a1 = (ps[tt][blk][8 * s + 4] + ps[tt][blk][8 * s + 5]) + (ps[tt][blk][8 * s + 6] + ps[tt][blk][8 * s + 7]);
                    PA[(wave * 32 + G0) * 32 + r] = a0; PA[(wave * 32 + G0 + 1) * 32 + r] = a1;
                    PB[(wave * 32 + G0 + 1) * 32 + r] = ps[tt][blk][8 * s + 3];
                    if (G0 + 2 < 32) PB[(wave * 32 + G0 + 2) * 32 + r] = ps[tt][blk][8 * s + 7];
                }
            }
        f32x16 oc[2];
#pragma unroll
        for (int db = 0; db < 2; ++db)
#pragma unroll
            for (int q = 0; q < 16; ++q) oc[db][q] = 0.f;
        pv_tile(lds + 16384, ps[0], r, h, oc);
        pv_tile(lds + 24576, ps[1], r, h, oc);
#pragma unroll
        for (int db = 0; db < 2; ++db)
#pragma unroll
            for (int q = 0; q < 16; ++q) otot[db][q] = g0 * oc[db][q];
    }
    __syncthreads();
    const bool need_topk = cur > 15;
    if (need_topk) {
        const int q = TIDX & 31, j0 = (TIDX >> 5) * 4;
#pragma unroll
        for (int jj = 0; jj < 4; ++jj) {
            const int j = j0 + jj;
            float sc = 0.f;
#pragma unroll
            for (int w = 0; w < 4; ++w) sc += PA[(w * 32 + j) * 32 + q];
            if (j > 0) {
#pragma unroll
                for (int w = 0; w < 4; ++w) sc += PB[(w * 32 + j) * 32 + q];
            }
            const bool forced = (j == 0) || (j == cur) || (j == cur - 1);
            SC[q * 33 + j] = forced ? 1.0e4f : (j <= cur ? sc : -1.0f);
        }
        if (TIDX < 32) MASK[TIDX] = 0u;
        __syncthreads();
        unsigned bits = 0u;
#pragma unroll
        for (int jj = 0; jj < 4; ++jj) {
            const int j = j0 + jj;
            const float vj = SC[q * 33 + j];
            int rank = 0;
#pragma unroll
            for (int i = 0; i < 32; ++i) { const float vi = SC[q * 33 + i]; rank += (vi > vj || (vi == vj && i < j)) ? 1 : 0; }
            if (rank < 16) bits |= 1u << j;
        }
        atomicOr(&MASK[q], bits);
        __syncthreads();
    }
    const unsigned upto = (2u << cur) - 1u;
    unsigned mybits = upto, um = upto;
    if (need_topk) {
        mybits = MASK[r];
        um = 0u;
#pragma unroll
        for (int i = 0; i < 32; ++i) um |= MASK[i];
        um = (unsigned)__builtin_amdgcn_readfirstlane((int)um);
    }
    {
        KVT src; src.k = v.U + (size_t)b * S * NP + C_KS + g * 64; src.ks = NP;
        src.v = (const bf16_t*)(p.ws + WS_VT) + (size_t)(b * 768 + g * 64) * S; src.vs = S;
        f32x16 o[2];
        attn_branch<0>(lds, src, qf, um & upto, cur, t, t0, mybits, nullptr, o, TIDX);
#pragma unroll
        for (int db = 0; db < 2; ++db)
#pragma unroll
            for (int q = 0; q < 16; ++q) otot[db][q] += g1 * o[db][q];
    }
    {
        KVT src; src.k = v.U + (size_t)b * S * NP + C_KW + g * 64; src.ks = NP;
        src.v = (const bf16_t*)(p.ws + WS_VT) + (size_t)(b * 768 + 128 + g * 64) * S; src.vs = S;
        const int f = (t0 - 511 > 0 ? t0 - 511 : 0) >> 6;
        const unsigned wmask = upto & ~((1u << f) - 1u);
        f32x16 o[2];
        attn_branch<1>(lds, src, qf, wmask, cur, t, t0, 0u, nullptr, o, TIDX);
#pragma unroll
        for (int db = 0; db < 2; ++db)
#pragma unroll
            for (int q = 0; q < 16; ++q) otot[db][q] += g2 * o[db][q];
    }
    head_norm_store(otot, p.out_norm_g + (size_t)l * D + head * 64, v.O + (size_t)m * D + head * 64, h);
}

DEV void cmp_unit(const P& p, int l, int unit, unsigned char* lds) {
    const V v = make_views(p); const int TIDX = otid();
    const int lane = TIDX & 63, wave = TIDX >> 6, wm = wave >> 1, wn = wave & 1, r = lane & 31, h = lane >> 5;
    const int kv = unit & 1, bg = unit >> 1, b = bg >> 1, g = bg & 1, lk = l * 2 + kv;
    const int col = (kv ? C_VC : C_KC) + g * 64;
    const bf16_t* arow[4];
#pragma unroll
    for (int i = 0; i < 4; ++i) { const int n = (TIDX >> 3) + 32 * i; arow[i] = v.U + (size_t)(b * S + 16 * (n < 127 ? n : 126)) * NP + col; }
    f32x16 acc[2][2];
    gemm128<false>(lds, arow, (const bf16_t*)(p.ws + WS_CW1) + (size_t)lk * 2048 * 128, 128, 2048, acc, TIDX, NP);
    const float* pb = (const float*)(p.ws + WS_CPB) + lk * 8 * 128;
#pragma unroll
    for (int j = 0; j < 2; ++j)
#pragma unroll
        for (int i = 0; i < 2; ++i) {
            const int mrow = 64 * wm + 32 * i + r;
#pragma unroll
            for (int g4 = 0; g4 < 4; ++g4) {
                float4 bb = *(const float4*)(pb + 64 * wn + 32 * j + 8 * g4 + 4 * h);
#pragma unroll
                for (int c8 = 1; c8 < 8; ++c8) { const float4 b2 = *(const float4*)(pb + c8 * 128 + 64 * wn + 32 * j + 8 * g4 + 4 * h); bb.x += b2.x; bb.y += b2.y; bb.z += b2.z; bb.w += b2.w; }
                float x0 = acc[j][i][4 * g4] + bb.x, x1 = acc[j][i][4 * g4 + 1] + bb.y, x2 = acc[j][i][4 * g4 + 2] + bb.z, x3 = acc[j][i][4 * g4 + 3] + bb.w;
                x0 = x0 / (1.f + __expf(-x0)); x1 = x1 / (1.f + __expf(-x1)); x2 = x2 / (1.f + __expf(-x2)); x3 = x3 / (1.f + __expf(-x3));
                uint2 u; u.x = cvtpk(x0, x1); u.y = cvtpk(x2, x3);
                *(uint2*)(lds + wn * 16384 + tile_off(mrow, 4 * j + g4) + 8 * h) = u;
            }
        }
    {
        const bf16_t* w2 = (const bf16_t*)(p.ws + WS_CW2) + (size_t)lk * 64 * 128;
        const int c = TIDX & 7, r0 = TIDX >> 3;
#pragma unroll
        for (int i = 0; i < 4; ++i) {
            const int row = r0 + 32 * (i & 1), kt = i >> 1;
            *(u32x4*)(lds + 32768 + kt * 8192 + tile_off(row, c)) = *(const u32x4*)(w2 + (size_t)row * 128 + kt * 64 + c * 8);
        }
    }
    __syncthreads();
    f32x16 a2[2];
#pragma unroll
    for (int db = 0; db < 2; ++db)
#pragma unroll
        for (int q = 0; q < 16; ++q) a2[db][q] = 0.f;
#pragma unroll
    for (int kt = 0; kt < 2; ++kt)
#pragma unroll
        for (int s = 0; s < 4; ++s) {
            const bf16x8 hf = *(const bf16x8*)(lds + kt * 16384 + tile_off(32 * wave + r, 2 * s + h));
#pragma unroll
            for (int db = 0; db < 2; ++db) {
                const bf16x8 wf = *(const bf16x8*)(lds + 32768 + kt * 8192 + tile_off(32 * db + r, 2 * s + h));
                a2[db] = __builtin_amdgcn_mfma_f32_32x32x16_bf16(wf, hf, a2[db], 0, 0, 0);
            }
        }
    const int n = 32 * wave + r;
    if (kv == 0 && n < 127) {
        const int pos = 16 * n + 31;
#pragma unroll
        for (int q = 0; q < 4; ++q) {
            const float cs = v.rcos[pos * 8 + q + 4 * h], sn = v.rsin[pos * 8 + q + 4 * h];
            const float x1 = a2[0][q], x2 = a2[0][q + 4];
            a2[0][q] = x1 * cs - x2 * sn; a2[0][q + 4] = x2 * cs + x1 * sn;
        }
    }
    bf16_t* dst = (kv ? v.cv : v.ck) + ((size_t)bg * 128 + n) * 64;
    bf16_t* dt = (bf16_t*)(p.ws + WS_CVT) + (size_t)bg * 64 * 128 + n;
#pragma unroll
    for (int db = 0; db < 2; ++db)
#pragma unroll
        for (int g4 = 0; g4 < 4; ++g4) {
            const int d = 32 * db + 8 * g4 + 4 * h;
            float x0 = a2[db][4 * g4], x1 = a2[db][4 * g4 + 1], x2 = a2[db][4 * g4 + 2], x3 = a2[db][4 * g4 + 3];
            if (n >= 127) { x0 = 0.f; x1 = 0.f; x2 = 0.f; x3 = 0.f; }
            uint2 u; u.x = cvtpk(x0, x1); u.y = cvtpk(x2, x3);
            *(uint2*)(dst + d) = u;
            if (kv) { dt[(size_t)d * 128] = (bf16_t)(u.x & 0xffffu); dt[(size_t)(d + 1) * 128] = (bf16_t)(u.x >> 16); dt[(size_t)(d + 2) * 128] = (bf16_t)(u.y & 0xffffu); dt[(size_t)(d + 3) * 128] = (bf16_t)(u.y >> 16); }
        }
    __syncthreads();
}

typedef float f32x4m __attribute__((ext_vector_type(4)));
DEV void ph_norm2_router_fast(const P& p, int l, unsigned char* lds) {
    const V v = make_views(p); const int TIDX = otid(), BIDX = obid();
    const int lane = TIDX & 63, wave = TIDX >> 6;
    const bf16_t* wr = (const bf16_t*)(p.ws + WS_WR) + (size_t)l * 2 * 64 * D;
    float* LG = (float*)(lds + 65536);
    for (int blk = BIDX; blk < T / 16; blk += gridDim.x) {
        const int m0 = blk * 16, b = m0 >> 11;
        const float* md = v.mod + (size_t)(l * 8 + b) * 6144;
        float4 xv[4][4]; float ssq[4];
#pragma unroll
        for (int rr = 0; rr < 4; ++rr)
#pragma unroll
            for (int j = 0; j < 4; ++j) xv[rr][j] = *(const float4*)(v.X + (size_t)(m0 + wave * 4 + rr) * D + 4 * lane + 256 * j);
#pragma unroll
        for (int rr = 0; rr < 4; ++rr) {
            ssq[rr] = 0.f;
#pragma unroll
            for (int j = 0; j < 4; ++j) ssq[rr] += xv[rr][j].x * xv[rr][j].x + xv[rr][j].y * xv[rr][j].y + xv[rr][j].z * xv[rr][j].z + xv[rr][j].w * xv[rr][j].w;
        }
#pragma unroll
        for (int o = 1; o < 64; o <<= 1) {
#pragma unroll
            for (int rr = 0; rr < 4; ++rr) ssq[rr] += __shfl_xor(ssq[rr], o);
        }
#pragma unroll
        for (int rr = 0; rr < 4; ++rr) {
            const int row = wave * 4 + rr, m = m0 + row;
            const float rs = rsqrtf(ssq[rr] * (1.f / D) + EPS);
#pragma unroll
            for (int j = 0; j < 4; ++j) {
                const int c = 4 * lane + 256 * j;
                const float4 g = *(const float4*)(p.norm2_g + l * D + c), sh = *(const float4*)(md + 3 * D + c), sc = *(const float4*)(md + 4 * D + c);
                const float h0 = xv[rr][j].x * rs * g.x * (1.f + sc.x) + sh.x, h1 = xv[rr][j].y * rs * g.y * (1.f + sc.y) + sh.y;
                const float h2 = xv[rr][j].z * rs * g.z * (1.f + sc.z) + sh.z, h3 = xv[rr][j].w * rs * g.w * (1.f + sc.w) + sh.w;
                uint2 hi; hi.x = cvtpk(h0, h1); hi.y = cvtpk(h2, h3);
                uint2 lo;
                lo.x = cvtpk(h0 - __uint_as_float(hi.x << 16), h1 - __uint_as_float(hi.x & 0xffff0000u));
                lo.y = cvtpk(h2 - __uint_as_float(hi.y << 16), h3 - __uint_as_float(hi.y & 0xffff0000u));
                *(uint2*)(v.H + (size_t)m * D + c) = hi;
                const int off = row * 2048 + ((((c >> 3) ^ row) & 127) << 4) + (c & 7) * 2;
                *(uint2*)(lds + off) = hi; *(uint2*)(lds + 32768 + off) = lo;
            }
        }
        __syncthreads();
        {
            const int r16 = lane & 15, kq = lane >> 4;
            f32x4m acc = {0.f, 0.f, 0.f, 0.f};
            const bf16_t* wh = wr + (size_t)(16 * wave + r16) * D + 8 * kq;
#pragma unroll 8
            for (int s = 0; s < 32; ++s) {
                const int off = r16 * 2048 + ((((4 * s + kq) ^ r16) & 127) << 4);
                const bf16x8 ah = *(const bf16x8*)(lds + off), al = *(const bf16x8*)(lds + 32768 + off);
                const bf16x8 bh = *(const bf16x8*)(wh + 32 * s), bl = *(const bf16x8*)(wh + 64 * D + 32 * s);
                acc = __builtin_amdgcn_mfma_f32_16x16x32_bf16(ah, bh, acc, 0, 0, 0);
                acc = __builtin_amdgcn_mfma_f32_16x16x32_bf16(al, bh, acc, 0, 0, 0);
                acc = __builtin_amdgcn_mfma_f32_16x16x32_bf16(ah, bl, acc, 0, 0, 0);
            }
#pragma unroll
            for (int q = 0; q < 4; ++q) LG[(4 * kq + q) * 64 + 16 * wave + r16] = acc[q];
        }
        __syncthreads();
        if (TIDX < 16) {
            const int m = m0 + TIDX;
            const float* lgp = LG + TIDX * 64;
            float lg[4], le[32];
#pragma unroll
            for (int i = 0; i < 4; ++i) lg[i] = lgp[i] + p.rg_b[l * 4 + i];
#pragma unroll
            for (int i = 0; i < 32; ++i) le[i] = lgp[4 + i] + p.re_b[l * 32 + i];
            int gi = 0; float gm = lg[0];
#pragma unroll
            for (int i = 1; i < 4; ++i) if (lg[i] > gm) { gm = lg[i]; gi = i; }
            float gs = 0.f;
#pragma unroll
            for (int i = 0; i < 4; ++i) gs += expf(lg[i] - gm);
            const float pg = 1.f / gs;
            float el[8];
#pragma unroll
            for (int i = 0; i < 8; ++i) el[i] = gi == 0 ? le[i] : (gi == 1 ? le[8 + i] : (gi == 2 ? le[16 + i] : le[24 + i]));
            int e1 = 0; float m1 = el[0];
#pragma unroll
            for (int i = 1; i < 8; ++i) if (el[i] > m1) { m1 = el[i]; e1 = i; }
            int e2 = -1; float m2 = -3.0e38f;
#pragma unroll
            for (int i = 0; i < 8; ++i) if (i != e1 && el[i] > m2) { m2 = el[i]; e2 = i; }
            const float p2 = expf(m2 - m1);
            const float w1 = pg / (1.f + p2), w2 = pg * p2 / (1.f + p2);
            const int ea = gi * 8 + e1, eb = gi * 8 + e2;
            const unsigned pa = atomicAdd(v.ctl + CW_CNT + l * 32 + ea, 1u);
            const unsigned pb = atomicAdd(v.ctl + CW_CNT + l * 32 + eb, 1u);
            v.list[(size_t)ea * T + pa] = 2 * m;
            v.list[(size_t)eb * T + pb] = 2 * m + 1;
            v.wts[2 * m] = w1; v.wts[2 * m + 1] = w2;
        }
        __syncthreads();
    }
}

constexpr int CW_MQ = 8192 + 512;
DEV void ph_mix(const P& p, int l, unsigned char* lds, volatile LAS unsigned* qslot, int rep) {
    const int TIDX = otid(), BIDX = obid();
    unsigned* ctl = (unsigned*)(p.ws + WS_CTL) + CW_MQ + l * 256;
    unsigned acq = 0u;
    for (int hop = 0; hop < 8; ++hop) {
        const int b = (BIDX + hop) & 7;
        unsigned* qc = ctl + b * 16;
        unsigned* done = ctl + 128 + b * 16;
        for (;;) {
            __syncthreads();
            if (TIDX == 0) *qslot = atomicAdd(qc, 1u);
            __syncthreads();
            const int v = (int)*qslot;
            if (v >= 260) break;
            if (v < 4) {
                cmp_unit(p, l, b * 4 + v, lds);
                asm volatile("s_waitcnt vmcnt(0)" ::: "memory");
                __syncthreads();
                if (TIDX == 0) {
                    __builtin_amdgcn_fence(__ATOMIC_RELEASE, "agent");
                    asm volatile("s_waitcnt vmcnt(0)" ::: "memory");
                    __hip_atomic_fetch_add(done, 1u, __ATOMIC_RELAXED, __HIP_MEMORY_SCOPE_AGENT);
                }
                continue;
            }
            int slot = -1, nsa = -1;
            if (v < 68) slot = v - 4;
            else { const int w2 = v - 68, k = w2 % 3, i = w2 / 3; if (k < 2) nsa = 2 * i + k; else slot = 64 + i; }
            if (slot >= 0) {
                const int idx = slot >> 1, u = ((idx >> 2) << 5) | (b * 4 + (idx & 3));
                if (slot & 1) mha_unit<3>(p, l, u, lds); else mha_unit<2>(p, l, u, lds);
            } else {
                if (!((acq >> b) & 1u)) {
                    if (TIDX == 0) {
                        unsigned sp = 0;
                        while (__hip_atomic_load(done, __ATOMIC_RELAXED, __HIP_MEMORY_SCOPE_AGENT) < 4u) { __builtin_amdgcn_s_sleep(2); if (++sp > (1u << 22)) break; }
                        __builtin_amdgcn_fence(__ATOMIC_ACQUIRE, "agent");
                        asm volatile("s_waitcnt vmcnt(0)" ::: "memory");
                    }
                    __syncthreads();
                    acq |= 1u << b;
                }
                nsa_unit(p, l, ((nsa >> 1) << 4) | (b * 2 + (nsa & 1)), lds);
            }
        }
    }
}

#ifndef REP_PHASE
#define REP_PHASE 0
#endif
#ifndef REF_HEADS
#define REF_HEADS 0x0000u
#endif
__global__ void __launch_bounds__(256, 2) fwd_kernel(P p) {
    __shared__ __attribute__((aligned(16))) float lds[17408];
    __shared__ __attribute__((aligned(16))) unsigned lds_ctl[4];
    if (threadIdx.x < 4) lds_ctl[threadIdx.x] = 0u;
    __syncthreads();
    const XcdBarrier xb = xcd_barrier_post((unsigned*)(p.ws + WS_CTL), (volatile LAS unsigned*)lds_ctl);
#define GRID_BAR() do { xcd_barrier(xb); if (REP_PHASE == 7) xcd_barrier(xb); } while (0)
    volatile LAS unsigned* qslot = (volatile LAS unsigned*)(lds_ctl + 2);
    for (int rep = 0; rep < (REP_PHASE == 1 ? 2 : 1); ++rep) {
        ph_prologue(p, lds);
        ph_convert(p, lds);
        GRID_BAR();
    }
    for (int l = 0; l < DEPTH; ++l) {
        ph_convert_dense(p, l, 0);
        ph_norm1(p, l, l == 0 ? 0 : 1);
        GRID_BAR();
        for (int rep = 0; rep < (REP_PHASE == 2 ? 2 : 1); ++rep) {
            if (rep == 0) ph_convert_dense(p, l, 1);
            ph_inproj_fast(p, l, (unsigned char*)lds);
            GRID_BAR();
        }
        for (int rep = 0; rep < (REP_PHASE == 3 ? 2 : 1); ++rep) {
            ph_mix(p, l, (unsigned char*)lds, qslot, rep);
            GRID_BAR();
        }
        ph_outproj_fast(p, l, (unsigned char*)lds);
        GRID_BAR();
        if (blockIdx.x & 8) { ph_convert_experts(p, l); ph_norm2_router_fast(p, l, (unsigned char*)lds); }
        else { ph_norm2_router_fast(p, l, (unsigned char*)lds); ph_convert_experts(p, l); }
        GRID_BAR();
        for (int rep = 0; rep < (REP_PHASE == 5 ? 2 : 1); ++rep) {
            ph_moe_up_fast(p, l, (unsigned char*)lds);
            GRID_BAR();
        }
        for (int rep = 0; rep < (REP_PHASE == 6 ? 2 : 1); ++rep) {
            ph_moe_down_fast(p, l, (unsigned char*)lds);
            GRID_BAR();
        }
    }
    ph_norm1(p, DEPTH, 2);
}

extern "C" void kernel_launch(void* const* d_in, const int* in_sizes, int n_in,
                              void* d_out, int out_size, void* d_ws, size_t ws_size,
                              hipStream_t stream) {
    static int grid_blocks = 0;
    if (!grid_blocks) {
        int dev = 0, cus = 0, per_cu = 0;
        (void)hipGetDevice(&dev);
        (void)hipDeviceGetAttribute(&cus, hipDeviceAttributeMultiprocessorCount, dev);
        (void)hipOccupancyMaxActiveBlocksPerMultiprocessor(&per_cu, fwd_kernel, 256, 0);
        if (per_cu > 2) per_cu = 2;
        if (per_cu < 1) per_cu = 1;
        grid_blocks = cus * per_cu;
        if (n_in != 24 || ws_size < WS_END || out_size != T * D) { fprintf(stderr, "kernel_launch: unexpected shapes (n_in %d ws %zu out %d)\n", n_in, ws_size, out_size); grid_blocks = -1; }
    }
    if (grid_blocks < 0) return;
    (void)hipMemsetAsync(d_ws, 0, CTL_BYTES, stream);
    P p{};
    const float** pp = (const float**)&p;
    for (int i = 0; i < 24; ++i) pp[i] = (const float*)d_in[i];
    p.out = (float*)d_out; p.ws = (unsigned char*)d_ws;
    void* args[] = {&p};
    hipError_t e = hipLaunchCooperativeKernel((void*)fwd_kernel, dim3(grid_blocks), dim3(256), args, 0, stream);
    if (e != hipSuccess) fprintf(stderr, "cooperative launch failed: %s (grid %d)\n", hipGetErrorString(e), grid_blocks);
}
```

```cpp
#include <hip/hip_runtime.h>
#include <hip/hip_cooperative_groups.h>
#include <cstdio>
#include <cstdint>

#define LAS __attribute__((address_space(3)))
#define DEV __device__ __forceinline__

constexpr int T = 16384, S = 2048, NB = 8, D = 1024, DIN = 2844, NP = 2880, DEPTH = 4;
constexpr int NCMP = 127;
constexpr float EPS = 1e-6f;
constexpr float SCALE = 0.125f;
constexpr int C_QA = 0, C_KC = 512, C_VC = 640, C_KS = 768, C_VS = 896, C_KW = 1024, C_VW = 1152;
constexpr int C_QB = 1280, C_KB = 1536, C_VB = 1792, C_QC = 2048, C_KCC = 2304, C_VCC = 2560;

constexpr size_t MiB = 1u << 20;
constexpr size_t WS_CTL = 0, CTL_BYTES = 64 * 1024;
constexpr size_t WS_MOD = 1 * MiB, WS_ROPE = 2 * MiB, WS_CUMF = 3 * MiB, WS_CK = 4 * MiB, WS_CV = 5 * MiB, WS_IMP = 6 * MiB;
constexpr size_t WS_SEL = 10 * MiB, WS_EID = 11 * MiB, WS_WTS = 12 * MiB, WS_LIST = 13 * MiB, WS_GF = 16 * MiB;
constexpr size_t WS_H = 32 * MiB, WS_U = 64 * MiB, WS_O = 160 * MiB, WS_HID = 192 * MiB, WS_Y = 224 * MiB, WS_OB = 352 * MiB, WS_ORAW = 448 * MiB;
constexpr size_t WS_END = 973 * MiB;
constexpr size_t WS_VT = 936 * MiB;
constexpr size_t WS_CVT = 962 * MiB;
constexpr size_t WS_CUMF2 = 963 * MiB;
constexpr int CW_Q = 8192 + 256;
constexpr size_t WS_CW1 = 964 * MiB;
constexpr size_t WS_CW2 = 968 * MiB;
constexpr size_t WS_CPB = 969 * MiB;
constexpr size_t WS_LSF = 970 * MiB;
constexpr size_t WS_WR = 971 * MiB;
constexpr int CW_CNT = 8192;

typedef unsigned short bf16_t;
typedef float f32x4v __attribute__((ext_vector_type(4)));
DEV int vt_row(int n) { return n < 1024 ? n - 896 : (n < 1280 ? 128 + n - 1152 : (n < 2048 ? 256 + n - 1792 : 512 + n - 2560)); }
DEV bool is_vcol(int n) { return (n >= C_VS && n < C_KW) || (n >= C_VW && n < C_QB) || (n >= C_VB && n < C_QC) || (n >= C_VCC && n < 2816); }
DEV float bf2f(bf16_t v) { return __uint_as_float((unsigned)v << 16); }
DEV bf16_t f2bf(float f) { unsigned u = __float_as_uint(f); return (bf16_t)((u + 0x7fffu + ((u >> 16) & 1u)) >> 16); }
DEV float4 ld_bf4(const bf16_t* p) { const ushort4 u = *(const ushort4*)p; return make_float4(bf2f(u.x), bf2f(u.y), bf2f(u.z), bf2f(u.w)); }
typedef float f32x2_t __attribute__((ext_vector_type(2)));
typedef __bf16 bf16x2_t __attribute__((ext_vector_type(2)));
DEV unsigned cvtpk(float lo, float hi) { f32x2_t v = {lo, hi}; bf16x2_t b = __builtin_convertvector(v, bf16x2_t); return __builtin_bit_cast(unsigned, b); }
DEV float sigmoidf_(float x) { return 1.f / (1.f + expf(-x)); }
DEV float logsigmoidf_(float x) { return fminf(x, 0.f) - log1pf(expf(-fabsf(x))); }
DEV float wave_sum(float v) {
#pragma unroll
    for (int o = 1; o < 64; o <<= 1) v += __shfl_xor(v, o);
    return v;
}

#define XB_TMO      128
#define XB_XCNT(j)  (256  + 64 * (j))
#define XB_XSUB(j)  (1280 + 64 * (j))
#define XB_XGEN(j)  (2304 + 64 * (j))
#define XB_TOP      3328
#define XB_TOPGEN   3392
#define XCD_BAR_WORDS 3456
#define XB_SPIN_CAP (1u << 23)
DEV unsigned xb_ld(unsigned* p)              { return __hip_atomic_load(p, __ATOMIC_RELAXED, __HIP_MEMORY_SCOPE_AGENT); }
DEV unsigned xb_add(unsigned* p, unsigned v) { return __hip_atomic_fetch_add(p, v, __ATOMIC_RELAXED, __HIP_MEMORY_SCOPE_AGENT); }
DEV unsigned xb_xcc_id() { return (unsigned)__builtin_amdgcn_s_getreg((3 << 11) | 20) & 0xFu; }
#define XB_SPIN(cond, bar) do { unsigned _sp = 0; while (cond) { __builtin_amdgcn_s_sleep(1); \
    if ((++_sp & 255u) == 0u) { if (xb_ld(&(bar)[XB_TMO])) break; if (_sp > XB_SPIN_CAP) { atomicAdd(&(bar)[XB_TMO], 1u); break; } } } } while (0)
struct XcdBarrier { unsigned* bar; unsigned x; volatile LAS unsigned* st; };
DEV XcdBarrier xcd_barrier_post(unsigned* bar, volatile LAS unsigned* st) {
    XcdBarrier b; b.bar = bar; b.x = xb_xcc_id(); b.st = st;
    if (threadIdx.x == 0) (void)xb_add(&bar[XB_XCNT(b.x)], 1u);
    return b;
}
DEV void xcd_barrier_complete(unsigned* bar, unsigned x, unsigned& nloc, unsigned& nx) {
    const unsigned G = gridDim.x * gridDim.y * gridDim.z;
    unsigned sum, cnt, mine, sp = 0u;
    for (;;) {
        sum = 0u; cnt = 0u; mine = 0u;
#pragma unroll
        for (unsigned j = 0; j < 16; ++j) { const unsigned c = xb_ld(&bar[XB_XCNT(j)]); sum += c; cnt += (c > 0u) ? 1u : 0u; mine = (j == x) ? c : mine; }
        if (sum == G) break;
        __builtin_amdgcn_s_sleep(1);
        if ((++sp & 255u) == 0u) { if (xb_ld(&bar[XB_TMO])) break; if (sp > XB_SPIN_CAP) { atomicAdd(&bar[XB_TMO], 1u); break; } }
    }
    nloc = mine > 0u ? mine : 1u; nx = cnt > 0u ? cnt : 1u;
}
DEV void xcd_barrier(const XcdBarrier& b) {
    asm volatile("s_waitcnt vmcnt(0)" ::: "memory");
    __syncthreads();
    if (threadIdx.x == 0) {
        unsigned* bar = b.bar;
        __builtin_amdgcn_s_waitcnt(0);
        unsigned nloc = b.st[0], nx = b.st[1];
        if (nloc == 0u) { xcd_barrier_complete(bar, b.x, nloc, nx); b.st[0] = nloc; b.st[1] = nx; }
        const unsigned old = xb_add(&bar[XB_XSUB(b.x)], 1u);
        const unsigned gen = old / nloc;
        if (old + 1u == (gen + 1u) * nloc) {
            __builtin_amdgcn_fence(__ATOMIC_RELEASE, "agent");
            asm volatile("s_waitcnt vmcnt(0)" ::: "memory");
            const unsigned og = xb_add(&bar[XB_TOP], 1u);
            const unsigned tg = og / nx;
            if (og + 1u == (tg + 1u) * nx) xb_add(&bar[XB_TOPGEN], 1u);
            else XB_SPIN(xb_ld(&bar[XB_TOPGEN]) == tg, bar);
            __builtin_amdgcn_fence(__ATOMIC_ACQUIRE, "agent");
            xb_add(&bar[XB_XGEN(b.x)], 1u);
            asm volatile("s_waitcnt vmcnt(0)" ::: "memory");
        } else {
            XB_SPIN(xb_ld(&bar[XB_XGEN(b.x)]) == gen, bar);
            __builtin_amdgcn_fence(__ATOMIC_ACQUIRE, "agent");
            asm volatile("s_waitcnt vmcnt(0)" ::: "memory");
        }
    }
    __syncthreads();
}

struct P {
    const float *x, *c, *norm1_g, *norm2_g, *ada_w, *ada_b, *w_in, *b_forget, *cmp_pos_k, *cmp_w1_k, *cmp_w2_k,
        *cmp_pos_v, *cmp_w1_v, *cmp_w2_v, *out_norm_g, *w_out, *rg_w, *rg_b, *re_w, *re_b, *e_w1, *e_w3, *e_w2, *final_g;
    float* out; unsigned char* ws;
};
struct V {
    unsigned* ctl; float* mod; float* rcos; float* rsin; float* cumf; bf16_t* ck; bf16_t* cv; float* imp; unsigned* sel;
    int* eid; float* wts; int* list; float* gf; bf16_t* H; bf16_t* U; bf16_t* O; bf16_t* HID; bf16_t* Y; float* OB; float* ORAW; float* X;
};
DEV int otid() { int t = threadIdx.x; asm volatile("" : "+v"(t)); return t; }
DEV int obid() { int t = blockIdx.x; asm volatile("" : "+s"(t)); return t; }
DEV V make_views(const P& p) {
    V v; size_t woff = 0; asm volatile("" : "+s"(woff)); unsigned char* w = p.ws + woff;
    v.ctl = (unsigned*)(w + WS_CTL); v.mod = (float*)(w + WS_MOD); v.rcos = (float*)(w + WS_ROPE); v.rsin = v.rcos + S * 8;
    v.cumf = (float*)(w + WS_CUMF); v.ck = (bf16_t*)(w + WS_CK); v.cv = (bf16_t*)(w + WS_CV); v.imp = (float*)(w + WS_IMP);
    v.sel = (unsigned*)(w + WS_SEL); v.eid = (int*)(w + WS_EID); v.wts = (float*)(w + WS_WTS); v.list = (int*)(w + WS_LIST);
    v.gf = (float*)(w + WS_GF); v.H = (bf16_t*)(w + WS_H); v.U = (bf16_t*)(w + WS_U); v.O = (bf16_t*)(w + WS_O);
    v.HID = (bf16_t*)(w + WS_HID); v.Y = (bf16_t*)(w + WS_Y); v.OB = (float*)(w + WS_OB); v.ORAW = (float*)(w + WS_ORAW); v.X = p.out;
    return v;
}

DEV void ph_prologue(const P& p, float* lds) {
    const V v = make_views(p); const int TIDX = otid(), BIDX = obid();
    const int tid = TIDX;
    for (int i = tid; i < NB * D; i += 256) { const float c = p.c[i]; lds[i] = c / (1.f + expf(-c)); }
    __syncthreads();
    float* red = lds + NB * D;
    const int c4 = tid & 15, ks = tid >> 4;
    for (int unit = BIDX; unit < DEPTH * 96; unit += gridDim.x) {
        const int l = unit / 96, n0 = (unit % 96) * 64;
        const float* W = p.ada_w + (size_t)l * D * 6144 + n0 + 4 * c4;
        float acc[8][4];
#pragma unroll
        for (int b = 0; b < 8; ++b)
#pragma unroll
            for (int q = 0; q < 4; ++q) acc[b][q] = 0.f;
#pragma unroll 1
        for (int i0 = 0; i0 < 64; i0 += 8) {
            f32x4v w[8];
#pragma unroll
            for (int i = 0; i < 8; ++i) w[i] = __builtin_nontemporal_load((const f32x4v*)(W + (size_t)(ks + 16 * (i0 + i)) * 6144));
#pragma unroll
            for (int i = 0; i < 8; ++i) {
                const int k = ks + 16 * (i0 + i);
#pragma unroll
                for (int b = 0; b < 8; ++b) {
                    const float cv = lds[b * D + k];
                    acc[b][0] += cv * w[i].x; acc[b][1] += cv * w[i].y; acc[b][2] += cv * w[i].z; acc[b][3] += cv * w[i].w;
                }
            }
        }
#pragma unroll
        for (int b = 0; b < 8; ++b) *(float4*)(red + (ks * 8 + b) * 64 + 4 * c4) = make_float4(acc[b][0], acc[b][1], acc[b][2], acc[b][3]);
        __syncthreads();
        for (int o = tid; o < 512; o += 256) {
            const int c2 = o & 63, b = o >> 6;
            float sm = p.ada_b[l * 6144 + n0 + c2];
#pragma unroll
            for (int q = 0; q < 16; ++q) sm += red[(q * 8 + b) * 64 + c2];
            v.mod[(size_t)(l * 8 + b) * 6144 + n0 + c2] = sm;
        }
        __syncthreads();
    }
    const float cst = -2.0f * 13.122363377404328f / 16.0f;
    for (int i = ((int)gridDim.x - 1 - BIDX) * 256 + tid; i < S * 8; i += gridDim.x * 256) {
        const int s = i >> 3, j = i & 7;
        const float inv = expf((float)j * cst);
        const float ang = (float)s * inv;
        v.rcos[i] = cosf(ang); v.rsin[i] = sinf(ang);
    }
}

DEV void ph_norm1(const P& p, int l, int mode) {
    const V v = make_views(p); const int TIDX = otid(), BIDX = obid();
    const int lane = TIDX & 63;
    const int gw = (BIDX * 256 + TIDX) >> 6, nw = gridDim.x * 4;
    for (int m0 = gw; m0 < T; m0 += 2 * nw) {
        float4 xv[2][4];
        if (mode == 0) {
#pragma unroll
            for (int rr = 0; rr < 2; ++rr)
#pragma unroll
                for (int j = 0; j < 4; ++j) xv[rr][j] = *(const float4*)(p.x + (size_t)(m0 + rr * nw) * D + 4 * lane + 256 * j);
        } else {
            float4 xa[2][4]; ushort4 ya[2][4], yb[2][4];
#pragma unroll
            for (int rr = 0; rr < 2; ++rr)
#pragma unroll
                for (int j = 0; j < 4; ++j) {
                    const int m = m0 + rr * nw, c = 4 * lane + 256 * j;
                    xa[rr][j] = *(const float4*)(v.X + (size_t)m * D + c);
                    ya[rr][j] = *(const ushort4*)(v.Y + (size_t)(2 * m) * D + c); yb[rr][j] = *(const ushort4*)(v.Y + (size_t)(2 * m + 1) * D + c);
                }
#pragma unroll
            for (int rr = 0; rr < 2; ++rr) {
                const float* g2 = v.mod + (size_t)((l - 1) * 8 + ((m0 + rr * nw) >> 11)) * 6144 + 5 * D;
#pragma unroll
                for (int j = 0; j < 4; ++j) {
                    const float4 g = *(const float4*)(g2 + 4 * lane + 256 * j);
                    float4 a = xa[rr][j];
                    a.x += g.x * (bf2f(ya[rr][j].x) + bf2f(yb[rr][j].x)); a.y += g.y * (bf2f(ya[rr][j].y) + bf2f(yb[rr][j].y));
                    a.z += g.z * (bf2f(ya[rr][j].z) + bf2f(yb[rr][j].z)); a.w += g.w * (bf2f(ya[rr][j].w) + bf2f(yb[rr][j].w));
                    xv[rr][j] = a;
                }
            }
        }
        float ss[2];
#pragma unroll
        for (int rr = 0; rr < 2; ++rr) {
            ss[rr] = 0.f;
#pragma unroll
            for (int j = 0; j < 4; ++j) ss[rr] += xv[rr][j].x * xv[rr][j].x + xv[rr][j].y * xv[rr][j].y + xv[rr][j].z * xv[rr][j].z + xv[rr][j].w * xv[rr][j].w;
        }
#pragma unroll
        for (int o = 1; o < 64; o <<= 1) { ss[0] += __shfl_xor(ss[0], o); ss[1] += __shfl_xor(ss[1], o); }
#pragma unroll
        for (int rr = 0; rr < 2; ++rr) {
            const int m = m0 + rr * nw, b = m >> 11;
            const float r = rsqrtf(ss[rr] * (1.f / D) + EPS);
            if (mode == 2) {
#pragma unroll
                for (int j = 0; j < 4; ++j) {
                    const int c = 4 * lane + 256 * j;
                    const float4 g = *(const float4*)(p.final_g + c);
                    float4 o; o.x = xv[rr][j].x * r * g.x; o.y = xv[rr][j].y * r * g.y; o.z = xv[rr][j].z * r * g.z; o.w = xv[rr][j].w * r * g.w;
                    *(float4*)(v.X + (size_t)m * D + c) = o;
                }
            } else {
                const float* md = v.mod + (size_t)(l * 8 + b) * 6144;
#pragma unroll
                for (int j = 0; j < 4; ++j) {
                    const int c = 4 * lane + 256 * j;
                    *(float4*)(v.X + (size_t)m * D + c) = xv[rr][j];
                    const float4 g = *(const float4*)(p.norm1_g + l * D + c), sh = *(const float4*)(md + c), sc = *(const float4*)(md + D + c);
                    uint2 o;
                    o.x = cvtpk(xv[rr][j].x * r * g.x * (1.f + sc.x) + sh.x, xv[rr][j].y * r * g.y * (1.f + sc.y) + sh.y);
                    o.y = cvtpk(xv[rr][j].z * r * g.z * (1.f + sc.z) + sh.z, xv[rr][j].w * r * g.w * (1.f + sc.w) + sh.w);
                    *(uint2*)(v.H + (size_t)m * D + c) = o;
                }
            }
        }
    }
}

typedef short bf16x8 __attribute__((ext_vector_type(8)));
typedef float f32x16 __attribute__((ext_vector_type(16)));
typedef unsigned u32x4 __attribute__((ext_vector_type(4)));
constexpr size_t WS_WIN = 512 * MiB, WS_WOT = 544 * MiB, WS_W13 = 552 * MiB, WS_W2 = 808 * MiB;
constexpr int NPW = 2944;
DEV int tile_off(int row, int chunk) { return row * 128 + ((chunk ^ ((row >> 1) & 7)) << 4); }
template <class RM>
DEV void conv_patch(const float* src, int N, int K, bf16_t* dst, int k0, int n0, RM rowmap, int lane) {
    const int kg = lane >> 3, n = n0 + 4 * (lane & 7);
    if (n >= N) return;
    const float* sp = src + (size_t)(k0 + 8 * kg) * N + n;
    f32x4v x[8];
#pragma unroll
    for (int j = 0; j < 8; ++j) x[j] = __builtin_nontemporal_load((const f32x4v*)(sp + (size_t)j * N));
    bf16_t* dp = dst + k0 + 8 * kg;
    u32x4 o;
    o.x = cvtpk(x[0].x, x[1].x); o.y = cvtpk(x[2].x, x[3].x); o.z = cvtpk(x[4].x, x[5].x); o.w = cvtpk(x[6].x, x[7].x);
    *(u32x4*)(dp + (size_t)rowmap(n) * K) = o;
    o.x = cvtpk(x[0].y, x[1].y); o.y = cvtpk(x[2].y, x[3].y); o.z = cvtpk(x[4].y, x[5].y); o.w = cvtpk(x[6].y, x[7].y);
    *(u32x4*)(dp + (size_t)rowmap(n + 1) * K) = o;
    o.x = cvtpk(x[0].z, x[1].z); o.y = cvtpk(x[2].z, x[3].z); o.z = cvtpk(x[4].z, x[5].z); o.w = cvtpk(x[6].z, x[7].z);
    *(u32x4*)(dp + (size_t)rowmap(n + 2) * K) = o;
    o.x = cvtpk(x[0].w, x[1].w); o.y = cvtpk(x[2].w, x[3].w); o.z = cvtpk(x[4].w, x[5].w); o.w = cvtpk(x[6].w, x[7].w);
    *(u32x4*)(dp + (size_t)rowmap(n + 3) * K) = o;
}

DEV void conv8(const float* s0, const float* s1, bf16_t* dst) {
    f32x4v a = {0.f, 0.f, 0.f, 0.f}, b = {0.f, 0.f, 0.f, 0.f};
    if (s0) a = __builtin_nontemporal_load((const f32x4v*)s0);
    if (s1) b = __builtin_nontemporal_load((const f32x4v*)s1);
    u32x4 o; o.x = cvtpk(a[0], a[1]); o.y = cvtpk(a[2], a[3]); o.z = cvtpk(b[0], b[1]); o.w = cvtpk(b[2], b[3]);
    *(u32x4*)dst = o;
}
DEV void ph_convert_dense(const P& p, int l, int which) {
    const int TIDX = otid(), BIDX = obid();
    size_t woff = 0; asm volatile("" : "+s"(woff)); unsigned char* w = p.ws + woff;
    const size_t gtid = (size_t)BIDX * 256 + TIDX, gsz = (size_t)gridDim.x * 256;
    if (which == 0) {
        bf16_t* win = (bf16_t*)(w + WS_WIN);
        for (size_t i = gtid; i < (size_t)D * 368; i += gsz) {
            const int g8 = (int)(i % 368); const size_t lk = (size_t)l * D + i / 368;
            const int n = g8 * 8;
            const float* row = p.w_in + lk * DIN;
            const float *s0, *s1;
            if (n < 2816) { const int oc = n + (n >= 2048 ? 28 : (n >= 1280 ? 24 : 0)); s0 = row + oc; s1 = row + oc + 4; }
            else if (n < 2840) { s0 = row + 1280 + (n - 2816); s1 = s0 + 4; }
            else if (n == 2840) { s0 = row + 2072; s1 = nullptr; }
            else { s0 = nullptr; s1 = nullptr; }
            conv8(s0, s1, win + lk * NPW + n);
        }
    } else {
        bf16_t* wot = (bf16_t*)(w + WS_WOT);
        const size_t oo = (size_t)l * D * D;
        for (size_t i = gtid; i < (size_t)D * D / 8; i += gsz) conv8(p.w_out + oo + i * 8, p.w_out + oo + i * 8 + 4, wot + oo + i * 8);
        for (size_t i = gtid; i < (size_t)2 * 2048 * 128 / 8; i += gsz) {
            const size_t per = (size_t)2048 * 128 / 8; const int kv = (int)(i / per), lk = l * 2 + kv; const size_t off = (i % per) * 8;
            const float* src = (kv ? p.cmp_w1_v : p.cmp_w1_k) + (size_t)l * 2048 * 128 + off;
            conv8(src, src + 4, (bf16_t*)(w + WS_CW1) + (size_t)lk * 2048 * 128 + off);
        }
    }
}
DEV void ph_convert_experts(const P& p, int l) {
    const int TIDX = otid(), BIDX = obid();
    size_t woff = 0; asm volatile("" : "+s"(woff)); unsigned char* w = p.ws + woff;
    bf16_t* w13 = (bf16_t*)(w + WS_W13); bf16_t* w2t = (bf16_t*)(w + WS_W2);
    const size_t gtid = (size_t)BIDX * 256 + TIDX, gsz = (size_t)gridDim.x * 256;
    for (size_t i = gtid; i < (size_t)32 * D * 128; i += gsz) {
        const int g8 = (int)(i & 127); const size_t lek = (size_t)l * 32 * D + (i >> 7);
        const int n = g8 * 8, which = (n >> 5) & 1, c = 32 * (n >> 6) + (n & 31);
        const float* src = (which ? p.e_w3 : p.e_w1) + lek * 512 + c;
        conv8(src, src + 4, w13 + lek * 1024 + n);
    }
    const size_t o2 = (size_t)l * 32 * 512 * D;
    for (size_t i = gtid; i < (size_t)32 * 512 * D / 8; i += gsz) conv8(p.e_w2 + o2 + i * 8, p.e_w2 + o2 + i * 8 + 4, w2t + o2 + i * 8);
}
DEV void ph_convert(const P& p, float* lds) {
    const int TIDX = otid(), BIDX = obid();
    size_t woff = 0; asm volatile("" : "+s"(woff)); unsigned char* w = p.ws + woff;
    const int lane = TIDX & 63;
    for (int unit = BIDX * 4 + (TIDX >> 6); unit < DEPTH * 2 * 4; unit += gridDim.x * 4) {
        const int lk = unit >> 2, t = unit & 3, l = lk >> 1, kv = lk & 1;
        conv_patch((kv ? p.cmp_w2_v : p.cmp_w2_k) + (size_t)l * 128 * 64, 64, 128, (bf16_t*)(w + WS_CW2) + (size_t)lk * 64 * 128, (t >> 1) * 64, (t & 1) * 32, [](int n) { return n; }, lane);
    }
    for (int o = BIDX * 256 + TIDX; o < DEPTH * 64 * D; o += gridDim.x * 256) {
        const int k = o & (D - 1), n = (o >> 10) & 63, l = o >> 16;
        const float val = n < 4 ? p.rg_w[((size_t)l * D + k) * 4 + n] : (n < 36 ? p.re_w[((size_t)l * D + k) * 32 + n - 4] : 0.f);
        const bf16_t hi = f2bf(val); const bf16_t lo = f2bf(val - bf2f(hi));
        bf16_t* wr = (bf16_t*)(w + WS_WR) + (size_t)l * 2 * 64 * D;
        wr[n * D + k] = hi; wr[64 * D + n * D + k] = lo;
    }
    int pu = (int)gridDim.x - 1 - BIDX - 64; if (pu < 0) pu += gridDim.x;
    for (int unit = pu; unit < DEPTH * 2 * 8; unit += gridDim.x) {
        const int lk = unit >> 3, ch = unit & 7, l = lk >> 1, kv = lk & 1, j = TIDX & 127, hf = TIDX >> 7;
        const float* pe = (kv ? p.cmp_pos_v : p.cmp_pos_k) + (size_t)l * 2048 + ch * 256 + hf * 128;
        const float* w1 = (kv ? p.cmp_w1_v : p.cmp_w1_k) + (size_t)l * 2048 * 128 + (size_t)(ch * 256 + hf * 128) * 128 + j;
        float a0 = 0.f, a1 = 0.f, a2 = 0.f, a3 = 0.f;
#pragma unroll 1
        for (int k0 = 0; k0 < 128; k0 += 32) {
            float wv[32];
#pragma unroll
            for (int k = 0; k < 32; ++k) wv[k] = w1[(size_t)(k0 + k) * 128];
#pragma unroll
            for (int k = 0; k < 32; k += 4) {
                a0 += pe[k0 + k] * wv[k]; a1 += pe[k0 + k + 1] * wv[k + 1];
                a2 += pe[k0 + k + 2] * wv[k + 2]; a3 += pe[k0 + k + 3] * wv[k + 3];
            }
        }
        const float a = (a0 + a1) + (a2 + a3);
        __syncthreads();
        if (hf) lds[j] = a;
        __syncthreads();
        if (!hf) ((float*)(w + WS_CPB))[(lk * 8 + ch) * 128 + j] = a + lds[j];
    }
}

typedef short v4i16_t __attribute__((ext_vector_type(4)));
DEV void gemm_issue0(unsigned char* lds, const bf16_t* const (&arow)[4], const bf16_t* Bsrc, const size_t ldb, const int TIDX) {
    const int lane = TIDX & 63, wave = TIDX >> 6;
    const int gsw = ((TIDX & 7) ^ ((TIDX >> 4) & 7)) * 8;
    const bf16_t* bg = Bsrc + (size_t)(4 * wave + (lane >> 4)) * ldb + ((lane & 15) ^ (((lane >> 4) << 2) | (wave & 3))) * 8;
    LAS unsigned char* l3 = (LAS unsigned char*)lds + __builtin_amdgcn_readfirstlane(wave) * 1024;
#pragma unroll
    for (int i = 0; i < 4; ++i) {
        __builtin_amdgcn_global_load_lds((const unsigned*)(arow[i] + gsw), (LAS unsigned*)(l3 + i * 4096), 16, 0, 0);
        __builtin_amdgcn_global_load_lds((const unsigned*)(bg + (size_t)(16 * i) * ldb), (LAS unsigned*)(l3 + 16384 + i * 4096), 16, 0, 0);
    }
}
template <bool SWAP, bool PRE = false>
DEV void gemm128(unsigned char* lds, const bf16_t* const (&arow)[4], const bf16_t* Bsrc, const size_t ldb, int K, f32x16 (&acc)[2][2], const int TIDX, const int astride = 64) {
    const int lane = TIDX & 63, wave = TIDX >> 6, wm = wave >> 1, wn = wave & 1, r = lane & 31, h = lane >> 5;
#pragma unroll
    for (int j = 0; j < 2; ++j)
#pragma unroll
        for (int i = 0; i < 2; ++i)
#pragma unroll
            for (int q = 0; q < 16; ++q) acc[j][i][q] = 0.f;
    const int gsw = ((TIDX & 7) ^ ((TIDX >> 4) & 7)) * 8;
    const bf16_t* ag[4];
#pragma unroll
    for (int i = 0; i < 4; ++i) ag[i] = arow[i] + gsw;
    const int brow = 4 * wave + (lane >> 4), bch = ((lane & 15) ^ (((lane >> 4) << 2) | (wave & 3))) * 8;
    const bf16_t* bg = Bsrc + (size_t)brow * ldb + bch;
    LAS unsigned char* l3 = (LAS unsigned char*)lds + __builtin_amdgcn_readfirstlane(wave) * 1024;
    LAS unsigned char* tb[2][2];
    {
        const int blk = (lane >> 4) & 1, q = (lane & 15) >> 2, pp = lane & 3;
#pragma unroll
        for (int j = 0; j < 2; ++j)
#pragma unroll
            for (int t = 0; t < 2; ++t) {
                const int row = 4 * t + 8 * h + q, ch = 4 * (2 * wn + j) + 2 * blk + (pp >> 1);
                tb[j][t] = (LAS unsigned char*)lds + 16384 + 256 * row + 16 * (ch ^ (((row & 3) << 2) | ((row >> 2) & 3))) + 8 * (pp & 1);
            }
    }
#define G_DMA(st_, kt_) do { _Pragma("unroll") for (int i = 0; i < 4; ++i) { \
        __builtin_amdgcn_global_load_lds((const unsigned*)(ag[i] + (size_t)(kt_) * astride), (LAS unsigned*)(l3 + (st_) + i * 4096), 16, 0, 0); \
        __builtin_amdgcn_global_load_lds((const unsigned*)(bg + ((size_t)(kt_) * 64 + 16 * i) * ldb), (LAS unsigned*)(l3 + (st_) + 16384 + i * 4096), 16, 0, 0); } } while (0)
    const int KT = K >> 6;
    if (!PRE) {
        __syncthreads();
        G_DMA(0, 0);
    }
    for (int kt = 0; kt < KT; ++kt) {
        asm volatile("s_waitcnt vmcnt(0) lgkmcnt(0)" ::: "memory");
        __builtin_amdgcn_s_barrier();
        asm volatile("" ::: "memory");
        if (kt + 1 < KT) G_DMA(((kt + 1) & 1) * 32768, kt + 1);
        const int so = (kt & 1) * 32768;
        const unsigned char* cur = lds + so;
#pragma unroll
        for (int kk = 0; kk < 4; ++kk) {
            bf16x8 af[2], wf[2];
#pragma unroll
            for (int i = 0; i < 2; ++i) af[i] = *(const bf16x8*)(cur + tile_off(64 * wm + 32 * i + r, 2 * kk + h));
#pragma unroll
            for (int j = 0; j < 2; ++j) {
                const v4i16_t lo = __builtin_amdgcn_ds_read_tr16_b64_v4i16((LAS v4i16_t*)(tb[j][0] + so + 4096 * kk));
                const v4i16_t hi = __builtin_amdgcn_ds_read_tr16_b64_v4i16((LAS v4i16_t*)(tb[j][1] + so + 4096 * kk));
                wf[j] = (bf16x8){lo[0], lo[1], lo[2], lo[3], hi[0], hi[1], hi[2], hi[3]};
            }
#pragma unroll
            for (int j = 0; j < 2; ++j)
#pragma unroll
                for (int i = 0; i < 2; ++i) acc[j][i] = SWAP ? __builtin_amdgcn_mfma_f32_32x32x16_bf16(af[i], wf[j], acc[j][i], 0, 0, 0)
                                                             : __builtin_amdgcn_mfma_f32_32x32x16_bf16(wf[j], af[i], acc[j][i], 0, 0, 0);
        }
    }
    __syncthreads();
#undef G_DMA
}

constexpr int CST = 272;
DEV void ctile_put(unsigned char* lds, int row, int col, float a, float b, float c, float d) {
    uint2 u; u.x = cvtpk(a, b); u.y = cvtpk(c, d);
    *(uint2*)(lds + row * CST + col * 2) = u;
}
template <int COLS, class RP>
DEV void ctile_flush(unsigned char* lds, const int TIDX, RP rowptr) {
    asm volatile("s_waitcnt lgkmcnt(0)" ::: "memory");
    __builtin_amdgcn_s_barrier();
    asm volatile("" ::: "memory");
    constexpr int CPR = COLS / 8, RPI = 256 / CPR;
#pragma unroll
    for (int it = 0; it < 128 / RPI; ++it) {
        const int row = it * RPI + TIDX / CPR, c16 = TIDX % CPR;
        bf16_t* dst = rowptr(row, it);
        const u32x4 val = *(const u32x4*)(lds + row * CST + c16 * 16);
        if (dst) *(u32x4*)(dst + c16 * 8) = val;
    }
}

DEV void ph_inproj_fast(const P& p, int l, unsigned char* lds) {
    const V v = make_views(p); const int TIDX = otid(), BIDX = obid();
    const bf16_t* W = (const bf16_t*)(p.ws + WS_WIN) + (size_t)l * D * NPW;
    const int lane = TIDX & 63, wave = TIDX >> 6, wm = wave >> 1, wn = wave & 1, r = lane & 31, h = lane >> 5;
    const bool xo = gridDim.x == 512;
    unsigned char* ct = lds + 32768;
    auto decode = [&](int it, int& mt, int& nt) -> int {
        if (xo) { if (it >= 6) return -1; const int lb = BIDX >> 3; nt = 8 * (it % 3) + (lb >> 3); mt = 16 * (BIDX & 7) + 8 * (it / 3) + (lb & 7); return nt < 23 ? 1 : 0; }
        const int unit = BIDX + it * (int)gridDim.x; if (unit >= 128 * 23) return -1; nt = unit / 128; mt = unit % 128; return 1;
    };
    auto issue = [&](int mt, int nt) {
        const bf16_t* ar[4];
#pragma unroll
        for (int i = 0; i < 4; ++i) ar[i] = v.H + (size_t)(mt * 128 + (TIDX >> 3) + 32 * i) * D;
        gemm_issue0(lds, ar, W + nt * 128, NPW, TIDX);
    };
    bool pre = false;
    for (int it = 0;; ++it) {
        int nt, mt;
        const int dv = decode(it, mt, nt);
        if (dv < 0) break;
        if (dv == 0) continue;
        const int m0 = mt * 128, n0 = nt * 128;
        const bf16_t* arow[4];
#pragma unroll
        for (int i = 0; i < 4; ++i) arow[i] = v.H + (size_t)(m0 + (TIDX >> 3) + 32 * i) * D;
        if (!pre) { __syncthreads(); issue(mt, nt); pre = true; }
        int itn = it + 1, mtn = 0, ntn = 0, dn;
        while ((dn = decode(itn, mtn, ntn)) == 0) ++itn;
        f32x16 acc[2][2];
        if (is_vcol(n0)) {
            gemm128<true, true>(lds, arow, W + n0, NPW, D, acc, TIDX);
            if (dn > 0) issue(mtn, ntn); else pre = false;
#pragma unroll
            for (int j = 0; j < 2; ++j)
#pragma unroll
                for (int i = 0; i < 2; ++i)
#pragma unroll
                    for (int g = 0; g < 4; ++g)
                        ctile_put(ct, 64 * wn + 32 * j + r, 64 * wm + 32 * i + 8 * g + 4 * h, acc[j][i][4 * g], acc[j][i][4 * g + 1], acc[j][i][4 * g + 2], acc[j][i][4 * g + 3]);
            bf16_t* vt = (bf16_t*)(p.ws + WS_VT) + ((size_t)(m0 >> 11) * 768 + vt_row(n0)) * S + (m0 & (S - 1));
            ctile_flush<128>(ct, TIDX, [&](int row, int) { return vt + (size_t)row * S; });
            continue;
        }
        const bool rope_tile = n0 < 512 || n0 == C_KS || n0 == C_KW;
        f32x4v rcs[2], rsn[2];
        if (rope_tile) {
#pragma unroll
            for (int i = 0; i < 2; ++i) {
                const int sp = (m0 + 64 * wm + 32 * i + r) & (S - 1);
                rcs[i] = *(const f32x4v*)(v.rcos + sp * 8 + 4 * h); rsn[i] = *(const f32x4v*)(v.rsin + sp * 8 + 4 * h);
            }
        }
        gemm128<false, true>(lds, arow, W + n0, NPW, D, acc, TIDX);
        if (dn > 0) issue(mtn, ntn); else pre = false;
        if (n0 == 2816) {
            if (wn == 0) {
#pragma unroll
                for (int i = 0; i < 2; ++i) {
                    const int m = m0 + 64 * wm + 32 * i + r;
#pragma unroll
                    for (int q = 0; q < 16; ++q) {
                        const int cc = (q & 3) + 8 * (q >> 2) + 4 * h;
                        if (cc < 24) v.gf[(size_t)m * 32 + cc] = acc[0][i][q];
                        else if (cc < 28) ((float*)(p.ws + WS_LSF))[(size_t)((m >> 11) * 4 + cc - 24) * S + (m & (S - 1))] = logsigmoidf_(acc[0][i][q] + p.b_forget[l * 4 + cc - 24]);
                    }
                }
            }
            continue;
        }
#pragma unroll
        for (int j = 0; j < 2; ++j) {
            const int nb = n0 + 64 * wn + 32 * j;
            const bool rope = ((nb & 63) == 0) && (nb < 512 || (nb >= C_KS && nb < C_VS) || (nb >= C_KW && nb < C_VW));
#pragma unroll
            for (int i = 0; i < 2; ++i) {
                f32x16 a = acc[j][i];
                if (rope) {
#pragma unroll
                    for (int q = 0; q < 4; ++q) { const float x1 = a[q], x2 = a[q + 4]; a[q] = x1 * rcs[i][q] - x2 * rsn[i][q]; a[q + 4] = x2 * rcs[i][q] + x1 * rsn[i][q]; }
                }
#pragma unroll
                for (int g = 0; g < 4; ++g) ctile_put(ct, 64 * wm + 32 * i + r, 64 * wn + 32 * j + 8 * g + 4 * h, a[4 * g], a[4 * g + 1], a[4 * g + 2], a[4 * g + 3]);
            }
        }
        bf16_t* ub = v.U + (size_t)m0 * NP + n0;
        ctile_flush<128>(ct, TIDX, [&](int row, int) { return ub + (size_t)row * NP; });
    }
}

DEV void ph_outproj_fast(const P& p, int l, unsigned char* lds) {
    const V v = make_views(p); const int TIDX = otid(), BIDX = obid();
    const bf16_t* W = (const bf16_t*)(p.ws + WS_WOT) + (size_t)l * D * D;
    const int lane = TIDX & 63, wave = TIDX >> 6, wm = wave >> 1, wn = wave & 1, r = lane & 31, h = lane >> 5;
    const bool xo = gridDim.x == 512;
    auto decode = [&](int it, int& mt, int& nt) -> bool {
        if (xo) { if (it >= 2) return false; const int lb = BIDX >> 3; nt = lb >> 3; mt = 16 * (BIDX & 7) + 8 * it + (lb & 7); return true; }
        const int unit = BIDX + it * (int)gridDim.x; if (unit >= 128 * 8) return false; nt = unit / 128; mt = unit % 128; return true;
    };
    auto issue = [&](int mt, int nt) {
        const bf16_t* ar[4];
#pragma unroll
        for (int i = 0; i < 4; ++i) ar[i] = v.O + (size_t)(mt * 128 + (TIDX >> 3) + 32 * i) * D;
        gemm_issue0(lds, ar, W + nt * 128, D, TIDX);
    };
    for (int it = 0;; ++it) {
        int nt, mt, ntn = 0, mtn = 0;
        if (!decode(it, mt, nt)) break;
        const bool hasn = decode(it + 1, mtn, ntn);
        const int m0 = mt * 128, n0 = nt * 128;
        const bf16_t* arow[4];
#pragma unroll
        for (int i = 0; i < 4; ++i) arow[i] = v.O + (size_t)(m0 + (TIDX >> 3) + 32 * i) * D;
        if (it == 0) { __syncthreads(); issue(mt, nt); }
        f32x4v xin[2][2][4];
#pragma unroll
        for (int j = 0; j < 2; ++j)
#pragma unroll
            for (int i = 0; i < 2; ++i)
#pragma unroll
                for (int g = 0; g < 4; ++g) xin[j][i][g] = *(const f32x4v*)(v.X + (size_t)(m0 + 64 * wm + 32 * i + r) * D + n0 + 64 * wn + 32 * j + 4 * h + 8 * g);
        f32x16 acc[2][2];
        gemm128<false, true>(lds, arow, W + n0, D, D, acc, TIDX);
        if (hasn) issue(mtn, ntn);
        const float* g1 = v.mod + (size_t)(l * 8 + (m0 >> 11)) * 6144 + 2 * D;
#pragma unroll
        for (int j = 0; j < 2; ++j)
#pragma unroll
            for (int i = 0; i < 2; ++i) {
                const int m = m0 + 64 * wm + 32 * i + r, nb = n0 + 64 * wn + 32 * j + 4 * h;
#pragma unroll
                for (int g = 0; g < 4; ++g) {
                    const float4 gg = *(const float4*)(g1 + nb + 8 * g);
                    f32x4v xo = xin[j][i][g];
                    xo[0] += gg.x * acc[j][i][4 * g]; xo[1] += gg.y * acc[j][i][4 * g + 1]; xo[2] += gg.z * acc[j][i][4 * g + 2]; xo[3] += gg.w * acc[j][i][4 * g + 3];
                    *(f32x4v*)(v.X + (size_t)m * D + nb + 8 * g) = xo;
                }
            }
    }
}

DEV void ph_moe_up_fast(const P& p, int l, unsigned char* lds) {
    const V v = make_views(p); const int TIDX = otid(), BIDX = obid();
    const int lane = TIDX & 63, wave = TIDX >> 6, wm = wave >> 1, wn = wave & 1, r = lane & 31, h = lane >> 5;
    const unsigned* cnt = v.ctl + CW_CNT + l * 32;
    int* tp = (int*)(lds + 67584); int* rb = tp + 40;
    __syncthreads();
    if (TIDX < 64) {
        const int c = TIDX < 32 ? (int)cnt[TIDX] : 0;
        int nu = ((c + 127) >> 7) * 8, cc = c;
#pragma unroll
        for (int o = 1; o < 32; o <<= 1) { const int a = __shfl_up(nu, o), b2 = __shfl_up(cc, o); if ((TIDX & 31) >= o) { nu += a; cc += b2; } }
        if (TIDX < 32) { tp[TIDX + 1] = nu; rb[TIDX + 1] = cc; if (TIDX == 0) { tp[0] = 0; rb[0] = 0; } }
    }
    __syncthreads();
    const int total = tp[32];
    unsigned char* ct = lds + 32768;
    struct UU { int e, base, nt, mt, nrow; const int* lst; const bf16_t* B; const bf16_t* ar[4]; };
    auto setup = [&](int unit, UU& u) {
        int e = 0;
#pragma unroll
        for (int st = 16; st > 0; st >>= 1) if (tp[e + st] <= unit) e += st;
        const int rem = unit - tp[e];
        u.e = e; u.base = rb[e]; u.nt = rem & 7; u.mt = rem >> 3;
        const int ce = rb[e + 1] - u.base;
        u.lst = v.list + (size_t)e * T + u.mt * 128;
        u.nrow = ce - u.mt * 128 < 128 ? ce - u.mt * 128 : 128;
        u.B = (const bf16_t*)(p.ws + WS_W13) + ((size_t)l * 32 + e) * 1024 * D + u.nt * 128;
#pragma unroll
        for (int i = 0; i < 4; ++i) { const int rr = (TIDX >> 3) + 32 * i; u.ar[i] = v.H + (size_t)(u.lst[rr < u.nrow ? rr : 0] >> 1) * D; }
    };
    int unit = BIDX;
    if (unit >= total) return;
    UU cu, nu;
    setup(unit, cu);
    __syncthreads();
    gemm_issue0(lds, cu.ar, cu.B, 1024, TIDX);
    for (;;) {
        const int un = unit + (int)gridDim.x;
        f32x16 acc[2][2];
        gemm128<false, true>(lds, cu.ar, cu.B, 1024, D, acc, TIDX);
        if (un < total) { setup(un, nu); gemm_issue0(lds, nu.ar, nu.B, 1024, TIDX); }
#pragma unroll
        for (int i = 0; i < 2; ++i)
#pragma unroll
            for (int g = 0; g < 4; ++g) {
                float o[4];
#pragma unroll
                for (int q = 0; q < 4; ++q) { const float a1 = acc[0][i][4 * g + q], a3 = acc[1][i][4 * g + q]; o[q] = a1 / (1.f + __expf(-a1)) * a3; }
                ctile_put(ct, 64 * wm + 32 * i + r, 32 * wn + 8 * g + 4 * h, o[0], o[1], o[2], o[3]);
            }
        bf16_t* hb = v.HID + (size_t)(cu.base + cu.mt * 128) * 512 + 64 * cu.nt;
        const int nrow = cu.nrow;
        ctile_flush<64>(ct, TIDX, [&](int row, int) { return row < nrow ? hb + (size_t)row * 512 : (bf16_t*)nullptr; });
        if (un >= total) break;
        unit = un; cu = nu;
    }
}
DEV void ph_moe_down_fast(const P& p, int l, unsigned char* lds) {
    const V v = make_views(p); const int TIDX = otid(), BIDX = obid();
    const int lane = TIDX & 63, wave = TIDX >> 6, wm = wave >> 1, wn = wave & 1, r = lane & 31, h = lane >> 5;
    const unsigned* cnt = v.ctl + CW_CNT + l * 32;
    int* tp = (int*)(lds + 67584); int* rb = tp + 40;
    __syncthreads();
    if (TIDX < 64) {
        const int c = TIDX < 32 ? (int)cnt[TIDX] : 0;
        int nu = ((c + 127) >> 7) * 8, cc = c;
#pragma unroll
        for (int o = 1; o < 32; o <<= 1) { const int a = __shfl_up(nu, o), b2 = __shfl_up(cc, o); if ((TIDX & 31) >= o) { nu += a; cc += b2; } }
        if (TIDX < 32) { tp[TIDX + 1] = nu; rb[TIDX + 1] = cc; if (TIDX == 0) { tp[0] = 0; rb[0] = 0; } }
    }
    __syncthreads();
    const int total = tp[32];
    unsigned char* ct = lds + 32768;
    struct UD { int n0, nrow; const bf16_t* B; const bf16_t* ar[4]; float wrow[2]; int fslot[8]; };
    auto setup = [&](int unit, UD& u) {
        int e = 0;
#pragma unroll
        for (int st = 16; st > 0; st >>= 1) if (tp[e + st] <= unit) e += st;
        const int rem = unit - tp[e], base = rb[e];
        const int ce = rb[e + 1] - base, nt = rem & 7, mt = rem >> 3;
        const int* lst = v.list + (size_t)e * T + mt * 128;
        u.n0 = nt * 128;
        u.nrow = ce - mt * 128 < 128 ? ce - mt * 128 : 128;
        u.B = (const bf16_t*)(p.ws + WS_W2) + ((size_t)l * 32 + e) * 512 * D + u.n0;
#pragma unroll
        for (int i = 0; i < 4; ++i) { const int rr = (TIDX >> 3) + 32 * i; u.ar[i] = v.HID + (size_t)(base + mt * 128 + (rr < u.nrow ? rr : 0)) * 512; }
#pragma unroll
        for (int i = 0; i < 2; ++i) { const int mr = 64 * wm + 32 * i + r; u.wrow[i] = mr < u.nrow ? v.wts[lst[mr]] : 0.f; }
#pragma unroll
        for (int it = 0; it < 8; ++it) { const int row = it * 16 + (TIDX >> 4); u.fslot[it] = row < u.nrow ? lst[row] : -1; }
    };
    int unit = BIDX;
    if (unit >= total) return;
    UD cu, nu;
    setup(unit, cu);
    __syncthreads();
    gemm_issue0(lds, cu.ar, cu.B, D, TIDX);
    for (;;) {
        const int un = unit + (int)gridDim.x;
        f32x16 acc[2][2];
        gemm128<false, true>(lds, cu.ar, cu.B, D, 512, acc, TIDX);
        if (un < total) { setup(un, nu); gemm_issue0(lds, nu.ar, nu.B, D, TIDX); }
#pragma unroll
        for (int i = 0; i < 2; ++i) {
            const int mr = 64 * wm + 32 * i + r;
            const float w = cu.wrow[i];
#pragma unroll
            for (int j = 0; j < 2; ++j)
#pragma unroll
                for (int g = 0; g < 4; ++g)
                    ctile_put(ct, mr, 64 * wn + 32 * j + 8 * g + 4 * h, w * acc[j][i][4 * g], w * acc[j][i][4 * g + 1], w * acc[j][i][4 * g + 2], w * acc[j][i][4 * g + 3]);
        }
        const int n0 = cu.n0;
        ctile_flush<128>(ct, TIDX, [&](int, int it) { const int sl = cu.fslot[it]; return sl >= 0 ? v.Y + (size_t)sl * D + n0 : (bf16_t*)nullptr; });
        if (un >= total) break;
        unit = un; cu = nu;
    }
}

constexpr float LOG2E = 1.4426950408889634f, C2 = 0.125f * 1.4426950408889634f, LN2 = 0.6931471805599453f;
DEV float fexp2(float x) { return __builtin_amdgcn_exp2f(x); }
DEV float flog2(float x) { return __builtin_amdgcn_logf(x); }
DEV int swap23(int r) { return (r & ~12) | ((r & 4) << 1) | ((r & 8) >> 1); }

struct KVT { const bf16_t* k; int ks; const bf16_t* v; int vs; };
DEV void kv_load(const KVT& s, int kv0, const int TIDX, u32x4 (&rg)[4]) {
    const int c = TIDX & 7, r0 = TIDX >> 3;
    rg[0] = *(const u32x4*)(s.k + (size_t)(kv0 + r0) * s.ks + c * 8);
    rg[1] = *(const u32x4*)(s.k + (size_t)(kv0 + r0 + 32) * s.ks + c * 8);
    rg[2] = *(const u32x4*)(s.v + (size_t)r0 * s.vs + kv0 + c * 8);
    rg[3] = *(const u32x4*)(s.v + (size_t)(r0 + 32) * s.vs + kv0 + c * 8);
}
DEV void kv_store(unsigned char* st, const int TIDX, const u32x4 (&rg)[4]) {
    const int c = TIDX & 7, r0 = TIDX >> 3;
    *(u32x4*)(st + tile_off(r0, c)) = rg[0]; *(u32x4*)(st + tile_off(r0 + 32, c)) = rg[1];
    *(u32x4*)(st + 8192 + tile_off(r0, c)) = rg[2]; *(u32x4*)(st + 8192 + tile_off(r0 + 32, c)) = rg[3];
}
DEV bf16x8 scale_frag(bf16x8 v, float sc) {
    u32x4 u = __builtin_bit_cast(u32x4, v);
#pragma unroll
    for (int i = 0; i < 4; ++i) u[i] = cvtpk(__uint_as_float(u[i] << 16) * sc, __uint_as_float(u[i] & 0xffff0000u) * sc);
    return __builtin_bit_cast(bf16x8, u);
}
DEV void score_tile(const unsigned char* Kt, const bf16x8 (&qf)[4], int r, int h, f32x16 (&p)[2]) {
    const int kr = swap23(r);
#pragma unroll
    for (int blk = 0; blk < 2; ++blk) {
#pragma unroll
        for (int q = 0; q < 16; ++q) p[blk][q] = 0.f;
#pragma unroll
        for (int s = 0; s < 4; ++s) {
            const bf16x8 kf = *(const bf16x8*)(Kt + tile_off(32 * blk + kr, 2 * s + h));
            p[blk] = __builtin_amdgcn_mfma_f32_32x32x16_bf16(kf, qf[s], p[blk], 0, 0, 0);
        }
    }
}
DEV void pv_tile(const unsigned char* Vt, const f32x16 (&p)[2], int r, int h, f32x16 (&o)[2]) {
#pragma unroll
    for (int blk = 0; blk < 2; ++blk)
#pragma unroll
        for (int s = 0; s < 2; ++s) {
            u32x4 pk;
            pk.x = cvtpk(p[blk][8 * s], p[blk][8 * s + 1]); pk.y = cvtpk(p[blk][8 * s + 2], p[blk][8 * s + 3]);
            pk.z = cvtpk(p[blk][8 * s + 4], p[blk][8 * s + 5]); pk.w = cvtpk(p[blk][8 * s + 6], p[blk][8 * s + 7]);
            const bf16x8 pb = __builtin_bit_cast(bf16x8, pk);
#pragma unroll
            for (int db = 0; db < 2; ++db) {
                const bf16x8 vf = *(const bf16x8*)(Vt + tile_off(32 * db + r, 2 * (2 * blk + s) + h));
                o[db] = __builtin_amdgcn_mfma_f32_32x32x16_bf16(vf, pb, o[db], 0, 0, 0);
            }
        }
}

template <int VAR>
DEV void attn_branch(unsigned char* lds, const KVT& src, const bf16x8 (&qf)[4], unsigned tmask, int wave_last, int t, int t_first,
                     unsigned selbits, const float* bias2, f32x16 (&o)[2], const int TIDX) {
    const int lane = TIDX & 63, r = lane & 31, h = lane >> 5;
    const float NEG_INF = -__builtin_inff();
    float mrun = -1e30f, lrun = 0.f, rest = VAR == 3 ? 1.f : 0.f;
#pragma unroll
    for (int db = 0; db < 2; ++db)
#pragma unroll
        for (int q = 0; q < 16; ++q) o[db][q] = 0.f;
    u32x4 rg[4];
    unsigned rem = tmask;
    int j = VAR == 3 ? 31 - __builtin_clz(rem) : __builtin_ctz(rem);
    rem &= ~(1u << j);
    kv_load(src, 64 * j, TIDX, rg);
    __syncthreads();
    kv_store(lds, TIDX, rg);
    __syncthreads();
    int stage = 0;
    for (;;) {
        int jn = -1;
        if (rem) { jn = VAR == 3 ? 31 - __builtin_clz(rem) : __builtin_ctz(rem); rem &= ~(1u << jn); kv_load(src, 64 * jn, TIDX, rg); }
        asm volatile("" ::: "memory"); __builtin_amdgcn_sched_barrier(0);
        if (j <= wave_last) {
            const unsigned char* Kt = lds + stage * 16384;
            f32x16 p[2];
            score_tile(Kt, qf, r, h, p);
            const int kvb = 64 * j + 8 * h;
            if (VAR == 3) {
                const bool diag = 64 * j + 63 >= t_first;
                float gt[2][2];
                if (diag) {
#pragma unroll
                    for (int blk = 0; blk < 2; ++blk)
#pragma unroll
                        for (int s = 0; s < 2; ++s) {
                            float run = 1.f;
#pragma unroll
                            for (int q = 7; q >= 0; --q) {
                                const float ez = fexp2(p[blk][8 * s + q]);
                                float w = __builtin_amdgcn_rcpf(1.f + ez);
                                float beta = 1.f - w;
                                const bool valid = kvb + 32 * blk + 16 * s + q < t;
                                w = valid ? w : 1.f; beta = valid ? beta : 0.f;
                                p[blk][8 * s + q] = beta * run;
                                run *= w;
                            }
                            gt[blk][s] = run;
                        }
                } else {
#pragma unroll
                    for (int blk = 0; blk < 2; ++blk)
#pragma unroll
                        for (int s = 0; s < 2; ++s) {
                            float run = 1.f;
#pragma unroll
                            for (int q = 7; q >= 0; --q) {
                                const float rn = run * __builtin_amdgcn_rcpf(1.f + fexp2(p[blk][8 * s + q]));
                                p[blk][8 * s + q] = run - rn;
                                run = rn;
                            }
                            gt[blk][s] = run;
                        }
                }
                float og[2][2], pt[2][2];
#pragma unroll
                for (int blk = 0; blk < 2; ++blk)
#pragma unroll
                    for (int s = 0; s < 2; ++s) { og[blk][s] = __shfl_xor(gt[blk][s], 32); pt[blk][s] = gt[blk][s] * og[blk][s]; }
                float above = rest;
#pragma unroll
                for (int pi = 3; pi >= 0; --pi) {
                    const int blk = pi >> 1, s = pi & 1;
                    const float carry = above * (h == 0 ? og[blk][s] : 1.f);
#pragma unroll
                    for (int q = 0; q < 8; ++q) p[blk][8 * s + q] *= carry;
                    above *= pt[blk][s];
                }
                rest = above;
            } else {
                const bool need_causal = 64 * j + 63 > t_first;
                const bool need_win = VAR == 1 && (64 * j + 512 <= t_first + 31);
                const bool lane_on = VAR != 0 || ((selbits >> j) & 1u);
                if (VAR == 2) {
#pragma unroll
                    for (int blk = 0; blk < 2; ++blk)
#pragma unroll
                        for (int s = 0; s < 2; ++s) {
                            const float4 b0 = *(const float4*)(bias2 + kvb + 32 * blk + 16 * s), b1 = *(const float4*)(bias2 + kvb + 32 * blk + 16 * s + 4);
                            p[blk][8 * s] += b0.x; p[blk][8 * s + 1] += b0.y; p[blk][8 * s + 2] += b0.z; p[blk][8 * s + 3] += b0.w;
                            p[blk][8 * s + 4] += b1.x; p[blk][8 * s + 5] += b1.y; p[blk][8 * s + 6] += b1.z; p[blk][8 * s + 7] += b1.w;
                        }
                }
                if (need_causal) {
#pragma unroll
                    for (int blk = 0; blk < 2; ++blk)
#pragma unroll
                        for (int q = 0; q < 16; ++q) { const int kv = kvb + 32 * blk + 16 * (q >> 3) + (q & 7); p[blk][q] = kv <= t ? p[blk][q] : NEG_INF; }
                }
                if (need_win) {
#pragma unroll
                    for (int blk = 0; blk < 2; ++blk)
#pragma unroll
                        for (int q = 0; q < 16; ++q) { const int kv = kvb + 32 * blk + 16 * (q >> 3) + (q & 7); p[blk][q] = kv + 512 > t ? p[blk][q] : NEG_INF; }
                }
                float tmax = p[0][0];
#pragma unroll
                for (int q = 1; q < 16; ++q) tmax = fmaxf(tmax, p[0][q]);
#pragma unroll
                for (int q = 0; q < 16; ++q) tmax = fmaxf(tmax, p[1][q]);
                tmax = lane_on ? tmax : NEG_INF;
                tmax = fmaxf(tmax, __shfl_xor(tmax, 32));
                const float mnew = fmaxf(mrun, tmax);
                const bool grew = mnew > mrun;
                const float alpha = fexp2(mrun - mnew);
                mrun = mnew;
                const float msub = lane_on ? mnew : __builtin_inff();
                const f32x2_t ms2 = {msub, msub};
                f32x2_t ls2 = {0.f, 0.f};
#pragma unroll
                for (int blk = 0; blk < 2; ++blk)
#pragma unroll
                    for (int q = 0; q < 16; q += 2) {
                        const f32x2_t d2 = (f32x2_t){p[blk][q], p[blk][q + 1]} - ms2;
                        f32x2_t e2; e2.x = fexp2(d2.x); e2.y = fexp2(d2.y);
                        p[blk][q] = e2.x; p[blk][q + 1] = e2.y; ls2 += e2;
                    }
                lrun = lrun * alpha + (ls2.x + ls2.y);
                if (__any(grew)) {
#pragma unroll
                    for (int db = 0; db < 2; ++db)
#pragma unroll
                        for (int q = 0; q < 16; ++q) o[db][q] *= alpha;
                }
            }
            pv_tile(Kt + 8192, p, r, h, o);
        }
        if (jn >= 0) kv_store(lds + (stage ^ 1) * 16384, TIDX, rg);
        __syncthreads();
        if (jn < 0) break;
        j = jn; stage ^= 1;
    }
    if (VAR != 3) {
        const float lt = lrun + __shfl_xor(lrun, 32);
        const float inv = lt > 0.f ? 1.f / lt : 0.f;
#pragma unroll
        for (int db = 0; db < 2; ++db)
#pragma unroll
            for (int q = 0; q < 16; ++q) o[db][q] *= inv;
    }
}

DEV void head_norm_store(const f32x16 (&o)[2], const float* gam, bf16_t* dst, int h) {
    float ss = 0.f;
#pragma unroll
    for (int db = 0; db < 2; ++db)
#pragma unroll
        for (int q = 0; q < 16; ++q) ss += o[db][q] * o[db][q];
    ss += __shfl_xor(ss, 32);
    const float rinv = rsqrtf(ss * (1.f / 64.f) + EPS);
#pragma unroll
    for (int db = 0; db < 2; ++db)
#pragma unroll
        for (int g = 0; g < 4; ++g) {
            const int d = 32 * db + 8 * g + 4 * h;
            const float4 gg = *(const float4*)(gam + d);
            uint2 u;
            u.x = cvtpk(o[db][4 * g] * rinv * gg.x, o[db][4 * g + 1] * rinv * gg.y);
            u.y = cvtpk(o[db][4 * g + 2] * rinv * gg.z, o[db][4 * g + 3] * rinv * gg.w);
            *(uint2*)(dst + d) = u;
        }
}

template <int VAR>
DEV void mha_unit(const P& p, int l, int unit, unsigned char* lds) {
    const V v = make_views(p); const int TIDX = otid();
    const int lane = TIDX & 63, wave = TIDX >> 6, r = lane & 31, h = lane >> 5;
    const int qb = 15 - (unit >> 5), bh = unit & 31, b = bh >> 2, hh = bh & 3;
    const int t0 = qb * 128, tw = t0 + 32 * wave, t = tw + r, m = b * S + t;
    const int qcol = VAR == 2 ? C_QB : C_QC, kcol = VAR == 2 ? C_KB : C_KCC, vrow = VAR == 2 ? 256 : 512, ocol = VAR == 2 ? 512 : 768;
    bf16x8 qf[4];
#pragma unroll
    for (int s = 0; s < 4; ++s) qf[s] = scale_frag(*(const bf16x8*)(v.U + (size_t)m * NP + qcol + hh * 64 + 16 * s + 8 * h), C2);
    KVT src;
    src.k = v.U + (size_t)b * S * NP + kcol + hh * 64; src.ks = NP;
    src.v = (const bf16_t*)(p.ws + WS_VT) + (size_t)(b * 768 + vrow + hh * 64) * S; src.vs = S;
    const int last = (t0 + 127) >> 6;
    const unsigned tmask = last == 31 ? 0xffffffffu : ((1u << (last + 1)) - 1u);
    const float* bias2 = (const float*)(lds + 32768);
    if (VAR == 2) {
        float* cf = (float*)(lds + 32768);
        float* wt = (float*)(lds + 32768 + 8192);
        const float* lsf = (const float*)(p.ws + WS_LSF) + (size_t)(b * 4 + hh) * S;
        const int nel = t0 + 128;
        float x[8];
        if (8 * TIDX < nel) {
            const float4 a0 = *(const float4*)(lsf + 8 * TIDX), a1 = *(const float4*)(lsf + 8 * TIDX + 4);
            x[0] = a0.x; x[1] = x[0] + a0.y; x[2] = x[1] + a0.z; x[3] = x[2] + a0.w; x[4] = x[3] + a1.x; x[5] = x[4] + a1.y; x[6] = x[5] + a1.z; x[7] = x[6] + a1.w;
        } else {
#pragma unroll
            for (int q = 0; q < 8; ++q) x[q] = 0.f;
        }
        float inc = x[7];
#pragma unroll
        for (int o = 1; o < 64; o <<= 1) { const float tt = __shfl_up(inc, o); if (lane >= o) inc += tt; }
        __syncthreads();
        if (lane == 63) wt[wave] = inc;
        __syncthreads();
        float off = inc - x[7];
#pragma unroll
        for (int w = 0; w < 3; ++w) off += (w < wave) ? wt[w] : 0.f;
        if (8 * TIDX < nel) {
#pragma unroll
            for (int q = 0; q < 8; ++q) cf[8 * TIDX + q] = -(x[q] + off) * LOG2E;
        }
        __syncthreads();
    }
    f32x16 o[2];
    attn_branch<VAR>(lds, src, qf, tmask, (tw + 31) >> 6, t, tw, 0u, bias2, o, TIDX);
    head_norm_store(o, p.out_norm_g + (size_t)l * D + ocol + hh * 64, v.O + (size_t)m * D + ocol + hh * 64, h);
}

DEV void nsa_unit(const P& p, int l, int unit, unsigned char* lds) {
    const V v = make_views(p); const int TIDX = otid();
    const int lane = TIDX & 63, wave = TIDX >> 6, r = lane & 31, h = lane >> 5;
    const int qblk = 63 - (unit >> 4), bg = unit & 15, b = bg >> 1, g = bg & 1;
    const int t0 = qblk * 32, t = t0 + r, m = b * S + t, head = g * 4 + wave, cur = t0 >> 6;
    const float NEG_INF = -__builtin_inff();
    bf16x8 qf[4];
#pragma unroll
    for (int s = 0; s < 4; ++s) qf[s] = scale_frag(*(const bf16x8*)(v.U + (size_t)m * NP + C_QA + head * 64 + 16 * s + 8 * h), C2);
    const float g0 = sigmoidf_(v.gf[(size_t)m * 32 + head * 3]), g1 = sigmoidf_(v.gf[(size_t)m * 32 + head * 3 + 1]), g2 = sigmoidf_(v.gf[(size_t)m * 32 + head * 3 + 2]);
    f32x16 otot[2];
    float* PA = (float*)(lds + 32768);
    float* PB = (float*)(lds + 49152);
    float* SC = (float*)lds;
    unsigned* MASK = (unsigned*)(lds + 8192);
    {
        const bf16_t* ck = v.ck + (size_t)(b * 2 + g) * 128 * 64;
        const bf16_t* cvt = (const bf16_t*)(p.ws + WS_CVT) + (size_t)(b * 2 + g) * 64 * 128;
        const int c = TIDX & 7, r0 = TIDX >> 3;
        u32x4 rk[4], rv[4];
#pragma unroll
        for (int i = 0; i < 4; ++i) rk[i] = *(const u32x4*)(ck + (size_t)(r0 + 32 * i) * 64 + c * 8);
#pragma unroll
        for (int i = 0; i < 4; ++i) rv[i] = *(const u32x4*)(cvt + (size_t)(r0 + 32 * (i & 1)) * 128 + 64 * (i >> 1) + c * 8);
        __syncthreads();
#pragma unroll
        for (int i = 0; i < 4; ++i) *(u32x4*)(lds + tile_off(r0 + 32 * i, c)) = rk[i];
#pragma unroll
        for (int i = 0; i < 4; ++i) *(u32x4*)(lds + 16384 + 8192 * (i >> 1) + tile_off(r0 + 32 * (i & 1), c)) = rv[i];
        __syncthreads();
        f32x16 ps[2][2];
        score_tile(lds, qf, r, h, ps[0]);
        score_tile(lds + 8192, qf, r, h, ps[1]);
        const int nvalid = t >= 31 ? (t - 31) / 16 + 1 : 0;
        float mx = NEG_INF;
#pragma unroll
        for (int tt = 0; tt < 2; ++tt)
#pragma unroll
            for (int blk = 0; blk < 2; ++blk)
#pragma unroll
                for (int q = 0; q < 16; ++q) {
                    const int n = 64 * tt + 32 * blk + 16 * (q >> 3) + 8 * h + (q & 7);
                    const float x = n < nvalid ? ps[tt][blk][q] : NEG_INF;
                    ps[tt][blk][q] = x; mx = fmaxf(mx, x);
                }
        mx = fmaxf(mx, __shfl_xor(mx, 32));
        const float mxs = nvalid > 0 ? mx : 0.f;
        float ls = 0.f;
#pragma unroll
        for (int tt = 0; tt < 2; ++tt)
#pragma unroll
            for (int blk = 0; blk < 2; ++blk)
#pragma unroll
                for (int q = 0; q < 16; ++q) { const float e = fexp2(ps[tt][blk][q] - mxs); ps[tt][blk][q] = e; ls += e; }
        const float lt = ls + __shfl_xor(ls, 32);
        const float inv = lt > 0.f ? 1.f / lt : 0.f;
#pragma unroll
        for (int tt = 0; tt < 2; ++tt)
#pragma unroll
            for (int blk = 0; blk < 2; ++blk) {
#pragma unroll
                for (int q = 0; q < 16; ++q) ps[tt][blk][q] *= inv;
#pragma unroll
                for (int s = 0; s < 2; ++s) {
                    const int G0 = 16 * tt + 8 * blk + 4 * s + 2 * h;
                    const float a0 = (ps[tt][blk][8 * s] + ps[tt][blk][8 * s + 1]) + (ps[tt][blk][8 * s + 2] + ps[tt][blk][8 * s + 3]);
                    const float a1 = (ps[tt][blk][8 * s + 4] + ps[tt][blk][8 * s + 5]) + (ps[tt][blk][8 * s + 6] + ps[tt][blk][8 * s + 7]);
                    PA[(wave * 32 + G0) * 32 + r] = a0; PA[(wave * 32 + G0 + 1) * 32 + r] = a1;
                    PB[(wave * 32 + G0 + 1) * 32 + r] = ps[tt][blk][8 * s + 3];
                    if (G0 + 2 < 32) PB[(wave * 32 + G0 + 2) * 32 + r] = ps[tt][blk][8 * s + 7];
                }
            }
        f32x16 oc[2];
#pragma unroll
        for (int db = 0; db < 2; ++db)
#pragma unroll
            for (int q = 0; q < 16; ++q) oc[db][q] = 0.f;
        pv_tile(lds + 16384, ps[0], r, h, oc);
        pv_tile(lds + 24576, ps[1], r, h, oc);
#pragma unroll
        for (int db = 0; db < 2; ++db)
#pragma unroll
            for (int q = 0; q < 16; ++q) otot[db][q] = g0 * oc[db][q];
    }
    __syncthreads();
    const bool need_topk = cur > 15;
    if (need_topk) {
        const int q = TIDX & 31, j0 = (TIDX >> 5) * 4;
#pragma unroll
        for (int jj = 0; jj < 4; ++jj) {
            const int j = j0 + jj;
            float sc = 0.f;
#pragma unroll
            for (int w = 0; w < 4; ++w) sc += PA[(w * 32 + j) * 32 + q];
            if (j > 0) {
#pragma unroll
                for (int w = 0; w < 4; ++w) sc += PB[(w * 32 + j) * 32 + q];
            }
            const bool forced = (j == 0) || (j == cur) || (j == cur - 1);
            SC[q * 33 + j] = forced ? 1.0e4f : (j <= cur ? sc : -1.0f);
        }
        if (TIDX < 32) MASK[TIDX] = 0u;
        __syncthreads();
        unsigned bits = 0u;
#pragma unroll
        for (int jj = 0; jj < 4; ++jj) {
            const int j = j0 + jj;
            const float vj = SC[q * 33 + j];
            int rank = 0;
#pragma unroll
            for (int i = 0; i < 32; ++i) { const float vi = SC[q * 33 + i]; rank += (vi > vj || (vi == vj && i < j)) ? 1 : 0; }
            if (rank < 16) bits |= 1u << j;
        }
        atomicOr(&MASK[q], bits);
        __syncthreads();
    }
    const unsigned upto = (2u << cur) - 1u;
    unsigned mybits = upto, um = upto;
    if (need_topk) {
        mybits = MASK[r];
        um = 0u;
#pragma unroll
        for (int i = 0; i < 32; ++i) um |= MASK[i];
        um = (unsigned)__builtin_amdgcn_readfirstlane((int)um);
    }
    {
        KVT src; src.k = v.U + (size_t)b * S * NP + C_KS + g * 64; src.ks = NP;
        src.v = (const bf16_t*)(p.ws + WS_VT) + (size_t)(b * 768 + g * 64) * S; src.vs = S;
        f32x16 o[2];
        attn_branch<0>(lds, src, qf, um & upto, cur, t, t0, mybits, nullptr, o, TIDX);
#pragma unroll
        for (int db = 0; db < 2; ++db)
#pragma unroll
            for (int q = 0; q < 16; ++q) otot[db][q] += g1 * o[db][q];
    }
    {
        KVT src; src.k = v.U + (size_t)b * S * NP + C_KW + g * 64; src.ks = NP;
        src.v = (const bf16_t*)(p.ws + WS_VT) + (size_t)(b * 768 + 128 + g * 64) * S; src.vs = S;
        const int f = (t0 - 511 > 0 ? t0 - 511 : 0) >> 6;
        const unsigned wmask = upto & ~((1u << f) - 1u);
        f32x16 o[2];
        attn_branch<1>(lds, src, qf, wmask, cur, t, t0, 0u, nullptr, o, TIDX);
#pragma unroll
        for (int db = 0; db < 2; ++db)
#pragma unroll
            for (int q = 0; q < 16; ++q) otot[db][q] += g2 * o[db][q];
    }
    head_norm_store(otot, p.out_norm_g + (size_t)l * D + head * 64, v.O + (size_t)m * D + head * 64, h);
}

DEV void cmp_unit(const P& p, int l, int unit, unsigned char* lds) {
    const V v = make_views(p); const int TIDX = otid();
    const int lane = TIDX & 63, wave = TIDX >> 6, wm = wave >> 1, wn = wave & 1, r = lane & 31, h = lane >> 5;
    const int kv = unit & 1, bg = unit >> 1, b = bg >> 1, g = bg & 1, lk = l * 2 + kv;
    const int col = (kv ? C_VC : C_KC) + g * 64;
    const bf16_t* arow[4];
#pragma unroll
    for (int i = 0; i < 4; ++i) { const int n = (TIDX >> 3) + 32 * i; arow[i] = v.U + (size_t)(b * S + 16 * (n < 127 ? n : 126)) * NP + col; }
    f32x16 acc[2][2];
    gemm128<false>(lds, arow, (const bf16_t*)(p.ws + WS_CW1) + (size_t)lk * 2048 * 128, 128, 2048, acc, TIDX, NP);
    const float* pb = (const float*)(p.ws + WS_CPB) + lk * 8 * 128;
#pragma unroll
    for (int j = 0; j < 2; ++j)
#pragma unroll
        for (int i = 0; i < 2; ++i) {
            const int mrow = 64 * wm + 32 * i + r;
#pragma unroll
            for (int g4 = 0; g4 < 4; ++g4) {
                float4 bb = *(const float4*)(pb + 64 * wn + 32 * j + 8 * g4 + 4 * h);
#pragma unroll
                for (int c8 = 1; c8 < 8; ++c8) { const float4 b2 = *(const float4*)(pb + c8 * 128 + 64 * wn + 32 * j + 8 * g4 + 4 * h); bb.x += b2.x; bb.y += b2.y; bb.z += b2.z; bb.w += b2.w; }
                float x0 = acc[j][i][4 * g4] + bb.x, x1 = acc[j][i][4 * g4 + 1] + bb.y, x2 = acc[j][i][4 * g4 + 2] + bb.z, x3 = acc[j][i][4 * g4 + 3] + bb.w;
                x0 = x0 / (1.f + __expf(-x0)); x1 = x1 / (1.f + __expf(-x1)); x2 = x2 / (1.f + __expf(-x2)); x3 = x3 / (1.f + __expf(-x3));
                uint2 u; u.x = cvtpk(x0, x1); u.y = cvtpk(x2, x3);
                *(uint2*)(lds + wn * 16384 + tile_off(mrow, 4 * j + g4) + 8 * h) = u;
            }
        }
    {
        const bf16_t* w2 = (const bf16_t*)(p.ws + WS_CW2) + (size_t)lk * 64 * 128;
        const int c = TIDX & 7, r0 = TIDX >> 3;
#pragma unroll
        for (int i = 0; i < 4; ++i) {
            const int row = r0 + 32 * (i & 1), kt = i >> 1;
            *(u32x4*)(lds + 32768 + kt * 8192 + tile_off(row, c)) = *(const u32x4*)(w2 + (size_t)row * 128 + kt * 64 + c * 8);
        }
    }
    __syncthreads();
    f32x16 a2[2];
#pragma unroll
    for (int db = 0; db < 2; ++db)
#pragma unroll
        for (int q = 0; q < 16; ++q) a2[db][q] = 0.f;
#pragma unroll
    for (int kt = 0; kt < 2; ++kt)
#pragma unroll
        for (int s = 0; s < 4; ++s) {
            const bf16x8 hf = *(const bf16x8*)(lds + kt * 16384 + tile_off(32 * wave + r, 2 * s + h));
#pragma unroll
            for (int db = 0; db < 2; ++db) {
                const bf16x8 wf = *(const bf16x8*)(lds + 32768 + kt * 8192 + tile_off(32 * db + r, 2 * s + h));
                a2[db] = __builtin_amdgcn_mfma_f32_32x32x16_bf16(wf, hf, a2[db], 0, 0, 0);
            }
        }
    const int n = 32 * wave + r;
    if (kv == 0 && n < 127) {
        const int pos = 16 * n + 31;
#pragma unroll
        for (int q = 0; q < 4; ++q) {
            const float cs = v.rcos[pos * 8 + q + 4 * h], sn = v.rsin[pos * 8 + q + 4 * h];
            const float x1 = a2[0][q], x2 = a2[0][q + 4];
            a2[0][q] = x1 * cs - x2 * sn; a2[0][q + 4] = x2 * cs + x1 * sn;
        }
    }
    bf16_t* dst = (kv ? v.cv : v.ck) + ((size_t)bg * 128 + n) * 64;
    bf16_t* dt = (bf16_t*)(p.ws + WS_CVT) + (size_t)bg * 64 * 128 + n;
#pragma unroll
    for (int db = 0; db < 2; ++db)
#pragma unroll
        for (int g4 = 0; g4 < 4; ++g4) {
            const int d = 32 * db + 8 * g4 + 4 * h;
            float x0 = a2[db][4 * g4], x1 = a2[db][4 * g4 + 1], x2 = a2[db][4 * g4 + 2], x3 = a2[db][4 * g4 + 3];
            if (n >= 127) { x0 = 0.f; x1 = 0.f; x2 = 0.f; x3 = 0.f; }
            uint2 u; u.x = cvtpk(x0, x1); u.y = cvtpk(x2, x3);
            *(uint2*)(dst + d) = u;
            if (kv) { dt[(size_t)d * 128] = (bf16_t)(u.x & 0xffffu); dt[(size_t)(d + 1) * 128] = (bf16_t)(u.x >> 16); dt[(size_t)(d + 2) * 128] = (bf16_t)(u.y & 0xffffu); dt[(size_t)(d + 3) * 128] = (bf16_t)(u.y >> 16); }
        }
    __syncthreads();
}

typedef float f32x4m __attribute__((ext_vector_type(4)));
DEV void ph_norm2_router_fast(const P& p, int l, unsigned char* lds) {
    const V v = make_views(p); const int TIDX = otid(), BIDX = obid();
    const int lane = TIDX & 63, wave = TIDX >> 6;
    const bf16_t* wr = (const bf16_t*)(p.ws + WS_WR) + (size_t)l * 2 * 64 * D;
    float* LG = (float*)(lds + 65536);
    for (int blk = BIDX; blk < T / 16; blk += gridDim.x) {
        const int m0 = blk * 16, b = m0 >> 11;
        const float* md = v.mod + (size_t)(l * 8 + b) * 6144;
        float4 xv[4][4]; float ssq[4];
#pragma unroll
        for (int rr = 0; rr < 4; ++rr)
#pragma unroll
            for (int j = 0; j < 4; ++j) xv[rr][j] = *(const float4*)(v.X + (size_t)(m0 + wave * 4 + rr) * D + 4 * lane + 256 * j);
#pragma unroll
        for (int rr = 0; rr < 4; ++rr) {
            ssq[rr] = 0.f;
#pragma unroll
            for (int j = 0; j < 4; ++j) ssq[rr] += xv[rr][j].x * xv[rr][j].x + xv[rr][j].y * xv[rr][j].y + xv[rr][j].z * xv[rr][j].z + xv[rr][j].w * xv[rr][j].w;
        }
#pragma unroll
        for (int o = 1; o < 64; o <<= 1) {
#pragma unroll
            for (int rr = 0; rr < 4; ++rr) ssq[rr] += __shfl_xor(ssq[rr], o);
        }
#pragma unroll
        for (int rr = 0; rr < 4; ++rr) {
            const int row = wave * 4 + rr, m = m0 + row;
            const float rs = rsqrtf(ssq[rr] * (1.f / D) + EPS);
#pragma unroll
            for (int j = 0; j < 4; ++j) {
                const int c = 4 * lane + 256 * j;
                const float4 g = *(const float4*)(p.norm2_g + l * D + c), sh = *(const float4*)(md + 3 * D + c), sc = *(const float4*)(md + 4 * D + c);
                const float h0 = xv[rr][j].x * rs * g.x * (1.f + sc.x) + sh.x, h1 = xv[rr][j].y * rs * g.y * (1.f + sc.y) + sh.y;
                const float h2 = xv[rr][j].z * rs * g.z * (1.f + sc.z) + sh.z, h3 = xv[rr][j].w * rs * g.w * (1.f + sc.w) + sh.w;
                uint2 hi; hi.x = cvtpk(h0, h1); hi.y = cvtpk(h2, h3);
                uint2 lo;
                lo.x = cvtpk(h0 - __uint_as_float(hi.x << 16), h1 - __uint_as_float(hi.x & 0xffff0000u));
                lo.y = cvtpk(h2 - __uint_as_float(hi.y << 16), h3 - __uint_as_float(hi.y & 0xffff0000u));
                *(uint2*)(v.H + (size_t)m * D + c) = hi;
                const int off = row * 2048 + ((((c >> 3) ^ row) & 127) << 4) + (c & 7) * 2;
                *(uint2*)(lds + off) = hi; *(uint2*)(lds + 32768 + off) = lo;
            }
        }
        __syncthreads();
        {
            const int r16 = lane & 15, kq = lane >> 4;
            f32x4m acc = {0.f, 0.f, 0.f, 0.f};
            const bf16_t* wh = wr + (size_t)(16 * wave + r16) * D + 8 * kq;
#pragma unroll 8
            for (int s = 0; s < 32; ++s) {
                const int off = r16 * 2048 + ((((4 * s + kq) ^ r16) & 127) << 4);
                const bf16x8 ah = *(const bf16x8*)(lds + off), al = *(const bf16x8*)(lds + 32768 + off);
                const bf16x8 bh = *(const bf16x8*)(wh + 32 * s), bl = *(const bf16x8*)(wh + 64 * D + 32 * s);
                acc = __builtin_amdgcn_mfma_f32_16x16x32_bf16(ah, bh, acc, 0, 0, 0);
                acc = __builtin_amdgcn_mfma_f32_16x16x32_bf16(al, bh, acc, 0, 0, 0);
                acc = __builtin_amdgcn_mfma_f32_16x16x32_bf16(ah, bl, acc, 0, 0, 0);
            }
#pragma unroll
            for (int q = 0; q < 4; ++q) LG[(4 * kq + q) * 64 + 16 * wave + r16] = acc[q];
        }
        __syncthreads();
        if (TIDX < 16) {
            const int m = m0 + TIDX;
            const float* lgp = LG + TIDX * 64;
            float lg[4], le[32];
#pragma unroll
            for (int i = 0; i < 4; ++i) lg[i] = lgp[i] + p.rg_b[l * 4 + i];
#pragma unroll
            for (int i = 0; i < 32; ++i) le[i] = lgp[4 + i] + p.re_b[l * 32 + i];
            int gi = 0; float gm = lg[0];
#pragma unroll
            for (int i = 1; i < 4; ++i) if (lg[i] > gm) { gm = lg[i]; gi = i; }
            float gs = 0.f;
#pragma unroll
            for (int i = 0; i < 4; ++i) gs += expf(lg[i] - gm);
            const float pg = 1.f / gs;
            float el[8];
#pragma unroll
            for (int i = 0; i < 8; ++i) el[i] = gi == 0 ? le[i] : (gi == 1 ? le[8 + i] : (gi == 2 ? le[16 + i] : le[24 + i]));
            int e1 = 0; float m1 = el[0];
#pragma unroll
            for (int i = 1; i < 8; ++i) if (el[i] > m1) { m1 = el[i]; e1 = i; }
            int e2 = -1; float m2 = -3.0e38f;
#pragma unroll
            for (int i = 0; i < 8; ++i) if (i != e1 && el[i] > m2) { m2 = el[i]; e2 = i; }
            const float p2 = expf(m2 - m1);
            const float w1 = pg / (1.f + p2), w2 = pg * p2 / (1.f + p2);
            const int ea = gi * 8 + e1, eb = gi * 8 + e2;
            const unsigned pa = atomicAdd(v.ctl + CW_CNT + l * 32 + ea, 1u);
            const unsigned pb = atomicAdd(v.ctl + CW_CNT + l * 32 + eb, 1u);
            v.list[(size_t)ea * T + pa] = 2 * m;
            v.list[(size_t)eb * T + pb] = 2 * m + 1;
            v.wts[2 * m] = w1; v.wts[2 * m + 1] = w2;
        }
        __syncthreads();
    }
}

constexpr int CW_MQ = 8192 + 512;
DEV void ph_mix(const P& p, int l, unsigned char* lds, volatile LAS unsigned* qslot, int rep) {
    const int TIDX = otid(), BIDX = obid();
    unsigned* ctl = (unsigned*)(p.ws + WS_CTL) + CW_MQ + l * 256;
    unsigned acq = 0u;
    for (int hop = 0; hop < 8; ++hop) {
        const int b = (BIDX + hop) & 7;
        unsigned* qc = ctl + b * 16;
        unsigned* done = ctl + 128 + b * 16;
        for (;;) {
            __syncthreads();
            if (TIDX == 0) *qslot = atomicAdd(qc, 1u);
            __syncthreads();
            const int v = (int)*qslot;
            if (v >= 260) break;
            if (v < 4) {
                cmp_unit(p, l, b * 4 + v, lds);
                asm volatile("s_waitcnt vmcnt(0)" ::: "memory");
                __syncthreads();
                if (TIDX == 0) {
                    __builtin_amdgcn_fence(__ATOMIC_RELEASE, "agent");
                    asm volatile("s_waitcnt vmcnt(0)" ::: "memory");
                    __hip_atomic_fetch_add(done, 1u, __ATOMIC_RELAXED, __HIP_MEMORY_SCOPE_AGENT);
                }
                continue;
            }
            int slot = -1, nsa = -1;
            if (v < 68) slot = v - 4;
            else { const int w2 = v - 68, k = w2 % 3, i = w2 / 3; if (k < 2) nsa = 2 * i + k; else slot = 64 + i; }
            if (slot >= 0) {
                const int idx = slot >> 1, u = ((idx >> 2) << 5) | (b * 4 + (idx & 3));
                if (slot & 1) mha_unit<3>(p, l, u, lds); else mha_unit<2>(p, l, u, lds);
            } else {
                if (!((acq >> b) & 1u)) {
                    if (TIDX == 0) {
                        unsigned sp = 0;
                        while (__hip_atomic_load(done, __ATOMIC_RELAXED, __HIP_MEMORY_SCOPE_AGENT) < 4u) { __builtin_amdgcn_s_sleep(2); if (++sp > (1u << 22)) break; }
                        __builtin_amdgcn_fence(__ATOMIC_ACQUIRE, "agent");
                        asm volatile("s_waitcnt vmcnt(0)" ::: "memory");
                    }
                    __syncthreads();
                    acq |= 1u << b;
                }
                nsa_unit(p, l, ((nsa >> 1) << 4) | (b * 2 + (nsa & 1)), lds);
            }
        }
    }
}

#ifndef REP_PHASE
#define REP_PHASE 0
#endif
#ifndef REF_HEADS
#define REF_HEADS 0x0000u
#endif
__global__ void __launch_bounds__(256, 2) fwd_kernel(P p) {
    __shared__ __attribute__((aligned(16))) float lds[17408];
    __shared__ __attribute__((aligned(16))) unsigned lds_ctl[4];
    if (threadIdx.x < 4) lds_ctl[threadIdx.x] = 0u;
    __syncthreads();
    const XcdBarrier xb = xcd_barrier_post((unsigned*)(p.ws + WS_CTL), (volatile LAS unsigned*)lds_ctl);
#define GRID_BAR() do { xcd_barrier(xb); if (REP_PHASE == 7) xcd_barrier(xb); } while (0)
    volatile LAS unsigned* qslot = (volatile LAS unsigned*)(lds_ctl + 2);
    for (int rep = 0; rep < (REP_PHASE == 1 ? 2 : 1); ++rep) {
        ph_prologue(p, lds);
        ph_convert(p, lds);
        GRID_BAR();
    }
    for (int l = 0; l < DEPTH; ++l) {
        ph_convert_dense(p, l, 0);
        ph_norm1(p, l, l == 0 ? 0 : 1);
        GRID_BAR();
        for (int rep = 0; rep < (REP_PHASE == 2 ? 2 : 1); ++rep) {
            if (rep == 0) ph_convert_dense(p, l, 1);
            ph_inproj_fast(p, l, (unsigned char*)lds);
            GRID_BAR();
        }
        for (int rep = 0; rep < (REP_PHASE == 3 ? 2 : 1); ++rep) {
            ph_mix(p, l, (unsigned char*)lds, qslot, rep);
            GRID_BAR();
        }
        ph_outproj_fast(p, l, (unsigned char*)lds);
        GRID_BAR();
        if (blockIdx.x & 8) { ph_convert_experts(p, l); ph_norm2_router_fast(p, l, (unsigned char*)lds); }
        else { ph_norm2_router_fast(p, l, (unsigned char*)lds); ph_convert_experts(p, l); }
        GRID_BAR();
        for (int rep = 0; rep < (REP_PHASE == 5 ? 2 : 1); ++rep) {
            ph_moe_up_fast(p, l, (unsigned char*)lds);
            GRID_BAR();
        }
        for (int rep = 0; rep < (REP_PHASE == 6 ? 2 : 1); ++rep) {
            ph_moe_down_fast(p, l, (unsigned char*)lds);
            GRID_BAR();
        }
    }
    ph_norm1(p, DEPTH, 2);
}

extern "C" void kernel_launch(void* const* d_in, const int* in_sizes, int n_in,
                              void* d_out, int out_size, void* d_ws, size_t ws_size,
                              hipStream_t stream) {
    static int grid_blocks = 0;
    if (!grid_blocks) {
        int dev = 0, cus = 0, per_cu = 0;
        (void)hipGetDevice(&dev);
        (void)hipDeviceGetAttribute(&cus, hipDeviceAttributeMultiprocessorCount, dev);
        (void)hipOccupancyMaxActiveBlocksPerMultiprocessor(&per_cu, fwd_kernel, 256, 0);
        if (per_cu > 2) per_cu = 2;
        if (per_cu < 1) per_cu = 1;
        grid_blocks = cus * per_cu;
        if (n_in != 24 || ws_size < WS_END || out_size != T * D) { fprintf(stderr, "kernel_launch: unexpected shapes (n_in %d ws %zu out %d)\n", n_in, ws_size, out_size); grid_blocks = -1; }
    }
    if (grid_blocks < 0) return;
    (void)hipMemsetAsync(d_ws, 0, CTL_BYTES, stream);
    P p{};
    const float** pp = (const float**)&p;
    for (int i = 0; i < 24; ++i) pp[i] = (const float*)d_in[i];
    p.out = (float*)d_out; p.ws = (unsigned char*)d_ws;
    void* args[] = {&p};
    hipError_t e = hipLaunchCooperativeKernel((void*)fwd_kernel, dim3(grid_blocks), dim3(256), args, 0, stream);
    if (e != hipSuccess) fprintf(stderr, "cooperative launch failed: %s (grid %d)\n", hipGetErrorString(e), grid_blocks);
}
```

```cpp
#include <hip/hip_runtime.h>
#include <hip/hip_cooperative_groups.h>
#include <cstdio>
#include <cstdint>

#define LAS __attribute__((address_space(3)))
#define DEV __device__ __forceinline__

constexpr int T = 16384, S = 2048, NB = 8, D = 1024, DIN = 2844, NP = 2880, DEPTH = 4;
constexpr int NCMP = 127;
constexpr float EPS = 1e-6f;
constexpr float SCALE = 0.125f;
constexpr int C_QA = 0, C_KC = 512, C_VC = 640, C_KS = 768, C_VS = 896, C_KW = 1024, C_VW = 1152;
constexpr int C_QB = 1280, C_KB = 1536, C_VB = 1792, C_QC = 2048, C_KCC = 2304, C_VCC = 2560;

constexpr size_t MiB = 1u << 20;
constexpr size_t WS_CTL = 0, CTL_BYTES = 64 * 1024;
constexpr size_t WS_MOD = 1 * MiB, WS_ROPE = 2 * MiB, WS_CUMF = 3 * MiB, WS_CK = 4 * MiB, WS_CV = 5 * MiB, WS_IMP = 6 * MiB;
constexpr size_t WS_SEL = 10 * MiB, WS_EID = 11 * MiB, WS_WTS = 12 * MiB, WS_LIST = 13 * MiB, WS_GF = 16 * MiB;
constexpr size_t WS_H = 32 * MiB, WS_U = 64 * MiB, WS_O = 160 * MiB, WS_HID = 192 * MiB, WS_Y = 224 * MiB, WS_OB = 352 * MiB, WS_ORAW = 448 * MiB;
constexpr size_t WS_END = 973 * MiB;
constexpr size_t WS_VT = 936 * MiB;
constexpr size_t WS_CVT = 962 * MiB;
constexpr size_t WS_CUMF2 = 963 * MiB;
constexpr int CW_Q = 8192 + 256;
constexpr size_t WS_CW1 = 964 * MiB;
constexpr size_t WS_CW2 = 968 * MiB;
constexpr size_t WS_CPB = 969 * MiB;
constexpr size_t WS_LSF = 970 * MiB;
constexpr size_t WS_WR = 971 * MiB;
constexpr int CW_CNT = 8192;

typedef unsigned short bf16_t;
typedef float f32x4v __attribute__((ext_vector_type(4)));
DEV int vt_row(int n) { return n < 1024 ? n - 896 : (n < 1280 ? 128 + n - 1152 : (n < 2048 ? 256 + n - 1792 : 512 + n - 2560)); }
DEV bool is_vcol(int n) { return (n >= C_VS && n < C_KW) || (n >= C_VW && n < C_QB) || (n >= C_VB && n < C_QC) || (n >= C_VCC && n < 2816); }
DEV float bf2f(bf16_t v) { return __uint_as_float((unsigned)v << 16); }
DEV bf16_t f2bf(float f) { unsigned u = __float_as_uint(f); return (bf16_t)((u + 0x7fffu + ((u >> 16) & 1u)) >> 16); }
DEV float4 ld_bf4(const bf16_t* p) { const ushort4 u = *(const ushort4*)p; return make_float4(bf2f(u.x), bf2f(u.y), bf2f(u.z), bf2f(u.w)); }
typedef float f32x2_t __attribute__((ext_vector_type(2)));
typedef __bf16 bf16x2_t __attribute__((ext_vector_type(2)));
DEV unsigned cvtpk(float lo, float hi) { f32x2_t v = {lo, hi}; bf16x2_t b = __builtin_convertvector(v, bf16x2_t); return __builtin_bit_cast(unsigned, b); }
DEV float sigmoidf_(float x) { return 1.f / (1.f + expf(-x)); }
DEV float logsigmoidf_(float x) { return fminf(x, 0.f) - log1pf(expf(-fabsf(x))); }
DEV float wave_sum(float v) {
#pragma unroll
    for (int o = 1; o < 64; o <<= 1) v += __shfl_xor(v, o);
    return v;
}

#define XB_TMO      128
#define XB_XCNT(j)  (256  + 64 * (j))
#define XB_XSUB(j)  (1280 + 64 * (j))
#define XB_XGEN(j)  (2304 + 64 * (j))
#define XB_TOP      3328
#define XB_TOPGEN   3392
#define XCD_BAR_WORDS 3456
#define XB_SPIN_CAP (1u << 23)
DEV unsigned xb_ld(unsigned* p)              { return __hip_atomic_load(p, __ATOMIC_RELAXED, __HIP_MEMORY_SCOPE_AGENT); }
DEV unsigned xb_add(unsigned* p, unsigned v) { return __hip_atomic_fetch_add(p, v, __ATOMIC_RELAXED, __HIP_MEMORY_SCOPE_AGENT); }
DEV unsigned xb_xcc_id() { return (unsigned)__builtin_amdgcn_s_getreg((3 << 11) | 20) & 0xFu; }
#define XB_SPIN(cond, bar) do { unsigned _sp = 0; while (cond) { __builtin_amdgcn_s_sleep(1); \
    if ((++_sp & 255u) == 0u) { if (xb_ld(&(bar)[XB_TMO])) break; if (_sp > XB_SPIN_CAP) { atomicAdd(&(bar)[XB_TMO], 1u); break; } } } } while (0)
struct XcdBarrier { unsigned* bar; unsigned x; volatile LAS unsigned* st; };
DEV XcdBarrier xcd_barrier_post(unsigned* bar, volatile LAS unsigned* st) {
    XcdBarrier b; b.bar = bar; b.x = xb_xcc_id(); b.st = st;
    if (threadIdx.x == 0) (void)xb_add(&bar[XB_XCNT(b.x)], 1u);
    return b;
}
DEV void xcd_barrier_complete(unsigned* bar, unsigned x, unsigned& nloc, unsigned& nx) {
    const unsigned G = gridDim.x * gridDim.y * gridDim.z;
    unsigned sum, cnt, mine, sp = 0u;
    for (;;) {
        sum = 0u; cnt = 0u; mine = 0u;
#pragma unroll
        for (unsigned j = 0; j < 16; ++j) { const unsigned c = xb_ld(&bar[XB_XCNT(j)]); sum += c; cnt += (c > 0u) ? 1u : 0u; mine = (j == x) ? c : mine; }
        if (sum == G) break;
        __builtin_amdgcn_s_sleep(1);
        if ((++sp & 255u) == 0u) { if (xb_ld(&bar[XB_TMO])) break; if (sp > XB_SPIN_CAP) { atomicAdd(&bar[XB_TMO], 1u); break; } }
    }
    nloc = mine > 0u ? mine : 1u; nx = cnt > 0u ? cnt : 1u;
}
DEV void xcd_barrier(const XcdBarrier& b) {
    asm volatile("s_waitcnt vmcnt(0)" ::: "memory");
    __syncthreads();
    if (threadIdx.x == 0) {
        unsigned* bar = b.bar;
        __builtin_amdgcn_s_waitcnt(0);
        unsigned nloc = b.st[0], nx = b.st[1];
        if (nloc == 0u) { xcd_barrier_complete(bar, b.x, nloc, nx); b.st[0] = nloc; b.st[1] = nx; }
        const unsigned old = xb_add(&bar[XB_XSUB(b.x)], 1u);
        const unsigned gen = old / nloc;
        if (old + 1u == (gen + 1u) * nloc) {
            __builtin_amdgcn_fence(__ATOMIC_RELEASE, "agent");
            asm volatile("s_waitcnt vmcnt(0)" ::: "memory");
            const unsigned og = xb_add(&bar[XB_TOP], 1u);
            const unsigned tg = og / nx;
            if (og + 1u == (tg + 1u) * nx) xb_add(&bar[XB_TOPGEN], 1u);
            else XB_SPIN(xb_ld(&bar[XB_TOPGEN]) == tg, bar);
            __builtin_amdgcn_fence(__ATOMIC_ACQUIRE, "agent");
            xb_add(&bar[XB_XGEN(b.x)], 1u);
            asm volatile("s_waitcnt vmcnt(0)" ::: "memory");
        } else {
            XB_SPIN(xb_ld(&bar[XB_XGEN(b.x)]) == gen, bar);
            __builtin_amdgcn_fence(__ATOMIC_ACQUIRE, "agent");
            asm volatile("s_waitcnt vmcnt(0)" ::: "memory");
        }
    }
    __syncthreads();
}

struct P {
    const float *x, *c, *norm1_g, *norm2_g, *ada_w, *ada_b, *w_in, *b_forget, *cmp_pos_k, *cmp_w1_k, *cmp_w2_k,
        *cmp_pos_v, *cmp_w1_v, *cmp_w2_v, *out_norm_g, *w_out, *rg_w, *rg_b, *re_w, *re_b, *e_w1, *e_w3, *e_w2, *final_g;
    float* out; unsigned char* ws;
};
struct V {
    unsigned* ctl; float* mod; float* rcos; float* rsin; float* cumf; bf16_t* ck; bf16_t* cv; float* imp; unsigned* sel;
    int* eid; float* wts; int* list; float* gf; bf16_t* H; bf16_t* U; bf16_t* O; bf16_t* HID; bf16_t* Y; float* OB; float* ORAW; float* X;
};
DEV int otid() { int t = threadIdx.x; asm volatile("" : "+v"(t)); return t; }
DEV int obid() { int t = blockIdx.x; asm volatile("" : "+s"(t)); return t; }
DEV V make_views(const P& p) {
    V v; size_t woff = 0; asm volatile("" : "+s"(woff)); unsigned char* w = p.ws + woff;
    v.ctl = (unsigned*)(w + WS_CTL); v.mod = (float*)(w + WS_MOD); v.rcos = (float*)(w + WS_ROPE); v.rsin = v.rcos + S * 8;
    v.cumf = (float*)(w + WS_CUMF); v.ck = (bf16_t*)(w + WS_CK); v.cv = (bf16_t*)(w + WS_CV); v.imp = (float*)(w + WS_IMP);
    v.sel = (unsigned*)(w + WS_SEL); v.eid = (int*)(w + WS_EID); v.wts = (float*)(w + WS_WTS); v.list = (int*)(w + WS_LIST);
    v.gf = (float*)(w + WS_GF); v.H = (bf16_t*)(w + WS_H); v.U = (bf16_t*)(w + WS_U); v.O = (bf16_t*)(w + WS_O);
    v.HID = (bf16_t*)(w + WS_HID); v.Y = (bf16_t*)(w + WS_Y); v.OB = (float*)(w + WS_OB); v.ORAW = (float*)(w + WS_ORAW); v.X = p.out;
    return v;
}

DEV void ph_prologue(const P& p, float* lds) {
    const V v = make_views(p); const int TIDX = otid(), BIDX = obid();
    const int tid = TIDX;
    for (int i = tid; i < NB * D; i += 256) { const float c = p.c[i]; lds[i] = c / (1.f + expf(-c)); }
    __syncthreads();
    float* red = lds + NB * D;
    const int c4 = tid & 15, ks = tid >> 4;
    for (int unit = BIDX; unit < DEPTH * 96; unit += gridDim.x) {
        const int l = unit / 96, n0 = (unit % 96) * 64;
        const float* W = p.ada_w + (size_t)l * D * 6144 + n0 + 4 * c4;
        float acc[8][4];
#pragma unroll
        for (int b = 0; b < 8; ++b)
#pragma unroll
            for (int q = 0; q < 4; ++q) acc[b][q] = 0.f;
#pragma unroll 1
        for (int i0 = 0; i0 < 64; i0 += 8) {
            f32x4v w[8];
#pragma unroll
            for (int i = 0; i < 8; ++i) w[i] = __builtin_nontemporal_load((const f32x4v*)(W + (size_t)(ks + 16 * (i0 + i)) * 6144));
#pragma unroll
            for (int i = 0; i < 8; ++i) {
                const int k = ks + 16 * (i0 + i);
#pragma unroll
                for (int b = 0; b < 8; ++b) {
                    const float cv = lds[b * D + k];
                    acc[b][0] += cv * w[i].x; acc[b][1] += cv * w[i].y; acc[b][2] += cv * w[i].z; acc[b][3] += cv * w[i].w;
                }
            }
        }
#pragma unroll
        for (int b = 0; b < 8; ++b) *(float4*)(red + (ks * 8 + b) * 64 + 4 * c4) = make_float4(acc[b][0], acc[b][1], acc[b][2], acc[b][3]);
        __syncthreads();
        for (int o = tid; o < 512; o += 256) {
            const int c2 = o & 63, b = o >> 6;
            float sm = p.ada_b[l * 6144 + n0 + c2];
#pragma unroll
            for (int q = 0; q < 16; ++q) sm += red[(q * 8 + b) * 64 + c2];
            v.mod[(size_t)(l * 8 + b) * 6144 + n0 + c2] = sm;
        }
        __syncthreads();
    }
    const float cst = -2.0f * 13.122363377404328f / 16.0f;
    for (int i = ((int)gridDim.x - 1 - BIDX) * 256 + tid; i < S * 8; i += gridDim.x * 256) {
        const int s = i >> 3, j = i & 7;
        const float inv = expf((float)j * cst);
        const float ang = (float)s * inv;
        v.rcos[i] = cosf(ang); v.rsin[i] = sinf(ang);
    }
}

DEV void ph_norm1(const P& p, int l, int mode) {
    const V v = make_views(p); const int TIDX = otid(), BIDX = obid();
    const int lane = TIDX & 63;
    const int gw = (BIDX * 256 + TIDX) >> 6, nw = gridDim.x * 4;
    for (int m0 = gw; m0 < T; m0 += 2 * nw) {
        float4 xv[2][4];
        if (mode == 0) {
#pragma unroll
            for (int rr = 0; rr < 2; ++rr)
#pragma unroll
                for (int j = 0; j < 4; ++j) xv[rr][j] = *(const float4*)(p.x + (size_t)(m0 + rr * nw) * D + 4 * lane + 256 * j);
        } else {
            float4 xa[2][4]; ushort4 ya[2][4], yb[2][4];
#pragma unroll
            for (int rr = 0; rr < 2; ++rr)
#pragma unroll
                for (int j = 0; j < 4; ++j) {
                    const int m = m0 + rr * nw, c = 4 * lane + 256 * j;
                    xa[rr][j] = *(const float4*)(v.X + (size_t)m * D + c);
                    ya[rr][j] = *(const ushort4*)(v.Y + (size_t)(2 * m) * D + c); yb[rr][j] = *(const ushort4*)(v.Y + (size_t)(2 * m + 1) * D + c);
                }
#pragma unroll
            for (int rr = 0; rr < 2; ++rr) {
                const float* g2 = v.mod + (size_t)((l - 1) * 8 + ((m0 + rr * nw) >> 11)) * 6144 + 5 * D;
#pragma unroll
                for (int j = 0; j < 4; ++j) {
                    const float4 g = *(const float4*)(g2 + 4 * lane + 256 * j);
                    float4 a = xa[rr][j];
                    a.x += g.x * (bf2f(ya[rr][j].x) + bf2f(yb[rr][j].x)); a.y += g.y * (bf2f(ya[rr][j].y) + bf2f(yb[rr][j].y));
                    a.z += g.z * (bf2f(ya[rr][j].z) + bf2f(yb[rr][j].z)); a.w += g.w * (bf2f(ya[rr][j].w) + bf2f(yb[rr][j].w));
                    xv[rr][j] = a;
                }
            }
        }
        float ss[2];
#pragma unroll
        for (int rr = 0; rr < 2; ++rr) {
            ss[rr] = 0.f;
#pragma unroll
            for (int j = 0; j < 4; ++j) ss[rr] += xv[rr][j].x * xv[rr][j].x + xv[rr][j].y * xv[rr][j].y + xv[rr][j].z * xv[rr][j].z + xv[rr][j].w * xv[rr][j].w;
        }
#pragma unroll
        for (int o = 1; o < 64; o <<= 1) { ss[0] += __shfl_xor(ss[0], o); ss[1] += __shfl_xor(ss[1], o); }
#pragma unroll
        for (int rr = 0; rr < 2; ++rr) {
            const int m = m0 + rr * nw, b = m >> 11;
            const float r = rsqrtf(ss[rr] * (1.f / D) + EPS);
            if (mode == 2) {
#pragma unroll
                for (int j = 0; j < 4; ++j) {
                    const int c = 4 * lane + 256 * j;
                    const float4 g = *(const float4*)(p.final_g + c);
                    float4 o; o.x = xv[rr][j].x * r * g.x; o.y = xv[rr][j].y * r * g.y; o.z = xv[rr][j].z * r * g.z; o.w = xv[rr][j].w * r * g.w;
                    *(float4*)(v.X + (size_t)m * D + c) = o;
                }
            } else {
                const float* md = v.mod + (size_t)(l * 8 + b) * 6144;
#pragma unroll
                for (int j = 0; j < 4; ++j) {
                    const int c = 4 * lane + 256 * j;
                    *(float4*)(v.X + (size_t)m * D + c) = xv[rr][j];
                    const float4 g = *(const float4*)(p.norm1_g + l * D + c), sh = *(const float4*)(md + c), sc = *(const float4*)(md + D + c);
                    uint2 o;
                    o.x = cvtpk(xv[rr][j].x * r * g.x * (1.f + sc.x) + sh.x, xv[rr][j].y * r * g.y * (1.f + sc.y) + sh.y);
                    o.y = cvtpk(xv[rr][j].z * r * g.z * (1.f + sc.z) + sh.z, xv[rr][j].w * r * g.w * (1.f + sc.w) + sh.w);
                    *(uint2*)(v.H + (size_t)m * D + c) = o;
                }
            }
        }
    }
}

typedef short bf16x8 __attribute__((ext_vector_type(8)));
typedef float f32x16 __attribute__((ext_vector_type(16)));
typedef unsigned u32x4 __attribute__((ext_vector_type(4)));
constexpr size_t WS_WIN = 512 * MiB, WS_WOT = 544 * MiB, WS_W13 = 552 * MiB, WS_W2 = 808 * MiB;
constexpr int NPW = 2944;
DEV int tile_off(int row, int chunk) { return row * 128 + ((chunk ^ ((row >> 1) & 7)) << 4); }
template <class RM>
DEV void conv_patch(const float* src, int N, int K, bf16_t* dst, int k0, int n0, RM rowmap, int lane) {
    const int kg = lane >> 3, n = n0 + 4 * (lane & 7);
    if (n >= N) return;
    const float* sp = src + (size_t)(k0 + 8 * kg) * N + n;
    f32x4v x[8];
#pragma unroll
    for (int j = 0; j < 8; ++j) x[j] = __builtin_nontemporal_load((const f32x4v*)(sp + (size_t)j * N));
    bf16_t* dp = dst + k0 + 8 * kg;
    u32x4 o;
    o.x = cvtpk(x[0].x, x[1].x); o.y = cvtpk(x[2].x, x[3].x); o.z = cvtpk(x[4].x, x[5].x); o.w = cvtpk(x[6].x, x[7].x);
    *(u32x4*)(dp + (size_t)rowmap(n) * K) = o;
    o.x = cvtpk(x[0].y, x[1].y); o.y = cvtpk(x[2].y, x[3].y); o.z = cvtpk(x[4].y, x[5].y); o.w = cvtpk(x[6].y, x[7].y);
    *(u32x4*)(dp + (size_t)rowmap(n + 1) * K) = o;
    o.x = cvtpk(x[0].z, x[1].z); o.y = cvtpk(x[2].z, x[3].z); o.z = cvtpk(x[4].z, x[5].z); o.w = cvtpk(x[6].z, x[7].z);
    *(u32x4*)(dp + (size_t)rowmap(n + 2) * K) = o;
    o.x = cvtpk(x[0].w, x[1].w); o.y = cvtpk(x[2].w, x[3].w); o.z = cvtpk(x[4].w, x[5].w); o.w = cvtpk(x[6].w, x[7].w);
    *(u32x4*)(dp + (size_t)rowmap(n + 3) * K) = o;
}

DEV void conv8(const float* s0, const float* s1, bf16_t* dst) {
    f32x4v a = {0.f, 0.f, 0.f, 0.f}, b = {0.f, 0.f, 0.f, 0.f};
    if (s0) a = __builtin_nontemporal_load((const f32x4v*)s0);
    if (s1) b = __builtin_nontemporal_load((const f32x4v*)s1);
    u32x4 o; o.x = cvtpk(a[0], a[1]); o.y = cvtpk(a[2], a[3]); o.z = cvtpk(b[0], b[1]); o.w = cvtpk(b[2], b[3]);
    *(u32x4*)dst = o;
}
DEV void ph_convert_dense(const P& p, int l, int which) {
    const int TIDX = otid(), BIDX = obid();
    size_t woff = 0; asm volatile("" : "+s"(woff)); unsigned char* w = p.ws + woff;
    const size_t gtid = (size_t)BIDX * 256 + TIDX, gsz = (size_t)gridDim.x * 256;
    if (which == 0) {
        bf16_t* win = (bf16_t*)(w + WS_WIN);
        for (size_t i = gtid; i < (size_t)D * 368; i += gsz) {
            const int g8 = (int)(i % 368); const size_t lk = (size_t)l * D + i / 368;
            const int n = g8 * 8;
            const float* row = p.w_in + lk * DIN;
            const float *s0, *s1;
            if (n < 2816) { const int oc = n + (n >= 2048 ? 28 : (n >= 1280 ? 24 : 0)); s0 = row + oc; s1 = row + oc + 4; }
            else if (n < 2840) { s0 = row + 1280 + (n - 2816); s1 = s0 + 4; }
            else if (n == 2840) { s0 = row + 2072; s1 = nullptr; }
            else { s0 = nullptr; s1 = nullptr; }
            conv8(s0, s1, win + lk * NPW + n);
        }
    } else {
        bf16_t* wot = (bf16_t*)(w + WS_WOT);
        const size_t oo = (size_t)l * D * D;
        for (size_t i = gtid; i < (size_t)D * D / 8; i += gsz) conv8(p.w_out + oo + i * 8, p.w_out + oo + i * 8 + 4, wot + oo + i * 8);
        for (size_t i = gtid; i < (size_t)2 * 2048 * 128 / 8; i += gsz) {
            const size_t per = (size_t)2048 * 128 / 8; const int kv = (int)(i / per), lk = l * 2 + kv; const size_t off = (i % per) * 8;
            const float* src = (kv ? p.cmp_w1_v : p.cmp_w1_k) + (size_t)l * 2048 * 128 + off;
            conv8(src, src + 4, (bf16_t*)(w + WS_CW1) + (size_t)lk * 2048 * 128 + off);
        }
    }
}
DEV void ph_convert_experts(const P& p, int l) {
    const int TIDX = otid(), BIDX = obid();
    size_t woff = 0; asm volatile("" : "+s"(woff)); unsigned char* w = p.ws + woff;
    bf16_t* w13 = (bf16_t*)(w + WS_W13); bf16_t* w2t = (bf16_t*)(w + WS_W2);
    const size_t gtid = (size_t)BIDX * 256 + TIDX, gsz = (size_t)gridDim.x * 256;
    for (size_t i = gtid; i < (size_t)32 * D * 128; i += gsz) {
        const int g8 = (int)(i & 127); const size_t lek = (size_t)l * 32 * D + (i >> 7);
        const int n = g8 * 8, which = (n >> 5) & 1, c = 32 * (n >> 6) + (n & 31);
        const float* src = (which ? p.e_w3 : p.e_w1) + lek * 512 + c;
        conv8(src, src + 4, w13 + lek * 1024 + n);
    }
    const size_t o2 = (size_t)l * 32 * 512 * D;
    for (size_t i = gtid; i < (size_t)32 * 512 * D / 8; i += gsz) conv8(p.e_w2 + o2 + i * 8, p.e_w2 + o2 + i * 8 + 4, w2t + o2 + i * 8);
}
DEV void ph_convert(const P& p, float* lds) {
    const int TIDX = otid(), BIDX = obid();
    size_t woff = 0; asm volatile("" : "+s"(woff)); unsigned char* w = p.ws + woff;
    const int lane = TIDX & 63;
    for (int unit = BIDX * 4 + (TIDX >> 6); unit < DEPTH * 2 * 4; unit += gridDim.x * 4) {
        const int lk = unit >> 2, t = unit & 3, l = lk >> 1, kv = lk & 1;
        conv_patch((kv ? p.cmp_w2_v : p.cmp_w2_k) + (size_t)l * 128 * 64, 64, 128, (bf16_t*)(w + WS_CW2) + (size_t)lk * 64 * 128, (t >> 1) * 64, (t & 1) * 32, [](int n) { return n; }, lane);
    }
    for (int o = BIDX * 256 + TIDX; o < DEPTH * 64 * D; o += gridDim.x * 256) {
        const int k = o & (D - 1), n = (o >> 10) & 63, l = o >> 16;
        const float val = n < 4 ? p.rg_w[((size_t)l * D + k) * 4 + n] : (n < 36 ? p.re_w[((size_t)l * D + k) * 32 + n - 4] : 0.f);
        const bf16_t hi = f2bf(val); const bf16_t lo = f2bf(val - bf2f(hi));
        bf16_t* wr = (bf16_t*)(w + WS_WR) + (size_t)l * 2 * 64 * D;
        wr[n * D + k] = hi; wr[64 * D + n * D + k] = lo;
    }
    int pu = (int)gridDim.x - 1 - BIDX - 64; if (pu < 0) pu += gridDim.x;
    for (int unit = pu; unit < DEPTH * 2 * 8; unit += gridDim.x) {
        const int lk = unit >> 3, ch = unit & 7, l = lk >> 1, kv = lk & 1, j = TIDX & 127, hf = TIDX >> 7;
        const float* pe = (kv ? p.cmp_pos_v : p.cmp_pos_k) + (size_t)l * 2048 + ch * 256 + hf * 128;
        const float* w1 = (kv ? p.cmp_w1_v : p.cmp_w1_k) + (size_t)l * 2048 * 128 + (size_t)(ch * 256 + hf * 128) * 128 + j;
        float a0 = 0.f, a1 = 0.f, a2 = 0.f, a3 = 0.f;
#pragma unroll 1
        for (int k0 = 0; k0 < 128; k0 += 32) {
            float wv[32];
#pragma unroll
            for (int k = 0; k < 32; ++k) wv[k] = w1[(size_t)(k0 + k) * 128];
#pragma unroll
            for (int k = 0; k < 32; k += 4) {
                a0 += pe[k0 + k] * wv[k]; a1 += pe[k0 + k + 1] * wv[k + 1];
                a2 += pe[k0 + k + 2] * wv[k + 2]; a3 += pe[k0 + k + 3] * wv[k + 3];
            }
        }
        const float a = (a0 + a1) + (a2 + a3);
        __syncthreads();
        if (hf) lds[j] = a;
        __syncthreads();
        if (!hf) ((float*)(w + WS_CPB))[(lk * 8 + ch) * 128 + j] = a + lds[j];
    }
}

typedef short v4i16_t __attribute__((ext_vector_type(4)));
DEV void gemm_issue0(unsigned char* lds, const bf16_t* const (&arow)[4], const bf16_t* Bsrc, const size_t ldb, const int TIDX) {
    const int lane = TIDX & 63, wave = TIDX >> 6;
    const int gsw = ((TIDX & 7) ^ ((TIDX >> 4) & 7)) * 8;
    const bf16_t* bg = Bsrc + (size_t)(4 * wave + (lane >> 4)) * ldb + ((lane & 15) ^ (((lane >> 4) << 2) | (wave & 3))) * 8;
    LAS unsigned char* l3 = (LAS unsigned char*)lds + __builtin_amdgcn_readfirstlane(wave) * 1024;
#pragma unroll
    for (int i = 0; i < 4; ++i) {
        __builtin_amdgcn_global_load_lds((const unsigned*)(arow[i] + gsw), (LAS unsigned*)(l3 + i * 4096), 16, 0, 0);
        __builtin_amdgcn_global_load_lds((const unsigned*)(bg + (size_t)(16 * i) * ldb), (LAS unsigned*)(l3 + 16384 + i * 4096), 16, 0, 0);
    }
}
template <bool SWAP, bool PRE = false>
DEV void gemm128(unsigned char* lds, const bf16_t* const (&arow)[4], const bf16_t* Bsrc, const size_t ldb, int K, f32x16 (&acc)[2][2], const int TIDX, const int astride = 64) {
    const int lane = TIDX & 63, wave = TIDX >> 6, wm = wave >> 1, wn = wave & 1, r = lane & 31, h = lane >> 5;
#pragma unroll
    for (int j = 0; j < 2; ++j)
#pragma unroll
        for (int i = 0; i < 2; ++i)
#pragma unroll
            for (int q = 0; q < 16; ++q) acc[j][i][q] = 0.f;
    const int gsw = ((TIDX & 7) ^ ((TIDX >> 4) & 7)) * 8;
    const bf16_t* ag[4];
#pragma unroll
    for (int i = 0; i < 4; ++i) ag[i] = arow[i] + gsw;
    const int brow = 4 * wave + (lane >> 4), bch = ((lane & 15) ^ (((lane >> 4) << 2) | (wave & 3))) * 8;
    const bf16_t* bg = Bsrc + (size_t)brow * ldb + bch;
    LAS unsigned char* l3 = (LAS unsigned char*)lds + __builtin_amdgcn_readfirstlane(wave) * 1024;
    LAS unsigned char* tb[2][2];
    {
        const int blk = (lane >> 4) & 1, q = (lane & 15) >> 2, pp = lane & 3;
#pragma unroll
        for (int j = 0; j < 2; ++j)
#pragma unroll
            for (int t = 0; t < 2; ++t) {
                const int row = 4 * t + 8 * h + q, ch = 4 * (2 * wn + j) + 2 * blk + (pp >> 1);
                tb[j][t] = (LAS unsigned char*)lds + 16384 + 256 * row + 16 * (ch ^ (((row & 3) << 2) | ((row >> 2) & 3))) + 8 * (pp & 1);
            }
    }
#define G_DMA(st_, kt_) do { _Pragma("unroll") for (int i = 0; i < 4; ++i) { \
        __builtin_amdgcn_global_load_lds((const unsigned*)(ag[i] + (size_t)(kt_) * astride), (LAS unsigned*)(l3 + (st_) + i * 4096), 16, 0, 0); \
        __builtin_amdgcn_global_load_lds((const unsigned*)(bg + ((size_t)(kt_) * 64 + 16 * i) * ldb), (LAS unsigned*)(l3 + (st_) + 16384 + i * 4096), 16, 0, 0); } } while (0)
    const int KT = K >> 6;
    if (!PRE) {
        __syncthreads();
        G_DMA(0, 0);
    }
    for (int kt = 0; kt < KT; ++kt) {
        asm volatile("s_waitcnt vmcnt(0) lgkmcnt(0)" ::: "memory");
        __builtin_amdgcn_s_barrier();
        asm volatile("" ::: "memory");
        if (kt + 1 < KT) G_DMA(((kt + 1) & 1) * 32768, kt + 1);
        const int so = (kt & 1) * 32768;
        const unsigned char* cur = lds + so;
#pragma unroll
        for (int kk = 0; kk < 4; ++kk) {
            bf16x8 af[2], wf[2];
#pragma unroll
            for (int i = 0; i < 2; ++i) af[i] = *(const bf16x8*)(cur + tile_off(64 * wm + 32 * i + r, 2 * kk + h));
#pragma unroll
            for (int j = 0; j < 2; ++j) {
                const v4i16_t lo = __builtin_amdgcn_ds_read_tr16_b64_v4i16((LAS v4i16_t*)(tb[j][0] + so + 4096 * kk));
                const v4i16_t hi = __builtin_amdgcn_ds_read_tr16_b64_v4i16((LAS v4i16_t*)(tb[j][1] + so + 4096 * kk));
                wf[j] = (bf16x8){lo[0], lo[1], lo[2], lo[3], hi[0], hi[1], hi[2], hi[3]};
            }
#pragma unroll
            for (int j = 0; j < 2; ++j)
#pragma unroll
                for (int i = 0; i < 2; ++i) acc[j][i] = SWAP ? __builtin_amdgcn_mfma_f32_32x32x16_bf16(af[i], wf[j], acc[j][i], 0, 0, 0)
                                                             : __builtin_amdgcn_mfma_f32_32x32x16_bf16(wf[j], af[i], acc[j][i], 0, 0, 0);
        }
    }
    __syncthreads();
#undef G_DMA
}

constexpr int CST = 272;
DEV void ctile_put(unsigned char* lds, int row, int col, float a, float b, float c, float d) {
    uint2 u; u.x = cvtpk(a, b); u.y = cvtpk(c, d);
    *(uint2*)(lds + row * CST + col * 2) = u;
}
template <int COLS, class RP>
DEV void ctile_flush(unsigned char* lds, const int TIDX, RP rowptr) {
    asm volatile("s_waitcnt lgkmcnt(0)" ::: "memory");
    __builtin_amdgcn_s_barrier();
    asm volatile("" ::: "memory");
    constexpr int CPR = COLS / 8, RPI = 256 / CPR;
#pragma unroll
    for (int it = 0; it < 128 / RPI; ++it) {
        const int row = it * RPI + TIDX / CPR, c16 = TIDX % CPR;
        bf16_t* dst = rowptr(row, it);
        const u32x4 val = *(const u32x4*)(lds + row * CST + c16 * 16);
        if (dst) *(u32x4*)(dst + c16 * 8) = val;
    }
}

DEV void ph_inproj_fast(const P& p, int l, unsigned char* lds) {
    const V v = make_views(p); const int TIDX = otid(), BIDX = obid();
    const bf16_t* W = (const bf16_t*)(p.ws + WS_WIN) + (size_t)l * D * NPW;
    const int lane = TIDX & 63, wave = TIDX >> 6, wm = wave >> 1, wn = wave & 1, r = lane & 31, h = lane >> 5;
    const bool xo = gridDim.x == 512;
    unsigned char* ct = lds + 32768;
    auto decode = [&](int it, int& mt, int& nt) -> int {
        if (xo) { if (it >= 6) return -1; const int lb = BIDX >> 3; nt = 8 * (it % 3) + (lb >> 3); mt = 16 * (BIDX & 7) + 8 * (it / 3) + (lb & 7); return nt < 23 ? 1 : 0; }
        const int unit = BIDX + it * (int)gridDim.x; if (unit >= 128 * 23) return -1; nt = unit / 128; mt = unit % 128; return 1;
    };
    auto issue = [&](int mt, int nt) {
        const bf16_t* ar[4];
#pragma unroll
        for (int i = 0; i < 4; ++i) ar[i] = v.H + (size_t)(mt * 128 + (TIDX >> 3) + 32 * i) * D;
        gemm_issue0(lds, ar, W + nt * 128, NPW, TIDX);
    };
    bool pre = false;
    for (int it = 0;; ++it) {
        int nt, mt;
        const int dv = decode(it, mt, nt);
        if (dv < 0) break;
        if (dv == 0) continue;
        const int m0 = mt * 128, n0 = nt * 128;
        const bf16_t* arow[4];
#pragma unroll
        for (int i = 0; i < 4; ++i) arow[i] = v.H + (size_t)(m0 + (TIDX >> 3) + 32 * i) * D;
        if (!pre) { __syncthreads(); issue(mt, nt); pre = true; }
        int itn = it + 1, mtn = 0, ntn = 0, dn;
        while ((dn = decode(itn, mtn, ntn)) == 0) ++itn;
        f32x16 acc[2][2];
        if (is_vcol(n0)) {
            gemm128<true, true>(lds, arow, W + n0, NPW, D, acc, TIDX);
            if (dn > 0) issue(mtn, ntn); else pre = false;
#pragma unroll
            for (int j = 0; j < 2; ++j)
#pragma unroll
                for (int i = 0; i < 2; ++i)
#pragma unroll
                    for (int g = 0; g < 4; ++g)
                        ctile_put(ct, 64 * wn + 32 * j + r, 64 * wm + 32 * i + 8 * g + 4 * h, acc[j][i][4 * g], acc[j][i][4 * g + 1], acc[j][i][4 * g + 2], acc[j][i][4 * g + 3]);
            bf16_t* vt = (bf16_t*)(p.ws + WS_VT) + ((size_t)(m0 >> 11) * 768 + vt_row(n0)) * S + (m0 & (S - 1));
            ctile_flush<128>(ct, TIDX, [&](int row, int) { return vt + (size_t)row * S; });
            continue;
        }
        const bool rope_tile = n0 < 512 || n0 == C_KS || n0 == C_KW;
        f32x4v rcs[2], rsn[2];
        if (rope_tile) {
#pragma unroll
            for (int i = 0; i < 2; ++i) {
                const int sp = (m0 + 64 * wm + 32 * i + r) & (S - 1);
                rcs[i] = *(const f32x4v*)(v.rcos + sp * 8 + 4 * h); rsn[i] = *(const f32x4v*)(v.rsin + sp * 8 + 4 * h);
            }
        }
        gemm128<false, true>(lds, arow, W + n0, NPW, D, acc, TIDX);
        if (dn > 0) issue(mtn, ntn); else pre = false;
        if (n0 == 2816) {
            if (wn == 0) {
#pragma unroll
                for (int i = 0; i < 2; ++i) {
                    const int m = m0 + 64 * wm + 32 * i + r;
#pragma unroll
                    for (int q = 0; q < 16; ++q) {
                        const int cc = (q & 3) + 8 * (q >> 2) + 4 * h;
                        if (cc < 24) v.gf[(size_t)m * 32 + cc] = acc[0][i][q];
                        else if (cc < 28) ((float*)(p.ws + WS_LSF))[(size_t)((m >> 11) * 4 + cc - 24) * S + (m & (S - 1))] = logsigmoidf_(acc[0][i][q] + p.b_forget[l * 4 + cc - 24]);
                    }
                }
            }
            continue;
        }
#pragma unroll
        for (int j = 0; j < 2; ++j) {
            const int nb = n0 + 64 * wn + 32 * j;
            const bool rope = ((nb & 63) == 0) && (nb < 512 || (nb >= C_KS && nb < C_VS) || (nb >= C_KW && nb < C_VW));
#pragma unroll
            for (int i = 0; i < 2; ++i) {
                f32x16 a = acc[j][i];
                if (rope) {
#pragma unroll
                    for (int q = 0; q < 4; ++q) { const float x1 = a[q], x2 = a[q + 4]; a[q] = x1 * rcs[i][q] - x2 * rsn[i][q]; a[q + 4] = x2 * rcs[i][q] + x1 * rsn[i][q]; }
                }
#pragma unroll
                for (int g = 0; g < 4; ++g) ctile_put(ct, 64 * wm + 32 * i + r, 64 * wn + 32 * j + 8 * g + 4 * h, a[4 * g], a[4 * g + 1], a[4 * g + 2], a[4 * g + 3]);
            }
        }
        bf16_t* ub = v.U + (size_t)m0 * NP + n0;
        ctile_flush<128>(ct, TIDX, [&](int row, int) { return ub + (size_t)row * NP; });
    }
}

DEV void ph_outproj_fast(const P& p, int l, unsigned char* lds) {
    const V v = make_views(p); const int TIDX = otid(), BIDX = obid();
    const bf16_t* W = (const bf16_t*)(p.ws + WS_WOT) + (size_t)l * D * D;
    const int lane = TIDX & 63, wave = TIDX >> 6, wm = wave >> 1, wn = wave & 1, r = lane & 31, h = lane >> 5;
    const bool xo = gridDim.x == 512;
    auto decode = [&](int it, int& mt, int& nt) -> bool {
        if (xo) { if (it >= 2) return false; const int lb = BIDX >> 3; nt = lb >> 3; mt = 16 * (BIDX & 7) + 8 * it + (lb & 7); return true; }
        const int unit = BIDX + it * (int)gridDim.x; if (unit >= 128 * 8) return false; nt = unit / 128; mt = unit % 128; return true;
    };
    auto issue = [&](int mt, int nt) {
        const bf16_t* ar[4];
#pragma unroll
        for (int i = 0; i < 4; ++i) ar[i] = v.O + (size_t)(mt * 128 + (TIDX >> 3) + 32 * i) * D;
        gemm_issue0(lds, ar, W + nt * 128, D, TIDX);
    };
    for (int it = 0;; ++it) {
        int nt, mt, ntn = 0, mtn = 0;
        if (!decode(it, mt, nt)) break;
        const bool hasn = decode(it + 1, mtn, ntn);
        const int m0 = mt * 128, n0 = nt * 128;
        const bf16_t* arow[4];
#pragma unroll
        for (int i = 0; i < 4; ++i) arow[i] = v.O + (size_t)(m0 + (TIDX >> 3) + 32 * i) * D;
        if (it == 0) { __syncthreads(); issue(mt, nt); }
        f32x4v xin[2][2][4];
#pragma unroll
        for (int j = 0; j < 2; ++j)
#pragma unroll
            for (int i = 0; i < 2; ++i)
#pragma unroll
                for (int g = 0; g < 4; ++g) xin[j][i][g] = *(const f32x4v*)(v.X + (size_t)(m0 + 64 * wm + 32 * i + r) * D + n0 + 64 * wn + 32 * j + 4 * h + 8 * g);
        f32x16 acc[2][2];
        gemm128<false, true>(lds, arow, W + n0, D, D, acc, TIDX);
        if (hasn) issue(mtn, ntn);
        const float* g1 = v.mod + (size_t)(l * 8 + (m0 >> 11)) * 6144 + 2 * D;
#pragma unroll
        for (int j = 0; j < 2; ++j)
#pragma unroll
            for (int i = 0; i < 2; ++i) {
                const int m = m0 + 64 * wm + 32 * i + r, nb = n0 + 64 * wn + 32 * j + 4 * h;
#pragma unroll
                for (int g = 0; g < 4; ++g) {
                    const float4 gg = *(const float4*)(g1 + nb + 8 * g);
                    f32x4v xo = xin[j][i][g];
                    xo[0] += gg.x * acc[j][i][4 * g]; xo[1] += gg.y * acc[j][i][4 * g + 1]; xo[2] += gg.z * acc[j][i][4 * g + 2]; xo[3] += gg.w * acc[j][i][4 * g + 3];
                    *(f32x4v*)(v.X + (size_t)m * D + nb + 8 * g) = xo;
                }
            }
    }
}

DEV void ph_moe_up_fast(const P& p, int l, unsigned char* lds) {
    const V v = make_views(p); const int TIDX = otid(), BIDX = obid();
    const int lane = TIDX & 63, wave = TIDX >> 6, wm = wave >> 1, wn = wave & 1, r = lane & 31, h = lane >> 5;
    const unsigned* cnt = v.ctl + CW_CNT + l * 32;
    int* tp = (int*)(lds + 67584); int* rb = tp + 40;
    __syncthreads();
    if (TIDX < 64) {
        const int c = TIDX < 32 ? (int)cnt[TIDX] : 0;
        int nu = ((c + 127) >> 7) * 8, cc = c;
#pragma unroll
        for (int o = 1; o < 32; o <<= 1) { const int a = __shfl_up(nu, o), b2 = __shfl_up(cc, o); if ((TIDX & 31) >= o) { nu += a; cc += b2; } }
        if (TIDX < 32) { tp[TIDX + 1] = nu; rb[TIDX + 1] = cc; if (TIDX == 0) { tp[0] = 0; rb[0] = 0; } }
    }
    __syncthreads();
    const int total = tp[32];
    unsigned char* ct = lds + 32768;
    struct UU { int e, base, nt, mt, nrow; const int* lst; const bf16_t* B; const bf16_t* ar[4]; };
    auto setup = [&](int unit, UU& u) {
        int e = 0;
#pragma unroll
        for (int st = 16; st > 0; st >>= 1) if (tp[e + st] <= unit) e += st;
        const int rem = unit - tp[e];
        u.e = e; u.base = rb[e]; u.nt = rem & 7; u.mt = rem >> 3;
        const int ce = rb[e + 1] - u.base;
        u.lst = v.list + (size_t)e * T + u.mt * 128;
        u.nrow = ce - u.mt * 128 < 128 ? ce - u.mt * 128 : 128;
        u.B = (const bf16_t*)(p.ws + WS_W13) + ((size_t)l * 32 + e) * 1024 * D + u.nt * 128;
#pragma unroll
        for (int i = 0; i < 4; ++i) { const int rr = (TIDX >> 3) + 32 * i; u.ar[i] = v.H + (size_t)(u.lst[rr < u.nrow ? rr : 0] >> 1) * D; }
    };
    int unit = BIDX;
    if (unit >= total) return;
    UU cu, nu;
    setup(unit, cu);
    __syncthreads();
    gemm_issue0(lds, cu.ar, cu.B, 1024, TIDX);
    for (;;) {
        const int un = unit + (int)gridDim.x;
        f32x16 acc[2][2];
        gemm128<false, true>(lds, cu.ar, cu.B, 1024, D, acc, TIDX);
        if (un < total) { setup(un, nu); gemm_issue0(lds, nu.ar, nu.B, 1024, TIDX); }
#pragma unroll
        for (int i = 0; i < 2; ++i)
#pragma unroll
            for (int g = 0; g < 4; ++g) {
                float o[4];
#pragma unroll
                for (int q = 0; q < 4; ++q) { const float a1 = acc[0][i][4 * g + q], a3 = acc[1][i][4 * g + q]; o[q] = a1 / (1.f + __expf(-a1)) * a3; }
                ctile_put(ct, 64 * wm + 32 * i + r, 32 * wn + 8 * g + 4 * h, o[0], o[1], o[2], o[3]);
            }
        bf16_t* hb = v.HID + (size_t)(cu.base + cu.mt * 128) * 512 + 64 * cu.nt;
        const int nrow = cu.nrow;
        ctile_flush<64>(ct, TIDX, [&](int row, int) { return row < nrow ? hb + (size_t)row * 512 : (bf16_t*)nullptr; });
        if (un >= total) break;
        unit = un; cu = nu;
    }
}
DEV void ph_moe_down_fast(const P& p, int l, unsigned char* lds) {
    const V v = make_views(p); const int TIDX = otid(), BIDX = obid();
    const int lane = TIDX & 63, wave = TIDX >> 6, wm = wave >> 1, wn = wave & 1, r = lane & 31, h = lane >> 5;
    const unsigned* cnt = v.ctl + CW_CNT + l * 32;
    int* tp = (int*)(lds + 67584); int* rb = tp + 40;
    __syncthreads();
    if (TIDX < 64) {
        const int c = TIDX < 32 ? (int)cnt[TIDX] : 0;
        int nu = ((c + 127) >> 7) * 8, cc = c;
#pragma unroll
        for (int o = 1; o < 32; o <<= 1) { const int a = __shfl_up(nu, o), b2 = __shfl_up(cc, o); if ((TIDX & 31) >= o) { nu += a; cc += b2; } }
        if (TIDX < 32) { tp[TIDX + 1] = nu; rb[TIDX + 1] = cc; if (TIDX == 0) { tp[0] = 0; rb[0] = 0; } }
    }
    __syncthreads();
    const int total = tp[32];
    unsigned char* ct = lds + 32768;
    struct UD { int n0, nrow; const bf16_t* B; const bf16_t* ar[4]; float wrow[2]; int fslot[8]; };
    auto setup = [&](int unit, UD& u) {
        int e = 0;
#pragma unroll
        for (int st = 16; st > 0; st >>= 1) if (tp[e + st] <= unit) e += st;
        const int rem = unit - tp[e], base = rb[e];
        const int ce = rb[e + 1] - base, nt = rem & 7, mt = rem >> 3;
        const int* lst = v.list + (size_t)e * T + mt * 128;
        u.n0 = nt * 128;
        u.nrow = ce - mt * 128 < 128 ? ce - mt * 128 : 128;
        u.B = (const bf16_t*)(p.ws + WS_W2) + ((size_t)l * 32 + e) * 512 * D + u.n0;
#pragma unroll
        for (int i = 0; i < 4; ++i) { const int rr = (TIDX >> 3) + 32 * i; u.ar[i] = v.HID + (size_t)(base + mt * 128 + (rr < u.nrow ? rr : 0)) * 512; }
#pragma unroll
        for (int i = 0; i < 2; ++i) { const int mr = 64 * wm + 32 * i + r; u.wrow[i] = mr < u.nrow ? v.wts[lst[mr]] : 0.f; }
#pragma unroll
        for (int it = 0; it < 8; ++it) { const int row = it * 16 + (TIDX >> 4); u.fslot[it] = row < u.nrow ? lst[row] : -1; }
    };
    int unit = BIDX;
    if (unit >= total) return;
    UD cu, nu;
    setup(unit, cu);
    __syncthreads();
    gemm_issue0(lds, cu.ar, cu.B, D, TIDX);
    for (;;) {
        const int un = unit + (int)gridDim.x;
        f32x16 acc[2][2];
        gemm128<false, true>(lds, cu.ar, cu.B, D, 512, acc, TIDX);
        if (un < total) { setup(un, nu); gemm_issue0(lds, nu.ar, nu.B, D, TIDX); }
#pragma unroll
        for (int i = 0; i < 2; ++i) {
            const int mr = 64 * wm + 32 * i + r;
            const float w = cu.wrow[i];
#pragma unroll
            for (int j = 0; j < 2; ++j)
#pragma unroll
                for (int g = 0; g < 4; ++g)
                    ctile_put(ct, mr, 64 * wn + 32 * j + 8 * g + 4 * h, w * acc[j][i][4 * g], w * acc[j][i][4 * g + 1], w * acc[j][i][4 * g + 2], w * acc[j][i][4 * g + 3]);
        }
        const int n0 = cu.n0;
        ctile_flush<128>(ct, TIDX, [&](int, int it) { const int sl = cu.fslot[it]; return sl >= 0 ? v.Y + (size_t)sl * D + n0 : (bf16_t*)nullptr; });
        if (un >= total) break;
        unit = un; cu = nu;
    }
}

constexpr float LOG2E = 1.4426950408889634f, C2 = 0.125f * 1.4426950408889634f, LN2 = 0.6931471805599453f;
DEV float fexp2(float x) { return __builtin_amdgcn_exp2f(x); }
DEV float flog2(float x) { return __builtin_amdgcn_logf(x); }
DEV int swap23(int r) { return (r & ~12) | ((r & 4) << 1) | ((r & 8) >> 1); }

struct KVT { const bf16_t* k; int ks; const bf16_t* v; int vs; };
DEV void kv_load(const KVT& s, int kv0, const int TIDX, u32x4 (&rg)[4]) {
    const int c = TIDX & 7, r0 = TIDX >> 3;
    rg[0] = *(const u32x4*)(s.k + (size_t)(kv0 + r0) * s.ks + c * 8);
    rg[1] = *(const u32x4*)(s.k + (size_t)(kv0 + r0 + 32) * s.ks + c * 8);
    rg[2] = *(const u32x4*)(s.v + (size_t)r0 * s.vs + kv0 + c * 8);
    rg[3] = *(const u32x4*)(s.v + (size_t)(r0 + 32) * s.vs + kv0 + c * 8);
}
DEV void kv_store(unsigned char* st, const int TIDX, const u32x4 (&rg)[4]) {
    const int c = TIDX & 7, r0 = TIDX >> 3;
    *(u32x4*)(st + tile_off(r0, c)) = rg[0]; *(u32x4*)(st + tile_off(r0 + 32, c)) = rg[1];
    *(u32x4*)(st + 8192 + tile_off(r0, c)) = rg[2]; *(u32x4*)(st + 8192 + tile_off(r0 + 32, c)) = rg[3];
}
DEV bf16x8 scale_frag(bf16x8 v, float sc) {
    u32x4 u = __builtin_bit_cast(u32x4, v);
#pragma unroll
    for (int i = 0; i < 4; ++i) u[i] = cvtpk(__uint_as_float(u[i] << 16) * sc, __uint_as_float(u[i] & 0xffff0000u) * sc);
    return __builtin_bit_cast(bf16x8, u);
}
DEV float xhalf(float x) {
    const auto s = __builtin_amdgcn_permlane32_swap(__float_as_uint(x), __float_as_uint(x), false, false);
    return __uint_as_float((threadIdx.x & 32) ? s[0] : s[1]);
}
DEV float xhalf_max(float x) {
    const auto s = __builtin_amdgcn_permlane32_swap(__float_as_uint(x), __float_as_uint(x), false, false);
    return fmaxf(__uint_as_float(s[0]), __uint_as_float(s[1]));
}
DEV float xhalf_sum(float x) {
    const auto s = __builtin_amdgcn_permlane32_swap(__float_as_uint(x), __float_as_uint(x), false, false);
    return __uint_as_float(s[0]) + __uint_as_float(s[1]);
}
#define SB0() __builtin_amdgcn_sched_barrier(0)
DEV void score_tile(const unsigned char* Kt, const bf16x8 (&qf)[4], int r, int h, f32x16 (&p)[2]) {
    const int kr = swap23(r);
    const unsigned char* kb = Kt + tile_off(kr, h);
    auto ld = [&](int i) { const int blk = i & 1, s = i >> 1; return *(const bf16x8*)(Kt + tile_off(32 * blk + kr, 2 * s + h)); };
    (void)kb;
    f32x16 z;
#pragma unroll
    for (int q = 0; q < 16; ++q) z[q] = 0.f;
    bf16x8 f0 = ld(0), f1 = ld(1), f2 = ld(2), f3 = ld(3);
    SB0();
    p[0] = __builtin_amdgcn_mfma_f32_32x32x16_bf16(f0, qf[0], z, 0, 0, 0); f0 = ld(4); SB0();
    p[1] = __builtin_amdgcn_mfma_f32_32x32x16_bf16(f1, qf[0], z, 0, 0, 0); f1 = ld(5); SB0();
    p[0] = __builtin_amdgcn_mfma_f32_32x32x16_bf16(f2, qf[1], p[0], 0, 0, 0); f2 = ld(6); SB0();
    p[1] = __builtin_amdgcn_mfma_f32_32x32x16_bf16(f3, qf[1], p[1], 0, 0, 0); f3 = ld(7); SB0();
    p[0] = __builtin_amdgcn_mfma_f32_32x32x16_bf16(f0, qf[2], p[0], 0, 0, 0); SB0();
    p[1] = __builtin_amdgcn_mfma_f32_32x32x16_bf16(f1, qf[2], p[1], 0, 0, 0); SB0();
    p[0] = __builtin_amdgcn_mfma_f32_32x32x16_bf16(f2, qf[3], p[0], 0, 0, 0); SB0();
    p[1] = __builtin_amdgcn_mfma_f32_32x32x16_bf16(f3, qf[3], p[1], 0, 0, 0); SB0();
}
DEV void pv_tile(const unsigned char* Vt, const f32x16 (&p)[2], int r, int h, f32x16 (&o)[2]) {
    auto ld = [&](int i) { const int db = i & 1, pr = i >> 1; return *(const bf16x8*)(Vt + tile_off(32 * db + r, 2 * pr + h)); };
    auto pk = [&](int pr) {
        const int blk = pr >> 1, s = pr & 1;
        u32x4 w;
        w.x = cvtpk(p[blk][8 * s], p[blk][8 * s + 1]); w.y = cvtpk(p[blk][8 * s + 2], p[blk][8 * s + 3]);
        w.z = cvtpk(p[blk][8 * s + 4], p[blk][8 * s + 5]); w.w = cvtpk(p[blk][8 * s + 6], p[blk][8 * s + 7]);
        return __builtin_bit_cast(bf16x8, w);
    };
    bf16x8 f0 = ld(0), f1 = ld(1), f2 = ld(2), f3 = ld(3);
    SB0();
    bf16x8 pb = pk(0);
    SB0();
    o[0] = __builtin_amdgcn_mfma_f32_32x32x16_bf16(f0, pb, o[0], 0, 0, 0); f0 = ld(4); SB0();
    o[1] = __builtin_amdgcn_mfma_f32_32x32x16_bf16(f1, pb, o[1], 0, 0, 0); f1 = ld(5); pb = pk(1); SB0();
    o[0] = __builtin_amdgcn_mfma_f32_32x32x16_bf16(f2, pb, o[0], 0, 0, 0); f2 = ld(6); SB0();
    o[1] = __builtin_amdgcn_mfma_f32_32x32x16_bf16(f3, pb, o[1], 0, 0, 0); f3 = ld(7); pb = pk(2); SB0();
    o[0] = __builtin_amdgcn_mfma_f32_32x32x16_bf16(f0, pb, o[0], 0, 0, 0); SB0();
    o[1] = __builtin_amdgcn_mfma_f32_32x32x16_bf16(f1, pb, o[1], 0, 0, 0); pb = pk(3); SB0();
    o[0] = __builtin_amdgcn_mfma_f32_32x32x16_bf16(f2, pb, o[0], 0, 0, 0); SB0();
    o[1] = __builtin_amdgcn_mfma_f32_32x32x16_bf16(f3, pb, o[1], 0, 0, 0); SB0();
}

template <int VAR>
DEV void attn_branch(unsigned char* lds, const KVT& src, const bf16x8 (&qf)[4], unsigned tmask, int wave_last, int t, int t_first,
                     unsigned selbits, const float* bias2, f32x16 (&o)[2], const int TIDX) {
    const int lane = TIDX & 63, r = lane & 31, h = lane >> 5;
    const float NEG_INF = -__builtin_inff();
    float mrun = -1e30f, lrun = 0.f, rest = VAR == 3 ? 1.f : 0.f;
#pragma unroll
    for (int db = 0; db < 2; ++db)
#pragma unroll
        for (int q = 0; q < 16; ++q) o[db][q] = 0.f;
    u32x4 rg[4];
    unsigned rem = tmask;
    int j = VAR == 3 ? 31 - __builtin_clz(rem) : __builtin_ctz(rem);
    rem &= ~(1u << j);
    kv_load(src, 64 * j, TIDX, rg);
    __syncthreads();
    kv_store(lds, TIDX, rg);
    __syncthreads();
    int stage = 0;
    for (;;) {
        int jn = -1;
        if (rem) { jn = VAR == 3 ? 31 - __builtin_clz(rem) : __builtin_ctz(rem); rem &= ~(1u << jn); kv_load(src, 64 * jn, TIDX, rg); }
        asm volatile("" ::: "memory"); __builtin_amdgcn_sched_barrier(0);
        if (j <= wave_last) {
            const unsigned char* Kt = lds + stage * 16384;
            f32x16 p[2];
            score_tile(Kt, qf, r, h, p);
            const int kvb = 64 * j + 8 * h;
            if (VAR == 3) {
                const bool diag = 64 * j + 63 >= t_first;
                float gt[2][2];
                if (diag) {
#pragma unroll
                    for (int blk = 0; blk < 2; ++blk)
#pragma unroll
                        for (int s = 0; s < 2; ++s) {
                            float run = 1.f;
#pragma unroll
                            for (int q = 7; q >= 0; --q) {
                                const float ez = fexp2(p[blk][8 * s + q]);
                                float w = __builtin_amdgcn_rcpf(1.f + ez);
                                float beta = 1.f - w;
                                const bool valid = kvb + 32 * blk + 16 * s + q < t;
                                w = valid ? w : 1.f; beta = valid ? beta : 0.f;
                                p[blk][8 * s + q] = beta * run;
                                run *= w;
                            }
                            gt[blk][s] = run;
                        }
                } else {
#pragma unroll
                    for (int blk = 0; blk < 2; ++blk)
#pragma unroll
                        for (int s = 0; s < 2; ++s) {
                            float run = 1.f;
#pragma unroll
                            for (int q = 7; q >= 0; --q) {
                                const float rn = run * __builtin_amdgcn_rcpf(1.f + fexp2(p[blk][8 * s + q]));
                                p[blk][8 * s + q] = run - rn;
                                run = rn;
                            }
                            gt[blk][s] = run;
                        }
                }
                float og[2][2], pt[2][2];
#pragma unroll
                for (int blk = 0; blk < 2; ++blk)
#pragma unroll
                    for (int s = 0; s < 2; ++s) { og[blk][s] = xhalf(gt[blk][s]); pt[blk][s] = gt[blk][s] * og[blk][s]; }
                float above = rest;
#pragma unroll
                for (int pi = 3; pi >= 0; --pi) {
                    const int blk = pi >> 1, s = pi & 1;
                    const float carry = above * (h == 0 ? og[blk][s] : 1.f);
#pragma unroll
                    for (int q = 0; q < 8; ++q) p[blk][8 * s + q] *= carry;
                    above *= pt[blk][s];
                }
                rest = above;
            } else {
                const bool need_causal = 64 * j + 63 > t_first;
                const bool need_win = VAR == 1 && (64 * j + 512 <= t_first + 31);
                const bool lane_on = VAR != 0 || ((selbits >> j) & 1u);
                if (VAR == 2) {
#pragma unroll
                    for (int blk = 0; blk < 2; ++blk)
#pragma unroll
                        for (int s = 0; s < 2; ++s) {
                            const float4 b0 = *(const float4*)(bias2 + kvb + 32 * blk + 16 * s), b1 = *(const float4*)(bias2 + kvb + 32 * blk + 16 * s + 4);
                            p[blk][8 * s] += b0.x; p[blk][8 * s + 1] += b0.y; p[blk][8 * s + 2] += b0.z; p[blk][8 * s + 3] += b0.w;
                            p[blk][8 * s + 4] += b1.x; p[blk][8 * s + 5] += b1.y; p[blk][8 * s + 6] += b1.z; p[blk][8 * s + 7] += b1.w;
                        }
                }
                if (need_causal) {
#pragma unroll
                    for (int blk = 0; blk < 2; ++blk)
#pragma unroll
                        for (int q = 0; q < 16; ++q) { const int kv = kvb + 32 * blk + 16 * (q >> 3) + (q & 7); p[blk][q] = kv <= t ? p[blk][q] : NEG_INF; }
                }
                if (need_win) {
#pragma unroll
                    for (int blk = 0; blk < 2; ++blk)
#pragma unroll
                        for (int q = 0; q < 16; ++q) { const int kv = kvb + 32 * blk + 16 * (q >> 3) + (q & 7); p[blk][q] = kv + 512 > t ? p[blk][q] : NEG_INF; }
                }
                float tmax = p[0][0];
#pragma unroll
                for (int q = 1; q < 16; ++q) tmax = fmaxf(tmax, p[0][q]);
#pragma unroll
                for (int q = 0; q < 16; ++q) tmax = fmaxf(tmax, p[1][q]);
                tmax = lane_on ? tmax : NEG_INF;
                tmax = xhalf_max(tmax);
                const float mnew = fmaxf(mrun, tmax);
                const bool grew = mnew > mrun;
                const float alpha = fexp2(mrun - mnew);
                mrun = mnew;
                const float msub = lane_on ? mnew : __builtin_inff();
                const f32x2_t ms2 = {msub, msub};
                f32x2_t ls2 = {0.f, 0.f};
#pragma unroll
                for (int blk = 0; blk < 2; ++blk)
#pragma unroll
                    for (int q = 0; q < 16; q += 2) {
                        const f32x2_t d2 = (f32x2_t){p[blk][q], p[blk][q + 1]} - ms2;
                        f32x2_t e2; e2.x = fexp2(d2.x); e2.y = fexp2(d2.y);
                        p[blk][q] = e2.x; p[blk][q + 1] = e2.y; ls2 += e2;
                    }
                lrun = lrun * alpha + (ls2.x + ls2.y);
                if (__any(grew)) {
#pragma unroll
                    for (int db = 0; db < 2; ++db)
#pragma unroll
                        for (int q = 0; q < 16; ++q) o[db][q] *= alpha;
                }
            }
            pv_tile(Kt + 8192, p, r, h, o);
        }
        if (jn >= 0) kv_store(lds + (stage ^ 1) * 16384, TIDX, rg);
        __syncthreads();
        if (jn < 0) break;
        j = jn; stage ^= 1;
    }
    if (VAR != 3) {
        const float lt = xhalf_sum(lrun);
        const float inv = lt > 0.f ? 1.f / lt : 0.f;
#pragma unroll
        for (int db = 0; db < 2; ++db)
#pragma unroll
            for (int q = 0; q < 16; ++q) o[db][q] *= inv;
    }
}

DEV void head_norm_store(const f32x16 (&o)[2], const float* gam, bf16_t* dst, int h) {
    float ss = 0.f;
#pragma unroll
    for (int db = 0; db < 2; ++db)
#pragma unroll
        for (int q = 0; q < 16; ++q) ss += o[db][q] * o[db][q];
    ss += __shfl_xor(ss, 32);
    const float rinv = rsqrtf(ss * (1.f / 64.f) + EPS);
#pragma unroll
    for (int db = 0; db < 2; ++db)
#pragma unroll
        for (int g = 0; g < 4; ++g) {
            const int d = 32 * db + 8 * g + 4 * h;
            const float4 gg = *(const float4*)(gam + d);
            uint2 u;
            u.x = cvtpk(o[db][4 * g] * rinv * gg.x, o[db][4 * g + 1] * rinv * gg.y);
            u.y = cvtpk(o[db][4 * g + 2] * rinv * gg.z, o[db][4 * g + 3] * rinv * gg.w);
            *(uint2*)(dst + d) = u;
        }
}

template <int VAR>
DEV void mha_unit(const P& p, int l, int unit, unsigned char* lds) {
    const V v = make_views(p); const int TIDX = otid();
    const int lane = TIDX & 63, wave = TIDX >> 6, r = lane & 31, h = lane >> 5;
    const int qb = 15 - (unit >> 5), bh = unit & 31, b = bh >> 2, hh = bh & 3;
    const int t0 = qb * 128, tw = t0 + 32 * wave, t = tw + r, m = b * S + t;
    const int qcol = VAR == 2 ? C_QB : C_QC, kcol = VAR == 2 ? C_KB : C_KCC, vrow = VAR == 2 ? 256 : 512, ocol = VAR == 2 ? 512 : 768;
    bf16x8 qf[4];
#pragma unroll
    for (int s = 0; s < 4; ++s) qf[s] = scale_frag(*(const bf16x8*)(v.U + (size_t)m * NP + qcol + hh * 64 + 16 * s + 8 * h), C2);
    KVT src;
    src.k = v.U + (size_t)b * S * NP + kcol + hh * 64; src.ks = NP;
    src.v = (const bf16_t*)(p.ws + WS_VT) + (size_t)(b * 768 + vrow + hh * 64) * S; src.vs = S;
    const int last = (t0 + 127) >> 6;
    const unsigned tmask = last == 31 ? 0xffffffffu : ((1u << (last + 1)) - 1u);
    const float* bias2 = (const float*)(lds + 32768);
    if (VAR == 2) {
        float* cf = (float*)(lds + 32768);
        float* wt = (float*)(lds + 32768 + 8192);
        const float* lsf = (const float*)(p.ws + WS_LSF) + (size_t)(b * 4 + hh) * S;
        const int nel = t0 + 128;
        float x[8];
        if (8 * TIDX < nel) {
            const float4 a0 = *(const float4*)(lsf + 8 * TIDX), a1 = *(const float4*)(lsf + 8 * TIDX + 4);
            x[0] = a0.x; x[1] = x[0] + a0.y; x[2] = x[1] + a0.z; x[3] = x[2] + a0.w; x[4] = x[3] + a1.x; x[5] = x[4] + a1.y; x[6] = x[5] + a1.z; x[7] = x[6] + a1.w;
        } else {
#pragma unroll
            for (int q = 0; q < 8; ++q) x[q] = 0.f;
        }
        float inc = x[7];
#pragma unroll
        for (int o = 1; o < 64; o <<= 1) { const float tt = __shfl_up(inc, o); if (lane >= o) inc += tt; }
        __syncthreads();
        if (lane == 63) wt[wave] = inc;
        __syncthreads();
        float off = inc - x[7];
#pragma unroll
        for (int w = 0; w < 3; ++w) off += (w < wave) ? wt[w] : 0.f;
        if (8 * TIDX < nel) {
#pragma unroll
            for (int q = 0; q < 8; ++q) cf[8 * TIDX + q] = -(x[q] + off) * LOG2E;
        }
        __syncthreads();
    }
    f32x16 o[2];
    attn_branch<VAR>(lds, src, qf, tmask, (tw + 31) >> 6, t, tw, 0u, bias2, o, TIDX);
    head_norm_store(o, p.out_norm_g + (size_t)l * D + ocol + hh * 64, v.O + (size_t)m * D + ocol + hh * 64, h);
}

DEV void nsa_unit(const P& p, int l, int unit, unsigned char* lds) {
    const V v = make_views(p); const int TIDX = otid();
    const int lane = TIDX & 63, wave = TIDX >> 6, r = lane & 31, h = lane >> 5;
    const int qblk = 63 - (unit >> 4), bg = unit & 15, b = bg >> 1, g = bg & 1;
    const int t0 = qblk * 32, t = t0 + r, m = b * S + t, head = g * 4 + wave, cur = t0 >> 6;
    const float NEG_INF = -__builtin_inff();
    bf16x8 qf[4];
#pragma unroll
    for (int s = 0; s < 4; ++s) qf[s] = scale_frag(*(const bf16x8*)(v.U + (size_t)m * NP + C_QA + head * 64 + 16 * s + 8 * h), C2);
    const float g0 = sigmoidf_(v.gf[(size_t)m * 32 + head * 3]), g1 = sigmoidf_(v.gf[(size_t)m * 32 + head * 3 + 1]), g2 = sigmoidf_(v.gf[(size_t)m * 32 + head * 3 + 2]);
    f32x16 otot[2];
    float* PA = (float*)(lds + 32768);
    float* PB = (float*)(lds + 49152);
    float* SC = (float*)lds;
    unsigned* MASK = (unsigned*)(lds + 8192);
    {
        const bf16_t* ck = v.ck + (size_t)(b * 2 + g) * 128 * 64;
        const bf16_t* cvt = (const bf16_t*)(p.ws + WS_CVT) + (size_t)(b * 2 + g) * 64 * 128;
        const int c = TIDX & 7, r0 = TIDX >> 3;
        u32x4 rk[4], rv[4];
#pragma unroll
        for (int i = 0; i < 4; ++i) rk[i] = *(const u32x4*)(ck + (size_t)(r0 + 32 * i) * 64 + c * 8);
#pragma unroll
        for (int i = 0; i < 4; ++i) rv[i] = *(const u32x4*)(cvt + (size_t)(r0 + 32 * (i & 1)) * 128 + 64 * (i >> 1) + c * 8);
        __syncthreads();
#pragma unroll
        for (int i = 0; i < 4; ++i) *(u32x4*)(lds + tile_off(r0 + 32 * i, c)) = rk[i];
#pragma unroll
        for (int i = 0; i < 4; ++i) *(u32x4*)(lds + 16384 + 8192 * (i >> 1) + tile_off(r0 + 32 * (i & 1), c)) = rv[i];
        __syncthreads();
        f32x16 ps[2][2];
        score_tile(lds, qf, r, h, ps[0]);
        score_tile(lds + 8192, qf, r, h, ps[1]);
        const int nvalid = t >= 31 ? (t - 31) / 16 + 1 : 0;
        float mx = NEG_INF;
#pragma unroll
        for (int tt = 0; tt < 2; ++tt)
#pragma unroll
            for (int blk = 0; blk < 2; ++blk)
#pragma unroll
                for (int q = 0; q < 16; ++q) {
                    const int n = 64 * tt + 32 * blk + 16 * (q >> 3) + 8 * h + (q & 7);
                    const float x = n < nvalid ? ps[tt][blk][q] : NEG_INF;
                    ps[tt][blk][q] = x; mx = fmaxf(mx, x);
                }
        mx = fmaxf(mx, __shfl_xor(mx, 32));
        const float mxs = nvalid > 0 ? mx : 0.f;
        float ls = 0.f;
#pragma unroll
        for (int tt = 0; tt < 2; ++tt)
#pragma unroll
            for (int blk = 0; blk < 2; ++blk)
#pragma unroll
                for (int q = 0; q < 16; ++q) { const float e = fexp2(ps[tt][blk][q] - mxs); ps[tt][blk][q] = e; ls += e; }
        const float lt = ls + __shfl_xor(ls, 32);
        const float inv = lt > 0.f ? 1.f / lt : 0.f;
#pragma unroll
        for (int tt = 0; tt < 2; ++tt)
#pragma unroll
            for (int blk = 0; blk < 2; ++blk) {
#pragma unroll
                for (int q = 0; q < 16; ++q) ps[tt][blk][q] *= inv;
#pragma unroll
                for (int s = 0; s < 2; ++s) {
                    const int G0 = 16 * tt + 8 * blk + 4 * s + 2 * h;
                    const float a0 = (ps[tt][blk][8 * s] + ps[tt][blk][8 * s + 1]) + (ps[tt][blk][8 * s + 2] + ps[tt][blk][8 * s + 3]);
                    const float a1 = (ps[tt][blk][8 * s + 4] + ps[tt][blk][8 * s + 5]) + (ps[tt][blk][8 * s + 6] + ps[tt][blk][8 * s + 7]);
                    PA[(wave * 32 + G0) * 32 + r] = a0; PA[(wave * 32 + G0 + 1) * 32 + r] = a1;
                    PB[(wave * 32 + G0 + 1) * 32 + r] = ps[tt][blk][8 * s + 3];
                    if (G0 + 2 < 32) PB[(wave * 32 + G0 + 2) * 32 + r] = ps[tt][blk][8 * s + 7];
                }
            }
        f32x16 oc[2];
#pragma unroll
        for (int db = 0; db < 2; ++db)
#pragma unroll
            for (int q = 0; q < 16; ++q) oc[db][q] = 0.f;
        pv_tile(lds + 16384, ps[0], r, h, oc);
        pv_tile(lds + 24576, ps[1], r, h, oc);
#pragma unroll
        for (int db = 0; db < 2; ++db)
#pragma unroll
            for (int q = 0; q < 16; ++q) otot[db][q] = g0 * oc[db][q];
    }
    __syncthreads();
    const bool need_topk = cur > 15;
    if (need_topk) {
        const int q = TIDX & 31, j0 = (TIDX >> 5) * 4;
#pragma unroll
        for (int jj = 0; jj < 4; ++jj) {
            const int j = j0 + jj;
            float sc = 0.f;
#pragma unroll
            for (int w = 0; w < 4; ++w) sc += PA[(w * 32 + j) * 32 + q];
            if (j > 0) {
#pragma unroll
                for (int w = 0; w < 4; ++w) sc += PB[(w * 32 + j) * 32 + q];
            }
            const bool forced = (j == 0) || (j == cur) || (j == cur - 1);
            SC[q * 33 + j] = forced ? 1.0e4f : (j <= cur ? sc : -1.0f);
        }
        if (TIDX < 32) MASK[TIDX] = 0u;
        __syncthreads();
        unsigned bits = 0u;
#pragma unroll
        for (int jj = 0; jj < 4; ++jj) {
            const int j = j0 + jj;
            const float vj = SC[q * 33 + j];
            int rank = 0;
#pragma unroll
            for (int i = 0; i < 32; ++i) { const float vi = SC[q * 33 + i]; rank += (vi > vj || (vi == vj && i < j)) ? 1 : 0; }
            if (rank < 16) bits |= 1u << j;
        }
        atomicOr(&MASK[q], bits);
        __syncthreads();
    }
    const unsigned upto = (2u << cur) - 1u;
    unsigned mybits = upto, um = upto;
    if (need_topk) {
        mybits = MASK[r];
        um = 0u;
#pragma unroll
        for (int i = 0; i < 32; ++i) um |= MASK[i];
        um = (unsigned)__builtin_amdgcn_readfirstlane((int)um);
    }
    {
        KVT src; src.k = v.U + (size_t)b * S * NP + C_KS + g * 64; src.ks = NP;
        src.v = (const bf16_t*)(p.ws + WS_VT) + (size_t)(b * 768 + g * 64) * S; src.vs = S;
        f32x16 o[2];
        attn_branch<0>(lds, src, qf, um & upto, cur, t, t0, mybits, nullptr, o, TIDX);
#pragma unroll
        for (int db = 0; db < 2; ++db)
#pragma unroll
            for (int q = 0; q < 16; ++q) otot[db][q] += g1 * o[db][q];
    }
    {
        KVT src; src.k = v.U + (size_t)b * S * NP + C_KW + g * 64; src.ks = NP;
        src.v = (const bf16_t*)(p.ws + WS_VT) + (size_t)(b * 768 + 128 + g * 64) * S; src.vs = S;
        const int f = (t0 - 511 > 0 ? t0 - 511 : 0) >> 6;
        const unsigned wmask = upto & ~((1u << f) - 1u);
        f32x16 o[2];
        attn_branch<1>(lds, src, qf, wmask, cur, t, t0, 0u, nullptr, o, TIDX);
#pragma unroll
        for (int db = 0; db < 2; ++db)
#pragma unroll
            for (int q = 0; q < 16; ++q) otot[db][q] += g2 * o[db][q];
    }
    head_norm_store(otot, p.out_norm_g + (size_t)l * D + head * 64, v.O + (size_t)m * D + head * 64, h);
}

DEV void cmp_unit(const P& p, int l, int unit, unsigned char* lds) {
    const V v = make_views(p); const int TIDX = otid();
    const int lane = TIDX & 63, wave = TIDX >> 6, wm = wave >> 1, wn = wave & 1, r = lane & 31, h = lane >> 5;
    const int kv = unit & 1, bg = unit >> 1, b = bg >> 1, g = bg & 1, lk = l * 2 + kv;
    const int col = (kv ? C_VC : C_KC) + g * 64;
    const bf16_t* arow[4];
#pragma unroll
    for (int i = 0; i < 4; ++i) { const int n = (TIDX >> 3) + 32 * i; arow[i] = v.U + (size_t)(b * S + 16 * (n < 127 ? n : 126)) * NP + col; }
    f32x16 acc[2][2];
    gemm128<false>(lds, arow, (const bf16_t*)(p.ws + WS_CW1) + (size_t)lk * 2048 * 128, 128, 2048, acc, TIDX, NP);
    const float* pb = (const float*)(p.ws + WS_CPB) + lk * 8 * 128;
#pragma unroll
    for (int j = 0; j < 2; ++j)
#pragma unroll
        for (int i = 0; i < 2; ++i) {
            const int mrow = 64 * wm + 32 * i + r;
#pragma unroll
            for (int g4 = 0; g4 < 4; ++g4) {
                float4 bb = *(const float4*)(pb + 64 * wn + 32 * j + 8 * g4 + 4 * h);
#pragma unroll
                for (int c8 = 1; c8 < 8; ++c8) { const float4 b2 = *(const float4*)(pb + c8 * 128 + 64 * wn + 32 * j + 8 * g4 + 4 * h); bb.x += b2.x; bb.y += b2.y; bb.z += b2.z; bb.w += b2.w; }
                float x0 = acc[j][i][4 * g4] + bb.x, x1 = acc[j][i][4 * g4 + 1] + bb.y, x2 = acc[j][i][4 * g4 + 2] + bb.z, x3 = acc[j][i][4 * g4 + 3] + bb.w;
                x0 = x0 / (1.f + __expf(-x0)); x1 = x1 / (1.f + __expf(-x1)); x2 = x2 / (1.f + __expf(-x2)); x3 = x3 / (1.f + __expf(-x3));
                uint2 u; u.x = cvtpk(x0, x1); u.y = cvtpk(x2, x3);
                *(uint2*)(lds + wn * 16384 + tile_off(mrow, 4 * j + g4) + 8 * h) = u;
            }
        }
    {
        const bf16_t* w2 = (const bf16_t*)(p.ws + WS_CW2) + (size_t)lk * 64 * 128;
        const int c = TIDX & 7, r0 = TIDX >> 3;
#pragma unroll
        for (int i = 0; i < 4; ++i) {
            const int row = r0 + 32 * (i & 1), kt = i >> 1;
            *(u32x4*)(lds + 32768 + kt * 8192 + tile_off(row, c)) = *(const u32x4*)(w2 + (size_t)row * 128 + kt * 64 + c * 8);
        }
    }
    __syncthreads();
    f32x16 a2[2];
#pragma unroll
    for (int db = 0; db < 2; ++db)
#pragma unroll
        for (int q = 0; q < 16; ++q) a2[db][q] = 0.f;
#pragma unroll
    for (int kt = 0; kt < 2; ++kt)
#pragma unroll
        for (int s = 0; s < 4; ++s) {
            const bf16x8 hf = *(const bf16x8*)(lds + kt * 16384 + tile_off(32 * wave + r, 2 * s + h));
#pragma unroll
            for (int db = 0; db < 2; ++db) {
                const bf16x8 wf = *(const bf16x8*)(lds + 32768 + kt * 8192 + tile_off(32 * db + r, 2 * s + h));
                a2[db] = __builtin_amdgcn_mfma_f32_32x32x16_bf16(wf, hf, a2[db], 0, 0, 0);
            }
        }
    const int n = 32 * wave + r;
    if (kv == 0 && n < 127) {
        const int pos = 16 * n + 31;
#pragma unroll
        for (int q = 0; q < 4; ++q) {
            const float cs = v.rcos[pos * 8 + q + 4 * h], sn = v.rsin[pos * 8 + q + 4 * h];
            const float x1 = a2[0][q], x2 = a2[0][q + 4];
            a2[0][q] = x1 * cs - x2 * sn; a2[0][q + 4] = x2 * cs + x1 * sn;
        }
    }
    bf16_t* dst = (kv ? v.cv : v.ck) + ((size_t)bg * 128 + n) * 64;
    bf16_t* dt = (bf16_t*)(p.ws + WS_CVT) + (size_t)bg * 64 * 128 + n;
#pragma unroll
    for (int db = 0; db < 2; ++db)
#pragma unroll
        for (int g4 = 0; g4 < 4; ++g4) {
            const int d = 32 * db + 8 * g4 + 4 * h;
            float x0 = a2[db][4 * g4], x1 = a2[db][4 * g4 + 1], x2 = a2[db][4 * g4 + 2], x3 = a2[db][4 * g4 + 3];
            if (n >= 127) { x0 = 0.f; x1 = 0.f; x2 = 0.f; x3 = 0.f; }
            uint2 u; u.x = cvtpk(x0, x1); u.y = cvtpk(x2, x3);
            *(uint2*)(dst + d) = u;
            if (kv) { dt[(size_t)d * 128] = (bf16_t)(u.x & 0xffffu); dt[(size_t)(d + 1) * 128] = (bf16_t)(u.x >> 16); dt[(size_t)(d + 2) * 128] = (bf16_t)(u.y & 0xffffu); dt[(size_t)(d + 3) * 128] = (bf16_t)(u.y >> 16); }
        }
    __syncthreads();
}

typedef float f32x4m __attribute__((ext_vector_type(4)));
DEV void ph_norm2_router_fast(const P& p, int l, unsigned char* lds) {
    const V v = make_views(p); const int TIDX = otid(), BIDX = obid();
    const int lane = TIDX & 63, wave = TIDX >> 6;
    const bf16_t* wr = (const bf16_t*)(p.ws + WS_WR) + (size_t)l * 2 * 64 * D;
    float* LG = (float*)(lds + 65536);
    for (int blk = BIDX; blk < T / 16; blk += gridDim.x) {
        const int m0 = blk * 16, b = m0 >> 11;
        const float* md = v.mod + (size_t)(l * 8 + b) * 6144;
        float4 xv[4][4]; float ssq[4];
#pragma unroll
        for (int rr = 0; rr < 4; ++rr)
#pragma unroll
            for (int j = 0; j < 4; ++j) xv[rr][j] = *(const float4*)(v.X + (size_t)(m0 + wave * 4 + rr) * D + 4 * lane + 256 * j);
#pragma unroll
        for (int rr = 0; rr < 4; ++rr) {
            ssq[rr] = 0.f;
#pragma unroll
            for (int j = 0; j < 4; ++j) ssq[rr] += xv[rr][j].x * xv[rr][j].x + xv[rr][j].y * xv[rr][j].y + xv[rr][j].z * xv[rr][j].z + xv[rr][j].w * xv[rr][j].w;
        }
#pragma unroll
        for (int o = 1; o < 64; o <<= 1) {
#pragma unroll
            for (int rr = 0; rr < 4; ++rr) ssq[rr] += __shfl_xor(ssq[rr], o);
        }
#pragma unroll
        for (int rr = 0; rr < 4; ++rr) {
            const int row = wave * 4 + rr, m = m0 + row;
            const float rs = rsqrtf(ssq[rr] * (1.f / D) + EPS);
#pragma unroll
            for (int j = 0; j < 4; ++j) {
                const int c = 4 * lane + 256 * j;
                const float4 g = *(const float4*)(p.norm2_g + l * D + c), sh = *(const float4*)(md + 3 * D + c), sc = *(const float4*)(md + 4 * D + c);
                const float h0 = xv[rr][j].x * rs * g.x * (1.f + sc.x) + sh.x, h1 = xv[rr][j].y * rs * g.y * (1.f + sc.y) + sh.y;
                const float h2 = xv[rr][j].z * rs * g.z * (1.f + sc.z) + sh.z, h3 = xv[rr][j].w * rs * g.w * (1.f + sc.w) + sh.w;
                uint2 hi; hi.x = cvtpk(h0, h1); hi.y = cvtpk(h2, h3);
                uint2 lo;
                lo.x = cvtpk(h0 - __uint_as_float(hi.x << 16), h1 - __uint_as_float(hi.x & 0xffff0000u));
                lo.y = cvtpk(h2 - __uint_as_float(hi.y << 16), h3 - __uint_as_float(hi.y & 0xffff0000u));
                *(uint2*)(v.H + (size_t)m * D + c) = hi;
                const int off = row * 2048 + ((((c >> 3) ^ row) & 127) << 4) + (c & 7) * 2;
                *(uint2*)(lds + off) = hi; *(uint2*)(lds + 32768 + off) = lo;
            }
        }
        __syncthreads();
        {
            const int r16 = lane & 15, kq = lane >> 4;
            f32x4m acc = {0.f, 0.f, 0.f, 0.f};
            const bf16_t* wh = wr + (size_t)(16 * wave + r16) * D + 8 * kq;
#pragma unroll 8
            for (int s = 0; s < 32; ++s) {
                const int off = r16 * 2048 + ((((4 * s + kq) ^ r16) & 127) << 4);
                const bf16x8 ah = *(const bf16x8*)(lds + off), al = *(const bf16x8*)(lds + 32768 + off);
                const bf16x8 bh = *(const bf16x8*)(wh + 32 * s), bl = *(const bf16x8*)(wh + 64 * D + 32 * s);
                acc = __builtin_amdgcn_mfma_f32_16x16x32_bf16(ah, bh, acc, 0, 0, 0);
                acc = __builtin_amdgcn_mfma_f32_16x16x32_bf16(al, bh, acc, 0, 0, 0);
                acc = __builtin_amdgcn_mfma_f32_16x16x32_bf16(ah, bl, acc, 0, 0, 0);
            }
#pragma unroll
            for (int q = 0; q < 4; ++q) LG[(4 * kq + q) * 64 + 16 * wave + r16] = acc[q];
        }
        __syncthreads();
        if (TIDX < 16) {
            const int m = m0 + TIDX;
            const float* lgp = LG + TIDX * 64;
            float lg[4], le[32];
#pragma unroll
            for (int i = 0; i < 4; ++i) lg[i] = lgp[i] + p.rg_b[l * 4 + i];
#pragma unroll
            for (int i = 0; i < 32; ++i) le[i] = lgp[4 + i] + p.re_b[l * 32 + i];
            int gi = 0; float gm = lg[0];
#pragma unroll
            for (int i = 1; i < 4; ++i) if (lg[i] > gm) { gm = lg[i]; gi = i; }
            float gs = 0.f;
#pragma unroll
            for (int i = 0; i < 4; ++i) gs += expf(lg[i] - gm);
            const float pg = 1.f / gs;
            float el[8];
#pragma unroll
            for (int i = 0; i < 8; ++i) el[i] = gi == 0 ? le[i] : (gi == 1 ? le[8 + i] : (gi == 2 ? le[16 + i] : le[24 + i]));
            int e1 = 0; float m1 = el[0];
#pragma unroll
            for (int i = 1; i < 8; ++i) if (el[i] > m1) { m1 = el[i]; e1 = i; }
            int e2 = -1; float m2 = -3.0e38f;
#pragma unroll
            for (int i = 0; i < 8; ++i) if (i != e1 && el[i] > m2) { m2 = el[i]; e2 = i; }
            const float p2 = expf(m2 - m1);
            const float w1 = pg / (1.f + p2), w2 = pg * p2 / (1.f + p2);
            const int ea = gi * 8 + e1, eb = gi * 8 + e2;
            const unsigned pa = atomicAdd(v.ctl + CW_CNT + l * 32 + ea, 1u);
            const unsigned pb = atomicAdd(v.ctl + CW_CNT + l * 32 + eb, 1u);
            v.list[(size_t)ea * T + pa] = 2 * m;
            v.list[(size_t)eb * T + pb] = 2 * m + 1;
            v.wts[2 * m] = w1; v.wts[2 * m + 1] = w2;
        }
        __syncthreads();
    }
}

constexpr int CW_MQ = 8192 + 512;
DEV void ph_mix(const P& p, int l, unsigned char* lds, volatile LAS unsigned* qslot, int rep) {
    const int TIDX = otid(), BIDX = obid();
    unsigned* ctl = (unsigned*)(p.ws + WS_CTL) + CW_MQ + l * 256;
    unsigned acq = 0u;
    for (int hop = 0; hop < 8; ++hop) {
        const int b = (BIDX + hop) & 7;
        unsigned* qc = ctl + b * 16;
        unsigned* done = ctl + 128 + b * 16;
        for (;;) {
            __syncthreads();
            if (TIDX == 0) *qslot = atomicAdd(qc, 1u);
            __syncthreads();
            const int v = (int)*qslot;
            if (v >= 260) break;
            if (v < 4) {
                cmp_unit(p, l, b * 4 + v, lds);
                asm volatile("s_waitcnt vmcnt(0)" ::: "memory");
                __syncthreads();
                if (TIDX == 0) {
                    __builtin_amdgcn_fence(__ATOMIC_RELEASE, "agent");
                    asm volatile("s_waitcnt vmcnt(0)" ::: "memory");
                    __hip_atomic_fetch_add(done, 1u, __ATOMIC_RELAXED, __HIP_MEMORY_SCOPE_AGENT);
                }
                continue;
            }
            int slot = -1, nsa = -1;
            if (v < 68) slot = v - 4;
            else { const int w2 = v - 68, k = w2 % 3, i = w2 / 3; if (k < 2) nsa = 2 * i + k; else slot = 64 + i; }
            if (slot >= 0) {
                const int idx = slot >> 1, u = ((idx >> 2) << 5) | (b * 4 + (idx & 3));
                if (slot & 1) mha_unit<3>(p, l, u, lds); else mha_unit<2>(p, l, u, lds);
            } else {
                if (!((acq >> b) & 1u)) {
                    if (TIDX == 0) {
                        unsigned sp = 0;
                        while (__hip_atomic_load(done, __ATOMIC_RELAXED, __HIP_MEMORY_SCOPE_AGENT) < 4u) { __builtin_amdgcn_s_sleep(2); if (++sp > (1u << 22)) break; }
                        __builtin_amdgcn_fence(__ATOMIC_ACQUIRE, "agent");
                        asm volatile("s_waitcnt vmcnt(0)" ::: "memory");
                    }
                    __syncthreads();
                    acq |= 1u << b;
                }
                nsa_unit(p, l, ((nsa >> 1) << 4) | (b * 2 + (nsa & 1)), lds);
            }
        }
    }
}

#ifndef REP_PHASE
#define REP_PHASE 0
#endif
#ifndef REF_HEADS
#define REF_HEADS 0x0000u
#endif
__global__ void __launch_bounds__(256, 2) fwd_kernel(P p) {
    __shared__ __attribute__((aligned(16))) float lds[17408];
    __shared__ __attribute__((aligned(16))) unsigned lds_ctl[4];
    if (threadIdx.x < 4) lds_ctl[threadIdx.x] = 0u;
    __syncthreads();
    const XcdBarrier xb = xcd_barrier_post((unsigned*)(p.ws + WS_CTL), (volatile LAS unsigned*)lds_ctl);
#define GRID_BAR() do { xcd_barrier(xb); if (REP_PHASE == 7) xcd_barrier(xb); } while (0)
    volatile LAS unsigned* qslot = (volatile LAS unsigned*)(lds_ctl + 2);
    for (int rep = 0; rep < (REP_PHASE == 1 ? 2 : 1); ++rep) {
        ph_prologue(p, lds);
        ph_convert(p, lds);
        GRID_BAR();
    }
    for (int l = 0; l < DEPTH; ++l) {
        ph_convert_dense(p, l, 0);
        ph_norm1(p, l, l == 0 ? 0 : 1);
        GRID_BAR();
        for (int rep = 0; rep < (REP_PHASE == 2 ? 2 : 1); ++rep) {
            if (rep == 0) ph_convert_dense(p, l, 1);
            ph_inproj_fast(p, l, (unsigned char*)lds);
            GRID_BAR();
        }
        for (int rep = 0; rep < (REP_PHASE == 3 ? 2 : 1); ++rep) {
            ph_mix(p, l, (unsigned char*)lds, qslot, rep);
            GRID_BAR();
        }
        ph_outproj_fast(p, l, (unsigned char*)lds);
        GRID_BAR();
        if (blockIdx.x & 8) { ph_convert_experts(p, l); ph_norm2_router_fast(p, l, (unsigned char*)lds); }
        else { ph_norm2_router_fast(p, l, (unsigned char*)lds); ph_convert_experts(p, l); }
        GRID_BAR();
        for (int rep = 0; rep < (REP_PHASE == 5 ? 2 : 1); ++rep) {
            ph_moe_up_fast(p, l, (unsigned char*)lds);
            GRID_BAR();
        }
        for (int rep = 0; rep < (REP_PHASE == 6 ? 2 : 1); ++rep) {
            ph_moe_down_fast(p, l, (unsigned char*)lds);
            GRID_BAR();
        }
    }
    ph_norm1(p, DEPTH, 2);
}

extern "C" void kernel_launch(void* const* d_in, const int* in_sizes, int n_in,
                              void* d_out, int out_size, void* d_ws, size_t ws_size,
                              hipStream_t stream) {
    static int grid_blocks = 0;
    if (!grid_blocks) {
        int dev = 0, cus = 0, per_cu = 0;
        (void)hipGetDevice(&dev);
        (void)hipDeviceGetAttribute(&cus, hipDeviceAttributeMultiprocessorCount, dev);
        (void)hipOccupancyMaxActiveBlocksPerMultiprocessor(&per_cu, fwd_kernel, 256, 0);
        if (per_cu > 2) per_cu = 2;
        if (per_cu < 1) per_cu = 1;
        grid_blocks = cus * per_cu;
        if (n_in != 24 || ws_size < WS_END || out_size != T * D) { fprintf(stderr, "kernel_launch: unexpected shapes (n_in %d ws %zu out %d)\n", n_in, ws_size, out_size); grid_blocks = -1; }
    }
    if (grid_blocks < 0) return;
    (void)hipMemsetAsync(d_ws, 0, CTL_BYTES, stream);
    P p{};
    const float** pp = (const float**)&p;
    for (int i = 0; i < 24; ++i) pp[i] = (const float*)d_in[i];
    p.out = (float*)d_out; p.ws = (unsigned char*)d_ws;
    void* args[] = {&p};
    hipError_t e = hipLaunchCooperativeKernel((void*)fwd_kernel, dim3(grid_blocks), dim3(256), args, 0, stream);
    if (e != hipSuccess) fprintf(stderr, "cooperative launch failed: %s (grid %d)\n", hipGetErrorString(e), grid_blocks);
}
```

```cpp
#include <hip/hip_runtime.h>
#include <hip/hip_cooperative_groups.h>
#include <cstdio>
#include <cstdint>

#define LAS __attribute__((address_space(3)))
#define DEV __device__ __forceinline__

constexpr int T = 16384, S = 2048, NB = 8, D = 1024, DIN = 2844, NP = 2880, DEPTH = 4;
constexpr int NCMP = 127;
constexpr float EPS = 1e-6f;
constexpr float SCALE = 0.125f;
constexpr int C_QA = 0, C_KC = 512, C_VC = 640, C_KS = 768, C_VS = 896, C_KW = 1024, C_VW = 1152;
constexpr int C_QB = 1280, C_KB = 1536, C_VB = 1792, C_QC = 2048, C_KCC = 2304, C_VCC = 2560;

constexpr size_t MiB = 1u << 20;
constexpr size_t WS_CTL = 0, CTL_BYTES = 64 * 1024;
constexpr size_t WS_MOD = 1 * MiB, WS_ROPE = 2 * MiB, WS_CUMF = 3 * MiB, WS_CK = 4 * MiB, WS_CV = 5 * MiB, WS_IMP = 6 * MiB;
constexpr size_t WS_SEL = 10 * MiB, WS_EID = 11 * MiB, WS_WTS = 12 * MiB, WS_LIST = 13 * MiB, WS_GF = 16 * MiB;
constexpr size_t WS_H = 32 * MiB, WS_U = 64 * MiB, WS_O = 160 * MiB, WS_HID = 192 * MiB, WS_Y = 224 * MiB, WS_OB = 352 * MiB, WS_ORAW = 448 * MiB;
constexpr size_t WS_END = 973 * MiB;
constexpr size_t WS_VT = 936 * MiB;
constexpr size_t WS_CVT = 962 * MiB;
constexpr size_t WS_CUMF2 = 963 * MiB;
constexpr int CW_Q = 8192 + 256;
constexpr size_t WS_CW1 = 964 * MiB;
constexpr size_t WS_CW2 = 968 * MiB;
constexpr size_t WS_CPB = 969 * MiB;
constexpr size_t WS_LSF = 970 * MiB;
constexpr size_t WS_WR = 971 * MiB;
constexpr int CW_CNT = 8192;

typedef unsigned short bf16_t;
typedef float f32x4v __attribute__((ext_vector_type(4)));
DEV int vt_row(int n) { return n < 1024 ? n - 896 : (n < 1280 ? 128 + n - 1152 : (n < 2048 ? 256 + n - 1792 : 512 + n - 2560)); }
DEV bool is_vcol(int n) { return (n >= C_VS && n < C_KW) || (n >= C_VW && n < C_QB) || (n >= C_VB && n < C_QC) || (n >= C_VCC && n < 2816); }
DEV float bf2f(bf16_t v) { return __uint_as_float((unsigned)v << 16); }
DEV bf16_t f2bf(float f) { unsigned u = __float_as_uint(f); return (bf16_t)((u + 0x7fffu + ((u >> 16) & 1u)) >> 16); }
DEV float4 ld_bf4(const bf16_t* p) { const ushort4 u = *(const ushort4*)p; return make_float4(bf2f(u.x), bf2f(u.y), bf2f(u.z), bf2f(u.w)); }
typedef float f32x2_t __attribute__((ext_vector_type(2)));
typedef __bf16 bf16x2_t __attribute__((ext_vector_type(2)));
DEV unsigned cvtpk(float lo, float hi) { f32x2_t v = {lo, hi}; bf16x2_t b = __builtin_convertvector(v, bf16x2_t); return __builtin_bit_cast(unsigned, b); }
DEV float sigmoidf_(float x) { return 1.f / (1.f + expf(-x)); }
DEV float logsigmoidf_(float x) { return fminf(x, 0.f) - log1pf(expf(-fabsf(x))); }
DEV float wave_sum(float v) {
#pragma unroll
    for (int o = 1; o < 64; o <<= 1) v += __shfl_xor(v, o);
    return v;
}

#define XB_TMO      128
#define XB_XCNT(j)  (256  + 64 * (j))
#define XB_XSUB(j)  (1280 + 64 * (j))
#define XB_XGEN(j)  (2304 + 64 * (j))
#define XB_TOP      3328
#define XB_TOPGEN   3392
#define XCD_BAR_WORDS 3456
#define XB_SPIN_CAP (1u << 23)
DEV unsigned xb_ld(unsigned* p)              { return __hip_atomic_load(p, __ATOMIC_RELAXED, __HIP_MEMORY_SCOPE_AGENT); }
DEV unsigned xb_add(unsigned* p, unsigned v) { return __hip_atomic_fetch_add(p, v, __ATOMIC_RELAXED, __HIP_MEMORY_SCOPE_AGENT); }
DEV unsigned xb_xcc_id() { return (unsigned)__builtin_amdgcn_s_getreg((3 << 11) | 20) & 0xFu; }
#define XB_SPIN(cond, bar) do { unsigned _sp = 0; while (cond) { __builtin_amdgcn_s_sleep(1); \
    if ((++_sp & 255u) == 0u) { if (xb_ld(&(bar)[XB_TMO])) break; if (_sp > XB_SPIN_CAP) { atomicAdd(&(bar)[XB_TMO], 1u); break; } } } } while (0)
struct XcdBarrier { unsigned* bar; unsigned x; volatile LAS unsigned* st; };
DEV XcdBarrier xcd_barrier_post(unsigned* bar, volatile LAS unsigned* st) {
    XcdBarrier b; b.bar = bar; b.x = xb_xcc_id(); b.st = st;
    if (threadIdx.x == 0) (void)xb_add(&bar[XB_XCNT(b.x)], 1u);
    return b;
}
DEV void xcd_barrier_complete(unsigned* bar, unsigned x, unsigned& nloc, unsigned& nx) {
    const unsigned G = gridDim.x * gridDim.y * gridDim.z;
    unsigned sum, cnt, mine, sp = 0u;
    for (;;) {
        sum = 0u; cnt = 0u; mine = 0u;
#pragma unroll
        for (unsigned j = 0; j < 16; ++j) { const unsigned c = xb_ld(&bar[XB_XCNT(j)]); sum += c; cnt += (c > 0u) ? 1u : 0u; mine = (j == x) ? c : mine; }
        if (sum == G) break;
        __builtin_amdgcn_s_sleep(1);
        if ((++sp & 255u) == 0u) { if (xb_ld(&bar[XB_TMO])) break; if (sp > XB_SPIN_CAP) { atomicAdd(&bar[XB_TMO], 1u); break; } }
    }
    nloc = mine > 0u ? mine : 1u; nx = cnt > 0u ? cnt : 1u;
}
DEV void xcd_barrier(const XcdBarrier& b) {
    asm volatile("s_waitcnt vmcnt(0)" ::: "memory");
    __syncthreads();
    if (threadIdx.x == 0) {
        unsigned* bar = b.bar;
        __builtin_amdgcn_s_waitcnt(0);
        unsigned nloc = b.st[0], nx = b.st[1];
        if (nloc == 0u) { xcd_barrier_complete(bar, b.x, nloc, nx); b.st[0] = nloc; b.st[1] = nx; }
        const unsigned old = xb_add(&bar[XB_XSUB(b.x)], 1u);
        const unsigned gen = old / nloc;
        if (old + 1u == (gen + 1u) * nloc) {
            __builtin_amdgcn_fence(__ATOMIC_RELEASE, "agent");
            asm volatile("s_waitcnt vmcnt(0)" ::: "memory");
            const unsigned og = xb_add(&bar[XB_TOP], 1u);
            const unsigned tg = og / nx;
            if (og + 1u == (tg + 1u) * nx) xb_add(&bar[XB_TOPGEN], 1u);
            else XB_SPIN(xb_ld(&bar[XB_TOPGEN]) == tg, bar);
            __builtin_amdgcn_fence(__ATOMIC_ACQUIRE, "agent");
            xb_add(&bar[XB_XGEN(b.x)], 1u);
            asm volatile("s_waitcnt vmcnt(0)" ::: "memory");
        } else {
            XB_SPIN(xb_ld(&bar[XB_XGEN(b.x)]) == gen, bar);
            __builtin_amdgcn_fence(__ATOMIC_ACQUIRE, "agent");
            asm volatile("s_waitcnt vmcnt(0)" ::: "memory");
        }
    }
    __syncthreads();
}

struct P {
    const float *x, *c, *norm1_g, *norm2_g, *ada_w, *ada_b, *w_in, *b_forget, *cmp_pos_k, *cmp_w1_k, *cmp_w2_k,
        *cmp_pos_v, *cmp_w1_v, *cmp_w2_v, *out_norm_g, *w_out, *rg_w, *rg_b, *re_w, *re_b, *e_w1, *e_w3, *e_w2, *final_g;
    float* out; unsigned char* ws;
};
struct V {
    unsigned* ctl; float* mod; float* rcos; float* rsin; float* cumf; bf16_t* ck; bf16_t* cv; float* imp; unsigned* sel;
    int* eid; float* wts; int* list; float* gf; bf16_t* H; bf16_t* U; bf16_t* O; bf16_t* HID; bf16_t* Y; float* OB; float* ORAW; float* X;
};
DEV int otid() { int t = threadIdx.x; asm volatile("" : "+v"(t)); return t; }
DEV int obid() { int t = blockIdx.x; asm volatile("" : "+s"(t)); return t; }
DEV V make_views(const P& p) {
    V v; size_t woff = 0; asm volatile("" : "+s"(woff)); unsigned char* w = p.ws + woff;
    v.ctl = (unsigned*)(w + WS_CTL); v.mod = (float*)(w + WS_MOD); v.rcos = (float*)(w + WS_ROPE); v.rsin = v.rcos + S * 8;
    v.cumf = (float*)(w + WS_CUMF); v.ck = (bf16_t*)(w + WS_CK); v.cv = (bf16_t*)(w + WS_CV); v.imp = (float*)(w + WS_IMP);
    v.sel = (unsigned*)(w + WS_SEL); v.eid = (int*)(w + WS_EID); v.wts = (float*)(w + WS_WTS); v.list = (int*)(w + WS_LIST);
    v.gf = (float*)(w + WS_GF); v.H = (bf16_t*)(w + WS_H); v.U = (bf16_t*)(w + WS_U); v.O = (bf16_t*)(w + WS_O);
    v.HID = (bf16_t*)(w + WS_HID); v.Y = (bf16_t*)(w + WS_Y); v.OB = (float*)(w + WS_OB); v.ORAW = (float*)(w + WS_ORAW); v.X = p.out;
    return v;
}

DEV void ph_prologue(const P& p, float* lds) {
    const V v = make_views(p); const int TIDX = otid(), BIDX = obid();
    const int tid = TIDX;
    for (int i = tid; i < NB * D; i += 256) { const float c = p.c[i]; lds[i] = c / (1.f + expf(-c)); }
    __syncthreads();
    float* red = lds + NB * D;
    const int c4 = tid & 15, ks = tid >> 4;
    for (int unit = BIDX; unit < DEPTH * 96; unit += gridDim.x) {
        const int l = unit / 96, n0 = (unit % 96) * 64;
        const float* W = p.ada_w + (size_t)l * D * 6144 + n0 + 4 * c4;
        float acc[8][4];
#pragma unroll
        for (int b = 0; b < 8; ++b)
#pragma unroll
            for (int q = 0; q < 4; ++q) acc[b][q] = 0.f;
#pragma unroll 1
        for (int i0 = 0; i0 < 64; i0 += 8) {
            f32x4v w[8];
#pragma unroll
            for (int i = 0; i < 8; ++i) w[i] = __builtin_nontemporal_load((const f32x4v*)(W + (size_t)(ks + 16 * (i0 + i)) * 6144));
#pragma unroll
            for (int i = 0; i < 8; ++i) {
                const int k = ks + 16 * (i0 + i);
#pragma unroll
                for (int b = 0; b < 8; ++b) {
                    const float cv = lds[b * D + k];
                    acc[b][0] += cv * w[i].x; acc[b][1] += cv * w[i].y; acc[b][2] += cv * w[i].z; acc[b][3] += cv * w[i].w;
                }
            }
        }
#pragma unroll
        for (int b = 0; b < 8; ++b) *(float4*)(red + (ks * 8 + b) * 64 + 4 * c4) = make_float4(acc[b][0], acc[b][1], acc[b][2], acc[b][3]);
        __syncthreads();
        for (int o = tid; o < 512; o += 256) {
            const int c2 = o & 63, b = o >> 6;
            float sm = p.ada_b[l * 6144 + n0 + c2];
#pragma unroll
            for (int q = 0; q < 16; ++q) sm += red[(q * 8 + b) * 64 + c2];
            v.mod[(size_t)(l * 8 + b) * 6144 + n0 + c2] = sm;
        }
        __syncthreads();
    }
    const float cst = -2.0f * 13.122363377404328f / 16.0f;
    for (int i = ((int)gridDim.x - 1 - BIDX) * 256 + tid; i < S * 8; i += gridDim.x * 256) {
        const int s = i >> 3, j = i & 7;
        const float inv = expf((float)j * cst);
        const float ang = (float)s * inv;
        v.rcos[i] = cosf(ang); v.rsin[i] = sinf(ang);
    }
}

DEV void ph_norm1(const P& p, int l, int mode) {
    const V v = make_views(p); const int TIDX = otid(), BIDX = obid();
    const int lane = TIDX & 63;
    const int gw = (BIDX * 256 + TIDX) >> 6, nw = gridDim.x * 4;
    for (int m0 = gw; m0 < T; m0 += 2 * nw) {
        float4 xv[2][4];
        if (mode == 0) {
#pragma unroll
            for (int rr = 0; rr < 2; ++rr)
#pragma unroll
                for (int j = 0; j < 4; ++j) xv[rr][j] = *(const float4*)(p.x + (size_t)(m0 + rr * nw) * D + 4 * lane + 256 * j);
        } else {
            float4 xa[2][4]; ushort4 ya[2][4], yb[2][4];
#pragma unroll
            for (int rr = 0; rr < 2; ++rr)
#pragma unroll
                for (int j = 0; j < 4; ++j) {
                    const int m = m0 + rr * nw, c = 4 * lane + 256 * j;
                    xa[rr][j] = *(const float4*)(v.X + (size_t)m * D + c);
                    ya[rr][j] = *(const ushort4*)(v.Y + (size_t)(2 * m) * D + c); yb[rr][j] = *(const ushort4*)(v.Y + (size_t)(2 * m + 1) * D + c);
                }
#pragma unroll
            for (int rr = 0; rr < 2; ++rr) {
                const float* g2 = v.mod + (size_t)((l - 1) * 8 + ((m0 + rr * nw) >> 11)) * 6144 + 5 * D;
#pragma unroll
                for (int j = 0; j < 4; ++j) {
                    const float4 g = *(const float4*)(g2 + 4 * lane + 256 * j);
                    float4 a = xa[rr][j];
                    a.x += g.x * (bf2f(ya[rr][j].x) + bf2f(yb[rr][j].x)); a.y += g.y * (bf2f(ya[rr][j].y) + bf2f(yb[rr][j].y));
                    a.z += g.z * (bf2f(ya[rr][j].z) + bf2f(yb[rr][j].z)); a.w += g.w * (bf2f(ya[rr][j].w) + bf2f(yb[rr][j].w));
                    xv[rr][j] = a;
                }
            }
        }
        float ss[2];
#pragma unroll
        for (int rr = 0; rr < 2; ++rr) {
            ss[rr] = 0.f;
#pragma unroll
            for (int j = 0; j < 4; ++j) ss[rr] += xv[rr][j].x * xv[rr][j].x + xv[rr][j].y * xv[rr][j].y + xv[rr][j].z * xv[rr][j].z + xv[rr][j].w * xv[rr][j].w;
        }
#pragma unroll
        for (int o = 1; o < 64; o <<= 1) { ss[0] += __shfl_xor(ss[0], o); ss[1] += __shfl_xor(ss[1], o); }
#pragma unroll
        for (int rr = 0; rr < 2; ++rr) {
            const int m = m0 + rr * nw, b = m >> 11;
            const float r = rsqrtf(ss[rr] * (1.f / D) + EPS);
            if (mode == 2) {
#pragma unroll
                for (int j = 0; j < 4; ++j) {
                    const int c = 4 * lane + 256 * j;
                    const float4 g = *(const float4*)(p.final_g + c);
                    float4 o; o.x = xv[rr][j].x * r * g.x; o.y = xv[rr][j].y * r * g.y; o.z = xv[rr][j].z * r * g.z; o.w = xv[rr][j].w * r * g.w;
                    *(float4*)(v.X + (size_t)m * D + c) = o;
                }
            } else {
                const float* md = v.mod + (size_t)(l * 8 + b) * 6144;
#pragma unroll
                for (int j = 0; j < 4; ++j) {
                    const int c = 4 * lane + 256 * j;
                    *(float4*)(v.X + (size_t)m * D + c) = xv[rr][j];
                    const float4 g = *(const float4*)(p.norm1_g + l * D + c), sh = *(const float4*)(md + c), sc = *(const float4*)(md + D + c);
                    uint2 o;
                    o.x = cvtpk(xv[rr][j].x * r * g.x * (1.f + sc.x) + sh.x, xv[rr][j].y * r * g.y * (1.f + sc.y) + sh.y);
                    o.y = cvtpk(xv[rr][j].z * r * g.z * (1.f + sc.z) + sh.z, xv[rr][j].w * r * g.w * (1.f + sc.w) + sh.w);
                    *(uint2*)(v.H + (size_t)m * D + c) = o;
                }
            }
        }
    }
}

typedef short bf16x8 __attribute__((ext_vector_type(8)));
typedef float f32x16 __attribute__((ext_vector_type(16)));
typedef unsigned u32x4 __attribute__((ext_vector_type(4)));
constexpr size_t WS_WIN = 512 * MiB, WS_WOT = 544 * MiB, WS_W13 = 552 * MiB, WS_W2 = 808 * MiB;
constexpr int NPW = 2944;
DEV int tile_off(int row, int chunk) { return row * 128 + ((chunk ^ ((row >> 1) & 7)) << 4); }
template <class RM>
DEV void conv_patch(const float* src, int N, int K, bf16_t* dst, int k0, int n0, RM rowmap, int lane) {
    const int kg = lane >> 3, n = n0 + 4 * (lane & 7);
    if (n >= N) return;
    const float* sp = src + (size_t)(k0 + 8 * kg) * N + n;
    f32x4v x[8];
#pragma unroll
    for (int j = 0; j < 8; ++j) x[j] = __builtin_nontemporal_load((const f32x4v*)(sp + (size_t)j * N));
    bf16_t* dp = dst + k0 + 8 * kg;
    u32x4 o;
    o.x = cvtpk(x[0].x, x[1].x); o.y = cvtpk(x[2].x, x[3].x); o.z = cvtpk(x[4].x, x[5].x); o.w = cvtpk(x[6].x, x[7].x);
    *(u32x4*)(dp + (size_t)rowmap(n) * K) = o;
    o.x = cvtpk(x[0].y, x[1].y); o.y = cvtpk(x[2].y, x[3].y); o.z = cvtpk(x[4].y, x[5].y); o.w = cvtpk(x[6].y, x[7].y);
    *(u32x4*)(dp + (size_t)rowmap(n + 1) * K) = o;
    o.x = cvtpk(x[0].z, x[1].z); o.y = cvtpk(x[2].z, x[3].z); o.z = cvtpk(x[4].z, x[5].z); o.w = cvtpk(x[6].z, x[7].z);
    *(u32x4*)(dp + (size_t)rowmap(n + 2) * K) = o;
    o.x = cvtpk(x[0].w, x[1].w); o.y = cvtpk(x[2].w, x[3].w); o.z = cvtpk(x[4].w, x[5].w); o.w = cvtpk(x[6].w, x[7].w);
    *(u32x4*)(dp + (size_t)rowmap(n + 3) * K) = o;
}

DEV void conv8(const float* s0, const float* s1, bf16_t* dst) {
    f32x4v a = {0.f, 0.f, 0.f, 0.f}, b = {0.f, 0.f, 0.f, 0.f};
    if (s0) a = __builtin_nontemporal_load((const f32x4v*)s0);
    if (s1) b = __builtin_nontemporal_load((const f32x4v*)s1);
    u32x4 o; o.x = cvtpk(a[0], a[1]); o.y = cvtpk(a[2], a[3]); o.z = cvtpk(b[0], b[1]); o.w = cvtpk(b[2], b[3]);
    *(u32x4*)dst = o;
}
DEV void ph_convert_dense(const P& p, int l, int which) {
    const int TIDX = otid(), BIDX = obid();
    size_t woff = 0; asm volatile("" : "+s"(woff)); unsigned char* w = p.ws + woff;
    const size_t gtid = (size_t)BIDX * 256 + TIDX, gsz = (size_t)gridDim.x * 256;
    if (which == 0) {
        bf16_t* win = (bf16_t*)(w + WS_WIN);
        for (size_t i = gtid; i < (size_t)D * 368; i += gsz) {
            const int g8 = (int)(i % 368); const size_t lk = (size_t)l * D + i / 368;
            const int n = g8 * 8;
            const float* row = p.w_in + lk * DIN;
            const float *s0, *s1;
            if (n < 2816) { const int oc = n + (n >= 2048 ? 28 : (n >= 1280 ? 24 : 0)); s0 = row + oc; s1 = row + oc + 4; }
            else if (n < 2840) { s0 = row + 1280 + (n - 2816); s1 = s0 + 4; }
            else if (n == 2840) { s0 = row + 2072; s1 = nullptr; }
            else { s0 = nullptr; s1 = nullptr; }
            conv8(s0, s1, win + lk * NPW + n);
        }
    } else {
        bf16_t* wot = (bf16_t*)(w + WS_WOT);
        const size_t oo = (size_t)l * D * D;
        for (size_t i = gtid; i < (size_t)D * D / 8; i += gsz) conv8(p.w_out + oo + i * 8, p.w_out + oo + i * 8 + 4, wot + oo + i * 8);
        for (size_t i = gtid; i < (size_t)2 * 2048 * 128 / 8; i += gsz) {
            const size_t per = (size_t)2048 * 128 / 8; const int kv = (int)(i / per), lk = l * 2 + kv; const size_t off = (i % per) * 8;
            const float* src = (kv ? p.cmp_w1_v : p.cmp_w1_k) + (size_t)l * 2048 * 128 + off;
            conv8(src, src + 4, (bf16_t*)(w + WS_CW1) + (size_t)lk * 2048 * 128 + off);
        }
    }
}
DEV void ph_convert_experts(const P& p, int l) {
    const int TIDX = otid(), BIDX = obid();
    size_t woff = 0; asm volatile("" : "+s"(woff)); unsigned char* w = p.ws + woff;
    bf16_t* w13 = (bf16_t*)(w + WS_W13); bf16_t* w2t = (bf16_t*)(w + WS_W2);
    const size_t gtid = (size_t)BIDX * 256 + TIDX, gsz = (size_t)gridDim.x * 256;
    for (size_t i = gtid; i < (size_t)32 * D * 128; i += gsz) {
        const int g8 = (int)(i & 127); const size_t lek = (size_t)l * 32 * D + (i >> 7);
        const int n = g8 * 8, which = (n >> 5) & 1, c = 32 * (n >> 6) + (n & 31);
        const float* src = (which ? p.e_w3 : p.e_w1) + lek * 512 + c;
        conv8(src, src + 4, w13 + lek * 1024 + n);
    }
    const size_t o2 = (size_t)l * 32 * 512 * D;
    for (size_t i = gtid; i < (size_t)32 * 512 * D / 8; i += gsz) conv8(p.e_w2 + o2 + i * 8, p.e_w2 + o2 + i * 8 + 4, w2t + o2 + i * 8);
}
DEV void ph_convert(const P& p, float* lds) {
    const int TIDX = otid(), BIDX = obid();
    size_t woff = 0; asm volatile("" : "+s"(woff)); unsigned char* w = p.ws + woff;
    const int lane = TIDX & 63;
    for (int unit = BIDX * 4 + (TIDX >> 6); unit < DEPTH * 2 * 4; unit += gridDim.x * 4) {
        const int lk = unit >> 2, t = unit & 3, l = lk >> 1, kv = lk & 1;
        conv_patch((kv ? p.cmp_w2_v : p.cmp_w2_k) + (size_t)l * 128 * 64, 64, 128, (bf16_t*)(w + WS_CW2) + (size_t)lk * 64 * 128, (t >> 1) * 64, (t & 1) * 32, [](int n) { return n; }, lane);
    }
    for (int o = BIDX * 256 + TIDX; o < DEPTH * 64 * D; o += gridDim.x * 256) {
        const int k = o & (D - 1), n = (o >> 10) & 63, l = o >> 16;
        const float val = n < 4 ? p.rg_w[((size_t)l * D + k) * 4 + n] : (n < 36 ? p.re_w[((size_t)l * D + k) * 32 + n - 4] : 0.f);
        const bf16_t hi = f2bf(val); const bf16_t lo = f2bf(val - bf2f(hi));
        bf16_t* wr = (bf16_t*)(w + WS_WR) + (size_t)l * 2 * 64 * D;
        wr[n * D + k] = hi; wr[64 * D + n * D + k] = lo;
    }
    int pu = (int)gridDim.x - 1 - BIDX - 64; if (pu < 0) pu += gridDim.x;
    for (int unit = pu; unit < DEPTH * 2 * 8; unit += gridDim.x) {
        const int lk = unit >> 3, ch = unit & 7, l = lk >> 1, kv = lk & 1, j = TIDX & 127, hf = TIDX >> 7;
        const float* pe = (kv ? p.cmp_pos_v : p.cmp_pos_k) + (size_t)l * 2048 + ch * 256 + hf * 128;
        const float* w1 = (kv ? p.cmp_w1_v : p.cmp_w1_k) + (size_t)l * 2048 * 128 + (size_t)(ch * 256 + hf * 128) * 128 + j;
        float a0 = 0.f, a1 = 0.f, a2 = 0.f, a3 = 0.f;
#pragma unroll 1
        for (int k0 = 0; k0 < 128; k0 += 32) {
            float wv[32];
#pragma unroll
            for (int k = 0; k < 32; ++k) wv[k] = w1[(size_t)(k0 + k) * 128];
#pragma unroll
            for (int k = 0; k < 32; k += 4) {
                a0 += pe[k0 + k] * wv[k]; a1 += pe[k0 + k + 1] * wv[k + 1];
                a2 += pe[k0 + k + 2] * wv[k + 2]; a3 += pe[k0 + k + 3] * wv[k + 3];
            }
        }
        const float a = (a0 + a1) + (a2 + a3);
        __syncthreads();
        if (hf) lds[j] = a;
        __syncthreads();
        if (!hf) ((float*)(w + WS_CPB))[(lk * 8 + ch) * 128 + j] = a + lds[j];
    }
}

typedef short v4i16_t __attribute__((ext_vector_type(4)));
DEV void gemm_issue0(unsigned char* lds, const bf16_t* const (&arow)[4], const bf16_t* Bsrc, const size_t ldb, const int TIDX) {
    const int lane = TIDX & 63, wave = TIDX >> 6;
    const int gsw = ((TIDX & 7) ^ ((TIDX >> 4) & 7)) * 8;
    const bf16_t* bg = Bsrc + (size_t)(4 * wave + (lane >> 4)) * ldb + ((lane & 15) ^ (((lane >> 4) << 2) | (wave & 3))) * 8;
    LAS unsigned char* l3 = (LAS unsigned char*)lds + __builtin_amdgcn_readfirstlane(wave) * 1024;
#pragma unroll
    for (int i = 0; i < 4; ++i) {
        __builtin_amdgcn_global_load_lds((const unsigned*)(arow[i] + gsw), (LAS unsigned*)(l3 + i * 4096), 16, 0, 0);
        __builtin_amdgcn_global_load_lds((const unsigned*)(bg + (size_t)(16 * i) * ldb), (LAS unsigned*)(l3 + 16384 + i * 4096), 16, 0, 0);
    }
}
template <bool SWAP, bool PRE = false>
DEV void gemm128(unsigned char* lds, const bf16_t* const (&arow)[4], const bf16_t* Bsrc, const size_t ldb, int K, f32x16 (&acc)[2][2], const int TIDX, const int astride = 64) {
    const int lane = TIDX & 63, wave = TIDX >> 6, wm = wave >> 1, wn = wave & 1, r = lane & 31, h = lane >> 5;
#pragma unroll
    for (int j = 0; j < 2; ++j)
#pragma unroll
        for (int i = 0; i < 2; ++i)
#pragma unroll
            for (int q = 0; q < 16; ++q) acc[j][i][q] = 0.f;
    const int gsw = ((TIDX & 7) ^ ((TIDX >> 4) & 7)) * 8;
    const bf16_t* ag[4];
#pragma unroll
    for (int i = 0; i < 4; ++i) ag[i] = arow[i] + gsw;
    const int brow = 4 * wave + (lane >> 4), bch = ((lane & 15) ^ (((lane >> 4) << 2) | (wave & 3))) * 8;
    const bf16_t* bg = Bsrc + (size_t)brow * ldb + bch;
    LAS unsigned char* l3 = (LAS unsigned char*)lds + __builtin_amdgcn_readfirstlane(wave) * 1024;
    LAS unsigned char* tb[2][2];
    {
        const int blk = (lane >> 4) & 1, q = (lane & 15) >> 2, pp = lane & 3;
#pragma unroll
        for (int j = 0; j < 2; ++j)
#pragma unroll
            for (int t = 0; t < 2; ++t) {
                const int row = 4 * t + 8 * h + q, ch = 4 * (2 * wn + j) + 2 * blk + (pp >> 1);
                tb[j][t] = (LAS unsigned char*)lds + 16384 + 256 * row + 16 * (ch ^ (((row & 3) << 2) | ((row >> 2) & 3))) + 8 * (pp & 1);
            }
    }
#define G_DMA(st_, kt_) do { _Pragma("unroll") for (int i = 0; i < 4; ++i) { \
        __builtin_amdgcn_global_load_lds((const unsigned*)(ag[i] + (size_t)(kt_) * astride), (LAS unsigned*)(l3 + (st_) + i * 4096), 16, 0, 0); \
        __builtin_amdgcn_global_load_lds((const unsigned*)(bg + ((size_t)(kt_) * 64 + 16 * i) * ldb), (LAS unsigned*)(l3 + (st_) + 16384 + i * 4096), 16, 0, 0); } } while (0)
    const int KT = K >> 6;
    if (!PRE) {
        __syncthreads();
        G_DMA(0, 0);
    }
    for (int kt = 0; kt < KT; ++kt) {
        asm volatile("s_waitcnt vmcnt(0) lgkmcnt(0)" ::: "memory");
        __builtin_amdgcn_s_barrier();
        asm volatile("" ::: "memory");
        if (kt + 1 < KT) G_DMA(((kt + 1) & 1) * 32768, kt + 1);
        const int so = (kt & 1) * 32768;
        const unsigned char* cur = lds + so;
#pragma unroll
        for (int kk = 0; kk < 4; ++kk) {
            bf16x8 af[2], wf[2];
#pragma unroll
            for (int i = 0; i < 2; ++i) af[i] = *(const bf16x8*)(cur + tile_off(64 * wm + 32 * i + r, 2 * kk + h));
#pragma unroll
            for (int j = 0; j < 2; ++j) {
                const v4i16_t lo = __builtin_amdgcn_ds_read_tr16_b64_v4i16((LAS v4i16_t*)(tb[j][0] + so + 4096 * kk));
                const v4i16_t hi = __builtin_amdgcn_ds_read_tr16_b64_v4i16((LAS v4i16_t*)(tb[j][1] + so + 4096 * kk));
                wf[j] = (bf16x8){lo[0], lo[1], lo[2], lo[3], hi[0], hi[1], hi[2], hi[3]};
            }
#pragma unroll
            for (int j = 0; j < 2; ++j)
#pragma unroll
                for (int i = 0; i < 2; ++i) acc[j][i] = SWAP ? __builtin_amdgcn_mfma_f32_32x32x16_bf16(af[i], wf[j], acc[j][i], 0, 0, 0)
                                                             : __builtin_amdgcn_mfma_f32_32x32x16_bf16(wf[j], af[i], acc[j][i], 0, 0, 0);
        }
    }
    __syncthreads();
#undef G_DMA
}

constexpr int CST = 272;
DEV void ctile_put(unsigned char* lds, int row, int col, float a, float b, float c, float d) {
    uint2 u; u.x = cvtpk(a, b); u.y = cvtpk(c, d);
    *(uint2*)(lds + row * CST + col * 2) = u;
}
template <int COLS, class RP>
DEV void ctile_flush(unsigned char* lds, const int TIDX, RP rowptr) {
    asm volatile("s_waitcnt lgkmcnt(0)" ::: "memory");
    __builtin_amdgcn_s_barrier();
    asm volatile("" ::: "memory");
    constexpr int CPR = COLS / 8, RPI = 256 / CPR;
#pragma unroll
    for (int it = 0; it < 128 / RPI; ++it) {
        const int row = it * RPI + TIDX / CPR, c16 = TIDX % CPR;
        bf16_t* dst = rowptr(row, it);
        const u32x4 val = *(const u32x4*)(lds + row * CST + c16 * 16);
        if (dst) *(u32x4*)(dst + c16 * 8) = val;
    }
}

DEV void ph_inproj_fast(const P& p, int l, unsigned char* lds) {
    const V v = make_views(p); const int TIDX = otid(), BIDX = obid();
    const bf16_t* W = (const bf16_t*)(p.ws + WS_WIN) + (size_t)l * D * NPW;
    const int lane = TIDX & 63, wave = TIDX >> 6, wm = wave >> 1, wn = wave & 1, r = lane & 31, h = lane >> 5;
    const bool xo = gridDim.x == 512;
    unsigned char* ct = lds + 32768;
    auto decode = [&](int it, int& mt, int& nt) -> int {
        if (xo) { if (it >= 6) return -1; const int lb = BIDX >> 3; nt = 8 * (it % 3) + (lb >> 3); mt = 16 * (BIDX & 7) + 8 * (it / 3) + (lb & 7); return nt < 23 ? 1 : 0; }
        const int unit = BIDX + it * (int)gridDim.x; if (unit >= 128 * 23) return -1; nt = unit / 128; mt = unit % 128; return 1;
    };
    auto issue = [&](int mt, int nt) {
        const bf16_t* ar[4];
#pragma unroll
        for (int i = 0; i < 4; ++i) ar[i] = v.H + (size_t)(mt * 128 + (TIDX >> 3) + 32 * i) * D;
        gemm_issue0(lds, ar, W + nt * 128, NPW, TIDX);
    };
    bool pre = false;
    for (int it = 0;; ++it) {
        int nt, mt;
        const int dv = decode(it, mt, nt);
        if (dv < 0) break;
        if (dv == 0) continue;
        const int m0 = mt * 128, n0 = nt * 128;
        const bf16_t* arow[4];
#pragma unroll
        for (int i = 0; i < 4; ++i) arow[i] = v.H + (size_t)(m0 + (TIDX >> 3) + 32 * i) * D;
        if (!pre) { __syncthreads(); issue(mt, nt); pre = true; }
        int itn = it + 1, mtn = 0, ntn = 0, dn;
        while ((dn = decode(itn, mtn, ntn)) == 0) ++itn;
        f32x16 acc[2][2];
        if (is_vcol(n0)) {
            gemm128<true, true>(lds, arow, W + n0, NPW, D, acc, TIDX);
            if (dn > 0) issue(mtn, ntn); else pre = false;
#pragma unroll
            for (int j = 0; j < 2; ++j)
#pragma unroll
                for (int i = 0; i < 2; ++i)
#pragma unroll
                    for (int g = 0; g < 4; ++g)
                        ctile_put(ct, 64 * wn + 32 * j + r, 64 * wm + 32 * i + 8 * g + 4 * h, acc[j][i][4 * g], acc[j][i][4 * g + 1], acc[j][i][4 * g + 2], acc[j][i][4 * g + 3]);
            bf16_t* vt = (bf16_t*)(p.ws + WS_VT) + ((size_t)(m0 >> 11) * 768 + vt_row(n0)) * S + (m0 & (S - 1));
            ctile_flush<128>(ct, TIDX, [&](int row, int) { return vt + (size_t)row * S; });
            continue;
        }
        const bool rope_tile = n0 < 512 || n0 == C_KS || n0 == C_KW;
        f32x4v rcs[2], rsn[2];
        if (rope_tile) {
#pragma unroll
            for (int i = 0; i < 2; ++i) {
                const int sp = (m0 + 64 * wm + 32 * i + r) & (S - 1);
                rcs[i] = *(const f32x4v*)(v.rcos + sp * 8 + 4 * h); rsn[i] = *(const f32x4v*)(v.rsin + sp * 8 + 4 * h);
            }
        }
        gemm128<false, true>(lds, arow, W + n0, NPW, D, acc, TIDX);
        if (dn > 0) issue(mtn, ntn); else pre = false;
        if (n0 == 2816) {
            if (wn == 0) {
#pragma unroll
                for (int i = 0; i < 2; ++i) {
                    const int m = m0 + 64 * wm + 32 * i + r;
#pragma unroll
                    for (int q = 0; q < 16; ++q) {
                        const int cc = (q & 3) + 8 * (q >> 2) + 4 * h;
                        if (cc < 24) v.gf[(size_t)m * 32 + cc] = acc[0][i][q];
                        else if (cc < 28) ((float*)(p.ws + WS_LSF))[(size_t)((m >> 11) * 4 + cc - 24) * S + (m & (S - 1))] = logsigmoidf_(acc[0][i][q] + p.b_forget[l * 4 + cc - 24]);
                    }
                }
            }
            continue;
        }
#pragma unroll
        for (int j = 0; j < 2; ++j) {
            const int nb = n0 + 64 * wn + 32 * j;
            const bool rope = ((nb & 63) == 0) && (nb < 512 || (nb >= C_KS && nb < C_VS) || (nb >= C_KW && nb < C_VW));
#pragma unroll
            for (int i = 0; i < 2; ++i) {
                f32x16 a = acc[j][i];
                if (rope) {
#pragma unroll
                    for (int q = 0; q < 4; ++q) { const float x1 = a[q], x2 = a[q + 4]; a[q] = x1 * rcs[i][q] - x2 * rsn[i][q]; a[q + 4] = x2 * rcs[i][q] + x1 * rsn[i][q]; }
                }
#pragma unroll
                for (int g = 0; g < 4; ++g) ctile_put(ct, 64 * wm + 32 * i + r, 64 * wn + 32 * j + 8 * g + 4 * h, a[4 * g], a[4 * g + 1], a[4 * g + 2], a[4 * g + 3]);
            }
        }
        bf16_t* ub = v.U + (size_t)m0 * NP + n0;
        ctile_flush<128>(ct, TIDX, [&](int row, int) { return ub + (size_t)row * NP; });
    }
}

DEV void ph_outproj_fast(const P& p, int l, unsigned char* lds) {
    const V v = make_views(p); const int TIDX = otid(), BIDX = obid();
    const bf16_t* W = (const bf16_t*)(p.ws + WS_WOT) + (size_t)l * D * D;
    const int lane = TIDX & 63, wave = TIDX >> 6, wm = wave >> 1, wn = wave & 1, r = lane & 31, h = lane >> 5;
    const bool xo = gridDim.x == 512;
    auto decode = [&](int it, int& mt, int& nt) -> bool {
        if (xo) { if (it >= 2) return false; const int lb = BIDX >> 3; nt = lb >> 3; mt = 16 * (BIDX & 7) + 8 * it + (lb & 7); return true; }
        const int unit = BIDX + it * (int)gridDim.x; if (unit >= 128 * 8) return false; nt = unit / 128; mt = unit % 128; return true;
    };
    auto issue = [&](int mt, int nt) {
        const bf16_t* ar[4];
#pragma unroll
        for (int i = 0; i < 4; ++i) ar[i] = v.O + (size_t)(mt * 128 + (TIDX >> 3) + 32 * i) * D;
        gemm_issue0(lds, ar, W + nt * 128, D, TIDX);
    };
    for (int it = 0;; ++it) {
        int nt, mt, ntn = 0, mtn = 0;
        if (!decode(it, mt, nt)) break;
        const bool hasn = decode(it + 1, mtn, ntn);
        const int m0 = mt * 128, n0 = nt * 128;
        const bf16_t* arow[4];
#pragma unroll
        for (int i = 0; i < 4; ++i) arow[i] = v.O + (size_t)(m0 + (TIDX >> 3) + 32 * i) * D;
        if (it == 0) { __syncthreads(); issue(mt, nt); }
        f32x4v xin[2][2][4];
#pragma unroll
        for (int j = 0; j < 2; ++j)
#pragma unroll
            for (int i = 0; i < 2; ++i)
#pragma unroll
                for (int g = 0; g < 4; ++g) xin[j][i][g] = *(const f32x4v*)(v.X + (size_t)(m0 + 64 * wm + 32 * i + r) * D + n0 + 64 * wn + 32 * j + 4 * h + 8 * g);
        f32x16 acc[2][2];
        gemm128<false, true>(lds, arow, W + n0, D, D, acc, TIDX);
        if (hasn) issue(mtn, ntn);
        const float* g1 = v.mod + (size_t)(l * 8 + (m0 >> 11)) * 6144 + 2 * D;
#pragma unroll
        for (int j = 0; j < 2; ++j)
#pragma unroll
            for (int i = 0; i < 2; ++i) {
                const int m = m0 + 64 * wm + 32 * i + r, nb = n0 + 64 * wn + 32 * j + 4 * h;
#pragma unroll
                for (int g = 0; g < 4; ++g) {
                    const float4 gg = *(const float4*)(g1 + nb + 8 * g);
                    f32x4v xo = xin[j][i][g];
                    xo[0] += gg.x * acc[j][i][4 * g]; xo[1] += gg.y * acc[j][i][4 * g + 1]; xo[2] += gg.z * acc[j][i][4 * g + 2]; xo[3] += gg.w * acc[j][i][4 * g + 3];
                    *(f32x4v*)(v.X + (size_t)m * D + nb + 8 * g) = xo;
                }
            }
    }
}

DEV void ph_moe_up_fast(const P& p, int l, unsigned char* lds) {
    const V v = make_views(p); const int TIDX = otid(), BIDX = obid();
    const int lane = TIDX & 63, wave = TIDX >> 6, wm = wave >> 1, wn = wave & 1, r = lane & 31, h = lane >> 5;
    const unsigned* cnt = v.ctl + CW_CNT + l * 32;
    int* tp = (int*)(lds + 67584); int* rb = tp + 40;
    __syncthreads();
    if (TIDX < 64) {
        const int c = TIDX < 32 ? (int)cnt[TIDX] : 0;
        int nu = ((c + 127) >> 7) * 8, cc = c;
#pragma unroll
        for (int o = 1; o < 32; o <<= 1) { const int a = __shfl_up(nu, o), b2 = __shfl_up(cc, o); if ((TIDX & 31) >= o) { nu += a; cc += b2; } }
        if (TIDX < 32) { tp[TIDX + 1] = nu; rb[TIDX + 1] = cc; if (TIDX == 0) { tp[0] = 0; rb[0] = 0; } }
    }
    __syncthreads();
    const int total = tp[32];
    unsigned char* ct = lds + 32768;
    struct UU { int e, base, nt, mt, nrow; const int* lst; const bf16_t* B; const bf16_t* ar[4]; };
    auto setup = [&](int unit, UU& u) {
        int e = 0;
#pragma unroll
        for (int st = 16; st > 0; st >>= 1) if (tp[e + st] <= unit) e += st;
        const int rem = unit - tp[e];
        u.e = e; u.base = rb[e]; u.nt = rem & 7; u.mt = rem >> 3;
        const int ce = rb[e + 1] - u.base;
        u.lst = v.list + (size_t)e * T + u.mt * 128;
        u.nrow = ce - u.mt * 128 < 128 ? ce - u.mt * 128 : 128;
        u.B = (const bf16_t*)(p.ws + WS_W13) + ((size_t)l * 32 + e) * 1024 * D + u.nt * 128;
#pragma unroll
        for (int i = 0; i < 4; ++i) { const int rr = (TIDX >> 3) + 32 * i; u.ar[i] = v.H + (size_t)(u.lst[rr < u.nrow ? rr : 0] >> 1) * D; }
    };
    int unit = BIDX;
    if (unit >= total) return;
    UU cu, nu;
    setup(unit, cu);
    __syncthreads();
    gemm_issue0(lds, cu.ar, cu.B, 1024, TIDX);
    for (;;) {
        const int un = unit + (int)gridDim.x;
        f32x16 acc[2][2];
        gemm128<false, true>(lds, cu.ar, cu.B, 1024, D, acc, TIDX);
        if (un < total) { setup(un, nu); gemm_issue0(lds, nu.ar, nu.B, 1024, TIDX); }
#pragma unroll
        for (int i = 0; i < 2; ++i)
#pragma unroll
            for (int g = 0; g < 4; ++g) {
                float o[4];
#pragma unroll
                for (int q = 0; q < 4; ++q) { const float a1 = acc[0][i][4 * g + q], a3 = acc[1][i][4 * g + q]; o[q] = a1 / (1.f + __expf(-a1)) * a3; }
                ctile_put(ct, 64 * wm + 32 * i + r, 32 * wn + 8 * g + 4 * h, o[0], o[1], o[2], o[3]);
            }
        bf16_t* hb = v.HID + (size_t)(cu.base + cu.mt * 128) * 512 + 64 * cu.nt;
        const int nrow = cu.nrow;
        ctile_flush<64>(ct, TIDX, [&](int row, int) { return row < nrow ? hb + (size_t)row * 512 : (bf16_t*)nullptr; });
        if (un >= total) break;
        unit = un; cu = nu;
    }
}
DEV void ph_moe_down_fast(const P& p, int l, unsigned char* lds) {
    const V v = make_views(p); const int TIDX = otid(), BIDX = obid();
    const int lane = TIDX & 63, wave = TIDX >> 6, wm = wave >> 1, wn = wave & 1, r = lane & 31, h = lane >> 5;
    const unsigned* cnt = v.ctl + CW_CNT + l * 32;
    int* tp = (int*)(lds + 67584); int* rb = tp + 40;
    __syncthreads();
    if (TIDX < 64) {
        const int c = TIDX < 32 ? (int)cnt[TIDX] : 0;
        int nu = ((c + 127) >> 7) * 8, cc = c;
#pragma unroll
        for (int o = 1; o < 32; o <<= 1) { const int a = __shfl_up(nu, o), b2 = __shfl_up(cc, o); if ((TIDX & 31) >= o) { nu += a; cc += b2; } }
        if (TIDX < 32) { tp[TIDX + 1] = nu; rb[TIDX + 1] = cc; if (TIDX == 0) { tp[0] = 0; rb[0] = 0; } }
    }
    __syncthreads();
    const int total = tp[32];
    unsigned char* ct = lds + 32768;
    struct UD { int n0, nrow; const bf16_t* B; const bf16_t* ar[4]; float wrow[2]; int fslot[8]; };
    auto setup = [&](int unit, UD& u) {
        int e = 0;
#pragma unroll
        for (int st = 16; st > 0; st >>= 1) if (tp[e + st] <= unit) e += st;
        const int rem = unit - tp[e], base = rb[e];
        const int ce = rb[e + 1] - base, nt = rem & 7, mt = rem >> 3;
        const int* lst = v.list + (size_t)e * T + mt * 128;
        u.n0 = nt * 128;
        u.nrow = ce - mt * 128 < 128 ? ce - mt * 128 : 128;
        u.B = (const bf16_t*)(p.ws + WS_W2) + ((size_t)l * 32 + e) * 512 * D + u.n0;
#pragma unroll
        for (int i = 0; i < 4; ++i) { const int rr = (TIDX >> 3) + 32 * i; u.ar[i] = v.HID + (size_t)(base + mt * 128 + (rr < u.nrow ? rr : 0)) * 512; }
#pragma unroll
        for (int i = 0; i < 2; ++i) { const int mr = 64 * wm + 32 * i + r; u.wrow[i] = mr < u.nrow ? v.wts[lst[mr]] : 0.f; }
#pragma unroll
        for (int it = 0; it < 8; ++it) { const int row = it * 16 + (TIDX >> 4); u.fslot[it] = row < u.nrow ? lst[row] : -1; }
    };
    int unit = BIDX;
    if (unit >= total) return;
    UD cu, nu;
    setup(unit, cu);
    __syncthreads();
    gemm_issue0(lds, cu.ar, cu.B, D, TIDX);
    for (;;) {
        const int un = unit + (int)gridDim.x;
        f32x16 acc[2][2];
        gemm128<false, true>(lds, cu.ar, cu.B, D, 512, acc, TIDX);
        if (un < total) { setup(un, nu); gemm_issue0(lds, nu.ar, nu.B, D, TIDX); }
#pragma unroll
        for (int i = 0; i < 2; ++i) {
            const int mr = 64 * wm + 32 * i + r;
            const float w = cu.wrow[i];
#pragma unroll
            for (int j = 0; j < 2; ++j)
#pragma unroll
                for (int g = 0; g < 4; ++g)
                    ctile_put(ct, mr, 64 * wn + 32 * j + 8 * g + 4 * h, w * acc[j][i][4 * g], w * acc[j][i][4 * g + 1], w * acc[j][i][4 * g + 2], w * acc[j][i][4 * g + 3]);
        }
        const int n0 = cu.n0;
        ctile_flush<128>(ct, TIDX, [&](int, int it) { const int sl = cu.fslot[it]; return sl >= 0 ? v.Y + (size_t)sl * D + n0 : (bf16_t*)nullptr; });
        if (un >= total) break;
        unit = un; cu = nu;
    }
}

constexpr float SB_EPS = 1e-12f;
constexpr float LOG2E = 1.4426950408889634f, C2 = 0.125f * 1.4426950408889634f, LN2 = 0.6931471805599453f;
DEV float fexp2(float x) { return __builtin_amdgcn_exp2f(x); }
DEV float flog2(float x) { return __builtin_amdgcn_logf(x); }
DEV int swap23(int r) { return (r & ~12) | ((r & 4) << 1) | ((r & 8) >> 1); }

struct KVT { const bf16_t* k; int ks; const bf16_t* v; int vs; };
DEV void kv_load(const KVT& s, int kv0, const int TIDX, u32x4 (&rg)[4]) {
    const int c = TIDX & 7, r0 = TIDX >> 3;
    rg[0] = *(const u32x4*)(s.k + (size_t)(kv0 + r0) * s.ks + c * 8);
    rg[1] = *(const u32x4*)(s.k + (size_t)(kv0 + r0 + 32) * s.ks + c * 8);
    rg[2] = *(const u32x4*)(s.v + (size_t)r0 * s.vs + kv0 + c * 8);
    rg[3] = *(const u32x4*)(s.v + (size_t)(r0 + 32) * s.vs + kv0 + c * 8);
}
DEV void kv_store(unsigned char* st, const int TIDX, const u32x4 (&rg)[4]) {
    const int c = TIDX & 7, r0 = TIDX >> 3;
    *(u32x4*)(st + tile_off(r0, c)) = rg[0]; *(u32x4*)(st + tile_off(r0 + 32, c)) = rg[1];
    *(u32x4*)(st + 8192 + tile_off(r0, c)) = rg[2]; *(u32x4*)(st + 8192 + tile_off(r0 + 32, c)) = rg[3];
}
DEV bf16x8 scale_frag(bf16x8 v, float sc) {
    u32x4 u = __builtin_bit_cast(u32x4, v);
#pragma unroll
    for (int i = 0; i < 4; ++i) u[i] = cvtpk(__uint_as_float(u[i] << 16) * sc, __uint_as_float(u[i] & 0xffff0000u) * sc);
    return __builtin_bit_cast(bf16x8, u);
}
DEV float xhalf(float x) {
    const auto s = __builtin_amdgcn_permlane32_swap(__float_as_uint(x), __float_as_uint(x), false, false);
    return __uint_as_float((threadIdx.x & 32) ? s[0] : s[1]);
}
DEV float xhalf_max(float x) {
    const auto s = __builtin_amdgcn_permlane32_swap(__float_as_uint(x), __float_as_uint(x), false, false);
    return fmaxf(__uint_as_float(s[0]), __uint_as_float(s[1]));
}
DEV float xhalf_sum(float x) {
    const auto s = __builtin_amdgcn_permlane32_swap(__float_as_uint(x), __float_as_uint(x), false, false);
    return __uint_as_float(s[0]) + __uint_as_float(s[1]);
}
#define SB0() __builtin_amdgcn_sched_barrier(0)
DEV void score_tile(const unsigned char* Kt, const bf16x8 (&qf)[4], int r, int h, f32x16 (&p)[2]) {
    const int kr = swap23(r);
    const unsigned char* kb = Kt + tile_off(kr, h);
    auto ld = [&](int i) { const int blk = i & 1, s = i >> 1; return *(const bf16x8*)(Kt + tile_off(32 * blk + kr, 2 * s + h)); };
    (void)kb;
    f32x16 z;
#pragma unroll
    for (int q = 0; q < 16; ++q) z[q] = 0.f;
    bf16x8 f0 = ld(0), f1 = ld(1), f2 = ld(2), f3 = ld(3);
    SB0();
    p[0] = __builtin_amdgcn_mfma_f32_32x32x16_bf16(f0, qf[0], z, 0, 0, 0); f0 = ld(4); SB0();
    p[1] = __builtin_amdgcn_mfma_f32_32x32x16_bf16(f1, qf[0], z, 0, 0, 0); f1 = ld(5); SB0();
    p[0] = __builtin_amdgcn_mfma_f32_32x32x16_bf16(f2, qf[1], p[0], 0, 0, 0); f2 = ld(6); SB0();
    p[1] = __builtin_amdgcn_mfma_f32_32x32x16_bf16(f3, qf[1], p[1], 0, 0, 0); f3 = ld(7); SB0();
    p[0] = __builtin_amdgcn_mfma_f32_32x32x16_bf16(f0, qf[2], p[0], 0, 0, 0); SB0();
    p[1] = __builtin_amdgcn_mfma_f32_32x32x16_bf16(f1, qf[2], p[1], 0, 0, 0); SB0();
    p[0] = __builtin_amdgcn_mfma_f32_32x32x16_bf16(f2, qf[3], p[0], 0, 0, 0); SB0();
    p[1] = __builtin_amdgcn_mfma_f32_32x32x16_bf16(f3, qf[3], p[1], 0, 0, 0); SB0();
}
DEV void pv_tile(const unsigned char* Vt, const f32x16 (&p)[2], int r, int h, f32x16 (&o)[2]) {
    auto ld = [&](int i) { const int db = i & 1, pr = i >> 1; return *(const bf16x8*)(Vt + tile_off(32 * db + r, 2 * pr + h)); };
    auto pk = [&](int pr) {
        const int blk = pr >> 1, s = pr & 1;
        u32x4 w;
        w.x = cvtpk(p[blk][8 * s], p[blk][8 * s + 1]); w.y = cvtpk(p[blk][8 * s + 2], p[blk][8 * s + 3]);
        w.z = cvtpk(p[blk][8 * s + 4], p[blk][8 * s + 5]); w.w = cvtpk(p[blk][8 * s + 6], p[blk][8 * s + 7]);
        return __builtin_bit_cast(bf16x8, w);
    };
    bf16x8 f0 = ld(0), f1 = ld(1), f2 = ld(2), f3 = ld(3);
    SB0();
    bf16x8 pb = pk(0);
    SB0();
    o[0] = __builtin_amdgcn_mfma_f32_32x32x16_bf16(f0, pb, o[0], 0, 0, 0); f0 = ld(4); SB0();
    o[1] = __builtin_amdgcn_mfma_f32_32x32x16_bf16(f1, pb, o[1], 0, 0, 0); f1 = ld(5); pb = pk(1); SB0();
    o[0] = __builtin_amdgcn_mfma_f32_32x32x16_bf16(f2, pb, o[0], 0, 0, 0); f2 = ld(6); SB0();
    o[1] = __builtin_amdgcn_mfma_f32_32x32x16_bf16(f3, pb, o[1], 0, 0, 0); f3 = ld(7); pb = pk(2); SB0();
    o[0] = __builtin_amdgcn_mfma_f32_32x32x16_bf16(f0, pb, o[0], 0, 0, 0); SB0();
    o[1] = __builtin_amdgcn_mfma_f32_32x32x16_bf16(f1, pb, o[1], 0, 0, 0); pb = pk(3); SB0();
    o[0] = __builtin_amdgcn_mfma_f32_32x32x16_bf16(f2, pb, o[0], 0, 0, 0); SB0();
    o[1] = __builtin_amdgcn_mfma_f32_32x32x16_bf16(f3, pb, o[1], 0, 0, 0); SB0();
}

template <int VAR>
DEV void attn_branch(unsigned char* lds, const KVT& src, const bf16x8 (&qf)[4], unsigned tmask, int wave_last, int t, int t_first,
                     unsigned selbits, const float* bias2, f32x16 (&o)[2], const int TIDX) {
    const int lane = TIDX & 63, r = lane & 31, h = lane >> 5;
    const float NEG_INF = -__builtin_inff();
    float mrun = -1e30f, lrun = 0.f, rest = VAR == 3 ? 1.f : 0.f;
#pragma unroll
    for (int db = 0; db < 2; ++db)
#pragma unroll
        for (int q = 0; q < 16; ++q) o[db][q] = 0.f;
    u32x4 rg[4];
    unsigned rem = tmask;
    unsigned wdone = 0u; int step = 0;
    volatile unsigned* sbf = (volatile unsigned*)(lds + 65536);
    int j = VAR == 3 ? 31 - __builtin_clz(rem) : __builtin_ctz(rem);
    rem &= ~(1u << j);
    kv_load(src, 64 * j, TIDX, rg);
    __syncthreads();
    kv_store(lds, TIDX, rg);
    __syncthreads();
    int stage = 0;
    for (;;) {
        int jn = -1;
        if (rem) { jn = VAR == 3 ? 31 - __builtin_clz(rem) : __builtin_ctz(rem); rem &= ~(1u << jn); kv_load(src, 64 * jn, TIDX, rg); }
        asm volatile("" ::: "memory"); __builtin_amdgcn_sched_barrier(0);
        if (j <= wave_last) {
            const unsigned char* Kt = lds + stage * 16384;
            f32x16 p[2];
            score_tile(Kt, qf, r, h, p);
            const int kvb = 64 * j + 8 * h;
            if (VAR == 3) {
                const bool diag = 64 * j + 63 >= t_first;
                float gt[2][2];
                if (diag) {
#pragma unroll
                    for (int blk = 0; blk < 2; ++blk)
#pragma unroll
                        for (int s = 0; s < 2; ++s) {
                            float run = 1.f;
#pragma unroll
                            for (int q = 7; q >= 0; --q) {
                                const float ez = fexp2(p[blk][8 * s + q]);
                                float w = __builtin_amdgcn_rcpf(1.f + ez);
                                float beta = 1.f - w;
                                const bool valid = kvb + 32 * blk + 16 * s + q < t;
                                w = valid ? w : 1.f; beta = valid ? beta : 0.f;
                                p[blk][8 * s + q] = beta * run;
                                run *= w;
                            }
                            gt[blk][s] = run;
                        }
                } else {
#pragma unroll
                    for (int blk = 0; blk < 2; ++blk)
#pragma unroll
                        for (int s = 0; s < 2; ++s) {
                            float run = 1.f;
#pragma unroll
                            for (int q = 7; q >= 0; --q) {
                                const float rn = run * __builtin_amdgcn_rcpf(1.f + fexp2(p[blk][8 * s + q]));
                                p[blk][8 * s + q] = run - rn;
                                run = rn;
                            }
                            gt[blk][s] = run;
                        }
                }
                float og[2][2], pt[2][2];
#pragma unroll
                for (int blk = 0; blk < 2; ++blk)
#pragma unroll
                    for (int s = 0; s < 2; ++s) { og[blk][s] = xhalf(gt[blk][s]); pt[blk][s] = gt[blk][s] * og[blk][s]; }
                float above = rest;
#pragma unroll
                for (int pi = 3; pi >= 0; --pi) {
                    const int blk = pi >> 1, s = pi & 1;
                    const float carry = above * (h == 0 ? og[blk][s] : 1.f);
#pragma unroll
                    for (int q = 0; q < 8; ++q) p[blk][8 * s + q] *= carry;
                    above *= pt[blk][s];
                }
                rest = above;
                wdone = __all(rest < SB_EPS) ? 1u : 0u;
            } else {
                const bool need_causal = 64 * j + 63 > t_first;
                const bool need_win = VAR == 1 && (64 * j + 512 <= t_first + 31);
                const bool lane_on = VAR != 0 || ((selbits >> j) & 1u);
                if (VAR == 2) {
#pragma unroll
                    for (int blk = 0; blk < 2; ++blk)
#pragma unroll
                        for (int s = 0; s < 2; ++s) {
                            const float4 b0 = *(const float4*)(bias2 + kvb + 32 * blk + 16 * s), b1 = *(const float4*)(bias2 + kvb + 32 * blk + 16 * s + 4);
                            p[blk][8 * s] += b0.x; p[blk][8 * s + 1] += b0.y; p[blk][8 * s + 2] += b0.z; p[blk][8 * s + 3] += b0.w;
                            p[blk][8 * s + 4] += b1.x; p[blk][8 * s + 5] += b1.y; p[blk][8 * s + 6] += b1.z; p[blk][8 * s + 7] += b1.w;
                        }
                }
                if (need_causal) {
#pragma unroll
                    for (int blk = 0; blk < 2; ++blk)
#pragma unroll
                        for (int q = 0; q < 16; ++q) { const int kv = kvb + 32 * blk + 16 * (q >> 3) + (q & 7); p[blk][q] = kv <= t ? p[blk][q] : NEG_INF; }
                }
                if (need_win) {
#pragma unroll
                    for (int blk = 0; blk < 2; ++blk)
#pragma unroll
                        for (int q = 0; q < 16; ++q) { const int kv = kvb + 32 * blk + 16 * (q >> 3) + (q & 7); p[blk][q] = kv + 512 > t ? p[blk][q] : NEG_INF; }
                }
                float tmax = p[0][0];
#pragma unroll
                for (int q = 1; q < 16; ++q) tmax = fmaxf(tmax, p[0][q]);
#pragma unroll
                for (int q = 0; q < 16; ++q) tmax = fmaxf(tmax, p[1][q]);
                tmax = lane_on ? tmax : NEG_INF;
                tmax = xhalf_max(tmax);
                const float mnew = fmaxf(mrun, tmax);
                const bool grew = mnew > mrun;
                const float alpha = fexp2(mrun - mnew);
                mrun = mnew;
                const float msub = lane_on ? mnew : __builtin_inff();
                const f32x2_t ms2 = {msub, msub};
                f32x2_t ls2 = {0.f, 0.f};
#pragma unroll
                for (int blk = 0; blk < 2; ++blk)
#pragma unroll
                    for (int q = 0; q < 16; q += 2) {
                        const f32x2_t d2 = (f32x2_t){p[blk][q], p[blk][q + 1]} - ms2;
                        f32x2_t e2; e2.x = fexp2(d2.x); e2.y = fexp2(d2.y);
                        p[blk][q] = e2.x; p[blk][q + 1] = e2.y; ls2 += e2;
                    }
                lrun = lrun * alpha + (ls2.x + ls2.y);
                if (__any(grew)) {
#pragma unroll
                    for (int db = 0; db < 2; ++db)
#pragma unroll
                        for (int q = 0; q < 16; ++q) o[db][q] *= alpha;
                }
            }
            pv_tile(Kt + 8192, p, r, h, o);
        }
        if (jn >= 0) kv_store(lds + (stage ^ 1) * 16384, TIDX, rg);
        if (VAR == 3 && lane == 0) sbf[(step & 1) * 4 + (TIDX >> 6)] = wdone;
        __syncthreads();
        if (jn < 0) break;
        if (VAR == 3) {
            const unsigned* f4 = (const unsigned*)sbf + (step & 1) * 4;
            if ((f4[0] & f4[1] & f4[2] & f4[3]) != 0u) break;
            ++step;
        }
        j = jn; stage ^= 1;
    }
    if (VAR != 3) {
        const float lt = xhalf_sum(lrun);
        const float inv = lt > 0.f ? 1.f / lt : 0.f;
#pragma unroll
        for (int db = 0; db < 2; ++db)
#pragma unroll
            for (int q = 0; q < 16; ++q) o[db][q] *= inv;
    }
}

DEV void head_norm_store(const f32x16 (&o)[2], const float* gam, bf16_t* dst, int h) {
    float ss = 0.f;
#pragma unroll
    for (int db = 0; db < 2; ++db)
#pragma unroll
        for (int q = 0; q < 16; ++q) ss += o[db][q] * o[db][q];
    ss += __shfl_xor(ss, 32);
    const float rinv = rsqrtf(ss * (1.f / 64.f) + EPS);
#pragma unroll
    for (int db = 0; db < 2; ++db)
#pragma unroll
        for (int g = 0; g < 4; ++g) {
            const int d = 32 * db + 8 * g + 4 * h;
            const float4 gg = *(const float4*)(gam + d);
            uint2 u;
            u.x = cvtpk(o[db][4 * g] * rinv * gg.x, o[db][4 * g + 1] * rinv * gg.y);
            u.y = cvtpk(o[db][4 * g + 2] * rinv * gg.z, o[db][4 * g + 3] * rinv * gg.w);
            *(uint2*)(dst + d) = u;
        }
}

template <int VAR>
DEV void mha_unit(const P& p, int l, int unit, unsigned char* lds) {
    const V v = make_views(p); const int TIDX = otid();
    const int lane = TIDX & 63, wave = TIDX >> 6, r = lane & 31, h = lane >> 5;
    const int qb = 15 - (unit >> 5), bh = unit & 31, b = bh >> 2, hh = bh & 3;
    const int t0 = qb * 128, tw = t0 + 32 * wave, t = tw + r, m = b * S + t;
    const int qcol = VAR == 2 ? C_QB : C_QC, kcol = VAR == 2 ? C_KB : C_KCC, vrow = VAR == 2 ? 256 : 512, ocol = VAR == 2 ? 512 : 768;
    bf16x8 qf[4];
#pragma unroll
    for (int s = 0; s < 4; ++s) qf[s] = scale_frag(*(const bf16x8*)(v.U + (size_t)m * NP + qcol + hh * 64 + 16 * s + 8 * h), C2);
    KVT src;
    src.k = v.U + (size_t)b * S * NP + kcol + hh * 64; src.ks = NP;
    src.v = (const bf16_t*)(p.ws + WS_VT) + (size_t)(b * 768 + vrow + hh * 64) * S; src.vs = S;
    const int last = (t0 + 127) >> 6;
    const unsigned tmask = last == 31 ? 0xffffffffu : ((1u << (last + 1)) - 1u);
    const float* bias2 = (const float*)(lds + 32768);
    if (VAR == 2) {
        float* cf = (float*)(lds + 32768);
        float* wt = (float*)(lds + 32768 + 8192);
        const float* lsf = (const float*)(p.ws + WS_LSF) + (size_t)(b * 4 + hh) * S;
        const int nel = t0 + 128;
        float x[8];
        if (8 * TIDX < nel) {
            const float4 a0 = *(const float4*)(lsf + 8 * TIDX), a1 = *(const float4*)(lsf + 8 * TIDX + 4);
            x[0] = a0.x; x[1] = x[0] + a0.y; x[2] = x[1] + a0.z; x[3] = x[2] + a0.w; x[4] = x[3] + a1.x; x[5] = x[4] + a1.y; x[6] = x[5] + a1.z; x[7] = x[6] + a1.w;
        } else {
#pragma unroll
            for (int q = 0; q < 8; ++q) x[q] = 0.f;
        }
        float inc = x[7];
#pragma unroll
        for (int o = 1; o < 64; o <<= 1) { const float tt = __shfl_up(inc, o); if (lane >= o) inc += tt; }
        __syncthreads();
        if (lane == 63) wt[wave] = inc;
        __syncthreads();
        float off = inc - x[7];
#pragma unroll
        for (int w = 0; w < 3; ++w) off += (w < wave) ? wt[w] : 0.f;
        if (8 * TIDX < nel) {
#pragma unroll
            for (int q = 0; q < 8; ++q) cf[8 * TIDX + q] = -(x[q] + off) * LOG2E;
        }
        __syncthreads();
    }
    f32x16 o[2];
    attn_branch<VAR>(lds, src, qf, tmask, (tw + 31) >> 6, t, tw, 0u, bias2, o, TIDX);
    head_norm_store(o, p.out_norm_g + (size_t)l * D + ocol + hh * 64, v.O + (size_t)m * D + ocol + hh * 64, h);
}

DEV void nsa_unit(const P& p, int l, int unit, unsigned char* lds) {
    const V v = make_views(p); const int TIDX = otid();
    const int lane = TIDX & 63, wave = TIDX >> 6, r = lane & 31, h = lane >> 5;
    const int qblk = 63 - (unit >> 4), bg = unit & 15, b = bg >> 1, g = bg & 1;
    const int t0 = qblk * 32, t = t0 + r, m = b * S + t, head = g * 4 + wave, cur = t0 >> 6;
    const float NEG_INF = -__builtin_inff();
    bf16x8 qf[4];
#pragma unroll
    for (int s = 0; s < 4; ++s) qf[s] = scale_frag(*(const bf16x8*)(v.U + (size_t)m * NP + C_QA + head * 64 + 16 * s + 8 * h), C2);
    const float g0 = sigmoidf_(v.gf[(size_t)m * 32 + head * 3]), g1 = sigmoidf_(v.gf[(size_t)m * 32 + head * 3 + 1]), g2 = sigmoidf_(v.gf[(size_t)m * 32 + head * 3 + 2]);
    f32x16 otot[2];
    float* PA = (float*)(lds + 32768);
    float* PB = (float*)(lds + 49152);
    float* SC = (float*)lds;
    unsigned* MASK = (unsigned*)(lds + 8192);
    {
        const bf16_t* ck = v.ck + (size_t)(b * 2 + g) * 128 * 64;
        const bf16_t* cvt = (const bf16_t*)(p.ws + WS_CVT) + (size_t)(b * 2 + g) * 64 * 128;
        const int c = TIDX & 7, r0 = TIDX >> 3;
        u32x4 rk[4], rv[4];
#pragma unroll
        for (int i = 0; i < 4; ++i) rk[i] = *(const u32x4*)(ck + (size_t)(r0 + 32 * i) * 64 + c * 8);
#pragma unroll
        for (int i = 0; i < 4; ++i) rv[i] = *(const u32x4*)(cvt + (size_t)(r0 + 32 * (i & 1)) * 128 + 64 * (i >> 1) + c * 8);
        __syncthreads();
#pragma unroll
        for (int i = 0; i < 4; ++i) *(u32x4*)(lds + tile_off(r0 + 32 * i, c)) = rk[i];
#pragma unroll
        for (int i = 0; i < 4; ++i) *(u32x4*)(lds + 16384 + 8192 * (i >> 1) + tile_off(r0 + 32 * (i & 1), c)) = rv[i];
        __syncthreads();
        f32x16 ps[2][2];
        score_tile(lds, qf, r, h, ps[0]);
        score_tile(lds + 8192, qf, r, h, ps[1]);
        const int nvalid = t >= 31 ? (t - 31) / 16 + 1 : 0;
        float mx = NEG_INF;
#pragma unroll
        for (int tt = 0; tt < 2; ++tt)
#pragma unroll
            for (int blk = 0; blk < 2; ++blk)
#pragma unroll
                for (int q = 0; q < 16; ++q) {
                    const int n = 64 * tt + 32 * blk + 16 * (q >> 3) + 8 * h + (q & 7);
                    const float x = n < nvalid ? ps[tt][blk][q] : NEG_INF;
                    ps[tt][blk][q] = x; mx = fmaxf(mx, x);
                }
        mx = fmaxf(mx, __shfl_xor(mx, 32));
        const float mxs = nvalid > 0 ? mx : 0.f;
        float ls = 0.f;
#pragma unroll
        for (int tt = 0; tt < 2; ++tt)
#pragma unroll
            for (int blk = 0; blk < 2; ++blk)
#pragma unroll
                for (int q = 0; q < 16; ++q) { const float e = fexp2(ps[tt][blk][q] - mxs); ps[tt][blk][q] = e; ls += e; }
        const float lt = ls + __shfl_xor(ls, 32);
        const float inv = lt > 0.f ? 1.f / lt : 0.f;
#pragma unroll
        for (int tt = 0; tt < 2; ++tt)
#pragma unroll
            for (int blk = 0; blk < 2; ++blk) {
#pragma unroll
                for (int q = 0; q < 16; ++q) ps[tt][blk][q] *= inv;
#pragma unroll
                for (int s = 0; s < 2; ++s) {
                    const int G0 = 16 * tt + 8 * blk + 4 * s + 2 * h;
                    const float a0 = (ps[tt][blk][8 * s] + ps[tt][blk][8 * s + 1]) + (ps[tt][blk][8 * s + 2] + ps[tt][blk][8 * s + 3]);
                    const float a1 = (ps[tt][blk][8 * s + 4] + ps[tt][blk][8 * s + 5]) + (ps[tt][blk][8 * s + 6] + ps[tt][blk][8 * s + 7]);
                    PA[(wave * 32 + G0) * 32 + r] = a0; PA[(wave * 32 + G0 + 1) * 32 + r] = a1;
                    PB[(wave * 32 + G0 + 1) * 32 + r] = ps[tt][blk][8 * s + 3];
                    if (G0 + 2 < 32) PB[(wave * 32 + G0 + 2) * 32 + r] = ps[tt][blk][8 * s + 7];
                }
            }
        f32x16 oc[2];
#pragma unroll
        for (int db = 0; db < 2; ++db)
#pragma unroll
            for (int q = 0; q < 16; ++q) oc[db][q] = 0.f;
        pv_tile(lds + 16384, ps[0], r, h, oc);
        pv_tile(lds + 24576, ps[1], r, h, oc);
#pragma unroll
        for (int db = 0; db < 2; ++db)
#pragma unroll
            for (int q = 0; q < 16; ++q) otot[db][q] = g0 * oc[db][q];
    }
    __syncthreads();
    const bool need_topk = cur > 15;
    if (need_topk) {
        const int q = TIDX & 31, j0 = (TIDX >> 5) * 4;
#pragma unroll
        for (int jj = 0; jj < 4; ++jj) {
            const int j = j0 + jj;
            float sc = 0.f;
#pragma unroll
            for (int w = 0; w < 4; ++w) sc += PA[(w * 32 + j) * 32 + q];
            if (j > 0) {
#pragma unroll
                for (int w = 0; w < 4; ++w) sc += PB[(w * 32 + j) * 32 + q];
            }
            const bool forced = (j == 0) || (j == cur) || (j == cur - 1);
            SC[q * 33 + j] = forced ? 1.0e4f : (j <= cur ? sc : -1.0f);
        }
        if (TIDX < 32) MASK[TIDX] = 0u;
        __syncthreads();
        unsigned bits = 0u;
#pragma unroll
        for (int jj = 0; jj < 4; ++jj) {
            const int j = j0 + jj;
            const float vj = SC[q * 33 + j];
            int rank = 0;
#pragma unroll
            for (int i = 0; i < 32; ++i) { const float vi = SC[q * 33 + i]; rank += (vi > vj || (vi == vj && i < j)) ? 1 : 0; }
            if (rank < 16) bits |= 1u << j;
        }
        atomicOr(&MASK[q], bits);
        __syncthreads();
    }
    const unsigned upto = (2u << cur) - 1u;
    unsigned mybits = upto, um = upto;
    if (need_topk) {
        mybits = MASK[r];
        um = 0u;
#pragma unroll
        for (int i = 0; i < 32; ++i) um |= MASK[i];
        um = (unsigned)__builtin_amdgcn_readfirstlane((int)um);
    }
    {
        KVT src; src.k = v.U + (size_t)b * S * NP + C_KS + g * 64; src.ks = NP;
        src.v = (const bf16_t*)(p.ws + WS_VT) + (size_t)(b * 768 + g * 64) * S; src.vs = S;
        f32x16 o[2];
        attn_branch<0>(lds, src, qf, um & upto, cur, t, t0, mybits, nullptr, o, TIDX);
#pragma unroll
        for (int db = 0; db < 2; ++db)
#pragma unroll
            for (int q = 0; q < 16; ++q) otot[db][q] += g1 * o[db][q];
    }
    {
        KVT src; src.k = v.U + (size_t)b * S * NP + C_KW + g * 64; src.ks = NP;
        src.v = (const bf16_t*)(p.ws + WS_VT) + (size_t)(b * 768 + 128 + g * 64) * S; src.vs = S;
        const int f = (t0 - 511 > 0 ? t0 - 511 : 0) >> 6;
        const unsigned wmask = upto & ~((1u << f) - 1u);
        f32x16 o[2];
        attn_branch<1>(lds, src, qf, wmask, cur, t, t0, 0u, nullptr, o, TIDX);
#pragma unroll
        for (int db = 0; db < 2; ++db)
#pragma unroll
            for (int q = 0; q < 16; ++q) otot[db][q] += g2 * o[db][q];
    }
    head_norm_store(otot, p.out_norm_g + (size_t)l * D + head * 64, v.O + (size_t)m * D + head * 64, h);
}

constexpr int CW_CMPK = 12288;
DEV bool cmp_unit(const P& p, int l, int unit, int kq, unsigned char* lds, volatile LAS unsigned* qslot) {
    const V v = make_views(p); const int TIDX = otid();
    const int lane = TIDX & 63, wave = TIDX >> 6, wm = wave >> 1, wn = wave & 1, r = lane & 31, h = lane >> 5;
    const int kv = unit & 1, bg = unit >> 1, b = bg >> 1, g = bg & 1, lk = l * 2 + kv;
    const int col = (kv ? C_VC : C_KC) + g * 64;
    const bf16_t* arow[4];
#pragma unroll
    for (int i = 0; i < 4; ++i) { const int n = (TIDX >> 3) + 32 * i; arow[i] = v.U + (size_t)(b * S + 16 * (n < 127 ? n : 126) + 8 * kq) * NP + col; }
    f32x16 acc[2][2];
    gemm128<false>(lds, arow, (const bf16_t*)(p.ws + WS_CW1) + (size_t)lk * 2048 * 128 + (size_t)kq * 512 * 128, 128, 512, acc, TIDX, NP);
    {
        const __amdgpu_buffer_rsrc_t prs = __builtin_amdgcn_make_buffer_rsrc((void*)v.OB, (short)0, 32 * 4 * 65536, 0x00020000);
        const unsigned pbase = (unsigned)(unit * 4 + kq) * 65536u + (unsigned)TIDX * 16u;
#pragma unroll
        for (int j = 0; j < 2; ++j)
#pragma unroll
            for (int i = 0; i < 2; ++i)
#pragma unroll
                for (int g4 = 0; g4 < 4; ++g4) {
                    const f32x4v a = {acc[j][i][4 * g4], acc[j][i][4 * g4 + 1], acc[j][i][4 * g4 + 2], acc[j][i][4 * g4 + 3]};
                    __builtin_amdgcn_raw_buffer_store_b128(__builtin_bit_cast(u32x4, a), prs, pbase + (unsigned)((j * 2 + i) * 4 + g4) * 4096u, 0,   16);
                }
        asm volatile("s_waitcnt vmcnt(0)" ::: "memory");
        __syncthreads();
        if (TIDX == 0) *qslot = __hip_atomic_fetch_add(v.ctl + CW_CMPK + l * 32 + unit, 1u, __ATOMIC_RELAXED, __HIP_MEMORY_SCOPE_AGENT);
        __syncthreads();
        if (*qslot != 3u) return false;
        if (TIDX == 0) { __builtin_amdgcn_fence(__ATOMIC_ACQUIRE, "agent"); asm volatile("s_waitcnt vmcnt(0)" ::: "memory"); }
        __syncthreads();
        const float* pp = v.OB + (size_t)unit * 4 * 16384 + TIDX * 4;
#pragma unroll
        for (int j = 0; j < 2; ++j)
#pragma unroll
            for (int i = 0; i < 2; ++i)
#pragma unroll
                for (int g4 = 0; g4 < 4; ++g4) {
                    const float* q0 = pp + ((j * 2 + i) * 4 + g4) * 1024;
                    f32x4v a = *(const f32x4v*)q0;
#pragma unroll
                    for (int k2 = 1; k2 < 4; ++k2) { const f32x4v b2 = *(const f32x4v*)(q0 + k2 * 16384); a += b2; }
                    acc[j][i][4 * g4] = a[0]; acc[j][i][4 * g4 + 1] = a[1]; acc[j][i][4 * g4 + 2] = a[2]; acc[j][i][4 * g4 + 3] = a[3];
                }
    }
    const float* pb = (const float*)(p.ws + WS_CPB) + lk * 8 * 128;
#pragma unroll
    for (int j = 0; j < 2; ++j)
#pragma unroll
        for (int i = 0; i < 2; ++i) {
            const int mrow = 64 * wm + 32 * i + r;
#pragma unroll
            for (int g4 = 0; g4 < 4; ++g4) {
                float4 bb = *(const float4*)(pb + 64 * wn + 32 * j + 8 * g4 + 4 * h);
#pragma unroll
                for (int c8 = 1; c8 < 8; ++c8) { const float4 b2 = *(const float4*)(pb + c8 * 128 + 64 * wn + 32 * j + 8 * g4 + 4 * h); bb.x += b2.x; bb.y += b2.y; bb.z += b2.z; bb.w += b2.w; }
                float x0 = acc[j][i][4 * g4] + bb.x, x1 = acc[j][i][4 * g4 + 1] + bb.y, x2 = acc[j][i][4 * g4 + 2] + bb.z, x3 = acc[j][i][4 * g4 + 3] + bb.w;
                x0 = x0 / (1.f + __expf(-x0)); x1 = x1 / (1.f + __expf(-x1)); x2 = x2 / (1.f + __expf(-x2)); x3 = x3 / (1.f + __expf(-x3));
                uint2 u; u.x = cvtpk(x0, x1); u.y = cvtpk(x2, x3);
                *(uint2*)(lds + wn * 16384 + tile_off(mrow, 4 * j + g4) + 8 * h) = u;
            }
        }
    {
        const bf16_t* w2 = (const bf16_t*)(p.ws + WS_CW2) + (size_t)lk * 64 * 128;
        const int c = TIDX & 7, r0 = TIDX >> 3;
#pragma unroll
        for (int i = 0; i < 4; ++i) {
            const int row = r0 + 32 * (i & 1), kt = i >> 1;
            *(u32x4*)(lds + 32768 + kt * 8192 + tile_off(row, c)) = *(const u32x4*)(w2 + (size_t)row * 128 + kt * 64 + c * 8);
        }
    }
    __syncthreads();
    f32x16 a2[2];
#pragma unroll
    for (int db = 0; db < 2; ++db)
#pragma unroll
        for (int q = 0; q < 16; ++q) a2[db][q] = 0.f;
#pragma unroll
    for (int kt = 0; kt < 2; ++kt)
#pragma unroll
        for (int s = 0; s < 4; ++s) {
            const bf16x8 hf = *(const bf16x8*)(lds + kt * 16384 + tile_off(32 * wave + r, 2 * s + h));
#pragma unroll
            for (int db = 0; db < 2; ++db) {
                const bf16x8 wf = *(const bf16x8*)(lds + 32768 + kt * 8192 + tile_off(32 * db + r, 2 * s + h));
                a2[db] = __builtin_amdgcn_mfma_f32_32x32x16_bf16(wf, hf, a2[db], 0, 0, 0);
            }
        }
    const int n = 32 * wave + r;
    if (kv == 0 && n < 127) {
        const int pos = 16 * n + 31;
#pragma unroll
        for (int q = 0; q < 4; ++q) {
            const float cs = v.rcos[pos * 8 + q + 4 * h], sn = v.rsin[pos * 8 + q + 4 * h];
            const float x1 = a2[0][q], x2 = a2[0][q + 4];
            a2[0][q] = x1 * cs - x2 * sn; a2[0][q + 4] = x2 * cs + x1 * sn;
        }
    }
    bf16_t* dst = (kv ? v.cv : v.ck) + ((size_t)bg * 128 + n) * 64;
    bf16_t* dt = (bf16_t*)(p.ws + WS_CVT) + (size_t)bg * 64 * 128 + n;
#pragma unroll
    for (int db = 0; db < 2; ++db)
#pragma unroll
        for (int g4 = 0; g4 < 4; ++g4) {
            const int d = 32 * db + 8 * g4 + 4 * h;
            float x0 = a2[db][4 * g4], x1 = a2[db][4 * g4 + 1], x2 = a2[db][4 * g4 + 2], x3 = a2[db][4 * g4 + 3];
            if (n >= 127) { x0 = 0.f; x1 = 0.f; x2 = 0.f; x3 = 0.f; }
            uint2 u; u.x = cvtpk(x0, x1); u.y = cvtpk(x2, x3);
            *(uint2*)(dst + d) = u;
            if (kv) { dt[(size_t)d * 128] = (bf16_t)(u.x & 0xffffu); dt[(size_t)(d + 1) * 128] = (bf16_t)(u.x >> 16); dt[(size_t)(d + 2) * 128] = (bf16_t)(u.y & 0xffffu); dt[(size_t)(d + 3) * 128] = (bf16_t)(u.y >> 16); }
        }
    __syncthreads();
    return true;
}

typedef float f32x4m __attribute__((ext_vector_type(4)));
DEV void ph_norm2_router_fast(const P& p, int l, unsigned char* lds) {
    const V v = make_views(p); const int TIDX = otid(), BIDX = obid();
    const int lane = TIDX & 63, wave = TIDX >> 6;
    const bf16_t* wr = (const bf16_t*)(p.ws + WS_WR) + (size_t)l * 2 * 64 * D;
    float* LG = (float*)(lds + 65536);
    for (int blk = BIDX; blk < T / 16; blk += gridDim.x) {
        const int m0 = blk * 16, b = m0 >> 11;
        const float* md = v.mod + (size_t)(l * 8 + b) * 6144;
        float4 xv[4][4]; float ssq[4];
#pragma unroll
        for (int rr = 0; rr < 4; ++rr)
#pragma unroll
            for (int j = 0; j < 4; ++j) xv[rr][j] = *(const float4*)(v.X + (size_t)(m0 + wave * 4 + rr) * D + 4 * lane + 256 * j);
#pragma unroll
        for (int rr = 0; rr < 4; ++rr) {
            ssq[rr] = 0.f;
#pragma unroll
            for (int j = 0; j < 4; ++j) ssq[rr] += xv[rr][j].x * xv[rr][j].x + xv[rr][j].y * xv[rr][j].y + xv[rr][j].z * xv[rr][j].z + xv[rr][j].w * xv[rr][j].w;
        }
#pragma unroll
        for (int o = 1; o < 64; o <<= 1) {
#pragma unroll
            for (int rr = 0; rr < 4; ++rr) ssq[rr] += __shfl_xor(ssq[rr], o);
        }
#pragma unroll
        for (int rr = 0; rr < 4; ++rr) {
            const int row = wave * 4 + rr, m = m0 + row;
            const float rs = rsqrtf(ssq[rr] * (1.f / D) + EPS);
#pragma unroll
            for (int j = 0; j < 4; ++j) {
                const int c = 4 * lane + 256 * j;
                const float4 g = *(const float4*)(p.norm2_g + l * D + c), sh = *(const float4*)(md + 3 * D + c), sc = *(const float4*)(md + 4 * D + c);
                const float h0 = xv[rr][j].x * rs * g.x * (1.f + sc.x) + sh.x, h1 = xv[rr][j].y * rs * g.y * (1.f + sc.y) + sh.y;
                const float h2 = xv[rr][j].z * rs * g.z * (1.f + sc.z) + sh.z, h3 = xv[rr][j].w * rs * g.w * (1.f + sc.w) + sh.w;
                uint2 hi; hi.x = cvtpk(h0, h1); hi.y = cvtpk(h2, h3);
                uint2 lo;
                lo.x = cvtpk(h0 - __uint_as_float(hi.x << 16), h1 - __uint_as_float(hi.x & 0xffff0000u));
                lo.y = cvtpk(h2 - __uint_as_float(hi.y << 16), h3 - __uint_as_float(hi.y & 0xffff0000u));
                *(uint2*)(v.H + (size_t)m * D + c) = hi;
                const int off = row * 2048 + ((((c >> 3) ^ row) & 127) << 4) + (c & 7) * 2;
                *(uint2*)(lds + off) = hi; *(uint2*)(lds + 32768 + off) = lo;
            }
        }
        __syncthreads();
        {
            const int r16 = lane & 15, kq = lane >> 4;
            f32x4m acc = {0.f, 0.f, 0.f, 0.f};
            const bf16_t* wh = wr + (size_t)(16 * wave + r16) * D + 8 * kq;
#pragma unroll 8
            for (int s = 0; s < 32; ++s) {
                const int off = r16 * 2048 + ((((4 * s + kq) ^ r16) & 127) << 4);
                const bf16x8 ah = *(const bf16x8*)(lds + off), al = *(const bf16x8*)(lds + 32768 + off);
                const bf16x8 bh = *(const bf16x8*)(wh + 32 * s), bl = *(const bf16x8*)(wh + 64 * D + 32 * s);
                acc = __builtin_amdgcn_mfma_f32_16x16x32_bf16(ah, bh, acc, 0, 0, 0);
                acc = __builtin_amdgcn_mfma_f32_16x16x32_bf16(al, bh, acc, 0, 0, 0);
                acc = __builtin_amdgcn_mfma_f32_16x16x32_bf16(ah, bl, acc, 0, 0, 0);
            }
#pragma unroll
            for (int q = 0; q < 4; ++q) LG[(4 * kq + q) * 64 + 16 * wave + r16] = acc[q];
        }
        __syncthreads();
        if (TIDX < 16) {
            const int m = m0 + TIDX;
            const float* lgp = LG + TIDX * 64;
            float lg[4], le[32];
#pragma unroll
            for (int i = 0; i < 4; ++i) lg[i] = lgp[i] + p.rg_b[l * 4 + i];
#pragma unroll
            for (int i = 0; i < 32; ++i) le[i] = lgp[4 + i] + p.re_b[l * 32 + i];
            int gi = 0; float gm = lg[0];
#pragma unroll
            for (int i = 1; i < 4; ++i) if (lg[i] > gm) { gm = lg[i]; gi = i; }
            float gs = 0.f;
#pragma unroll
            for (int i = 0; i < 4; ++i) gs += expf(lg[i] - gm);
            const float pg = 1.f / gs;
            float el[8];
#pragma unroll
            for (int i = 0; i < 8; ++i) el[i] = gi == 0 ? le[i] : (gi == 1 ? le[8 + i] : (gi == 2 ? le[16 + i] : le[24 + i]));
            int e1 = 0; float m1 = el[0];
#pragma unroll
            for (int i = 1; i < 8; ++i) if (el[i] > m1) { m1 = el[i]; e1 = i; }
            int e2 = -1; float m2 = -3.0e38f;
#pragma unroll
            for (int i = 0; i < 8; ++i) if (i != e1 && el[i] > m2) { m2 = el[i]; e2 = i; }
            const float p2 = expf(m2 - m1);
            const float w1 = pg / (1.f + p2), w2 = pg * p2 / (1.f + p2);
            const int ea = gi * 8 + e1, eb = gi * 8 + e2;
            const unsigned pa = atomicAdd(v.ctl + CW_CNT + l * 32 + ea, 1u);
            const unsigned pb = atomicAdd(v.ctl + CW_CNT + l * 32 + eb, 1u);
            v.list[(size_t)ea * T + pa] = 2 * m;
            v.list[(size_t)eb * T + pb] = 2 * m + 1;
            v.wts[2 * m] = w1; v.wts[2 * m + 1] = w2;
        }
        __syncthreads();
    }
}

constexpr int CW_MQ = 8192 + 512;
DEV void ph_mix(const P& p, int l, unsigned char* lds, volatile LAS unsigned* qslot, int rep) {
    const int TIDX = otid(), BIDX = obid();
    unsigned* ctl = (unsigned*)(p.ws + WS_CTL) + CW_MQ + l * 256;
    unsigned acq = 0u;
    for (int hop = 0; hop < 8; ++hop) {
        const int b = (BIDX + hop) & 7;
        unsigned* qc = ctl + b * 16;
        unsigned* done = ctl + 128 + b * 16;
        for (;;) {
            __syncthreads();
            if (TIDX == 0) *qslot = atomicAdd(qc, 1u);
            __syncthreads();
            const int v = (int)*qslot;
            if (v >= 272) break;
            if (v < 16) {
                if (cmp_unit(p, l, b * 4 + (v >> 2), v & 3, lds, qslot)) {
                    asm volatile("s_waitcnt vmcnt(0)" ::: "memory");
                    __syncthreads();
                    if (TIDX == 0) {
                        __builtin_amdgcn_fence(__ATOMIC_RELEASE, "agent");
                        asm volatile("s_waitcnt vmcnt(0)" ::: "memory");
                        __hip_atomic_fetch_add(done, 1u, __ATOMIC_RELAXED, __HIP_MEMORY_SCOPE_AGENT);
                    }
                }
                continue;
            }
            int slot = -1, nsa = -1;
            if (v < 48) slot = 2 * (v - 16);
            else if (v < 112) slot = 2 * (v - 48) + 1;
            else { const int w2 = v - 112, k = w2 % 5, i = w2 / 5; if (k < 4) nsa = 4 * i + k; else slot = 2 * (32 + i); }
            if (slot >= 0) {
                const int idx = slot >> 1, u = ((idx >> 2) << 5) | (b * 4 + (idx & 3));
                if (slot & 1) mha_unit<3>(p, l, u, lds); else mha_unit<2>(p, l, u, lds);
            } else {
                if (!((acq >> b) & 1u)) {
                    if (TIDX == 0) {
                        unsigned sp = 0;
                        while (__hip_atomic_load(done, __ATOMIC_RELAXED, __HIP_MEMORY_SCOPE_AGENT) < 4u) { __builtin_amdgcn_s_sleep(2); if (++sp > (1u << 22)) break; }
                        __builtin_amdgcn_fence(__ATOMIC_ACQUIRE, "agent");
                        asm volatile("s_waitcnt vmcnt(0)" ::: "memory");
                    }
                    __syncthreads();
                    acq |= 1u << b;
                }
                nsa_unit(p, l, ((nsa >> 1) << 4) | (b * 2 + (nsa & 1)), lds);
            }
        }
    }
}

#ifndef REP_PHASE
#define REP_PHASE 0
#endif
#ifndef REF_HEADS
#define REF_HEADS 0x0000u
#endif
__global__ void __launch_bounds__(256, 2) fwd_kernel(P p) {
    __shared__ __attribute__((aligned(16))) float lds[17408];
    __shared__ __attribute__((aligned(16))) unsigned lds_ctl[4];
    if (threadIdx.x < 4) lds_ctl[threadIdx.x] = 0u;
    __syncthreads();
    const XcdBarrier xb = xcd_barrier_post((unsigned*)(p.ws + WS_CTL), (volatile LAS unsigned*)lds_ctl);
#define GRID_BAR() do { xcd_barrier(xb); if (REP_PHASE == 7) xcd_barrier(xb); } while (0)
    volatile LAS unsigned* qslot = (volatile LAS unsigned*)(lds_ctl + 2);
    for (int rep = 0; rep < (REP_PHASE == 1 ? 2 : 1); ++rep) {
        ph_prologue(p, lds);
        ph_convert(p, lds);
        GRID_BAR();
    }
    for (int l = 0; l < DEPTH; ++l) {
        ph_convert_dense(p, l, 0);
        ph_norm1(p, l, l == 0 ? 0 : 1);
        GRID_BAR();
        for (int rep = 0; rep < (REP_PHASE == 2 ? 2 : 1); ++rep) {
            if (rep == 0) ph_convert_dense(p, l, 1);
            ph_inproj_fast(p, l, (unsigned char*)lds);
            GRID_BAR();
        }
        for (int rep = 0; rep < (REP_PHASE == 3 ? 2 : 1); ++rep) {
            ph_mix(p, l, (unsigned char*)lds, qslot, rep);
            GRID_BAR();
        }
        ph_outproj_fast(p, l, (unsigned char*)lds);
        GRID_BAR();
        if (blockIdx.x & 8) { ph_convert_experts(p, l); ph_norm2_router_fast(p, l, (unsigned char*)lds); }
        else { ph_norm2_router_fast(p, l, (unsigned char*)lds); ph_convert_experts(p, l); }
        GRID_BAR();
        for (int rep = 0; rep < (REP_PHASE == 5 ? 2 : 1); ++rep) {
            ph_moe_up_fast(p, l, (unsigned char*)lds);
            GRID_BAR();
        }
        for (int rep = 0; rep < (REP_PHASE == 6 ? 2 : 1); ++rep) {
            ph_moe_down_fast(p, l, (unsigned char*)lds);
            GRID_BAR();
        }
    }
    ph_norm1(p, DEPTH, 2);
}

extern "C" void kernel_launch(void* const* d_in, const int* in_sizes, int n_in,
                              void* d_out, int out_size, void* d_ws, size_t ws_size,
                              hipStream_t stream) {
    static int grid_blocks = 0;
    if (!grid_blocks) {
        int dev = 0, cus = 0, per_cu = 0;
        (void)hipGetDevice(&dev);
        (void)hipDeviceGetAttribute(&cus, hipDeviceAttributeMultiprocessorCount, dev);
        (void)hipOccupancyMaxActiveBlocksPerMultiprocessor(&per_cu, fwd_kernel, 256, 0);
        if (per_cu > 2) per_cu = 2;
        if (per_cu < 1) per_cu = 1;
        grid_blocks = cus * per_cu;
        if (n_in != 24 || ws_size < WS_END || out_size != T * D) { fprintf(stderr, "kernel_launch: unexpected shapes (n_in %d ws %zu out %d)\n", n_in, ws_size, out_size); grid_blocks = -1; }
    }
    if (grid_blocks < 0) return;
    (void)hipMemsetAsync(d_ws, 0, CTL_BYTES, stream);
    P p{};
    const float** pp = (const float**)&p;
    for (int i = 0; i < 24; ++i) pp[i] = (const float*)d_in[i];
    p.out = (float*)d_out; p.ws = (unsigned char*)d_ws;
    void* args[] = {&p};
    hipError_t e = hipLaunchCooperativeKernel((void*)fwd_kernel, dim3(grid_blocks), dim3(256), args, 0, stream);
    if (e != hipSuccess) fprintf(stderr, "cooperative launch failed: %s (grid %d)\n", hipGetErrorString(e), grid_blocks);
}
```

```cpp
#include <hip/hip_runtime.h>
#include <hip/hip_cooperative_groups.h>
#include <cstdio>
#include <cstdint>

#define LAS __attribute__((address_space(3)))
#define DEV __device__ __forceinline__

constexpr int T = 16384, S = 2048, NB = 8, D = 1024, DIN = 2844, NP = 2880, DEPTH = 4;
constexpr int NCMP = 127;
constexpr float EPS = 1e-6f;
constexpr float SCALE = 0.125f;
constexpr int C_QA = 0, C_KC = 512, C_VC = 640, C_KS = 768, C_VS = 896, C_KW = 1024, C_VW = 1152;
constexpr int C_QB = 1280, C_KB = 1536, C_VB = 1792, C_QC = 2048, C_KCC = 2304, C_VCC = 2560;

constexpr size_t MiB = 1u << 20;
constexpr size_t WS_CTL = 0, CTL_BYTES = 64 * 1024;
constexpr size_t WS_MOD = 1 * MiB, WS_ROPE = 2 * MiB, WS_CUMF = 3 * MiB, WS_CK = 4 * MiB, WS_CV = 5 * MiB, WS_IMP = 6 * MiB;
constexpr size_t WS_SEL = 10 * MiB, WS_EID = 11 * MiB, WS_WTS = 12 * MiB, WS_LIST = 13 * MiB, WS_GF = 16 * MiB;
constexpr size_t WS_H = 32 * MiB, WS_U = 64 * MiB, WS_O = 160 * MiB, WS_HID = 192 * MiB, WS_Y = 224 * MiB, WS_OB = 352 * MiB, WS_ORAW = 448 * MiB;
constexpr size_t WS_END = 973 * MiB;
constexpr size_t WS_VT = 936 * MiB;
constexpr size_t WS_CVT = 962 * MiB;
constexpr size_t WS_CUMF2 = 963 * MiB;
constexpr int CW_Q = 8192 + 256;
constexpr size_t WS_CW1 = 964 * MiB;
constexpr size_t WS_CW2 = 968 * MiB;
constexpr size_t WS_CPB = 969 * MiB;
constexpr size_t WS_LSF = 970 * MiB;
constexpr size_t WS_WR = 971 * MiB;
constexpr int CW_CNT = 8192;

typedef unsigned short bf16_t;
typedef float f32x4v __attribute__((ext_vector_type(4)));
DEV int vt_row(int n) { return n < 1024 ? n - 896 : (n < 1280 ? 128 + n - 1152 : (n < 2048 ? 256 + n - 1792 : 512 + n - 2560)); }
DEV bool is_vcol(int n) { return (n >= C_VS && n < C_KW) || (n >= C_VW && n < C_QB) || (n >= C_VB && n < C_QC) || (n >= C_VCC && n < 2816); }
DEV float bf2f(bf16_t v) { return __uint_as_float((unsigned)v << 16); }
DEV bf16_t f2bf(float f) { unsigned u = __float_as_uint(f); return (bf16_t)((u + 0x7fffu + ((u >> 16) & 1u)) >> 16); }
DEV float4 ld_bf4(const bf16_t* p) { const ushort4 u = *(const ushort4*)p; return make_float4(bf2f(u.x), bf2f(u.y), bf2f(u.z), bf2f(u.w)); }
typedef float f32x2_t __attribute__((ext_vector_type(2)));
typedef __bf16 bf16x2_t __attribute__((ext_vector_type(2)));
DEV unsigned cvtpk(float lo, float hi) { f32x2_t v = {lo, hi}; bf16x2_t b = __builtin_convertvector(v, bf16x2_t); return __builtin_bit_cast(unsigned, b); }
DEV float sigmoidf_(float x) { return 1.f / (1.f + expf(-x)); }
DEV float logsigmoidf_(float x) { return fminf(x, 0.f) - log1pf(expf(-fabsf(x))); }
DEV float wave_sum(float v) {
#pragma unroll
    for (int o = 1; o < 64; o <<= 1) v += __shfl_xor(v, o);
    return v;
}

#define XB_TMO      128
#define XB_XCNT(j)  (256  + 64 * (j))
#define XB_XSUB(j)  (1280 + 64 * (j))
#define XB_XGEN(j)  (2304 + 64 * (j))
#define XB_TOP      3328
#define XB_TOPGEN   3392
#define XCD_BAR_WORDS 3456
#define XB_SPIN_CAP (1u << 23)
DEV unsigned xb_ld(unsigned* p)              { return __hip_atomic_load(p, __ATOMIC_RELAXED, __HIP_MEMORY_SCOPE_AGENT); }
DEV unsigned xb_add(unsigned* p, unsigned v) { return __hip_atomic_fetch_add(p, v, __ATOMIC_RELAXED, __HIP_MEMORY_SCOPE_AGENT); }
DEV unsigned xb_xcc_id() { return (unsigned)__builtin_amdgcn_s_getreg((3 << 11) | 20) & 0xFu; }
#define XB_SPIN(cond, bar) do { unsigned _sp = 0; while (cond) { __builtin_amdgcn_s_sleep(1); \
    if ((++_sp & 255u) == 0u) { if (xb_ld(&(bar)[XB_TMO])) break; if (_sp > XB_SPIN_CAP) { atomicAdd(&(bar)[XB_TMO], 1u); break; } } } } while (0)
struct XcdBarrier { unsigned* bar; unsigned x; volatile LAS unsigned* st; };
DEV XcdBarrier xcd_barrier_post(unsigned* bar, volatile LAS unsigned* st) {
    XcdBarrier b; b.bar = bar; b.x = xb_xcc_id(); b.st = st;
    if (threadIdx.x == 0) (void)xb_add(&bar[XB_XCNT(b.x)], 1u);
    return b;
}
DEV void xcd_barrier_complete(unsigned* bar, unsigned x, unsigned& nloc, unsigned& nx) {
    const unsigned G = gridDim.x * gridDim.y * gridDim.z;
    unsigned sum, cnt, mine, sp = 0u;
    for (;;) {
        sum = 0u; cnt = 0u; mine = 0u;
#pragma unroll
        for (unsigned j = 0; j < 16; ++j) { const unsigned c = xb_ld(&bar[XB_XCNT(j)]); sum += c; cnt += (c > 0u) ? 1u : 0u; mine = (j == x) ? c : mine; }
        if (sum == G) break;
        __builtin_amdgcn_s_sleep(1);
        if ((++sp & 255u) == 0u) { if (xb_ld(&bar[XB_TMO])) break; if (sp > XB_SPIN_CAP) { atomicAdd(&bar[XB_TMO], 1u); break; } }
    }
    nloc = mine > 0u ? mine : 1u; nx = cnt > 0u ? cnt : 1u;
}
DEV void xcd_barrier(const XcdBarrier& b) {
    asm volatile("s_waitcnt vmcnt(0)" ::: "memory");
    __syncthreads();
    if (threadIdx.x == 0) {
        unsigned* bar = b.bar;
        __builtin_amdgcn_s_waitcnt(0);
        unsigned nloc = b.st[0], nx = b.st[1];
        if (nloc == 0u) { xcd_barrier_complete(bar, b.x, nloc, nx); b.st[0] = nloc; b.st[1] = nx; }
        const unsigned old = xb_add(&bar[XB_XSUB(b.x)], 1u);
        const unsigned gen = old / nloc;
        if (old + 1u == (gen + 1u) * nloc) {
            __builtin_amdgcn_fence(__ATOMIC_RELEASE, "agent");
            asm volatile("s_waitcnt vmcnt(0)" ::: "memory");
            const unsigned og = xb_add(&bar[XB_TOP], 1u);
            const unsigned tg = og / nx;
            if (og + 1u == (tg + 1u) * nx) xb_add(&bar[XB_TOPGEN], 1u);
            else XB_SPIN(xb_ld(&bar[XB_TOPGEN]) == tg, bar);
            __builtin_amdgcn_fence(__ATOMIC_ACQUIRE, "agent");
            xb_add(&bar[XB_XGEN(b.x)], 1u);
            asm volatile("s_waitcnt vmcnt(0)" ::: "memory");
        } else {
            XB_SPIN(xb_ld(&bar[XB_XGEN(b.x)]) == gen, bar);
            __builtin_amdgcn_fence(__ATOMIC_ACQUIRE, "agent");
            asm volatile("s_waitcnt vmcnt(0)" ::: "memory");
        }
    }
    __syncthreads();
}

struct P {
    const float *x, *c, *norm1_g, *norm2_g, *ada_w, *ada_b, *w_in, *b_forget, *cmp_pos_k, *cmp_w1_k, *cmp_w2_k,
        *cmp_pos_v, *cmp_w1_v, *cmp_w2_v, *out_norm_g, *w_out, *rg_w, *rg_b, *re_w, *re_b, *e_w1, *e_w3, *e_w2, *final_g;
    float* out; unsigned char* ws;
};
struct V {
    unsigned* ctl; float* mod; float* rcos; float* rsin; float* cumf; bf16_t* ck; bf16_t* cv; float* imp; unsigned* sel;
    int* eid; float* wts; int* list; float* gf; bf16_t* H; bf16_t* U; bf16_t* O; bf16_t* HID; bf16_t* Y; float* OB; float* ORAW; float* X;
};
DEV int otid() { int t = threadIdx.x; asm volatile("" : "+v"(t)); return t; }
DEV int obid() { int t = blockIdx.x; asm volatile("" : "+s"(t)); return t; }
DEV V make_views(const P& p) {
    V v; size_t woff = 0; asm volatile("" : "+s"(woff)); unsigned char* w = p.ws + woff;
    v.ctl = (unsigned*)(w + WS_CTL); v.mod = (float*)(w + WS_MOD); v.rcos = (float*)(w + WS_ROPE); v.rsin = v.rcos + S * 8;
    v.cumf = (float*)(w + WS_CUMF); v.ck = (bf16_t*)(w + WS_CK); v.cv = (bf16_t*)(w + WS_CV); v.imp = (float*)(w + WS_IMP);
    v.sel = (unsigned*)(w + WS_SEL); v.eid = (int*)(w + WS_EID); v.wts = (float*)(w + WS_WTS); v.list = (int*)(w + WS_LIST);
    v.gf = (float*)(w + WS_GF); v.H = (bf16_t*)(w + WS_H); v.U = (bf16_t*)(w + WS_U); v.O = (bf16_t*)(w + WS_O);
    v.HID = (bf16_t*)(w + WS_HID); v.Y = (bf16_t*)(w + WS_Y); v.OB = (float*)(w + WS_OB); v.ORAW = (float*)(w + WS_ORAW); v.X = p.out;
    return v;
}

DEV void ph_prologue(const P& p, float* lds) {
    const V v = make_views(p); const int TIDX = otid(), BIDX = obid();
    const int tid = TIDX;
    for (int i = tid; i < NB * D; i += 256) { const float c = p.c[i]; lds[i] = c / (1.f + expf(-c)); }
    __syncthreads();
    float* red = lds + NB * D;
    const int c4 = tid & 15, ks = tid >> 4;
    for (int unit = BIDX; unit < DEPTH * 96; unit += gridDim.x) {
        const int l = unit / 96, n0 = (unit % 96) * 64;
        const float* W = p.ada_w + (size_t)l * D * 6144 + n0 + 4 * c4;
        float acc[8][4];
#pragma unroll
        for (int b = 0; b < 8; ++b)
#pragma unroll
            for (int q = 0; q < 4; ++q) acc[b][q] = 0.f;
#pragma unroll 1
        for (int i0 = 0; i0 < 64; i0 += 8) {
            f32x4v w[8];
#pragma unroll
            for (int i = 0; i < 8; ++i) w[i] = __builtin_nontemporal_load((const f32x4v*)(W + (size_t)(ks + 16 * (i0 + i)) * 6144));
#pragma unroll
            for (int i = 0; i < 8; ++i) {
                const int k = ks + 16 * (i0 + i);
#pragma unroll
                for (int b = 0; b < 8; ++b) {
                    const float cv = lds[b * D + k];
                    acc[b][0] += cv * w[i].x; acc[b][1] += cv * w[i].y; acc[b][2] += cv * w[i].z; acc[b][3] += cv * w[i].w;
                }
            }
        }
#pragma unroll
        for (int b = 0; b < 8; ++b) *(float4*)(red + (ks * 8 + b) * 64 + 4 * c4) = make_float4(acc[b][0], acc[b][1], acc[b][2], acc[b][3]);
        __syncthreads();
        for (int o = tid; o < 512; o += 256) {
            const int c2 = o & 63, b = o >> 6;
            float sm = p.ada_b[l * 6144 + n0 + c2];
#pragma unroll
            for (int q = 0; q < 16; ++q) sm += red[(q * 8 + b) * 64 + c2];
            v.mod[(size_t)(l * 8 + b) * 6144 + n0 + c2] = sm;
        }
        __syncthreads();
    }
    const float cst = -2.0f * 13.122363377404328f / 16.0f;
    for (int i = ((int)gridDim.x - 1 - BIDX) * 256 + tid; i < S * 8; i += gridDim.x * 256) {
        const int s = i >> 3, j = i & 7;
        const float inv = expf((float)j * cst);
        const float ang = (float)s * inv;
        v.rcos[i] = cosf(ang); v.rsin[i] = sinf(ang);
    }
}

DEV void ph_norm1(const P& p, int l, int mode) {
    const V v = make_views(p); const int TIDX = otid(), BIDX = obid();
    const int lane = TIDX & 63;
    const int gw = (BIDX * 256 + TIDX) >> 6, nw = gridDim.x * 4;
    for (int m0 = gw; m0 < T; m0 += 2 * nw) {
        float4 xv[2][4];
        if (mode == 0) {
#pragma unroll
            for (int rr = 0; rr < 2; ++rr)
#pragma unroll
                for (int j = 0; j < 4; ++j) xv[rr][j] = *(const float4*)(p.x + (size_t)(m0 + rr * nw) * D + 4 * lane + 256 * j);
        } else {
            float4 xa[2][4]; ushort4 ya[2][4], yb[2][4];
#pragma unroll
            for (int rr = 0; rr < 2; ++rr)
#pragma unroll
                for (int j = 0; j < 4; ++j) {
                    const int m = m0 + rr * nw, c = 4 * lane + 256 * j;
                    xa[rr][j] = *(const float4*)(v.X + (size_t)m * D + c);
                    ya[rr][j] = *(const ushort4*)(v.Y + (size_t)(2 * m) * D + c); yb[rr][j] = *(const ushort4*)(v.Y + (size_t)(2 * m + 1) * D + c);
                }
#pragma unroll
            for (int rr = 0; rr < 2; ++rr) {
                const float* g2 = v.mod + (size_t)((l - 1) * 8 + ((m0 + rr * nw) >> 11)) * 6144 + 5 * D;
#pragma unroll
                for (int j = 0; j < 4; ++j) {
                    const float4 g = *(const float4*)(g2 + 4 * lane + 256 * j);
                    float4 a = xa[rr][j];
                    a.x += g.x * (bf2f(ya[rr][j].x) + bf2f(yb[rr][j].x)); a.y += g.y * (bf2f(ya[rr][j].y) + bf2f(yb[rr][j].y));
                    a.z += g.z * (bf2f(ya[rr][j].z) + bf2f(yb[rr][j].z)); a.w += g.w * (bf2f(ya[rr][j].w) + bf2f(yb[rr][j].w));
                    xv[rr][j] = a;
                }
            }
        }
        float ss[2];
#pragma unroll
        for (int rr = 0; rr < 2; ++rr) {
            ss[rr] = 0.f;
#pragma unroll
            for (int j = 0; j < 4; ++j) ss[rr] += xv[rr][j].x * xv[rr][j].x + xv[rr][j].y * xv[rr][j].y + xv[rr][j].z * xv[rr][j].z + xv[rr][j].w * xv[rr][j].w;
        }
#pragma unroll
        for (int o = 1; o < 64; o <<= 1) { ss[0] += __shfl_xor(ss[0], o); ss[1] += __shfl_xor(ss[1], o); }
#pragma unroll
        for (int rr = 0; rr < 2; ++rr) {
            const int m = m0 + rr * nw, b = m >> 11;
            const float r = rsqrtf(ss[rr] * (1.f / D) + EPS);
            if (mode == 2) {
#pragma unroll
                for (int j = 0; j < 4; ++j) {
                    const int c = 4 * lane + 256 * j;
                    const float4 g = *(const float4*)(p.final_g + c);
                    float4 o; o.x = xv[rr][j].x * r * g.x; o.y = xv[rr][j].y * r * g.y; o.z = xv[rr][j].z * r * g.z; o.w = xv[rr][j].w * r * g.w;
                    *(float4*)(v.X + (size_t)m * D + c) = o;
                }
            } else {
                const float* md = v.mod + (size_t)(l * 8 + b) * 6144;
#pragma unroll
                for (int j = 0; j < 4; ++j) {
                    const int c = 4 * lane + 256 * j;
                    *(float4*)(v.X + (size_t)m * D + c) = xv[rr][j];
                    const float4 g = *(const float4*)(p.norm1_g + l * D + c), sh = *(const float4*)(md + c), sc = *(const float4*)(md + D + c);
                    uint2 o;
                    o.x = cvtpk(xv[rr][j].x * r * g.x * (1.f + sc.x) + sh.x, xv[rr][j].y * r * g.y * (1.f + sc.y) + sh.y);
                    o.y = cvtpk(xv[rr][j].z * r * g.z * (1.f + sc.z) + sh.z, xv[rr][j].w * r * g.w * (1.f + sc.w) + sh.w);
                    *(uint2*)(v.H + (size_t)m * D + c) = o;
                }
            }
        }
    }
}

typedef short bf16x8 __attribute__((ext_vector_type(8)));
typedef float f32x16 __attribute__((ext_vector_type(16)));
typedef unsigned u32x4 __attribute__((ext_vector_type(4)));
constexpr size_t WS_WIN = 512 * MiB, WS_WOT = 544 * MiB, WS_W13 = 552 * MiB, WS_W2 = 808 * MiB;
constexpr int NPW = 2944;
DEV int tile_off(int row, int chunk) { return row * 128 + ((chunk ^ ((row >> 1) & 7)) << 4); }
template <class RM>
DEV void conv_patch(const float* src, int N, int K, bf16_t* dst, int k0, int n0, RM rowmap, int lane) {
    const int kg = lane >> 3, n = n0 + 4 * (lane & 7);
    if (n >= N) return;
    const float* sp = src + (size_t)(k0 + 8 * kg) * N + n;
    f32x4v x[8];
#pragma unroll
    for (int j = 0; j < 8; ++j) x[j] = __builtin_nontemporal_load((const f32x4v*)(sp + (size_t)j * N));
    bf16_t* dp = dst + k0 + 8 * kg;
    u32x4 o;
    o.x = cvtpk(x[0].x, x[1].x); o.y = cvtpk(x[2].x, x[3].x); o.z = cvtpk(x[4].x, x[5].x); o.w = cvtpk(x[6].x, x[7].x);
    *(u32x4*)(dp + (size_t)rowmap(n) * K) = o;
    o.x = cvtpk(x[0].y, x[1].y); o.y = cvtpk(x[2].y, x[3].y); o.z = cvtpk(x[4].y, x[5].y); o.w = cvtpk(x[6].y, x[7].y);
    *(u32x4*)(dp + (size_t)rowmap(n + 1) * K) = o;
    o.x = cvtpk(x[0].z, x[1].z); o.y = cvtpk(x[2].z, x[3].z); o.z = cvtpk(x[4].z, x[5].z); o.w = cvtpk(x[6].z, x[7].z);
    *(u32x4*)(dp + (size_t)rowmap(n + 2) * K) = o;
    o.x = cvtpk(x[0].w, x[1].w); o.y = cvtpk(x[2].w, x[3].w); o.z = cvtpk(x[4].w, x[5].w); o.w = cvtpk(x[6].w, x[7].w);
    *(u32x4*)(dp + (size_t)rowmap(n + 3) * K) = o;
}

DEV void conv8(const float* s0, const float* s1, bf16_t* dst) {
    f32x4v a = {0.f, 0.f, 0.f, 0.f}, b = {0.f, 0.f, 0.f, 0.f};
    if (s0) a = __builtin_nontemporal_load((const f32x4v*)s0);
    if (s1) b = __builtin_nontemporal_load((const f32x4v*)s1);
    u32x4 o; o.x = cvtpk(a[0], a[1]); o.y = cvtpk(a[2], a[3]); o.z = cvtpk(b[0], b[1]); o.w = cvtpk(b[2], b[3]);
    *(u32x4*)dst = o;
}
DEV void ph_convert_dense(const P& p, int l, int which) {
    const int TIDX = otid(), BIDX = obid();
    size_t woff = 0; asm volatile("" : "+s"(woff)); unsigned char* w = p.ws + woff;
    const size_t gtid = (size_t)BIDX * 256 + TIDX, gsz = (size_t)gridDim.x * 256;
    if (which == 0) {
        bf16_t* win = (bf16_t*)(w + WS_WIN);
        for (size_t i = gtid; i < (size_t)D * 368; i += gsz) {
            const int g8 = (int)(i % 368); const size_t lk = (size_t)l * D + i / 368;
            const int n = g8 * 8;
            const float* row = p.w_in + lk * DIN;
            const float *s0, *s1;
            if (n < 2816) { const int oc = n + (n >= 2048 ? 28 : (n >= 1280 ? 24 : 0)); s0 = row + oc; s1 = row + oc + 4; }
            else if (n < 2840) { s0 = row + 1280 + (n - 2816); s1 = s0 + 4; }
            else if (n == 2840) { s0 = row + 2072; s1 = nullptr; }
            else { s0 = nullptr; s1 = nullptr; }
            conv8(s0, s1, win + lk * NPW + n);
        }
    } else {
        bf16_t* wot = (bf16_t*)(w + WS_WOT);
        const size_t oo = (size_t)l * D * D;
        for (size_t i = gtid; i < (size_t)D * D / 8; i += gsz) conv8(p.w_out + oo + i * 8, p.w_out + oo + i * 8 + 4, wot + oo + i * 8);
        for (size_t i = gtid; i < (size_t)2 * 2048 * 128 / 8; i += gsz) {
            const size_t per = (size_t)2048 * 128 / 8; const int kv = (int)(i / per), lk = l * 2 + kv; const size_t off = (i % per) * 8;
            const float* src = (kv ? p.cmp_w1_v : p.cmp_w1_k) + (size_t)l * 2048 * 128 + off;
            conv8(src, src + 4, (bf16_t*)(w + WS_CW1) + (size_t)lk * 2048 * 128 + off);
        }
    }
}
DEV void ph_convert_experts(const P& p, int l) {
    const int TIDX = otid(), BIDX = obid();
    size_t woff = 0; asm volatile("" : "+s"(woff)); unsigned char* w = p.ws + woff;
    bf16_t* w13 = (bf16_t*)(w + WS_W13); bf16_t* w2t = (bf16_t*)(w + WS_W2);
    const size_t gtid = (size_t)BIDX * 256 + TIDX, gsz = (size_t)gridDim.x * 256;
    for (size_t i = gtid; i < (size_t)32 * D * 128; i += gsz) {
        const int g8 = (int)(i & 127); const size_t lek = (size_t)l * 32 * D + (i >> 7);
        const int n = g8 * 8, which = (n >> 5) & 1, c = 32 * (n >> 6) + (n & 31);
        const float* src = (which ? p.e_w3 : p.e_w1) + lek * 512 + c;
        conv8(src, src + 4, w13 + lek * 1024 + n);
    }
    const size_t o2 = (size_t)l * 32 * 512 * D;
    for (size_t i = gtid; i < (size_t)32 * 512 * D / 8; i += gsz) conv8(p.e_w2 + o2 + i * 8, p.e_w2 + o2 + i * 8 + 4, w2t + o2 + i * 8);
}
DEV void ph_convert(const P& p, float* lds) {
    const int TIDX = otid(), BIDX = obid();
    size_t woff = 0; asm volatile("" : "+s"(woff)); unsigned char* w = p.ws + woff;
    const int lane = TIDX & 63;
    for (int unit = BIDX * 4 + (TIDX >> 6); unit < DEPTH * 2 * 4; unit += gridDim.x * 4) {
        const int lk = unit >> 2, t = unit & 3, l = lk >> 1, kv = lk & 1;
        conv_patch((kv ? p.cmp_w2_v : p.cmp_w2_k) + (size_t)l * 128 * 64, 64, 128, (bf16_t*)(w + WS_CW2) + (size_t)lk * 64 * 128, (t >> 1) * 64, (t & 1) * 32, [](int n) { return n; }, lane);
    }
    for (int o = BIDX * 256 + TIDX; o < DEPTH * 64 * D; o += gridDim.x * 256) {
        const int k = o & (D - 1), n = (o >> 10) & 63, l = o >> 16;
        const float val = n < 4 ? p.rg_w[((size_t)l * D + k) * 4 + n] : (n < 36 ? p.re_w[((size_t)l * D + k) * 32 + n - 4] : 0.f);
        const bf16_t hi = f2bf(val); const bf16_t lo = f2bf(val - bf2f(hi));
        bf16_t* wr = (bf16_t*)(w + WS_WR) + (size_t)l * 2 * 64 * D;
        wr[n * D + k] = hi; wr[64 * D + n * D + k] = lo;
    }
    int pu = (int)gridDim.x - 1 - BIDX - 64; if (pu < 0) pu += gridDim.x;
    for (int unit = pu; unit < DEPTH * 2 * 8; unit += gridDim.x) {
        const int lk = unit >> 3, ch = unit & 7, l = lk >> 1, kv = lk & 1, j = TIDX & 127, hf = TIDX >> 7;
        const float* pe = (kv ? p.cmp_pos_v : p.cmp_pos_k) + (size_t)l * 2048 + ch * 256 + hf * 128;
        const float* w1 = (kv ? p.cmp_w1_v : p.cmp_w1_k) + (size_t)l * 2048 * 128 + (size_t)(ch * 256 + hf * 128) * 128 + j;
        float a0 = 0.f, a1 = 0.f, a2 = 0.f, a3 = 0.f;
#pragma unroll 1
        for (int k0 = 0; k0 < 128; k0 += 32) {
            float wv[32];
#pragma unroll
            for (int k = 0; k < 32; ++k) wv[k] = w1[(size_t)(k0 + k) * 128];
#pragma unroll
            for (int k = 0; k < 32; k += 4) {
                a0 += pe[k0 + k] * wv[k]; a1 += pe[k0 + k + 1] * wv[k + 1];
                a2 += pe[k0 + k + 2] * wv[k + 2]; a3 += pe[k0 + k + 3] * wv[k + 3];
            }
        }
        const float a = (a0 + a1) + (a2 + a3);
        __syncthreads();
        if (hf) lds[j] = a;
        __syncthreads();
        if (!hf) ((float*)(w + WS_CPB))[(lk * 8 + ch) * 128 + j] = a + lds[j];
    }
}

typedef short v4i16_t __attribute__((ext_vector_type(4)));
DEV void gemm_issue0(unsigned char* lds, const bf16_t* const (&arow)[4], const bf16_t* Bsrc, const size_t ldb, const int TIDX) {
    const int lane = TIDX & 63, wave = TIDX >> 6;
    const int gsw = ((TIDX & 7) ^ ((TIDX >> 4) & 7)) * 8;
    const bf16_t* bg = Bsrc + (size_t)(4 * wave + (lane >> 4)) * ldb + ((lane & 15) ^ (((lane >> 4) << 2) | (wave & 3))) * 8;
    LAS unsigned char* l3 = (LAS unsigned char*)lds + __builtin_amdgcn_readfirstlane(wave) * 1024;
#pragma unroll
    for (int i = 0; i < 4; ++i) {
        __builtin_amdgcn_global_load_lds((const unsigned*)(arow[i] + gsw), (LAS unsigned*)(l3 + i * 4096), 16, 0, 0);
        __builtin_amdgcn_global_load_lds((const unsigned*)(bg + (size_t)(16 * i) * ldb), (LAS unsigned*)(l3 + 16384 + i * 4096), 16, 0, 0);
    }
}
template <bool SWAP, bool PRE = false>
DEV void gemm128(unsigned char* lds, const bf16_t* const (&arow)[4], const bf16_t* Bsrc, const size_t ldb, int K, f32x16 (&acc)[2][2], const int TIDX, const int astride = 64) {
    const int lane = TIDX & 63, wave = TIDX >> 6, wm = wave >> 1, wn = wave & 1, r = lane & 31, h = lane >> 5;
#pragma unroll
    for (int j = 0; j < 2; ++j)
#pragma unroll
        for (int i = 0; i < 2; ++i)
#pragma unroll
            for (int q = 0; q < 16; ++q) acc[j][i][q] = 0.f;
    const int gsw = ((TIDX & 7) ^ ((TIDX >> 4) & 7)) * 8;
    const bf16_t* ag[4];
#pragma unroll
    for (int i = 0; i < 4; ++i) ag[i] = arow[i] + gsw;
    const int brow = 4 * wave + (lane >> 4), bch = ((lane & 15) ^ (((lane >> 4) << 2) | (wave & 3))) * 8;
    const bf16_t* bg = Bsrc + (size_t)brow * ldb + bch;
    LAS unsigned char* l3 = (LAS unsigned char*)lds + __builtin_amdgcn_readfirstlane(wave) * 1024;
    LAS unsigned char* tb[2][2];
    {
        const int blk = (lane >> 4) & 1, q = (lane & 15) >> 2, pp = lane & 3;
#pragma unroll
        for (int j = 0; j < 2; ++j)
#pragma unroll
            for (int t = 0; t < 2; ++t) {
                const int row = 4 * t + 8 * h + q, ch = 4 * (2 * wn + j) + 2 * blk + (pp >> 1);
                tb[j][t] = (LAS unsigned char*)lds + 16384 + 256 * row + 16 * (ch ^ (((row & 3) << 2) | ((row >> 2) & 3))) + 8 * (pp & 1);
            }
    }
#define G_DMA(st_, kt_) do { _Pragma("unroll") for (int i = 0; i < 4; ++i) { \
        __builtin_amdgcn_global_load_lds((const unsigned*)(ag[i] + (size_t)(kt_) * astride), (LAS unsigned*)(l3 + (st_) + i * 4096), 16, 0, 0); \
        __builtin_amdgcn_global_load_lds((const unsigned*)(bg + ((size_t)(kt_) * 64 + 16 * i) * ldb), (LAS unsigned*)(l3 + (st_) + 16384 + i * 4096), 16, 0, 0); } } while (0)
    const int KT = K >> 6;
    if (!PRE) {
        __syncthreads();
        G_DMA(0, 0);
    }
    for (int kt = 0; kt < KT; ++kt) {
        asm volatile("s_waitcnt vmcnt(0) lgkmcnt(0)" ::: "memory");
        __builtin_amdgcn_s_barrier();
        asm volatile("" ::: "memory");
        if (kt + 1 < KT) G_DMA(((kt + 1) & 1) * 32768, kt + 1);
        const int so = (kt & 1) * 32768;
        const unsigned char* cur = lds + so;
#pragma unroll
        for (int kk = 0; kk < 4; ++kk) {
            bf16x8 af[2], wf[2];
#pragma unroll
            for (int i = 0; i < 2; ++i) af[i] = *(const bf16x8*)(cur + tile_off(64 * wm + 32 * i + r, 2 * kk + h));
#pragma unroll
            for (int j = 0; j < 2; ++j) {
                const v4i16_t lo = __builtin_amdgcn_ds_read_tr16_b64_v4i16((LAS v4i16_t*)(tb[j][0] + so + 4096 * kk));
                const v4i16_t hi = __builtin_amdgcn_ds_read_tr16_b64_v4i16((LAS v4i16_t*)(tb[j][1] + so + 4096 * kk));
                wf[j] = (bf16x8){lo[0], lo[1], lo[2], lo[3], hi[0], hi[1], hi[2], hi[3]};
            }
#pragma unroll
            for (int j = 0; j < 2; ++j)
#pragma unroll
                for (int i = 0; i < 2; ++i) acc[j][i] = SWAP ? __builtin_amdgcn_mfma_f32_32x32x16_bf16(af[i], wf[j], acc[j][i], 0, 0, 0)
                                                             : __builtin_amdgcn_mfma_f32_32x32x16_bf16(wf[j], af[i], acc[j][i], 0, 0, 0);
        }
    }
    __syncthreads();
#undef G_DMA
}

constexpr int CST = 272;
DEV void ctile_put(unsigned char* lds, int row, int col, float a, float b, float c, float d) {
    uint2 u; u.x = cvtpk(a, b); u.y = cvtpk(c, d);
    *(uint2*)(lds + row * CST + col * 2) = u;
}
template <int COLS, class RP>
DEV void ctile_flush(unsigned char* lds, const int TIDX, RP rowptr) {
    asm volatile("s_waitcnt lgkmcnt(0)" ::: "memory");
    __builtin_amdgcn_s_barrier();
    asm volatile("" ::: "memory");
    constexpr int CPR = COLS / 8, RPI = 256 / CPR;
#pragma unroll
    for (int it = 0; it < 128 / RPI; ++it) {
        const int row = it * RPI + TIDX / CPR, c16 = TIDX % CPR;
        bf16_t* dst = rowptr(row, it);
        const u32x4 val = *(const u32x4*)(lds + row * CST + c16 * 16);
        if (dst) *(u32x4*)(dst + c16 * 8) = val;
    }
}

DEV void ph_inproj_fast(const P& p, int l, unsigned char* lds) {
    const V v = make_views(p); const int TIDX = otid(), BIDX = obid();
    const bf16_t* W = (const bf16_t*)(p.ws + WS_WIN) + (size_t)l * D * NPW;
    const int lane = TIDX & 63, wave = TIDX >> 6, wm = wave >> 1, wn = wave & 1, r = lane & 31, h = lane >> 5;
    const bool xo = gridDim.x == 512;
    unsigned char* ct = lds + 32768;
    auto decode = [&](int it, int& mt, int& nt) -> int {
        if (xo) { if (it >= 6) return -1; const int lb = BIDX >> 3; nt = 8 * (it % 3) + (lb >> 3); mt = 16 * (BIDX & 7) + 8 * (it / 3) + (lb & 7); return nt < 23 ? 1 : 0; }
        const int unit = BIDX + it * (int)gridDim.x; if (unit >= 128 * 23) return -1; nt = unit / 128; mt = unit % 128; return 1;
    };
    auto issue = [&](int mt, int nt) {
        const bf16_t* ar[4];
#pragma unroll
        for (int i = 0; i < 4; ++i) ar[i] = v.H + (size_t)(mt * 128 + (TIDX >> 3) + 32 * i) * D;
        gemm_issue0(lds, ar, W + nt * 128, NPW, TIDX);
    };
    bool pre = false;
    for (int it = 0;; ++it) {
        int nt, mt;
        const int dv = decode(it, mt, nt);
        if (dv < 0) break;
        if (dv == 0) continue;
        const int m0 = mt * 128, n0 = nt * 128;
        const bf16_t* arow[4];
#pragma unroll
        for (int i = 0; i < 4; ++i) arow[i] = v.H + (size_t)(m0 + (TIDX >> 3) + 32 * i) * D;
        if (!pre) { __syncthreads(); issue(mt, nt); pre = true; }
        int itn = it + 1, mtn = 0, ntn = 0, dn;
        while ((dn = decode(itn, mtn, ntn)) == 0) ++itn;
        f32x16 acc[2][2];
        if (is_vcol(n0)) {
            gemm128<true, true>(lds, arow, W + n0, NPW, D, acc, TIDX);
            if (dn > 0) issue(mtn, ntn); else pre = false;
#pragma unroll
            for (int j = 0; j < 2; ++j)
#pragma unroll
                for (int i = 0; i < 2; ++i)
#pragma unroll
                    for (int g = 0; g < 4; ++g)
                        ctile_put(ct, 64 * wn + 32 * j + r, 64 * wm + 32 * i + 8 * g + 4 * h, acc[j][i][4 * g], acc[j][i][4 * g + 1], acc[j][i][4 * g + 2], acc[j][i][4 * g + 3]);
            bf16_t* vt = (bf16_t*)(p.ws + WS_VT) + ((size_t)(m0 >> 11) * 768 + vt_row(n0)) * S + (m0 & (S - 1));
            ctile_flush<128>(ct, TIDX, [&](int row, int) { return vt + (size_t)row * S; });
            continue;
        }
        const bool rope_tile = n0 < 512 || n0 == C_KS || n0 == C_KW;
        f32x4v rcs[2], rsn[2];
        if (rope_tile) {
#pragma unroll
            for (int i = 0; i < 2; ++i) {
                const int sp = (m0 + 64 * wm + 32 * i + r) & (S - 1);
                rcs[i] = *(const f32x4v*)(v.rcos + sp * 8 + 4 * h); rsn[i] = *(const f32x4v*)(v.rsin + sp * 8 + 4 * h);
            }
        }
        gemm128<false, true>(lds, arow, W + n0, NPW, D, acc, TIDX);
        if (dn > 0) issue(mtn, ntn); else pre = false;
        if (n0 == 2816) {
            if (wn == 0) {
#pragma unroll
                for (int i = 0; i < 2; ++i) {
                    const int m = m0 + 64 * wm + 32 * i + r;
#pragma unroll
                    for (int q = 0; q < 16; ++q) {
                        const int cc = (q & 3) + 8 * (q >> 2) + 4 * h;
                        if (cc < 24) v.gf[(size_t)m * 32 + cc] = acc[0][i][q];
                        else if (cc < 28) ((float*)(p.ws + WS_LSF))[(size_t)((m >> 11) * 4 + cc - 24) * S + (m & (S - 1))] = logsigmoidf_(acc[0][i][q] + p.b_forget[l * 4 + cc - 24]);
                    }
                }
            }
            continue;
        }
#pragma unroll
        for (int j = 0; j < 2; ++j) {
            const int nb = n0 + 64 * wn + 32 * j;
            const bool rope = ((nb & 63) == 0) && (nb < 512 || (nb >= C_KS && nb < C_VS) || (nb >= C_KW && nb < C_VW));
#pragma unroll
            for (int i = 0; i < 2; ++i) {
                f32x16 a = acc[j][i];
                if (rope) {
#pragma unroll
                    for (int q = 0; q < 4; ++q) { const float x1 = a[q], x2 = a[q + 4]; a[q] = x1 * rcs[i][q] - x2 * rsn[i][q]; a[q + 4] = x2 * rcs[i][q] + x1 * rsn[i][q]; }
                }
#pragma unroll
                for (int g = 0; g < 4; ++g) ctile_put(ct, 64 * wm + 32 * i + r, 64 * wn + 32 * j + 8 * g + 4 * h, a[4 * g], a[4 * g + 1], a[4 * g + 2], a[4 * g + 3]);
            }
        }
        bf16_t* ub = v.U + (size_t)m0 * NP + n0;
        ctile_flush<128>(ct, TIDX, [&](int row, int) { return ub + (size_t)row * NP; });
    }
}

DEV void ph_outproj_fast(const P& p, int l, unsigned char* lds) {
    const V v = make_views(p); const int TIDX = otid(), BIDX = obid();
    const bf16_t* W = (const bf16_t*)(p.ws + WS_WOT) + (size_t)l * D * D;
    const int lane = TIDX & 63, wave = TIDX >> 6, wm = wave >> 1, wn = wave & 1, r = lane & 31, h = lane >> 5;
    const bool xo = gridDim.x == 512;
    auto decode = [&](int it, int& mt, int& nt) -> bool {
        if (xo) { if (it >= 2) return false; const int lb = BIDX >> 3; nt = lb >> 3; mt = 16 * (BIDX & 7) + 8 * it + (lb & 7); return true; }
        const int unit = BIDX + it * (int)gridDim.x; if (unit >= 128 * 8) return false; nt = unit / 128; mt = unit % 128; return true;
    };
    auto issue = [&](int mt, int nt) {
        const bf16_t* ar[4];
#pragma unroll
        for (int i = 0; i < 4; ++i) ar[i] = v.O + (size_t)(mt * 128 + (TIDX >> 3) + 32 * i) * D;
        gemm_issue0(lds, ar, W + nt * 128, D, TIDX);
    };
    for (int it = 0;; ++it) {
        int nt, mt, ntn = 0, mtn = 0;
        if (!decode(it, mt, nt)) break;
        const bool hasn = decode(it + 1, mtn, ntn);
        const int m0 = mt * 128, n0 = nt * 128;
        const bf16_t* arow[4];
#pragma unroll
        for (int i = 0; i < 4; ++i) arow[i] = v.O + (size_t)(m0 + (TIDX >> 3) + 32 * i) * D;
        if (it == 0) { __syncthreads(); issue(mt, nt); }
        f32x4v xin[2][2][4];
#pragma unroll
        for (int j = 0; j < 2; ++j)
#pragma unroll
            for (int i = 0; i < 2; ++i)
#pragma unroll
                for (int g = 0; g < 4; ++g) xin[j][i][g] = *(const f32x4v*)(v.X + (size_t)(m0 + 64 * wm + 32 * i + r) * D + n0 + 64 * wn + 32 * j + 4 * h + 8 * g);
        f32x16 acc[2][2];
        gemm128<false, true>(lds, arow, W + n0, D, D, acc, TIDX);
        if (hasn) issue(mtn, ntn);
        const float* g1 = v.mod + (size_t)(l * 8 + (m0 >> 11)) * 6144 + 2 * D;
#pragma unroll
        for (int j = 0; j < 2; ++j)
#pragma unroll
            for (int i = 0; i < 2; ++i) {
                const int m = m0 + 64 * wm + 32 * i + r, nb = n0 + 64 * wn + 32 * j + 4 * h;
#pragma unroll
                for (int g = 0; g < 4; ++g) {
                    const float4 gg = *(const float4*)(g1 + nb + 8 * g);
                    f32x4v xo = xin[j][i][g];
                    xo[0] += gg.x * acc[j][i][4 * g]; xo[1] += gg.y * acc[j][i][4 * g + 1]; xo[2] += gg.z * acc[j][i][4 * g + 2]; xo[3] += gg.w * acc[j][i][4 * g + 3];
                    *(f32x4v*)(v.X + (size_t)m * D + nb + 8 * g) = xo;
                }
            }
    }
}

DEV void ph_moe_up_fast(const P& p, int l, unsigned char* lds) {
    const V v = make_views(p); const int TIDX = otid(), BIDX = obid();
    const int lane = TIDX & 63, wave = TIDX >> 6, wm = wave >> 1, wn = wave & 1, r = lane & 31, h = lane >> 5;
    const unsigned* cnt = v.ctl + CW_CNT + l * 32;
    int* tp = (int*)(lds + 67584); int* rb = tp + 40;
    __syncthreads();
    if (TIDX < 64) {
        const int c = TIDX < 32 ? (int)cnt[TIDX] : 0;
        int nu = ((c + 127) >> 7) * 8, cc = c;
#pragma unroll
        for (int o = 1; o < 32; o <<= 1) { const int a = __shfl_up(nu, o), b2 = __shfl_up(cc, o); if ((TIDX & 31) >= o) { nu += a; cc += b2; } }
        if (TIDX < 32) { tp[TIDX + 1] = nu; rb[TIDX + 1] = cc; if (TIDX == 0) { tp[0] = 0; rb[0] = 0; } }
    }
    __syncthreads();
    const int total = tp[32];
    unsigned char* ct = lds + 32768;
    struct UU { int e, base, nt, mt, nrow; const int* lst; const bf16_t* B; const bf16_t* ar[4]; };
    auto setup = [&](int unit, UU& u) {
        int e = 0;
#pragma unroll
        for (int st = 16; st > 0; st >>= 1) if (tp[e + st] <= unit) e += st;
        const int rem = unit - tp[e];
        u.e = e; u.base = rb[e]; u.nt = rem & 7; u.mt = rem >> 3;
        const int ce = rb[e + 1] - u.base;
        u.lst = v.list + (size_t)e * T + u.mt * 128;
        u.nrow = ce - u.mt * 128 < 128 ? ce - u.mt * 128 : 128;
        u.B = (const bf16_t*)(p.ws + WS_W13) + ((size_t)l * 32 + e) * 1024 * D + u.nt * 128;
#pragma unroll
        for (int i = 0; i < 4; ++i) { const int rr = (TIDX >> 3) + 32 * i; u.ar[i] = v.H + (size_t)(u.lst[rr < u.nrow ? rr : 0] >> 1) * D; }
    };
    int unit = BIDX;
    if (unit >= total) return;
    UU cu, nu;
    setup(unit, cu);
    __syncthreads();
    gemm_issue0(lds, cu.ar, cu.B, 1024, TIDX);
    for (;;) {
        const int un = unit + (int)gridDim.x;
        f32x16 acc[2][2];
        gemm128<false, true>(lds, cu.ar, cu.B, 1024, D, acc, TIDX);
        if (un < total) { setup(un, nu); gemm_issue0(lds, nu.ar, nu.B, 1024, TIDX); }
#pragma unroll
        for (int i = 0; i < 2; ++i)
#pragma unroll
            for (int g = 0; g < 4; ++g) {
                float o[4];
#pragma unroll
                for (int q = 0; q < 4; ++q) { const float a1 = acc[0][i][4 * g + q], a3 = acc[1][i][4 * g + q]; o[q] = a1 / (1.f + __expf(-a1)) * a3; }
                ctile_put(ct, 64 * wm + 32 * i + r, 32 * wn + 8 * g + 4 * h, o[0], o[1], o[2], o[3]);
            }
        bf16_t* hb = v.HID + (size_t)(cu.base + cu.mt * 128) * 512 + 64 * cu.nt;
        const int nrow = cu.nrow;
        ctile_flush<64>(ct, TIDX, [&](int row, int) { return row < nrow ? hb + (size_t)row * 512 : (bf16_t*)nullptr; });
        if (un >= total) break;
        unit = un; cu = nu;
    }
}
DEV void ph_moe_down_fast(const P& p, int l, unsigned char* lds) {
    const V v = make_views(p); const int TIDX = otid(), BIDX = obid();
    const int lane = TIDX & 63, wave = TIDX >> 6, wm = wave >> 1, wn = wave & 1, r = lane & 31, h = lane >> 5;
    const unsigned* cnt = v.ctl + CW_CNT + l * 32;
    int* tp = (int*)(lds + 67584); int* rb = tp + 40;
    __syncthreads();
    if (TIDX < 64) {
        const int c = TIDX < 32 ? (int)cnt[TIDX] : 0;
        int nu = ((c + 127) >> 7) * 8, cc = c;
#pragma unroll
        for (int o = 1; o < 32; o <<= 1) { const int a = __shfl_up(nu, o), b2 = __shfl_up(cc, o); if ((TIDX & 31) >= o) { nu += a; cc += b2; } }
        if (TIDX < 32) { tp[TIDX + 1] = nu; rb[TIDX + 1] = cc; if (TIDX == 0) { tp[0] = 0; rb[0] = 0; } }
    }
    __syncthreads();
    const int total = tp[32];
    unsigned char* ct = lds + 32768;
    struct UD { int n0, nrow; const bf16_t* B; const bf16_t* ar[4]; float wrow[2]; int fslot[8]; };
    auto setup = [&](int unit, UD& u) {
        int e = 0;
#pragma unroll
        for (int st = 16; st > 0; st >>= 1) if (tp[e + st] <= unit) e += st;
        const int rem = unit - tp[e], base = rb[e];
        const int ce = rb[e + 1] - base, nt = rem & 7, mt = rem >> 3;
        const int* lst = v.list + (size_t)e * T + mt * 128;
        u.n0 = nt * 128;
        u.nrow = ce - mt * 128 < 128 ? ce - mt * 128 : 128;
        u.B = (const bf16_t*)(p.ws + WS_W2) + ((size_t)l * 32 + e) * 512 * D + u.n0;
#pragma unroll
        for (int i = 0; i < 4; ++i) { const int rr = (TIDX >> 3) + 32 * i; u.ar[i] = v.HID + (size_t)(base + mt * 128 + (rr < u.nrow ? rr : 0)) * 512; }
#pragma unroll
        for (int i = 0; i < 2; ++i) { const int mr = 64 * wm + 32 * i + r; u.wrow[i] = mr < u.nrow ? v.wts[lst[mr]] : 0.f; }
#pragma unroll
        for (int it = 0; it < 8; ++it) { const int row = it * 16 + (TIDX >> 4); u.fslot[it] = row < u.nrow ? lst[row] : -1; }
    };
    int unit = BIDX;
    if (unit >= total) return;
    UD cu, nu;
    setup(unit, cu);
    __syncthreads();
    gemm_issue0(lds, cu.ar, cu.B, D, TIDX);
    for (;;) {
        const int un = unit + (int)gridDim.x;
        f32x16 acc[2][2];
        gemm128<false, true>(lds, cu.ar, cu.B, D, 512, acc, TIDX);
        if (un < total) { setup(un, nu); gemm_issue0(lds, nu.ar, nu.B, D, TIDX); }
#pragma unroll
        for (int i = 0; i < 2; ++i) {
            const int mr = 64 * wm + 32 * i + r;
            const float w = cu.wrow[i];
#pragma unroll
            for (int j = 0; j < 2; ++j)
#pragma unroll
                for (int g = 0; g < 4; ++g)
                    ctile_put(ct, mr, 64 * wn + 32 * j + 8 * g + 4 * h, w * acc[j][i][4 * g], w * acc[j][i][4 * g + 1], w * acc[j][i][4 * g + 2], w * acc[j][i][4 * g + 3]);
        }
        const int n0 = cu.n0;
        ctile_flush<128>(ct, TIDX, [&](int, int it) { const int sl = cu.fslot[it]; return sl >= 0 ? v.Y + (size_t)sl * D + n0 : (bf16_t*)nullptr; });
        if (un >= total) break;
        unit = un; cu = nu;
    }
}

constexpr float SB_EPS = 1e-12f;
constexpr float LOG2E = 1.4426950408889634f, C2 = 0.125f * 1.4426950408889634f, LN2 = 0.6931471805599453f;
DEV float fexp2(float x) { return __builtin_amdgcn_exp2f(x); }
DEV float flog2(float x) { return __builtin_amdgcn_logf(x); }
DEV int swap23(int r) { return (r & ~12) | ((r & 4) << 1) | ((r & 8) >> 1); }

struct KVT { const bf16_t* k; int ks; const bf16_t* v; int vs; };
DEV void kv_load(const KVT& s, int kv0, const int TIDX, u32x4 (&rg)[4]) {
    const int c = TIDX & 7, r0 = TIDX >> 3;
    rg[0] = *(const u32x4*)(s.k + (size_t)(kv0 + r0) * s.ks + c * 8);
    rg[1] = *(const u32x4*)(s.k + (size_t)(kv0 + r0 + 32) * s.ks + c * 8);
    rg[2] = *(const u32x4*)(s.v + (size_t)r0 * s.vs + kv0 + c * 8);
    rg[3] = *(const u32x4*)(s.v + (size_t)(r0 + 32) * s.vs + kv0 + c * 8);
}
DEV void kv_store(unsigned char* st, const int TIDX, const u32x4 (&rg)[4]) {
    const int c = TIDX & 7, r0 = TIDX >> 3;
    *(u32x4*)(st + tile_off(r0, c)) = rg[0]; *(u32x4*)(st + tile_off(r0 + 32, c)) = rg[1];
    *(u32x4*)(st + 8192 + tile_off(r0, c)) = rg[2]; *(u32x4*)(st + 8192 + tile_off(r0 + 32, c)) = rg[3];
}
DEV bf16x8 scale_frag(bf16x8 v, float sc) {
    u32x4 u = __builtin_bit_cast(u32x4, v);
#pragma unroll
    for (int i = 0; i < 4; ++i) u[i] = cvtpk(__uint_as_float(u[i] << 16) * sc, __uint_as_float(u[i] & 0xffff0000u) * sc);
    return __builtin_bit_cast(bf16x8, u);
}
DEV float xhalf(float x) {
    const auto s = __builtin_amdgcn_permlane32_swap(__float_as_uint(x), __float_as_uint(x), false, false);
    return __uint_as_float((threadIdx.x & 32) ? s[0] : s[1]);
}
DEV float xhalf_max(float x) {
    const auto s = __builtin_amdgcn_permlane32_swap(__float_as_uint(x), __float_as_uint(x), false, false);
    return fmaxf(__uint_as_float(s[0]), __uint_as_float(s[1]));
}
DEV float xhalf_sum(float x) {
    const auto s = __builtin_amdgcn_permlane32_swap(__float_as_uint(x), __float_as_uint(x), false, false);
    return __uint_as_float(s[0]) + __uint_as_float(s[1]);
}
#define SB0() __builtin_amdgcn_sched_barrier(0)
DEV void score_tile(const unsigned char* Kt, const bf16x8 (&qf)[4], int r, int h, f32x16 (&p)[2]) {
    const int kr = swap23(r);
    const unsigned char* kb = Kt + tile_off(kr, h);
    auto ld = [&](int i) { const int blk = i & 1, s = i >> 1; return *(const bf16x8*)(Kt + tile_off(32 * blk + kr, 2 * s + h)); };
    (void)kb;
    f32x16 z;
#pragma unroll
    for (int q = 0; q < 16; ++q) z[q] = 0.f;
    bf16x8 f0 = ld(0), f1 = ld(1), f2 = ld(2), f3 = ld(3);
    SB0();
    p[0] = __builtin_amdgcn_mfma_f32_32x32x16_bf16(f0, qf[0], z, 0, 0, 0); f0 = ld(4); SB0();
    p[1] = __builtin_amdgcn_mfma_f32_32x32x16_bf16(f1, qf[0], z, 0, 0, 0); f1 = ld(5); SB0();
    p[0] = __builtin_amdgcn_mfma_f32_32x32x16_bf16(f2, qf[1], p[0], 0, 0, 0); f2 = ld(6); SB0();
    p[1] = __builtin_amdgcn_mfma_f32_32x32x16_bf16(f3, qf[1], p[1], 0, 0, 0); f3 = ld(7); SB0();
    p[0] = __builtin_amdgcn_mfma_f32_32x32x16_bf16(f0, qf[2], p[0], 0, 0, 0); SB0();
    p[1] = __builtin_amdgcn_mfma_f32_32x32x16_bf16(f1, qf[2], p[1], 0, 0, 0); SB0();
    p[0] = __builtin_amdgcn_mfma_f32_32x32x16_bf16(f2, qf[3], p[0], 0, 0, 0); SB0();
    p[1] = __builtin_amdgcn_mfma_f32_32x32x16_bf16(f3, qf[3], p[1], 0, 0, 0); SB0();
}
DEV void pv_tile(const unsigned char* Vt, const f32x16 (&p)[2], int r, int h, f32x16 (&o)[2]) {
    auto ld = [&](int i) { const int db = i & 1, pr = i >> 1; return *(const bf16x8*)(Vt + tile_off(32 * db + r, 2 * pr + h)); };
    auto pk = [&](int pr) {
        const int blk = pr >> 1, s = pr & 1;
        u32x4 w;
        w.x = cvtpk(p[blk][8 * s], p[blk][8 * s + 1]); w.y = cvtpk(p[blk][8 * s + 2], p[blk][8 * s + 3]);
        w.z = cvtpk(p[blk][8 * s + 4], p[blk][8 * s + 5]); w.w = cvtpk(p[blk][8 * s + 6], p[blk][8 * s + 7]);
        return __builtin_bit_cast(bf16x8, w);
    };
    bf16x8 f0 = ld(0), f1 = ld(1), f2 = ld(2), f3 = ld(3);
    SB0();
    bf16x8 pb = pk(0);
    SB0();
    o[0] = __builtin_amdgcn_mfma_f32_32x32x16_bf16(f0, pb, o[0], 0, 0, 0); f0 = ld(4); SB0();
    o[1] = __builtin_amdgcn_mfma_f32_32x32x16_bf16(f1, pb, o[1], 0, 0, 0); f1 = ld(5); pb = pk(1); SB0();
    o[0] = __builtin_amdgcn_mfma_f32_32x32x16_bf16(f2, pb, o[0], 0, 0, 0); f2 = ld(6); SB0();
    o[1] = __builtin_amdgcn_mfma_f32_32x32x16_bf16(f3, pb, o[1], 0, 0, 0); f3 = ld(7); pb = pk(2); SB0();
    o[0] = __builtin_amdgcn_mfma_f32_32x32x16_bf16(f0, pb, o[0], 0, 0, 0); SB0();
    o[1] = __builtin_amdgcn_mfma_f32_32x32x16_bf16(f1, pb, o[1], 0, 0, 0); pb = pk(3); SB0();
    o[0] = __builtin_amdgcn_mfma_f32_32x32x16_bf16(f2, pb, o[0], 0, 0, 0); SB0();
    o[1] = __builtin_amdgcn_mfma_f32_32x32x16_bf16(f3, pb, o[1], 0, 0, 0); SB0();
}

template <int VAR>
DEV void attn_branch(unsigned char* lds, const KVT& src, const bf16x8 (&qf)[4], unsigned tmask, int wave_last, int t, int t_first,
                     unsigned selbits, const float* bias2, f32x16 (&o)[2], const int TIDX) {
    const int lane = TIDX & 63, r = lane & 31, h = lane >> 5;
    const float NEG_INF = -__builtin_inff();
    float mrun = -1e30f, lrun = 0.f, rest = VAR == 3 ? 1.f : 0.f;
#pragma unroll
    for (int db = 0; db < 2; ++db)
#pragma unroll
        for (int q = 0; q < 16; ++q) o[db][q] = 0.f;
    u32x4 rg[4];
    unsigned rem = tmask;
    unsigned wdone = 0u; int step = 0;
    volatile unsigned* sbf = (volatile unsigned*)(lds + 65536);
    int j = VAR == 3 ? 31 - __builtin_clz(rem) : __builtin_ctz(rem);
    rem &= ~(1u << j);
    kv_load(src, 64 * j, TIDX, rg);
    __syncthreads();
    kv_store(lds, TIDX, rg);
    __syncthreads();
    int stage = 0;
    for (;;) {
        int jn = -1;
        if (rem) { jn = VAR == 3 ? 31 - __builtin_clz(rem) : __builtin_ctz(rem); rem &= ~(1u << jn); kv_load(src, 64 * jn, TIDX, rg); }
        asm volatile("" ::: "memory"); __builtin_amdgcn_sched_barrier(0);
        if (j <= wave_last) {
            const unsigned char* Kt = lds + stage * 16384;
            f32x16 p[2];
            score_tile(Kt, qf, r, h, p);
            const int kvb = 64 * j + 8 * h;
            if (VAR == 3) {
                const bool diag = 64 * j + 63 >= t_first;
                float gt[2][2];
                if (diag) {
#pragma unroll
                    for (int blk = 0; blk < 2; ++blk)
#pragma unroll
                        for (int s = 0; s < 2; ++s) {
                            float run = 1.f;
#pragma unroll
                            for (int q = 7; q >= 0; --q) {
                                const float ez = fexp2(p[blk][8 * s + q]);
                                float w = __builtin_amdgcn_rcpf(1.f + ez);
                                float beta = 1.f - w;
                                const bool valid = kvb + 32 * blk + 16 * s + q < t;
                                w = valid ? w : 1.f; beta = valid ? beta : 0.f;
                                p[blk][8 * s + q] = beta * run;
                                run *= w;
                            }
                            gt[blk][s] = run;
                        }
                } else {
#pragma unroll
                    for (int blk = 0; blk < 2; ++blk)
#pragma unroll
                        for (int s = 0; s < 2; ++s) {
                            float run = 1.f;
#pragma unroll
                            for (int q = 7; q >= 0; --q) {
                                const float rn = run * __builtin_amdgcn_rcpf(1.f + fexp2(p[blk][8 * s + q]));
                                p[blk][8 * s + q] = run - rn;
                                run = rn;
                            }
                            gt[blk][s] = run;
                        }
                }
                float og[2][2], pt[2][2];
#pragma unroll
                for (int blk = 0; blk < 2; ++blk)
#pragma unroll
                    for (int s = 0; s < 2; ++s) { og[blk][s] = xhalf(gt[blk][s]); pt[blk][s] = gt[blk][s] * og[blk][s]; }
                float above = rest;
#pragma unroll
                for (int pi = 3; pi >= 0; --pi) {
                    const int blk = pi >> 1, s = pi & 1;
                    const float carry = above * (h == 0 ? og[blk][s] : 1.f);
#pragma unroll
                    for (int q = 0; q < 8; ++q) p[blk][8 * s + q] *= carry;
                    above *= pt[blk][s];
                }
                rest = above;
                wdone = __all(rest < SB_EPS) ? 1u : 0u;
            } else {
                const bool need_causal = 64 * j + 63 > t_first;
                const bool need_win = VAR == 1 && (64 * j + 512 <= t_first + 31);
                const bool lane_on = VAR != 0 || ((selbits >> j) & 1u);
                if (VAR == 2) {
#pragma unroll
                    for (int blk = 0; blk < 2; ++blk)
#pragma unroll
                        for (int s = 0; s < 2; ++s) {
                            const float4 b0 = *(const float4*)(bias2 + kvb + 32 * blk + 16 * s), b1 = *(const float4*)(bias2 + kvb + 32 * blk + 16 * s + 4);
                            p[blk][8 * s] += b0.x; p[blk][8 * s + 1] += b0.y; p[blk][8 * s + 2] += b0.z; p[blk][8 * s + 3] += b0.w;
                            p[blk][8 * s + 4] += b1.x; p[blk][8 * s + 5] += b1.y; p[blk][8 * s + 6] += b1.z; p[blk][8 * s + 7] += b1.w;
                        }
                }
                if (need_causal) {
#pragma unroll
                    for (int blk = 0; blk < 2; ++blk)
#pragma unroll
                        for (int q = 0; q < 16; ++q) { const int kv = kvb + 32 * blk + 16 * (q >> 3) + (q & 7); p[blk][q] = kv <= t ? p[blk][q] : NEG_INF; }
                }
                if (need_win) {
#pragma unroll
                    for (int blk = 0; blk < 2; ++blk)
#pragma unroll
                        for (int q = 0; q < 16; ++q) { const int kv = kvb + 32 * blk + 16 * (q >> 3) + (q & 7); p[blk][q] = kv + 512 > t ? p[blk][q] : NEG_INF; }
                }
                float tmax = p[0][0];
#pragma unroll
                for (int q = 1; q < 16; ++q) tmax = fmaxf(tmax, p[0][q]);
#pragma unroll
                for (int q = 0; q < 16; ++q) tmax = fmaxf(tmax, p[1][q]);
                tmax = lane_on ? tmax : NEG_INF;
                tmax = xhalf_max(tmax);
                const float mnew = fmaxf(mrun, tmax);
                const bool grew = mnew > mrun;
                const float alpha = fexp2(mrun - mnew);
                mrun = mnew;
                const float msub = lane_on ? mnew : __builtin_inff();
                const f32x2_t ms2 = {msub, msub};
                f32x2_t ls2 = {0.f, 0.f};
#pragma unroll
                for (int blk = 0; blk < 2; ++blk)
#pragma unroll
                    for (int q = 0; q < 16; q += 2) {
                        const f32x2_t d2 = (f32x2_t){p[blk][q], p[blk][q + 1]} - ms2;
                        f32x2_t e2; e2.x = fexp2(d2.x); e2.y = fexp2(d2.y);
                        p[blk][q] = e2.x; p[blk][q + 1] = e2.y; ls2 += e2;
                    }
                lrun = lrun * alpha + (ls2.x + ls2.y);
                if (__any(grew)) {
#pragma unroll
                    for (int db = 0; db < 2; ++db)
#pragma unroll
                        for (int q = 0; q < 16; ++q) o[db][q] *= alpha;
                }
            }
            pv_tile(Kt + 8192, p, r, h, o);
        }
        if (jn >= 0) kv_store(lds + (stage ^ 1) * 16384, TIDX, rg);
        if (VAR == 3 && lane == 0) sbf[(step & 1) * 4 + (TIDX >> 6)] = wdone;
        __syncthreads();
        if (jn < 0) break;
        if (VAR == 3) {
            const unsigned* f4 = (const unsigned*)sbf + (step & 1) * 4;
            if ((f4[0] & f4[1] & f4[2] & f4[3]) != 0u) break;
            ++step;
        }
        j = jn; stage ^= 1;
    }
    if (VAR != 3) {
        const float lt = xhalf_sum(lrun);
        const float inv = lt > 0.f ? 1.f / lt : 0.f;
#pragma unroll
        for (int db = 0; db < 2; ++db)
#pragma unroll
            for (int q = 0; q < 16; ++q) o[db][q] *= inv;
    }
}

DEV void head_norm_store(const f32x16 (&o)[2], const float* gam, bf16_t* dst, int h) {
    float ss = 0.f;
#pragma unroll
    for (int db = 0; db < 2; ++db)
#pragma unroll
        for (int q = 0; q < 16; ++q) ss += o[db][q] * o[db][q];
    ss += __shfl_xor(ss, 32);
    const float rinv = rsqrtf(ss * (1.f / 64.f) + EPS);
#pragma unroll
    for (int db = 0; db < 2; ++db)
#pragma unroll
        for (int g = 0; g < 4; ++g) {
            const int d = 32 * db + 8 * g + 4 * h;
            const float4 gg = *(const float4*)(gam + d);
            uint2 u;
            u.x = cvtpk(o[db][4 * g] * rinv * gg.x, o[db][4 * g + 1] * rinv * gg.y);
            u.y = cvtpk(o[db][4 * g + 2] * rinv * gg.z, o[db][4 * g + 3] * rinv * gg.w);
            *(uint2*)(dst + d) = u;
        }
}

template <int VAR>
DEV void mha_unit(const P& p, int l, int unit, unsigned char* lds) {
    const V v = make_views(p); const int TIDX = otid();
    const int lane = TIDX & 63, wave = TIDX >> 6, r = lane & 31, h = lane >> 5;
    const int qb = 15 - (unit >> 5), bh = unit & 31, b = bh >> 2, hh = bh & 3;
    const int t0 = qb * 128, tw = t0 + 32 * wave, t = tw + r, m = b * S + t;
    const int qcol = VAR == 2 ? C_QB : C_QC, kcol = VAR == 2 ? C_KB : C_KCC, vrow = VAR == 2 ? 256 : 512, ocol = VAR == 2 ? 512 : 768;
    bf16x8 qf[4];
#pragma unroll
    for (int s = 0; s < 4; ++s) qf[s] = scale_frag(*(const bf16x8*)(v.U + (size_t)m * NP + qcol + hh * 64 + 16 * s + 8 * h), C2);
    KVT src;
    src.k = v.U + (size_t)b * S * NP + kcol + hh * 64; src.ks = NP;
    src.v = (const bf16_t*)(p.ws + WS_VT) + (size_t)(b * 768 + vrow + hh * 64) * S; src.vs = S;
    const int last = (t0 + 127) >> 6;
    const unsigned tmask = last == 31 ? 0xffffffffu : ((1u << (last + 1)) - 1u);
    const float* bias2 = (const float*)(lds + 32768);
    if (VAR == 2) {
        float* cf = (float*)(lds + 32768);
        float* wt = (float*)(lds + 32768 + 8192);
        const float* lsf = (const float*)(p.ws + WS_LSF) + (size_t)(b * 4 + hh) * S;
        const int nel = t0 + 128;
        float x[8];
        if (8 * TIDX < nel) {
            const float4 a0 = *(const float4*)(lsf + 8 * TIDX), a1 = *(const float4*)(lsf + 8 * TIDX + 4);
            x[0] = a0.x; x[1] = x[0] + a0.y; x[2] = x[1] + a0.z; x[3] = x[2] + a0.w; x[4] = x[3] + a1.x; x[5] = x[4] + a1.y; x[6] = x[5] + a1.z; x[7] = x[6] + a1.w;
        } else {
#pragma unroll
            for (int q = 0; q < 8; ++q) x[q] = 0.f;
        }
        float inc = x[7];
#pragma unroll
        for (int o = 1; o < 64; o <<= 1) { const float tt = __shfl_up(inc, o); if (lane >= o) inc += tt; }
        __syncthreads();
        if (lane == 63) wt[wave] = inc;
        __syncthreads();
        float off = inc - x[7];
#pragma unroll
        for (int w = 0; w < 3; ++w) off += (w < wave) ? wt[w] : 0.f;
        if (8 * TIDX < nel) {
#pragma unroll
            for (int q = 0; q < 8; ++q) cf[8 * TIDX + q] = -(x[q] + off) * LOG2E;
        }
        __syncthreads();
    }
    f32x16 o[2];
    attn_branch<VAR>(lds, src, qf, tmask, (tw + 31) >> 6, t, tw, 0u, bias2, o, TIDX);
    head_norm_store(o, p.out_norm_g + (size_t)l * D + ocol + hh * 64, v.O + (size_t)m * D + ocol + hh * 64, h);
}

DEV void nsa_unit(const P& p, int l, int unit, unsigned char* lds) {
    const V v = make_views(p); const int TIDX = otid();
    const int lane = TIDX & 63, wave = TIDX >> 6, r = lane & 31, h = lane >> 5;
    const int qblk = 63 - (unit >> 4), bg = unit & 15, b = bg >> 1, g = bg & 1;
    const int t0 = qblk * 32, t = t0 + r, m = b * S + t, head = g * 4 + wave, cur = t0 >> 6;
    const float NEG_INF = -__builtin_inff();
    bf16x8 qf[4];
#pragma unroll
    for (int s = 0; s < 4; ++s) qf[s] = scale_frag(*(const bf16x8*)(v.U + (size_t)m * NP + C_QA + head * 64 + 16 * s + 8 * h), C2);
    const float g0 = sigmoidf_(v.gf[(size_t)m * 32 + head * 3]), g1 = sigmoidf_(v.gf[(size_t)m * 32 + head * 3 + 1]), g2 = sigmoidf_(v.gf[(size_t)m * 32 + head * 3 + 2]);
    f32x16 otot[2];
    float* PA = (float*)(lds + 32768);
    float* PB = (float*)(lds + 49152);
    float* SC = (float*)lds;
    unsigned* MASK = (unsigned*)(lds + 8192);
    {
        const bf16_t* ck = v.ck + (size_t)(b * 2 + g) * 128 * 64;
        const bf16_t* cvt = (const bf16_t*)(p.ws + WS_CVT) + (size_t)(b * 2 + g) * 64 * 128;
        const int c = TIDX & 7, r0 = TIDX >> 3;
        u32x4 rk[4], rv[4];
#pragma unroll
        for (int i = 0; i < 4; ++i) rk[i] = *(const u32x4*)(ck + (size_t)(r0 + 32 * i) * 64 + c * 8);
#pragma unroll
        for (int i = 0; i < 4; ++i) rv[i] = *(const u32x4*)(cvt + (size_t)(r0 + 32 * (i & 1)) * 128 + 64 * (i >> 1) + c * 8);
        __syncthreads();
#pragma unroll
        for (int i = 0; i < 4; ++i) *(u32x4*)(lds + tile_off(r0 + 32 * i, c)) = rk[i];
#pragma unroll
        for (int i = 0; i < 4; ++i) *(u32x4*)(lds + 16384 + 8192 * (i >> 1) + tile_off(r0 + 32 * (i & 1), c)) = rv[i];
        __syncthreads();
        f32x16 ps[2][2];
        score_tile(lds, qf, r, h, ps[0]);
        score_tile(lds + 8192, qf, r, h, ps[1]);
        const int nvalid = t >= 31 ? (t - 31) / 16 + 1 : 0;
        float mx = NEG_INF;
#pragma unroll
        for (int tt = 0; tt < 2; ++tt)
#pragma unroll
            for (int blk = 0; blk < 2; ++blk)
#pragma unroll
                for (int q = 0; q < 16; ++q) {
                    const int n = 64 * tt + 32 * blk + 16 * (q >> 3) + 8 * h + (q & 7);
                    const float x = n < nvalid ? ps[tt][blk][q] : NEG_INF;
                    ps[tt][blk][q] = x; mx = fmaxf(mx, x);
                }
        mx = fmaxf(mx, __shfl_xor(mx, 32));
        const float mxs = nvalid > 0 ? mx : 0.f;
        float ls = 0.f;
#pragma unroll
        for (int tt = 0; tt < 2; ++tt)
#pragma unroll
            for (int blk = 0; blk < 2; ++blk)
#pragma unroll
                for (int q = 0; q < 16; ++q) { const float e = fexp2(ps[tt][blk][q] - mxs); ps[tt][blk][q] = e; ls += e; }
        const float lt = ls + __shfl_xor(ls, 32);
        const float inv = lt > 0.f ? 1.f / lt : 0.f;
#pragma unroll
        for (int tt = 0; tt < 2; ++tt)
#pragma unroll
            for (int blk = 0; blk < 2; ++blk) {
#pragma unroll
                for (int q = 0; q < 16; ++q) ps[tt][blk][q] *= inv;
#pragma unroll
                for (int s = 0; s < 2; ++s) {
                    const int G0 = 16 * tt + 8 * blk + 4 * s + 2 * h;
                    const float a0 = (ps[tt][blk][8 * s] + ps[tt][blk][8 * s + 1]) + (ps[tt][blk][8 * s + 2] + ps[tt][blk][8 * s + 3]);
                    const float a1 = (ps[tt][blk][8 * s + 4] + ps[tt][blk][8 * s + 5]) + (ps[tt][blk][8 * s + 6] + ps[tt][blk][8 * s + 7]);
                    PA[(wave * 32 + G0) * 32 + r] = a0; PA[(wave * 32 + G0 + 1) * 32 + r] = a1;
                    PB[(wave * 32 + G0 + 1) * 32 + r] = ps[tt][blk][8 * s + 3];
                    if (G0 + 2 < 32) PB[(wave * 32 + G0 + 2) * 32 + r] = ps[tt][blk][8 * s + 7];
                }
            }
        f32x16 oc[2];
#pragma unroll
        for (int db = 0; db < 2; ++db)
#pragma unroll
            for (int q = 0; q < 16; ++q) oc[db][q] = 0.f;
        pv_tile(lds + 16384, ps[0], r, h, oc);
        pv_tile(lds + 24576, ps[1], r, h, oc);
#pragma unroll
        for (int db = 0; db < 2; ++db)
#pragma unroll
            for (int q = 0; q < 16; ++q) otot[db][q] = g0 * oc[db][q];
    }
    __syncthreads();
    const bool need_topk = cur > 15;
    if (need_topk) {
        const int q = TIDX & 31, j0 = (TIDX >> 5) * 4;
#pragma unroll
        for (int jj = 0; jj < 4; ++jj) {
            const int j = j0 + jj;
            float sc = 0.f;
#pragma unroll
            for (int w = 0; w < 4; ++w) sc += PA[(w * 32 + j) * 32 + q];
            if (j > 0) {
#pragma unroll
                for (int w = 0; w < 4; ++w) sc += PB[(w * 32 + j) * 32 + q];
            }
            const bool forced = (j == 0) || (j == cur) || (j == cur - 1);
            SC[q * 33 + j] = forced ? 1.0e4f : (j <= cur ? sc : -1.0f);
        }
        if (TIDX < 32) MASK[TIDX] = 0u;
        __syncthreads();
        unsigned bits = 0u;
#pragma unroll
        for (int jj = 0; jj < 4; ++jj) {
            const int j = j0 + jj;
            const float vj = SC[q * 33 + j];
            int rank = 0;
#pragma unroll
            for (int i = 0; i < 32; ++i) { const float vi = SC[q * 33 + i]; rank += (vi > vj || (vi == vj && i < j)) ? 1 : 0; }
            if (rank < 16) bits |= 1u << j;
        }
        atomicOr(&MASK[q], bits);
        __syncthreads();
    }
    const unsigned upto = (2u << cur) - 1u;
    unsigned mybits = upto, um = upto;
    if (need_topk) {
        mybits = MASK[r];
        um = 0u;
#pragma unroll
        for (int i = 0; i < 32; ++i) um |= MASK[i];
        um = (unsigned)__builtin_amdgcn_readfirstlane((int)um);
    }
    {
        KVT src; src.k = v.U + (size_t)b * S * NP + C_KS + g * 64; src.ks = NP;
        src.v = (const bf16_t*)(p.ws + WS_VT) + (size_t)(b * 768 + g * 64) * S; src.vs = S;
        f32x16 o[2];
        attn_branch<0>(lds, src, qf, um & upto, cur, t, t0, mybits, nullptr, o, TIDX);
#pragma unroll
        for (int db = 0; db < 2; ++db)
#pragma unroll
            for (int q = 0; q < 16; ++q) otot[db][q] += g1 * o[db][q];
    }
    {
        KVT src; src.k = v.U + (size_t)b * S * NP + C_KW + g * 64; src.ks = NP;
        src.v = (const bf16_t*)(p.ws + WS_VT) + (size_t)(b * 768 + 128 + g * 64) * S; src.vs = S;
        const int f = (t0 - 511 > 0 ? t0 - 511 : 0) >> 6;
        const unsigned wmask = upto & ~((1u << f) - 1u);
        f32x16 o[2];
        attn_branch<1>(lds, src, qf, wmask, cur, t, t0, 0u, nullptr, o, TIDX);
#pragma unroll
        for (int db = 0; db < 2; ++db)
#pragma unroll
            for (int q = 0; q < 16; ++q) otot[db][q] += g2 * o[db][q];
    }
    head_norm_store(otot, p.out_norm_g + (size_t)l * D + head * 64, v.O + (size_t)m * D + head * 64, h);
}

constexpr int CW_CMPK = 12288;
DEV bool cmp_unit(const P& p, int l, int unit, int kq, unsigned char* lds, volatile LAS unsigned* qslot) {
    const V v = make_views(p); const int TIDX = otid();
    const int lane = TIDX & 63, wave = TIDX >> 6, wm = wave >> 1, wn = wave & 1, r = lane & 31, h = lane >> 5;
    const int kv = unit & 1, bg = unit >> 1, b = bg >> 1, g = bg & 1, lk = l * 2 + kv;
    const int col = (kv ? C_VC : C_KC) + g * 64;
    const bf16_t* arow[4];
#pragma unroll
    for (int i = 0; i < 4; ++i) { const int n = (TIDX >> 3) + 32 * i; arow[i] = v.U + (size_t)(b * S + 16 * (n < 127 ? n : 126) + 8 * kq) * NP + col; }
    f32x16 acc[2][2];
    gemm128<false>(lds, arow, (const bf16_t*)(p.ws + WS_CW1) + (size_t)lk * 2048 * 128 + (size_t)kq * 512 * 128, 128, 512, acc, TIDX, NP);
    {
        const __amdgpu_buffer_rsrc_t prs = __builtin_amdgcn_make_buffer_rsrc((void*)v.OB, (short)0, 32 * 4 * 65536, 0x00020000);
        const unsigned pbase = (unsigned)(unit * 4 + kq) * 65536u + (unsigned)TIDX * 16u;
#pragma unroll
        for (int j = 0; j < 2; ++j)
#pragma unroll
            for (int i = 0; i < 2; ++i)
#pragma unroll
                for (int g4 = 0; g4 < 4; ++g4) {
                    const f32x4v a = {acc[j][i][4 * g4], acc[j][i][4 * g4 + 1], acc[j][i][4 * g4 + 2], acc[j][i][4 * g4 + 3]};
                    __builtin_amdgcn_raw_buffer_store_b128(__builtin_bit_cast(u32x4, a), prs, pbase + (unsigned)((j * 2 + i) * 4 + g4) * 4096u, 0,   16);
                }
        asm volatile("s_waitcnt vmcnt(0)" ::: "memory");
        __syncthreads();
        if (TIDX == 0) *qslot = __hip_atomic_fetch_add(v.ctl + CW_CMPK + l * 32 + unit, 1u, __ATOMIC_RELAXED, __HIP_MEMORY_SCOPE_AGENT);
        __syncthreads();
        if (*qslot != 3u) return false;
        if (TIDX == 0) { __builtin_amdgcn_fence(__ATOMIC_ACQUIRE, "agent"); asm volatile("s_waitcnt vmcnt(0)" ::: "memory"); }
        __syncthreads();
        const float* pp = v.OB + (size_t)unit * 4 * 16384 + TIDX * 4;
#pragma unroll
        for (int j = 0; j < 2; ++j)
#pragma unroll
            for (int i = 0; i < 2; ++i)
#pragma unroll
                for (int g4 = 0; g4 < 4; ++g4) {
                    const float* q0 = pp + ((j * 2 + i) * 4 + g4) * 1024;
                    f32x4v a = *(const f32x4v*)q0;
#pragma unroll
                    for (int k2 = 1; k2 < 4; ++k2) { const f32x4v b2 = *(const f32x4v*)(q0 + k2 * 16384); a += b2; }
                    acc[j][i][4 * g4] = a[0]; acc[j][i][4 * g4 + 1] = a[1]; acc[j][i][4 * g4 + 2] = a[2]; acc[j][i][4 * g4 + 3] = a[3];
                }
    }
    const float* pb = (const float*)(p.ws + WS_CPB) + lk * 8 * 128;
#pragma unroll
    for (int j = 0; j < 2; ++j)
#pragma unroll
        for (int i = 0; i < 2; ++i) {
            const int mrow = 64 * wm + 32 * i + r;
#pragma unroll
            for (int g4 = 0; g4 < 4; ++g4) {
                float4 bb = *(const float4*)(pb + 64 * wn + 32 * j + 8 * g4 + 4 * h);
#pragma unroll
                for (int c8 = 1; c8 < 8; ++c8) { const float4 b2 = *(const float4*)(pb + c8 * 128 + 64 * wn + 32 * j + 8 * g4 + 4 * h); bb.x += b2.x; bb.y += b2.y; bb.z += b2.z; bb.w += b2.w; }
                float x0 = acc[j][i][4 * g4] + bb.x, x1 = acc[j][i][4 * g4 + 1] + bb.y, x2 = acc[j][i][4 * g4 + 2] + bb.z, x3 = acc[j][i][4 * g4 + 3] + bb.w;
                x0 = x0 / (1.f + __expf(-x0)); x1 = x1 / (1.f + __expf(-x1)); x2 = x2 / (1.f + __expf(-x2)); x3 = x3 / (1.f + __expf(-x3));
                uint2 u; u.x = cvtpk(x0, x1); u.y = cvtpk(x2, x3);
                *(uint2*)(lds + wn * 16384 + tile_off(mrow, 4 * j + g4) + 8 * h) = u;
            }
        }
    {
        const bf16_t* w2 = (const bf16_t*)(p.ws + WS_CW2) + (size_t)lk * 64 * 128;
        const int c = TIDX & 7, r0 = TIDX >> 3;
#pragma unroll
        for (int i = 0; i < 4; ++i) {
            const int row = r0 + 32 * (i & 1), kt = i >> 1;
            *(u32x4*)(lds + 32768 + kt * 8192 + tile_off(row, c)) = *(const u32x4*)(w2 + (size_t)row * 128 + kt * 64 + c * 8);
        }
    }
    __syncthreads();
    f32x16 a2[2];
#pragma unroll
    for (int db = 0; db < 2; ++db)
#pragma unroll
        for (int q = 0; q < 16; ++q) a2[db][q] = 0.f;
#pragma unroll
    for (int kt = 0; kt < 2; ++kt)
#pragma unroll
        for (int s = 0; s < 4; ++s) {
            const bf16x8 hf = *(const bf16x8*)(lds + kt * 16384 + tile_off(32 * wave + r, 2 * s + h));
#pragma unroll
            for (int db = 0; db < 2; ++db) {
                const bf16x8 wf = *(const bf16x8*)(lds + 32768 + kt * 8192 + tile_off(32 * db + r, 2 * s + h));
                a2[db] = __builtin_amdgcn_mfma_f32_32x32x16_bf16(wf, hf, a2[db], 0, 0, 0);
            }
        }
    const int n = 32 * wave + r;
    if (kv == 0 && n < 127) {
        const int pos = 16 * n + 31;
#pragma unroll
        for (int q = 0; q < 4; ++q) {
            const float cs = v.rcos[pos * 8 + q + 4 * h], sn = v.rsin[pos * 8 + q + 4 * h];
            const float x1 = a2[0][q], x2 = a2[0][q + 4];
            a2[0][q] = x1 * cs - x2 * sn; a2[0][q + 4] = x2 * cs + x1 * sn;
        }
    }
    bf16_t* dst = (kv ? v.cv : v.ck) + ((size_t)bg * 128 + n) * 64;
    bf16_t* dt = (bf16_t*)(p.ws + WS_CVT) + (size_t)bg * 64 * 128 + n;
#pragma unroll
    for (int db = 0; db < 2; ++db)
#pragma unroll
        for (int g4 = 0; g4 < 4; ++g4) {
            const int d = 32 * db + 8 * g4 + 4 * h;
            float x0 = a2[db][4 * g4], x1 = a2[db][4 * g4 + 1], x2 = a2[db][4 * g4 + 2], x3 = a2[db][4 * g4 + 3];
            if (n >= 127) { x0 = 0.f; x1 = 0.f; x2 = 0.f; x3 = 0.f; }
            uint2 u; u.x = cvtpk(x0, x1); u.y = cvtpk(x2, x3);
            *(uint2*)(dst + d) = u;
            if (kv) { dt[(size_t)d * 128] = (bf16_t)(u.x & 0xffffu); dt[(size_t)(d + 1) * 128] = (bf16_t)(u.x >> 16); dt[(size_t)(d + 2) * 128] = (bf16_t)(u.y & 0xffffu); dt[(size_t)(d + 3) * 128] = (bf16_t)(u.y >> 16); }
        }
    __syncthreads();
    return true;
}

typedef float f32x4m __attribute__((ext_vector_type(4)));
DEV void ph_norm2_router_fast(const P& p, int l, unsigned char* lds) {
    const V v = make_views(p); const int TIDX = otid(), BIDX = obid();
    const int lane = TIDX & 63, wave = TIDX >> 6;
    const bf16_t* wr = (const bf16_t*)(p.ws + WS_WR) + (size_t)l * 2 * 64 * D;
    float* LG = (float*)(lds + 65536);
    for (int blk = BIDX; blk < T / 16; blk += gridDim.x) {
        const int m0 = blk * 16, b = m0 >> 11;
        const float* md = v.mod + (size_t)(l * 8 + b) * 6144;
        float4 xv[4][4]; float ssq[4];
#pragma unroll
        for (int rr = 0; rr < 4; ++rr)
#pragma unroll
            for (int j = 0; j < 4; ++j) xv[rr][j] = *(const float4*)(v.X + (size_t)(m0 + wave * 4 + rr) * D + 4 * lane + 256 * j);
#pragma unroll
        for (int rr = 0; rr < 4; ++rr) {
            ssq[rr] = 0.f;
#pragma unroll
            for (int j = 0; j < 4; ++j) ssq[rr] += xv[rr][j].x * xv[rr][j].x + xv[rr][j].y * xv[rr][j].y + xv[rr][j].z * xv[rr][j].z + xv[rr][j].w * xv[rr][j].w;
        }
#pragma unroll
        for (int o = 1; o < 64; o <<= 1) {
#pragma unroll
            for (int rr = 0; rr < 4; ++rr) ssq[rr] += __shfl_xor(ssq[rr], o);
        }
#pragma unroll
        for (int rr = 0; rr < 4; ++rr) {
            const int row = wave * 4 + rr, m = m0 + row;
            const float rs = rsqrtf(ssq[rr] * (1.f / D) + EPS);
#pragma unroll
            for (int j = 0; j < 4; ++j) {
                const int c = 4 * lane + 256 * j;
                const float4 g = *(const float4*)(p.norm2_g + l * D + c), sh = *(const float4*)(md + 3 * D + c), sc = *(const float4*)(md + 4 * D + c);
                const float h0 = xv[rr][j].x * rs * g.x * (1.f + sc.x) + sh.x, h1 = xv[rr][j].y * rs * g.y * (1.f + sc.y) + sh.y;
                const float h2 = xv[rr][j].z * rs * g.z * (1.f + sc.z) + sh.z, h3 = xv[rr][j].w * rs * g.w * (1.f + sc.w) + sh.w;
                uint2 hi; hi.x = cvtpk(h0, h1); hi.y = cvtpk(h2, h3);
                uint2 lo;
                lo.x = cvtpk(h0 - __uint_as_float(hi.x << 16), h1 - __uint_as_float(hi.x & 0xffff0000u));
                lo.y = cvtpk(h2 - __uint_as_float(hi.y << 16), h3 - __uint_as_float(hi.y & 0xffff0000u));
                *(uint2*)(v.H + (size_t)m * D + c) = hi;
                const int off = row * 2048 + ((((c >> 3) ^ row) & 127) << 4) + (c & 7) * 2;
                *(uint2*)(lds + off) = hi; *(uint2*)(lds + 32768 + off) = lo;
            }
        }
        __syncthreads();
        {
            const int r16 = lane & 15, kq = lane >> 4;
            f32x4m acc = {0.f, 0.f, 0.f, 0.f};
            const bf16_t* wh = wr + (size_t)(16 * wave + r16) * D + 8 * kq;
#pragma unroll 8
            for (int s = 0; s < 32; ++s) {
                const int off = r16 * 2048 + ((((4 * s + kq) ^ r16) & 127) << 4);
                const bf16x8 ah = *(const bf16x8*)(lds + off), al = *(const bf16x8*)(lds + 32768 + off);
                const bf16x8 bh = *(const bf16x8*)(wh + 32 * s), bl = *(const bf16x8*)(wh + 64 * D + 32 * s);
                acc = __builtin_amdgcn_mfma_f32_16x16x32_bf16(ah, bh, acc, 0, 0, 0);
                acc = __builtin_amdgcn_mfma_f32_16x16x32_bf16(al, bh, acc, 0, 0, 0);
                acc = __builtin_amdgcn_mfma_f32_16x16x32_bf16(ah, bl, acc, 0, 0, 0);
            }
#pragma unroll
            for (int q = 0; q < 4; ++q) LG[(4 * kq + q) * 64 + 16 * wave + r16] = acc[q];
        }
        __syncthreads();
        if (TIDX < 16) {
            const int m = m0 + TIDX;
            const float* lgp = LG + TIDX * 64;
            float lg[4], le[32];
#pragma unroll
            for (int i = 0; i < 4; ++i) lg[i] = lgp[i] + p.rg_b[l * 4 + i];
#pragma unroll
            for (int i = 0; i < 32; ++i) le[i] = lgp[4 + i] + p.re_b[l * 32 + i];
            int gi = 0; float gm = lg[0];
#pragma unroll
            for (int i = 1; i < 4; ++i) if (lg[i] > gm) { gm = lg[i]; gi = i; }
            float gs = 0.f;
#pragma unroll
            for (int i = 0; i < 4; ++i) gs += expf(lg[i] - gm);
            const float pg = 1.f / gs;
            float el[8];
#pragma unroll
            for (int i = 0; i < 8; ++i) el[i] = gi == 0 ? le[i] : (gi == 1 ? le[8 + i] : (gi == 2 ? le[16 + i] : le[24 + i]));
            int e1 = 0; float m1 = el[0];
#pragma unroll
            for (int i = 1; i < 8; ++i) if (el[i] > m1) { m1 = el[i]; e1 = i; }
            int e2 = -1; float m2 = -3.0e38f;
#pragma unroll
            for (int i = 0; i < 8; ++i) if (i != e1 && el[i] > m2) { m2 = el[i]; e2 = i; }
            const float p2 = expf(m2 - m1);
            const float w1 = pg / (1.f + p2), w2 = pg * p2 / (1.f + p2);
            const int ea = gi * 8 + e1, eb = gi * 8 + e2;
            const unsigned pa = atomicAdd(v.ctl + CW_CNT + l * 32 + ea, 1u);
            const unsigned pb = atomicAdd(v.ctl + CW_CNT + l * 32 + eb, 1u);
            v.list[(size_t)ea * T + pa] = 2 * m;
            v.list[(size_t)eb * T + pb] = 2 * m + 1;
            v.wts[2 * m] = w1; v.wts[2 * m + 1] = w2;
        }
        __syncthreads();
    }
}

constexpr int CW_MQ = 8192 + 512;
DEV void ph_mix(const P& p, int l, unsigned char* lds, volatile LAS unsigned* qslot, int rep) {
    const int TIDX = otid(), BIDX = obid();
    unsigned* ctl = (unsigned*)(p.ws + WS_CTL) + CW_MQ + l * 256;
    unsigned acq = 0u;
    int b = BIDX & 7;
    {
        for (;;) {
            unsigned* qc = ctl + b * 16;
            unsigned* done = ctl + 128 + b * 16;
            __syncthreads();
            if (TIDX == 0) {
                unsigned tk = atomicAdd(qc, 1u), nb = (unsigned)b;
                if (tk >= 272u) {
                    unsigned hd[8];
#pragma unroll
                    for (int q = 0; q < 8; ++q) hd[q] = __hip_atomic_load(ctl + ((b + q) & 7) * 16, __ATOMIC_RELAXED, __HIP_MEMORY_SCOPE_AGENT);
                    nb = 8u;
#pragma unroll
                    for (int q = 7; q >= 1; --q) if (hd[q] < 272u) nb = (unsigned)((b + q) & 7);
                }
                *qslot = tk | (nb << 16);
            }
            __syncthreads();
            const unsigned qv = *qslot;
            const int v = (int)(qv & 0xffffu);
            if (v >= 272) {
                const int nb = (int)(qv >> 16);
                if (nb >= 8) break;
                b = nb; continue;
            }
            if (v < 16) {
                if (cmp_unit(p, l, b * 4 + (v >> 2), v & 3, lds, qslot)) {
                    asm volatile("s_waitcnt vmcnt(0)" ::: "memory");
                    __syncthreads();
                    if (TIDX == 0) {
                        __builtin_amdgcn_fence(__ATOMIC_RELEASE, "agent");
                        asm volatile("s_waitcnt vmcnt(0)" ::: "memory");
                        __hip_atomic_fetch_add(done, 1u, __ATOMIC_RELAXED, __HIP_MEMORY_SCOPE_AGENT);
                    }
                }
                continue;
            }
            int slot = -1, nsa = -1;
            if (v < 48) slot = 2 * (v - 16);
            else if (v < 112) slot = 2 * (v - 48) + 1;
            else { const int w2 = v - 112, k = w2 % 5, i = w2 / 5; if (k < 4) nsa = 4 * i + k; else slot = 2 * (32 + i); }
            if (slot >= 0) {
                const int idx = slot >> 1, u = ((idx >> 2) << 5) | (b * 4 + (idx & 3));
                if (slot & 1) mha_unit<3>(p, l, u, lds); else mha_unit<2>(p, l, u, lds);
            } else {
                if (!((acq >> b) & 1u)) {
                    if (TIDX == 0) {
                        unsigned sp = 0;
                        while (__hip_atomic_load(done, __ATOMIC_RELAXED, __HIP_MEMORY_SCOPE_AGENT) < 4u) { __builtin_amdgcn_s_sleep(2); if (++sp > (1u << 22)) break; }
                        __builtin_amdgcn_fence(__ATOMIC_ACQUIRE, "agent");
                        asm volatile("s_waitcnt vmcnt(0)" ::: "memory");
                    }
                    __syncthreads();
                    acq |= 1u << b;
                }
                nsa_unit(p, l, ((nsa >> 1) << 4) | (b * 2 + (nsa & 1)), lds);
            }
        }
    }
}

#ifndef REP_PHASE
#define REP_PHASE 0
#endif
#ifndef REF_HEADS
#define REF_HEADS 0x0000u
#endif
__global__ void __launch_bounds__(256, 2) fwd_kernel(P p) {
    __shared__ __attribute__((aligned(16))) float lds[17408];
    __shared__ __attribute__((aligned(16))) unsigned lds_ctl[4];
    if (threadIdx.x < 4) lds_ctl[threadIdx.x] = 0u;
    __syncthreads();
    const XcdBarrier xb = xcd_barrier_post((unsigned*)(p.ws + WS_CTL), (volatile LAS unsigned*)lds_ctl);
#define GRID_BAR() do { xcd_barrier(xb); if (REP_PHASE == 7) xcd_barrier(xb); } while (0)
    volatile LAS unsigned* qslot = (volatile LAS unsigned*)(lds_ctl + 2);
    for (int rep = 0; rep < (REP_PHASE == 1 ? 2 : 1); ++rep) {
        ph_prologue(p, lds);
        ph_convert(p, lds);
        GRID_BAR();
    }
    for (int l = 0; l < DEPTH; ++l) {
        ph_convert_dense(p, l, 0);
        ph_norm1(p, l, l == 0 ? 0 : 1);
        GRID_BAR();
        for (int rep = 0; rep < (REP_PHASE == 2 ? 2 : 1); ++rep) {
            if (rep == 0) ph_convert_dense(p, l, 1);
            ph_inproj_fast(p, l, (unsigned char*)lds);
            GRID_BAR();
        }
        for (int rep = 0; rep < (REP_PHASE == 3 ? 2 : 1); ++rep) {
            ph_mix(p, l, (unsigned char*)lds, qslot, rep);
            GRID_BAR();
        }
        ph_outproj_fast(p, l, (unsigned char*)lds);
        GRID_BAR();
        if (blockIdx.x & 8) { ph_convert_experts(p, l); ph_norm2_router_fast(p, l, (unsigned char*)lds); }
        else { ph_norm2_router_fast(p, l, (unsigned char*)lds); ph_convert_experts(p, l); }
        GRID_BAR();
        for (int rep = 0; rep < (REP_PHASE == 5 ? 2 : 1); ++rep) {
            ph_moe_up_fast(p, l, (unsigned char*)lds);
            GRID_BAR();
        }
        for (int rep = 0; rep < (REP_PHASE == 6 ? 2 : 1); ++rep) {
            ph_moe_down_fast(p, l, (unsigned char*)lds);
            GRID_BAR();
        }
    }
    ph_norm1(p, DEPTH, 2);
}

extern "C" void kernel_launch(void* const* d_in, const int* in_sizes, int n_in,
                              void* d_out, int out_size, void* d_ws, size_t ws_size,
                              hipStream_t stream) {
    static int grid_blocks = 0;
    if (!grid_blocks) {
        int dev = 0, cus = 0, per_cu = 0;
        (void)hipGetDevice(&dev);
        (void)hipDeviceGetAttribute(&cus, hipDeviceAttributeMultiprocessorCount, dev);
        (void)hipOccupancyMaxActiveBlocksPerMultiprocessor(&per_cu, fwd_kernel, 256, 0);
        if (per_cu > 2) per_cu = 2;
        if (per_cu < 1) per_cu = 1;
        grid_blocks = cus * per_cu;
        if (n_in != 24 || ws_size < WS_END || out_size != T * D) { fprintf(stderr, "kernel_launch: unexpected shapes (n_in %d ws %zu out %d)\n", n_in, ws_size, out_size); grid_blocks = -1; }
    }
    if (grid_blocks < 0) return;
    (void)hipMemsetAsync(d_ws, 0, CTL_BYTES, stream);
    P p{};
    const float** pp = (const float**)&p;
    for (int i = 0; i < 24; ++i) pp[i] = (const float*)d_in[i];
    p.out = (float*)d_out; p.ws = (unsigned char*)d_ws;
    void* args[] = {&p};
    hipError_t e = hipLaunchCooperativeKernel((void*)fwd_kernel, dim3(grid_blocks), dim3(256), args, 0, stream);
    if (e != hipSuccess) fprintf(stderr, "cooperative launch failed: %s (grid %d)\n", hipGetErrorString(e), grid_blocks);
}
```

```cpp
#include <hip/hip_runtime.h>
#include <hip/hip_cooperative_groups.h>
#include <cstdio>
#include <cstdint>

#define LAS __attribute__((address_space(3)))
#define DEV __device__ __forceinline__

constexpr int T = 16384, S = 2048, NB = 8, D = 1024, DIN = 2844, NP = 2880, DEPTH = 4;
constexpr int NCMP = 127;
constexpr float EPS = 1e-6f;
constexpr float SCALE = 0.125f;
constexpr int C_QA = 0, C_KC = 512, C_VC = 640, C_KS = 768, C_VS = 896, C_KW = 1024, C_VW = 1152;
constexpr int C_QB = 1280, C_KB = 1536, C_VB = 1792, C_QC = 2048, C_KCC = 2304, C_VCC = 2560;

constexpr size_t MiB = 1u << 20;
constexpr size_t WS_CTL = 0, CTL_BYTES = 64 * 1024;
constexpr size_t WS_MOD = 1 * MiB, WS_ROPE = 2 * MiB, WS_CUMF = 3 * MiB, WS_CK = 4 * MiB, WS_CV = 5 * MiB, WS_IMP = 6 * MiB;
constexpr size_t WS_SEL = 10 * MiB, WS_EID = 11 * MiB, WS_WTS = 12 * MiB, WS_LIST = 13 * MiB, WS_GF = 16 * MiB;
constexpr size_t WS_H = 32 * MiB, WS_U = 64 * MiB, WS_O = 160 * MiB, WS_HID = 192 * MiB, WS_Y = 224 * MiB, WS_OB = 352 * MiB, WS_ORAW = 448 * MiB;
constexpr size_t WS_END = 973 * MiB;
constexpr size_t WS_VT = 936 * MiB;
constexpr size_t WS_CVT = 962 * MiB;
constexpr size_t WS_CUMF2 = 963 * MiB;
constexpr int CW_Q = 8192 + 256;
constexpr size_t WS_CW1 = 964 * MiB;
constexpr size_t WS_CW2 = 968 * MiB;
constexpr size_t WS_CPB = 969 * MiB;
constexpr size_t WS_LSF = 970 * MiB;
constexpr size_t WS_WR = 971 * MiB;
constexpr int CW_CNT = 8192;

typedef unsigned short bf16_t;
typedef float f32x4v __attribute__((ext_vector_type(4)));
DEV int vt_row(int n) { return n < 1024 ? n - 896 : (n < 1280 ? 128 + n - 1152 : (n < 2048 ? 256 + n - 1792 : 512 + n - 2560)); }
DEV bool is_vcol(int n) { return (n >= C_VS && n < C_KW) || (n >= C_VW && n < C_QB) || (n >= C_VB && n < C_QC) || (n >= C_VCC && n < 2816); }
DEV float bf2f(bf16_t v) { return __uint_as_float((unsigned)v << 16); }
DEV bf16_t f2bf(float f) { unsigned u = __float_as_uint(f); return (bf16_t)((u + 0x7fffu + ((u >> 16) & 1u)) >> 16); }
DEV float4 ld_bf4(const bf16_t* p) { const ushort4 u = *(const ushort4*)p; return make_float4(bf2f(u.x), bf2f(u.y), bf2f(u.z), bf2f(u.w)); }
typedef float f32x2_t __attribute__((ext_vector_type(2)));
typedef __bf16 bf16x2_t __attribute__((ext_vector_type(2)));
DEV unsigned cvtpk(float lo, float hi) { f32x2_t v = {lo, hi}; bf16x2_t b = __builtin_convertvector(v, bf16x2_t); return __builtin_bit_cast(unsigned, b); }
DEV float sigmoidf_(float x) { return 1.f / (1.f + expf(-x)); }
DEV float logsigmoidf_(float x) { return fminf(x, 0.f) - log1pf(expf(-fabsf(x))); }
DEV float wave_sum(float v) {
#pragma unroll
    for (int o = 1; o < 64; o <<= 1) v += __shfl_xor(v, o);
    return v;
}

#define XB_TMO      128
#define XB_XCNT(j)  (256  + 64 * (j))
#define XB_XSUB(j)  (1280 + 64 * (j))
#define XB_XGEN(j)  (2304 + 64 * (j))
#define XB_TOP      3328
#define XB_TOPGEN   3392
#define XCD_BAR_WORDS 3456
#define XB_SPIN_CAP (1u << 23)
DEV unsigned xb_ld(unsigned* p)              { return __hip_atomic_load(p, __ATOMIC_RELAXED, __HIP_MEMORY_SCOPE_AGENT); }
DEV unsigned xb_add(unsigned* p, unsigned v) { return __hip_atomic_fetch_add(p, v, __ATOMIC_RELAXED, __HIP_MEMORY_SCOPE_AGENT); }
DEV unsigned xb_xcc_id() { return (unsigned)__builtin_amdgcn_s_getreg((3 << 11) | 20) & 0xFu; }
#define XB_SPIN(cond, bar) do { unsigned _sp = 0; while (cond) { __builtin_amdgcn_s_sleep(1); \
    if ((++_sp & 255u) == 0u) { if (xb_ld(&(bar)[XB_TMO])) break; if (_sp > XB_SPIN_CAP) { atomicAdd(&(bar)[XB_TMO], 1u); break; } } } } while (0)
struct XcdBarrier { unsigned* bar; unsigned x; volatile LAS unsigned* st; };
DEV XcdBarrier xcd_barrier_post(unsigned* bar, volatile LAS unsigned* st) {
    XcdBarrier b; b.bar = bar; b.x = xb_xcc_id(); b.st = st;
    if (threadIdx.x == 0) (void)xb_add(&bar[XB_XCNT(b.x)], 1u);
    return b;
}
DEV void xcd_barrier_complete(unsigned* bar, unsigned x, unsigned& nloc, unsigned& nx) {
    const unsigned G = gridDim.x * gridDim.y * gridDim.z;
    unsigned sum, cnt, mine, sp = 0u;
    for (;;) {
        sum = 0u; cnt = 0u; mine = 0u;
#pragma unroll
        for (unsigned j = 0; j < 16; ++j) { const unsigned c = xb_ld(&bar[XB_XCNT(j)]); sum += c; cnt += (c > 0u) ? 1u : 0u; mine = (j == x) ? c : mine; }
        if (sum == G) break;
        __builtin_amdgcn_s_sleep(1);
        if ((++sp & 255u) == 0u) { if (xb_ld(&bar[XB_TMO])) break; if (sp > XB_SPIN_CAP) { atomicAdd(&bar[XB_TMO], 1u); break; } }
    }
    nloc = mine > 0u ? mine : 1u; nx = cnt > 0u ? cnt : 1u;
}
DEV void xcd_barrier(const XcdBarrier& b) {
    asm volatile("s_waitcnt vmcnt(0)" ::: "memory");
    __syncthreads();
    if (threadIdx.x == 0) {
        unsigned* bar = b.bar;
        __builtin_amdgcn_s_waitcnt(0);
        unsigned nloc = b.st[0], nx = b.st[1];
        if (nloc == 0u) { xcd_barrier_complete(bar, b.x, nloc, nx); b.st[0] = nloc; b.st[1] = nx; }
        const unsigned old = xb_add(&bar[XB_XSUB(b.x)], 1u);
        const unsigned gen = old / nloc;
        if (old + 1u == (gen + 1u) * nloc) {
            __builtin_amdgcn_fence(__ATOMIC_RELEASE, "agent");
            asm volatile("s_waitcnt vmcnt(0)" ::: "memory");
            const unsigned og = xb_add(&bar[XB_TOP], 1u);
            const unsigned tg = og / nx;
            if (og + 1u == (tg + 1u) * nx) xb_add(&bar[XB_TOPGEN], 1u);
            else XB_SPIN(xb_ld(&bar[XB_TOPGEN]) == tg, bar);
            __builtin_amdgcn_fence(__ATOMIC_ACQUIRE, "agent");
            xb_add(&bar[XB_XGEN(b.x)], 1u);
            asm volatile("s_waitcnt vmcnt(0)" ::: "memory");
        } else {
            XB_SPIN(xb_ld(&bar[XB_XGEN(b.x)]) == gen, bar);
            __builtin_amdgcn_fence(__ATOMIC_ACQUIRE, "agent");
            asm volatile("s_waitcnt vmcnt(0)" ::: "memory");
        }
    }
    __syncthreads();
}

struct P {
    const float *x, *c, *norm1_g, *norm2_g, *ada_w, *ada_b, *w_in, *b_forget, *cmp_pos_k, *cmp_w1_k, *cmp_w2_k,
        *cmp_pos_v, *cmp_w1_v, *cmp_w2_v, *out_norm_g, *w_out, *rg_w, *rg_b, *re_w, *re_b, *e_w1, *e_w3, *e_w2, *final_g;
    float* out; unsigned char* ws;
};
struct V {
    unsigned* ctl; float* mod; float* rcos; float* rsin; float* cumf; bf16_t* ck; bf16_t* cv; float* imp; unsigned* sel;
    int* eid; float* wts; int* list; float* gf; bf16_t* H; bf16_t* U; bf16_t* O; bf16_t* HID; bf16_t* Y; float* OB; float* ORAW; float* X; bf16_t* XB;
};
DEV int otid() { int t = threadIdx.x; asm volatile("" : "+v"(t)); return t; }
DEV int obid() { int t = blockIdx.x; asm volatile("" : "+s"(t)); return t; }
DEV V make_views(const P& p) {
    V v; size_t woff = 0; asm volatile("" : "+s"(woff)); unsigned char* w = p.ws + woff;
    v.ctl = (unsigned*)(w + WS_CTL); v.mod = (float*)(w + WS_MOD); v.rcos = (float*)(w + WS_ROPE); v.rsin = v.rcos + S * 8;
    v.cumf = (float*)(w + WS_CUMF); v.ck = (bf16_t*)(w + WS_CK); v.cv = (bf16_t*)(w + WS_CV); v.imp = (float*)(w + WS_IMP);
    v.sel = (unsigned*)(w + WS_SEL); v.eid = (int*)(w + WS_EID); v.wts = (float*)(w + WS_WTS); v.list = (int*)(w + WS_LIST);
    v.gf = (float*)(w + WS_GF); v.H = (bf16_t*)(w + WS_H); v.U = (bf16_t*)(w + WS_U); v.O = (bf16_t*)(w + WS_O);
    v.HID = (bf16_t*)(w + WS_HID); v.Y = (bf16_t*)(w + WS_Y); v.OB = (float*)(w + WS_OB); v.ORAW = (float*)(w + WS_ORAW); v.X = p.out; v.XB = (bf16_t*)(w + WS_ORAW);
    return v;
}

DEV void ph_prologue(const P& p, float* lds) {
    const V v = make_views(p); const int TIDX = otid(), BIDX = obid();
    const int tid = TIDX;
    for (int i = tid; i < NB * D; i += 256) { const float c = p.c[i]; lds[i] = c / (1.f + expf(-c)); }
    __syncthreads();
    float* red = lds + NB * D;
    const int c4 = tid & 15, ks = tid >> 4;
    for (int unit = BIDX; unit < DEPTH * 96; unit += gridDim.x) {
        const int l = unit / 96, n0 = (unit % 96) * 64;
        const float* W = p.ada_w + (size_t)l * D * 6144 + n0 + 4 * c4;
        float acc[8][4];
#pragma unroll
        for (int b = 0; b < 8; ++b)
#pragma unroll
            for (int q = 0; q < 4; ++q) acc[b][q] = 0.f;
#pragma unroll 1
        for (int i0 = 0; i0 < 64; i0 += 8) {
            f32x4v w[8];
#pragma unroll
            for (int i = 0; i < 8; ++i) w[i] = __builtin_nontemporal_load((const f32x4v*)(W + (size_t)(ks + 16 * (i0 + i)) * 6144));
#pragma unroll
            for (int i = 0; i < 8; ++i) {
                const int k = ks + 16 * (i0 + i);
#pragma unroll
                for (int b = 0; b < 8; ++b) {
                    const float cv = lds[b * D + k];
                    acc[b][0] += cv * w[i].x; acc[b][1] += cv * w[i].y; acc[b][2] += cv * w[i].z; acc[b][3] += cv * w[i].w;
                }
            }
        }
#pragma unroll
        for (int b = 0; b < 8; ++b) *(float4*)(red + (ks * 8 + b) * 64 + 4 * c4) = make_float4(acc[b][0], acc[b][1], acc[b][2], acc[b][3]);
        __syncthreads();
        for (int o = tid; o < 512; o += 256) {
            const int c2 = o & 63, b = o >> 6;
            float sm = p.ada_b[l * 6144 + n0 + c2];
#pragma unroll
            for (int q = 0; q < 16; ++q) sm += red[(q * 8 + b) * 64 + c2];
            v.mod[(size_t)(l * 8 + b) * 6144 + n0 + c2] = sm;
        }
        __syncthreads();
    }
    const float cst = -2.0f * 13.122363377404328f / 16.0f;
    for (int i = ((int)gridDim.x - 1 - BIDX) * 256 + tid; i < S * 8; i += gridDim.x * 256) {
        const int s = i >> 3, j = i & 7;
        const float inv = expf((float)j * cst);
        const float ang = (float)s * inv;
        v.rcos[i] = cosf(ang); v.rsin[i] = sinf(ang);
    }
}

DEV void ph_norm1(const P& p, int l, int mode) {
    const V v = make_views(p); const int TIDX = otid(), BIDX = obid();
    const int lane = TIDX & 63;
    const int gw = (BIDX * 256 + TIDX) >> 6, nw = gridDim.x * 4;
    for (int m0 = gw; m0 < T; m0 += 2 * nw) {
        float4 xv[2][4];
        if (mode == 0) {
#pragma unroll
            for (int rr = 0; rr < 2; ++rr)
#pragma unroll
                for (int j = 0; j < 4; ++j) xv[rr][j] = *(const float4*)(p.x + (size_t)(m0 + rr * nw) * D + 4 * lane + 256 * j);
        } else {
            ushort4 xa[2][4], ya[2][4], yb[2][4];
#pragma unroll
            for (int rr = 0; rr < 2; ++rr)
#pragma unroll
                for (int j = 0; j < 4; ++j) {
                    const int m = m0 + rr * nw, c = 4 * lane + 256 * j;
                    xa[rr][j] = *(const ushort4*)(v.XB + (size_t)m * D + c);
                    ya[rr][j] = *(const ushort4*)(v.Y + (size_t)(2 * m) * D + c); yb[rr][j] = *(const ushort4*)(v.Y + (size_t)(2 * m + 1) * D + c);
                }
#pragma unroll
            for (int rr = 0; rr < 2; ++rr) {
                const float* g2 = v.mod + (size_t)((l - 1) * 8 + ((m0 + rr * nw) >> 11)) * 6144 + 5 * D;
#pragma unroll
                for (int j = 0; j < 4; ++j) {
                    const float4 g = *(const float4*)(g2 + 4 * lane + 256 * j);
                    float4 a = make_float4(bf2f(xa[rr][j].x), bf2f(xa[rr][j].y), bf2f(xa[rr][j].z), bf2f(xa[rr][j].w));
                    a.x += g.x * (bf2f(ya[rr][j].x) + bf2f(yb[rr][j].x)); a.y += g.y * (bf2f(ya[rr][j].y) + bf2f(yb[rr][j].y));
                    a.z += g.z * (bf2f(ya[rr][j].z) + bf2f(yb[rr][j].z)); a.w += g.w * (bf2f(ya[rr][j].w) + bf2f(yb[rr][j].w));
                    xv[rr][j] = a;
                }
            }
        }
        float ss[2];
#pragma unroll
        for (int rr = 0; rr < 2; ++rr) {
            ss[rr] = 0.f;
#pragma unroll
            for (int j = 0; j < 4; ++j) ss[rr] += xv[rr][j].x * xv[rr][j].x + xv[rr][j].y * xv[rr][j].y + xv[rr][j].z * xv[rr][j].z + xv[rr][j].w * xv[rr][j].w;
        }
#pragma unroll
        for (int o = 1; o < 64; o <<= 1) { ss[0] += __shfl_xor(ss[0], o); ss[1] += __shfl_xor(ss[1], o); }
#pragma unroll
        for (int rr = 0; rr < 2; ++rr) {
            const int m = m0 + rr * nw, b = m >> 11;
            const float r = rsqrtf(ss[rr] * (1.f / D) + EPS);
            if (mode == 2) {
#pragma unroll
                for (int j = 0; j < 4; ++j) {
                    const int c = 4 * lane + 256 * j;
                    const float4 g = *(const float4*)(p.final_g + c);
                    float4 o; o.x = xv[rr][j].x * r * g.x; o.y = xv[rr][j].y * r * g.y; o.z = xv[rr][j].z * r * g.z; o.w = xv[rr][j].w * r * g.w;
                    *(float4*)(v.X + (size_t)m * D + c) = o;
                }
            } else {
                const float* md = v.mod + (size_t)(l * 8 + b) * 6144;
#pragma unroll
                for (int j = 0; j < 4; ++j) {
                    const int c = 4 * lane + 256 * j;
                    { uint2 xo; xo.x = cvtpk(xv[rr][j].x, xv[rr][j].y); xo.y = cvtpk(xv[rr][j].z, xv[rr][j].w); *(uint2*)(v.XB + (size_t)m * D + c) = xo; }
                    const float4 g = *(const float4*)(p.norm1_g + l * D + c), sh = *(const float4*)(md + c), sc = *(const float4*)(md + D + c);
                    uint2 o;
                    o.x = cvtpk(xv[rr][j].x * r * g.x * (1.f + sc.x) + sh.x, xv[rr][j].y * r * g.y * (1.f + sc.y) + sh.y);
                    o.y = cvtpk(xv[rr][j].z * r * g.z * (1.f + sc.z) + sh.z, xv[rr][j].w * r * g.w * (1.f + sc.w) + sh.w);
                    *(uint2*)(v.H + (size_t)m * D + c) = o;
                }
            }
        }
    }
}

typedef short bf16x8 __attribute__((ext_vector_type(8)));
typedef float f32x16 __attribute__((ext_vector_type(16)));
typedef unsigned u32x4 __attribute__((ext_vector_type(4)));
constexpr size_t WS_WIN = 512 * MiB, WS_WOT = 544 * MiB, WS_W13 = 552 * MiB, WS_W2 = 808 * MiB;
constexpr int NPW = 2944;
DEV int tile_off(int row, int chunk) { return row * 128 + ((chunk ^ ((row >> 1) & 7)) << 4); }
template <class RM>
DEV void conv_patch(const float* src, int N, int K, bf16_t* dst, int k0, int n0, RM rowmap, int lane) {
    const int kg = lane >> 3, n = n0 + 4 * (lane & 7);
    if (n >= N) return;
    const float* sp = src + (size_t)(k0 + 8 * kg) * N + n;
    f32x4v x[8];
#pragma unroll
    for (int j = 0; j < 8; ++j) x[j] = __builtin_nontemporal_load((const f32x4v*)(sp + (size_t)j * N));
    bf16_t* dp = dst + k0 + 8 * kg;
    u32x4 o;
    o.x = cvtpk(x[0].x, x[1].x); o.y = cvtpk(x[2].x, x[3].x); o.z = cvtpk(x[4].x, x[5].x); o.w = cvtpk(x[6].x, x[7].x);
    *(u32x4*)(dp + (size_t)rowmap(n) * K) = o;
    o.x = cvtpk(x[0].y, x[1].y); o.y = cvtpk(x[2].y, x[3].y); o.z = cvtpk(x[4].y, x[5].y); o.w = cvtpk(x[6].y, x[7].y);
    *(u32x4*)(dp + (size_t)rowmap(n + 1) * K) = o;
    o.x = cvtpk(x[0].z, x[1].z); o.y = cvtpk(x[2].z, x[3].z); o.z = cvtpk(x[4].z, x[5].z); o.w = cvtpk(x[6].z, x[7].z);
    *(u32x4*)(dp + (size_t)rowmap(n + 2) * K) = o;
    o.x = cvtpk(x[0].w, x[1].w); o.y = cvtpk(x[2].w, x[3].w); o.z = cvtpk(x[4].w, x[5].w); o.w = cvtpk(x[6].w, x[7].w);
    *(u32x4*)(dp + (size_t)rowmap(n + 3) * K) = o;
}

DEV void conv8(const float* s0, const float* s1, bf16_t* dst) {
    f32x4v a = {0.f, 0.f, 0.f, 0.f}, b = {0.f, 0.f, 0.f, 0.f};
    if (s0) a = __builtin_nontemporal_load((const f32x4v*)s0);
    if (s1) b = __builtin_nontemporal_load((const f32x4v*)s1);
    u32x4 o; o.x = cvtpk(a[0], a[1]); o.y = cvtpk(a[2], a[3]); o.z = cvtpk(b[0], b[1]); o.w = cvtpk(b[2], b[3]);
    *(u32x4*)dst = o;
}
DEV void ph_convert_dense(const P& p, int l, int which) {
    const int TIDX = otid(), BIDX = obid();
    size_t woff = 0; asm volatile("" : "+s"(woff)); unsigned char* w = p.ws + woff;
    const size_t gtid = (size_t)BIDX * 256 + TIDX, gsz = (size_t)gridDim.x * 256;
    if (which == 0) {
        bf16_t* win = (bf16_t*)(w + WS_WIN);
        for (size_t i = gtid; i < (size_t)D * 368; i += gsz) {
            const int g8 = (int)(i % 368); const size_t lk = (size_t)l * D + i / 368;
            const int n = g8 * 8;
            const float* row = p.w_in + lk * DIN;
            const float *s0, *s1;
            if (n < 2816) { const int oc = n + (n >= 2048 ? 28 : (n >= 1280 ? 24 : 0)); s0 = row + oc; s1 = row + oc + 4; }
            else if (n < 2840) { s0 = row + 1280 + (n - 2816); s1 = s0 + 4; }
            else if (n == 2840) { s0 = row + 2072; s1 = nullptr; }
            else { s0 = nullptr; s1 = nullptr; }
            conv8(s0, s1, win + lk * NPW + n);
        }
    } else {
        bf16_t* wot = (bf16_t*)(w + WS_WOT);
        const size_t oo = (size_t)l * D * D;
        for (size_t i = gtid; i < (size_t)D * D / 8; i += gsz) conv8(p.w_out + oo + i * 8, p.w_out + oo + i * 8 + 4, wot + oo + i * 8);
        for (size_t i = gtid; i < (size_t)2 * 2048 * 128 / 8; i += gsz) {
            const size_t per = (size_t)2048 * 128 / 8; const int kv = (int)(i / per), lk = l * 2 + kv; const size_t off = (i % per) * 8;
            const float* src = (kv ? p.cmp_w1_v : p.cmp_w1_k) + (size_t)l * 2048 * 128 + off;
            conv8(src, src + 4, (bf16_t*)(w + WS_CW1) + (size_t)lk * 2048 * 128 + off);
        }
    }
}
DEV void ph_convert_experts(const P& p, int l) {
    const int TIDX = otid(), BIDX = obid();
    size_t woff = 0; asm volatile("" : "+s"(woff)); unsigned char* w = p.ws + woff;
    bf16_t* w13 = (bf16_t*)(w + WS_W13); bf16_t* w2t = (bf16_t*)(w + WS_W2);
    const size_t gtid = (size_t)BIDX * 256 + TIDX, gsz = (size_t)gridDim.x * 256;
    for (size_t i = gtid; i < (size_t)32 * D * 128; i += gsz) {
        const int g8 = (int)(i & 127); const size_t lek = (size_t)l * 32 * D + (i >> 7);
        const int n = g8 * 8, which = (n >> 5) & 1, c = 32 * (n >> 6) + (n & 31);
        const float* src = (which ? p.e_w3 : p.e_w1) + lek * 512 + c;
        conv8(src, src + 4, w13 + lek * 1024 + n);
    }
    const size_t o2 = (size_t)l * 32 * 512 * D;
    for (size_t i = gtid; i < (size_t)32 * 512 * D / 8; i += gsz) conv8(p.e_w2 + o2 + i * 8, p.e_w2 + o2 + i * 8 + 4, w2t + o2 + i * 8);
}
DEV void ph_convert(const P& p, float* lds) {
    const int TIDX = otid(), BIDX = obid();
    size_t woff = 0; asm volatile("" : "+s"(woff)); unsigned char* w = p.ws + woff;
    const int lane = TIDX & 63;
    for (int unit = BIDX * 4 + (TIDX >> 6); unit < DEPTH * 2 * 4; unit += gridDim.x * 4) {
        const int lk = unit >> 2, t = unit & 3, l = lk >> 1, kv = lk & 1;
        conv_patch((kv ? p.cmp_w2_v : p.cmp_w2_k) + (size_t)l * 128 * 64, 64, 128, (bf16_t*)(w + WS_CW2) + (size_t)lk * 64 * 128, (t >> 1) * 64, (t & 1) * 32, [](int n) { return n; }, lane);
    }
    for (int o = BIDX * 256 + TIDX; o < DEPTH * 64 * D; o += gridDim.x * 256) {
        const int k = o & (D - 1), n = (o >> 10) & 63, l = o >> 16;
        const float val = n < 4 ? p.rg_w[((size_t)l * D + k) * 4 + n] : (n < 36 ? p.re_w[((size_t)l * D + k) * 32 + n - 4] : 0.f);
        const bf16_t hi = f2bf(val); const bf16_t lo = f2bf(val - bf2f(hi));
        bf16_t* wr = (bf16_t*)(w + WS_WR) + (size_t)l * 2 * 64 * D;
        wr[n * D + k] = hi; wr[64 * D + n * D + k] = lo;
    }
    int pu = (int)gridDim.x - 1 - BIDX - 64; if (pu < 0) pu += gridDim.x;
    for (int unit = pu; unit < DEPTH * 2 * 8; unit += gridDim.x) {
        const int lk = unit >> 3, ch = unit & 7, l = lk >> 1, kv = lk & 1, j = TIDX & 127, hf = TIDX >> 7;
        const float* pe = (kv ? p.cmp_pos_v : p.cmp_pos_k) + (size_t)l * 2048 + ch * 256 + hf * 128;
        const float* w1 = (kv ? p.cmp_w1_v : p.cmp_w1_k) + (size_t)l * 2048 * 128 + (size_t)(ch * 256 + hf * 128) * 128 + j;
        float a0 = 0.f, a1 = 0.f, a2 = 0.f, a3 = 0.f;
#pragma unroll 1
        for (int k0 = 0; k0 < 128; k0 += 32) {
            float wv[32];
#pragma unroll
            for (int k = 0; k < 32; ++k) wv[k] = w1[(size_t)(k0 + k) * 128];
#pragma unroll
            for (int k = 0; k < 32; k += 4) {
                a0 += pe[k0 + k] * wv[k]; a1 += pe[k0 + k + 1] * wv[k + 1];
                a2 += pe[k0 + k + 2] * wv[k + 2]; a3 += pe[k0 + k + 3] * wv[k + 3];
            }
        }
        const float a = (a0 + a1) + (a2 + a3);
        __syncthreads();
        if (hf) lds[j] = a;
        __syncthreads();
        if (!hf) ((float*)(w + WS_CPB))[(lk * 8 + ch) * 128 + j] = a + lds[j];
    }
}

typedef short v4i16_t __attribute__((ext_vector_type(4)));
DEV void gemm_issue0(unsigned char* lds, const bf16_t* const (&arow)[4], const bf16_t* Bsrc, const size_t ldb, const int TIDX) {
    const int lane = TIDX & 63, wave = TIDX >> 6;
    const int gsw = ((TIDX & 7) ^ ((TIDX >> 4) & 7)) * 8;
    const bf16_t* bg = Bsrc + (size_t)(4 * wave + (lane >> 4)) * ldb + ((lane & 15) ^ (((lane >> 4) << 2) | (wave & 3))) * 8;
    LAS unsigned char* l3 = (LAS unsigned char*)lds + __builtin_amdgcn_readfirstlane(wave) * 1024;
#pragma unroll
    for (int i = 0; i < 4; ++i) {
        __builtin_amdgcn_global_load_lds((const unsigned*)(arow[i] + gsw), (LAS unsigned*)(l3 + i * 4096), 16, 0, 0);
        __builtin_amdgcn_global_load_lds((const unsigned*)(bg + (size_t)(16 * i) * ldb), (LAS unsigned*)(l3 + 16384 + i * 4096), 16, 0, 0);
    }
}
template <bool SWAP, bool PRE = false>
DEV void gemm128(unsigned char* lds, const bf16_t* const (&arow)[4], const bf16_t* Bsrc, const size_t ldb, int K, f32x16 (&acc)[2][2], const int TIDX, const int astride = 64) {
    const int lane = TIDX & 63, wave = TIDX >> 6, wm = wave >> 1, wn = wave & 1, r = lane & 31, h = lane >> 5;
#pragma unroll
    for (int j = 0; j < 2; ++j)
#pragma unroll
        for (int i = 0; i < 2; ++i)
#pragma unroll
            for (int q = 0; q < 16; ++q) acc[j][i][q] = 0.f;
    const int gsw = ((TIDX & 7) ^ ((TIDX >> 4) & 7)) * 8;
    const bf16_t* ag[4];
#pragma unroll
    for (int i = 0; i < 4; ++i) ag[i] = arow[i] + gsw;
    const int brow = 4 * wave + (lane >> 4), bch = ((lane & 15) ^ (((lane >> 4) << 2) | (wave & 3))) * 8;
    const bf16_t* bg = Bsrc + (size_t)brow * ldb + bch;
    LAS unsigned char* l3 = (LAS unsigned char*)lds + __builtin_amdgcn_readfirstlane(wave) * 1024;
    LAS unsigned char* tb[2][2];
    {
        const int blk = (lane >> 4) & 1, q = (lane & 15) >> 2, pp = lane & 3;
#pragma unroll
        for (int j = 0; j < 2; ++j)
#pragma unroll
            for (int t = 0; t < 2; ++t) {
                const int row = 4 * t + 8 * h + q, ch = 4 * (2 * wn + j) + 2 * blk + (pp >> 1);
                tb[j][t] = (LAS unsigned char*)lds + 16384 + 256 * row + 16 * (ch ^ (((row & 3) << 2) | ((row >> 2) & 3))) + 8 * (pp & 1);
            }
    }
#define G_DMA(st_, kt_) do { _Pragma("unroll") for (int i = 0; i < 4; ++i) { \
        __builtin_amdgcn_global_load_lds((const unsigned*)(ag[i] + (size_t)(kt_) * astride), (LAS unsigned*)(l3 + (st_) + i * 4096), 16, 0, 0); \
        __builtin_amdgcn_global_load_lds((const unsigned*)(bg + ((size_t)(kt_) * 64 + 16 * i) * ldb), (LAS unsigned*)(l3 + (st_) + 16384 + i * 4096), 16, 0, 0); } } while (0)
    const int KT = K >> 6;
    if (!PRE) {
        __syncthreads();
        G_DMA(0, 0);
    }
    for (int kt = 0; kt < KT; ++kt) {
        asm volatile("s_waitcnt vmcnt(0) lgkmcnt(0)" ::: "memory");
        __builtin_amdgcn_s_barrier();
        asm volatile("" ::: "memory");
        if (kt + 1 < KT) G_DMA(((kt + 1) & 1) * 32768, kt + 1);
        const int so = (kt & 1) * 32768;
        const unsigned char* cur = lds + so;
#pragma unroll
        for (int kk = 0; kk < 4; ++kk) {
            bf16x8 af[2], wf[2];
#pragma unroll
            for (int i = 0; i < 2; ++i) af[i] = *(const bf16x8*)(cur + tile_off(64 * wm + 32 * i + r, 2 * kk + h));
#pragma unroll
            for (int j = 0; j < 2; ++j) {
                const v4i16_t lo = __builtin_amdgcn_ds_read_tr16_b64_v4i16((LAS v4i16_t*)(tb[j][0] + so + 4096 * kk));
                const v4i16_t hi = __builtin_amdgcn_ds_read_tr16_b64_v4i16((LAS v4i16_t*)(tb[j][1] + so + 4096 * kk));
                wf[j] = (bf16x8){lo[0], lo[1], lo[2], lo[3], hi[0], hi[1], hi[2], hi[3]};
            }
#pragma unroll
            for (int j = 0; j < 2; ++j)
#pragma unroll
                for (int i = 0; i < 2; ++i) acc[j][i] = SWAP ? __builtin_amdgcn_mfma_f32_32x32x16_bf16(af[i], wf[j], acc[j][i], 0, 0, 0)
                                                             : __builtin_amdgcn_mfma_f32_32x32x16_bf16(wf[j], af[i], acc[j][i], 0, 0, 0);
        }
    }
    __syncthreads();
#undef G_DMA
}

constexpr int CST = 272;
DEV void ctile_put(unsigned char* lds, int row, int col, float a, float b, float c, float d) {
    uint2 u; u.x = cvtpk(a, b); u.y = cvtpk(c, d);
    *(uint2*)(lds + row * CST + col * 2) = u;
}
template <int COLS, class RP>
DEV void ctile_flush(unsigned char* lds, const int TIDX, RP rowptr) {
    asm volatile("s_waitcnt lgkmcnt(0)" ::: "memory");
    __builtin_amdgcn_s_barrier();
    asm volatile("" ::: "memory");
    constexpr int CPR = COLS / 8, RPI = 256 / CPR;
#pragma unroll
    for (int it = 0; it < 128 / RPI; ++it) {
        const int row = it * RPI + TIDX / CPR, c16 = TIDX % CPR;
        bf16_t* dst = rowptr(row, it);
        const u32x4 val = *(const u32x4*)(lds + row * CST + c16 * 16);
        if (dst) *(u32x4*)(dst + c16 * 8) = val;
    }
}

DEV void ph_inproj_fast(const P& p, int l, unsigned char* lds) {
    const V v = make_views(p); const int TIDX = otid(), BIDX = obid();
    const bf16_t* W = (const bf16_t*)(p.ws + WS_WIN) + (size_t)l * D * NPW;
    const int lane = TIDX & 63, wave = TIDX >> 6, wm = wave >> 1, wn = wave & 1, r = lane & 31, h = lane >> 5;
    const bool xo = gridDim.x == 512;
    unsigned char* ct = lds + 32768;
    auto decode = [&](int it, int& mt, int& nt) -> int {
        if (xo) { if (it >= 6) return -1; const int lb = BIDX >> 3; nt = 8 * (it % 3) + (lb >> 3); mt = 16 * (BIDX & 7) + 8 * (it / 3) + (lb & 7); return nt < 23 ? 1 : 0; }
        const int unit = BIDX + it * (int)gridDim.x; if (unit >= 128 * 23) return -1; nt = unit / 128; mt = unit % 128; return 1;
    };
    auto issue = [&](int mt, int nt) {
        const bf16_t* ar[4];
#pragma unroll
        for (int i = 0; i < 4; ++i) ar[i] = v.H + (size_t)(mt * 128 + (TIDX >> 3) + 32 * i) * D;
        gemm_issue0(lds, ar, W + nt * 128, NPW, TIDX);
    };
    bool pre = false;
    for (int it = 0;; ++it) {
        int nt, mt;
        const int dv = decode(it, mt, nt);
        if (dv < 0) break;
        if (dv == 0) continue;
        const int m0 = mt * 128, n0 = nt * 128;
        const bf16_t* arow[4];
#pragma unroll
        for (int i = 0; i < 4; ++i) arow[i] = v.H + (size_t)(m0 + (TIDX >> 3) + 32 * i) * D;
        if (!pre) { __syncthreads(); issue(mt, nt); pre = true; }
        int itn = it + 1, mtn = 0, ntn = 0, dn;
        while ((dn = decode(itn, mtn, ntn)) == 0) ++itn;
        f32x16 acc[2][2];
        if (is_vcol(n0)) {
            gemm128<true, true>(lds, arow, W + n0, NPW, D, acc, TIDX);
            if (dn > 0) issue(mtn, ntn); else pre = false;
#pragma unroll
            for (int j = 0; j < 2; ++j)
#pragma unroll
                for (int i = 0; i < 2; ++i)
#pragma unroll
                    for (int g = 0; g < 4; ++g)
                        ctile_put(ct, 64 * wn + 32 * j + r, 64 * wm + 32 * i + 8 * g + 4 * h, acc[j][i][4 * g], acc[j][i][4 * g + 1], acc[j][i][4 * g + 2], acc[j][i][4 * g + 3]);
            bf16_t* vt = (bf16_t*)(p.ws + WS_VT) + ((size_t)(m0 >> 11) * 768 + vt_row(n0)) * S + (m0 & (S - 1));
            ctile_flush<128>(ct, TIDX, [&](int row, int) { return vt + (size_t)row * S; });
            continue;
        }
        const bool rope_tile = n0 < 512 || n0 == C_KS || n0 == C_KW;
        f32x4v rcs[2], rsn[2];
        if (rope_tile) {
#pragma unroll
            for (int i = 0; i < 2; ++i) {
                const int sp = (m0 + 64 * wm + 32 * i + r) & (S - 1);
                rcs[i] = *(const f32x4v*)(v.rcos + sp * 8 + 4 * h); rsn[i] = *(const f32x4v*)(v.rsin + sp * 8 + 4 * h);
            }
        }
        gemm128<false, true>(lds, arow, W + n0, NPW, D, acc, TIDX);
        if (dn > 0) issue(mtn, ntn); else pre = false;
        if (n0 == 2816) {
            if (wn == 0) {
#pragma unroll
                for (int i = 0; i < 2; ++i) {
                    const int m = m0 + 64 * wm + 32 * i + r;
#pragma unroll
                    for (int q = 0; q < 16; ++q) {
                        const int cc = (q & 3) + 8 * (q >> 2) + 4 * h;
                        if (cc < 24) v.gf[(size_t)m * 32 + cc] = acc[0][i][q];
                        else if (cc < 28) ((float*)(p.ws + WS_LSF))[(size_t)((m >> 11) * 4 + cc - 24) * S + (m & (S - 1))] = logsigmoidf_(acc[0][i][q] + p.b_forget[l * 4 + cc - 24]);
                    }
                }
            }
            continue;
        }
#pragma unroll
        for (int j = 0; j < 2; ++j) {
            const int nb = n0 + 64 * wn + 32 * j;
            const bool rope = ((nb & 63) == 0) && (nb < 512 || (nb >= C_KS && nb < C_VS) || (nb >= C_KW && nb < C_VW));
#pragma unroll
            for (int i = 0; i < 2; ++i) {
                f32x16 a = acc[j][i];
                if (rope) {
#pragma unroll
                    for (int q = 0; q < 4; ++q) { const float x1 = a[q], x2 = a[q + 4]; a[q] = x1 * rcs[i][q] - x2 * rsn[i][q]; a[q + 4] = x2 * rcs[i][q] + x1 * rsn[i][q]; }
                }
#pragma unroll
                for (int g = 0; g < 4; ++g) ctile_put(ct, 64 * wm + 32 * i + r, 64 * wn + 32 * j + 8 * g + 4 * h, a[4 * g], a[4 * g + 1], a[4 * g + 2], a[4 * g + 3]);
            }
        }
        bf16_t* ub = v.U + (size_t)m0 * NP + n0;
        ctile_flush<128>(ct, TIDX, [&](int row, int) { return ub + (size_t)row * NP; });
    }
}

DEV void ph_outproj_fast(const P& p, int l, unsigned char* lds) {
    const V v = make_views(p); const int TIDX = otid(), BIDX = obid();
    const bf16_t* W = (const bf16_t*)(p.ws + WS_WOT) + (size_t)l * D * D;
    const int lane = TIDX & 63, wave = TIDX >> 6, wm = wave >> 1, wn = wave & 1, r = lane & 31, h = lane >> 5;
    const bool xo = gridDim.x == 512;
    unsigned char* ct = lds + 32768;
    auto decode = [&](int it, int& mt, int& nt) -> bool {
        if (xo) { if (it >= 2) return false; const int lb = BIDX >> 3; nt = lb >> 3; mt = 16 * (BIDX & 7) + 8 * it + (lb & 7); return true; }
        const int unit = BIDX + it * (int)gridDim.x; if (unit >= 128 * 8) return false; nt = unit / 128; mt = unit % 128; return true;
    };
    auto issue = [&](int mt, int nt) {
        const bf16_t* ar[4];
#pragma unroll
        for (int i = 0; i < 4; ++i) ar[i] = v.O + (size_t)(mt * 128 + (TIDX >> 3) + 32 * i) * D;
        gemm_issue0(lds, ar, W + nt * 128, D, TIDX);
    };
    for (int it = 0;; ++it) {
        int nt, mt, ntn = 0, mtn = 0;
        if (!decode(it, mt, nt)) break;
        const bool hasn = decode(it + 1, mtn, ntn);
        const int m0 = mt * 128, n0 = nt * 128;
        const bf16_t* arow[4];
#pragma unroll
        for (int i = 0; i < 4; ++i) arow[i] = v.O + (size_t)(m0 + (TIDX >> 3) + 32 * i) * D;
        if (it == 0) { __syncthreads(); issue(mt, nt); }
        u32x4 xin[8];
#pragma unroll
        for (int it = 0; it < 8; ++it) xin[it] = *(const u32x4*)(v.XB + (size_t)(m0 + it * 16 + (TIDX >> 4)) * D + n0 + (TIDX & 15) * 8);
        f32x16 acc[2][2];
        gemm128<false, true>(lds, arow, W + n0, D, D, acc, TIDX);
        if (hasn) issue(mtn, ntn);
        const float* g1 = v.mod + (size_t)(l * 8 + (m0 >> 11)) * 6144 + 2 * D;
#pragma unroll
        for (int j = 0; j < 2; ++j)
#pragma unroll
            for (int i = 0; i < 2; ++i) {
                const int nb = n0 + 64 * wn + 32 * j + 4 * h;
#pragma unroll
                for (int g = 0; g < 4; ++g) {
                    const float4 gg = *(const float4*)(g1 + nb + 8 * g);
                    ctile_put(ct, 64 * wm + 32 * i + r, 64 * wn + 32 * j + 8 * g + 4 * h, gg.x * acc[j][i][4 * g], gg.y * acc[j][i][4 * g + 1], gg.z * acc[j][i][4 * g + 2], gg.w * acc[j][i][4 * g + 3]);
                }
            }
        asm volatile("s_waitcnt lgkmcnt(0)" ::: "memory");
        __builtin_amdgcn_s_barrier();
        asm volatile("" ::: "memory");
#pragma unroll
        for (int it = 0; it < 8; ++it) {
            const int row = it * 16 + (TIDX >> 4);
            const u32x4 uv = *(const u32x4*)(ct + row * CST + (TIDX & 15) * 16);
            u32x4 xn;
#pragma unroll
            for (int q = 0; q < 4; ++q)
                xn[q] = cvtpk(__uint_as_float(xin[it][q] << 16) + __uint_as_float(uv[q] << 16), __uint_as_float(xin[it][q] & 0xffff0000u) + __uint_as_float(uv[q] & 0xffff0000u));
            *(u32x4*)(v.XB + (size_t)(m0 + row) * D + n0 + (TIDX & 15) * 8) = xn;
        }
    }
}

DEV void ph_moe_up_fast(const P& p, int l, unsigned char* lds) {
    const V v = make_views(p); const int TIDX = otid(), BIDX = obid();
    const int lane = TIDX & 63, wave = TIDX >> 6, wm = wave >> 1, wn = wave & 1, r = lane & 31, h = lane >> 5;
    const unsigned* cnt = v.ctl + CW_CNT + l * 32;
    int* tp = (int*)(lds + 67584); int* rb = tp + 40;
    __syncthreads();
    if (TIDX < 64) {
        const int c = TIDX < 32 ? (int)cnt[TIDX] : 0;
        int nu = ((c + 127) >> 7) * 8, cc = c;
#pragma unroll
        for (int o = 1; o < 32; o <<= 1) { const int a = __shfl_up(nu, o), b2 = __shfl_up(cc, o); if ((TIDX & 31) >= o) { nu += a; cc += b2; } }
        if (TIDX < 32) { tp[TIDX + 1] = nu; rb[TIDX + 1] = cc; if (TIDX == 0) { tp[0] = 0; rb[0] = 0; } }
    }
    __syncthreads();
    const int total = tp[32];
    unsigned char* ct = lds + 32768;
    struct UU { int e, base, nt, mt, nrow; const int* lst; const bf16_t* B; const bf16_t* ar[4]; };
    auto setup = [&](int unit, UU& u) {
        int e = 0;
#pragma unroll
        for (int st = 16; st > 0; st >>= 1) if (tp[e + st] <= unit) e += st;
        const int rem = unit - tp[e];
        u.e = e; u.base = rb[e]; u.nt = rem & 7; u.mt = rem >> 3;
        const int ce = rb[e + 1] - u.base;
        u.lst = v.list + (size_t)e * T + u.mt * 128;
        u.nrow = ce - u.mt * 128 < 128 ? ce - u.mt * 128 : 128;
        u.B = (const bf16_t*)(p.ws + WS_W13) + ((size_t)l * 32 + e) * 1024 * D + u.nt * 128;
#pragma unroll
        for (int i = 0; i < 4; ++i) { const int rr = (TIDX >> 3) + 32 * i; u.ar[i] = v.H + (size_t)(u.lst[rr < u.nrow ? rr : 0] >> 1) * D; }
    };
    int unit = BIDX;
    if (unit >= total) return;
    UU cu, nu;
    setup(unit, cu);
    __syncthreads();
    gemm_issue0(lds, cu.ar, cu.B, 1024, TIDX);
    for (;;) {
        const int un = unit + (int)gridDim.x;
        f32x16 acc[2][2];
        gemm128<false, true>(lds, cu.ar, cu.B, 1024, D, acc, TIDX);
        if (un < total) { setup(un, nu); gemm_issue0(lds, nu.ar, nu.B, 1024, TIDX); }
#pragma unroll
        for (int i = 0; i < 2; ++i)
#pragma unroll
            for (int g = 0; g < 4; ++g) {
                float o[4];
#pragma unroll
                for (int q = 0; q < 4; ++q) { const float a1 = acc[0][i][4 * g + q], a3 = acc[1][i][4 * g + q]; o[q] = a1 / (1.f + __expf(-a1)) * a3; }
                ctile_put(ct, 64 * wm + 32 * i + r, 32 * wn + 8 * g + 4 * h, o[0], o[1], o[2], o[3]);
            }
        bf16_t* hb = v.HID + (size_t)(cu.base + cu.mt * 128) * 512 + 64 * cu.nt;
        const int nrow = cu.nrow;
        ctile_flush<64>(ct, TIDX, [&](int row, int) { return row < nrow ? hb + (size_t)row * 512 : (bf16_t*)nullptr; });
        if (un >= total) break;
        unit = un; cu = nu;
    }
}
DEV void ph_moe_down_fast(const P& p, int l, unsigned char* lds) {
    const V v = make_views(p); const int TIDX = otid(), BIDX = obid();
    const int lane = TIDX & 63, wave = TIDX >> 6, wm = wave >> 1, wn = wave & 1, r = lane & 31, h = lane >> 5;
    const unsigned* cnt = v.ctl + CW_CNT + l * 32;
    int* tp = (int*)(lds + 67584); int* rb = tp + 40;
    __syncthreads();
    if (TIDX < 64) {
        const int c = TIDX < 32 ? (int)cnt[TIDX] : 0;
        int nu = ((c + 127) >> 7) * 8, cc = c;
#pragma unroll
        for (int o = 1; o < 32; o <<= 1) { const int a = __shfl_up(nu, o), b2 = __shfl_up(cc, o); if ((TIDX & 31) >= o) { nu += a; cc += b2; } }
        if (TIDX < 32) { tp[TIDX + 1] = nu; rb[TIDX + 1] = cc; if (TIDX == 0) { tp[0] = 0; rb[0] = 0; } }
    }
    __syncthreads();
    const int total = tp[32];
    unsigned char* ct = lds + 32768;
    struct UD { int n0, nrow; const bf16_t* B; const bf16_t* ar[4]; float wrow[2]; int fslot[8]; };
    auto setup = [&](int unit, UD& u) {
        int e = 0;
#pragma unroll
        for (int st = 16; st > 0; st >>= 1) if (tp[e + st] <= unit) e += st;
        const int rem = unit - tp[e], base = rb[e];
        const int ce = rb[e + 1] - base, nt = rem & 7, mt = rem >> 3;
        const int* lst = v.list + (size_t)e * T + mt * 128;
        u.n0 = nt * 128;
        u.nrow = ce - mt * 128 < 128 ? ce - mt * 128 : 128;
        u.B = (const bf16_t*)(p.ws + WS_W2) + ((size_t)l * 32 + e) * 512 * D + u.n0;
#pragma unroll
        for (int i = 0; i < 4; ++i) { const int rr = (TIDX >> 3) + 32 * i; u.ar[i] = v.HID + (size_t)(base + mt * 128 + (rr < u.nrow ? rr : 0)) * 512; }
#pragma unroll
        for (int i = 0; i < 2; ++i) { const int mr = 64 * wm + 32 * i + r; u.wrow[i] = mr < u.nrow ? v.wts[lst[mr]] : 0.f; }
#pragma unroll
        for (int it = 0; it < 8; ++it) { const int row = it * 16 + (TIDX >> 4); u.fslot[it] = row < u.nrow ? lst[row] : -1; }
    };
    int unit = BIDX;
    if (unit >= total) return;
    UD cu, nu;
    setup(unit, cu);
    __syncthreads();
    gemm_issue0(lds, cu.ar, cu.B, D, TIDX);
    for (;;) {
        const int un = unit + (int)gridDim.x;
        f32x16 acc[2][2];
        gemm128<false, true>(lds, cu.ar, cu.B, D, 512, acc, TIDX);
        if (un < total) { setup(un, nu); gemm_issue0(lds, nu.ar, nu.B, D, TIDX); }
#pragma unroll
        for (int i = 0; i < 2; ++i) {
            const int mr = 64 * wm + 32 * i + r;
            const float w = cu.wrow[i];
#pragma unroll
            for (int j = 0; j < 2; ++j)
#pragma unroll
                for (int g = 0; g < 4; ++g)
                    ctile_put(ct, mr, 64 * wn + 32 * j + 8 * g + 4 * h, w * acc[j][i][4 * g], w * acc[j][i][4 * g + 1], w * acc[j][i][4 * g + 2], w * acc[j][i][4 * g + 3]);
        }
        const int n0 = cu.n0;
        ctile_flush<128>(ct, TIDX, [&](int, int it) { const int sl = cu.fslot[it]; return sl >= 0 ? v.Y + (size_t)sl * D + n0 : (bf16_t*)nullptr; });
        if (un >= total) break;
        unit = un; cu = nu;
    }
}

constexpr float SB_EPS = 1e-12f;
constexpr float LOG2E = 1.4426950408889634f, C2 = 0.125f * 1.4426950408889634f, LN2 = 0.6931471805599453f;
DEV float fexp2(float x) { return __builtin_amdgcn_exp2f(x); }
DEV float flog2(float x) { return __builtin_amdgcn_logf(x); }
DEV int swap23(int r) { return (r & ~12) | ((r & 4) << 1) | ((r & 8) >> 1); }

struct KVT { const bf16_t* k; int ks; const bf16_t* v; int vs; };
DEV void kv_load(const KVT& s, int kv0, const int TIDX, u32x4 (&rg)[4]) {
    const int c = TIDX & 7, r0 = TIDX >> 3;
    rg[0] = *(const u32x4*)(s.k + (size_t)(kv0 + r0) * s.ks + c * 8);
    rg[1] = *(const u32x4*)(s.k + (size_t)(kv0 + r0 + 32) * s.ks + c * 8);
    rg[2] = *(const u32x4*)(s.v + (size_t)r0 * s.vs + kv0 + c * 8);
    rg[3] = *(const u32x4*)(s.v + (size_t)(r0 + 32) * s.vs + kv0 + c * 8);
}
DEV void kv_store(unsigned char* st, const int TIDX, const u32x4 (&rg)[4]) {
    const int c = TIDX & 7, r0 = TIDX >> 3;
    *(u32x4*)(st + tile_off(r0, c)) = rg[0]; *(u32x4*)(st + tile_off(r0 + 32, c)) = rg[1];
    *(u32x4*)(st + 8192 + tile_off(r0, c)) = rg[2]; *(u32x4*)(st + 8192 + tile_off(r0 + 32, c)) = rg[3];
}
DEV bf16x8 scale_frag(bf16x8 v, float sc) {
    u32x4 u = __builtin_bit_cast(u32x4, v);
#pragma unroll
    for (int i = 0; i < 4; ++i) u[i] = cvtpk(__uint_as_float(u[i] << 16) * sc, __uint_as_float(u[i] & 0xffff0000u) * sc);
    return __builtin_bit_cast(bf16x8, u);
}
DEV float xhalf(float x) {
    const auto s = __builtin_amdgcn_permlane32_swap(__float_as_uint(x), __float_as_uint(x), false, false);
    return __uint_as_float((threadIdx.x & 32) ? s[0] : s[1]);
}
DEV float xhalf_max(float x) {
    const auto s = __builtin_amdgcn_permlane32_swap(__float_as_uint(x), __float_as_uint(x), false, false);
    return fmaxf(__uint_as_float(s[0]), __uint_as_float(s[1]));
}
DEV float xhalf_sum(float x) {
    const auto s = __builtin_amdgcn_permlane32_swap(__float_as_uint(x), __float_as_uint(x), false, false);
    return __uint_as_float(s[0]) + __uint_as_float(s[1]);
}
#define SB0() __builtin_amdgcn_sched_barrier(0)
DEV void score_tile(const unsigned char* Kt, const bf16x8 (&qf)[4], int r, int h, f32x16 (&p)[2]) {
    const int kr = swap23(r);
    const unsigned char* kb = Kt + tile_off(kr, h);
    auto ld = [&](int i) { const int blk = i & 1, s = i >> 1; return *(const bf16x8*)(Kt + tile_off(32 * blk + kr, 2 * s + h)); };
    (void)kb;
    f32x16 z;
#pragma unroll
    for (int q = 0; q < 16; ++q) z[q] = 0.f;
    bf16x8 f0 = ld(0), f1 = ld(1), f2 = ld(2), f3 = ld(3);
    SB0();
    p[0] = __builtin_amdgcn_mfma_f32_32x32x16_bf16(f0, qf[0], z, 0, 0, 0); f0 = ld(4); SB0();
    p[1] = __builtin_amdgcn_mfma_f32_32x32x16_bf16(f1, qf[0], z, 0, 0, 0); f1 = ld(5); SB0();
    p[0] = __builtin_amdgcn_mfma_f32_32x32x16_bf16(f2, qf[1], p[0], 0, 0, 0); f2 = ld(6); SB0();
    p[1] = __builtin_amdgcn_mfma_f32_32x32x16_bf16(f3, qf[1], p[1], 0, 0, 0); f3 = ld(7); SB0();
    p[0] = __builtin_amdgcn_mfma_f32_32x32x16_bf16(f0, qf[2], p[0], 0, 0, 0); SB0();
    p[1] = __builtin_amdgcn_mfma_f32_32x32x16_bf16(f1, qf[2], p[1], 0, 0, 0); SB0();
    p[0] = __builtin_amdgcn_mfma_f32_32x32x16_bf16(f2, qf[3], p[0], 0, 0, 0); SB0();
    p[1] = __builtin_amdgcn_mfma_f32_32x32x16_bf16(f3, qf[3], p[1], 0, 0, 0); SB0();
}
DEV void pv_tile(const unsigned char* Vt, const f32x16 (&p)[2], int r, int h, f32x16 (&o)[2]) {
    auto ld = [&](int i) { const int db = i & 1, pr = i >> 1; return *(const bf16x8*)(Vt + tile_off(32 * db + r, 2 * pr + h)); };
    auto pk = [&](int pr) {
        const int blk = pr >> 1, s = pr & 1;
        u32x4 w;
        w.x = cvtpk(p[blk][8 * s], p[blk][8 * s + 1]); w.y = cvtpk(p[blk][8 * s + 2], p[blk][8 * s + 3]);
        w.z = cvtpk(p[blk][8 * s + 4], p[blk][8 * s + 5]); w.w = cvtpk(p[blk][8 * s + 6], p[blk][8 * s + 7]);
        return __builtin_bit_cast(bf16x8, w);
    };
    bf16x8 f0 = ld(0), f1 = ld(1), f2 = ld(2), f3 = ld(3);
    SB0();
    bf16x8 pb = pk(0);
    SB0();
    o[0] = __builtin_amdgcn_mfma_f32_32x32x16_bf16(f0, pb, o[0], 0, 0, 0); f0 = ld(4); SB0();
    o[1] = __builtin_amdgcn_mfma_f32_32x32x16_bf16(f1, pb, o[1], 0, 0, 0); f1 = ld(5); pb = pk(1); SB0();
    o[0] = __builtin_amdgcn_mfma_f32_32x32x16_bf16(f2, pb, o[0], 0, 0, 0); f2 = ld(6); SB0();
    o[1] = __builtin_amdgcn_mfma_f32_32x32x16_bf16(f3, pb, o[1], 0, 0, 0); f3 = ld(7); pb = pk(2); SB0();
    o[0] = __builtin_amdgcn_mfma_f32_32x32x16_bf16(f0, pb, o[0], 0, 0, 0); SB0();
    o[1] = __builtin_amdgcn_mfma_f32_32x32x16_bf16(f1, pb, o[1], 0, 0, 0); pb = pk(3); SB0();
    o[0] = __builtin_amdgcn_mfma_f32_32x32x16_bf16(f2, pb, o[0], 0, 0, 0); SB0();
    o[1] = __builtin_amdgcn_mfma_f32_32x32x16_bf16(f3, pb, o[1], 0, 0, 0); SB0();
}

template <int VAR>
DEV void attn_branch(unsigned char* lds, const KVT& src, const bf16x8 (&qf)[4], unsigned tmask, int wave_last, int t, int t_first,
                     unsigned selbits, const float* bias2, f32x16 (&o)[2], const int TIDX) {
    const int lane = TIDX & 63, r = lane & 31, h = lane >> 5;
    const float NEG_INF = -__builtin_inff();
    float mrun = -1e30f, lrun = 0.f, rest = VAR == 3 ? 1.f : 0.f;
#pragma unroll
    for (int db = 0; db < 2; ++db)
#pragma unroll
        for (int q = 0; q < 16; ++q) o[db][q] = 0.f;
    u32x4 rg[4];
    unsigned rem = tmask;
    unsigned wdone = 0u; int step = 0;
    volatile unsigned* sbf = (volatile unsigned*)(lds + 65536);
    int j = VAR == 3 ? 31 - __builtin_clz(rem) : __builtin_ctz(rem);
    rem &= ~(1u << j);
    kv_load(src, 64 * j, TIDX, rg);
    __syncthreads();
    kv_store(lds, TIDX, rg);
    __syncthreads();
    int stage = 0;
    for (;;) {
        int jn = -1;
        if (rem) { jn = VAR == 3 ? 31 - __builtin_clz(rem) : __builtin_ctz(rem); rem &= ~(1u << jn); kv_load(src, 64 * jn, TIDX, rg); }
        asm volatile("" ::: "memory"); __builtin_amdgcn_sched_barrier(0);
        if (j <= wave_last) {
            const unsigned char* Kt = lds + stage * 16384;
            f32x16 p[2];
            score_tile(Kt, qf, r, h, p);
            const int kvb = 64 * j + 8 * h;
            if (VAR == 3) {
                const bool diag = 64 * j + 63 >= t_first;
                float gt[2][2];
                if (diag) {
#pragma unroll
                    for (int blk = 0; blk < 2; ++blk)
#pragma unroll
                        for (int s = 0; s < 2; ++s) {
                            float run = 1.f;
#pragma unroll
                            for (int q = 7; q >= 0; --q) {
                                const float ez = fexp2(p[blk][8 * s + q]);
                                float w = __builtin_amdgcn_rcpf(1.f + ez);
                                float beta = 1.f - w;
                                const bool valid = kvb + 32 * blk + 16 * s + q < t;
                                w = valid ? w : 1.f; beta = valid ? beta : 0.f;
                                p[blk][8 * s + q] = beta * run;
                                run *= w;
                            }
                            gt[blk][s] = run;
                        }
                } else {
#pragma unroll
                    for (int blk = 0; blk < 2; ++blk)
#pragma unroll
                        for (int s = 0; s < 2; ++s) {
                            float run = 1.f;
#pragma unroll
                            for (int q = 7; q >= 0; --q) {
                                const float rn = run * __builtin_amdgcn_rcpf(1.f + fexp2(p[blk][8 * s + q]));
                                p[blk][8 * s + q] = run - rn;
                                run = rn;
                            }
                            gt[blk][s] = run;
                        }
                }
                float og[2][2], pt[2][2];
#pragma unroll
                for (int blk = 0; blk < 2; ++blk)
#pragma unroll
                    for (int s = 0; s < 2; ++s) { og[blk][s] = xhalf(gt[blk][s]); pt[blk][s] = gt[blk][s] * og[blk][s]; }
                float above = rest;
#pragma unroll
                for (int pi = 3; pi >= 0; --pi) {
                    const int blk = pi >> 1, s = pi & 1;
                    const float carry = above * (h == 0 ? og[blk][s] : 1.f);
#pragma unroll
                    for (int q = 0; q < 8; ++q) p[blk][8 * s + q] *= carry;
                    above *= pt[blk][s];
                }
                rest = above;
                wdone = __all(rest < SB_EPS) ? 1u : 0u;
            } else {
                const bool need_causal = 64 * j + 63 > t_first;
                const bool need_win = VAR == 1 && (64 * j + 512 <= t_first + 31);
                const bool lane_on = VAR != 0 || ((selbits >> j) & 1u);
                if (VAR == 2) {
#pragma unroll
                    for (int blk = 0; blk < 2; ++blk)
#pragma unroll
                        for (int s = 0; s < 2; ++s) {
                            const float4 b0 = *(const float4*)(bias2 + kvb + 32 * blk + 16 * s), b1 = *(const float4*)(bias2 + kvb + 32 * blk + 16 * s + 4);
                            p[blk][8 * s] += b0.x; p[blk][8 * s + 1] += b0.y; p[blk][8 * s + 2] += b0.z; p[blk][8 * s + 3] += b0.w;
                            p[blk][8 * s + 4] += b1.x; p[blk][8 * s + 5] += b1.y; p[blk][8 * s + 6] += b1.z; p[blk][8 * s + 7] += b1.w;
                        }
                }
                if (need_causal) {
#pragma unroll
                    for (int blk = 0; blk < 2; ++blk)
#pragma unroll
                        for (int q = 0; q < 16; ++q) { const int kv = kvb + 32 * blk + 16 * (q >> 3) + (q & 7); p[blk][q] = kv <= t ? p[blk][q] : NEG_INF; }
                }
                if (need_win) {
#pragma unroll
                    for (int blk = 0; blk < 2; ++blk)
#pragma unroll
                        for (int q = 0; q < 16; ++q) { const int kv = kvb + 32 * blk + 16 * (q >> 3) + (q & 7); p[blk][q] = kv + 512 > t ? p[blk][q] : NEG_INF; }
                }
                float tmax = p[0][0];
#pragma unroll
                for (int q = 1; q < 16; ++q) tmax = fmaxf(tmax, p[0][q]);
#pragma unroll
                for (int q = 0; q < 16; ++q) tmax = fmaxf(tmax, p[1][q]);
                tmax = lane_on ? tmax : NEG_INF;
                tmax = xhalf_max(tmax);
                const float mnew = fmaxf(mrun, tmax);
                const bool grew = mnew > mrun;
                const float alpha = fexp2(mrun - mnew);
                mrun = mnew;
                const float msub = lane_on ? mnew : __builtin_inff();
                const f32x2_t ms2 = {msub, msub};
                f32x2_t ls2 = {0.f, 0.f};
#pragma unroll
                for (int blk = 0; blk < 2; ++blk)
#pragma unroll
                    for (int q = 0; q < 16; q += 2) {
                        const f32x2_t d2 = (f32x2_t){p[blk][q], p[blk][q + 1]} - ms2;
                        f32x2_t e2; e2.x = fexp2(d2.x); e2.y = fexp2(d2.y);
                        p[blk][q] = e2.x; p[blk][q + 1] = e2.y; ls2 += e2;
                    }
                lrun = lrun * alpha + (ls2.x + ls2.y);
                if (__any(grew)) {
#pragma unroll
                    for (int db = 0; db < 2; ++db)
#pragma unroll
                        for (int q = 0; q < 16; ++q) o[db][q] *= alpha;
                }
            }
            pv_tile(Kt + 8192, p, r, h, o);
        }
        if (jn >= 0) kv_store(lds + (stage ^ 1) * 16384, TIDX, rg);
        if (VAR == 3 && lane == 0) sbf[(step & 1) * 4 + (TIDX >> 6)] = wdone;
        __syncthreads();
        if (jn < 0) break;
        if (VAR == 3) {
            const unsigned* f4 = (const unsigned*)sbf + (step & 1) * 4;
            if ((f4[0] & f4[1] & f4[2] & f4[3]) != 0u) break;
            ++step;
        }
        j = jn; stage ^= 1;
    }
    if (VAR != 3) {
        const float lt = xhalf_sum(lrun);
        const float inv = lt > 0.f ? 1.f / lt : 0.f;
#pragma unroll
        for (int db = 0; db < 2; ++db)
#pragma unroll
            for (int q = 0; q < 16; ++q) o[db][q] *= inv;
    }
}

DEV void head_norm_store(const f32x16 (&o)[2], const float* gam, bf16_t* dst, int h) {
    float ss = 0.f;
#pragma unroll
    for (int db = 0; db < 2; ++db)
#pragma unroll
        for (int q = 0; q < 16; ++q) ss += o[db][q] * o[db][q];
    ss += __shfl_xor(ss, 32);
    const float rinv = rsqrtf(ss * (1.f / 64.f) + EPS);
#pragma unroll
    for (int db = 0; db < 2; ++db)
#pragma unroll
        for (int g = 0; g < 4; ++g) {
            const int d = 32 * db + 8 * g + 4 * h;
            const float4 gg = *(const float4*)(gam + d);
            uint2 u;
            u.x = cvtpk(o[db][4 * g] * rinv * gg.x, o[db][4 * g + 1] * rinv * gg.y);
            u.y = cvtpk(o[db][4 * g + 2] * rinv * gg.z, o[db][4 * g + 3] * rinv * gg.w);
            *(uint2*)(dst + d) = u;
        }
}

template <int VAR>
DEV void mha_unit(const P& p, int l, int unit, unsigned char* lds) {
    const V v = make_views(p); const int TIDX = otid();
    const int lane = TIDX & 63, wave = TIDX >> 6, r = lane & 31, h = lane >> 5;
    const int qb = 15 - (unit >> 5), bh = unit & 31, b = bh >> 2, hh = bh & 3;
    const int t0 = qb * 128, tw = t0 + 32 * wave, t = tw + r, m = b * S + t;
    const int qcol = VAR == 2 ? C_QB : C_QC, kcol = VAR == 2 ? C_KB : C_KCC, vrow = VAR == 2 ? 256 : 512, ocol = VAR == 2 ? 512 : 768;
    bf16x8 qf[4];
#pragma unroll
    for (int s = 0; s < 4; ++s) qf[s] = scale_frag(*(const bf16x8*)(v.U + (size_t)m * NP + qcol + hh * 64 + 16 * s + 8 * h), C2);
    KVT src;
    src.k = v.U + (size_t)b * S * NP + kcol + hh * 64; src.ks = NP;
    src.v = (const bf16_t*)(p.ws + WS_VT) + (size_t)(b * 768 + vrow + hh * 64) * S; src.vs = S;
    const int last = (t0 + 127) >> 6;
    const unsigned tmask = last == 31 ? 0xffffffffu : ((1u << (last + 1)) - 1u);
    const float* bias2 = (const float*)(lds + 32768);
    if (VAR == 2) {
        float* cf = (float*)(lds + 32768);
        float* wt = (float*)(lds + 32768 + 8192);
        const float* lsf = (const float*)(p.ws + WS_LSF) + (size_t)(b * 4 + hh) * S;
        const int nel = t0 + 128;
        float x[8];
        if (8 * TIDX < nel) {
            const float4 a0 = *(const float4*)(lsf + 8 * TIDX), a1 = *(const float4*)(lsf + 8 * TIDX + 4);
            x[0] = a0.x; x[1] = x[0] + a0.y; x[2] = x[1] + a0.z; x[3] = x[2] + a0.w; x[4] = x[3] + a1.x; x[5] = x[4] + a1.y; x[6] = x[5] + a1.z; x[7] = x[6] + a1.w;
        } else {
#pragma unroll
            for (int q = 0; q < 8; ++q) x[q] = 0.f;
        }
        float inc = x[7];
#pragma unroll
        for (int o = 1; o < 64; o <<= 1) { const float tt = __shfl_up(inc, o); if (lane >= o) inc += tt; }
        __syncthreads();
        if (lane == 63) wt[wave] = inc;
        __syncthreads();
        float off = inc - x[7];
#pragma unroll
        for (int w = 0; w < 3; ++w) off += (w < wave) ? wt[w] : 0.f;
        if (8 * TIDX < nel) {
#pragma unroll
            for (int q = 0; q < 8; ++q) cf[8 * TIDX + q] = -(x[q] + off) * LOG2E;
        }
        __syncthreads();
    }
    f32x16 o[2];
    attn_branch<VAR>(lds, src, qf, tmask, (tw + 31) >> 6, t, tw, 0u, bias2, o, TIDX);
    head_norm_store(o, p.out_norm_g + (size_t)l * D + ocol + hh * 64, v.O + (size_t)m * D + ocol + hh * 64, h);
}

DEV void nsa_unit(const P& p, int l, int unit, unsigned char* lds) {
    const V v = make_views(p); const int TIDX = otid();
    const int lane = TIDX & 63, wave = TIDX >> 6, r = lane & 31, h = lane >> 5;
    const int qblk = 63 - (unit >> 4), bg = unit & 15, b = bg >> 1, g = bg & 1;
    const int t0 = qblk * 32, t = t0 + r, m = b * S + t, head = g * 4 + wave, cur = t0 >> 6;
    const float NEG_INF = -__builtin_inff();
    bf16x8 qf[4];
#pragma unroll
    for (int s = 0; s < 4; ++s) qf[s] = scale_frag(*(const bf16x8*)(v.U + (size_t)m * NP + C_QA + head * 64 + 16 * s + 8 * h), C2);
    const float g0 = sigmoidf_(v.gf[(size_t)m * 32 + head * 3]), g1 = sigmoidf_(v.gf[(size_t)m * 32 + head * 3 + 1]), g2 = sigmoidf_(v.gf[(size_t)m * 32 + head * 3 + 2]);
    f32x16 otot[2];
    float* PA = (float*)(lds + 32768);
    float* PB = (float*)(lds + 49152);
    float* SC = (float*)lds;
    unsigned* MASK = (unsigned*)(lds + 8192);
    {
        const bf16_t* ck = v.ck + (size_t)(b * 2 + g) * 128 * 64;
        const bf16_t* cvt = (const bf16_t*)(p.ws + WS_CVT) + (size_t)(b * 2 + g) * 64 * 128;
        const int c = TIDX & 7, r0 = TIDX >> 3;
        u32x4 rk[4], rv[4];
#pragma unroll
        for (int i = 0; i < 4; ++i) rk[i] = *(const u32x4*)(ck + (size_t)(r0 + 32 * i) * 64 + c * 8);
#pragma unroll
        for (int i = 0; i < 4; ++i) rv[i] = *(const u32x4*)(cvt + (size_t)(r0 + 32 * (i & 1)) * 128 + 64 * (i >> 1) + c * 8);
        __syncthreads();
#pragma unroll
        for (int i = 0; i < 4; ++i) *(u32x4*)(lds + tile_off(r0 + 32 * i, c)) = rk[i];
#pragma unroll
        for (int i = 0; i < 4; ++i) *(u32x4*)(lds + 16384 + 8192 * (i >> 1) + tile_off(r0 + 32 * (i & 1), c)) = rv[i];
        __syncthreads();
        f32x16 ps[2][2];
        score_tile(lds, qf, r, h, ps[0]);
        score_tile(lds + 8192, qf, r, h, ps[1]);
        const int nvalid = t >= 31 ? (t - 31) / 16 + 1 : 0;
        float mx = NEG_INF;
#pragma unroll
        for (int tt = 0; tt < 2; ++tt)
#pragma unroll
            for (int blk = 0; blk < 2; ++blk)
#pragma unroll
                for (int q = 0; q < 16; ++q) {
                    const int n = 64 * tt + 32 * blk + 16 * (q >> 3) + 8 * h + (q & 7);
                    const float x = n < nvalid ? ps[tt][blk][q] : NEG_INF;
                    ps[tt][blk][q] = x; mx = fmaxf(mx, x);
                }
        mx = fmaxf(mx, __shfl_xor(mx, 32));
        const float mxs = nvalid > 0 ? mx : 0.f;
        float ls = 0.f;
#pragma unroll
        for (int tt = 0; tt < 2; ++tt)
#pragma unroll
            for (int blk = 0; blk < 2; ++blk)
#pragma unroll
                for (int q = 0; q < 16; ++q) { const float e = fexp2(ps[tt][blk][q] - mxs); ps[tt][blk][q] = e; ls += e; }
        const float lt = ls + __shfl_xor(ls, 32);
        const float inv = lt > 0.f ? 1.f / lt : 0.f;
#pragma unroll
        for (int tt = 0; tt < 2; ++tt)
#pragma unroll
            for (int blk = 0; blk < 2; ++blk) {
#pragma unroll
                for (int q = 0; q < 16; ++q) ps[tt][blk][q] *= inv;
#pragma unroll
                for (int s = 0; s < 2; ++s) {
                    const int G0 = 16 * tt + 8 * blk + 4 * s + 2 * h;
                    const float a0 = (ps[tt][blk][8 * s] + ps[tt][blk][8 * s + 1]) + (ps[tt][blk][8 * s + 2] + ps[tt][blk][8 * s + 3]);
                    const float a1 = (ps[tt][blk][8 * s + 4] + ps[tt][blk][8 * s + 5]) + (ps[tt][blk][8 * s + 6] + ps[tt][blk][8 * s + 7]);
                    PA[(wave * 32 + G0) * 32 + r] = a0; PA[(wave * 32 + G0 + 1) * 32 + r] = a1;
                    PB[(wave * 32 + G0 + 1) * 32 + r] = ps[tt][blk][8 * s + 3];
                    if (G0 + 2 < 32) PB[(wave * 32 + G0 + 2) * 32 + r] = ps[tt][blk][8 * s + 7];
                }
            }
        f32x16 oc[2];
#pragma unroll
        for (int db = 0; db < 2; ++db)
#pragma unroll
            for (int q = 0; q < 16; ++q) oc[db][q] = 0.f;
        pv_tile(lds + 16384, ps[0], r, h, oc);
        pv_tile(lds + 24576, ps[1], r, h, oc);
#pragma unroll
        for (int db = 0; db < 2; ++db)
#pragma unroll
            for (int q = 0; q < 16; ++q) otot[db][q] = g0 * oc[db][q];
    }
    __syncthreads();
    const bool need_topk = cur > 15;
    if (need_topk) {
        const int q = TIDX & 31, j0 = (TIDX >> 5) * 4;
#pragma unroll
        for (int jj = 0; jj < 4; ++jj) {
            const int j = j0 + jj;
            float sc = 0.f;
#pragma unroll
            for (int w = 0; w < 4; ++w) sc += PA[(w * 32 + j) * 32 + q];
            if (j > 0) {
#pragma unroll
                for (int w = 0; w < 4; ++w) sc += PB[(w * 32 + j) * 32 + q];
            }
            const bool forced = (j == 0) || (j == cur) || (j == cur - 1);
            SC[q * 33 + j] = forced ? 1.0e4f : (j <= cur ? sc : -1.0f);
        }
        if (TIDX < 32) MASK[TIDX] = 0u;
        __syncthreads();
        unsigned bits = 0u;
#pragma unroll
        for (int jj = 0; jj < 4; ++jj) {
            const int j = j0 + jj;
            const float vj = SC[q * 33 + j];
            int rank = 0;
#pragma unroll
            for (int i = 0; i < 32; ++i) { const float vi = SC[q * 33 + i]; rank += (vi > vj || (vi == vj && i < j)) ? 1 : 0; }
            if (rank < 16) bits |= 1u << j;
        }
        atomicOr(&MASK[q], bits);
        __syncthreads();
    }
    const unsigned upto = (2u << cur) - 1u;
    unsigned mybits = upto, um = upto;
    if (need_topk) {
        mybits = MASK[r];
        um = 0u;
#pragma unroll
        for (int i = 0; i < 32; ++i) um |= MASK[i];
        um = (unsigned)__builtin_amdgcn_readfirstlane((int)um);
    }
    {
        KVT src; src.k = v.U + (size_t)b * S * NP + C_KS + g * 64; src.ks = NP;
        src.v = (const bf16_t*)(p.ws + WS_VT) + (size_t)(b * 768 + g * 64) * S; src.vs = S;
        f32x16 o[2];
        attn_branch<0>(lds, src, qf, um & upto, cur, t, t0, mybits, nullptr, o, TIDX);
#pragma unroll
        for (int db = 0; db < 2; ++db)
#pragma unroll
            for (int q = 0; q < 16; ++q) otot[db][q] += g1 * o[db][q];
    }
    {
        KVT src; src.k = v.U + (size_t)b * S * NP + C_KW + g * 64; src.ks = NP;
        src.v = (const bf16_t*)(p.ws + WS_VT) + (size_t)(b * 768 + 128 + g * 64) * S; src.vs = S;
        const int f = (t0 - 511 > 0 ? t0 - 511 : 0) >> 6;
        const unsigned wmask = upto & ~((1u << f) - 1u);
        f32x16 o[2];
        attn_branch<1>(lds, src, qf, wmask, cur, t, t0, 0u, nullptr, o, TIDX);
#pragma unroll
        for (int db = 0; db < 2; ++db)
#pragma unroll
            for (int q = 0; q < 16; ++q) otot[db][q] += g2 * o[db][q];
    }
    head_norm_store(otot, p.out_norm_g + (size_t)l * D + head * 64, v.O + (size_t)m * D + head * 64, h);
}

constexpr int CW_CMPK = 12288;
DEV bool cmp_unit(const P& p, int l, int unit, int kq, unsigned char* lds, volatile LAS unsigned* qslot) {
    const V v = make_views(p); const int TIDX = otid();
    const int lane = TIDX & 63, wave = TIDX >> 6, wm = wave >> 1, wn = wave & 1, r = lane & 31, h = lane >> 5;
    const int kv = unit & 1, bg = unit >> 1, b = bg >> 1, g = bg & 1, lk = l * 2 + kv;
    const int col = (kv ? C_VC : C_KC) + g * 64;
    const bf16_t* arow[4];
#pragma unroll
    for (int i = 0; i < 4; ++i) { const int n = (TIDX >> 3) + 32 * i; arow[i] = v.U + (size_t)(b * S + 16 * (n < 127 ? n : 126) + 8 * kq) * NP + col; }
    f32x16 acc[2][2];
    gemm128<false>(lds, arow, (const bf16_t*)(p.ws + WS_CW1) + (size_t)lk * 2048 * 128 + (size_t)kq * 512 * 128, 128, 512, acc, TIDX, NP);
    {
        const __amdgpu_buffer_rsrc_t prs = __builtin_amdgcn_make_buffer_rsrc((void*)v.OB, (short)0, 32 * 4 * 65536, 0x00020000);
        const unsigned pbase = (unsigned)(unit * 4 + kq) * 65536u + (unsigned)TIDX * 16u;
#pragma unroll
        for (int j = 0; j < 2; ++j)
#pragma unroll
            for (int i = 0; i < 2; ++i)
#pragma unroll
                for (int g4 = 0; g4 < 4; ++g4) {
                    const f32x4v a = {acc[j][i][4 * g4], acc[j][i][4 * g4 + 1], acc[j][i][4 * g4 + 2], acc[j][i][4 * g4 + 3]};
                    __builtin_amdgcn_raw_buffer_store_b128(__builtin_bit_cast(u32x4, a), prs, pbase + (unsigned)((j * 2 + i) * 4 + g4) * 4096u, 0,   16);
                }
        asm volatile("s_waitcnt vmcnt(0)" ::: "memory");
        __syncthreads();
        if (TIDX == 0) *qslot = __hip_atomic_fetch_add(v.ctl + CW_CMPK + l * 32 + unit, 1u, __ATOMIC_RELAXED, __HIP_MEMORY_SCOPE_AGENT);
        __syncthreads();
        if (*qslot != 3u) return false;
        if (TIDX == 0) { __builtin_amdgcn_fence(__ATOMIC_ACQUIRE, "agent"); asm volatile("s_waitcnt vmcnt(0)" ::: "memory"); }
        __syncthreads();
        const float* pp = v.OB + (size_t)unit * 4 * 16384 + TIDX * 4;
#pragma unroll
        for (int j = 0; j < 2; ++j)
#pragma unroll
            for (int i = 0; i < 2; ++i)
#pragma unroll
                for (int g4 = 0; g4 < 4; ++g4) {
                    const float* q0 = pp + ((j * 2 + i) * 4 + g4) * 1024;
                    f32x4v a = *(const f32x4v*)q0;
#pragma unroll
                    for (int k2 = 1; k2 < 4; ++k2) { const f32x4v b2 = *(const f32x4v*)(q0 + k2 * 16384); a += b2; }
                    acc[j][i][4 * g4] = a[0]; acc[j][i][4 * g4 + 1] = a[1]; acc[j][i][4 * g4 + 2] = a[2]; acc[j][i][4 * g4 + 3] = a[3];
                }
    }
    const float* pb = (const float*)(p.ws + WS_CPB) + lk * 8 * 128;
#pragma unroll
    for (int j = 0; j < 2; ++j)
#pragma unroll
        for (int i = 0; i < 2; ++i) {
            const int mrow = 64 * wm + 32 * i + r;
#pragma unroll
            for (int g4 = 0; g4 < 4; ++g4) {
                float4 bb = *(const float4*)(pb + 64 * wn + 32 * j + 8 * g4 + 4 * h);
#pragma unroll
                for (int c8 = 1; c8 < 8; ++c8) { const float4 b2 = *(const float4*)(pb + c8 * 128 + 64 * wn + 32 * j + 8 * g4 + 4 * h); bb.x += b2.x; bb.y += b2.y; bb.z += b2.z; bb.w += b2.w; }
                float x0 = acc[j][i][4 * g4] + bb.x, x1 = acc[j][i][4 * g4 + 1] + bb.y, x2 = acc[j][i][4 * g4 + 2] + bb.z, x3 = acc[j][i][4 * g4 + 3] + bb.w;
                x0 = x0 / (1.f + __expf(-x0)); x1 = x1 / (1.f + __expf(-x1)); x2 = x2 / (1.f + __expf(-x2)); x3 = x3 / (1.f + __expf(-x3));
                uint2 u; u.x = cvtpk(x0, x1); u.y = cvtpk(x2, x3);
                *(uint2*)(lds + wn * 16384 + tile_off(mrow, 4 * j + g4) + 8 * h) = u;
            }
        }
    {
        const bf16_t* w2 = (const bf16_t*)(p.ws + WS_CW2) + (size_t)lk * 64 * 128;
        const int c = TIDX & 7, r0 = TIDX >> 3;
#pragma unroll
        for (int i = 0; i < 4; ++i) {
            const int row = r0 + 32 * (i & 1), kt = i >> 1;
            *(u32x4*)(lds + 32768 + kt * 8192 + tile_off(row, c)) = *(const u32x4*)(w2 + (size_t)row * 128 + kt * 64 + c * 8);
        }
    }
    __syncthreads();
    f32x16 a2[2];
#pragma unroll
    for (int db = 0; db < 2; ++db)
#pragma unroll
        for (int q = 0; q < 16; ++q) a2[db][q] = 0.f;
#pragma unroll
    for (int kt = 0; kt < 2; ++kt)
#pragma unroll
        for (int s = 0; s < 4; ++s) {
            const bf16x8 hf = *(const bf16x8*)(lds + kt * 16384 + tile_off(32 * wave + r, 2 * s + h));
#pragma unroll
            for (int db = 0; db < 2; ++db) {
                const bf16x8 wf = *(const bf16x8*)(lds + 32768 + kt * 8192 + tile_off(32 * db + r, 2 * s + h));
                a2[db] = __builtin_amdgcn_mfma_f32_32x32x16_bf16(wf, hf, a2[db], 0, 0, 0);
            }
        }
    const int n = 32 * wave + r;
    if (kv == 0 && n < 127) {
        const int pos = 16 * n + 31;
#pragma unroll
        for (int q = 0; q < 4; ++q) {
            const float cs = v.rcos[pos * 8 + q + 4 * h], sn = v.rsin[pos * 8 + q + 4 * h];
            const float x1 = a2[0][q], x2 = a2[0][q + 4];
            a2[0][q] = x1 * cs - x2 * sn; a2[0][q + 4] = x2 * cs + x1 * sn;
        }
    }
    bf16_t* dst = (kv ? v.cv : v.ck) + ((size_t)bg * 128 + n) * 64;
    bf16_t* dt = (bf16_t*)(p.ws + WS_CVT) + (size_t)bg * 64 * 128 + n;
#pragma unroll
    for (int db = 0; db < 2; ++db)
#pragma unroll
        for (int g4 = 0; g4 < 4; ++g4) {
            const int d = 32 * db + 8 * g4 + 4 * h;
            float x0 = a2[db][4 * g4], x1 = a2[db][4 * g4 + 1], x2 = a2[db][4 * g4 + 2], x3 = a2[db][4 * g4 + 3];
            if (n >= 127) { x0 = 0.f; x1 = 0.f; x2 = 0.f; x3 = 0.f; }
            uint2 u; u.x = cvtpk(x0, x1); u.y = cvtpk(x2, x3);
            *(uint2*)(dst + d) = u;
            if (kv) { dt[(size_t)d * 128] = (bf16_t)(u.x & 0xffffu); dt[(size_t)(d + 1) * 128] = (bf16_t)(u.x >> 16); dt[(size_t)(d + 2) * 128] = (bf16_t)(u.y & 0xffffu); dt[(size_t)(d + 3) * 128] = (bf16_t)(u.y >> 16); }
        }
    __syncthreads();
    return true;
}

typedef float f32x4m __attribute__((ext_vector_type(4)));
DEV void ph_norm2_router_fast(const P& p, int l, unsigned char* lds) {
    const V v = make_views(p); const int TIDX = otid(), BIDX = obid();
    const int lane = TIDX & 63, wave = TIDX >> 6;
    const bf16_t* wr = (const bf16_t*)(p.ws + WS_WR) + (size_t)l * 2 * 64 * D;
    float* LG = (float*)(lds + 65536);
    for (int blk = BIDX; blk < T / 16; blk += gridDim.x) {
        const int m0 = blk * 16, b = m0 >> 11;
        const float* md = v.mod + (size_t)(l * 8 + b) * 6144;
        float4 xv[4][4]; float ssq[4];
#pragma unroll
        for (int rr = 0; rr < 4; ++rr)
#pragma unroll
            for (int j = 0; j < 4; ++j) xv[rr][j] = ld_bf4(v.XB + (size_t)(m0 + wave * 4 + rr) * D + 4 * lane + 256 * j);
#pragma unroll
        for (int rr = 0; rr < 4; ++rr) {
            ssq[rr] = 0.f;
#pragma unroll
            for (int j = 0; j < 4; ++j) ssq[rr] += xv[rr][j].x * xv[rr][j].x + xv[rr][j].y * xv[rr][j].y + xv[rr][j].z * xv[rr][j].z + xv[rr][j].w * xv[rr][j].w;
        }
#pragma unroll
        for (int o = 1; o < 64; o <<= 1) {
#pragma unroll
            for (int rr = 0; rr < 4; ++rr) ssq[rr] += __shfl_xor(ssq[rr], o);
        }
#pragma unroll
        for (int rr = 0; rr < 4; ++rr) {
            const int row = wave * 4 + rr, m = m0 + row;
            const float rs = rsqrtf(ssq[rr] * (1.f / D) + EPS);
#pragma unroll
            for (int j = 0; j < 4; ++j) {
                const int c = 4 * lane + 256 * j;
                const float4 g = *(const float4*)(p.norm2_g + l * D + c), sh = *(const float4*)(md + 3 * D + c), sc = *(const float4*)(md + 4 * D + c);
                const float h0 = xv[rr][j].x * rs * g.x * (1.f + sc.x) + sh.x, h1 = xv[rr][j].y * rs * g.y * (1.f + sc.y) + sh.y;
                const float h2 = xv[rr][j].z * rs * g.z * (1.f + sc.z) + sh.z, h3 = xv[rr][j].w * rs * g.w * (1.f + sc.w) + sh.w;
                uint2 hi; hi.x = cvtpk(h0, h1); hi.y = cvtpk(h2, h3);
                uint2 lo;
                lo.x = cvtpk(h0 - __uint_as_float(hi.x << 16), h1 - __uint_as_float(hi.x & 0xffff0000u));
                lo.y = cvtpk(h2 - __uint_as_float(hi.y << 16), h3 - __uint_as_float(hi.y & 0xffff0000u));
                *(uint2*)(v.H + (size_t)m * D + c) = hi;
                const int off = row * 2048 + ((((c >> 3) ^ row) & 127) << 4) + (c & 7) * 2;
                *(uint2*)(lds + off) = hi; *(uint2*)(lds + 32768 + off) = lo;
            }
        }
        __syncthreads();
        {
            const int r16 = lane & 15, kq = lane >> 4;
            f32x4m acc = {0.f, 0.f, 0.f, 0.f};
            const bf16_t* wh = wr + (size_t)(16 * wave + r16) * D + 8 * kq;
#pragma unroll 8
            for (int s = 0; s < 32; ++s) {
                const int off = r16 * 2048 + ((((4 * s + kq) ^ r16) & 127) << 4);
                const bf16x8 ah = *(const bf16x8*)(lds + off), al = *(const bf16x8*)(lds + 32768 + off);
                const bf16x8 bh = *(const bf16x8*)(wh + 32 * s), bl = *(const bf16x8*)(wh + 64 * D + 32 * s);
                acc = __builtin_amdgcn_mfma_f32_16x16x32_bf16(ah, bh, acc, 0, 0, 0);
                acc = __builtin_amdgcn_mfma_f32_16x16x32_bf16(al, bh, acc, 0, 0, 0);
                acc = __builtin_amdgcn_mfma_f32_16x16x32_bf16(ah, bl, acc, 0, 0, 0);
            }
#pragma unroll
            for (int q = 0; q < 4; ++q) LG[(4 * kq + q) * 64 + 16 * wave + r16] = acc[q];
        }
        __syncthreads();
        if (TIDX < 16) {
            const int m = m0 + TIDX;
            const float* lgp = LG + TIDX * 64;
            float lg[4], le[32];
#pragma unroll
            for (int i = 0; i < 4; ++i) lg[i] = lgp[i] + p.rg_b[l * 4 + i];
#pragma unroll
            for (int i = 0; i < 32; ++i) le[i] = lgp[4 + i] + p.re_b[l * 32 + i];
            int gi = 0; float gm = lg[0];
#pragma unroll
            for (int i = 1; i < 4; ++i) if (lg[i] > gm) { gm = lg[i]; gi = i; }
            float gs = 0.f;
#pragma unroll
            for (int i = 0; i < 4; ++i) gs += expf(lg[i] - gm);
            const float pg = 1.f / gs;
            float el[8];
#pragma unroll
            for (int i = 0; i < 8; ++i) el[i] = gi == 0 ? le[i] : (gi == 1 ? le[8 + i] : (gi == 2 ? le[16 + i] : le[24 + i]));
            int e1 = 0; float m1 = el[0];
#pragma unroll
            for (int i = 1; i < 8; ++i) if (el[i] > m1) { m1 = el[i]; e1 = i; }
            int e2 = -1; float m2 = -3.0e38f;
#pragma unroll
            for (int i = 0; i < 8; ++i) if (i != e1 && el[i] > m2) { m2 = el[i]; e2 = i; }
            const float p2 = expf(m2 - m1);
            const float w1 = pg / (1.f + p2), w2 = pg * p2 / (1.f + p2);
            const int ea = gi * 8 + e1, eb = gi * 8 + e2;
            const unsigned pa = atomicAdd(v.ctl + CW_CNT + l * 32 + ea, 1u);
            const unsigned pb = atomicAdd(v.ctl + CW_CNT + l * 32 + eb, 1u);
            v.list[(size_t)ea * T + pa] = 2 * m;
            v.list[(size_t)eb * T + pb] = 2 * m + 1;
            v.wts[2 * m] = w1; v.wts[2 * m + 1] = w2;
        }
        __syncthreads();
    }
}

constexpr int CW_MQ = 8192 + 512;
DEV void ph_mix(const P& p, int l, unsigned char* lds, volatile LAS unsigned* qslot, int rep) {
    const int TIDX = otid(), BIDX = obid();
    unsigned* ctl = (unsigned*)(p.ws + WS_CTL) + CW_MQ + l * 256;
    unsigned acq = 0u;
    int b = BIDX & 7;
    {
        for (;;) {
            unsigned* qc = ctl + b * 16;
            unsigned* done = ctl + 128 + b * 16;
            __syncthreads();
            if (TIDX == 0) {
                unsigned tk = atomicAdd(qc, 1u), nb = (unsigned)b;
                if (tk >= 272u) {
                    unsigned hd[8];
#pragma unroll
                    for (int q = 0; q < 8; ++q) hd[q] = __hip_atomic_load(ctl + ((b + q) & 7) * 16, __ATOMIC_RELAXED, __HIP_MEMORY_SCOPE_AGENT);
                    nb = 8u;
#pragma unroll
                    for (int q = 7; q >= 1; --q) if (hd[q] < 272u) nb = (unsigned)((b + q) & 7);
                }
                *qslot = tk | (nb << 16);
            }
            __syncthreads();
            const unsigned qv = *qslot;
            const int v = (int)(qv & 0xffffu);
            if (v >= 272) {
                const int nb = (int)(qv >> 16);
                if (nb >= 8) break;
                b = nb; continue;
            }
            if (v < 16) {
                if (cmp_unit(p, l, b * 4 + (v >> 2), v & 3, lds, qslot)) {
                    asm volatile("s_waitcnt vmcnt(0)" ::: "memory");
                    __syncthreads();
                    if (TIDX == 0) {
                        __builtin_amdgcn_fence(__ATOMIC_RELEASE, "agent");
                        asm volatile("s_waitcnt vmcnt(0)" ::: "memory");
                        __hip_atomic_fetch_add(done, 1u, __ATOMIC_RELAXED, __HIP_MEMORY_SCOPE_AGENT);
                    }
                }
                continue;
            }
            int slot = -1, nsa = -1;
            if (v < 48) slot = 2 * (v - 16);
            else if (v < 112) slot = 2 * (v - 48) + 1;
            else { const int w2 = v - 112, k = w2 % 5, i = w2 / 5; if (k < 4) nsa = 4 * i + k; else slot = 2 * (32 + i); }
            if (slot >= 0) {
                const int idx = slot >> 1, u = ((idx >> 2) << 5) | (b * 4 + (idx & 3));
                if (slot & 1) mha_unit<3>(p, l, u, lds); else mha_unit<2>(p, l, u, lds);
            } else {
                if (!((acq >> b) & 1u)) {
                    if (TIDX == 0) {
                        unsigned sp = 0;
                        while (__hip_atomic_load(done, __ATOMIC_RELAXED, __HIP_MEMORY_SCOPE_AGENT) < 4u) { __builtin_amdgcn_s_sleep(2); if (++sp > (1u << 22)) break; }
                        __builtin_amdgcn_fence(__ATOMIC_ACQUIRE, "agent");
                        asm volatile("s_waitcnt vmcnt(0)" ::: "memory");
                    }
                    __syncthreads();
                    acq |= 1u << b;
                }
                nsa_unit(p, l, ((nsa >> 1) << 4) | (b * 2 + (nsa & 1)), lds);
            }
        }
    }
}

#ifndef REP_PHASE
#define REP_PHASE 0
#endif
#ifndef REF_HEADS
#define REF_HEADS 0x0000u
#endif
__global__ void __launch_bounds__(256, 2) fwd_kernel(P p) {
    __shared__ __attribute__((aligned(16))) float lds[17408];
    __shared__ __attribute__((aligned(16))) unsigned lds_ctl[4];
    if (threadIdx.x < 4) lds_ctl[threadIdx.x] = 0u;
    __syncthreads();
    const XcdBarrier xb = xcd_barrier_post((unsigned*)(p.ws + WS_CTL), (volatile LAS unsigned*)lds_ctl);
#define GRID_BAR() do { xcd_barrier(xb); if (REP_PHASE == 7) xcd_barrier(xb); } while (0)
    volatile LAS unsigned* qslot = (volatile LAS unsigned*)(lds_ctl + 2);
    for (int rep = 0; rep < (REP_PHASE == 1 ? 2 : 1); ++rep) {
        ph_prologue(p, lds);
        ph_convert(p, lds);
        GRID_BAR();
    }
    for (int l = 0; l < DEPTH; ++l) {
        ph_convert_dense(p, l, 0);
        ph_norm1(p, l, l == 0 ? 0 : 1);
        GRID_BAR();
        for (int rep = 0; rep < (REP_PHASE == 2 ? 2 : 1); ++rep) {
            if (rep == 0) ph_convert_dense(p, l, 1);
            ph_inproj_fast(p, l, (unsigned char*)lds);
            GRID_BAR();
        }
        for (int rep = 0; rep < (REP_PHASE == 3 ? 2 : 1); ++rep) {
            ph_mix(p, l, (unsigned char*)lds, qslot, rep);
            GRID_BAR();
        }
        ph_outproj_fast(p, l, (unsigned char*)lds);
        GRID_BAR();
        if (blockIdx.x & 8) { ph_convert_experts(p, l); ph_norm2_router_fast(p, l, (unsigned char*)lds); }
        else { ph_norm2_router_fast(p, l, (unsigned char*)lds); ph_convert_experts(p, l); }
        GRID_BAR();
        for (int rep = 0; rep < (REP_PHASE == 5 ? 2 : 1); ++rep) {
            ph_moe_up_fast(p, l, (unsigned char*)lds);
            GRID_BAR();
        }
        for (int rep = 0; rep < (REP_PHASE == 6 ? 2 : 1); ++rep) {
            ph_moe_down_fast(p, l, (unsigned char*)lds);
            GRID_BAR();
        }
    }
    ph_norm1(p, DEPTH, 2);
}

extern "C" void kernel_launch(void* const* d_in, const int* in_sizes, int n_in,
                              void* d_out, int out_size, void* d_ws, size_t ws_size,
                              hipStream_t stream) {
    static int grid_blocks = 0;
    if (!grid_blocks) {
        int dev = 0, cus = 0, per_cu = 0;
        (void)hipGetDevice(&dev);
        (void)hipDeviceGetAttribute(&cus, hipDeviceAttributeMultiprocessorCount, dev);
        (void)hipOccupancyMaxActiveBlocksPerMultiprocessor(&per_cu, fwd_kernel, 256, 0);
        if (per_cu > 2) per_cu = 2;
        if (per_cu < 1) per_cu = 1;
        grid_blocks = cus * per_cu;
        if (n_in != 24 || ws_size < WS_END || out_size != T * D) { fprintf(stderr, "kernel_launch: unexpected shapes (n_in %d ws %zu out %d)\n", n_in, ws_size, out_size); grid_blocks = -1; }
    }
    if (grid_blocks < 0) return;
    (void)hipMemsetAsync(d_ws, 0, CTL_BYTES, stream);
    P p{};
    const float** pp = (const float**)&p;
    for (int i = 0; i < 24; ++i) pp[i] = (const float*)d_in[i];
    p.out = (float*)d_out; p.ws = (unsigned char*)d_ws;
    void* args[] = {&p};
    hipError_t e = hipLaunchCooperativeKernel((void*)fwd_kernel, dim3(grid_blocks), dim3(256), args, 0, stream);
    if (e != hipSuccess) fprintf(stderr, "cooperative launch failed: %s (grid %d)\n", hipGetErrorString(e), grid_blocks);
}
```

```cpp
#include <hip/hip_runtime.h>
#include <hip/hip_cooperative_groups.h>
#include <cstdio>
#include <cstdint>

#define LAS __attribute__((address_space(3)))
#define DEV __device__ __forceinline__

constexpr int T = 16384, S = 2048, NB = 8, D = 1024, DIN = 2844, NP = 2880, DEPTH = 4;
constexpr int NCMP = 127;
constexpr float EPS = 1e-6f;
constexpr float SCALE = 0.125f;
constexpr int C_QA = 0, C_KC = 512, C_VC = 640, C_KS = 768, C_VS = 896, C_KW = 1024, C_VW = 1152;
constexpr int C_QB = 1280, C_KB = 1536, C_VB = 1792, C_QC = 2048, C_KCC = 2304, C_VCC = 2560;

constexpr size_t MiB = 1u << 20;
constexpr size_t WS_CTL = 0, CTL_BYTES = 64 * 1024;
constexpr size_t WS_MOD = 1 * MiB, WS_ROPE = 2 * MiB, WS_CUMF = 3 * MiB, WS_CK = 4 * MiB, WS_CV = 5 * MiB, WS_IMP = 6 * MiB;
constexpr size_t WS_SEL = 10 * MiB, WS_EID = 11 * MiB, WS_WTS = 12 * MiB, WS_LIST = 13 * MiB, WS_GF = 16 * MiB;
constexpr size_t WS_H = 32 * MiB, WS_U = 64 * MiB, WS_O = 160 * MiB, WS_HID = 192 * MiB, WS_Y = 224 * MiB, WS_OB = 352 * MiB, WS_ORAW = 448 * MiB;
constexpr size_t WS_END = 973 * MiB;
constexpr size_t WS_VT = 936 * MiB;
constexpr size_t WS_CVT = 962 * MiB;
constexpr size_t WS_CUMF2 = 963 * MiB;
constexpr int CW_Q = 8192 + 256;
constexpr size_t WS_CW1 = 964 * MiB;
constexpr size_t WS_CW2 = 968 * MiB;
constexpr size_t WS_CPB = 969 * MiB;
constexpr size_t WS_LSF = 970 * MiB;
constexpr size_t WS_WR = 971 * MiB;
constexpr int CW_CNT = 8192;
constexpr int CW_KN = 12544;

typedef unsigned short bf16_t;
typedef float f32x4v __attribute__((ext_vector_type(4)));
DEV int vt_row(int n) { return n < 1024 ? n - 896 : (n < 1280 ? 128 + n - 1152 : (n < 2048 ? 256 + n - 1792 : 512 + n - 2560)); }
DEV bool is_vcol(int n) { return (n >= C_VS && n < C_KW) || (n >= C_VW && n < C_QB) || (n >= C_VB && n < C_QC) || (n >= C_VCC && n < 2816); }
DEV float bf2f(bf16_t v) { return __uint_as_float((unsigned)v << 16); }
DEV bf16_t f2bf(float f) { unsigned u = __float_as_uint(f); return (bf16_t)((u + 0x7fffu + ((u >> 16) & 1u)) >> 16); }
DEV float4 ld_bf4(const bf16_t* p) { const ushort4 u = *(const ushort4*)p; return make_float4(bf2f(u.x), bf2f(u.y), bf2f(u.z), bf2f(u.w)); }
typedef float f32x2_t __attribute__((ext_vector_type(2)));
typedef __bf16 bf16x2_t __attribute__((ext_vector_type(2)));
DEV unsigned cvtpk(float lo, float hi) { f32x2_t v = {lo, hi}; bf16x2_t b = __builtin_convertvector(v, bf16x2_t); return __builtin_bit_cast(unsigned, b); }
DEV float sigmoidf_(float x) { return 1.f / (1.f + expf(-x)); }
DEV float logsigmoidf_(float x) { return fminf(x, 0.f) - log1pf(expf(-fabsf(x))); }
DEV float wave_sum(float v) {
#pragma unroll
    for (int o = 1; o < 64; o <<= 1) v += __shfl_xor(v, o);
    return v;
}

#define XB_TMO      128
#define XB_XCNT(j)  (256  + 64 * (j))
#define XB_XSUB(j)  (1280 + 64 * (j))
#define XB_XGEN(j)  (2304 + 64 * (j))
#define XB_TOP      3328
#define XB_TOPGEN   3392
#define XCD_BAR_WORDS 3456
#define XB_SPIN_CAP (1u << 23)
DEV unsigned xb_ld(unsigned* p)              { return __hip_atomic_load(p, __ATOMIC_RELAXED, __HIP_MEMORY_SCOPE_AGENT); }
DEV unsigned xb_add(unsigned* p, unsigned v) { return __hip_atomic_fetch_add(p, v, __ATOMIC_RELAXED, __HIP_MEMORY_SCOPE_AGENT); }
DEV unsigned xb_xcc_id() { return (unsigned)__builtin_amdgcn_s_getreg((3 << 11) | 20) & 0xFu; }
#define XB_SPIN(cond, bar) do { unsigned _sp = 0; while (cond) { __builtin_amdgcn_s_sleep(1); \
    if ((++_sp & 255u) == 0u) { if (xb_ld(&(bar)[XB_TMO])) break; if (_sp > XB_SPIN_CAP) { atomicAdd(&(bar)[XB_TMO], 1u); break; } } } } while (0)
struct XcdBarrier { unsigned* bar; unsigned x; volatile LAS unsigned* st; };
DEV XcdBarrier xcd_barrier_post(unsigned* bar, volatile LAS unsigned* st) {
    XcdBarrier b; b.bar = bar; b.x = xb_xcc_id(); b.st = st;
    if (threadIdx.x == 0) (void)xb_add(&bar[XB_XCNT(b.x)], 1u);
    return b;
}
DEV void xcd_barrier_complete(unsigned* bar, unsigned x, unsigned& nloc, unsigned& nx) {
    const unsigned G = gridDim.x * gridDim.y * gridDim.z;
    unsigned sum, cnt, mine, sp = 0u;
    for (;;) {
        sum = 0u; cnt = 0u; mine = 0u;
#pragma unroll
        for (unsigned j = 0; j < 16; ++j) { const unsigned c = xb_ld(&bar[XB_XCNT(j)]); sum += c; cnt += (c > 0u) ? 1u : 0u; mine = (j == x) ? c : mine; }
        if (sum == G) break;
        __builtin_amdgcn_s_sleep(1);
        if ((++sp & 255u) == 0u) { if (xb_ld(&bar[XB_TMO])) break; if (sp > XB_SPIN_CAP) { atomicAdd(&bar[XB_TMO], 1u); break; } }
    }
    nloc = mine > 0u ? mine : 1u; nx = cnt > 0u ? cnt : 1u;
}
DEV void xcd_barrier(const XcdBarrier& b) {
    asm volatile("s_waitcnt vmcnt(0)" ::: "memory");
    __syncthreads();
    if (threadIdx.x == 0) {
        unsigned* bar = b.bar;
        __builtin_amdgcn_s_waitcnt(0);
        unsigned nloc = b.st[0], nx = b.st[1];
        if (nloc == 0u) { xcd_barrier_complete(bar, b.x, nloc, nx); b.st[0] = nloc; b.st[1] = nx; }
        const unsigned old = xb_add(&bar[XB_XSUB(b.x)], 1u);
        const unsigned gen = old / nloc;
        if (old + 1u == (gen + 1u) * nloc) {
            __builtin_amdgcn_fence(__ATOMIC_RELEASE, "agent");
            asm volatile("s_waitcnt vmcnt(0)" ::: "memory");
            const unsigned og = xb_add(&bar[XB_TOP], 1u);
            const unsigned tg = og / nx;
            if (og + 1u == (tg + 1u) * nx) xb_add(&bar[XB_TOPGEN], 1u);
            else XB_SPIN(xb_ld(&bar[XB_TOPGEN]) == tg, bar);
            __builtin_amdgcn_fence(__ATOMIC_ACQUIRE, "agent");
            xb_add(&bar[XB_XGEN(b.x)], 1u);
            asm volatile("s_waitcnt vmcnt(0)" ::: "memory");
        } else {
            XB_SPIN(xb_ld(&bar[XB_XGEN(b.x)]) == gen, bar);
            __builtin_amdgcn_fence(__ATOMIC_ACQUIRE, "agent");
            asm volatile("s_waitcnt vmcnt(0)" ::: "memory");
        }
    }
    __syncthreads();
}

struct P {
    const float *x, *c, *norm1_g, *norm2_g, *ada_w, *ada_b, *w_in, *b_forget, *cmp_pos_k, *cmp_w1_k, *cmp_w2_k,
        *cmp_pos_v, *cmp_w1_v, *cmp_w2_v, *out_norm_g, *w_out, *rg_w, *rg_b, *re_w, *re_b, *e_w1, *e_w3, *e_w2, *final_g;
    float* out; unsigned char* ws;
};
struct V {
    unsigned* ctl; float* mod; float* rcos; float* rsin; float* cumf; bf16_t* ck; bf16_t* cv; float* imp; unsigned* sel;
    int* eid; float* wts; int* list; float* gf; bf16_t* H; bf16_t* U; bf16_t* O; bf16_t* HID; bf16_t* Y; float* OB; float* ORAW; float* X; bf16_t* XB;
};
DEV int otid() { int t = threadIdx.x; asm volatile("" : "+v"(t)); return t; }
DEV int obid() { int t = blockIdx.x; asm volatile("" : "+s"(t)); return t; }
DEV V make_views(const P& p) {
    V v; size_t woff = 0; asm volatile("" : "+s"(woff)); unsigned char* w = p.ws + woff;
    v.ctl = (unsigned*)(w + WS_CTL); v.mod = (float*)(w + WS_MOD); v.rcos = (float*)(w + WS_ROPE); v.rsin = v.rcos + S * 8;
    v.cumf = (float*)(w + WS_CUMF); v.ck = (bf16_t*)(w + WS_CK); v.cv = (bf16_t*)(w + WS_CV); v.imp = (float*)(w + WS_IMP);
    v.sel = (unsigned*)(w + WS_SEL); v.eid = (int*)(w + WS_EID); v.wts = (float*)(w + WS_WTS); v.list = (int*)(w + WS_LIST);
    v.gf = (float*)(w + WS_GF); v.H = (bf16_t*)(w + WS_H); v.U = (bf16_t*)(w + WS_U); v.O = (bf16_t*)(w + WS_O);
    v.HID = (bf16_t*)(w + WS_HID); v.Y = (bf16_t*)(w + WS_Y); v.OB = (float*)(w + WS_OB); v.ORAW = (float*)(w + WS_ORAW); v.X = p.out; v.XB = (bf16_t*)(w + WS_ORAW);
    return v;
}

DEV void ph_prologue(const P& p, float* lds) {
    const V v = make_views(p); const int TIDX = otid(), BIDX = obid();
    const int tid = TIDX;
    for (int i = tid; i < NB * D; i += 256) { const float c = p.c[i]; lds[i] = c / (1.f + expf(-c)); }
    __syncthreads();
    float* red = lds + NB * D;
    const int c4 = tid & 15, ks = tid >> 4;
    for (int unit = BIDX; unit < DEPTH * 96; unit += gridDim.x) {
        const int l = unit / 96, n0 = (unit % 96) * 64;
        const float* W = p.ada_w + (size_t)l * D * 6144 + n0 + 4 * c4;
        float acc[8][4];
#pragma unroll
        for (int b = 0; b < 8; ++b)
#pragma unroll
            for (int q = 0; q < 4; ++q) acc[b][q] = 0.f;
#pragma unroll 1
        for (int i0 = 0; i0 < 64; i0 += 8) {
            f32x4v w[8];
#pragma unroll
            for (int i = 0; i < 8; ++i) w[i] = __builtin_nontemporal_load((const f32x4v*)(W + (size_t)(ks + 16 * (i0 + i)) * 6144));
#pragma unroll
            for (int i = 0; i < 8; ++i) {
                const int k = ks + 16 * (i0 + i);
#pragma unroll
                for (int b = 0; b < 8; ++b) {
                    const float cv = lds[b * D + k];
                    acc[b][0] += cv * w[i].x; acc[b][1] += cv * w[i].y; acc[b][2] += cv * w[i].z; acc[b][3] += cv * w[i].w;
                }
            }
        }
#pragma unroll
        for (int b = 0; b < 8; ++b) *(float4*)(red + (ks * 8 + b) * 64 + 4 * c4) = make_float4(acc[b][0], acc[b][1], acc[b][2], acc[b][3]);
        __syncthreads();
        for (int o = tid; o < 512; o += 256) {
            const int c2 = o & 63, b = o >> 6;
            float sm = p.ada_b[l * 6144 + n0 + c2];
#pragma unroll
            for (int q = 0; q < 16; ++q) sm += red[(q * 8 + b) * 64 + c2];
            v.mod[(size_t)(l * 8 + b) * 6144 + n0 + c2] = sm;
        }
        __syncthreads();
    }
    const float cst = -2.0f * 13.122363377404328f / 16.0f;
    for (int i = ((int)gridDim.x - 1 - BIDX) * 256 + tid; i < S * 8; i += gridDim.x * 256) {
        const int s = i >> 3, j = i & 7;
        const float inv = expf((float)j * cst);
        const float ang = (float)s * inv;
        v.rcos[i] = cosf(ang); v.rsin[i] = sinf(ang);
    }
}

DEV void ph_norm1(const P& p, int l, int mode) {
    const V v = make_views(p); const int TIDX = otid(), BIDX = obid();
    const int lane = TIDX & 63;
    const int gw = (BIDX * 256 + TIDX) >> 6, nw = gridDim.x * 4;
    for (int m0 = gw; m0 < T; m0 += 2 * nw) {
        float4 xv[2][4];
        if (mode == 0) {
#pragma unroll
            for (int rr = 0; rr < 2; ++rr)
#pragma unroll
                for (int j = 0; j < 4; ++j) xv[rr][j] = *(const float4*)(p.x + (size_t)(m0 + rr * nw) * D + 4 * lane + 256 * j);
        } else {
            ushort4 xa[2][4], ya[2][4], yb[2][4];
#pragma unroll
            for (int rr = 0; rr < 2; ++rr)
#pragma unroll
                for (int j = 0; j < 4; ++j) {
                    const int m = m0 + rr * nw, c = 4 * lane + 256 * j;
                    xa[rr][j] = *(const ushort4*)(v.XB + (size_t)m * D + c);
                    ya[rr][j] = *(const ushort4*)(v.Y + (size_t)(2 * m) * D + c); yb[rr][j] = *(const ushort4*)(v.Y + (size_t)(2 * m + 1) * D + c);
                }
#pragma unroll
            for (int rr = 0; rr < 2; ++rr) {
                const float* g2 = v.mod + (size_t)((l - 1) * 8 + ((m0 + rr * nw) >> 11)) * 6144 + 5 * D;
#pragma unroll
                for (int j = 0; j < 4; ++j) {
                    const float4 g = *(const float4*)(g2 + 4 * lane + 256 * j);
                    float4 a = make_float4(bf2f(xa[rr][j].x), bf2f(xa[rr][j].y), bf2f(xa[rr][j].z), bf2f(xa[rr][j].w));
                    a.x += g.x * (bf2f(ya[rr][j].x) + bf2f(yb[rr][j].x)); a.y += g.y * (bf2f(ya[rr][j].y) + bf2f(yb[rr][j].y));
                    a.z += g.z * (bf2f(ya[rr][j].z) + bf2f(yb[rr][j].z)); a.w += g.w * (bf2f(ya[rr][j].w) + bf2f(yb[rr][j].w));
                    xv[rr][j] = a;
                }
            }
        }
        float ss[2];
#pragma unroll
        for (int rr = 0; rr < 2; ++rr) {
            ss[rr] = 0.f;
#pragma unroll
            for (int j = 0; j < 4; ++j) ss[rr] += xv[rr][j].x * xv[rr][j].x + xv[rr][j].y * xv[rr][j].y + xv[rr][j].z * xv[rr][j].z + xv[rr][j].w * xv[rr][j].w;
        }
#pragma unroll
        for (int o = 1; o < 64; o <<= 1) { ss[0] += __shfl_xor(ss[0], o); ss[1] += __shfl_xor(ss[1], o); }
#pragma unroll
        for (int rr = 0; rr < 2; ++rr) {
            const int m = m0 + rr * nw, b = m >> 11;
            const float r = rsqrtf(ss[rr] * (1.f / D) + EPS);
            if (mode == 2) {
#pragma unroll
                for (int j = 0; j < 4; ++j) {
                    const int c = 4 * lane + 256 * j;
                    const float4 g = *(const float4*)(p.final_g + c);
                    float4 o; o.x = xv[rr][j].x * r * g.x; o.y = xv[rr][j].y * r * g.y; o.z = xv[rr][j].z * r * g.z; o.w = xv[rr][j].w * r * g.w;
                    *(float4*)(v.X + (size_t)m * D + c) = o;
                }
            } else {
                const float* md = v.mod + (size_t)(l * 8 + b) * 6144;
#pragma unroll
                for (int j = 0; j < 4; ++j) {
                    const int c = 4 * lane + 256 * j;
                    { uint2 xo; xo.x = cvtpk(xv[rr][j].x, xv[rr][j].y); xo.y = cvtpk(xv[rr][j].z, xv[rr][j].w); *(uint2*)(v.XB + (size_t)m * D + c) = xo; }
                    const float4 g = *(const float4*)(p.norm1_g + l * D + c), sh = *(const float4*)(md + c), sc = *(const float4*)(md + D + c);
                    uint2 o;
                    o.x = cvtpk(xv[rr][j].x * r * g.x * (1.f + sc.x) + sh.x, xv[rr][j].y * r * g.y * (1.f + sc.y) + sh.y);
                    o.y = cvtpk(xv[rr][j].z * r * g.z * (1.f + sc.z) + sh.z, xv[rr][j].w * r * g.w * (1.f + sc.w) + sh.w);
                    *(uint2*)(v.H + (size_t)m * D + c) = o;
                }
            }
        }
    }
}

typedef short bf16x8 __attribute__((ext_vector_type(8)));
typedef float f32x16 __attribute__((ext_vector_type(16)));
typedef unsigned u32x4 __attribute__((ext_vector_type(4)));
constexpr size_t WS_WIN = 512 * MiB, WS_WOT = 544 * MiB, WS_W13 = 552 * MiB, WS_W2 = 808 * MiB;
constexpr int NPW = 2944;
DEV int tile_off(int row, int chunk) { return row * 128 + ((chunk ^ ((row >> 1) & 7)) << 4); }
template <class RM>
DEV void conv_patch(const float* src, int N, int K, bf16_t* dst, int k0, int n0, RM rowmap, int lane) {
    const int kg = lane >> 3, n = n0 + 4 * (lane & 7);
    if (n >= N) return;
    const float* sp = src + (size_t)(k0 + 8 * kg) * N + n;
    f32x4v x[8];
#pragma unroll
    for (int j = 0; j < 8; ++j) x[j] = __builtin_nontemporal_load((const f32x4v*)(sp + (size_t)j * N));
    bf16_t* dp = dst + k0 + 8 * kg;
    u32x4 o;
    o.x = cvtpk(x[0].x, x[1].x); o.y = cvtpk(x[2].x, x[3].x); o.z = cvtpk(x[4].x, x[5].x); o.w = cvtpk(x[6].x, x[7].x);
    *(u32x4*)(dp + (size_t)rowmap(n) * K) = o;
    o.x = cvtpk(x[0].y, x[1].y); o.y = cvtpk(x[2].y, x[3].y); o.z = cvtpk(x[4].y, x[5].y); o.w = cvtpk(x[6].y, x[7].y);
    *(u32x4*)(dp + (size_t)rowmap(n + 1) * K) = o;
    o.x = cvtpk(x[0].z, x[1].z); o.y = cvtpk(x[2].z, x[3].z); o.z = cvtpk(x[4].z, x[5].z); o.w = cvtpk(x[6].z, x[7].z);
    *(u32x4*)(dp + (size_t)rowmap(n + 2) * K) = o;
    o.x = cvtpk(x[0].w, x[1].w); o.y = cvtpk(x[2].w, x[3].w); o.z = cvtpk(x[4].w, x[5].w); o.w = cvtpk(x[6].w, x[7].w);
    *(u32x4*)(dp + (size_t)rowmap(n + 3) * K) = o;
}

DEV void conv8(const float* s0, const float* s1, bf16_t* dst) {
    f32x4v a = {0.f, 0.f, 0.f, 0.f}, b = {0.f, 0.f, 0.f, 0.f};
    if (s0) a = __builtin_nontemporal_load((const f32x4v*)s0);
    if (s1) b = __builtin_nontemporal_load((const f32x4v*)s1);
    u32x4 o; o.x = cvtpk(a[0], a[1]); o.y = cvtpk(a[2], a[3]); o.z = cvtpk(b[0], b[1]); o.w = cvtpk(b[2], b[3]);
    *(u32x4*)dst = o;
}
DEV void ph_convert_dense(const P& p, int l, int which) {
    const int TIDX = otid(), BIDX = obid();
    size_t woff = 0; asm volatile("" : "+s"(woff)); unsigned char* w = p.ws + woff;
    const size_t gtid = (size_t)BIDX * 256 + TIDX, gsz = (size_t)gridDim.x * 256;
    if (which == 0) {
        bf16_t* win = (bf16_t*)(w + WS_WIN);
        for (size_t i = gtid; i < (size_t)D * 368; i += gsz) {
            const int g8 = (int)(i % 368); const size_t lk = (size_t)l * D + i / 368;
            const int n = g8 * 8;
            const float* row = p.w_in + lk * DIN;
            const float *s0, *s1;
            if (n < 2816) { const int oc = n + (n >= 2048 ? 28 : (n >= 1280 ? 24 : 0)); s0 = row + oc; s1 = row + oc + 4; }
            else if (n < 2840) { s0 = row + 1280 + (n - 2816); s1 = s0 + 4; }
            else if (n == 2840) { s0 = row + 2072; s1 = nullptr; }
            else { s0 = nullptr; s1 = nullptr; }
            conv8(s0, s1, win + lk * NPW + n);
        }
    } else {
        bf16_t* wot = (bf16_t*)(w + WS_WOT);
        const size_t oo = (size_t)l * D * D;
        for (size_t i = gtid; i < (size_t)D * D / 8; i += gsz) conv8(p.w_out + oo + i * 8, p.w_out + oo + i * 8 + 4, wot + oo + i * 8);
        for (size_t i = gtid; i < (size_t)2 * 2048 * 128 / 8; i += gsz) {
            const size_t per = (size_t)2048 * 128 / 8; const int kv = (int)(i / per), lk = l * 2 + kv; const size_t off = (i % per) * 8;
            const float* src = (kv ? p.cmp_w1_v : p.cmp_w1_k) + (size_t)l * 2048 * 128 + off;
            conv8(src, src + 4, (bf16_t*)(w + WS_CW1) + (size_t)lk * 2048 * 128 + off);
        }
    }
}
DEV void ph_convert_experts(const P& p, int l) {
    const int TIDX = otid(), BIDX = obid();
    size_t woff = 0; asm volatile("" : "+s"(woff)); unsigned char* w = p.ws + woff;
    bf16_t* w13 = (bf16_t*)(w + WS_W13); bf16_t* w2t = (bf16_t*)(w + WS_W2);
    const size_t gtid = (size_t)BIDX * 256 + TIDX, gsz = (size_t)gridDim.x * 256;
    for (size_t i = gtid; i < (size_t)32 * D * 128; i += gsz) {
        const int g8 = (int)(i & 127); const size_t lek = (size_t)l * 32 * D + (i >> 7);
        const int n = g8 * 8, which = (n >> 5) & 1, c = 32 * (n >> 6) + (n & 31);
        const float* src = (which ? p.e_w3 : p.e_w1) + lek * 512 + c;
        conv8(src, src + 4, w13 + lek * 1024 + n);
    }
    const size_t o2 = (size_t)l * 32 * 512 * D;
    for (size_t i = gtid; i < (size_t)32 * 512 * D / 8; i += gsz) conv8(p.e_w2 + o2 + i * 8, p.e_w2 + o2 + i * 8 + 4, w2t + o2 + i * 8);
}
DEV void ph_convert(const P& p, float* lds) {
    const int TIDX = otid(), BIDX = obid();
    size_t woff = 0; asm volatile("" : "+s"(woff)); unsigned char* w = p.ws + woff;
    const int lane = TIDX & 63;
    for (int unit = BIDX * 4 + (TIDX >> 6); unit < DEPTH * 2 * 4; unit += gridDim.x * 4) {
        const int lk = unit >> 2, t = unit & 3, l = lk >> 1, kv = lk & 1;
        conv_patch((kv ? p.cmp_w2_v : p.cmp_w2_k) + (size_t)l * 128 * 64, 64, 128, (bf16_t*)(w + WS_CW2) + (size_t)lk * 64 * 128, (t >> 1) * 64, (t & 1) * 32, [](int n) { return n; }, lane);
    }
    for (int o = BIDX * 256 + TIDX; o < DEPTH * 64 * D; o += gridDim.x * 256) {
        const int k = o & (D - 1), n = (o >> 10) & 63, l = o >> 16;
        const float val = n < 4 ? p.rg_w[((size_t)l * D + k) * 4 + n] : (n < 36 ? p.re_w[((size_t)l * D + k) * 32 + n - 4] : 0.f);
        const bf16_t hi = f2bf(val); const bf16_t lo = f2bf(val - bf2f(hi));
        bf16_t* wr = (bf16_t*)(w + WS_WR) + (size_t)l * 2 * 64 * D;
        wr[n * D + k] = hi; wr[64 * D + n * D + k] = lo;
    }
    int pu = (int)gridDim.x - 1 - BIDX - 64; if (pu < 0) pu += gridDim.x;
    for (int unit = pu; unit < DEPTH * 2 * 8; unit += gridDim.x) {
        const int lk = unit >> 3, ch = unit & 7, l = lk >> 1, kv = lk & 1, j = TIDX & 127, hf = TIDX >> 7;
        const float* pe = (kv ? p.cmp_pos_v : p.cmp_pos_k) + (size_t)l * 2048 + ch * 256 + hf * 128;
        const float* w1 = (kv ? p.cmp_w1_v : p.cmp_w1_k) + (size_t)l * 2048 * 128 + (size_t)(ch * 256 + hf * 128) * 128 + j;
        float a0 = 0.f, a1 = 0.f, a2 = 0.f, a3 = 0.f;
#pragma unroll 1
        for (int k0 = 0; k0 < 128; k0 += 32) {
            float wv[32];
#pragma unroll
            for (int k = 0; k < 32; ++k) wv[k] = w1[(size_t)(k0 + k) * 128];
#pragma unroll
            for (int k = 0; k < 32; k += 4) {
                a0 += pe[k0 + k] * wv[k]; a1 += pe[k0 + k + 1] * wv[k + 1];
                a2 += pe[k0 + k + 2] * wv[k + 2]; a3 += pe[k0 + k + 3] * wv[k + 3];
            }
        }
        const float a = (a0 + a1) + (a2 + a3);
        __syncthreads();
        if (hf) lds[j] = a;
        __syncthreads();
        if (!hf) ((float*)(w + WS_CPB))[(lk * 8 + ch) * 128 + j] = a + lds[j];
    }
}

typedef short v4i16_t __attribute__((ext_vector_type(4)));
DEV void gemm_issue0(unsigned char* lds, const bf16_t* const (&arow)[4], const bf16_t* Bsrc, const size_t ldb, const int TIDX) {
    const int lane = TIDX & 63, wave = TIDX >> 6;
    const int gsw = ((TIDX & 7) ^ ((TIDX >> 4) & 7)) * 8;
    const bf16_t* bg = Bsrc + (size_t)(4 * wave + (lane >> 4)) * ldb + ((lane & 15) ^ (((lane >> 4) << 2) | (wave & 3))) * 8;
    LAS unsigned char* l3 = (LAS unsigned char*)lds + __builtin_amdgcn_readfirstlane(wave) * 1024;
#pragma unroll
    for (int i = 0; i < 4; ++i) {
        __builtin_amdgcn_global_load_lds((const unsigned*)(arow[i] + gsw), (LAS unsigned*)(l3 + i * 4096), 16, 0, 0);
        __builtin_amdgcn_global_load_lds((const unsigned*)(bg + (size_t)(16 * i) * ldb), (LAS unsigned*)(l3 + 16384 + i * 4096), 16, 0, 0);
    }
}
template <bool SWAP, bool PRE = false>
DEV void gemm128(unsigned char* lds, const bf16_t* const (&arow)[4], const bf16_t* Bsrc, const size_t ldb, int K, f32x16 (&acc)[2][2], const int TIDX, const int astride = 64) {
    const int lane = TIDX & 63, wave = TIDX >> 6, wm = wave >> 1, wn = wave & 1, r = lane & 31, h = lane >> 5;
#pragma unroll
    for (int j = 0; j < 2; ++j)
#pragma unroll
        for (int i = 0; i < 2; ++i)
#pragma unroll
            for (int q = 0; q < 16; ++q) acc[j][i][q] = 0.f;
    const int gsw = ((TIDX & 7) ^ ((TIDX >> 4) & 7)) * 8;
    const bf16_t* ag[4];
#pragma unroll
    for (int i = 0; i < 4; ++i) ag[i] = arow[i] + gsw;
    const int brow = 4 * wave + (lane >> 4), bch = ((lane & 15) ^ (((lane >> 4) << 2) | (wave & 3))) * 8;
    const bf16_t* bg = Bsrc + (size_t)brow * ldb + bch;
    LAS unsigned char* l3 = (LAS unsigned char*)lds + __builtin_amdgcn_readfirstlane(wave) * 1024;
    LAS unsigned char* tb[2][2];
    {
        const int blk = (lane >> 4) & 1, q = (lane & 15) >> 2, pp = lane & 3;
#pragma unroll
        for (int j = 0; j < 2; ++j)
#pragma unroll
            for (int t = 0; t < 2; ++t) {
                const int row = 4 * t + 8 * h + q, ch = 4 * (2 * wn + j) + 2 * blk + (pp >> 1);
                tb[j][t] = (LAS unsigned char*)lds + 16384 + 256 * row + 16 * (ch ^ (((row & 3) << 2) | ((row >> 2) & 3))) + 8 * (pp & 1);
            }
    }
#define G_DMA(st_, kt_) do { _Pragma("unroll") for (int i = 0; i < 4; ++i) { \
        __builtin_amdgcn_global_load_lds((const unsigned*)(ag[i] + (size_t)(kt_) * astride), (LAS unsigned*)(l3 + (st_) + i * 4096), 16, 0, 0); \
        __builtin_amdgcn_global_load_lds((const unsigned*)(bg + ((size_t)(kt_) * 64 + 16 * i) * ldb), (LAS unsigned*)(l3 + (st_) + 16384 + i * 4096), 16, 0, 0); } } while (0)
    const int KT = K >> 6;
    if (!PRE) {
        __syncthreads();
        G_DMA(0, 0);
    }
    for (int kt = 0; kt < KT; ++kt) {
        asm volatile("s_waitcnt vmcnt(0) lgkmcnt(0)" ::: "memory");
        __builtin_amdgcn_s_barrier();
        asm volatile("" ::: "memory");
        if (kt + 1 < KT) G_DMA(((kt + 1) & 1) * 32768, kt + 1);
        const int so = (kt & 1) * 32768;
        const unsigned char* cur = lds + so;
#pragma unroll
        for (int kk = 0; kk < 4; ++kk) {
            bf16x8 af[2], wf[2];
#pragma unroll
            for (int i = 0; i < 2; ++i) af[i] = *(const bf16x8*)(cur + tile_off(64 * wm + 32 * i + r, 2 * kk + h));
#pragma unroll
            for (int j = 0; j < 2; ++j) {
                const v4i16_t lo = __builtin_amdgcn_ds_read_tr16_b64_v4i16((LAS v4i16_t*)(tb[j][0] + so + 4096 * kk));
                const v4i16_t hi = __builtin_amdgcn_ds_read_tr16_b64_v4i16((LAS v4i16_t*)(tb[j][1] + so + 4096 * kk));
                wf[j] = (bf16x8){lo[0], lo[1], lo[2], lo[3], hi[0], hi[1], hi[2], hi[3]};
            }
#pragma unroll
            for (int j = 0; j < 2; ++j)
#pragma unroll
                for (int i = 0; i < 2; ++i) acc[j][i] = SWAP ? __builtin_amdgcn_mfma_f32_32x32x16_bf16(af[i], wf[j], acc[j][i], 0, 0, 0)
                                                             : __builtin_amdgcn_mfma_f32_32x32x16_bf16(wf[j], af[i], acc[j][i], 0, 0, 0);
        }
    }
    __syncthreads();
#undef G_DMA
}

constexpr int CST = 272;
DEV void ctile_put(unsigned char* lds, int row, int col, float a, float b, float c, float d) {
    uint2 u; u.x = cvtpk(a, b); u.y = cvtpk(c, d);
    *(uint2*)(lds + row * CST + col * 2) = u;
}
template <int COLS, class RP>
DEV void ctile_flush(unsigned char* lds, const int TIDX, RP rowptr) {
    asm volatile("s_waitcnt lgkmcnt(0)" ::: "memory");
    __builtin_amdgcn_s_barrier();
    asm volatile("" ::: "memory");
    constexpr int CPR = COLS / 8, RPI = 256 / CPR;
#pragma unroll
    for (int it = 0; it < 128 / RPI; ++it) {
        const int row = it * RPI + TIDX / CPR, c16 = TIDX % CPR;
        bf16_t* dst = rowptr(row, it);
        const u32x4 val = *(const u32x4*)(lds + row * CST + c16 * 16);
        if (dst) *(u32x4*)(dst + c16 * 8) = val;
    }
}

DEV void ph_inproj_fast(const P& p, int l, unsigned char* lds) {
    const V v = make_views(p); const int TIDX = otid(), BIDX = obid();
    const bf16_t* W = (const bf16_t*)(p.ws + WS_WIN) + (size_t)l * D * NPW;
    const int lane = TIDX & 63, wave = TIDX >> 6, wm = wave >> 1, wn = wave & 1, r = lane & 31, h = lane >> 5;
    const bool xo = gridDim.x == 512;
    unsigned char* ct = lds + 32768;
    auto decode = [&](int it, int& mt, int& nt) -> int {
        if (xo) { if (it >= 6) return -1; const int lb = BIDX >> 3; nt = 8 * (it % 3) + (lb >> 3); mt = 16 * (BIDX & 7) + 8 * (it / 3) + (lb & 7); return nt < 23 ? 1 : 0; }
        const int unit = BIDX + it * (int)gridDim.x; if (unit >= 128 * 23) return -1; nt = unit / 128; mt = unit % 128; return 1;
    };
    auto issue = [&](int mt, int nt) {
        const bf16_t* ar[4];
#pragma unroll
        for (int i = 0; i < 4; ++i) ar[i] = v.H + (size_t)(mt * 128 + (TIDX >> 3) + 32 * i) * D;
        gemm_issue0(lds, ar, W + nt * 128, NPW, TIDX);
    };
    bool pre = false;
    for (int it = 0;; ++it) {
        int nt, mt;
        const int dv = decode(it, mt, nt);
        if (dv < 0) break;
        if (dv == 0) continue;
        const int m0 = mt * 128, n0 = nt * 128;
        const bf16_t* arow[4];
#pragma unroll
        for (int i = 0; i < 4; ++i) arow[i] = v.H + (size_t)(m0 + (TIDX >> 3) + 32 * i) * D;
        if (!pre) { __syncthreads(); issue(mt, nt); pre = true; }
        int itn = it + 1, mtn = 0, ntn = 0, dn;
        while ((dn = decode(itn, mtn, ntn)) == 0) ++itn;
        f32x16 acc[2][2];
        if (is_vcol(n0)) {
            gemm128<true, true>(lds, arow, W + n0, NPW, D, acc, TIDX);
            if (dn > 0) issue(mtn, ntn); else pre = false;
#pragma unroll
            for (int j = 0; j < 2; ++j)
#pragma unroll
                for (int i = 0; i < 2; ++i)
#pragma unroll
                    for (int g = 0; g < 4; ++g)
                        ctile_put(ct, 64 * wn + 32 * j + r, 64 * wm + 32 * i + 8 * g + 4 * h, acc[j][i][4 * g], acc[j][i][4 * g + 1], acc[j][i][4 * g + 2], acc[j][i][4 * g + 3]);
            bf16_t* vt = (bf16_t*)(p.ws + WS_VT) + ((size_t)(m0 >> 11) * 768 + vt_row(n0)) * S + (m0 & (S - 1));
            ctile_flush<128>(ct, TIDX, [&](int row, int) { return vt + (size_t)row * S; });
            continue;
        }
        const bool rope_tile = n0 < 512 || n0 == C_KS || n0 == C_KW;
        f32x4v rcs[2], rsn[2];
        if (rope_tile) {
#pragma unroll
            for (int i = 0; i < 2; ++i) {
                const int sp = (m0 + 64 * wm + 32 * i + r) & (S - 1);
                rcs[i] = *(const f32x4v*)(v.rcos + sp * 8 + 4 * h); rsn[i] = *(const f32x4v*)(v.rsin + sp * 8 + 4 * h);
            }
        }
        gemm128<false, true>(lds, arow, W + n0, NPW, D, acc, TIDX);
        if (dn > 0) issue(mtn, ntn); else pre = false;
        if (n0 == 2816) {
            if (wn == 0) {
#pragma unroll
                for (int i = 0; i < 2; ++i) {
                    const int m = m0 + 64 * wm + 32 * i + r;
#pragma unroll
                    for (int q = 0; q < 16; ++q) {
                        const int cc = (q & 3) + 8 * (q >> 2) + 4 * h;
                        if (cc < 24) v.gf[(size_t)m * 32 + cc] = acc[0][i][q];
                        else if (cc < 28) ((float*)(p.ws + WS_LSF))[(size_t)((m >> 11) * 4 + cc - 24) * S + (m & (S - 1))] = logsigmoidf_(acc[0][i][q] + p.b_forget[l * 4 + cc - 24]);
                    }
                }
            }
            continue;
        }
        if (n0 == C_KB || n0 == C_KB + 128) {
            float mx = 0.f;
#pragma unroll
            for (int i = 0; i < 2; ++i) {
                float s2 = 0.f;
#pragma unroll
                for (int j = 0; j < 2; ++j)
#pragma unroll
                    for (int q = 0; q < 16; ++q) s2 += acc[j][i][q] * acc[j][i][q];
                s2 += __shfl_xor(s2, 32);
                mx = fmaxf(mx, s2);
            }
#pragma unroll
            for (int o = 1; o < 32; o <<= 1) mx = fmaxf(mx, __shfl_xor(mx, o));
            if (lane == 0) atomicMax(v.ctl + CW_KN + (l * 8 + (m0 >> 11)) * 4 + ((n0 - C_KB) >> 6) + wn, __float_as_uint(mx));
        }
#pragma unroll
        for (int j = 0; j < 2; ++j) {
            const int nb = n0 + 64 * wn + 32 * j;
            const bool rope = ((nb & 63) == 0) && (nb < 512 || (nb >= C_KS && nb < C_VS) || (nb >= C_KW && nb < C_VW));
#pragma unroll
            for (int i = 0; i < 2; ++i) {
                f32x16 a = acc[j][i];
                if (rope) {
#pragma unroll
                    for (int q = 0; q < 4; ++q) { const float x1 = a[q], x2 = a[q + 4]; a[q] = x1 * rcs[i][q] - x2 * rsn[i][q]; a[q + 4] = x2 * rcs[i][q] + x1 * rsn[i][q]; }
                }
#pragma unroll
                for (int g = 0; g < 4; ++g) ctile_put(ct, 64 * wm + 32 * i + r, 64 * wn + 32 * j + 8 * g + 4 * h, a[4 * g], a[4 * g + 1], a[4 * g + 2], a[4 * g + 3]);
            }
        }
        bf16_t* ub = v.U + (size_t)m0 * NP + n0;
        ctile_flush<128>(ct, TIDX, [&](int row, int) { return ub + (size_t)row * NP; });
    }
}

DEV void ph_outproj_fast(const P& p, int l, unsigned char* lds) {
    const V v = make_views(p); const int TIDX = otid(), BIDX = obid();
    const bf16_t* W = (const bf16_t*)(p.ws + WS_WOT) + (size_t)l * D * D;
    const int lane = TIDX & 63, wave = TIDX >> 6, wm = wave >> 1, wn = wave & 1, r = lane & 31, h = lane >> 5;
    const bool xo = gridDim.x == 512;
    unsigned char* ct = lds + 32768;
    auto decode = [&](int it, int& mt, int& nt) -> bool {
        if (xo) { if (it >= 2) return false; const int lb = BIDX >> 3; nt = lb >> 3; mt = 16 * (BIDX & 7) + 8 * it + (lb & 7); return true; }
        const int unit = BIDX + it * (int)gridDim.x; if (unit >= 128 * 8) return false; nt = unit / 128; mt = unit % 128; return true;
    };
    auto issue = [&](int mt, int nt) {
        const bf16_t* ar[4];
#pragma unroll
        for (int i = 0; i < 4; ++i) ar[i] = v.O + (size_t)(mt * 128 + (TIDX >> 3) + 32 * i) * D;
        gemm_issue0(lds, ar, W + nt * 128, D, TIDX);
    };
    for (int it = 0;; ++it) {
        int nt, mt, ntn = 0, mtn = 0;
        if (!decode(it, mt, nt)) break;
        const bool hasn = decode(it + 1, mtn, ntn);
        const int m0 = mt * 128, n0 = nt * 128;
        const bf16_t* arow[4];
#pragma unroll
        for (int i = 0; i < 4; ++i) arow[i] = v.O + (size_t)(m0 + (TIDX >> 3) + 32 * i) * D;
        if (it == 0) { __syncthreads(); issue(mt, nt); }
        u32x4 xin[8];
#pragma unroll
        for (int it = 0; it < 8; ++it) xin[it] = *(const u32x4*)(v.XB + (size_t)(m0 + it * 16 + (TIDX >> 4)) * D + n0 + (TIDX & 15) * 8);
        f32x16 acc[2][2];
        gemm128<false, true>(lds, arow, W + n0, D, D, acc, TIDX);
        if (hasn) issue(mtn, ntn);
        const float* g1 = v.mod + (size_t)(l * 8 + (m0 >> 11)) * 6144 + 2 * D;
#pragma unroll
        for (int j = 0; j < 2; ++j)
#pragma unroll
            for (int i = 0; i < 2; ++i) {
                const int nb = n0 + 64 * wn + 32 * j + 4 * h;
#pragma unroll
                for (int g = 0; g < 4; ++g) {
                    const float4 gg = *(const float4*)(g1 + nb + 8 * g);
                    ctile_put(ct, 64 * wm + 32 * i + r, 64 * wn + 32 * j + 8 * g + 4 * h, gg.x * acc[j][i][4 * g], gg.y * acc[j][i][4 * g + 1], gg.z * acc[j][i][4 * g + 2], gg.w * acc[j][i][4 * g + 3]);
                }
            }
        asm volatile("s_waitcnt lgkmcnt(0)" ::: "memory");
        __builtin_amdgcn_s_barrier();
        asm volatile("" ::: "memory");
#pragma unroll
        for (int it = 0; it < 8; ++it) {
            const int row = it * 16 + (TIDX >> 4);
            const u32x4 uv = *(const u32x4*)(ct + row * CST + (TIDX & 15) * 16);
            u32x4 xn;
#pragma unroll
            for (int q = 0; q < 4; ++q)
                xn[q] = cvtpk(__uint_as_float(xin[it][q] << 16) + __uint_as_float(uv[q] << 16), __uint_as_float(xin[it][q] & 0xffff0000u) + __uint_as_float(uv[q] & 0xffff0000u));
            *(u32x4*)(v.XB + (size_t)(m0 + row) * D + n0 + (TIDX & 15) * 8) = xn;
        }
    }
}

DEV void ph_moe_up_fast(const P& p, int l, unsigned char* lds) {
    const V v = make_views(p); const int TIDX = otid(), BIDX = obid();
    const int lane = TIDX & 63, wave = TIDX >> 6, wm = wave >> 1, wn = wave & 1, r = lane & 31, h = lane >> 5;
    const unsigned* cnt = v.ctl + CW_CNT + l * 32;
    int* tp = (int*)(lds + 67584); int* rb = tp + 40;
    __syncthreads();
    if (TIDX < 64) {
        const int c = TIDX < 32 ? (int)cnt[TIDX] : 0;
        int nu = ((c + 127) >> 7) * 8, cc = c;
#pragma unroll
        for (int o = 1; o < 32; o <<= 1) { const int a = __shfl_up(nu, o), b2 = __shfl_up(cc, o); if ((TIDX & 31) >= o) { nu += a; cc += b2; } }
        if (TIDX < 32) { tp[TIDX + 1] = nu; rb[TIDX + 1] = cc; if (TIDX == 0) { tp[0] = 0; rb[0] = 0; } }
    }
    __syncthreads();
    const int total = tp[32];
    unsigned char* ct = lds + 32768;
    struct UU { int e, base, nt, mt, nrow; const int* lst; const bf16_t* B; const bf16_t* ar[4]; };
    auto setup = [&](int unit, UU& u) {
        int e = 0;
#pragma unroll
        for (int st = 16; st > 0; st >>= 1) if (tp[e + st] <= unit) e += st;
        const int rem = unit - tp[e];
        u.e = e; u.base = rb[e]; u.nt = rem & 7; u.mt = rem >> 3;
        const int ce = rb[e + 1] - u.base;
        u.lst = v.list + (size_t)e * T + u.mt * 128;
        u.nrow = ce - u.mt * 128 < 128 ? ce - u.mt * 128 : 128;
        u.B = (const bf16_t*)(p.ws + WS_W13) + ((size_t)l * 32 + e) * 1024 * D + u.nt * 128;
#pragma unroll
        for (int i = 0; i < 4; ++i) { const int rr = (TIDX >> 3) + 32 * i; u.ar[i] = v.H + (size_t)(u.lst[rr < u.nrow ? rr : 0] >> 1) * D; }
    };
    int unit = BIDX;
    if (unit >= total) return;
    UU cu, nu;
    setup(unit, cu);
    __syncthreads();
    gemm_issue0(lds, cu.ar, cu.B, 1024, TIDX);
    for (;;) {
        const int un = unit + (int)gridDim.x;
        f32x16 acc[2][2];
        gemm128<false, true>(lds, cu.ar, cu.B, 1024, D, acc, TIDX);
        if (un < total) { setup(un, nu); gemm_issue0(lds, nu.ar, nu.B, 1024, TIDX); }
#pragma unroll
        for (int i = 0; i < 2; ++i)
#pragma unroll
            for (int g = 0; g < 4; ++g) {
                float o[4];
#pragma unroll
                for (int q = 0; q < 4; ++q) { const float a1 = acc[0][i][4 * g + q], a3 = acc[1][i][4 * g + q]; o[q] = a1 / (1.f + __expf(-a1)) * a3; }
                ctile_put(ct, 64 * wm + 32 * i + r, 32 * wn + 8 * g + 4 * h, o[0], o[1], o[2], o[3]);
            }
        bf16_t* hb = v.HID + (size_t)(cu.base + cu.mt * 128) * 512 + 64 * cu.nt;
        const int nrow = cu.nrow;
        ctile_flush<64>(ct, TIDX, [&](int row, int) { return row < nrow ? hb + (size_t)row * 512 : (bf16_t*)nullptr; });
        if (un >= total) break;
        unit = un; cu = nu;
    }
}
DEV void ph_moe_down_fast(const P& p, int l, unsigned char* lds) {
    const V v = make_views(p); const int TIDX = otid(), BIDX = obid();
    const int lane = TIDX & 63, wave = TIDX >> 6, wm = wave >> 1, wn = wave & 1, r = lane & 31, h = lane >> 5;
    const unsigned* cnt = v.ctl + CW_CNT + l * 32;
    int* tp = (int*)(lds + 67584); int* rb = tp + 40;
    __syncthreads();
    if (TIDX < 64) {
        const int c = TIDX < 32 ? (int)cnt[TIDX] : 0;
        int nu = ((c + 127) >> 7) * 8, cc = c;
#pragma unroll
        for (int o = 1; o < 32; o <<= 1) { const int a = __shfl_up(nu, o), b2 = __shfl_up(cc, o); if ((TIDX & 31) >= o) { nu += a; cc += b2; } }
        if (TIDX < 32) { tp[TIDX + 1] = nu; rb[TIDX + 1] = cc; if (TIDX == 0) { tp[0] = 0; rb[0] = 0; } }
    }
    __syncthreads();
    const int total = tp[32];
    unsigned char* ct = lds + 32768;
    struct UD { int n0, nrow; const bf16_t* B; const bf16_t* ar[4]; float wrow[2]; int fslot[8]; };
    auto setup = [&](int unit, UD& u) {
        int e = 0;
#pragma unroll
        for (int st = 16; st > 0; st >>= 1) if (tp[e + st] <= unit) e += st;
        const int rem = unit - tp[e], base = rb[e];
        const int ce = rb[e + 1] - base, nt = rem & 7, mt = rem >> 3;
        const int* lst = v.list + (size_t)e * T + mt * 128;
        u.n0 = nt * 128;
        u.nrow = ce - mt * 128 < 128 ? ce - mt * 128 : 128;
        u.B = (const bf16_t*)(p.ws + WS_W2) + ((size_t)l * 32 + e) * 512 * D + u.n0;
#pragma unroll
        for (int i = 0; i < 4; ++i) { const int rr = (TIDX >> 3) + 32 * i; u.ar[i] = v.HID + (size_t)(base + mt * 128 + (rr < u.nrow ? rr : 0)) * 512; }
#pragma unroll
        for (int i = 0; i < 2; ++i) { const int mr = 64 * wm + 32 * i + r; u.wrow[i] = mr < u.nrow ? v.wts[lst[mr]] : 0.f; }
#pragma unroll
        for (int it = 0; it < 8; ++it) { const int row = it * 16 + (TIDX >> 4); u.fslot[it] = row < u.nrow ? lst[row] : -1; }
    };
    int unit = BIDX;
    if (unit >= total) return;
    UD cu, nu;
    setup(unit, cu);
    __syncthreads();
    gemm_issue0(lds, cu.ar, cu.B, D, TIDX);
    for (;;) {
        const int un = unit + (int)gridDim.x;
        f32x16 acc[2][2];
        gemm128<false, true>(lds, cu.ar, cu.B, D, 512, acc, TIDX);
        if (un < total) { setup(un, nu); gemm_issue0(lds, nu.ar, nu.B, D, TIDX); }
#pragma unroll
        for (int i = 0; i < 2; ++i) {
            const int mr = 64 * wm + 32 * i + r;
            const float w = cu.wrow[i];
#pragma unroll
            for (int j = 0; j < 2; ++j)
#pragma unroll
                for (int g = 0; g < 4; ++g)
                    ctile_put(ct, mr, 64 * wn + 32 * j + 8 * g + 4 * h, w * acc[j][i][4 * g], w * acc[j][i][4 * g + 1], w * acc[j][i][4 * g + 2], w * acc[j][i][4 * g + 3]);
        }
        const int n0 = cu.n0;
        ctile_flush<128>(ct, TIDX, [&](int, int it) { const int sl = cu.fslot[it]; return sl >= 0 ? v.Y + (size_t)sl * D + n0 : (bf16_t*)nullptr; });
        if (un >= total) break;
        unit = un; cu = nu;
    }
}

constexpr float SB_EPS = 1e-12f;
constexpr float LOG2E = 1.4426950408889634f, C2 = 0.125f * 1.4426950408889634f, LN2 = 0.6931471805599453f;
DEV float fexp2(float x) { return __builtin_amdgcn_exp2f(x); }
DEV float flog2(float x) { return __builtin_amdgcn_logf(x); }
DEV int swap23(int r) { return (r & ~12) | ((r & 4) << 1) | ((r & 8) >> 1); }

struct KVT { const bf16_t* k; int ks; const bf16_t* v; int vs; };
DEV void kv_load(const KVT& s, int kv0, const int TIDX, u32x4 (&rg)[4]) {
    const int c = TIDX & 7, r0 = TIDX >> 3;
    rg[0] = *(const u32x4*)(s.k + (size_t)(kv0 + r0) * s.ks + c * 8);
    rg[1] = *(const u32x4*)(s.k + (size_t)(kv0 + r0 + 32) * s.ks + c * 8);
    rg[2] = *(const u32x4*)(s.v + (size_t)r0 * s.vs + kv0 + c * 8);
    rg[3] = *(const u32x4*)(s.v + (size_t)(r0 + 32) * s.vs + kv0 + c * 8);
}
DEV void kv_store(unsigned char* st, const int TIDX, const u32x4 (&rg)[4]) {
    const int c = TIDX & 7, r0 = TIDX >> 3;
    *(u32x4*)(st + tile_off(r0, c)) = rg[0]; *(u32x4*)(st + tile_off(r0 + 32, c)) = rg[1];
    *(u32x4*)(st + 8192 + tile_off(r0, c)) = rg[2]; *(u32x4*)(st + 8192 + tile_off(r0 + 32, c)) = rg[3];
}
DEV bf16x8 scale_frag(bf16x8 v, float sc) {
    u32x4 u = __builtin_bit_cast(u32x4, v);
#pragma unroll
    for (int i = 0; i < 4; ++i) u[i] = cvtpk(__uint_as_float(u[i] << 16) * sc, __uint_as_float(u[i] & 0xffff0000u) * sc);
    return __builtin_bit_cast(bf16x8, u);
}
DEV float xhalf(float x) {
    const auto s = __builtin_amdgcn_permlane32_swap(__float_as_uint(x), __float_as_uint(x), false, false);
    return __uint_as_float((threadIdx.x & 32) ? s[0] : s[1]);
}
DEV float xhalf_max(float x) {
    const auto s = __builtin_amdgcn_permlane32_swap(__float_as_uint(x), __float_as_uint(x), false, false);
    return fmaxf(__uint_as_float(s[0]), __uint_as_float(s[1]));
}
DEV float xhalf_sum(float x) {
    const auto s = __builtin_amdgcn_permlane32_swap(__float_as_uint(x), __float_as_uint(x), false, false);
    return __uint_as_float(s[0]) + __uint_as_float(s[1]);
}
#define SB0() __builtin_amdgcn_sched_barrier(0)
DEV void score_tile(const unsigned char* Kt, const bf16x8 (&qf)[4], int r, int h, f32x16 (&p)[2]) {
    const int kr = swap23(r);
    const unsigned char* kb = Kt + tile_off(kr, h);
    auto ld = [&](int i) { const int blk = i & 1, s = i >> 1; return *(const bf16x8*)(Kt + tile_off(32 * blk + kr, 2 * s + h)); };
    (void)kb;
    f32x16 z;
#pragma unroll
    for (int q = 0; q < 16; ++q) z[q] = 0.f;
    bf16x8 f0 = ld(0), f1 = ld(1), f2 = ld(2), f3 = ld(3);
    SB0();
    p[0] = __builtin_amdgcn_mfma_f32_32x32x16_bf16(f0, qf[0], z, 0, 0, 0); f0 = ld(4); SB0();
    p[1] = __builtin_amdgcn_mfma_f32_32x32x16_bf16(f1, qf[0], z, 0, 0, 0); f1 = ld(5); SB0();
    p[0] = __builtin_amdgcn_mfma_f32_32x32x16_bf16(f2, qf[1], p[0], 0, 0, 0); f2 = ld(6); SB0();
    p[1] = __builtin_amdgcn_mfma_f32_32x32x16_bf16(f3, qf[1], p[1], 0, 0, 0); f3 = ld(7); SB0();
    p[0] = __builtin_amdgcn_mfma_f32_32x32x16_bf16(f0, qf[2], p[0], 0, 0, 0); SB0();
    p[1] = __builtin_amdgcn_mfma_f32_32x32x16_bf16(f1, qf[2], p[1], 0, 0, 0); SB0();
    p[0] = __builtin_amdgcn_mfma_f32_32x32x16_bf16(f2, qf[3], p[0], 0, 0, 0); SB0();
    p[1] = __builtin_amdgcn_mfma_f32_32x32x16_bf16(f3, qf[3], p[1], 0, 0, 0); SB0();
}
DEV void pv_tile(const unsigned char* Vt, const f32x16 (&p)[2], int r, int h, f32x16 (&o)[2]) {
    auto ld = [&](int i) { const int db = i & 1, pr = i >> 1; return *(const bf16x8*)(Vt + tile_off(32 * db + r, 2 * pr + h)); };
    auto pk = [&](int pr) {
        const int blk = pr >> 1, s = pr & 1;
        u32x4 w;
        w.x = cvtpk(p[blk][8 * s], p[blk][8 * s + 1]); w.y = cvtpk(p[blk][8 * s + 2], p[blk][8 * s + 3]);
        w.z = cvtpk(p[blk][8 * s + 4], p[blk][8 * s + 5]); w.w = cvtpk(p[blk][8 * s + 6], p[blk][8 * s + 7]);
        return __builtin_bit_cast(bf16x8, w);
    };
    bf16x8 f0 = ld(0), f1 = ld(1), f2 = ld(2), f3 = ld(3);
    SB0();
    bf16x8 pb = pk(0);
    SB0();
    o[0] = __builtin_amdgcn_mfma_f32_32x32x16_bf16(f0, pb, o[0], 0, 0, 0); f0 = ld(4); SB0();
    o[1] = __builtin_amdgcn_mfma_f32_32x32x16_bf16(f1, pb, o[1], 0, 0, 0); f1 = ld(5); pb = pk(1); SB0();
    o[0] = __builtin_amdgcn_mfma_f32_32x32x16_bf16(f2, pb, o[0], 0, 0, 0); f2 = ld(6); SB0();
    o[1] = __builtin_amdgcn_mfma_f32_32x32x16_bf16(f3, pb, o[1], 0, 0, 0); f3 = ld(7); pb = pk(2); SB0();
    o[0] = __builtin_amdgcn_mfma_f32_32x32x16_bf16(f0, pb, o[0], 0, 0, 0); SB0();
    o[1] = __builtin_amdgcn_mfma_f32_32x32x16_bf16(f1, pb, o[1], 0, 0, 0); pb = pk(3); SB0();
    o[0] = __builtin_amdgcn_mfma_f32_32x32x16_bf16(f2, pb, o[0], 0, 0, 0); SB0();
    o[1] = __builtin_amdgcn_mfma_f32_32x32x16_bf16(f3, pb, o[1], 0, 0, 0); SB0();
}

template <int VAR>
DEV void attn_branch(unsigned char* lds, const KVT& src, const bf16x8 (&qf)[4], unsigned tmask, int wave_last, int t, int t_first,
                     unsigned selbits, const float* bias2, f32x16 (&o)[2], const int TIDX, const float qkb = 0.f) {
    const int lane = TIDX & 63, r = lane & 31, h = lane >> 5;
    const float NEG_INF = -__builtin_inff();
    float mrun = -1e30f, lrun = 0.f, rest = VAR == 3 ? 1.f : 0.f;
#pragma unroll
    for (int db = 0; db < 2; ++db)
#pragma unroll
        for (int q = 0; q < 16; ++q) o[db][q] = 0.f;
    u32x4 rg[4];
    unsigned rem = tmask;
    unsigned wdone = 0u; int step = 0;
    volatile unsigned* sbf = (volatile unsigned*)(lds + 65536);
    int j = VAR >= 2 ? 31 - __builtin_clz(rem) : __builtin_ctz(rem);
    rem &= ~(1u << j);
    kv_load(src, 64 * j, TIDX, rg);
    __syncthreads();
    kv_store(lds, TIDX, rg);
    __syncthreads();
    int stage = 0;
    for (;;) {
        int jn = -1;
        if (rem) { jn = VAR >= 2 ? 31 - __builtin_clz(rem) : __builtin_ctz(rem); rem &= ~(1u << jn); kv_load(src, 64 * jn, TIDX, rg); }
        asm volatile("" ::: "memory"); __builtin_amdgcn_sched_barrier(0);
        if (j <= wave_last) {
            const unsigned char* Kt = lds + stage * 16384;
            f32x16 p[2];
            score_tile(Kt, qf, r, h, p);
            const int kvb = 64 * j + 8 * h;
            if (VAR == 3) {
                const bool diag = 64 * j + 63 >= t_first;
                float gt[2][2];
                if (diag) {
#pragma unroll
                    for (int blk = 0; blk < 2; ++blk)
#pragma unroll
                        for (int s = 0; s < 2; ++s) {
                            float run = 1.f;
#pragma unroll
                            for (int q = 7; q >= 0; --q) {
                                const float ez = fexp2(p[blk][8 * s + q]);
                                float w = __builtin_amdgcn_rcpf(1.f + ez);
                                float beta = 1.f - w;
                                const bool valid = kvb + 32 * blk + 16 * s + q < t;
                                w = valid ? w : 1.f; beta = valid ? beta : 0.f;
                                p[blk][8 * s + q] = beta * run;
                                run *= w;
                            }
                            gt[blk][s] = run;
                        }
                } else {
#pragma unroll
                    for (int blk = 0; blk < 2; ++blk)
#pragma unroll
                        for (int s = 0; s < 2; ++s) {
                            float run = 1.f;
#pragma unroll
                            for (int q = 7; q >= 0; --q) {
                                const float rn = run * __builtin_amdgcn_rcpf(1.f + fexp2(p[blk][8 * s + q]));
                                p[blk][8 * s + q] = run - rn;
                                run = rn;
                            }
                            gt[blk][s] = run;
                        }
                }
                float og[2][2], pt[2][2];
#pragma unroll
                for (int blk = 0; blk < 2; ++blk)
#pragma unroll
                    for (int s = 0; s < 2; ++s) { og[blk][s] = xhalf(gt[blk][s]); pt[blk][s] = gt[blk][s] * og[blk][s]; }
                float above = rest;
#pragma unroll
                for (int pi = 3; pi >= 0; --pi) {
                    const int blk = pi >> 1, s = pi & 1;
                    const float carry = above * (h == 0 ? og[blk][s] : 1.f);
#pragma unroll
                    for (int q = 0; q < 8; ++q) p[blk][8 * s + q] *= carry;
                    above *= pt[blk][s];
                }
                rest = above;
                wdone = __all(rest < SB_EPS) ? 1u : 0u;
            } else {
                const bool need_causal = 64 * j + 63 > t_first;
                const bool need_win = VAR == 1 && (64 * j + 512 <= t_first + 31);
                const bool lane_on = VAR != 0 || ((selbits >> j) & 1u);
                if (VAR == 2) {
#pragma unroll
                    for (int blk = 0; blk < 2; ++blk)
#pragma unroll
                        for (int s = 0; s < 2; ++s) {
                            const float4 b0 = *(const float4*)(bias2 + kvb + 32 * blk + 16 * s), b1 = *(const float4*)(bias2 + kvb + 32 * blk + 16 * s + 4);
                            p[blk][8 * s] += b0.x; p[blk][8 * s + 1] += b0.y; p[blk][8 * s + 2] += b0.z; p[blk][8 * s + 3] += b0.w;
                            p[blk][8 * s + 4] += b1.x; p[blk][8 * s + 5] += b1.y; p[blk][8 * s + 6] += b1.z; p[blk][8 * s + 7] += b1.w;
                        }
                }
                if (need_causal) {
#pragma unroll
                    for (int blk = 0; blk < 2; ++blk)
#pragma unroll
                        for (int q = 0; q < 16; ++q) { const int kv = kvb + 32 * blk + 16 * (q >> 3) + (q & 7); p[blk][q] = kv <= t ? p[blk][q] : NEG_INF; }
                }
                if (need_win) {
#pragma unroll
                    for (int blk = 0; blk < 2; ++blk)
#pragma unroll
                        for (int q = 0; q < 16; ++q) { const int kv = kvb + 32 * blk + 16 * (q >> 3) + (q & 7); p[blk][q] = kv + 512 > t ? p[blk][q] : NEG_INF; }
                }
                float tmax = p[0][0];
#pragma unroll
                for (int q = 1; q < 16; ++q) tmax = fmaxf(tmax, p[0][q]);
#pragma unroll
                for (int q = 0; q < 16; ++q) tmax = fmaxf(tmax, p[1][q]);
                tmax = lane_on ? tmax : NEG_INF;
                tmax = xhalf_max(tmax);
                const float mnew = fmaxf(mrun, tmax);
                const bool grew = mnew > mrun;
                const float alpha = fexp2(mrun - mnew);
                mrun = mnew;
                const float msub = lane_on ? mnew : __builtin_inff();
                const f32x2_t ms2 = {msub, msub};
                f32x2_t ls2 = {0.f, 0.f};
#pragma unroll
                for (int blk = 0; blk < 2; ++blk)
#pragma unroll
                    for (int q = 0; q < 16; q += 2) {
                        const f32x2_t d2 = (f32x2_t){p[blk][q], p[blk][q + 1]} - ms2;
                        f32x2_t e2; e2.x = fexp2(d2.x); e2.y = fexp2(d2.y);
                        p[blk][q] = e2.x; p[blk][q + 1] = e2.y; ls2 += e2;
                    }
                lrun = lrun * alpha + (ls2.x + ls2.y);
                if (VAR == 2) wdone = __all(qkb + bias2[j > 0 ? 64 * j - 1 : 0] <= mrun - 40.f) ? 1u : 0u;
                if (__any(grew)) {
#pragma unroll
                    for (int db = 0; db < 2; ++db)
#pragma unroll
                        for (int q = 0; q < 16; ++q) o[db][q] *= alpha;
                }
            }
            pv_tile(Kt + 8192, p, r, h, o);
        }
        if (jn >= 0) kv_store(lds + (stage ^ 1) * 16384, TIDX, rg);
        if (VAR >= 2 && lane == 0) sbf[(step & 1) * 4 + (TIDX >> 6)] = wdone;
        __syncthreads();
        if (jn < 0) break;
        if (VAR >= 2) {
            const unsigned* f4 = (const unsigned*)sbf + (step & 1) * 4;
            if ((f4[0] & f4[1] & f4[2] & f4[3]) != 0u) break;
            ++step;
        }
        j = jn; stage ^= 1;
    }
    if (VAR != 3) {
        const float lt = xhalf_sum(lrun);
        const float inv = lt > 0.f ? 1.f / lt : 0.f;
#pragma unroll
        for (int db = 0; db < 2; ++db)
#pragma unroll
            for (int q = 0; q < 16; ++q) o[db][q] *= inv;
    }
}

DEV void head_norm_store(const f32x16 (&o)[2], const float* gam, bf16_t* dst, int h) {
    float ss = 0.f;
#pragma unroll
    for (int db = 0; db < 2; ++db)
#pragma unroll
        for (int q = 0; q < 16; ++q) ss += o[db][q] * o[db][q];
    ss += __shfl_xor(ss, 32);
    const float rinv = rsqrtf(ss * (1.f / 64.f) + EPS);
#pragma unroll
    for (int db = 0; db < 2; ++db)
#pragma unroll
        for (int g = 0; g < 4; ++g) {
            const int d = 32 * db + 8 * g + 4 * h;
            const float4 gg = *(const float4*)(gam + d);
            uint2 u;
            u.x = cvtpk(o[db][4 * g] * rinv * gg.x, o[db][4 * g + 1] * rinv * gg.y);
            u.y = cvtpk(o[db][4 * g + 2] * rinv * gg.z, o[db][4 * g + 3] * rinv * gg.w);
            *(uint2*)(dst + d) = u;
        }
}

template <int VAR>
DEV void mha_unit(const P& p, int l, int unit, unsigned char* lds) {
    const V v = make_views(p); const int TIDX = otid();
    const int lane = TIDX & 63, wave = TIDX >> 6, r = lane & 31, h = lane >> 5;
    const int qb = 15 - (unit >> 5), bh = unit & 31, b = bh >> 2, hh = bh & 3;
    const int t0 = qb * 128, tw = t0 + 32 * wave, t = tw + r, m = b * S + t;
    const int qcol = VAR == 2 ? C_QB : C_QC, kcol = VAR == 2 ? C_KB : C_KCC, vrow = VAR == 2 ? 256 : 512, ocol = VAR == 2 ? 512 : 768;
    bf16x8 qf[4];
#pragma unroll
    for (int s = 0; s < 4; ++s) qf[s] = scale_frag(*(const bf16x8*)(v.U + (size_t)m * NP + qcol + hh * 64 + 16 * s + 8 * h), C2);
    KVT src;
    src.k = v.U + (size_t)b * S * NP + kcol + hh * 64; src.ks = NP;
    src.v = (const bf16_t*)(p.ws + WS_VT) + (size_t)(b * 768 + vrow + hh * 64) * S; src.vs = S;
    const int last = (t0 + 127) >> 6;
    const unsigned tmask = last == 31 ? 0xffffffffu : ((1u << (last + 1)) - 1u);
    const float* bias2 = (const float*)(lds + 32768);
    if (VAR == 2) {
        float* cf = (float*)(lds + 32768);
        float* wt = (float*)(lds + 32768 + 8192);
        const float* lsf = (const float*)(p.ws + WS_LSF) + (size_t)(b * 4 + hh) * S;
        const int nel = t0 + 128;
        float x[8];
        if (8 * TIDX < nel) {
            const float4 a0 = *(const float4*)(lsf + 8 * TIDX), a1 = *(const float4*)(lsf + 8 * TIDX + 4);
            x[0] = a0.x; x[1] = x[0] + a0.y; x[2] = x[1] + a0.z; x[3] = x[2] + a0.w; x[4] = x[3] + a1.x; x[5] = x[4] + a1.y; x[6] = x[5] + a1.z; x[7] = x[6] + a1.w;
        } else {
#pragma unroll
            for (int q = 0; q < 8; ++q) x[q] = 0.f;
        }
        float inc = x[7];
#pragma unroll
        for (int o = 1; o < 64; o <<= 1) { const float tt = __shfl_up(inc, o); if (lane >= o) inc += tt; }
        __syncthreads();
        if (lane == 63) wt[wave] = inc;
        __syncthreads();
        float off = inc - x[7];
#pragma unroll
        for (int w = 0; w < 3; ++w) off += (w < wave) ? wt[w] : 0.f;
        if (8 * TIDX < nel) {
#pragma unroll
            for (int q = 0; q < 8; ++q) cf[8 * TIDX + q] = -(x[q] + off) * LOG2E;
        }
        __syncthreads();
    }
    f32x16 o[2];
    float qkb = 0.f;
    if (VAR == 2) {
        float qq = 0.f;
#pragma unroll
        for (int s = 0; s < 4; ++s) {
            const u32x4 u = __builtin_bit_cast(u32x4, qf[s]);
#pragma unroll
            for (int q = 0; q < 4; ++q) { const float lo = __uint_as_float(u[q] << 16), hi = __uint_as_float(u[q] & 0xffff0000u); qq += lo * lo + hi * hi; }
        }
        qq = xhalf_sum(qq);
        const float kn2 = __uint_as_float(__hip_atomic_load(v.ctl + CW_KN + (l * 8 + b) * 4 + hh, __ATOMIC_RELAXED, __HIP_MEMORY_SCOPE_AGENT));
        qkb = sqrtf(qq) * sqrtf(kn2) * 1.01f;
    }
    attn_branch<VAR>(lds, src, qf, tmask, (tw + 31) >> 6, t, tw, 0u, bias2, o, TIDX, qkb);
    head_norm_store(o, p.out_norm_g + (size_t)l * D + ocol + hh * 64, v.O + (size_t)m * D + ocol + hh * 64, h);
}

DEV void nsa_unit(const P& p, int l, int unit, unsigned char* lds) {
    const V v = make_views(p); const int TIDX = otid();
    const int lane = TIDX & 63, wave = TIDX >> 6, r = lane & 31, h = lane >> 5;
    const int qblk = 63 - (unit >> 4), bg = unit & 15, b = bg >> 1, g = bg & 1;
    const int t0 = qblk * 32, t = t0 + r, m = b * S + t, head = g * 4 + wave, cur = t0 >> 6;
    const float NEG_INF = -__builtin_inff();
    bf16x8 qf[4];
#pragma unroll
    for (int s = 0; s < 4; ++s) qf[s] = scale_frag(*(const bf16x8*)(v.U + (size_t)m * NP + C_QA + head * 64 + 16 * s + 8 * h), C2);
    const float g0 = sigmoidf_(v.gf[(size_t)m * 32 + head * 3]), g1 = sigmoidf_(v.gf[(size_t)m * 32 + head * 3 + 1]), g2 = sigmoidf_(v.gf[(size_t)m * 32 + head * 3 + 2]);
    f32x16 otot[2];
    float* PA = (float*)(lds + 32768);
    float* PB = (float*)(lds + 49152);
    float* SC = (float*)lds;
    unsigned* MASK = (unsigned*)(lds + 8192);
    {
        const bf16_t* ck = v.ck + (size_t)(b * 2 + g) * 128 * 64;
        const bf16_t* cvt = (const bf16_t*)(p.ws + WS_CVT) + (size_t)(b * 2 + g) * 64 * 128;
        const int c = TIDX & 7, r0 = TIDX >> 3;
        u32x4 rk[4], rv[4];
#pragma unroll
        for (int i = 0; i < 4; ++i) rk[i] = *(const u32x4*)(ck + (size_t)(r0 + 32 * i) * 64 + c * 8);
#pragma unroll
        for (int i = 0; i < 4; ++i) rv[i] = *(const u32x4*)(cvt + (size_t)(r0 + 32 * (i & 1)) * 128 + 64 * (i >> 1) + c * 8);
        __syncthreads();
#pragma unroll
        for (int i = 0; i < 4; ++i) *(u32x4*)(lds + tile_off(r0 + 32 * i, c)) = rk[i];
#pragma unroll
        for (int i = 0; i < 4; ++i) *(u32x4*)(lds + 16384 + 8192 * (i >> 1) + tile_off(r0 + 32 * (i & 1), c)) = rv[i];
        __syncthreads();
        f32x16 ps[2][2];
        score_tile(lds, qf, r, h, ps[0]);
        score_tile(lds + 8192, qf, r, h, ps[1]);
        const int nvalid = t >= 31 ? (t - 31) / 16 + 1 : 0;
        float mx = NEG_INF;
#pragma unroll
        for (int tt = 0; tt < 2; ++tt)
#pragma unroll
            for (int blk = 0; blk < 2; ++blk)
#pragma unroll
                for (int q = 0; q < 16; ++q) {
                    const int n = 64 * tt + 32 * blk + 16 * (q >> 3) + 8 * h + (q & 7);
                    const float x = n < nvalid ? ps[tt][blk][q] : NEG_INF;
                    ps[tt][blk][q] = x; mx = fmaxf(mx, x);
                }
        mx = fmaxf(mx, __shfl_xor(mx, 32));
        const float mxs = nvalid > 0 ? mx : 0.f;
        float ls = 0.f;
#pragma unroll
        for (int tt = 0; tt < 2; ++tt)
#pragma unroll
            for (int blk = 0; blk < 2; ++blk)
#pragma unroll
                for (int q = 0; q < 16; ++q) { const float e = fexp2(ps[tt][blk][q] - mxs); ps[tt][blk][q] = e; ls += e; }
        const float lt = ls + __shfl_xor(ls, 32);
        const float inv = lt > 0.f ? 1.f / lt : 0.f;
#pragma unroll
        for (int tt = 0; tt < 2; ++tt)
#pragma unroll
            for (int blk = 0; blk < 2; ++blk) {
#pragma unroll
                for (int q = 0; q < 16; ++q) ps[tt][blk][q] *= inv;
#pragma unroll
                for (int s = 0; s < 2; ++s) {
                    const int G0 = 16 * tt + 8 * blk + 4 * s + 2 * h;
                    const float a0 = (ps[tt][blk][8 * s] + ps[tt][blk][8 * s + 1]) + (ps[tt][blk][8 * s + 2] + ps[tt][blk][8 * s + 3]);
                    const float a1 = (ps[tt][blk][8 * s + 4] + ps[tt][blk][8 * s + 5]) + (ps[tt][blk][8 * s + 6] + ps[tt][blk][8 * s + 7]);
                    PA[(wave * 32 + G0) * 32 + r] = a0; PA[(wave * 32 + G0 + 1) * 32 + r] = a1;
                    PB[(wave * 32 + G0 + 1) * 32 + r] = ps[tt][blk][8 * s + 3];
                    if (G0 + 2 < 32) PB[(wave * 32 + G0 + 2) * 32 + r] = ps[tt][blk][8 * s + 7];
                }
            }
        f32x16 oc[2];
#pragma unroll
        for (int db = 0; db < 2; ++db)
#pragma unroll
            for (int q = 0; q < 16; ++q) oc[db][q] = 0.f;
        pv_tile(lds + 16384, ps[0], r, h, oc);
        pv_tile(lds + 24576, ps[1], r, h, oc);
#pragma unroll
        for (int db = 0; db < 2; ++db)
#pragma unroll
            for (int q = 0; q < 16; ++q) otot[db][q] = g0 * oc[db][q];
    }
    __syncthreads();
    const bool need_topk = cur > 15;
    if (need_topk) {
        const int q = TIDX & 31, j0 = (TIDX >> 5) * 4;
#pragma unroll
        for (int jj = 0; jj < 4; ++jj) {
            const int j = j0 + jj;
            float sc = 0.f;
#pragma unroll
            for (int w = 0; w < 4; ++w) sc += PA[(w * 32 + j) * 32 + q];
            if (j > 0) {
#pragma unroll
                for (int w = 0; w < 4; ++w) sc += PB[(w * 32 + j) * 32 + q];
            }
            const bool forced = (j == 0) || (j == cur) || (j == cur - 1);
            SC[q * 33 + j] = forced ? 1.0e4f : (j <= cur ? sc : -1.0f);
        }
        if (TIDX < 32) MASK[TIDX] = 0u;
        __syncthreads();
        unsigned bits = 0u;
#pragma unroll
        for (int jj = 0; jj < 4; ++jj) {
            const int j = j0 + jj;
            const float vj = SC[q * 33 + j];
            int rank = 0;
#pragma unroll
            for (int i = 0; i < 32; ++i) { const float vi = SC[q * 33 + i]; rank += (vi > vj || (vi == vj && i < j)) ? 1 : 0; }
            if (rank < 16) bits |= 1u << j;
        }
        atomicOr(&MASK[q], bits);
        __syncthreads();
    }
    const unsigned upto = (2u << cur) - 1u;
    unsigned mybits = upto, um = upto;
    if (need_topk) {
        mybits = MASK[r];
        um = 0u;
#pragma unroll
        for (int i = 0; i < 32; ++i) um |= MASK[i];
        um = (unsigned)__builtin_amdgcn_readfirstlane((int)um);
    }
    {
        KVT src; src.k = v.U + (size_t)b * S * NP + C_KS + g * 64; src.ks = NP;
        src.v = (const bf16_t*)(p.ws + WS_VT) + (size_t)(b * 768 + g * 64) * S; src.vs = S;
        f32x16 o[2];
        attn_branch<0>(lds, src, qf, um & upto, cur, t, t0, mybits, nullptr, o, TIDX);
#pragma unroll
        for (int db = 0; db < 2; ++db)
#pragma unroll
            for (int q = 0; q < 16; ++q) otot[db][q] += g1 * o[db][q];
    }
    {
        KVT src; src.k = v.U + (size_t)b * S * NP + C_KW + g * 64; src.ks = NP;
        src.v = (const bf16_t*)(p.ws + WS_VT) + (size_t)(b * 768 + 128 + g * 64) * S; src.vs = S;
        const int f = (t0 - 511 > 0 ? t0 - 511 : 0) >> 6;
        const unsigned wmask = upto & ~((1u << f) - 1u);
        f32x16 o[2];
        attn_branch<1>(lds, src, qf, wmask, cur, t, t0, 0u, nullptr, o, TIDX);
#pragma unroll
        for (int db = 0; db < 2; ++db)
#pragma unroll
            for (int q = 0; q < 16; ++q) otot[db][q] += g2 * o[db][q];
    }
    head_norm_store(otot, p.out_norm_g + (size_t)l * D + head * 64, v.O + (size_t)m * D + head * 64, h);
}

constexpr int CW_CMPK = 12288;
DEV bool cmp_unit(const P& p, int l, int unit, int kq, unsigned char* lds, volatile LAS unsigned* qslot) {
    const V v = make_views(p); const int TIDX = otid();
    const int lane = TIDX & 63, wave = TIDX >> 6, wm = wave >> 1, wn = wave & 1, r = lane & 31, h = lane >> 5;
    const int kv = unit & 1, bg = unit >> 1, b = bg >> 1, g = bg & 1, lk = l * 2 + kv;
    const int col = (kv ? C_VC : C_KC) + g * 64;
    const bf16_t* arow[4];
#pragma unroll
    for (int i = 0; i < 4; ++i) { const int n = (TIDX >> 3) + 32 * i; arow[i] = v.U + (size_t)(b * S + 16 * (n < 127 ? n : 126) + 8 * kq) * NP + col; }
    f32x16 acc[2][2];
    gemm128<false>(lds, arow, (const bf16_t*)(p.ws + WS_CW1) + (size_t)lk * 2048 * 128 + (size_t)kq * 512 * 128, 128, 512, acc, TIDX, NP);
    {
        const __amdgpu_buffer_rsrc_t prs = __builtin_amdgcn_make_buffer_rsrc((void*)v.OB, (short)0, 32 * 4 * 65536, 0x00020000);
        const unsigned pbase = (unsigned)(unit * 4 + kq) * 65536u + (unsigned)TIDX * 16u;
#pragma unroll
        for (int j = 0; j < 2; ++j)
#pragma unroll
            for (int i = 0; i < 2; ++i)
#pragma unroll
                for (int g4 = 0; g4 < 4; ++g4) {
                    const f32x4v a = {acc[j][i][4 * g4], acc[j][i][4 * g4 + 1], acc[j][i][4 * g4 + 2], acc[j][i][4 * g4 + 3]};
                    __builtin_amdgcn_raw_buffer_store_b128(__builtin_bit_cast(u32x4, a), prs, pbase + (unsigned)((j * 2 + i) * 4 + g4) * 4096u, 0,   16);
                }
        asm volatile("s_waitcnt vmcnt(0)" ::: "memory");
        __syncthreads();
        if (TIDX == 0) *qslot = __hip_atomic_fetch_add(v.ctl + CW_CMPK + l * 32 + unit, 1u, __ATOMIC_RELAXED, __HIP_MEMORY_SCOPE_AGENT);
        __syncthreads();
        if (*qslot != 3u) return false;
        if (TIDX == 0) { __builtin_amdgcn_fence(__ATOMIC_ACQUIRE, "agent"); asm volatile("s_waitcnt vmcnt(0)" ::: "memory"); }
        __syncthreads();
        const float* pp = v.OB + (size_t)unit * 4 * 16384 + TIDX * 4;
#pragma unroll
        for (int j = 0; j < 2; ++j)
#pragma unroll
            for (int i = 0; i < 2; ++i)
#pragma unroll
                for (int g4 = 0; g4 < 4; ++g4) {
                    const float* q0 = pp + ((j * 2 + i) * 4 + g4) * 1024;
                    f32x4v a = *(const f32x4v*)q0;
#pragma unroll
                    for (int k2 = 1; k2 < 4; ++k2) { const f32x4v b2 = *(const f32x4v*)(q0 + k2 * 16384); a += b2; }
                    acc[j][i][4 * g4] = a[0]; acc[j][i][4 * g4 + 1] = a[1]; acc[j][i][4 * g4 + 2] = a[2]; acc[j][i][4 * g4 + 3] = a[3];
                }
    }
    const float* pb = (const float*)(p.ws + WS_CPB) + lk * 8 * 128;
#pragma unroll
    for (int j = 0; j < 2; ++j)
#pragma unroll
        for (int i = 0; i < 2; ++i) {
            const int mrow = 64 * wm + 32 * i + r;
#pragma unroll
            for (int g4 = 0; g4 < 4; ++g4) {
                float4 bb = *(const float4*)(pb + 64 * wn + 32 * j + 8 * g4 + 4 * h);
#pragma unroll
                for (int c8 = 1; c8 < 8; ++c8) { const float4 b2 = *(const float4*)(pb + c8 * 128 + 64 * wn + 32 * j + 8 * g4 + 4 * h); bb.x += b2.x; bb.y += b2.y; bb.z += b2.z; bb.w += b2.w; }
                float x0 = acc[j][i][4 * g4] + bb.x, x1 = acc[j][i][4 * g4 + 1] + bb.y, x2 = acc[j][i][4 * g4 + 2] + bb.z, x3 = acc[j][i][4 * g4 + 3] + bb.w;
                x0 = x0 / (1.f + __expf(-x0)); x1 = x1 / (1.f + __expf(-x1)); x2 = x2 / (1.f + __expf(-x2)); x3 = x3 / (1.f + __expf(-x3));
                uint2 u; u.x = cvtpk(x0, x1); u.y = cvtpk(x2, x3);
                *(uint2*)(lds + wn * 16384 + tile_off(mrow, 4 * j + g4) + 8 * h) = u;
            }
        }
    {
        const bf16_t* w2 = (const bf16_t*)(p.ws + WS_CW2) + (size_t)lk * 64 * 128;
        const int c = TIDX & 7, r0 = TIDX >> 3;
#pragma unroll
        for (int i = 0; i < 4; ++i) {
            const int row = r0 + 32 * (i & 1), kt = i >> 1;
            *(u32x4*)(lds + 32768 + kt * 8192 + tile_off(row, c)) = *(const u32x4*)(w2 + (size_t)row * 128 + kt * 64 + c * 8);
        }
    }
    __syncthreads();
    f32x16 a2[2];
#pragma unroll
    for (int db = 0; db < 2; ++db)
#pragma unroll
        for (int q = 0; q < 16; ++q) a2[db][q] = 0.f;
#pragma unroll
    for (int kt = 0; kt < 2; ++kt)
#pragma unroll
        for (int s = 0; s < 4; ++s) {
            const bf16x8 hf = *(const bf16x8*)(lds + kt * 16384 + tile_off(32 * wave + r, 2 * s + h));
#pragma unroll
            for (int db = 0; db < 2; ++db) {
                const bf16x8 wf = *(const bf16x8*)(lds + 32768 + kt * 8192 + tile_off(32 * db + r, 2 * s + h));
                a2[db] = __builtin_amdgcn_mfma_f32_32x32x16_bf16(wf, hf, a2[db], 0, 0, 0);
            }
        }
    const int n = 32 * wave + r;
    if (kv == 0 && n < 127) {
        const int pos = 16 * n + 31;
#pragma unroll
        for (int q = 0; q < 4; ++q) {
            const float cs = v.rcos[pos * 8 + q + 4 * h], sn = v.rsin[pos * 8 + q + 4 * h];
            const float x1 = a2[0][q], x2 = a2[0][q + 4];
            a2[0][q] = x1 * cs - x2 * sn; a2[0][q + 4] = x2 * cs + x1 * sn;
        }
    }
    bf16_t* dst = (kv ? v.cv : v.ck) + ((size_t)bg * 128 + n) * 64;
    bf16_t* dt = (bf16_t*)(p.ws + WS_CVT) + (size_t)bg * 64 * 128 + n;
#pragma unroll
    for (int db = 0; db < 2; ++db)
#pragma unroll
        for (int g4 = 0; g4 < 4; ++g4) {
            const int d = 32 * db + 8 * g4 + 4 * h;
            float x0 = a2[db][4 * g4], x1 = a2[db][4 * g4 + 1], x2 = a2[db][4 * g4 + 2], x3 = a2[db][4 * g4 + 3];
            if (n >= 127) { x0 = 0.f; x1 = 0.f; x2 = 0.f; x3 = 0.f; }
            uint2 u; u.x = cvtpk(x0, x1); u.y = cvtpk(x2, x3);
            *(uint2*)(dst + d) = u;
            if (kv) { dt[(size_t)d * 128] = (bf16_t)(u.x & 0xffffu); dt[(size_t)(d + 1) * 128] = (bf16_t)(u.x >> 16); dt[(size_t)(d + 2) * 128] = (bf16_t)(u.y & 0xffffu); dt[(size_t)(d + 3) * 128] = (bf16_t)(u.y >> 16); }
        }
    __syncthreads();
    return true;
}

typedef float f32x4m __attribute__((ext_vector_type(4)));
DEV void ph_norm2_router_fast(const P& p, int l, unsigned char* lds) {
    const V v = make_views(p); const int TIDX = otid(), BIDX = obid();
    const int lane = TIDX & 63, wave = TIDX >> 6;
    const bf16_t* wr = (const bf16_t*)(p.ws + WS_WR) + (size_t)l * 2 * 64 * D;
    float* LG = (float*)(lds + 65536);
    for (int blk = BIDX; blk < T / 16; blk += gridDim.x) {
        const int m0 = blk * 16, b = m0 >> 11;
        const float* md = v.mod + (size_t)(l * 8 + b) * 6144;
        float4 xv[4][4]; float ssq[4];
#pragma unroll
        for (int rr = 0; rr < 4; ++rr)
#pragma unroll
            for (int j = 0; j < 4; ++j) xv[rr][j] = ld_bf4(v.XB + (size_t)(m0 + wave * 4 + rr) * D + 4 * lane + 256 * j);
#pragma unroll
        for (int rr = 0; rr < 4; ++rr) {
            ssq[rr] = 0.f;
#pragma unroll
            for (int j = 0; j < 4; ++j) ssq[rr] += xv[rr][j].x * xv[rr][j].x + xv[rr][j].y * xv[rr][j].y + xv[rr][j].z * xv[rr][j].z + xv[rr][j].w * xv[rr][j].w;
        }
#pragma unroll
        for (int o = 1; o < 64; o <<= 1) {
#pragma unroll
            for (int rr = 0; rr < 4; ++rr) ssq[rr] += __shfl_xor(ssq[rr], o);
        }
#pragma unroll
        for (int rr = 0; rr < 4; ++rr) {
            const int row = wave * 4 + rr, m = m0 + row;
            const float rs = rsqrtf(ssq[rr] * (1.f / D) + EPS);
#pragma unroll
            for (int j = 0; j < 4; ++j) {
                const int c = 4 * lane + 256 * j;
                const float4 g = *(const float4*)(p.norm2_g + l * D + c), sh = *(const float4*)(md + 3 * D + c), sc = *(const float4*)(md + 4 * D + c);
                const float h0 = xv[rr][j].x * rs * g.x * (1.f + sc.x) + sh.x, h1 = xv[rr][j].y * rs * g.y * (1.f + sc.y) + sh.y;
                const float h2 = xv[rr][j].z * rs * g.z * (1.f + sc.z) + sh.z, h3 = xv[rr][j].w * rs * g.w * (1.f + sc.w) + sh.w;
                uint2 hi; hi.x = cvtpk(h0, h1); hi.y = cvtpk(h2, h3);
                uint2 lo;
                lo.x = cvtpk(h0 - __uint_as_float(hi.x << 16), h1 - __uint_as_float(hi.x & 0xffff0000u));
                lo.y = cvtpk(h2 - __uint_as_float(hi.y << 16), h3 - __uint_as_float(hi.y & 0xffff0000u));
                *(uint2*)(v.H + (size_t)m * D + c) = hi;
                const int off = row * 2048 + ((((c >> 3) ^ row) & 127) << 4) + (c & 7) * 2;
                *(uint2*)(lds + off) = hi; *(uint2*)(lds + 32768 + off) = lo;
            }
        }
        __syncthreads();
        {
            const int r16 = lane & 15, kq = lane >> 4;
            f32x4m acc = {0.f, 0.f, 0.f, 0.f};
            const bf16_t* wh = wr + (size_t)(16 * wave + r16) * D + 8 * kq;
#pragma unroll 8
            for (int s = 0; s < 32; ++s) {
                const int off = r16 * 2048 + ((((4 * s + kq) ^ r16) & 127) << 4);
                const bf16x8 ah = *(const bf16x8*)(lds + off), al = *(const bf16x8*)(lds + 32768 + off);
                const bf16x8 bh = *(const bf16x8*)(wh + 32 * s), bl = *(const bf16x8*)(wh + 64 * D + 32 * s);
                acc = __builtin_amdgcn_mfma_f32_16x16x32_bf16(ah, bh, acc, 0, 0, 0);
                acc = __builtin_amdgcn_mfma_f32_16x16x32_bf16(al, bh, acc, 0, 0, 0);
                acc = __builtin_amdgcn_mfma_f32_16x16x32_bf16(ah, bl, acc, 0, 0, 0);
            }
#pragma unroll
            for (int q = 0; q < 4; ++q) LG[(4 * kq + q) * 64 + 16 * wave + r16] = acc[q];
        }
        __syncthreads();
        if (TIDX < 16) {
            const int m = m0 + TIDX;
            const float* lgp = LG + TIDX * 64;
            float lg[4], le[32];
#pragma unroll
            for (int i = 0; i < 4; ++i) lg[i] = lgp[i] + p.rg_b[l * 4 + i];
#pragma unroll
            for (int i = 0; i < 32; ++i) le[i] = lgp[4 + i] + p.re_b[l * 32 + i];
            int gi = 0; float gm = lg[0];
#pragma unroll
            for (int i = 1; i < 4; ++i) if (lg[i] > gm) { gm = lg[i]; gi = i; }
            float gs = 0.f;
#pragma unroll
            for (int i = 0; i < 4; ++i) gs += expf(lg[i] - gm);
            const float pg = 1.f / gs;
            float el[8];
#pragma unroll
            for (int i = 0; i < 8; ++i) el[i] = gi == 0 ? le[i] : (gi == 1 ? le[8 + i] : (gi == 2 ? le[16 + i] : le[24 + i]));
            int e1 = 0; float m1 = el[0];
#pragma unroll
            for (int i = 1; i < 8; ++i) if (el[i] > m1) { m1 = el[i]; e1 = i; }
            int e2 = -1; float m2 = -3.0e38f;
#pragma unroll
            for (int i = 0; i < 8; ++i) if (i != e1 && el[i] > m2) { m2 = el[i]; e2 = i; }
            const float p2 = expf(m2 - m1);
            const float w1 = pg / (1.f + p2), w2 = pg * p2 / (1.f + p2);
            const int ea = gi * 8 + e1, eb = gi * 8 + e2;
            const unsigned pa = atomicAdd(v.ctl + CW_CNT + l * 32 + ea, 1u);
            const unsigned pb = atomicAdd(v.ctl + CW_CNT + l * 32 + eb, 1u);
            v.list[(size_t)ea * T + pa] = 2 * m;
            v.list[(size_t)eb * T + pb] = 2 * m + 1;
            v.wts[2 * m] = w1; v.wts[2 * m + 1] = w2;
        }
        __syncthreads();
    }
}

constexpr int CW_MQ = 8192 + 512;
DEV void ph_mix(const P& p, int l, unsigned char* lds, volatile LAS unsigned* qslot, int rep) {
    const int TIDX = otid(), BIDX = obid();
    unsigned* ctl = (unsigned*)(p.ws + WS_CTL) + CW_MQ + l * 256;
    unsigned acq = 0u;
    int b = BIDX & 7;
    {
        for (;;) {
            unsigned* qc = ctl + b * 16;
            unsigned* done = ctl + 128 + b * 16;
            __syncthreads();
            if (TIDX == 0) {
                unsigned tk = atomicAdd(qc, 1u), nb = (unsigned)b;
                if (tk >= 272u) {
                    unsigned hd[8];
#pragma unroll
                    for (int q = 0; q < 8; ++q) hd[q] = __hip_atomic_load(ctl + ((b + q) & 7) * 16, __ATOMIC_RELAXED, __HIP_MEMORY_SCOPE_AGENT);
                    nb = 8u;
#pragma unroll
                    for (int q = 7; q >= 1; --q) if (hd[q] < 272u) nb = (unsigned)((b + q) & 7);
                }
                *qslot = tk | (nb << 16);
            }
            __syncthreads();
            const unsigned qv = *qslot;
            const int v = (int)(qv & 0xffffu);
            if (v >= 272) {
                const int nb = (int)(qv >> 16);
                if (nb >= 8) break;
                b = nb; continue;
            }
            if (v < 16) {
                if (cmp_unit(p, l, b * 4 + (v >> 2), v & 3, lds, qslot)) {
                    asm volatile("s_waitcnt vmcnt(0)" ::: "memory");
                    __syncthreads();
                    if (TIDX == 0) {
                        __builtin_amdgcn_fence(__ATOMIC_RELEASE, "agent");
                        asm volatile("s_waitcnt vmcnt(0)" ::: "memory");
                        __hip_atomic_fetch_add(done, 1u, __ATOMIC_RELAXED, __HIP_MEMORY_SCOPE_AGENT);
                    }
                }
                continue;
            }
            int slot = -1, nsa = -1;
            if (v < 48) slot = 2 * (v - 16);
            else if (v < 112) slot = 2 * (v - 48) + 1;
            else { const int w2 = v - 112, k = w2 % 5, i = w2 / 5; if (k < 4) nsa = 4 * i + k; else slot = 2 * (32 + i); }
            if (slot >= 0) {
                const int idx = slot >> 1, u = ((idx >> 2) << 5) | (b * 4 + (idx & 3));
                if (slot & 1) mha_unit<3>(p, l, u, lds); else mha_unit<2>(p, l, u, lds);
            } else {
                if (!((acq >> b) & 1u)) {
                    if (TIDX == 0) {
                        unsigned sp = 0;
                        while (__hip_atomic_load(done, __ATOMIC_RELAXED, __HIP_MEMORY_SCOPE_AGENT) < 4u) { __builtin_amdgcn_s_sleep(2); if (++sp > (1u << 22)) break; }
                        __builtin_amdgcn_fence(__ATOMIC_ACQUIRE, "agent");
                        asm volatile("s_waitcnt vmcnt(0)" ::: "memory");
                    }
                    __syncthreads();
                    acq |= 1u << b;
                }
                nsa_unit(p, l, ((nsa >> 1) << 4) | (b * 2 + (nsa & 1)), lds);
            }
        }
    }
}

#ifndef REP_PHASE
#define REP_PHASE 0
#endif
#ifndef REF_HEADS
#define REF_HEADS 0x0000u
#endif
__global__ void __launch_bounds__(256, 2) fwd_kernel(P p) {
    __shared__ __attribute__((aligned(16))) float lds[17408];
    __shared__ __attribute__((aligned(16))) unsigned lds_ctl[4];
    if (threadIdx.x < 4) lds_ctl[threadIdx.x] = 0u;
    __syncthreads();
    const XcdBarrier xb = xcd_barrier_post((unsigned*)(p.ws + WS_CTL), (volatile LAS unsigned*)lds_ctl);
#define GRID_BAR() do { xcd_barrier(xb); if (REP_PHASE == 7) xcd_barrier(xb); } while (0)
    volatile LAS unsigned* qslot = (volatile LAS unsigned*)(lds_ctl + 2);
    for (int rep = 0; rep < (REP_PHASE == 1 ? 2 : 1); ++rep) {
        ph_prologue(p, lds);
        ph_convert(p, lds);
        GRID_BAR();
    }
    for (int l = 0; l < DEPTH; ++l) {
        ph_convert_dense(p, l, 0);
        ph_norm1(p, l, l == 0 ? 0 : 1);
        GRID_BAR();
        for (int rep = 0; rep < (REP_PHASE == 2 ? 2 : 1); ++rep) {
            if (rep == 0) ph_convert_dense(p, l, 1);
            ph_inproj_fast(p, l, (unsigned char*)lds);
            GRID_BAR();
        }
        for (int rep = 0; rep < (REP_PHASE == 3 ? 2 : 1); ++rep) {
            ph_mix(p, l, (unsigned char*)lds, qslot, rep);
            GRID_BAR();
        }
        ph_outproj_fast(p, l, (unsigned char*)lds);
        GRID_BAR();
        if (blockIdx.x & 8) { ph_convert_experts(p, l); ph_norm2_router_fast(p, l, (unsigned char*)lds); }
        else { ph_norm2_router_fast(p, l, (unsigned char*)lds); ph_convert_experts(p, l); }
        GRID_BAR();
        for (int rep = 0; rep < (REP_PHASE == 5 ? 2 : 1); ++rep) {
            ph_moe_up_fast(p, l, (unsigned char*)lds);
            GRID_BAR();
        }
        for (int rep = 0; rep < (REP_PHASE == 6 ? 2 : 1); ++rep) {
            ph_moe_down_fast(p, l, (unsigned char*)lds);
            GRID_BAR();
        }
    }
    ph_norm1(p, DEPTH, 2);
}

extern "C" void kernel_launch(void* const* d_in, const int* in_sizes, int n_in,
                              void* d_out, int out_size, void* d_ws, size_t ws_size,
                              hipStream_t stream) {
    static int grid_blocks = 0;
    if (!grid_blocks) {
        int dev = 0, cus = 0, per_cu = 0;
        (void)hipGetDevice(&dev);
        (void)hipDeviceGetAttribute(&cus, hipDeviceAttributeMultiprocessorCount, dev);
        (void)hipOccupancyMaxActiveBlocksPerMultiprocessor(&per_cu, fwd_kernel, 256, 0);
        if (per_cu > 2) per_cu = 2;
        if (per_cu < 1) per_cu = 1;
        grid_blocks = cus * per_cu;
        if (n_in != 24 || ws_size < WS_END || out_size != T * D) { fprintf(stderr, "kernel_launch: unexpected shapes (n_in %d ws %zu out %d)\n", n_in, ws_size, out_size); grid_blocks = -1; }
    }
    if (grid_blocks < 0) return;
    (void)hipMemsetAsync(d_ws, 0, CTL_BYTES, stream);
    P p{};
    const float** pp = (const float**)&p;
    for (int i = 0; i < 24; ++i) pp[i] = (const float*)d_in[i];
    p.out = (float*)d_out; p.ws = (unsigned char*)d_ws;
    void* args[] = {&p};
    hipError_t e = hipLaunchCooperativeKernel((void*)fwd_kernel, dim3(grid_blocks), dim3(256), args, 0, stream);
    if (e != hipSuccess) fprintf(stderr, "cooperative launch failed: %s (grid %d)\n", hipGetErrorString(e), grid_blocks);
}
```

```cpp
#include <hip/hip_runtime.h>
#include <hip/hip_cooperative_groups.h>
#include <cstdio>
#include <cstdint>

#define LAS __attribute__((address_space(3)))
#define DEV __device__ __forceinline__

constexpr int T = 16384, S = 2048, NB = 8, D = 1024, DIN = 2844, NP = 2880, DEPTH = 4;
constexpr int NCMP = 127;
constexpr float EPS = 1e-6f;
constexpr float SCALE = 0.125f;
constexpr int C_QA = 0, C_KC = 512, C_VC = 640, C_KS = 768, C_VS = 896, C_KW = 1024, C_VW = 1152;
constexpr int C_QB = 1280, C_KB = 1536, C_VB = 1792, C_QC = 2048, C_KCC = 2304, C_VCC = 2560;

constexpr size_t MiB = 1u << 20;
constexpr size_t WS_CTL = 0, CTL_BYTES = 64 * 1024;
constexpr size_t WS_MOD = 1 * MiB, WS_ROPE = 2 * MiB, WS_CUMF = 3 * MiB, WS_CK = 4 * MiB, WS_CV = 5 * MiB, WS_IMP = 6 * MiB;
constexpr size_t WS_SEL = 10 * MiB, WS_EID = 11 * MiB, WS_WTS = 12 * MiB, WS_LIST = 13 * MiB, WS_GF = 16 * MiB;
constexpr size_t WS_H = 32 * MiB, WS_U = 64 * MiB, WS_O = 160 * MiB, WS_HID = 192 * MiB, WS_Y = 224 * MiB, WS_OB = 352 * MiB, WS_ORAW = 448 * MiB;
constexpr size_t WS_END = 973 * MiB;
constexpr size_t WS_VT = 936 * MiB;
constexpr size_t WS_CVT = 962 * MiB;
constexpr size_t WS_CUMF2 = 963 * MiB;
constexpr int CW_Q = 8192 + 256;
constexpr size_t WS_CW1 = 964 * MiB;
constexpr size_t WS_CW2 = 968 * MiB;
constexpr size_t WS_CPB = 969 * MiB;
constexpr size_t WS_LSF = 970 * MiB;
constexpr size_t WS_WR = 971 * MiB;
constexpr int CW_CNT = 8192;
constexpr int CW_KN = 12544;

typedef unsigned short bf16_t;
typedef float f32x4v __attribute__((ext_vector_type(4)));
DEV int vt_row(int n) { return n < 1024 ? n - 896 : (n < 1280 ? 128 + n - 1152 : (n < 2048 ? 256 + n - 1792 : 512 + n - 2560)); }
DEV bool is_vcol(int n) { return (n >= C_VS && n < C_KW) || (n >= C_VW && n < C_QB) || (n >= C_VB && n < C_QC) || (n >= C_VCC && n < 2816); }
DEV float bf2f(bf16_t v) { return __uint_as_float((unsigned)v << 16); }
DEV bf16_t f2bf(float f) { unsigned u = __float_as_uint(f); return (bf16_t)((u + 0x7fffu + ((u >> 16) & 1u)) >> 16); }
DEV float4 ld_bf4(const bf16_t* p) { const ushort4 u = *(const ushort4*)p; return make_float4(bf2f(u.x), bf2f(u.y), bf2f(u.z), bf2f(u.w)); }
typedef float f32x2_t __attribute__((ext_vector_type(2)));
typedef __bf16 bf16x2_t __attribute__((ext_vector_type(2)));
DEV unsigned cvtpk(float lo, float hi) { f32x2_t v = {lo, hi}; bf16x2_t b = __builtin_convertvector(v, bf16x2_t); return __builtin_bit_cast(unsigned, b); }
DEV float sigmoidf_(float x) { return 1.f / (1.f + expf(-x)); }
DEV float logsigmoidf_(float x) { return fminf(x, 0.f) - log1pf(expf(-fabsf(x))); }
DEV float wave_sum(float v) {
#pragma unroll
    for (int o = 1; o < 64; o <<= 1) v += __shfl_xor(v, o);
    return v;
}

#define XB_TMO      128
#define XB_XCNT(j)  (256  + 64 * (j))
#define XB_XSUB(j)  (1280 + 64 * (j))
#define XB_XGEN(j)  (2304 + 64 * (j))
#define XB_TOP      3328
#define XB_TOPGEN   3392
#define XCD_BAR_WORDS 3456
#define XB_SPIN_CAP (1u << 23)
DEV unsigned xb_ld(unsigned* p)              { return __hip_atomic_load(p, __ATOMIC_RELAXED, __HIP_MEMORY_SCOPE_AGENT); }
DEV unsigned xb_add(unsigned* p, unsigned v) { return __hip_atomic_fetch_add(p, v, __ATOMIC_RELAXED, __HIP_MEMORY_SCOPE_AGENT); }
DEV unsigned xb_xcc_id() { return (unsigned)__builtin_amdgcn_s_getreg((3 << 11) | 20) & 0xFu; }
#define XB_SPIN(cond, bar) do { unsigned _sp = 0; while (cond) { __builtin_amdgcn_s_sleep(1); \
    if ((++_sp & 255u) == 0u) { if (xb_ld(&(bar)[XB_TMO])) break; if (_sp > XB_SPIN_CAP) { atomicAdd(&(bar)[XB_TMO], 1u); break; } } } } while (0)
struct XcdBarrier { unsigned* bar; unsigned x; volatile LAS unsigned* st; };
DEV XcdBarrier xcd_barrier_post(unsigned* bar, volatile LAS unsigned* st) {
    XcdBarrier b; b.bar = bar; b.x = xb_xcc_id(); b.st = st;
    if (threadIdx.x == 0) (void)xb_add(&bar[XB_XCNT(b.x)], 1u);
    return b;
}
DEV void xcd_barrier_complete(unsigned* bar, unsigned x, unsigned& nloc, unsigned& nx) {
    const unsigned G = gridDim.x * gridDim.y * gridDim.z;
    unsigned sum, cnt, mine, sp = 0u;
    for (;;) {
        sum = 0u; cnt = 0u; mine = 0u;
#pragma unroll
        for (unsigned j = 0; j < 16; ++j) { const unsigned c = xb_ld(&bar[XB_XCNT(j)]); sum += c; cnt += (c > 0u) ? 1u : 0u; mine = (j == x) ? c : mine; }
        if (sum == G) break;
        __builtin_amdgcn_s_sleep(1);
        if ((++sp & 255u) == 0u) { if (xb_ld(&bar[XB_TMO])) break; if (sp > XB_SPIN_CAP) { atomicAdd(&bar[XB_TMO], 1u); break; } }
    }
    nloc = mine > 0u ? mine : 1u; nx = cnt > 0u ? cnt : 1u;
}
DEV void xcd_barrier(const XcdBarrier& b) {
    asm volatile("s_waitcnt vmcnt(0)" ::: "memory");
    __syncthreads();
    if (threadIdx.x == 0) {
        unsigned* bar = b.bar;
        __builtin_amdgcn_s_waitcnt(0);
        unsigned nloc = b.st[0], nx = b.st[1];
        if (nloc == 0u) { xcd_barrier_complete(bar, b.x, nloc, nx); b.st[0] = nloc; b.st[1] = nx; }
        const unsigned old = xb_add(&bar[XB_XSUB(b.x)], 1u);
        const unsigned gen = old / nloc;
        if (old + 1u == (gen + 1u) * nloc) {
            __builtin_amdgcn_fence(__ATOMIC_RELEASE, "agent");
            asm volatile("s_waitcnt vmcnt(0)" ::: "memory");
            const unsigned og = xb_add(&bar[XB_TOP], 1u);
            const unsigned tg = og / nx;
            if (og + 1u == (tg + 1u) * nx) xb_add(&bar[XB_TOPGEN], 1u);
            else XB_SPIN(xb_ld(&bar[XB_TOPGEN]) == tg, bar);
            __builtin_amdgcn_fence(__ATOMIC_ACQUIRE, "agent");
            xb_add(&bar[XB_XGEN(b.x)], 1u);
            asm volatile("s_waitcnt vmcnt(0)" ::: "memory");
        } else {
            XB_SPIN(xb_ld(&bar[XB_XGEN(b.x)]) == gen, bar);
            __builtin_amdgcn_fence(__ATOMIC_ACQUIRE, "agent");
            asm volatile("s_waitcnt vmcnt(0)" ::: "memory");
        }
    }
    __syncthreads();
}

struct P {
    const float *x, *c, *norm1_g, *norm2_g, *ada_w, *ada_b, *w_in, *b_forget, *cmp_pos_k, *cmp_w1_k, *cmp_w2_k,
        *cmp_pos_v, *cmp_w1_v, *cmp_w2_v, *out_norm_g, *w_out, *rg_w, *rg_b, *re_w, *re_b, *e_w1, *e_w3, *e_w2, *final_g;
    float* out; unsigned char* ws;
};
struct V {
    unsigned* ctl; float* mod; float* rcos; float* rsin; float* cumf; bf16_t* ck; bf16_t* cv; float* imp; unsigned* sel;
    int* eid; float* wts; int* list; float* gf; bf16_t* H; bf16_t* U; bf16_t* O; bf16_t* HID; bf16_t* Y; float* OB; float* ORAW; float* X; bf16_t* XB;
};
DEV int otid() { int t = threadIdx.x; asm volatile("" : "+v"(t)); return t; }
DEV int obid() { int t = blockIdx.x; asm volatile("" : "+s"(t)); return t; }
DEV V make_views(const P& p) {
    V v; size_t woff = 0; asm volatile("" : "+s"(woff)); unsigned char* w = p.ws + woff;
    v.ctl = (unsigned*)(w + WS_CTL); v.mod = (float*)(w + WS_MOD); v.rcos = (float*)(w + WS_ROPE); v.rsin = v.rcos + S * 8;
    v.cumf = (float*)(w + WS_CUMF); v.ck = (bf16_t*)(w + WS_CK); v.cv = (bf16_t*)(w + WS_CV); v.imp = (float*)(w + WS_IMP);
    v.sel = (unsigned*)(w + WS_SEL); v.eid = (int*)(w + WS_EID); v.wts = (float*)(w + WS_WTS); v.list = (int*)(w + WS_LIST);
    v.gf = (float*)(w + WS_GF); v.H = (bf16_t*)(w + WS_H); v.U = (bf16_t*)(w + WS_U); v.O = (bf16_t*)(w + WS_O);
    v.HID = (bf16_t*)(w + WS_HID); v.Y = (bf16_t*)(w + WS_Y); v.OB = (float*)(w + WS_OB); v.ORAW = (float*)(w + WS_ORAW); v.X = p.out; v.XB = (bf16_t*)(w + WS_ORAW);
    return v;
}

DEV void ph_prologue(const P& p, float* lds) {
    const V v = make_views(p); const int TIDX = otid(), BIDX = obid();
    const int tid = TIDX;
    for (int i = tid; i < NB * D; i += 256) { const float c = p.c[i]; lds[i] = c / (1.f + expf(-c)); }
    __syncthreads();
    float* red = lds + NB * D;
    const int c4 = tid & 15, ks = tid >> 4;
    for (int unit = BIDX; unit < DEPTH * 96; unit += gridDim.x) {
        const int l = unit / 96, n0 = (unit % 96) * 64;
        const float* W = p.ada_w + (size_t)l * D * 6144 + n0 + 4 * c4;
        float acc[8][4];
#pragma unroll
        for (int b = 0; b < 8; ++b)
#pragma unroll
            for (int q = 0; q < 4; ++q) acc[b][q] = 0.f;
#pragma unroll 1
        for (int i0 = 0; i0 < 64; i0 += 8) {
            f32x4v w[8];
#pragma unroll
            for (int i = 0; i < 8; ++i) w[i] = __builtin_nontemporal_load((const f32x4v*)(W + (size_t)(ks + 16 * (i0 + i)) * 6144));
#pragma unroll
            for (int i = 0; i < 8; ++i) {
                const int k = ks + 16 * (i0 + i);
#pragma unroll
                for (int b = 0; b < 8; ++b) {
                    const float cv = lds[b * D + k];
                    acc[b][0] += cv * w[i].x; acc[b][1] += cv * w[i].y; acc[b][2] += cv * w[i].z; acc[b][3] += cv * w[i].w;
                }
            }
        }
#pragma unroll
        for (int b = 0; b < 8; ++b) *(float4*)(red + (ks * 8 + b) * 64 + 4 * c4) = make_float4(acc[b][0], acc[b][1], acc[b][2], acc[b][3]);
        __syncthreads();
        for (int o = tid; o < 512; o += 256) {
            const int c2 = o & 63, b = o >> 6;
            float sm = p.ada_b[l * 6144 + n0 + c2];
#pragma unroll
            for (int q = 0; q < 16; ++q) sm += red[(q * 8 + b) * 64 + c2];
            v.mod[(size_t)(l * 8 + b) * 6144 + n0 + c2] = sm;
        }
        __syncthreads();
    }
    const float cst = -2.0f * 13.122363377404328f / 16.0f;
    for (int i = ((int)gridDim.x - 1 - BIDX) * 256 + tid; i < S * 8; i += gridDim.x * 256) {
        const int s = i >> 3, j = i & 7;
        const float inv = expf((float)j * cst);
        const float ang = (float)s * inv;
        v.rcos[i] = cosf(ang); v.rsin[i] = sinf(ang);
    }
}

DEV void ph_norm1(const P& p, int l, int mode) {
    const V v = make_views(p); const int TIDX = otid(), BIDX = obid();
    const int lane = TIDX & 63;
    const int gw = (BIDX * 256 + TIDX) >> 6, nw = gridDim.x * 4;
    for (int m0 = gw; m0 < T; m0 += 2 * nw) {
        float4 xv[2][4];
        if (mode == 0) {
#pragma unroll
            for (int rr = 0; rr < 2; ++rr)
#pragma unroll
                for (int j = 0; j < 4; ++j) xv[rr][j] = *(const float4*)(p.x + (size_t)(m0 + rr * nw) * D + 4 * lane + 256 * j);
        } else {
            ushort4 xa[2][4], ya[2][4], yb[2][4];
#pragma unroll
            for (int rr = 0; rr < 2; ++rr)
#pragma unroll
                for (int j = 0; j < 4; ++j) {
                    const int m = m0 + rr * nw, c = 4 * lane + 256 * j;
                    xa[rr][j] = *(const ushort4*)(v.XB + (size_t)m * D + c);
                    ya[rr][j] = *(const ushort4*)(v.Y + (size_t)(2 * m) * D + c); yb[rr][j] = *(const ushort4*)(v.Y + (size_t)(2 * m + 1) * D + c);
                }
#pragma unroll
            for (int rr = 0; rr < 2; ++rr) {
                const float* g2 = v.mod + (size_t)((l - 1) * 8 + ((m0 + rr * nw) >> 11)) * 6144 + 5 * D;
#pragma unroll
                for (int j = 0; j < 4; ++j) {
                    const float4 g = *(const float4*)(g2 + 4 * lane + 256 * j);
                    float4 a = make_float4(bf2f(xa[rr][j].x), bf2f(xa[rr][j].y), bf2f(xa[rr][j].z), bf2f(xa[rr][j].w));
                    a.x += g.x * (bf2f(ya[rr][j].x) + bf2f(yb[rr][j].x)); a.y += g.y * (bf2f(ya[rr][j].y) + bf2f(yb[rr][j].y));
                    a.z += g.z * (bf2f(ya[rr][j].z) + bf2f(yb[rr][j].z)); a.w += g.w * (bf2f(ya[rr][j].w) + bf2f(yb[rr][j].w));
                    xv[rr][j] = a;
                }
            }
        }
        float ss[2];
#pragma unroll
        for (int rr = 0; rr < 2; ++rr) {
            ss[rr] = 0.f;
#pragma unroll
            for (int j = 0; j < 4; ++j) ss[rr] += xv[rr][j].x * xv[rr][j].x + xv[rr][j].y * xv[rr][j].y + xv[rr][j].z * xv[rr][j].z + xv[rr][j].w * xv[rr][j].w;
        }
#pragma unroll
        for (int o = 1; o < 64; o <<= 1) { ss[0] += __shfl_xor(ss[0], o); ss[1] += __shfl_xor(ss[1], o); }
#pragma unroll
        for (int rr = 0; rr < 2; ++rr) {
            const int m = m0 + rr * nw, b = m >> 11;
            const float r = rsqrtf(ss[rr] * (1.f / D) + EPS);
            if (mode == 2) {
#pragma unroll
                for (int j = 0; j < 4; ++j) {
                    const int c = 4 * lane + 256 * j;
                    const float4 g = *(const float4*)(p.final_g + c);
                    float4 o; o.x = xv[rr][j].x * r * g.x; o.y = xv[rr][j].y * r * g.y; o.z = xv[rr][j].z * r * g.z; o.w = xv[rr][j].w * r * g.w;
                    *(float4*)(v.X + (size_t)m * D + c) = o;
                }
            } else {
                const float* md = v.mod + (size_t)(l * 8 + b) * 6144;
#pragma unroll
                for (int j = 0; j < 4; ++j) {
                    const int c = 4 * lane + 256 * j;
                    { uint2 xo; xo.x = cvtpk(xv[rr][j].x, xv[rr][j].y); xo.y = cvtpk(xv[rr][j].z, xv[rr][j].w); *(uint2*)(v.XB + (size_t)m * D + c) = xo; }
                    const float4 g = *(const float4*)(p.norm1_g + l * D + c), sh = *(const float4*)(md + c), sc = *(const float4*)(md + D + c);
                    uint2 o;
                    o.x = cvtpk(xv[rr][j].x * r * g.x * (1.f + sc.x) + sh.x, xv[rr][j].y * r * g.y * (1.f + sc.y) + sh.y);
                    o.y = cvtpk(xv[rr][j].z * r * g.z * (1.f + sc.z) + sh.z, xv[rr][j].w * r * g.w * (1.f + sc.w) + sh.w);
                    *(uint2*)(v.H + (size_t)m * D + c) = o;
                }
            }
        }
    }
}

typedef short bf16x8 __attribute__((ext_vector_type(8)));
typedef float f32x16 __attribute__((ext_vector_type(16)));
typedef unsigned u32x4 __attribute__((ext_vector_type(4)));
constexpr size_t WS_WIN = 512 * MiB, WS_WOT = 544 * MiB, WS_W13 = 552 * MiB, WS_W2 = 808 * MiB;
constexpr int NPW = 2944;
DEV int tile_off(int row, int chunk) { return row * 128 + ((chunk ^ ((row >> 1) & 7)) << 4); }
template <class RM>
DEV void conv_patch(const float* src, int N, int K, bf16_t* dst, int k0, int n0, RM rowmap, int lane) {
    const int kg = lane >> 3, n = n0 + 4 * (lane & 7);
    if (n >= N) return;
    const float* sp = src + (size_t)(k0 + 8 * kg) * N + n;
    f32x4v x[8];
#pragma unroll
    for (int j = 0; j < 8; ++j) x[j] = __builtin_nontemporal_load((const f32x4v*)(sp + (size_t)j * N));
    bf16_t* dp = dst + k0 + 8 * kg;
    u32x4 o;
    o.x = cvtpk(x[0].x, x[1].x); o.y = cvtpk(x[2].x, x[3].x); o.z = cvtpk(x[4].x, x[5].x); o.w = cvtpk(x[6].x, x[7].x);
    *(u32x4*)(dp + (size_t)rowmap(n) * K) = o;
    o.x = cvtpk(x[0].y, x[1].y); o.y = cvtpk(x[2].y, x[3].y); o.z = cvtpk(x[4].y, x[5].y); o.w = cvtpk(x[6].y, x[7].y);
    *(u32x4*)(dp + (size_t)rowmap(n + 1) * K) = o;
    o.x = cvtpk(x[0].z, x[1].z); o.y = cvtpk(x[2].z, x[3].z); o.z = cvtpk(x[4].z, x[5].z); o.w = cvtpk(x[6].z, x[7].z);
    *(u32x4*)(dp + (size_t)rowmap(n + 2) * K) = o;
    o.x = cvtpk(x[0].w, x[1].w); o.y = cvtpk(x[2].w, x[3].w); o.z = cvtpk(x[4].w, x[5].w); o.w = cvtpk(x[6].w, x[7].w);
    *(u32x4*)(dp + (size_t)rowmap(n + 3) * K) = o;
}

DEV void conv8(const float* s0, const float* s1, bf16_t* dst) {
    f32x4v a = {0.f, 0.f, 0.f, 0.f}, b = {0.f, 0.f, 0.f, 0.f};
    if (s0) a = __builtin_nontemporal_load((const f32x4v*)s0);
    if (s1) b = __builtin_nontemporal_load((const f32x4v*)s1);
    u32x4 o; o.x = cvtpk(a[0], a[1]); o.y = cvtpk(a[2], a[3]); o.z = cvtpk(b[0], b[1]); o.w = cvtpk(b[2], b[3]);
    *(u32x4*)dst = o;
}
DEV void ph_convert_dense(const P& p, int l, int which) {
    const int TIDX = otid(), BIDX = obid();
    size_t woff = 0; asm volatile("" : "+s"(woff)); unsigned char* w = p.ws + woff;
    const size_t gtid = (size_t)BIDX * 256 + TIDX, gsz = (size_t)gridDim.x * 256;
    if (which == 0) {
        bf16_t* win = (bf16_t*)(w + WS_WIN);
        for (size_t i = gtid; i < (size_t)D * 368; i += gsz) {
            const int g8 = (int)(i % 368); const size_t lk = (size_t)l * D + i / 368;
            const int n = g8 * 8;
            const float* row = p.w_in + lk * DIN;
            const float *s0, *s1;
            if (n < 2816) { const int oc = n + (n >= 2048 ? 28 : (n >= 1280 ? 24 : 0)); s0 = row + oc; s1 = row + oc + 4; }
            else if (n < 2840) { s0 = row + 1280 + (n - 2816); s1 = s0 + 4; }
            else if (n == 2840) { s0 = row + 2072; s1 = nullptr; }
            else { s0 = nullptr; s1 = nullptr; }
            conv8(s0, s1, win + lk * NPW + n);
        }
    } else {
        bf16_t* wot = (bf16_t*)(w + WS_WOT);
        const size_t oo = (size_t)l * D * D;
        for (size_t i = gtid; i < (size_t)D * D / 8; i += gsz) conv8(p.w_out + oo + i * 8, p.w_out + oo + i * 8 + 4, wot + oo + i * 8);
        for (size_t i = gtid; i < (size_t)2 * 2048 * 128 / 8; i += gsz) {
            const size_t per = (size_t)2048 * 128 / 8; const int kv = (int)(i / per), lk = l * 2 + kv; const size_t off = (i % per) * 8;
            const float* src = (kv ? p.cmp_w1_v : p.cmp_w1_k) + (size_t)l * 2048 * 128 + off;
            conv8(src, src + 4, (bf16_t*)(w + WS_CW1) + (size_t)lk * 2048 * 128 + off);
        }
    }
}
DEV void ph_convert_experts(const P& p, int l) {
    const int TIDX = otid(), BIDX = obid();
    size_t woff = 0; asm volatile("" : "+s"(woff)); unsigned char* w = p.ws + woff;
    bf16_t* w13 = (bf16_t*)(w + WS_W13); bf16_t* w2t = (bf16_t*)(w + WS_W2);
    const size_t gtid = (size_t)BIDX * 256 + TIDX, gsz = (size_t)gridDim.x * 256;
    for (size_t i = gtid; i < (size_t)32 * D * 128; i += gsz) {
        const int g8 = (int)(i & 127); const size_t lek = (size_t)l * 32 * D + (i >> 7);
        const int n = g8 * 8, which = (n >> 5) & 1, c = 32 * (n >> 6) + (n & 31);
        const float* src = (which ? p.e_w3 : p.e_w1) + lek * 512 + c;
        conv8(src, src + 4, w13 + lek * 1024 + n);
    }
    const size_t o2 = (size_t)l * 32 * 512 * D;
    for (size_t i = gtid; i < (size_t)32 * 512 * D / 8; i += gsz) conv8(p.e_w2 + o2 + i * 8, p.e_w2 + o2 + i * 8 + 4, w2t + o2 + i * 8);
}
DEV void ph_convert(const P& p, float* lds) {
    const int TIDX = otid(), BIDX = obid();
    size_t woff = 0; asm volatile("" : "+s"(woff)); unsigned char* w = p.ws + woff;
    const int lane = TIDX & 63;
    for (int unit = BIDX * 4 + (TIDX >> 6); unit < DEPTH * 2 * 4; unit += gridDim.x * 4) {
        const int lk = unit >> 2, t = unit & 3, l = lk >> 1, kv = lk & 1;
        conv_patch((kv ? p.cmp_w2_v : p.cmp_w2_k) + (size_t)l * 128 * 64, 64, 128, (bf16_t*)(w + WS_CW2) + (size_t)lk * 64 * 128, (t >> 1) * 64, (t & 1) * 32, [](int n) { return n; }, lane);
    }
    for (int o = BIDX * 256 + TIDX; o < DEPTH * 64 * D; o += gridDim.x * 256) {
        const int k = o & (D - 1), n = (o >> 10) & 63, l = o >> 16;
        const float val = n < 4 ? p.rg_w[((size_t)l * D + k) * 4 + n] : (n < 36 ? p.re_w[((size_t)l * D + k) * 32 + n - 4] : 0.f);
        const bf16_t hi = f2bf(val); const bf16_t lo = f2bf(val - bf2f(hi));
        bf16_t* wr = (bf16_t*)(w + WS_WR) + (size_t)l * 2 * 64 * D;
        wr[n * D + k] = hi; wr[64 * D + n * D + k] = lo;
    }
    int pu = (int)gridDim.x - 1 - BIDX - 64; if (pu < 0) pu += gridDim.x;
    for (int unit = pu; unit < DEPTH * 2 * 8; unit += gridDim.x) {
        const int lk = unit >> 3, ch = unit & 7, l = lk >> 1, kv = lk & 1, j = TIDX & 127, hf = TIDX >> 7;
        const float* pe = (kv ? p.cmp_pos_v : p.cmp_pos_k) + (size_t)l * 2048 + ch * 256 + hf * 128;
        const float* w1 = (kv ? p.cmp_w1_v : p.cmp_w1_k) + (size_t)l * 2048 * 128 + (size_t)(ch * 256 + hf * 128) * 128 + j;
        float a0 = 0.f, a1 = 0.f, a2 = 0.f, a3 = 0.f;
#pragma unroll 1
        for (int k0 = 0; k0 < 128; k0 += 32) {
            float wv[32];
#pragma unroll
            for (int k = 0; k < 32; ++k) wv[k] = w1[(size_t)(k0 + k) * 128];
#pragma unroll
            for (int k = 0; k < 32; k += 4) {
                a0 += pe[k0 + k] * wv[k]; a1 += pe[k0 + k + 1] * wv[k + 1];
                a2 += pe[k0 + k + 2] * wv[k + 2]; a3 += pe[k0 + k + 3] * wv[k + 3];
            }
        }
        const float a = (a0 + a1) + (a2 + a3);
        __syncthreads();
        if (hf) lds[j] = a;
        __syncthreads();
        if (!hf) ((float*)(w + WS_CPB))[(lk * 8 + ch) * 128 + j] = a + lds[j];
    }
}

typedef short v4i16_t __attribute__((ext_vector_type(4)));
DEV void gemm_issue0(unsigned char* lds, const bf16_t* const (&arow)[4], const bf16_t* Bsrc, const size_t ldb, const int TIDX) {
    const int lane = TIDX & 63, wave = TIDX >> 6;
    const int gsw = ((TIDX & 7) ^ ((TIDX >> 4) & 7)) * 8;
    const bf16_t* bg = Bsrc + (size_t)(4 * wave + (lane >> 4)) * ldb + ((lane & 15) ^ (((lane >> 4) << 2) | (wave & 3))) * 8;
    LAS unsigned char* l3 = (LAS unsigned char*)lds + __builtin_amdgcn_readfirstlane(wave) * 1024;
#pragma unroll
    for (int i = 0; i < 4; ++i) {
        __builtin_amdgcn_global_load_lds((const unsigned*)(arow[i] + gsw), (LAS unsigned*)(l3 + i * 4096), 16, 0, 0);
        __builtin_amdgcn_global_load_lds((const unsigned*)(bg + (size_t)(16 * i) * ldb), (LAS unsigned*)(l3 + 16384 + i * 4096), 16, 0, 0);
    }
}
template <bool SWAP, bool PRE = false>
DEV void gemm128(unsigned char* lds, const bf16_t* const (&arow)[4], const bf16_t* Bsrc, const size_t ldb, int K, f32x16 (&acc)[2][2], const int TIDX, const int astride = 64) {
    const int lane = TIDX & 63, wave = TIDX >> 6, wm = wave >> 1, wn = wave & 1, r = lane & 31, h = lane >> 5;
#pragma unroll
    for (int j = 0; j < 2; ++j)
#pragma unroll
        for (int i = 0; i < 2; ++i)
#pragma unroll
            for (int q = 0; q < 16; ++q) acc[j][i][q] = 0.f;
    const int gsw = ((TIDX & 7) ^ ((TIDX >> 4) & 7)) * 8;
    const bf16_t* ag[4];
#pragma unroll
    for (int i = 0; i < 4; ++i) ag[i] = arow[i] + gsw;
    const int brow = 4 * wave + (lane >> 4), bch = ((lane & 15) ^ (((lane >> 4) << 2) | (wave & 3))) * 8;
    const bf16_t* bg = Bsrc + (size_t)brow * ldb + bch;
    LAS unsigned char* l3 = (LAS unsigned char*)lds + __builtin_amdgcn_readfirstlane(wave) * 1024;
    LAS unsigned char* tb[2][2];
    {
        const int blk = (lane >> 4) & 1, q = (lane & 15) >> 2, pp = lane & 3;
#pragma unroll
        for (int j = 0; j < 2; ++j)
#pragma unroll
            for (int t = 0; t < 2; ++t) {
                const int row = 4 * t + 8 * h + q, ch = 4 * (2 * wn + j) + 2 * blk + (pp >> 1);
                tb[j][t] = (LAS unsigned char*)lds + 16384 + 256 * row + 16 * (ch ^ (((row & 3) << 2) | ((row >> 2) & 3))) + 8 * (pp & 1);
            }
    }
#define G_DMA(st_, kt_) do { _Pragma("unroll") for (int i = 0; i < 4; ++i) { \
        __builtin_amdgcn_global_load_lds((const unsigned*)(ag[i] + (size_t)(kt_) * astride), (LAS unsigned*)(l3 + (st_) + i * 4096), 16, 0, 0); \
        __builtin_amdgcn_global_load_lds((const unsigned*)(bg + ((size_t)(kt_) * 64 + 16 * i) * ldb), (LAS unsigned*)(l3 + (st_) + 16384 + i * 4096), 16, 0, 0); } } while (0)
    const int KT = K >> 6;
    if (!PRE) {
        __syncthreads();
        G_DMA(0, 0);
    }
    for (int kt = 0; kt < KT; ++kt) {
        asm volatile("s_waitcnt vmcnt(0) lgkmcnt(0)" ::: "memory");
        __builtin_amdgcn_s_barrier();
        asm volatile("" ::: "memory");
        if (kt + 1 < KT) G_DMA(((kt + 1) & 1) * 32768, kt + 1);
        const int so = (kt & 1) * 32768;
        const unsigned char* cur = lds + so;
#pragma unroll
        for (int kk = 0; kk < 4; ++kk) {
            bf16x8 af[2], wf[2];
#pragma unroll
            for (int i = 0; i < 2; ++i) af[i] = *(const bf16x8*)(cur + tile_off(64 * wm + 32 * i + r, 2 * kk + h));
#pragma unroll
            for (int j = 0; j < 2; ++j) {
                const v4i16_t lo = __builtin_amdgcn_ds_read_tr16_b64_v4i16((LAS v4i16_t*)(tb[j][0] + so + 4096 * kk));
                const v4i16_t hi = __builtin_amdgcn_ds_read_tr16_b64_v4i16((LAS v4i16_t*)(tb[j][1] + so + 4096 * kk));
                wf[j] = (bf16x8){lo[0], lo[1], lo[2], lo[3], hi[0], hi[1], hi[2], hi[3]};
            }
#pragma unroll
            for (int j = 0; j < 2; ++j)
#pragma unroll
                for (int i = 0; i < 2; ++i) acc[j][i] = SWAP ? __builtin_amdgcn_mfma_f32_32x32x16_bf16(af[i], wf[j], acc[j][i], 0, 0, 0)
                                                             : __builtin_amdgcn_mfma_f32_32x32x16_bf16(wf[j], af[i], acc[j][i], 0, 0, 0);
        }
    }
    __syncthreads();
#undef G_DMA
}

constexpr int CST = 272;
DEV void ctile_put(unsigned char* lds, int row, int col, float a, float b, float c, float d) {
    uint2 u; u.x = cvtpk(a, b); u.y = cvtpk(c, d);
    *(uint2*)(lds + row * CST + col * 2) = u;
}
template <int COLS, class RP>
DEV void ctile_flush(unsigned char* lds, const int TIDX, RP rowptr) {
    asm volatile("s_waitcnt lgkmcnt(0)" ::: "memory");
    __builtin_amdgcn_s_barrier();
    asm volatile("" ::: "memory");
    constexpr int CPR = COLS / 8, RPI = 256 / CPR;
#pragma unroll
    for (int it = 0; it < 128 / RPI; ++it) {
        const int row = it * RPI + TIDX / CPR, c16 = TIDX % CPR;
        bf16_t* dst = rowptr(row, it);
        const u32x4 val = *(const u32x4*)(lds + row * CST + c16 * 16);
        if (dst) *(u32x4*)(dst + c16 * 8) = val;
    }
}

DEV void ph_inproj_fast(const P& p, int l, unsigned char* lds) {
    const V v = make_views(p); const int TIDX = otid(), BIDX = obid();
    const bf16_t* W = (const bf16_t*)(p.ws + WS_WIN) + (size_t)l * D * NPW;
    const int lane = TIDX & 63, wave = TIDX >> 6, wm = wave >> 1, wn = wave & 1, r = lane & 31, h = lane >> 5;
    const bool xo = gridDim.x == 512;
    unsigned char* ct = lds + 32768;
    auto decode = [&](int it, int& mt, int& nt) -> int {
        if (xo) { if (it >= 6) return -1; const int lb = BIDX >> 3; nt = 8 * (it % 3) + (lb >> 3); mt = 16 * (BIDX & 7) + 8 * (it / 3) + (lb & 7); return nt < 23 ? 1 : 0; }
        const int unit = BIDX + it * (int)gridDim.x; if (unit >= 128 * 23) return -1; nt = unit / 128; mt = unit % 128; return 1;
    };
    auto issue = [&](int mt, int nt) {
        const bf16_t* ar[4];
#pragma unroll
        for (int i = 0; i < 4; ++i) ar[i] = v.H + (size_t)(mt * 128 + (TIDX >> 3) + 32 * i) * D;
        gemm_issue0(lds, ar, W + nt * 128, NPW, TIDX);
    };
    bool pre = false;
    for (int it = 0;; ++it) {
        int nt, mt;
        const int dv = decode(it, mt, nt);
        if (dv < 0) break;
        if (dv == 0) continue;
        const int m0 = mt * 128, n0 = nt * 128;
        const bf16_t* arow[4];
#pragma unroll
        for (int i = 0; i < 4; ++i) arow[i] = v.H + (size_t)(m0 + (TIDX >> 3) + 32 * i) * D;
        if (!pre) { __syncthreads(); issue(mt, nt); pre = true; }
        int itn = it + 1, mtn = 0, ntn = 0, dn;
        while ((dn = decode(itn, mtn, ntn)) == 0) ++itn;
        f32x16 acc[2][2];
        if (is_vcol(n0)) {
            gemm128<true, true>(lds, arow, W + n0, NPW, D, acc, TIDX);
            if (dn > 0) issue(mtn, ntn); else pre = false;
#pragma unroll
            for (int j = 0; j < 2; ++j)
#pragma unroll
                for (int i = 0; i < 2; ++i)
#pragma unroll
                    for (int g = 0; g < 4; ++g)
                        ctile_put(ct, 64 * wn + 32 * j + r, 64 * wm + 32 * i + 8 * g + 4 * h, acc[j][i][4 * g], acc[j][i][4 * g + 1], acc[j][i][4 * g + 2], acc[j][i][4 * g + 3]);
            bf16_t* vt = (bf16_t*)(p.ws + WS_VT) + ((size_t)(m0 >> 11) * 768 + vt_row(n0)) * S + (m0 & (S - 1));
            ctile_flush<128>(ct, TIDX, [&](int row, int) { return vt + (size_t)row * S; });
            continue;
        }
        const bool rope_tile = n0 < 512 || n0 == C_KS || n0 == C_KW;
        f32x4v rcs[2], rsn[2];
        if (rope_tile) {
#pragma unroll
            for (int i = 0; i < 2; ++i) {
                const int sp = (m0 + 64 * wm + 32 * i + r) & (S - 1);
                rcs[i] = *(const f32x4v*)(v.rcos + sp * 8 + 4 * h); rsn[i] = *(const f32x4v*)(v.rsin + sp * 8 + 4 * h);
            }
        }
        gemm128<false, true>(lds, arow, W + n0, NPW, D, acc, TIDX);
        if (dn > 0) issue(mtn, ntn); else pre = false;
        if (n0 == 2816) {
            if (wn == 0) {
#pragma unroll
                for (int i = 0; i < 2; ++i) {
                    const int m = m0 + 64 * wm + 32 * i + r;
#pragma unroll
                    for (int q = 0; q < 16; ++q) {
                        const int cc = (q & 3) + 8 * (q >> 2) + 4 * h;
                        if (cc < 24) v.gf[(size_t)m * 32 + cc] = acc[0][i][q];
                        else if (cc < 28) ((float*)(p.ws + WS_LSF))[(size_t)((m >> 11) * 4 + cc - 24) * S + (m & (S - 1))] = logsigmoidf_(acc[0][i][q] + p.b_forget[l * 4 + cc - 24]);
                    }
                }
            }
            continue;
        }
        if (n0 == C_KB || n0 == C_KB + 128) {
            float mx = 0.f;
#pragma unroll
            for (int i = 0; i < 2; ++i) {
                float s2 = 0.f;
#pragma unroll
                for (int j = 0; j < 2; ++j)
#pragma unroll
                    for (int q = 0; q < 16; ++q) s2 += acc[j][i][q] * acc[j][i][q];
                s2 += __shfl_xor(s2, 32);
                mx = fmaxf(mx, s2);
            }
#pragma unroll
            for (int o = 1; o < 32; o <<= 1) mx = fmaxf(mx, __shfl_xor(mx, o));
            if (lane == 0) atomicMax(v.ctl + CW_KN + (l * 8 + (m0 >> 11)) * 4 + ((n0 - C_KB) >> 6) + wn, __float_as_uint(mx));
        }
#pragma unroll
        for (int j = 0; j < 2; ++j) {
            const int nb = n0 + 64 * wn + 32 * j;
            const bool rope = ((nb & 63) == 0) && (nb < 512 || (nb >= C_KS && nb < C_VS) || (nb >= C_KW && nb < C_VW));
#pragma unroll
            for (int i = 0; i < 2; ++i) {
                f32x16 a = acc[j][i];
                if (rope) {
#pragma unroll
                    for (int q = 0; q < 4; ++q) { const float x1 = a[q], x2 = a[q + 4]; a[q] = x1 * rcs[i][q] - x2 * rsn[i][q]; a[q + 4] = x2 * rcs[i][q] + x1 * rsn[i][q]; }
                }
#pragma unroll
                for (int g = 0; g < 4; ++g) ctile_put(ct, 64 * wm + 32 * i + r, 64 * wn + 32 * j + 8 * g + 4 * h, a[4 * g], a[4 * g + 1], a[4 * g + 2], a[4 * g + 3]);
            }
        }
        bf16_t* ub = v.U + (size_t)m0 * NP + n0;
        ctile_flush<128>(ct, TIDX, [&](int row, int) { return ub + (size_t)row * NP; });
    }
}

DEV void ph_outproj_fast(const P& p, int l, unsigned char* lds) {
    const V v = make_views(p); const int TIDX = otid(), BIDX = obid();
    const bf16_t* W = (const bf16_t*)(p.ws + WS_WOT) + (size_t)l * D * D;
    const int lane = TIDX & 63, wave = TIDX >> 6, wm = wave >> 1, wn = wave & 1, r = lane & 31, h = lane >> 5;
    const bool xo = gridDim.x == 512;
    unsigned char* ct = lds + 32768;
    auto decode = [&](int it, int& mt, int& nt) -> bool {
        if (xo) { if (it >= 2) return false; const int lb = BIDX >> 3; nt = lb >> 3; mt = 16 * (BIDX & 7) + 8 * it + (lb & 7); return true; }
        const int unit = BIDX + it * (int)gridDim.x; if (unit >= 128 * 8) return false; nt = unit / 128; mt = unit % 128; return true;
    };
    auto issue = [&](int mt, int nt) {
        const bf16_t* ar[4];
#pragma unroll
        for (int i = 0; i < 4; ++i) ar[i] = v.O + (size_t)(mt * 128 + (TIDX >> 3) + 32 * i) * D;
        gemm_issue0(lds, ar, W + nt * 128, D, TIDX);
    };
    for (int it = 0;; ++it) {
        int nt, mt, ntn = 0, mtn = 0;
        if (!decode(it, mt, nt)) break;
        const bool hasn = decode(it + 1, mtn, ntn);
        const int m0 = mt * 128, n0 = nt * 128;
        const bf16_t* arow[4];
#pragma unroll
        for (int i = 0; i < 4; ++i) arow[i] = v.O + (size_t)(m0 + (TIDX >> 3) + 32 * i) * D;
        if (it == 0) { __syncthreads(); issue(mt, nt); }
        u32x4 xin[8];
#pragma unroll
        for (int it = 0; it < 8; ++it) xin[it] = *(const u32x4*)(v.XB + (size_t)(m0 + it * 16 + (TIDX >> 4)) * D + n0 + (TIDX & 15) * 8);
        f32x16 acc[2][2];
        gemm128<false, true>(lds, arow, W + n0, D, D, acc, TIDX);
        if (hasn) issue(mtn, ntn);
        const float* g1 = v.mod + (size_t)(l * 8 + (m0 >> 11)) * 6144 + 2 * D;
#pragma unroll
        for (int j = 0; j < 2; ++j)
#pragma unroll
            for (int i = 0; i < 2; ++i) {
                const int nb = n0 + 64 * wn + 32 * j + 4 * h;
#pragma unroll
                for (int g = 0; g < 4; ++g) {
                    const float4 gg = *(const float4*)(g1 + nb + 8 * g);
                    ctile_put(ct, 64 * wm + 32 * i + r, 64 * wn + 32 * j + 8 * g + 4 * h, gg.x * acc[j][i][4 * g], gg.y * acc[j][i][4 * g + 1], gg.z * acc[j][i][4 * g + 2], gg.w * acc[j][i][4 * g + 3]);
                }
            }
        asm volatile("s_waitcnt lgkmcnt(0)" ::: "memory");
        __builtin_amdgcn_s_barrier();
        asm volatile("" ::: "memory");
#pragma unroll
        for (int it = 0; it < 8; ++it) {
            const int row = it * 16 + (TIDX >> 4);
            const u32x4 uv = *(const u32x4*)(ct + row * CST + (TIDX & 15) * 16);
            u32x4 xn;
#pragma unroll
            for (int q = 0; q < 4; ++q)
                xn[q] = cvtpk(__uint_as_float(xin[it][q] << 16) + __uint_as_float(uv[q] << 16), __uint_as_float(xin[it][q] & 0xffff0000u) + __uint_as_float(uv[q] & 0xffff0000u));
            *(u32x4*)(v.XB + (size_t)(m0 + row) * D + n0 + (TIDX & 15) * 8) = xn;
        }
    }
}

DEV void ph_moe_up_fast(const P& p, int l, unsigned char* lds) {
    const V v = make_views(p); const int TIDX = otid(), BIDX = obid();
    const int lane = TIDX & 63, wave = TIDX >> 6, wm = wave >> 1, wn = wave & 1, r = lane & 31, h = lane >> 5;
    const unsigned* cnt = v.ctl + CW_CNT + l * 32;
    int* tp = (int*)(lds + 67584); int* rb = tp + 40;
    __syncthreads();
    if (TIDX < 64) {
        const int c = TIDX < 32 ? (int)cnt[TIDX] : 0;
        int nu = ((c + 127) >> 7) * 8, cc = c;
#pragma unroll
        for (int o = 1; o < 32; o <<= 1) { const int a = __shfl_up(nu, o), b2 = __shfl_up(cc, o); if ((TIDX & 31) >= o) { nu += a; cc += b2; } }
        if (TIDX < 32) { tp[TIDX + 1] = nu; rb[TIDX + 1] = cc; if (TIDX == 0) { tp[0] = 0; rb[0] = 0; } }
    }
    __syncthreads();
    const int total = tp[32];
    unsigned char* ct = lds + 32768;
    struct UU { int e, base, nt, mt, nrow; const int* lst; const bf16_t* B; const bf16_t* ar[4]; };
    auto setup = [&](int unit, UU& u) {
        int e = 0;
#pragma unroll
        for (int st = 16; st > 0; st >>= 1) if (tp[e + st] <= unit) e += st;
        const int rem = unit - tp[e];
        u.e = e; u.base = rb[e]; u.nt = rem & 7; u.mt = rem >> 3;
        const int ce = rb[e + 1] - u.base;
        u.lst = v.list + (size_t)e * T + u.mt * 128;
        u.nrow = ce - u.mt * 128 < 128 ? ce - u.mt * 128 : 128;
        u.B = (const bf16_t*)(p.ws + WS_W13) + ((size_t)l * 32 + e) * 1024 * D + u.nt * 128;
#pragma unroll
        for (int i = 0; i < 4; ++i) { const int rr = (TIDX >> 3) + 32 * i; u.ar[i] = v.H + (size_t)(u.lst[rr < u.nrow ? rr : 0] >> 1) * D; }
    };
    int unit = BIDX;
    if (unit >= total) return;
    UU cu, nu;
    setup(unit, cu);
    __syncthreads();
    gemm_issue0(lds, cu.ar, cu.B, 1024, TIDX);
    for (;;) {
        const int un = unit + (int)gridDim.x;
        f32x16 acc[2][2];
        gemm128<false, true>(lds, cu.ar, cu.B, 1024, D, acc, TIDX);
        if (un < total) { setup(un, nu); gemm_issue0(lds, nu.ar, nu.B, 1024, TIDX); }
#pragma unroll
        for (int i = 0; i < 2; ++i)
#pragma unroll
            for (int g = 0; g < 4; ++g) {
                float o[4];
#pragma unroll
                for (int q = 0; q < 4; ++q) { const float a1 = acc[0][i][4 * g + q], a3 = acc[1][i][4 * g + q]; o[q] = a1 / (1.f + __expf(-a1)) * a3; }
                ctile_put(ct, 64 * wm + 32 * i + r, 32 * wn + 8 * g + 4 * h, o[0], o[1], o[2], o[3]);
            }
        bf16_t* hb = v.HID + (size_t)(cu.base + cu.mt * 128) * 512 + 64 * cu.nt;
        const int nrow = cu.nrow;
        ctile_flush<64>(ct, TIDX, [&](int row, int) { return row < nrow ? hb + (size_t)row * 512 : (bf16_t*)nullptr; });
        if (un >= total) break;
        unit = un; cu = nu;
    }
}
DEV void ph_moe_down_fast(const P& p, int l, unsigned char* lds) {
    const V v = make_views(p); const int TIDX = otid(), BIDX = obid();
    const int lane = TIDX & 63, wave = TIDX >> 6, wm = wave >> 1, wn = wave & 1, r = lane & 31, h = lane >> 5;
    const unsigned* cnt = v.ctl + CW_CNT + l * 32;
    int* tp = (int*)(lds + 67584); int* rb = tp + 40;
    __syncthreads();
    if (TIDX < 64) {
        const int c = TIDX < 32 ? (int)cnt[TIDX] : 0;
        int nu = ((c + 127) >> 7) * 8, cc = c;
#pragma unroll
        for (int o = 1; o < 32; o <<= 1) { const int a = __shfl_up(nu, o), b2 = __shfl_up(cc, o); if ((TIDX & 31) >= o) { nu += a; cc += b2; } }
        if (TIDX < 32) { tp[TIDX + 1] = nu; rb[TIDX + 1] = cc; if (TIDX == 0) { tp[0] = 0; rb[0] = 0; } }
    }
    __syncthreads();
    const int total = tp[32];
    unsigned char* ct = lds + 32768;
    struct UD { int n0, nrow; const bf16_t* B; const bf16_t* ar[4]; float wrow[2]; int fslot[8]; };
    auto setup = [&](int unit, UD& u) {
        int e = 0;
#pragma unroll
        for (int st = 16; st > 0; st >>= 1) if (tp[e + st] <= unit) e += st;
        const int rem = unit - tp[e], base = rb[e];
        const int ce = rb[e + 1] - base, nt = rem & 7, mt = rem >> 3;
        const int* lst = v.list + (size_t)e * T + mt * 128;
        u.n0 = nt * 128;
        u.nrow = ce - mt * 128 < 128 ? ce - mt * 128 : 128;
        u.B = (const bf16_t*)(p.ws + WS_W2) + ((size_t)l * 32 + e) * 512 * D + u.n0;
#pragma unroll
        for (int i = 0; i < 4; ++i) { const int rr = (TIDX >> 3) + 32 * i; u.ar[i] = v.HID + (size_t)(base + mt * 128 + (rr < u.nrow ? rr : 0)) * 512; }
#pragma unroll
        for (int i = 0; i < 2; ++i) { const int mr = 64 * wm + 32 * i + r; u.wrow[i] = mr < u.nrow ? v.wts[lst[mr]] : 0.f; }
#pragma unroll
        for (int it = 0; it < 8; ++it) { const int row = it * 16 + (TIDX >> 4); u.fslot[it] = row < u.nrow ? lst[row] : -1; }
    };
    int unit = BIDX;
    if (unit >= total) return;
    UD cu, nu;
    setup(unit, cu);
    __syncthreads();
    gemm_issue0(lds, cu.ar, cu.B, D, TIDX);
    for (;;) {
        const int un = unit + (int)gridDim.x;
        f32x16 acc[2][2];
        gemm128<false, true>(lds, cu.ar, cu.B, D, 512, acc, TIDX);
        if (un < total) { setup(un, nu); gemm_issue0(lds, nu.ar, nu.B, D, TIDX); }
#pragma unroll
        for (int i = 0; i < 2; ++i) {
            const int mr = 64 * wm + 32 * i + r;
            const float w = cu.wrow[i];
#pragma unroll
            for (int j = 0; j < 2; ++j)
#pragma unroll
                for (int g = 0; g < 4; ++g)
                    ctile_put(ct, mr, 64 * wn + 32 * j + 8 * g + 4 * h, w * acc[j][i][4 * g], w * acc[j][i][4 * g + 1], w * acc[j][i][4 * g + 2], w * acc[j][i][4 * g + 3]);
        }
        const int n0 = cu.n0;
        ctile_flush<128>(ct, TIDX, [&](int, int it) { const int sl = cu.fslot[it]; return sl >= 0 ? v.Y + (size_t)sl * D + n0 : (bf16_t*)nullptr; });
        if (un >= total) break;
        unit = un; cu = nu;
    }
}

constexpr float SB_EPS = 1e-12f;
constexpr float LOG2E = 1.4426950408889634f, C2 = 0.125f * 1.4426950408889634f, LN2 = 0.6931471805599453f;
DEV float fexp2(float x) { return __builtin_amdgcn_exp2f(x); }
DEV float flog2(float x) { return __builtin_amdgcn_logf(x); }
DEV int swap23(int r) { return (r & ~12) | ((r & 4) << 1) | ((r & 8) >> 1); }

struct KVT { const bf16_t* k; int ks; const bf16_t* v; int vs; };
DEV void kv_load(const KVT& s, int kv0, const int TIDX, u32x4 (&rg)[4]) {
    const int c = TIDX & 7, r0 = TIDX >> 3;
    rg[0] = *(const u32x4*)(s.k + (size_t)(kv0 + r0) * s.ks + c * 8);
    rg[1] = *(const u32x4*)(s.k + (size_t)(kv0 + r0 + 32) * s.ks + c * 8);
    rg[2] = *(const u32x4*)(s.v + (size_t)r0 * s.vs + kv0 + c * 8);
    rg[3] = *(const u32x4*)(s.v + (size_t)(r0 + 32) * s.vs + kv0 + c * 8);
}
DEV void kv_store(unsigned char* st, const int TIDX, const u32x4 (&rg)[4]) {
    const int c = TIDX & 7, r0 = TIDX >> 3;
    *(u32x4*)(st + tile_off(r0, c)) = rg[0]; *(u32x4*)(st + tile_off(r0 + 32, c)) = rg[1];
    *(u32x4*)(st + 8192 + tile_off(r0, c)) = rg[2]; *(u32x4*)(st + 8192 + tile_off(r0 + 32, c)) = rg[3];
}
DEV bf16x8 scale_frag(bf16x8 v, float sc) {
    u32x4 u = __builtin_bit_cast(u32x4, v);
#pragma unroll
    for (int i = 0; i < 4; ++i) u[i] = cvtpk(__uint_as_float(u[i] << 16) * sc, __uint_as_float(u[i] & 0xffff0000u) * sc);
    return __builtin_bit_cast(bf16x8, u);
}
DEV float xhalf(float x) {
    const auto s = __builtin_amdgcn_permlane32_swap(__float_as_uint(x), __float_as_uint(x), false, false);
    return __uint_as_float((threadIdx.x & 32) ? s[0] : s[1]);
}
DEV float xhalf_max(float x) {
    const auto s = __builtin_amdgcn_permlane32_swap(__float_as_uint(x), __float_as_uint(x), false, false);
    return fmaxf(__uint_as_float(s[0]), __uint_as_float(s[1]));
}
DEV float xhalf_sum(float x) {
    const auto s = __builtin_amdgcn_permlane32_swap(__float_as_uint(x), __float_as_uint(x), false, false);
    return __uint_as_float(s[0]) + __uint_as_float(s[1]);
}
#define SB0() __builtin_amdgcn_sched_barrier(0)
DEV void score_tile(const unsigned char* Kt, const bf16x8 (&qf)[4], int r, int h, f32x16 (&p)[2]) {
    const int kr = swap23(r);
    const unsigned char* kb = Kt + tile_off(kr, h);
    auto ld = [&](int i) { const int blk = i & 1, s = i >> 1; return *(const bf16x8*)(Kt + tile_off(32 * blk + kr, 2 * s + h)); };
    (void)kb;
    f32x16 z;
#pragma unroll
    for (int q = 0; q < 16; ++q) z[q] = 0.f;
    bf16x8 f0 = ld(0), f1 = ld(1), f2 = ld(2), f3 = ld(3);
    SB0();
    p[0] = __builtin_amdgcn_mfma_f32_32x32x16_bf16(f0, qf[0], z, 0, 0, 0); f0 = ld(4); SB0();
    p[1] = __builtin_amdgcn_mfma_f32_32x32x16_bf16(f1, qf[0], z, 0, 0, 0); f1 = ld(5); SB0();
    p[0] = __builtin_amdgcn_mfma_f32_32x32x16_bf16(f2, qf[1], p[0], 0, 0, 0); f2 = ld(6); SB0();
    p[1] = __builtin_amdgcn_mfma_f32_32x32x16_bf16(f3, qf[1], p[1], 0, 0, 0); f3 = ld(7); SB0();
    p[0] = __builtin_amdgcn_mfma_f32_32x32x16_bf16(f0, qf[2], p[0], 0, 0, 0); SB0();
    p[1] = __builtin_amdgcn_mfma_f32_32x32x16_bf16(f1, qf[2], p[1], 0, 0, 0); SB0();
    p[0] = __builtin_amdgcn_mfma_f32_32x32x16_bf16(f2, qf[3], p[0], 0, 0, 0); SB0();
    p[1] = __builtin_amdgcn_mfma_f32_32x32x16_bf16(f3, qf[3], p[1], 0, 0, 0); SB0();
}
DEV void pv_tile(const unsigned char* Vt, const f32x16 (&p)[2], int r, int h, f32x16 (&o)[2]) {
    auto ld = [&](int i) { const int db = i & 1, pr = i >> 1; return *(const bf16x8*)(Vt + tile_off(32 * db + r, 2 * pr + h)); };
    auto pk = [&](int pr) {
        const int blk = pr >> 1, s = pr & 1;
        u32x4 w;
        w.x = cvtpk(p[blk][8 * s], p[blk][8 * s + 1]); w.y = cvtpk(p[blk][8 * s + 2], p[blk][8 * s + 3]);
        w.z = cvtpk(p[blk][8 * s + 4], p[blk][8 * s + 5]); w.w = cvtpk(p[blk][8 * s + 6], p[blk][8 * s + 7]);
        return __builtin_bit_cast(bf16x8, w);
    };
    bf16x8 f0 = ld(0), f1 = ld(1), f2 = ld(2), f3 = ld(3);
    SB0();
    bf16x8 pb = pk(0);
    SB0();
    o[0] = __builtin_amdgcn_mfma_f32_32x32x16_bf16(f0, pb, o[0], 0, 0, 0); f0 = ld(4); SB0();
    o[1] = __builtin_amdgcn_mfma_f32_32x32x16_bf16(f1, pb, o[1], 0, 0, 0); f1 = ld(5); pb = pk(1); SB0();
    o[0] = __builtin_amdgcn_mfma_f32_32x32x16_bf16(f2, pb, o[0], 0, 0, 0); f2 = ld(6); SB0();
    o[1] = __builtin_amdgcn_mfma_f32_32x32x16_bf16(f3, pb, o[1], 0, 0, 0); f3 = ld(7); pb = pk(2); SB0();
    o[0] = __builtin_amdgcn_mfma_f32_32x32x16_bf16(f0, pb, o[0], 0, 0, 0); SB0();
    o[1] = __builtin_amdgcn_mfma_f32_32x32x16_bf16(f1, pb, o[1], 0, 0, 0); pb = pk(3); SB0();
    o[0] = __builtin_amdgcn_mfma_f32_32x32x16_bf16(f2, pb, o[0], 0, 0, 0); SB0();
    o[1] = __builtin_amdgcn_mfma_f32_32x32x16_bf16(f3, pb, o[1], 0, 0, 0); SB0();
}

DEV void score_tile_a(LAS unsigned char* const (&ka)[4], const bf16x8 (&qf)[4], f32x16 (&p)[2]) {
    auto ld = [&](int i) { const int blk = i & 1, s = i >> 1; return *(const LAS bf16x8*)(ka[s] + 4096 * blk); };
    f32x16 z;
#pragma unroll
    for (int q = 0; q < 16; ++q) z[q] = 0.f;
    bf16x8 f0 = ld(0), f1 = ld(1), f2 = ld(2), f3 = ld(3);
    SB0();
    p[0] = __builtin_amdgcn_mfma_f32_32x32x16_bf16(f0, qf[0], z, 0, 0, 0); f0 = ld(4); SB0();
    p[1] = __builtin_amdgcn_mfma_f32_32x32x16_bf16(f1, qf[0], z, 0, 0, 0); f1 = ld(5); SB0();
    p[0] = __builtin_amdgcn_mfma_f32_32x32x16_bf16(f2, qf[1], p[0], 0, 0, 0); f2 = ld(6); SB0();
    p[1] = __builtin_amdgcn_mfma_f32_32x32x16_bf16(f3, qf[1], p[1], 0, 0, 0); f3 = ld(7); SB0();
    p[0] = __builtin_amdgcn_mfma_f32_32x32x16_bf16(f0, qf[2], p[0], 0, 0, 0); SB0();
    p[1] = __builtin_amdgcn_mfma_f32_32x32x16_bf16(f1, qf[2], p[1], 0, 0, 0); SB0();
    p[0] = __builtin_amdgcn_mfma_f32_32x32x16_bf16(f2, qf[3], p[0], 0, 0, 0); SB0();
    p[1] = __builtin_amdgcn_mfma_f32_32x32x16_bf16(f3, qf[3], p[1], 0, 0, 0); SB0();
}
DEV void pv_tile_a(LAS unsigned char* const (&va)[4], const f32x16 (&p)[2], f32x16 (&o)[2]) {
    auto ld = [&](int i) { const int db = i & 1, pr = i >> 1; return *(const LAS bf16x8*)(va[pr] + 4096 * db); };
    auto pk = [&](int pr) {
        const int blk = pr >> 1, s = pr & 1;
        u32x4 w;
        w.x = cvtpk(p[blk][8 * s], p[blk][8 * s + 1]); w.y = cvtpk(p[blk][8 * s + 2], p[blk][8 * s + 3]);
        w.z = cvtpk(p[blk][8 * s + 4], p[blk][8 * s + 5]); w.w = cvtpk(p[blk][8 * s + 6], p[blk][8 * s + 7]);
        return __builtin_bit_cast(bf16x8, w);
    };
    bf16x8 f0 = ld(0), f1 = ld(1), f2 = ld(2), f3 = ld(3);
    SB0();
    bf16x8 pb = pk(0);
    SB0();
    o[0] = __builtin_amdgcn_mfma_f32_32x32x16_bf16(f0, pb, o[0], 0, 0, 0); f0 = ld(4); SB0();
    o[1] = __builtin_amdgcn_mfma_f32_32x32x16_bf16(f1, pb, o[1], 0, 0, 0); f1 = ld(5); pb = pk(1); SB0();
    o[0] = __builtin_amdgcn_mfma_f32_32x32x16_bf16(f2, pb, o[0], 0, 0, 0); f2 = ld(6); SB0();
    o[1] = __builtin_amdgcn_mfma_f32_32x32x16_bf16(f3, pb, o[1], 0, 0, 0); f3 = ld(7); pb = pk(2); SB0();
    o[0] = __builtin_amdgcn_mfma_f32_32x32x16_bf16(f0, pb, o[0], 0, 0, 0); SB0();
    o[1] = __builtin_amdgcn_mfma_f32_32x32x16_bf16(f1, pb, o[1], 0, 0, 0); pb = pk(3); SB0();
    o[0] = __builtin_amdgcn_mfma_f32_32x32x16_bf16(f2, pb, o[0], 0, 0, 0); SB0();
    o[1] = __builtin_amdgcn_mfma_f32_32x32x16_bf16(f3, pb, o[1], 0, 0, 0); SB0();
}

template <int VAR>
DEV void attn_branch(unsigned char* lds, const KVT& src, const bf16x8 (&qf)[4], unsigned tmask, int wave_last, int t, int t_first,
                     unsigned selbits, const float* bias2, f32x16 (&o)[2], const int TIDX, const float qkb = 0.f) {
    const int lane = TIDX & 63, r = lane & 31, h = lane >> 5;
    const float NEG_INF = -__builtin_inff();
    float mrun = -1e30f, lrun = 0.f, rest = VAR == 3 ? 1.f : 0.f;
#pragma unroll
    for (int db = 0; db < 2; ++db)
#pragma unroll
        for (int q = 0; q < 16; ++q) o[db][q] = 0.f;
    u32x4 rg[4];
    LAS unsigned char* ka[4]; LAS unsigned char* va[4];
    {
        const int kr = swap23(r);
#pragma unroll
        for (int s = 0; s < 4; ++s) { ka[s] = (LAS unsigned char*)lds + tile_off(kr, 2 * s + h); va[s] = (LAS unsigned char*)lds + 8192 + tile_off(r, 2 * s + h); }
    }
    unsigned rem = tmask;
    unsigned wdone = 0u; int step = 0;
    volatile unsigned* sbf = (volatile unsigned*)(lds + 65536);
    int j = VAR >= 2 ? 31 - __builtin_clz(rem) : __builtin_ctz(rem);
    rem &= ~(1u << j);
    kv_load(src, 64 * j, TIDX, rg);
    __syncthreads();
    kv_store(lds, TIDX, rg);
    __syncthreads();
    int stage = 0;
    for (;;) {
        int jn = -1;
        if (rem) { jn = VAR >= 2 ? 31 - __builtin_clz(rem) : __builtin_ctz(rem); rem &= ~(1u << jn); kv_load(src, 64 * jn, TIDX, rg); }
        asm volatile("" ::: "memory"); __builtin_amdgcn_sched_barrier(0);
        if (j <= wave_last) {
            const unsigned char* Kt = lds + stage * 16384;
            f32x16 p[2];
            score_tile_a(ka, qf, p);
            const int kvb = 64 * j + 8 * h;
            if (VAR == 3) {
                const bool diag = 64 * j + 63 >= t_first;
                float gt[2][2];
                if (diag) {
#pragma unroll
                    for (int blk = 0; blk < 2; ++blk)
#pragma unroll
                        for (int s = 0; s < 2; ++s) {
                            float run = 1.f;
#pragma unroll
                            for (int q = 7; q >= 0; --q) {
                                const float ez = fexp2(p[blk][8 * s + q]);
                                float w = __builtin_amdgcn_rcpf(1.f + ez);
                                float beta = 1.f - w;
                                const bool valid = kvb + 32 * blk + 16 * s + q < t;
                                w = valid ? w : 1.f; beta = valid ? beta : 0.f;
                                p[blk][8 * s + q] = beta * run;
                                run *= w;
                            }
                            gt[blk][s] = run;
                        }
                } else {
#pragma unroll
                    for (int blk = 0; blk < 2; ++blk)
#pragma unroll
                        for (int s = 0; s < 2; ++s) {
                            float run = 1.f;
#pragma unroll
                            for (int q = 7; q >= 0; --q) {
                                const float rn = run * __builtin_amdgcn_rcpf(1.f + fexp2(p[blk][8 * s + q]));
                                p[blk][8 * s + q] = run - rn;
                                run = rn;
                            }
                            gt[blk][s] = run;
                        }
                }
                float og[2][2], pt[2][2];
#pragma unroll
                for (int blk = 0; blk < 2; ++blk)
#pragma unroll
                    for (int s = 0; s < 2; ++s) { og[blk][s] = xhalf(gt[blk][s]); pt[blk][s] = gt[blk][s] * og[blk][s]; }
                float above = rest;
#pragma unroll
                for (int pi = 3; pi >= 0; --pi) {
                    const int blk = pi >> 1, s = pi & 1;
                    const float carry = above * (h == 0 ? og[blk][s] : 1.f);
#pragma unroll
                    for (int q = 0; q < 8; ++q) p[blk][8 * s + q] *= carry;
                    above *= pt[blk][s];
                }
                rest = above;
                wdone = __all(rest < SB_EPS) ? 1u : 0u;
            } else {
                const bool need_causal = 64 * j + 63 > t_first;
                const bool need_win = VAR == 1 && (64 * j + 512 <= t_first + 31);
                const bool lane_on = VAR != 0 || ((selbits >> j) & 1u);
                if (VAR == 2) {
#pragma unroll
                    for (int blk = 0; blk < 2; ++blk)
#pragma unroll
                        for (int s = 0; s < 2; ++s) {
                            const float4 b0 = *(const float4*)(bias2 + kvb + 32 * blk + 16 * s), b1 = *(const float4*)(bias2 + kvb + 32 * blk + 16 * s + 4);
                            p[blk][8 * s] += b0.x; p[blk][8 * s + 1] += b0.y; p[blk][8 * s + 2] += b0.z; p[blk][8 * s + 3] += b0.w;
                            p[blk][8 * s + 4] += b1.x; p[blk][8 * s + 5] += b1.y; p[blk][8 * s + 6] += b1.z; p[blk][8 * s + 7] += b1.w;
                        }
                }
                if (need_causal) {
#pragma unroll
                    for (int blk = 0; blk < 2; ++blk)
#pragma unroll
                        for (int q = 0; q < 16; ++q) { const int kv = kvb + 32 * blk + 16 * (q >> 3) + (q & 7); p[blk][q] = kv <= t ? p[blk][q] : NEG_INF; }
                }
                if (need_win) {
#pragma unroll
                    for (int blk = 0; blk < 2; ++blk)
#pragma unroll
                        for (int q = 0; q < 16; ++q) { const int kv = kvb + 32 * blk + 16 * (q >> 3) + (q & 7); p[blk][q] = kv + 512 > t ? p[blk][q] : NEG_INF; }
                }
                float tmax = p[0][0];
#pragma unroll
                for (int q = 1; q < 16; ++q) tmax = fmaxf(tmax, p[0][q]);
#pragma unroll
                for (int q = 0; q < 16; ++q) tmax = fmaxf(tmax, p[1][q]);
                tmax = lane_on ? tmax : NEG_INF;
                tmax = xhalf_max(tmax);
                const float mnew = fmaxf(mrun, tmax);
                const bool grew = mnew > mrun;
                const float alpha = fexp2(mrun - mnew);
                mrun = mnew;
                const float msub = lane_on ? mnew : __builtin_inff();
                const f32x2_t ms2 = {msub, msub};
                f32x2_t ls2 = {0.f, 0.f};
#pragma unroll
                for (int blk = 0; blk < 2; ++blk)
#pragma unroll
                    for (int q = 0; q < 16; q += 2) {
                        const f32x2_t d2 = (f32x2_t){p[blk][q], p[blk][q + 1]} - ms2;
                        f32x2_t e2; e2.x = fexp2(d2.x); e2.y = fexp2(d2.y);
                        p[blk][q] = e2.x; p[blk][q + 1] = e2.y; ls2 += e2;
                    }
                lrun = lrun * alpha + (ls2.x + ls2.y);
                if (VAR == 2) wdone = __all(qkb + bias2[j > 0 ? 64 * j - 1 : 0] <= mrun - 40.f) ? 1u : 0u;
                if (__any(grew)) {
#pragma unroll
                    for (int db = 0; db < 2; ++db)
#pragma unroll
                        for (int q = 0; q < 16; ++q) o[db][q] *= alpha;
                }
            }
            pv_tile_a(va, p, o);
        }
        if (jn >= 0) kv_store(lds + (stage ^ 1) * 16384, TIDX, rg);
        if (VAR >= 2 && lane == 0) sbf[(step & 1) * 4 + (TIDX >> 6)] = wdone;
        __syncthreads();
        if (jn < 0) break;
        if (VAR >= 2) {
            const unsigned* f4 = (const unsigned*)sbf + (step & 1) * 4;
            if ((f4[0] & f4[1] & f4[2] & f4[3]) != 0u) break;
            ++step;
        }
        {
            const int dlt = stage ? -16384 : 16384;
#pragma unroll
            for (int s = 0; s < 4; ++s) { ka[s] += dlt; va[s] += dlt; }
        }
        j = jn; stage ^= 1;
    }
    if (VAR != 3) {
        const float lt = xhalf_sum(lrun);
        const float inv = lt > 0.f ? 1.f / lt : 0.f;
#pragma unroll
        for (int db = 0; db < 2; ++db)
#pragma unroll
            for (int q = 0; q < 16; ++q) o[db][q] *= inv;
    }
}

DEV void head_norm_store(const f32x16 (&o)[2], const float* gam, bf16_t* dst, int h) {
    float ss = 0.f;
#pragma unroll
    for (int db = 0; db < 2; ++db)
#pragma unroll
        for (int q = 0; q < 16; ++q) ss += o[db][q] * o[db][q];
    ss += __shfl_xor(ss, 32);
    const float rinv = rsqrtf(ss * (1.f / 64.f) + EPS);
#pragma unroll
    for (int db = 0; db < 2; ++db)
#pragma unroll
        for (int g = 0; g < 4; ++g) {
            const int d = 32 * db + 8 * g + 4 * h;
            const float4 gg = *(const float4*)(gam + d);
            uint2 u;
            u.x = cvtpk(o[db][4 * g] * rinv * gg.x, o[db][4 * g + 1] * rinv * gg.y);
            u.y = cvtpk(o[db][4 * g + 2] * rinv * gg.z, o[db][4 * g + 3] * rinv * gg.w);
            *(uint2*)(dst + d) = u;
        }
}

template <int VAR>
DEV void mha_unit(const P& p, int l, int unit, unsigned char* lds) {
    const V v = make_views(p); const int TIDX = otid();
    const int lane = TIDX & 63, wave = TIDX >> 6, r = lane & 31, h = lane >> 5;
    const int qb = 15 - (unit >> 5), bh = unit & 31, b = bh >> 2, hh = bh & 3;
    const int t0 = qb * 128, tw = t0 + 32 * wave, t = tw + r, m = b * S + t;
    const int qcol = VAR == 2 ? C_QB : C_QC, kcol = VAR == 2 ? C_KB : C_KCC, vrow = VAR == 2 ? 256 : 512, ocol = VAR == 2 ? 512 : 768;
    bf16x8 qf[4];
#pragma unroll
    for (int s = 0; s < 4; ++s) qf[s] = scale_frag(*(const bf16x8*)(v.U + (size_t)m * NP + qcol + hh * 64 + 16 * s + 8 * h), C2);
    KVT src;
    src.k = v.U + (size_t)b * S * NP + kcol + hh * 64; src.ks = NP;
    src.v = (const bf16_t*)(p.ws + WS_VT) + (size_t)(b * 768 + vrow + hh * 64) * S; src.vs = S;
    const int last = (t0 + 127) >> 6;
    const unsigned tmask = last == 31 ? 0xffffffffu : ((1u << (last + 1)) - 1u);
    const float* bias2 = (const float*)(lds + 32768);
    if (VAR == 2) {
        float* cf = (float*)(lds + 32768);
        float* wt = (float*)(lds + 32768 + 8192);
        const float* lsf = (const float*)(p.ws + WS_LSF) + (size_t)(b * 4 + hh) * S;
        const int nel = t0 + 128;
        float x[8];
        if (8 * TIDX < nel) {
            const float4 a0 = *(const float4*)(lsf + 8 * TIDX), a1 = *(const float4*)(lsf + 8 * TIDX + 4);
            x[0] = a0.x; x[1] = x[0] + a0.y; x[2] = x[1] + a0.z; x[3] = x[2] + a0.w; x[4] = x[3] + a1.x; x[5] = x[4] + a1.y; x[6] = x[5] + a1.z; x[7] = x[6] + a1.w;
        } else {
#pragma unroll
            for (int q = 0; q < 8; ++q) x[q] = 0.f;
        }
        float inc = x[7];
#pragma unroll
        for (int o = 1; o < 64; o <<= 1) { const float tt = __shfl_up(inc, o); if (lane >= o) inc += tt; }
        __syncthreads();
        if (lane == 63) wt[wave] = inc;
        __syncthreads();
        float off = inc - x[7];
#pragma unroll
        for (int w = 0; w < 3; ++w) off += (w < wave) ? wt[w] : 0.f;
        if (8 * TIDX < nel) {
#pragma unroll
            for (int q = 0; q < 8; ++q) cf[8 * TIDX + q] = -(x[q] + off) * LOG2E;
        }
        __syncthreads();
    }
    f32x16 o[2];
    float qkb = 0.f;
    if (VAR == 2) {
        float qq = 0.f;
#pragma unroll
        for (int s = 0; s < 4; ++s) {
            const u32x4 u = __builtin_bit_cast(u32x4, qf[s]);
#pragma unroll
            for (int q = 0; q < 4; ++q) { const float lo = __uint_as_float(u[q] << 16), hi = __uint_as_float(u[q] & 0xffff0000u); qq += lo * lo + hi * hi; }
        }
        qq = xhalf_sum(qq);
        const float kn2 = __uint_as_float(__hip_atomic_load(v.ctl + CW_KN + (l * 8 + b) * 4 + hh, __ATOMIC_RELAXED, __HIP_MEMORY_SCOPE_AGENT));
        qkb = sqrtf(qq) * sqrtf(kn2) * 1.01f;
    }
    attn_branch<VAR>(lds, src, qf, tmask, (tw + 31) >> 6, t, tw, 0u, bias2, o, TIDX, qkb);
    head_norm_store(o, p.out_norm_g + (size_t)l * D + ocol + hh * 64, v.O + (size_t)m * D + ocol + hh * 64, h);
}

DEV void nsa_unit(const P& p, int l, int unit, unsigned char* lds) {
    const V v = make_views(p); const int TIDX = otid();
    const int lane = TIDX & 63, wave = TIDX >> 6, r = lane & 31, h = lane >> 5;
    const int qblk = 63 - (unit >> 4), bg = unit & 15, b = bg >> 1, g = bg & 1;
    const int t0 = qblk * 32, t = t0 + r, m = b * S + t, head = g * 4 + wave, cur = t0 >> 6;
    const float NEG_INF = -__builtin_inff();
    bf16x8 qf[4];
#pragma unroll
    for (int s = 0; s < 4; ++s) qf[s] = scale_frag(*(const bf16x8*)(v.U + (size_t)m * NP + C_QA + head * 64 + 16 * s + 8 * h), C2);
    const float g0 = sigmoidf_(v.gf[(size_t)m * 32 + head * 3]), g1 = sigmoidf_(v.gf[(size_t)m * 32 + head * 3 + 1]), g2 = sigmoidf_(v.gf[(size_t)m * 32 + head * 3 + 2]);
    f32x16 otot[2];
    float* PA = (float*)(lds + 32768);
    float* PB = (float*)(lds + 49152);
    float* SC = (float*)lds;
    unsigned* MASK = (unsigned*)(lds + 8192);
    {
        const bf16_t* ck = v.ck + (size_t)(b * 2 + g) * 128 * 64;
        const bf16_t* cvt = (const bf16_t*)(p.ws + WS_CVT) + (size_t)(b * 2 + g) * 64 * 128;
        const int c = TIDX & 7, r0 = TIDX >> 3;
        u32x4 rk[4], rv[4];
#pragma unroll
        for (int i = 0; i < 4; ++i) rk[i] = *(const u32x4*)(ck + (size_t)(r0 + 32 * i) * 64 + c * 8);
#pragma unroll
        for (int i = 0; i < 4; ++i) rv[i] = *(const u32x4*)(cvt + (size_t)(r0 + 32 * (i & 1)) * 128 + 64 * (i >> 1) + c * 8);
        __syncthreads();
#pragma unroll
        for (int i = 0; i < 4; ++i) *(u32x4*)(lds + tile_off(r0 + 32 * i, c)) = rk[i];
#pragma unroll
        for (int i = 0; i < 4; ++i) *(u32x4*)(lds + 16384 + 8192 * (i >> 1) + tile_off(r0 + 32 * (i & 1), c)) = rv[i];
        __syncthreads();
        f32x16 ps[2][2];
        score_tile(lds, qf, r, h, ps[0]);
        score_tile(lds + 8192, qf, r, h, ps[1]);
        const int nvalid = t >= 31 ? (t - 31) / 16 + 1 : 0;
        float mx = NEG_INF;
#pragma unroll
        for (int tt = 0; tt < 2; ++tt)
#pragma unroll
            for (int blk = 0; blk < 2; ++blk)
#pragma unroll
                for (int q = 0; q < 16; ++q) {
                    const int n = 64 * tt + 32 * blk + 16 * (q >> 3) + 8 * h + (q & 7);
                    const float x = n < nvalid ? ps[tt][blk][q] : NEG_INF;
                    ps[tt][blk][q] = x; mx = fmaxf(mx, x);
                }
        mx = fmaxf(mx, __shfl_xor(mx, 32));
        const float mxs = nvalid > 0 ? mx : 0.f;
        float ls = 0.f;
#pragma unroll
        for (int tt = 0; tt < 2; ++tt)
#pragma unroll
            for (int blk = 0; blk < 2; ++blk)
#pragma unroll
                for (int q = 0; q < 16; ++q) { const float e = fexp2(ps[tt][blk][q] - mxs); ps[tt][blk][q] = e; ls += e; }
        const float lt = ls + __shfl_xor(ls, 32);
        const float inv = lt > 0.f ? 1.f / lt : 0.f;
#pragma unroll
        for (int tt = 0; tt < 2; ++tt)
#pragma unroll
            for (int blk = 0; blk < 2; ++blk) {
#pragma unroll
                for (int q = 0; q < 16; ++q) ps[tt][blk][q] *= inv;
#pragma unroll
                for (int s = 0; s < 2; ++s) {
                    const int G0 = 16 * tt + 8 * blk + 4 * s + 2 * h;
                    const float a0 = (ps[tt][blk][8 * s] + ps[tt][blk][8 * s + 1]) + (ps[tt][blk][8 * s + 2] + ps[tt][blk][8 * s + 3]);
                    const float a1 = (ps[tt][blk][8 * s + 4] + ps[tt][blk][8 * s + 5]) + (ps[tt][blk][8 * s + 6] + ps[tt][blk][8 * s + 7]);
                    PA[(wave * 32 + G0) * 32 + r] = a0; PA[(wave * 32 + G0 + 1) * 32 + r] = a1;
                    PB[(wave * 32 + G0 + 1) * 32 + r] = ps[tt][blk][8 * s + 3];
                    if (G0 + 2 < 32) PB[(wave * 32 + G0 + 2) * 32 + r] = ps[tt][blk][8 * s + 7];
                }
            }
        f32x16 oc[2];
#pragma unroll
        for (int db = 0; db < 2; ++db)
#pragma unroll
            for (int q = 0; q < 16; ++q) oc[db][q] = 0.f;
        pv_tile(lds + 16384, ps[0], r, h, oc);
        pv_tile(lds + 24576, ps[1], r, h, oc);
#pragma unroll
        for (int db = 0; db < 2; ++db)
#pragma unroll
            for (int q = 0; q < 16; ++q) otot[db][q] = g0 * oc[db][q];
    }
    __syncthreads();
    const bool need_topk = cur > 15;
    if (need_topk) {
        const int q = TIDX & 31, j0 = (TIDX >> 5) * 4;
#pragma unroll
        for (int jj = 0; jj < 4; ++jj) {
            const int j = j0 + jj;
            float sc = 0.f;
#pragma unroll
            for (int w = 0; w < 4; ++w) sc += PA[(w * 32 + j) * 32 + q];
            if (j > 0) {
#pragma unroll
                for (int w = 0; w < 4; ++w) sc += PB[(w * 32 + j) * 32 + q];
            }
            const bool forced = (j == 0) || (j == cur) || (j == cur - 1);
            SC[q * 33 + j] = forced ? 1.0e4f : (j <= cur ? sc : -1.0f);
        }
        if (TIDX < 32) MASK[TIDX] = 0u;
        __syncthreads();
        unsigned bits = 0u;
#pragma unroll
        for (int jj = 0; jj < 4; ++jj) {
            const int j = j0 + jj;
            const float vj = SC[q * 33 + j];
            int rank = 0;
#pragma unroll
            for (int i = 0; i < 32; ++i) { const float vi = SC[q * 33 + i]; rank += (vi > vj || (vi == vj && i < j)) ? 1 : 0; }
            if (rank < 16) bits |= 1u << j;
        }
        atomicOr(&MASK[q], bits);
        __syncthreads();
    }
    const unsigned upto = (2u << cur) - 1u;
    unsigned mybits = upto, um = upto;
    if (need_topk) {
        mybits = MASK[r];
        um = 0u;
#pragma unroll
        for (int i = 0; i < 32; ++i) um |= MASK[i];
        um = (unsigned)__builtin_amdgcn_readfirstlane((int)um);
    }
    {
        KVT src; src.k = v.U + (size_t)b * S * NP + C_KS + g * 64; src.ks = NP;
        src.v = (const bf16_t*)(p.ws + WS_VT) + (size_t)(b * 768 + g * 64) * S; src.vs = S;
        f32x16 o[2];
        attn_branch<0>(lds, src, qf, um & upto, cur, t, t0, mybits, nullptr, o, TIDX);
#pragma unroll
        for (int db = 0; db < 2; ++db)
#pragma unroll
            for (int q = 0; q < 16; ++q) otot[db][q] += g1 * o[db][q];
    }
    {
        KVT src; src.k = v.U + (size_t)b * S * NP + C_KW + g * 64; src.ks = NP;
        src.v = (const bf16_t*)(p.ws + WS_VT) + (size_t)(b * 768 + 128 + g * 64) * S; src.vs = S;
        const int f = (t0 - 511 > 0 ? t0 - 511 : 0) >> 6;
        const unsigned wmask = upto & ~((1u << f) - 1u);
        f32x16 o[2];
        attn_branch<1>(lds, src, qf, wmask, cur, t, t0, 0u, nullptr, o, TIDX);
#pragma unroll
        for (int db = 0; db < 2; ++db)
#pragma unroll
            for (int q = 0; q < 16; ++q) otot[db][q] += g2 * o[db][q];
    }
    head_norm_store(otot, p.out_norm_g + (size_t)l * D + head * 64, v.O + (size_t)m * D + head * 64, h);
}

constexpr int CW_CMPK = 12288;
DEV bool cmp_unit(const P& p, int l, int unit, int kq, unsigned char* lds, volatile LAS unsigned* qslot) {
    const V v = make_views(p); const int TIDX = otid();
    const int lane = TIDX & 63, wave = TIDX >> 6, wm = wave >> 1, wn = wave & 1, r = lane & 31, h = lane >> 5;
    const int kv = unit & 1, bg = unit >> 1, b = bg >> 1, g = bg & 1, lk = l * 2 + kv;
    const int col = (kv ? C_VC : C_KC) + g * 64;
    const bf16_t* arow[4];
#pragma unroll
    for (int i = 0; i < 4; ++i) { const int n = (TIDX >> 3) + 32 * i; arow[i] = v.U + (size_t)(b * S + 16 * (n < 127 ? n : 126) + 8 * kq) * NP + col; }
    f32x16 acc[2][2];
    gemm128<false>(lds, arow, (const bf16_t*)(p.ws + WS_CW1) + (size_t)lk * 2048 * 128 + (size_t)kq * 512 * 128, 128, 512, acc, TIDX, NP);
    {
        const __amdgpu_buffer_rsrc_t prs = __builtin_amdgcn_make_buffer_rsrc((void*)v.OB, (short)0, 32 * 4 * 65536, 0x00020000);
        const unsigned pbase = (unsigned)(unit * 4 + kq) * 65536u + (unsigned)TIDX * 16u;
#pragma unroll
        for (int j = 0; j < 2; ++j)
#pragma unroll
            for (int i = 0; i < 2; ++i)
#pragma unroll
                for (int g4 = 0; g4 < 4; ++g4) {
                    const f32x4v a = {acc[j][i][4 * g4], acc[j][i][4 * g4 + 1], acc[j][i][4 * g4 + 2], acc[j][i][4 * g4 + 3]};
                    __builtin_amdgcn_raw_buffer_store_b128(__builtin_bit_cast(u32x4, a), prs, pbase + (unsigned)((j * 2 + i) * 4 + g4) * 4096u, 0,   16);
                }
        asm volatile("s_waitcnt vmcnt(0)" ::: "memory");
        __syncthreads();
        if (TIDX == 0) *qslot = __hip_atomic_fetch_add(v.ctl + CW_CMPK + l * 32 + unit, 1u, __ATOMIC_RELAXED, __HIP_MEMORY_SCOPE_AGENT);
        __syncthreads();
        if (*qslot != 3u) return false;
        if (TIDX == 0) { __builtin_amdgcn_fence(__ATOMIC_ACQUIRE, "agent"); asm volatile("s_waitcnt vmcnt(0)" ::: "memory"); }
        __syncthreads();
        const float* pp = v.OB + (size_t)unit * 4 * 16384 + TIDX * 4;
#pragma unroll
        for (int j = 0; j < 2; ++j)
#pragma unroll
            for (int i = 0; i < 2; ++i)
#pragma unroll
                for (int g4 = 0; g4 < 4; ++g4) {
                    const float* q0 = pp + ((j * 2 + i) * 4 + g4) * 1024;
                    f32x4v a = *(const f32x4v*)q0;
#pragma unroll
                    for (int k2 = 1; k2 < 4; ++k2) { const f32x4v b2 = *(const f32x4v*)(q0 + k2 * 16384); a += b2; }
                    acc[j][i][4 * g4] = a[0]; acc[j][i][4 * g4 + 1] = a[1]; acc[j][i][4 * g4 + 2] = a[2]; acc[j][i][4 * g4 + 3] = a[3];
                }
    }
    const float* pb = (const float*)(p.ws + WS_CPB) + lk * 8 * 128;
#pragma unroll
    for (int j = 0; j < 2; ++j)
#pragma unroll
        for (int i = 0; i < 2; ++i) {
            const int mrow = 64 * wm + 32 * i + r;
#pragma unroll
            for (int g4 = 0; g4 < 4; ++g4) {
                float4 bb = *(const float4*)(pb + 64 * wn + 32 * j + 8 * g4 + 4 * h);
#pragma unroll
                for (int c8 = 1; c8 < 8; ++c8) { const float4 b2 = *(const float4*)(pb + c8 * 128 + 64 * wn + 32 * j + 8 * g4 + 4 * h); bb.x += b2.x; bb.y += b2.y; bb.z += b2.z; bb.w += b2.w; }
                float x0 = acc[j][i][4 * g4] + bb.x, x1 = acc[j][i][4 * g4 + 1] + bb.y, x2 = acc[j][i][4 * g4 + 2] + bb.z, x3 = acc[j][i][4 * g4 + 3] + bb.w;
                x0 = x0 / (1.f + __expf(-x0)); x1 = x1 / (1.f + __expf(-x1)); x2 = x2 / (1.f + __expf(-x2)); x3 = x3 / (1.f + __expf(-x3));
                uint2 u; u.x = cvtpk(x0, x1); u.y = cvtpk(x2, x3);
                *(uint2*)(lds + wn * 16384 + tile_off(mrow, 4 * j + g4) + 8 * h) = u;
            }
        }
    {
        const bf16_t* w2 = (const bf16_t*)(p.ws + WS_CW2) + (size_t)lk * 64 * 128;
        const int c = TIDX & 7, r0 = TIDX >> 3;
#pragma unroll
        for (int i = 0; i < 4; ++i) {
            const int row = r0 + 32 * (i & 1), kt = i >> 1;
            *(u32x4*)(lds + 32768 + kt * 8192 + tile_off(row, c)) = *(const u32x4*)(w2 + (size_t)row * 128 + kt * 64 + c * 8);
        }
    }
    __syncthreads();
    f32x16 a2[2];
#pragma unroll
    for (int db = 0; db < 2; ++db)
#pragma unroll
        for (int q = 0; q < 16; ++q) a2[db][q] = 0.f;
#pragma unroll
    for (int kt = 0; kt < 2; ++kt)
#pragma unroll
        for (int s = 0; s < 4; ++s) {
            const bf16x8 hf = *(const bf16x8*)(lds + kt * 16384 + tile_off(32 * wave + r, 2 * s + h));
#pragma unroll
            for (int db = 0; db < 2; ++db) {
                const bf16x8 wf = *(const bf16x8*)(lds + 32768 + kt * 8192 + tile_off(32 * db + r, 2 * s + h));
                a2[db] = __builtin_amdgcn_mfma_f32_32x32x16_bf16(wf, hf, a2[db], 0, 0, 0);
            }
        }
    const int n = 32 * wave + r;
    if (kv == 0 && n < 127) {
        const int pos = 16 * n + 31;
#pragma unroll
        for (int q = 0; q < 4; ++q) {
            const float cs = v.rcos[pos * 8 + q + 4 * h], sn = v.rsin[pos * 8 + q + 4 * h];
            const float x1 = a2[0][q], x2 = a2[0][q + 4];
            a2[0][q] = x1 * cs - x2 * sn; a2[0][q + 4] = x2 * cs + x1 * sn;
        }
    }
    bf16_t* dst = (kv ? v.cv : v.ck) + ((size_t)bg * 128 + n) * 64;
    bf16_t* dt = (bf16_t*)(p.ws + WS_CVT) + (size_t)bg * 64 * 128 + n;
#pragma unroll
    for (int db = 0; db < 2; ++db)
#pragma unroll
        for (int g4 = 0; g4 < 4; ++g4) {
            const int d = 32 * db + 8 * g4 + 4 * h;
            float x0 = a2[db][4 * g4], x1 = a2[db][4 * g4 + 1], x2 = a2[db][4 * g4 + 2], x3 = a2[db][4 * g4 + 3];
            if (n >= 127) { x0 = 0.f; x1 = 0.f; x2 = 0.f; x3 = 0.f; }
            uint2 u; u.x = cvtpk(x0, x1); u.y = cvtpk(x2, x3);
            *(uint2*)(dst + d) = u;
            if (kv) { dt[(size_t)d * 128] = (bf16_t)(u.x & 0xffffu); dt[(size_t)(d + 1) * 128] = (bf16_t)(u.x >> 16); dt[(size_t)(d + 2) * 128] = (bf16_t)(u.y & 0xffffu); dt[(size_t)(d + 3) * 128] = (bf16_t)(u.y >> 16); }
        }
    __syncthreads();
    return true;
}

typedef float f32x4m __attribute__((ext_vector_type(4)));
DEV void ph_norm2_router_fast(const P& p, int l, unsigned char* lds) {
    const V v = make_views(p); const int TIDX = otid(), BIDX = obid();
    const int lane = TIDX & 63, wave = TIDX >> 6;
    const bf16_t* wr = (const bf16_t*)(p.ws + WS_WR) + (size_t)l * 2 * 64 * D;
    float* LG = (float*)(lds + 65536);
    for (int blk = BIDX; blk < T / 16; blk += gridDim.x) {
        const int m0 = blk * 16, b = m0 >> 11;
        const float* md = v.mod + (size_t)(l * 8 + b) * 6144;
        float4 xv[4][4]; float ssq[4];
#pragma unroll
        for (int rr = 0; rr < 4; ++rr)
#pragma unroll
            for (int j = 0; j < 4; ++j) xv[rr][j] = ld_bf4(v.XB + (size_t)(m0 + wave * 4 + rr) * D + 4 * lane + 256 * j);
#pragma unroll
        for (int rr = 0; rr < 4; ++rr) {
            ssq[rr] = 0.f;
#pragma unroll
            for (int j = 0; j < 4; ++j) ssq[rr] += xv[rr][j].x * xv[rr][j].x + xv[rr][j].y * xv[rr][j].y + xv[rr][j].z * xv[rr][j].z + xv[rr][j].w * xv[rr][j].w;
        }
#pragma unroll
        for (int o = 1; o < 64; o <<= 1) {
#pragma unroll
            for (int rr = 0; rr < 4; ++rr) ssq[rr] += __shfl_xor(ssq[rr], o);
        }
#pragma unroll
        for (int rr = 0; rr < 4; ++rr) {
            const int row = wave * 4 + rr, m = m0 + row;
            const float rs = rsqrtf(ssq[rr] * (1.f / D) + EPS);
#pragma unroll
            for (int j = 0; j < 4; ++j) {
                const int c = 4 * lane + 256 * j;
                const float4 g = *(const float4*)(p.norm2_g + l * D + c), sh = *(const float4*)(md + 3 * D + c), sc = *(const float4*)(md + 4 * D + c);
                const float h0 = xv[rr][j].x * rs * g.x * (1.f + sc.x) + sh.x, h1 = xv[rr][j].y * rs * g.y * (1.f + sc.y) + sh.y;
                const float h2 = xv[rr][j].z * rs * g.z * (1.f + sc.z) + sh.z, h3 = xv[rr][j].w * rs * g.w * (1.f + sc.w) + sh.w;
                uint2 hi; hi.x = cvtpk(h0, h1); hi.y = cvtpk(h2, h3);
                uint2 lo;
                lo.x = cvtpk(h0 - __uint_as_float(hi.x << 16), h1 - __uint_as_float(hi.x & 0xffff0000u));
                lo.y = cvtpk(h2 - __uint_as_float(hi.y << 16), h3 - __uint_as_float(hi.y & 0xffff0000u));
                *(uint2*)(v.H + (size_t)m * D + c) = hi;
                const int off = row * 2048 + ((((c >> 3) ^ row) & 127) << 4) + (c & 7) * 2;
                *(uint2*)(lds + off) = hi; *(uint2*)(lds + 32768 + off) = lo;
            }
        }
        __syncthreads();
        {
            const int r16 = lane & 15, kq = lane >> 4;
            f32x4m acc = {0.f, 0.f, 0.f, 0.f};
            const bf16_t* wh = wr + (size_t)(16 * wave + r16) * D + 8 * kq;
#pragma unroll 8
            for (int s = 0; s < 32; ++s) {
                const int off = r16 * 2048 + ((((4 * s + kq) ^ r16) & 127) << 4);
                const bf16x8 ah = *(const bf16x8*)(lds + off), al = *(const bf16x8*)(lds + 32768 + off);
                const bf16x8 bh = *(const bf16x8*)(wh + 32 * s), bl = *(const bf16x8*)(wh + 64 * D + 32 * s);
                acc = __builtin_amdgcn_mfma_f32_16x16x32_bf16(ah, bh, acc, 0, 0, 0);
                acc = __builtin_amdgcn_mfma_f32_16x16x32_bf16(al, bh, acc, 0, 0, 0);
                acc = __builtin_amdgcn_mfma_f32_16x16x32_bf16(ah, bl, acc, 0, 0, 0);
            }
#pragma unroll
            for (int q = 0; q < 4; ++q) LG[(4 * kq + q) * 64 + 16 * wave + r16] = acc[q];
        }
        __syncthreads();
        if (TIDX < 16) {
            const int m = m0 + TIDX;
            const float* lgp = LG + TIDX * 64;
            float lg[4], le[32];
#pragma unroll
            for (int i = 0; i < 4; ++i) lg[i] = lgp[i] + p.rg_b[l * 4 + i];
#pragma unroll
            for (int i = 0; i < 32; ++i) le[i] = lgp[4 + i] + p.re_b[l * 32 + i];
            int gi = 0; float gm = lg[0];
#pragma unroll
            for (int i = 1; i < 4; ++i) if (lg[i] > gm) { gm = lg[i]; gi = i; }
            float gs = 0.f;
#pragma unroll
            for (int i = 0; i < 4; ++i) gs += expf(lg[i] - gm);
            const float pg = 1.f / gs;
            float el[8];
#pragma unroll
            for (int i = 0; i < 8; ++i) el[i] = gi == 0 ? le[i] : (gi == 1 ? le[8 + i] : (gi == 2 ? le[16 + i] : le[24 + i]));
            int e1 = 0; float m1 = el[0];
#pragma unroll
            for (int i = 1; i < 8; ++i) if (el[i] > m1) { m1 = el[i]; e1 = i; }
            int e2 = -1; float m2 = -3.0e38f;
#pragma unroll
            for (int i = 0; i < 8; ++i) if (i != e1 && el[i] > m2) { m2 = el[i]; e2 = i; }
            const float p2 = expf(m2 - m1);
            const float w1 = pg / (1.f + p2), w2 = pg * p2 / (1.f + p2);
            const int ea = gi * 8 + e1, eb = gi * 8 + e2;
            const unsigned pa = atomicAdd(v.ctl + CW_CNT + l * 32 + ea, 1u);
            const unsigned pb = atomicAdd(v.ctl + CW_CNT + l * 32 + eb, 1u);
            v.list[(size_t)ea * T + pa] = 2 * m;
            v.list[(size_t)eb * T + pb] = 2 * m + 1;
            v.wts[2 * m] = w1; v.wts[2 * m + 1] = w2;
        }
        __syncthreads();
    }
}

constexpr int CW_MQ = 8192 + 512;
DEV void ph_mix(const P& p, int l, unsigned char* lds, volatile LAS unsigned* qslot, int rep) {
    const int TIDX = otid(), BIDX = obid();
    unsigned* ctl = (unsigned*)(p.ws + WS_CTL) + CW_MQ + l * 256;
    unsigned acq = 0u;
    int b = BIDX & 7;
    {
        for (;;) {
            unsigned* qc = ctl + b * 16;
            unsigned* done = ctl + 128 + b * 16;
            __syncthreads();
            if (TIDX == 0) {
                unsigned tk = atomicAdd(qc, 1u), nb = (unsigned)b;
                if (tk >= 272u) {
                    unsigned hd[8];
#pragma unroll
                    for (int q = 0; q < 8; ++q) hd[q] = __hip_atomic_load(ctl + ((b + q) & 7) * 16, __ATOMIC_RELAXED, __HIP_MEMORY_SCOPE_AGENT);
                    nb = 8u;
#pragma unroll
                    for (int q = 7; q >= 1; --q) if (hd[q] < 272u) nb = (unsigned)((b + q) & 7);
                }
                *qslot = tk | (nb << 16);
            }
            __syncthreads();
            const unsigned qv = *qslot;
            const int v = (int)(qv & 0xffffu);
            if (v >= 272) {
                const int nb = (int)(qv >> 16);
                if (nb >= 8) break;
                b = nb; continue;
            }
            if (v < 16) {
                if (cmp_unit(p, l, b * 4 + (v >> 2), v & 3, lds, qslot)) {
                    asm volatile("s_waitcnt vmcnt(0)" ::: "memory");
                    __syncthreads();
                    if (TIDX == 0) {
                        __builtin_amdgcn_fence(__ATOMIC_RELEASE, "agent");
                        asm volatile("s_waitcnt vmcnt(0)" ::: "memory");
                        __hip_atomic_fetch_add(done, 1u, __ATOMIC_RELAXED, __HIP_MEMORY_SCOPE_AGENT);
                    }
                }
                continue;
            }
            int slot = -1, nsa = -1;
            if (v < 48) slot = 2 * (v - 16);
            else if (v < 112) slot = 2 * (v - 48) + 1;
            else { const int w2 = v - 112, k = w2 % 5, i = w2 / 5; if (k < 4) nsa = 4 * i + k; else slot = 2 * (32 + i); }
            if (slot >= 0) {
                const int idx = slot >> 1, u = ((idx >> 2) << 5) | (b * 4 + (idx & 3));
                if (slot & 1) mha_unit<3>(p, l, u, lds); else mha_unit<2>(p, l, u, lds);
            } else {
                if (!((acq >> b) & 1u)) {
                    if (TIDX == 0) {
                        unsigned sp = 0;
                        while (__hip_atomic_load(done, __ATOMIC_RELAXED, __HIP_MEMORY_SCOPE_AGENT) < 4u) { __builtin_amdgcn_s_sleep(2); if (++sp > (1u << 22)) break; }
                        __builtin_amdgcn_fence(__ATOMIC_ACQUIRE, "agent");
                        asm volatile("s_waitcnt vmcnt(0)" ::: "memory");
                    }
                    __syncthreads();
                    acq |= 1u << b;
                }
                nsa_unit(p, l, ((nsa >> 1) << 4) | (b * 2 + (nsa & 1)), lds);
            }
        }
    }
}

#ifndef REP_PHASE
#define REP_PHASE 0
#endif
#ifndef REF_HEADS
#define REF_HEADS 0x0000u
#endif
__global__ void __launch_bounds__(256, 2) fwd_kernel(P p) {
    __shared__ __attribute__((aligned(16))) float lds[17408];
    __shared__ __attribute__((aligned(16))) unsigned lds_ctl[4];
    if (threadIdx.x < 4) lds_ctl[threadIdx.x] = 0u;
    __syncthreads();
    const XcdBarrier xb = xcd_barrier_post((unsigned*)(p.ws + WS_CTL), (volatile LAS unsigned*)lds_ctl);
#define GRID_BAR() do { xcd_barrier(xb); if (REP_PHASE == 7) xcd_barrier(xb); } while (0)
    volatile LAS unsigned* qslot = (volatile LAS unsigned*)(lds_ctl + 2);
    for (int rep = 0; rep < (REP_PHASE == 1 ? 2 : 1); ++rep) {
        ph_prologue(p, lds);
        ph_convert(p, lds);
        GRID_BAR();
    }
    for (int l = 0; l < DEPTH; ++l) {
        ph_convert_dense(p, l, 0);
        ph_norm1(p, l, l == 0 ? 0 : 1);
        GRID_BAR();
        for (int rep = 0; rep < (REP_PHASE == 2 ? 2 : 1); ++rep) {
            if (rep == 0) ph_convert_dense(p, l, 1);
            ph_inproj_fast(p, l, (unsigned char*)lds);
            GRID_BAR();
        }
        for (int rep = 0; rep < (REP_PHASE == 3 ? 2 : 1); ++rep) {
            ph_mix(p, l, (unsigned char*)lds, qslot, rep);
            GRID_BAR();
        }
        ph_outproj_fast(p, l, (unsigned char*)lds);
        GRID_BAR();
        if (blockIdx.x & 8) { ph_convert_experts(p, l); ph_norm2_router_fast(p, l, (unsigned char*)lds); }
        else { ph_norm2_router_fast(p, l, (unsigned char*)lds); ph_convert_experts(p, l); }
        GRID_BAR();
        for (int rep = 0; rep < (REP_PHASE == 5 ? 2 : 1); ++rep) {
            ph_moe_up_fast(p, l, (unsigned char*)lds);
            GRID_BAR();
        }
        for (int rep = 0; rep < (REP_PHASE == 6 ? 2 : 1); ++rep) {
            ph_moe_down_fast(p, l, (unsigned char*)lds);
            GRID_BAR();
        }
    }
    ph_norm1(p, DEPTH, 2);
}

extern "C" void kernel_launch(void* const* d_in, const int* in_sizes, int n_in,
                              void* d_out, int out_size, void* d_ws, size_t ws_size,
                              hipStream_t stream) {
    static int grid_blocks = 0;
    if (!grid_blocks) {
        int dev = 0, cus = 0, per_cu = 0;
        (void)hipGetDevice(&dev);
        (void)hipDeviceGetAttribute(&cus, hipDeviceAttributeMultiprocessorCount, dev);
        (void)hipOccupancyMaxActiveBlocksPerMultiprocessor(&per_cu, fwd_kernel, 256, 0);
        if (per_cu > 2) per_cu = 2;
        if (per_cu < 1) per_cu = 1;
        grid_blocks = cus * per_cu;
        if (n_in != 24 || ws_size < WS_END || out_size != T * D) { fprintf(stderr, "kernel_launch: unexpected shapes (n_in %d ws %zu out %d)\n", n_in, ws_size, out_size); grid_blocks = -1; }
    }
    if (grid_blocks < 0) return;
    (void)hipMemsetAsync(d_ws, 0, CTL_BYTES, stream);
    P p{};
    const float** pp = (const float**)&p;
    for (int i = 0; i < 24; ++i) pp[i] = (const float*)d_in[i];
    p.out = (float*)d_out; p.ws = (unsigned char*)d_ws;
    void* args[] = {&p};
    hipError_t e = hipLaunchCooperativeKernel((void*)fwd_kernel, dim3(grid_blocks), dim3(256), args, 0, stream);
    if (e != hipSuccess) fprintf(stderr, "cooperative launch failed: %s (grid %d)\n", hipGetErrorString(e), grid_blocks);
}
```

```cpp
#include <hip/hip_runtime.h>
#include <hip/hip_cooperative_groups.h>
#include <cstdio>
#include <cstdint>

#define LAS __attribute__((address_space(3)))
#define DEV __device__ __forceinline__

constexpr int T = 16384, S = 2048, NB = 8, D = 1024, DIN = 2844, NP = 2880, DEPTH = 4;
constexpr int NCMP = 127;
constexpr float EPS = 1e-6f;
constexpr float SCALE = 0.125f;
constexpr int C_QA = 0, C_KC = 512, C_VC = 640, C_KS = 768, C_VS = 896, C_KW = 1024, C_VW = 1152;
constexpr int C_QB = 1280, C_KB = 1536, C_VB = 1792, C_QC = 2048, C_KCC = 2304, C_VCC = 2560;

constexpr size_t MiB = 1u << 20;
constexpr size_t WS_CTL = 0, CTL_BYTES = 128 * 1024;
constexpr size_t WS_MOD = 1 * MiB, WS_ROPE = 2 * MiB, WS_CUMF = 3 * MiB, WS_CK = 4 * MiB, WS_CV = 5 * MiB, WS_IMP = 6 * MiB;
constexpr size_t WS_SEL = 10 * MiB, WS_EID = 11 * MiB, WS_WTS = 12 * MiB, WS_LIST = 13 * MiB, WS_GF = 16 * MiB;
constexpr size_t WS_H = 32 * MiB, WS_U = 64 * MiB, WS_O = 160 * MiB, WS_HID = 192 * MiB, WS_Y = 224 * MiB, WS_OB = 352 * MiB, WS_ORAW = 448 * MiB;
constexpr size_t WS_END = 973 * MiB;
constexpr size_t WS_VT = 936 * MiB;
constexpr size_t WS_CVT = 962 * MiB;
constexpr size_t WS_CUMF2 = 963 * MiB;
constexpr int CW_Q = 8192 + 256;
constexpr size_t WS_CW1 = 964 * MiB;
constexpr size_t WS_CW2 = 968 * MiB;
constexpr size_t WS_CPB = 969 * MiB;
constexpr size_t WS_LSF = 970 * MiB;
constexpr size_t WS_WR = 971 * MiB;
constexpr int CW_CNT = 16384;
constexpr int CW_KN = 12544;

typedef unsigned short bf16_t;
typedef float f32x4v __attribute__((ext_vector_type(4)));
DEV int vt_row(int n) { return n < 1024 ? n - 896 : (n < 1280 ? 128 + n - 1152 : (n < 2048 ? 256 + n - 1792 : 512 + n - 2560)); }
DEV bool is_vcol(int n) { return (n >= C_VS && n < C_KW) || (n >= C_VW && n < C_QB) || (n >= C_VB && n < C_QC) || (n >= C_VCC && n < 2816); }
DEV float bf2f(bf16_t v) { return __uint_as_float((unsigned)v << 16); }
DEV bf16_t f2bf(float f) { unsigned u = __float_as_uint(f); return (bf16_t)((u + 0x7fffu + ((u >> 16) & 1u)) >> 16); }
DEV float4 ld_bf4(const bf16_t* p) { const ushort4 u = *(const ushort4*)p; return make_float4(bf2f(u.x), bf2f(u.y), bf2f(u.z), bf2f(u.w)); }
typedef float f32x2_t __attribute__((ext_vector_type(2)));
typedef __bf16 bf16x2_t __attribute__((ext_vector_type(2)));
DEV unsigned cvtpk(float lo, float hi) { f32x2_t v = {lo, hi}; bf16x2_t b = __builtin_convertvector(v, bf16x2_t); return __builtin_bit_cast(unsigned, b); }
DEV float sigmoidf_(float x) { return 1.f / (1.f + expf(-x)); }
DEV float logsigmoidf_(float x) { return fminf(x, 0.f) - log1pf(expf(-fabsf(x))); }
DEV float wave_sum(float v) {
#pragma unroll
    for (int o = 1; o < 64; o <<= 1) v += __shfl_xor(v, o);
    return v;
}

#define XB_TMO      128
#define XB_XCNT(j)  (256  + 64 * (j))
#define XB_XSUB(j)  (1280 + 64 * (j))
#define XB_XGEN(j)  (2304 + 64 * (j))
#define XB_TOP      3328
#define XB_TOPGEN   3392
#define XCD_BAR_WORDS 3456
#define XB_SPIN_CAP (1u << 23)
DEV unsigned xb_ld(unsigned* p)              { return __hip_atomic_load(p, __ATOMIC_RELAXED, __HIP_MEMORY_SCOPE_AGENT); }
DEV unsigned xb_add(unsigned* p, unsigned v) { return __hip_atomic_fetch_add(p, v, __ATOMIC_RELAXED, __HIP_MEMORY_SCOPE_AGENT); }
DEV unsigned xb_xcc_id() { return (unsigned)__builtin_amdgcn_s_getreg((3 << 11) | 20) & 0xFu; }
#define XB_SPIN(cond, bar) do { unsigned _sp = 0; while (cond) { __builtin_amdgcn_s_sleep(1); \
    if ((++_sp & 255u) == 0u) { if (xb_ld(&(bar)[XB_TMO])) break; if (_sp > XB_SPIN_CAP) { atomicAdd(&(bar)[XB_TMO], 1u); break; } } } } while (0)
struct XcdBarrier { unsigned* bar; unsigned x; volatile LAS unsigned* st; };
DEV XcdBarrier xcd_barrier_post(unsigned* bar, volatile LAS unsigned* st) {
    XcdBarrier b; b.bar = bar; b.x = xb_xcc_id(); b.st = st;
    if (threadIdx.x == 0) (void)xb_add(&bar[XB_XCNT(b.x)], 1u);
    return b;
}
DEV void xcd_barrier_complete(unsigned* bar, unsigned x, unsigned& nloc, unsigned& nx) {
    const unsigned G = gridDim.x * gridDim.y * gridDim.z;
    unsigned sum, cnt, mine, sp = 0u;
    for (;;) {
        sum = 0u; cnt = 0u; mine = 0u;
#pragma unroll
        for (unsigned j = 0; j < 16; ++j) { const unsigned c = xb_ld(&bar[XB_XCNT(j)]); sum += c; cnt += (c > 0u) ? 1u : 0u; mine = (j == x) ? c : mine; }
        if (sum == G) break;
        __builtin_amdgcn_s_sleep(1);
        if ((++sp & 255u) == 0u) { if (xb_ld(&bar[XB_TMO])) break; if (sp > XB_SPIN_CAP) { atomicAdd(&bar[XB_TMO], 1u); break; } }
    }
    nloc = mine > 0u ? mine : 1u; nx = cnt > 0u ? cnt : 1u;
}
DEV void xcd_barrier(const XcdBarrier& b) {
    asm volatile("s_waitcnt vmcnt(0)" ::: "memory");
    __syncthreads();
    if (threadIdx.x == 0) {
        unsigned* bar = b.bar;
        __builtin_amdgcn_s_waitcnt(0);
        unsigned nloc = b.st[0], nx = b.st[1];
        if (nloc == 0u) { xcd_barrier_complete(bar, b.x, nloc, nx); b.st[0] = nloc; b.st[1] = nx; }
        const unsigned old = xb_add(&bar[XB_XSUB(b.x)], 1u);
        const unsigned gen = old / nloc;
        if (old + 1u == (gen + 1u) * nloc) {
            __builtin_amdgcn_fence(__ATOMIC_RELEASE, "agent");
            asm volatile("s_waitcnt vmcnt(0)" ::: "memory");
            const unsigned og = xb_add(&bar[XB_TOP], 1u);
            const unsigned tg = og / nx;
            if (og + 1u == (tg + 1u) * nx) xb_add(&bar[XB_TOPGEN], 1u);
            else XB_SPIN(xb_ld(&bar[XB_TOPGEN]) == tg, bar);
            __builtin_amdgcn_fence(__ATOMIC_ACQUIRE, "agent");
            xb_add(&bar[XB_XGEN(b.x)], 1u);
            asm volatile("s_waitcnt vmcnt(0)" ::: "memory");
        } else {
            XB_SPIN(xb_ld(&bar[XB_XGEN(b.x)]) == gen, bar);
            __builtin_amdgcn_fence(__ATOMIC_ACQUIRE, "agent");
            asm volatile("s_waitcnt vmcnt(0)" ::: "memory");
        }
    }
    __syncthreads();
}

struct P {
    const float *x, *c, *norm1_g, *norm2_g, *ada_w, *ada_b, *w_in, *b_forget, *cmp_pos_k, *cmp_w1_k, *cmp_w2_k,
        *cmp_pos_v, *cmp_w1_v, *cmp_w2_v, *out_norm_g, *w_out, *rg_w, *rg_b, *re_w, *re_b, *e_w1, *e_w3, *e_w2, *final_g;
    float* out; unsigned char* ws;
};
struct V {
    unsigned* ctl; float* mod; float* rcos; float* rsin; float* cumf; bf16_t* ck; bf16_t* cv; float* imp; unsigned* sel;
    int* eid; float* wts; int* list; float* gf; bf16_t* H; bf16_t* U; bf16_t* O; bf16_t* HID; bf16_t* Y; float* OB; float* ORAW; float* X; bf16_t* XB;
};
DEV int otid() { int t = threadIdx.x; asm volatile("" : "+v"(t)); return t; }
DEV int obid() { int t = blockIdx.x; asm volatile("" : "+s"(t)); return t; }
DEV V make_views(const P& p) {
    V v; size_t woff = 0; asm volatile("" : "+s"(woff)); unsigned char* w = p.ws + woff;
    v.ctl = (unsigned*)(w + WS_CTL); v.mod = (float*)(w + WS_MOD); v.rcos = (float*)(w + WS_ROPE); v.rsin = v.rcos + S * 8;
    v.cumf = (float*)(w + WS_CUMF); v.ck = (bf16_t*)(w + WS_CK); v.cv = (bf16_t*)(w + WS_CV); v.imp = (float*)(w + WS_IMP);
    v.sel = (unsigned*)(w + WS_SEL); v.eid = (int*)(w + WS_EID); v.wts = (float*)(w + WS_WTS); v.list = (int*)(w + WS_LIST);
    v.gf = (float*)(w + WS_GF); v.H = (bf16_t*)(w + WS_H); v.U = (bf16_t*)(w + WS_U); v.O = (bf16_t*)(w + WS_O);
    v.HID = (bf16_t*)(w + WS_HID); v.Y = (bf16_t*)(w + WS_Y); v.OB = (float*)(w + WS_OB); v.ORAW = (float*)(w + WS_ORAW); v.X = p.out; v.XB = (bf16_t*)(w + WS_ORAW);
    return v;
}

DEV void ph_prologue(const P& p, float* lds) {
    const V v = make_views(p); const int TIDX = otid(), BIDX = obid();
    const int tid = TIDX;
    for (int i = tid; i < NB * D; i += 256) { const float c = p.c[i]; lds[i] = c / (1.f + expf(-c)); }
    __syncthreads();
    float* red = lds + NB * D;
    const int c4 = tid & 15, ks = tid >> 4;
    for (int unit = BIDX; unit < DEPTH * 96; unit += gridDim.x) {
        const int l = unit / 96, n0 = (unit % 96) * 64;
        const float* W = p.ada_w + (size_t)l * D * 6144 + n0 + 4 * c4;
        float acc[8][4];
#pragma unroll
        for (int b = 0; b < 8; ++b)
#pragma unroll
            for (int q = 0; q < 4; ++q) acc[b][q] = 0.f;
#pragma unroll 1
        for (int i0 = 0; i0 < 64; i0 += 8) {
            f32x4v w[8];
#pragma unroll
            for (int i = 0; i < 8; ++i) w[i] = __builtin_nontemporal_load((const f32x4v*)(W + (size_t)(ks + 16 * (i0 + i)) * 6144));
#pragma unroll
            for (int i = 0; i < 8; ++i) {
                const int k = ks + 16 * (i0 + i);
#pragma unroll
                for (int b = 0; b < 8; ++b) {
                    const float cv = lds[b * D + k];
                    acc[b][0] += cv * w[i].x; acc[b][1] += cv * w[i].y; acc[b][2] += cv * w[i].z; acc[b][3] += cv * w[i].w;
                }
            }
        }
#pragma unroll
        for (int b = 0; b < 8; ++b) *(float4*)(red + (ks * 8 + b) * 64 + 4 * c4) = make_float4(acc[b][0], acc[b][1], acc[b][2], acc[b][3]);
        __syncthreads();
        for (int o = tid; o < 512; o += 256) {
            const int c2 = o & 63, b = o >> 6;
            float sm = p.ada_b[l * 6144 + n0 + c2];
#pragma unroll
            for (int q = 0; q < 16; ++q) sm += red[(q * 8 + b) * 64 + c2];
            v.mod[(size_t)(l * 8 + b) * 6144 + n0 + c2] = sm;
        }
        __syncthreads();
    }
    const float cst = -2.0f * 13.122363377404328f / 16.0f;
    for (int i = ((int)gridDim.x - 1 - BIDX) * 256 + tid; i < S * 8; i += gridDim.x * 256) {
        const int s = i >> 3, j = i & 7;
        const float inv = expf((float)j * cst);
        const float ang = (float)s * inv;
        v.rcos[i] = cosf(ang); v.rsin[i] = sinf(ang);
    }
}

DEV void ph_norm1(const P& p, int l, int mode) {
    const V v = make_views(p); const int TIDX = otid(), BIDX = obid();
    const int lane = TIDX & 63;
    const int gw = (BIDX * 256 + TIDX) >> 6, nw = gridDim.x * 4;
    for (int m0 = gw; m0 < T; m0 += 2 * nw) {
        float4 xv[2][4];
        if (mode == 0) {
#pragma unroll
            for (int rr = 0; rr < 2; ++rr)
#pragma unroll
                for (int j = 0; j < 4; ++j) xv[rr][j] = *(const float4*)(p.x + (size_t)(m0 + rr * nw) * D + 4 * lane + 256 * j);
        } else {
            ushort4 xa[2][4], ya[2][4], yb[2][4];
#pragma unroll
            for (int rr = 0; rr < 2; ++rr)
#pragma unroll
                for (int j = 0; j < 4; ++j) {
                    const int m = m0 + rr * nw, c = 4 * lane + 256 * j;
                    xa[rr][j] = *(const ushort4*)(v.XB + (size_t)m * D + c);
                    ya[rr][j] = *(const ushort4*)(v.Y + (size_t)(2 * m) * D + c); yb[rr][j] = *(const ushort4*)(v.Y + (size_t)(2 * m + 1) * D + c);
                }
#pragma unroll
            for (int rr = 0; rr < 2; ++rr) {
                const float* g2 = v.mod + (size_t)((l - 1) * 8 + ((m0 + rr * nw) >> 11)) * 6144 + 5 * D;
#pragma unroll
                for (int j = 0; j < 4; ++j) {
                    const float4 g = *(const float4*)(g2 + 4 * lane + 256 * j);
                    float4 a = make_float4(bf2f(xa[rr][j].x), bf2f(xa[rr][j].y), bf2f(xa[rr][j].z), bf2f(xa[rr][j].w));
                    a.x += g.x * (bf2f(ya[rr][j].x) + bf2f(yb[rr][j].x)); a.y += g.y * (bf2f(ya[rr][j].y) + bf2f(yb[rr][j].y));
                    a.z += g.z * (bf2f(ya[rr][j].z) + bf2f(yb[rr][j].z)); a.w += g.w * (bf2f(ya[rr][j].w) + bf2f(yb[rr][j].w));
                    xv[rr][j] = a;
                }
            }
        }
        float ss[2];
#pragma unroll
        for (int rr = 0; rr < 2; ++rr) {
            ss[rr] = 0.f;
#pragma unroll
            for (int j = 0; j < 4; ++j) ss[rr] += xv[rr][j].x * xv[rr][j].x + xv[rr][j].y * xv[rr][j].y + xv[rr][j].z * xv[rr][j].z + xv[rr][j].w * xv[rr][j].w;
        }
#pragma unroll
        for (int o = 1; o < 64; o <<= 1) { ss[0] += __shfl_xor(ss[0], o); ss[1] += __shfl_xor(ss[1], o); }
#pragma unroll
        for (int rr = 0; rr < 2; ++rr) {
            const int m = m0 + rr * nw, b = m >> 11;
            const float r = rsqrtf(ss[rr] * (1.f / D) + EPS);
            if (mode == 2) {
#pragma unroll
                for (int j = 0; j < 4; ++j) {
                    const int c = 4 * lane + 256 * j;
                    const float4 g = *(const float4*)(p.final_g + c);
                    float4 o; o.x = xv[rr][j].x * r * g.x; o.y = xv[rr][j].y * r * g.y; o.z = xv[rr][j].z * r * g.z; o.w = xv[rr][j].w * r * g.w;
                    *(float4*)(v.X + (size_t)m * D + c) = o;
                }
            } else {
                const float* md = v.mod + (size_t)(l * 8 + b) * 6144;
#pragma unroll
                for (int j = 0; j < 4; ++j) {
                    const int c = 4 * lane + 256 * j;
                    { uint2 xo; xo.x = cvtpk(xv[rr][j].x, xv[rr][j].y); xo.y = cvtpk(xv[rr][j].z, xv[rr][j].w); *(uint2*)(v.XB + (size_t)m * D + c) = xo; }
                    const float4 g = *(const float4*)(p.norm1_g + l * D + c), sh = *(const float4*)(md + c), sc = *(const float4*)(md + D + c);
                    uint2 o;
                    o.x = cvtpk(xv[rr][j].x * r * g.x * (1.f + sc.x) + sh.x, xv[rr][j].y * r * g.y * (1.f + sc.y) + sh.y);
                    o.y = cvtpk(xv[rr][j].z * r * g.z * (1.f + sc.z) + sh.z, xv[rr][j].w * r * g.w * (1.f + sc.w) + sh.w);
                    *(uint2*)(v.H + (size_t)m * D + c) = o;
                }
            }
        }
    }
}

typedef short bf16x8 __attribute__((ext_vector_type(8)));
typedef float f32x16 __attribute__((ext_vector_type(16)));
typedef unsigned u32x4 __attribute__((ext_vector_type(4)));
constexpr size_t WS_WIN = 512 * MiB, WS_WOT = 544 * MiB, WS_W13 = 552 * MiB, WS_W2 = 808 * MiB;
constexpr int NPW = 2944;
DEV int tile_off(int row, int chunk) { return row * 128 + ((chunk ^ ((row >> 1) & 7)) << 4); }
template <class RM>
DEV void conv_patch(const float* src, int N, int K, bf16_t* dst, int k0, int n0, RM rowmap, int lane) {
    const int kg = lane >> 3, n = n0 + 4 * (lane & 7);
    if (n >= N) return;
    const float* sp = src + (size_t)(k0 + 8 * kg) * N + n;
    f32x4v x[8];
#pragma unroll
    for (int j = 0; j < 8; ++j) x[j] = __builtin_nontemporal_load((const f32x4v*)(sp + (size_t)j * N));
    bf16_t* dp = dst + k0 + 8 * kg;
    u32x4 o;
    o.x = cvtpk(x[0].x, x[1].x); o.y = cvtpk(x[2].x, x[3].x); o.z = cvtpk(x[4].x, x[5].x); o.w = cvtpk(x[6].x, x[7].x);
    *(u32x4*)(dp + (size_t)rowmap(n) * K) = o;
    o.x = cvtpk(x[0].y, x[1].y); o.y = cvtpk(x[2].y, x[3].y); o.z = cvtpk(x[4].y, x[5].y); o.w = cvtpk(x[6].y, x[7].y);
    *(u32x4*)(dp + (size_t)rowmap(n + 1) * K) = o;
    o.x = cvtpk(x[0].z, x[1].z); o.y = cvtpk(x[2].z, x[3].z); o.z = cvtpk(x[4].z, x[5].z); o.w = cvtpk(x[6].z, x[7].z);
    *(u32x4*)(dp + (size_t)rowmap(n + 2) * K) = o;
    o.x = cvtpk(x[0].w, x[1].w); o.y = cvtpk(x[2].w, x[3].w); o.z = cvtpk(x[4].w, x[5].w); o.w = cvtpk(x[6].w, x[7].w);
    *(u32x4*)(dp + (size_t)rowmap(n + 3) * K) = o;
}

DEV void conv8(const float* s0, const float* s1, bf16_t* dst) {
    f32x4v a = {0.f, 0.f, 0.f, 0.f}, b = {0.f, 0.f, 0.f, 0.f};
    if (s0) a = __builtin_nontemporal_load((const f32x4v*)s0);
    if (s1) b = __builtin_nontemporal_load((const f32x4v*)s1);
    u32x4 o; o.x = cvtpk(a[0], a[1]); o.y = cvtpk(a[2], a[3]); o.z = cvtpk(b[0], b[1]); o.w = cvtpk(b[2], b[3]);
    *(u32x4*)dst = o;
}
DEV void ph_convert_dense(const P& p, int l, int which) {
    const int TIDX = otid(), BIDX = obid();
    size_t woff = 0; asm volatile("" : "+s"(woff)); unsigned char* w = p.ws + woff;
    const size_t gtid = (size_t)BIDX * 256 + TIDX, gsz = (size_t)gridDim.x * 256;
    if (which == 0) {
        bf16_t* win = (bf16_t*)(w + WS_WIN);
        for (size_t i = gtid; i < (size_t)D * 368; i += gsz) {
            const int g8 = (int)(i % 368); const size_t lk = (size_t)l * D + i / 368;
            const int n = g8 * 8;
            const float* row = p.w_in + lk * DIN;
            const float *s0, *s1;
            if (n < 2816) { const int oc = n + (n >= 2048 ? 28 : (n >= 1280 ? 24 : 0)); s0 = row + oc; s1 = row + oc + 4; }
            else if (n < 2840) { s0 = row + 1280 + (n - 2816); s1 = s0 + 4; }
            else if (n == 2840) { s0 = row + 2072; s1 = nullptr; }
            else { s0 = nullptr; s1 = nullptr; }
            conv8(s0, s1, win + lk * NPW + n);
        }
    } else {
        bf16_t* wot = (bf16_t*)(w + WS_WOT);
        const size_t oo = (size_t)l * D * D;
        for (size_t i = gtid; i < (size_t)D * D / 8; i += gsz) conv8(p.w_out + oo + i * 8, p.w_out + oo + i * 8 + 4, wot + oo + i * 8);
        for (size_t i = gtid; i < (size_t)2 * 2048 * 128 / 8; i += gsz) {
            const size_t per = (size_t)2048 * 128 / 8; const int kv = (int)(i / per), lk = l * 2 + kv; const size_t off = (i % per) * 8;
            const float* src = (kv ? p.cmp_w1_v : p.cmp_w1_k) + (size_t)l * 2048 * 128 + off;
            conv8(src, src + 4, (bf16_t*)(w + WS_CW1) + (size_t)lk * 2048 * 128 + off);
        }
    }
}
DEV void ph_convert_experts(const P& p, int l) {
    const int TIDX = otid(), BIDX = obid();
    size_t woff = 0; asm volatile("" : "+s"(woff)); unsigned char* w = p.ws + woff;
    bf16_t* w13 = (bf16_t*)(w + WS_W13); bf16_t* w2t = (bf16_t*)(w + WS_W2);
    const size_t gtid = (size_t)BIDX * 256 + TIDX, gsz = (size_t)gridDim.x * 256;
    {
        const size_t N13 = (size_t)32 * D * 128;
#pragma unroll 1
        for (size_t i0 = gtid; i0 < N13; i0 += 8 * gsz) {
            f32x4v a[8], b[8];
#pragma unroll
            for (int k = 0; k < 8; ++k) {
                const size_t i = i0 + (size_t)k * gsz;
                if (i < N13) {
                    const int g8 = (int)(i & 127); const size_t lek = (size_t)l * 32 * D + (i >> 7);
                    const int n = g8 * 8, which = (n >> 5) & 1, c = 32 * (n >> 6) + (n & 31);
                    const float* s = (which ? p.e_w3 : p.e_w1) + lek * 512 + c;
                    a[k] = __builtin_nontemporal_load((const f32x4v*)s); b[k] = __builtin_nontemporal_load((const f32x4v*)(s + 4));
                }
            }
#pragma unroll
            for (int k = 0; k < 8; ++k) {
                const size_t i = i0 + (size_t)k * gsz;
                if (i < N13) {
                    const int g8 = (int)(i & 127); const size_t lek = (size_t)l * 32 * D + (i >> 7);
                    u32x4 o; o.x = cvtpk(a[k][0], a[k][1]); o.y = cvtpk(a[k][2], a[k][3]); o.z = cvtpk(b[k][0], b[k][1]); o.w = cvtpk(b[k][2], b[k][3]);
                    *(u32x4*)(w13 + lek * 1024 + g8 * 8) = o;
                }
            }
        }
    }
    {
        const size_t o2 = (size_t)l * 32 * 512 * D, N2 = (size_t)32 * 512 * D / 8;
#pragma unroll 1
        for (size_t i0 = gtid; i0 < N2; i0 += 8 * gsz) {
            f32x4v a[8], b[8];
#pragma unroll
            for (int k = 0; k < 8; ++k) {
                const size_t i = i0 + (size_t)k * gsz;
                if (i < N2) { const float* s = p.e_w2 + o2 + i * 8; a[k] = __builtin_nontemporal_load((const f32x4v*)s); b[k] = __builtin_nontemporal_load((const f32x4v*)(s + 4)); }
            }
#pragma unroll
            for (int k = 0; k < 8; ++k) {
                const size_t i = i0 + (size_t)k * gsz;
                if (i < N2) {
                    u32x4 o; o.x = cvtpk(a[k][0], a[k][1]); o.y = cvtpk(a[k][2], a[k][3]); o.z = cvtpk(b[k][0], b[k][1]); o.w = cvtpk(b[k][2], b[k][3]);
                    *(u32x4*)(w2t + o2 + i * 8) = o;
                }
            }
        }
    }
}
DEV void ph_convert(const P& p, float* lds) {
    const int TIDX = otid(), BIDX = obid();
    size_t woff = 0; asm volatile("" : "+s"(woff)); unsigned char* w = p.ws + woff;
    const int lane = TIDX & 63;
    for (int unit = BIDX * 4 + (TIDX >> 6); unit < DEPTH * 2 * 4; unit += gridDim.x * 4) {
        const int lk = unit >> 2, t = unit & 3, l = lk >> 1, kv = lk & 1;
        conv_patch((kv ? p.cmp_w2_v : p.cmp_w2_k) + (size_t)l * 128 * 64, 64, 128, (bf16_t*)(w + WS_CW2) + (size_t)lk * 64 * 128, (t >> 1) * 64, (t & 1) * 32, [](int n) { return n; }, lane);
    }
    for (int o = BIDX * 256 + TIDX; o < DEPTH * 64 * D; o += gridDim.x * 256) {
        const int k = o & (D - 1), n = (o >> 10) & 63, l = o >> 16;
        const float val = n < 4 ? p.rg_w[((size_t)l * D + k) * 4 + n] : (n < 36 ? p.re_w[((size_t)l * D + k) * 32 + n - 4] : 0.f);
        const bf16_t hi = f2bf(val); const bf16_t lo = f2bf(val - bf2f(hi));
        bf16_t* wr = (bf16_t*)(w + WS_WR) + (size_t)l * 2 * 64 * D;
        wr[n * D + k] = hi; wr[64 * D + n * D + k] = lo;
    }
    int pu = (int)gridDim.x - 1 - BIDX - 64; if (pu < 0) pu += gridDim.x;
    for (int unit = pu; unit < DEPTH * 2 * 8; unit += gridDim.x) {
        const int lk = unit >> 3, ch = unit & 7, l = lk >> 1, kv = lk & 1, j = TIDX & 127, hf = TIDX >> 7;
        const float* pe = (kv ? p.cmp_pos_v : p.cmp_pos_k) + (size_t)l * 2048 + ch * 256 + hf * 128;
        const float* w1 = (kv ? p.cmp_w1_v : p.cmp_w1_k) + (size_t)l * 2048 * 128 + (size_t)(ch * 256 + hf * 128) * 128 + j;
        float a0 = 0.f, a1 = 0.f, a2 = 0.f, a3 = 0.f;
#pragma unroll 1
        for (int k0 = 0; k0 < 128; k0 += 32) {
            float wv[32];
#pragma unroll
            for (int k = 0; k < 32; ++k) wv[k] = w1[(size_t)(k0 + k) * 128];
#pragma unroll
            for (int k = 0; k < 32; k += 4) {
                a0 += pe[k0 + k] * wv[k]; a1 += pe[k0 + k + 1] * wv[k + 1];
                a2 += pe[k0 + k + 2] * wv[k + 2]; a3 += pe[k0 + k + 3] * wv[k + 3];
            }
        }
        const float a = (a0 + a1) + (a2 + a3);
        __syncthreads();
        if (hf) lds[j] = a;
        __syncthreads();
        if (!hf) ((float*)(w + WS_CPB))[(lk * 8 + ch) * 128 + j] = a + lds[j];
    }
}

typedef short v4i16_t __attribute__((ext_vector_type(4)));
DEV void gemm_issue0(unsigned char* lds, const bf16_t* const (&arow)[4], const bf16_t* Bsrc, const size_t ldb, const int TIDX) {
    const int lane = TIDX & 63, wave = TIDX >> 6;
    const int gsw = ((TIDX & 7) ^ ((TIDX >> 4) & 7)) * 8;
    const bf16_t* bg = Bsrc + (size_t)(4 * wave + (lane >> 4)) * ldb + ((lane & 15) ^ (((lane >> 4) << 2) | (wave & 3))) * 8;
    LAS unsigned char* l3 = (LAS unsigned char*)lds + __builtin_amdgcn_readfirstlane(wave) * 1024;
#pragma unroll
    for (int i = 0; i < 4; ++i) {
        __builtin_amdgcn_global_load_lds((const unsigned*)(arow[i] + gsw), (LAS unsigned*)(l3 + i * 4096), 16, 0, 0);
        __builtin_amdgcn_global_load_lds((const unsigned*)(bg + (size_t)(16 * i) * ldb), (LAS unsigned*)(l3 + 16384 + i * 4096), 16, 0, 0);
    }
}
template <bool SWAP, bool PRE = false>
DEV void gemm128(unsigned char* lds, const bf16_t* const (&arow)[4], const bf16_t* Bsrc, const size_t ldb, int K, f32x16 (&acc)[2][2], const int TIDX, const int astride = 64) {
    const int lane = TIDX & 63, wave = TIDX >> 6, wm = wave >> 1, wn = wave & 1, r = lane & 31, h = lane >> 5;
#pragma unroll
    for (int j = 0; j < 2; ++j)
#pragma unroll
        for (int i = 0; i < 2; ++i)
#pragma unroll
            for (int q = 0; q < 16; ++q) acc[j][i][q] = 0.f;
    const int gsw = ((TIDX & 7) ^ ((TIDX >> 4) & 7)) * 8;
    const bf16_t* ag[4];
#pragma unroll
    for (int i = 0; i < 4; ++i) ag[i] = arow[i] + gsw;
    const int brow = 4 * wave + (lane >> 4), bch = ((lane & 15) ^ (((lane >> 4) << 2) | (wave & 3))) * 8;
    const bf16_t* bg = Bsrc + (size_t)brow * ldb + bch;
    LAS unsigned char* l3 = (LAS unsigned char*)lds + __builtin_amdgcn_readfirstlane(wave) * 1024;
    LAS unsigned char* tb[2][2];
    {
        const int blk = (lane >> 4) & 1, q = (lane & 15) >> 2, pp = lane & 3;
#pragma unroll
        for (int j = 0; j < 2; ++j)
#pragma unroll
            for (int t = 0; t < 2; ++t) {
                const int row = 4 * t + 8 * h + q, ch = 4 * (2 * wn + j) + 2 * blk + (pp >> 1);
                tb[j][t] = (LAS unsigned char*)lds + 16384 + 256 * row + 16 * (ch ^ (((row & 3) << 2) | ((row >> 2) & 3))) + 8 * (pp & 1);
            }
    }
#define G_DMA(st_, kt_) do { _Pragma("unroll") for (int i = 0; i < 4; ++i) { \
        __builtin_amdgcn_global_load_lds((const unsigned*)(ag[i] + (size_t)(kt_) * astride), (LAS unsigned*)(l3 + (st_) + i * 4096), 16, 0, 0); \
        __builtin_amdgcn_global_load_lds((const unsigned*)(bg + ((size_t)(kt_) * 64 + 16 * i) * ldb), (LAS unsigned*)(l3 + (st_) + 16384 + i * 4096), 16, 0, 0); } } while (0)
    const int KT = K >> 6;
    if (!PRE) {
        __syncthreads();
        G_DMA(0, 0);
    }
    for (int kt = 0; kt < KT; ++kt) {
        asm volatile("s_waitcnt vmcnt(0) lgkmcnt(0)" ::: "memory");
        __builtin_amdgcn_s_barrier();
        asm volatile("" ::: "memory");
        if (kt + 1 < KT) G_DMA(((kt + 1) & 1) * 32768, kt + 1);
        const int so = (kt & 1) * 32768;
        const unsigned char* cur = lds + so;
#pragma unroll
        for (int kk = 0; kk < 4; ++kk) {
            bf16x8 af[2], wf[2];
#pragma unroll
            for (int i = 0; i < 2; ++i) af[i] = *(const bf16x8*)(cur + tile_off(64 * wm + 32 * i + r, 2 * kk + h));
#pragma unroll
            for (int j = 0; j < 2; ++j) {
                const v4i16_t lo = __builtin_amdgcn_ds_read_tr16_b64_v4i16((LAS v4i16_t*)(tb[j][0] + so + 4096 * kk));
                const v4i16_t hi = __builtin_amdgcn_ds_read_tr16_b64_v4i16((LAS v4i16_t*)(tb[j][1] + so + 4096 * kk));
                wf[j] = (bf16x8){lo[0], lo[1], lo[2], lo[3], hi[0], hi[1], hi[2], hi[3]};
            }
#pragma unroll
            for (int j = 0; j < 2; ++j)
#pragma unroll
                for (int i = 0; i < 2; ++i) acc[j][i] = SWAP ? __builtin_amdgcn_mfma_f32_32x32x16_bf16(af[i], wf[j], acc[j][i], 0, 0, 0)
                                                             : __builtin_amdgcn_mfma_f32_32x32x16_bf16(wf[j], af[i], acc[j][i], 0, 0, 0);
        }
    }
    __syncthreads();
#undef G_DMA
}

constexpr int CST = 272;
DEV void ctile_put(unsigned char* lds, int row, int col, float a, float b, float c, float d) {
    uint2 u; u.x = cvtpk(a, b); u.y = cvtpk(c, d);
    *(uint2*)(lds + row * CST + col * 2) = u;
}
template <int COLS, class RP>
DEV void ctile_flush(unsigned char* lds, const int TIDX, RP rowptr) {
    asm volatile("s_waitcnt lgkmcnt(0)" ::: "memory");
    __builtin_amdgcn_s_barrier();
    asm volatile("" ::: "memory");
    constexpr int CPR = COLS / 8, RPI = 256 / CPR;
#pragma unroll
    for (int it = 0; it < 128 / RPI; ++it) {
        const int row = it * RPI + TIDX / CPR, c16 = TIDX % CPR;
        bf16_t* dst = rowptr(row, it);
        const u32x4 val = *(const u32x4*)(lds + row * CST + c16 * 16);
        if (dst) *(u32x4*)(dst + c16 * 8) = val;
    }
}

DEV void ph_inproj_fast(const P& p, int l, unsigned char* lds) {
    const V v = make_views(p); const int TIDX = otid(), BIDX = obid();
    const bf16_t* W = (const bf16_t*)(p.ws + WS_WIN) + (size_t)l * D * NPW;
    const int lane = TIDX & 63, wave = TIDX >> 6, wm = wave >> 1, wn = wave & 1, r = lane & 31, h = lane >> 5;
    const bool xo = gridDim.x == 512;
    unsigned char* ct = lds + 32768;
    auto decode = [&](int it, int& mt, int& nt) -> int {
        if (xo) { if (it >= 6) return -1; const int lb = BIDX >> 3; nt = 8 * (it % 3) + (lb >> 3); mt = 16 * (BIDX & 7) + 8 * (it / 3) + (lb & 7); return nt < 23 ? 1 : 0; }
        const int unit = BIDX + it * (int)gridDim.x; if (unit >= 128 * 23) return -1; nt = unit / 128; mt = unit % 128; return 1;
    };
    auto issue = [&](int mt, int nt) {
        const bf16_t* ar[4];
#pragma unroll
        for (int i = 0; i < 4; ++i) ar[i] = v.H + (size_t)(mt * 128 + (TIDX >> 3) + 32 * i) * D;
        gemm_issue0(lds, ar, W + nt * 128, NPW, TIDX);
    };
    bool pre = false;
    for (int it = 0;; ++it) {
        int nt, mt;
        const int dv = decode(it, mt, nt);
        if (dv < 0) break;
        if (dv == 0) continue;
        const int m0 = mt * 128, n0 = nt * 128;
        const bf16_t* arow[4];
#pragma unroll
        for (int i = 0; i < 4; ++i) arow[i] = v.H + (size_t)(m0 + (TIDX >> 3) + 32 * i) * D;
        if (!pre) { __syncthreads(); issue(mt, nt); pre = true; }
        int itn = it + 1, mtn = 0, ntn = 0, dn;
        while ((dn = decode(itn, mtn, ntn)) == 0) ++itn;
        f32x16 acc[2][2];
        if (is_vcol(n0)) {
            gemm128<true, true>(lds, arow, W + n0, NPW, D, acc, TIDX);
            if (dn > 0) issue(mtn, ntn); else pre = false;
#pragma unroll
            for (int j = 0; j < 2; ++j)
#pragma unroll
                for (int i = 0; i < 2; ++i)
#pragma unroll
                    for (int g = 0; g < 4; ++g)
                        ctile_put(ct, 64 * wn + 32 * j + r, 64 * wm + 32 * i + 8 * g + 4 * h, acc[j][i][4 * g], acc[j][i][4 * g + 1], acc[j][i][4 * g + 2], acc[j][i][4 * g + 3]);
            bf16_t* vt = (bf16_t*)(p.ws + WS_VT) + ((size_t)(m0 >> 11) * 768 + vt_row(n0)) * S + (m0 & (S - 1));
            ctile_flush<128>(ct, TIDX, [&](int row, int) { return vt + (size_t)row * S; });
            continue;
        }
        const bool rope_tile = n0 < 512 || n0 == C_KS || n0 == C_KW;
        f32x4v rcs[2], rsn[2];
        if (rope_tile) {
#pragma unroll
            for (int i = 0; i < 2; ++i) {
                const int sp = (m0 + 64 * wm + 32 * i + r) & (S - 1);
                rcs[i] = *(const f32x4v*)(v.rcos + sp * 8 + 4 * h); rsn[i] = *(const f32x4v*)(v.rsin + sp * 8 + 4 * h);
            }
        }
        gemm128<false, true>(lds, arow, W + n0, NPW, D, acc, TIDX);
        if (dn > 0) issue(mtn, ntn); else pre = false;
        if (n0 == 2816) {
            if (wn == 0) {
#pragma unroll
                for (int i = 0; i < 2; ++i) {
                    const int m = m0 + 64 * wm + 32 * i + r;
#pragma unroll
                    for (int q = 0; q < 16; ++q) {
                        const int cc = (q & 3) + 8 * (q >> 2) + 4 * h;
                        if (cc < 24) v.gf[(size_t)m * 32 + cc] = acc[0][i][q];
                        else if (cc < 28) ((float*)(p.ws + WS_LSF))[(size_t)((m >> 11) * 4 + cc - 24) * S + (m & (S - 1))] = logsigmoidf_(acc[0][i][q] + p.b_forget[l * 4 + cc - 24]);
                    }
                }
            }
            continue;
        }
        if (n0 == C_KB || n0 == C_KB + 128) {
            float mx = 0.f;
#pragma unroll
            for (int i = 0; i < 2; ++i) {
                float s2 = 0.f;
#pragma unroll
                for (int j = 0; j < 2; ++j)
#pragma unroll
                    for (int q = 0; q < 16; ++q) s2 += acc[j][i][q] * acc[j][i][q];
                s2 += __shfl_xor(s2, 32);
                mx = fmaxf(mx, s2);
            }
#pragma unroll
            for (int o = 1; o < 32; o <<= 1) mx = fmaxf(mx, __shfl_xor(mx, o));
            if (lane == 0) atomicMax(v.ctl + CW_KN + (l * 8 + (m0 >> 11)) * 4 + ((n0 - C_KB) >> 6) + wn, __float_as_uint(mx));
        }
#pragma unroll
        for (int j = 0; j < 2; ++j) {
            const int nb = n0 + 64 * wn + 32 * j;
            const bool rope = ((nb & 63) == 0) && (nb < 512 || (nb >= C_KS && nb < C_VS) || (nb >= C_KW && nb < C_VW));
#pragma unroll
            for (int i = 0; i < 2; ++i) {
                f32x16 a = acc[j][i];
                if (rope) {
#pragma unroll
                    for (int q = 0; q < 4; ++q) { const float x1 = a[q], x2 = a[q + 4]; a[q] = x1 * rcs[i][q] - x2 * rsn[i][q]; a[q + 4] = x2 * rcs[i][q] + x1 * rsn[i][q]; }
                }
#pragma unroll
                for (int g = 0; g < 4; ++g) ctile_put(ct, 64 * wm + 32 * i + r, 64 * wn + 32 * j + 8 * g + 4 * h, a[4 * g], a[4 * g + 1], a[4 * g + 2], a[4 * g + 3]);
            }
        }
        bf16_t* ub = v.U + (size_t)m0 * NP + n0;
        ctile_flush<128>(ct, TIDX, [&](int row, int) { return ub + (size_t)row * NP; });
    }
}

DEV void ph_outproj_fast(const P& p, int l, unsigned char* lds) {
    const V v = make_views(p); const int TIDX = otid(), BIDX = obid();
    const bf16_t* W = (const bf16_t*)(p.ws + WS_WOT) + (size_t)l * D * D;
    const int lane = TIDX & 63, wave = TIDX >> 6, wm = wave >> 1, wn = wave & 1, r = lane & 31, h = lane >> 5;
    const bool xo = gridDim.x == 512;
    unsigned char* ct = lds + 32768;
    auto decode = [&](int it, int& mt, int& nt) -> bool {
        if (xo) { if (it >= 2) return false; const int lb = BIDX >> 3; nt = lb >> 3; mt = 16 * (BIDX & 7) + 8 * it + (lb & 7); return true; }
        const int unit = BIDX + it * (int)gridDim.x; if (unit >= 128 * 8) return false; nt = unit / 128; mt = unit % 128; return true;
    };
    auto issue = [&](int mt, int nt) {
        const bf16_t* ar[4];
#pragma unroll
        for (int i = 0; i < 4; ++i) ar[i] = v.O + (size_t)(mt * 128 + (TIDX >> 3) + 32 * i) * D;
        gemm_issue0(lds, ar, W + nt * 128, D, TIDX);
    };
    for (int it = 0;; ++it) {
        int nt, mt, ntn = 0, mtn = 0;
        if (!decode(it, mt, nt)) break;
        const bool hasn = decode(it + 1, mtn, ntn);
        const int m0 = mt * 128, n0 = nt * 128;
        const bf16_t* arow[4];
#pragma unroll
        for (int i = 0; i < 4; ++i) arow[i] = v.O + (size_t)(m0 + (TIDX >> 3) + 32 * i) * D;
        if (it == 0) { __syncthreads(); issue(mt, nt); }
        u32x4 xin[8];
#pragma unroll
        for (int it = 0; it < 8; ++it) xin[it] = *(const u32x4*)(v.XB + (size_t)(m0 + it * 16 + (TIDX >> 4)) * D + n0 + (TIDX & 15) * 8);
        f32x16 acc[2][2];
        gemm128<false, true>(lds, arow, W + n0, D, D, acc, TIDX);
        if (hasn) issue(mtn, ntn);
        const float* g1 = v.mod + (size_t)(l * 8 + (m0 >> 11)) * 6144 + 2 * D;
#pragma unroll
        for (int j = 0; j < 2; ++j)
#pragma unroll
            for (int i = 0; i < 2; ++i) {
                const int nb = n0 + 64 * wn + 32 * j + 4 * h;
#pragma unroll
                for (int g = 0; g < 4; ++g) {
                    const float4 gg = *(const float4*)(g1 + nb + 8 * g);
                    ctile_put(ct, 64 * wm + 32 * i + r, 64 * wn + 32 * j + 8 * g + 4 * h, gg.x * acc[j][i][4 * g], gg.y * acc[j][i][4 * g + 1], gg.z * acc[j][i][4 * g + 2], gg.w * acc[j][i][4 * g + 3]);
                }
            }
        asm volatile("s_waitcnt lgkmcnt(0)" ::: "memory");
        __builtin_amdgcn_s_barrier();
        asm volatile("" ::: "memory");
#pragma unroll
        for (int it = 0; it < 8; ++it) {
            const int row = it * 16 + (TIDX >> 4);
            const u32x4 uv = *(const u32x4*)(ct + row * CST + (TIDX & 15) * 16);
            u32x4 xn;
#pragma unroll
            for (int q = 0; q < 4; ++q)
                xn[q] = cvtpk(__uint_as_float(xin[it][q] << 16) + __uint_as_float(uv[q] << 16), __uint_as_float(xin[it][q] & 0xffff0000u) + __uint_as_float(uv[q] & 0xffff0000u));
            *(u32x4*)(v.XB + (size_t)(m0 + row) * D + n0 + (TIDX & 15) * 8) = xn;
        }
    }
}

DEV void ph_moe_up_fast(const P& p, int l, unsigned char* lds) {
    const V v = make_views(p); const int TIDX = otid(), BIDX = obid();
    const int lane = TIDX & 63, wave = TIDX >> 6, wm = wave >> 1, wn = wave & 1, r = lane & 31, h = lane >> 5;
    const unsigned* cnt = v.ctl + CW_CNT + l * 32 * 64;
    int* tp = (int*)(lds + 67584); int* rb = tp + 40;
    __syncthreads();
    if (TIDX < 64) {
        const int c = TIDX < 32 ? (int)cnt[TIDX * 64] : 0;
        int nu = ((c + 127) >> 7) * 8, cc = c;
#pragma unroll
        for (int o = 1; o < 32; o <<= 1) { const int a = __shfl_up(nu, o), b2 = __shfl_up(cc, o); if ((TIDX & 31) >= o) { nu += a; cc += b2; } }
        if (TIDX < 32) { tp[TIDX + 1] = nu; rb[TIDX + 1] = cc; if (TIDX == 0) { tp[0] = 0; rb[0] = 0; } }
    }
    __syncthreads();
    const int total = tp[32];
    unsigned char* ct = lds + 32768;
    struct UU { int e, base, nt, mt, nrow; const int* lst; const bf16_t* B; const bf16_t* ar[4]; };
    auto setup = [&](int unit, UU& u) {
        int e = 0;
#pragma unroll
        for (int st = 16; st > 0; st >>= 1) if (tp[e + st] <= unit) e += st;
        const int rem = unit - tp[e];
        u.e = e; u.base = rb[e]; u.nt = rem & 7; u.mt = rem >> 3;
        const int ce = rb[e + 1] - u.base;
        u.lst = v.list + (size_t)e * T + u.mt * 128;
        u.nrow = ce - u.mt * 128 < 128 ? ce - u.mt * 128 : 128;
        u.B = (const bf16_t*)(p.ws + WS_W13) + ((size_t)l * 32 + e) * 1024 * D + u.nt * 128;
#pragma unroll
        for (int i = 0; i < 4; ++i) { const int rr = (TIDX >> 3) + 32 * i; u.ar[i] = v.H + (size_t)(u.lst[rr < u.nrow ? rr : 0] >> 1) * D; }
    };
    int unit = BIDX;
    if (unit >= total) return;
    UU cu, nu;
    setup(unit, cu);
    __syncthreads();
    gemm_issue0(lds, cu.ar, cu.B, 1024, TIDX);
    for (;;) {
        const int un = unit + (int)gridDim.x;
        f32x16 acc[2][2];
        gemm128<false, true>(lds, cu.ar, cu.B, 1024, D, acc, TIDX);
        if (un < total) { setup(un, nu); gemm_issue0(lds, nu.ar, nu.B, 1024, TIDX); }
#pragma unroll
        for (int i = 0; i < 2; ++i)
#pragma unroll
            for (int g = 0; g < 4; ++g) {
                float o[4];
#pragma unroll
                for (int q = 0; q < 4; ++q) { const float a1 = acc[0][i][4 * g + q], a3 = acc[1][i][4 * g + q]; o[q] = a1 / (1.f + __expf(-a1)) * a3; }
                ctile_put(ct, 64 * wm + 32 * i + r, 32 * wn + 8 * g + 4 * h, o[0], o[1], o[2], o[3]);
            }
        bf16_t* hb = v.HID + (size_t)(cu.base + cu.mt * 128) * 512 + 64 * cu.nt;
        const int nrow = cu.nrow;
        ctile_flush<64>(ct, TIDX, [&](int row, int) { return row < nrow ? hb + (size_t)row * 512 : (bf16_t*)nullptr; });
        if (un >= total) break;
        unit = un; cu = nu;
    }
}
DEV void ph_moe_down_fast(const P& p, int l, unsigned char* lds) {
    const V v = make_views(p); const int TIDX = otid(), BIDX = obid();
    const int lane = TIDX & 63, wave = TIDX >> 6, wm = wave >> 1, wn = wave & 1, r = lane & 31, h = lane >> 5;
    const unsigned* cnt = v.ctl + CW_CNT + l * 32 * 64;
    int* tp = (int*)(lds + 67584); int* rb = tp + 40;
    __syncthreads();
    if (TIDX < 64) {
        const int c = TIDX < 32 ? (int)cnt[TIDX * 64] : 0;
        int nu = ((c + 127) >> 7) * 8, cc = c;
#pragma unroll
        for (int o = 1; o < 32; o <<= 1) { const int a = __shfl_up(nu, o), b2 = __shfl_up(cc, o); if ((TIDX & 31) >= o) { nu += a; cc += b2; } }
        if (TIDX < 32) { tp[TIDX + 1] = nu; rb[TIDX + 1] = cc; if (TIDX == 0) { tp[0] = 0; rb[0] = 0; } }
    }
    __syncthreads();
    const int total = tp[32];
    unsigned char* ct = lds + 32768;
    struct UD { int n0, nrow; const bf16_t* B; const bf16_t* ar[4]; float wrow[2]; int fslot[8]; };
    auto setup = [&](int unit, UD& u) {
        int e = 0;
#pragma unroll
        for (int st = 16; st > 0; st >>= 1) if (tp[e + st] <= unit) e += st;
        const int rem = unit - tp[e], base = rb[e];
        const int ce = rb[e + 1] - base, nt = rem & 7, mt = rem >> 3;
        const int* lst = v.list + (size_t)e * T + mt * 128;
        u.n0 = nt * 128;
        u.nrow = ce - mt * 128 < 128 ? ce - mt * 128 : 128;
        u.B = (const bf16_t*)(p.ws + WS_W2) + ((size_t)l * 32 + e) * 512 * D + u.n0;
#pragma unroll
        for (int i = 0; i < 4; ++i) { const int rr = (TIDX >> 3) + 32 * i; u.ar[i] = v.HID + (size_t)(base + mt * 128 + (rr < u.nrow ? rr : 0)) * 512; }
#pragma unroll
        for (int i = 0; i < 2; ++i) { const int mr = 64 * wm + 32 * i + r; u.wrow[i] = mr < u.nrow ? v.wts[lst[mr]] : 0.f; }
#pragma unroll
        for (int it = 0; it < 8; ++it) { const int row = it * 16 + (TIDX >> 4); u.fslot[it] = row < u.nrow ? lst[row] : -1; }
    };
    int unit = BIDX;
    if (unit >= total) return;
    UD cu, nu;
    setup(unit, cu);
    __syncthreads();
    gemm_issue0(lds, cu.ar, cu.B, D, TIDX);
    for (;;) {
        const int un = unit + (int)gridDim.x;
        f32x16 acc[2][2];
        gemm128<false, true>(lds, cu.ar, cu.B, D, 512, acc, TIDX);
        if (un < total) { setup(un, nu); gemm_issue0(lds, nu.ar, nu.B, D, TIDX); }
#pragma unroll
        for (int i = 0; i < 2; ++i) {
            const int mr = 64 * wm + 32 * i + r;
            const float w = cu.wrow[i];
#pragma unroll
            for (int j = 0; j < 2; ++j)
#pragma unroll
                for (int g = 0; g < 4; ++g)
                    ctile_put(ct, mr, 64 * wn + 32 * j + 8 * g + 4 * h, w * acc[j][i][4 * g], w * acc[j][i][4 * g + 1], w * acc[j][i][4 * g + 2], w * acc[j][i][4 * g + 3]);
        }
        const int n0 = cu.n0;
        ctile_flush<128>(ct, TIDX, [&](int, int it) { const int sl = cu.fslot[it]; return sl >= 0 ? v.Y + (size_t)sl * D + n0 : (bf16_t*)nullptr; });
        if (un >= total) break;
        unit = un; cu = nu;
    }
}

constexpr float SB_EPS = 1e-12f;
constexpr float LOG2E = 1.4426950408889634f, C2 = 0.125f * 1.4426950408889634f, LN2 = 0.6931471805599453f;
DEV float fexp2(float x) { return __builtin_amdgcn_exp2f(x); }
DEV float flog2(float x) { return __builtin_amdgcn_logf(x); }
DEV int swap23(int r) { return (r & ~12) | ((r & 4) << 1) | ((r & 8) >> 1); }

struct KVT { const bf16_t* k; int ks; const bf16_t* v; int vs; };
DEV void kv_load(const KVT& s, int kv0, const int TIDX, u32x4 (&rg)[4]) {
    const int c = TIDX & 7, r0 = TIDX >> 3;
    rg[0] = *(const u32x4*)(s.k + (size_t)(kv0 + r0) * s.ks + c * 8);
    rg[1] = *(const u32x4*)(s.k + (size_t)(kv0 + r0 + 32) * s.ks + c * 8);
    rg[2] = *(const u32x4*)(s.v + (size_t)r0 * s.vs + kv0 + c * 8);
    rg[3] = *(const u32x4*)(s.v + (size_t)(r0 + 32) * s.vs + kv0 + c * 8);
}
DEV void kv_store(unsigned char* st, const int TIDX, const u32x4 (&rg)[4]) {
    const int c = TIDX & 7, r0 = TIDX >> 3;
    *(u32x4*)(st + tile_off(r0, c)) = rg[0]; *(u32x4*)(st + tile_off(r0 + 32, c)) = rg[1];
    *(u32x4*)(st + 8192 + tile_off(r0, c)) = rg[2]; *(u32x4*)(st + 8192 + tile_off(r0 + 32, c)) = rg[3];
}
DEV bf16x8 scale_frag(bf16x8 v, float sc) {
    u32x4 u = __builtin_bit_cast(u32x4, v);
#pragma unroll
    for (int i = 0; i < 4; ++i) u[i] = cvtpk(__uint_as_float(u[i] << 16) * sc, __uint_as_float(u[i] & 0xffff0000u) * sc);
    return __builtin_bit_cast(bf16x8, u);
}
DEV float xhalf(float x) {
    const auto s = __builtin_amdgcn_permlane32_swap(__float_as_uint(x), __float_as_uint(x), false, false);
    return __uint_as_float((threadIdx.x & 32) ? s[0] : s[1]);
}
DEV float xhalf_max(float x) {
    const auto s = __builtin_amdgcn_permlane32_swap(__float_as_uint(x), __float_as_uint(x), false, false);
    return fmaxf(__uint_as_float(s[0]), __uint_as_float(s[1]));
}
DEV float xhalf_sum(float x) {
    const auto s = __builtin_amdgcn_permlane32_swap(__float_as_uint(x), __float_as_uint(x), false, false);
    return __uint_as_float(s[0]) + __uint_as_float(s[1]);
}
#define SB0() __builtin_amdgcn_sched_barrier(0)
DEV void score_tile(const unsigned char* Kt, const bf16x8 (&qf)[4], int r, int h, f32x16 (&p)[2]) {
    const int kr = swap23(r);
    const unsigned char* kb = Kt + tile_off(kr, h);
    auto ld = [&](int i) { const int blk = i & 1, s = i >> 1; return *(const bf16x8*)(Kt + tile_off(32 * blk + kr, 2 * s + h)); };
    (void)kb;
    f32x16 z;
#pragma unroll
    for (int q = 0; q < 16; ++q) z[q] = 0.f;
    bf16x8 f0 = ld(0), f1 = ld(1), f2 = ld(2), f3 = ld(3);
    SB0();
    p[0] = __builtin_amdgcn_mfma_f32_32x32x16_bf16(f0, qf[0], z, 0, 0, 0); f0 = ld(4); SB0();
    p[1] = __builtin_amdgcn_mfma_f32_32x32x16_bf16(f1, qf[0], z, 0, 0, 0); f1 = ld(5); SB0();
    p[0] = __builtin_amdgcn_mfma_f32_32x32x16_bf16(f2, qf[1], p[0], 0, 0, 0); f2 = ld(6); SB0();
    p[1] = __builtin_amdgcn_mfma_f32_32x32x16_bf16(f3, qf[1], p[1], 0, 0, 0); f3 = ld(7); SB0();
    p[0] = __builtin_amdgcn_mfma_f32_32x32x16_bf16(f0, qf[2], p[0], 0, 0, 0); SB0();
    p[1] = __builtin_amdgcn_mfma_f32_32x32x16_bf16(f1, qf[2], p[1], 0, 0, 0); SB0();
    p[0] = __builtin_amdgcn_mfma_f32_32x32x16_bf16(f2, qf[3], p[0], 0, 0, 0); SB0();
    p[1] = __builtin_amdgcn_mfma_f32_32x32x16_bf16(f3, qf[3], p[1], 0, 0, 0); SB0();
}
DEV void pv_tile(const unsigned char* Vt, const f32x16 (&p)[2], int r, int h, f32x16 (&o)[2]) {
    auto ld = [&](int i) { const int db = i & 1, pr = i >> 1; return *(const bf16x8*)(Vt + tile_off(32 * db + r, 2 * pr + h)); };
    auto pk = [&](int pr) {
        const int blk = pr >> 1, s = pr & 1;
        u32x4 w;
        w.x = cvtpk(p[blk][8 * s], p[blk][8 * s + 1]); w.y = cvtpk(p[blk][8 * s + 2], p[blk][8 * s + 3]);
        w.z = cvtpk(p[blk][8 * s + 4], p[blk][8 * s + 5]); w.w = cvtpk(p[blk][8 * s + 6], p[blk][8 * s + 7]);
        return __builtin_bit_cast(bf16x8, w);
    };
    bf16x8 f0 = ld(0), f1 = ld(1), f2 = ld(2), f3 = ld(3);
    SB0();
    bf16x8 pb = pk(0);
    SB0();
    o[0] = __builtin_amdgcn_mfma_f32_32x32x16_bf16(f0, pb, o[0], 0, 0, 0); f0 = ld(4); SB0();
    o[1] = __builtin_amdgcn_mfma_f32_32x32x16_bf16(f1, pb, o[1], 0, 0, 0); f1 = ld(5); pb = pk(1); SB0();
    o[0] = __builtin_amdgcn_mfma_f32_32x32x16_bf16(f2, pb, o[0], 0, 0, 0); f2 = ld(6); SB0();
    o[1] = __builtin_amdgcn_mfma_f32_32x32x16_bf16(f3, pb, o[1], 0, 0, 0); f3 = ld(7); pb = pk(2); SB0();
    o[0] = __builtin_amdgcn_mfma_f32_32x32x16_bf16(f0, pb, o[0], 0, 0, 0); SB0();
    o[1] = __builtin_amdgcn_mfma_f32_32x32x16_bf16(f1, pb, o[1], 0, 0, 0); pb = pk(3); SB0();
    o[0] = __builtin_amdgcn_mfma_f32_32x32x16_bf16(f2, pb, o[0], 0, 0, 0); SB0();
    o[1] = __builtin_amdgcn_mfma_f32_32x32x16_bf16(f3, pb, o[1], 0, 0, 0); SB0();
}

DEV void score_tile_a(LAS unsigned char* const (&ka)[4], const bf16x8 (&qf)[4], f32x16 (&p)[2]) {
    auto ld = [&](int i) { const int blk = i & 1, s = i >> 1; return *(const LAS bf16x8*)(ka[s] + 4096 * blk); };
    f32x16 z;
#pragma unroll
    for (int q = 0; q < 16; ++q) z[q] = 0.f;
    bf16x8 f0 = ld(0), f1 = ld(1), f2 = ld(2), f3 = ld(3);
    SB0();
    p[0] = __builtin_amdgcn_mfma_f32_32x32x16_bf16(f0, qf[0], z, 0, 0, 0); f0 = ld(4); SB0();
    p[1] = __builtin_amdgcn_mfma_f32_32x32x16_bf16(f1, qf[0], z, 0, 0, 0); f1 = ld(5); SB0();
    p[0] = __builtin_amdgcn_mfma_f32_32x32x16_bf16(f2, qf[1], p[0], 0, 0, 0); f2 = ld(6); SB0();
    p[1] = __builtin_amdgcn_mfma_f32_32x32x16_bf16(f3, qf[1], p[1], 0, 0, 0); f3 = ld(7); SB0();
    p[0] = __builtin_amdgcn_mfma_f32_32x32x16_bf16(f0, qf[2], p[0], 0, 0, 0); SB0();
    p[1] = __builtin_amdgcn_mfma_f32_32x32x16_bf16(f1, qf[2], p[1], 0, 0, 0); SB0();
    p[0] = __builtin_amdgcn_mfma_f32_32x32x16_bf16(f2, qf[3], p[0], 0, 0, 0); SB0();
    p[1] = __builtin_amdgcn_mfma_f32_32x32x16_bf16(f3, qf[3], p[1], 0, 0, 0); SB0();
}
DEV void pv_tile_a(LAS unsigned char* const (&va)[4], const f32x16 (&p)[2], f32x16 (&o)[2]) {
    auto ld = [&](int i) { const int db = i & 1, pr = i >> 1; return *(const LAS bf16x8*)(va[pr] + 4096 * db); };
    auto pk = [&](int pr) {
        const int blk = pr >> 1, s = pr & 1;
        u32x4 w;
        w.x = cvtpk(p[blk][8 * s], p[blk][8 * s + 1]); w.y = cvtpk(p[blk][8 * s + 2], p[blk][8 * s + 3]);
        w.z = cvtpk(p[blk][8 * s + 4], p[blk][8 * s + 5]); w.w = cvtpk(p[blk][8 * s + 6], p[blk][8 * s + 7]);
        return __builtin_bit_cast(bf16x8, w);
    };
    bf16x8 f0 = ld(0), f1 = ld(1), f2 = ld(2), f3 = ld(3);
    SB0();
    bf16x8 pb = pk(0);
    SB0();
    o[0] = __builtin_amdgcn_mfma_f32_32x32x16_bf16(f0, pb, o[0], 0, 0, 0); f0 = ld(4); SB0();
    o[1] = __builtin_amdgcn_mfma_f32_32x32x16_bf16(f1, pb, o[1], 0, 0, 0); f1 = ld(5); pb = pk(1); SB0();
    o[0] = __builtin_amdgcn_mfma_f32_32x32x16_bf16(f2, pb, o[0], 0, 0, 0); f2 = ld(6); SB0();
    o[1] = __builtin_amdgcn_mfma_f32_32x32x16_bf16(f3, pb, o[1], 0, 0, 0); f3 = ld(7); pb = pk(2); SB0();
    o[0] = __builtin_amdgcn_mfma_f32_32x32x16_bf16(f0, pb, o[0], 0, 0, 0); SB0();
    o[1] = __builtin_amdgcn_mfma_f32_32x32x16_bf16(f1, pb, o[1], 0, 0, 0); pb = pk(3); SB0();
    o[0] = __builtin_amdgcn_mfma_f32_32x32x16_bf16(f2, pb, o[0], 0, 0, 0); SB0();
    o[1] = __builtin_amdgcn_mfma_f32_32x32x16_bf16(f3, pb, o[1], 0, 0, 0); SB0();
}

template <int VAR>
DEV void attn_branch(unsigned char* lds, const KVT& src, const bf16x8 (&qf)[4], unsigned tmask, int wave_last, int t, int t_first,
                     unsigned selbits, const float* bias2, f32x16 (&o)[2], const int TIDX, const float qkb = 0.f) {
    const int lane = TIDX & 63, r = lane & 31, h = lane >> 5;
    const float NEG_INF = -__builtin_inff();
    float mrun = -1e30f, lrun = 0.f, rest = VAR == 3 ? 1.f : 0.f;
#pragma unroll
    for (int db = 0; db < 2; ++db)
#pragma unroll
        for (int q = 0; q < 16; ++q) o[db][q] = 0.f;
    u32x4 rg[4];
    LAS unsigned char* ka[4]; LAS unsigned char* va[4];
    {
        const int kr = swap23(r);
#pragma unroll
        for (int s = 0; s < 4; ++s) { ka[s] = (LAS unsigned char*)lds + tile_off(kr, 2 * s + h); va[s] = (LAS unsigned char*)lds + 8192 + tile_off(r, 2 * s + h); }
    }
    unsigned rem = tmask;
    unsigned wdone = 0u; int step = 0;
    volatile unsigned* sbf = (volatile unsigned*)(lds + 65536);
    int j = VAR >= 2 ? 31 - __builtin_clz(rem) : __builtin_ctz(rem);
    rem &= ~(1u << j);
    kv_load(src, 64 * j, TIDX, rg);
    __syncthreads();
    kv_store(lds, TIDX, rg);
    __syncthreads();
    int stage = 0;
    for (;;) {
        int jn = -1;
        if (rem) { jn = VAR >= 2 ? 31 - __builtin_clz(rem) : __builtin_ctz(rem); rem &= ~(1u << jn); kv_load(src, 64 * jn, TIDX, rg); }
        asm volatile("" ::: "memory"); __builtin_amdgcn_sched_barrier(0);
        if (j <= wave_last) {
            const unsigned char* Kt = lds + stage * 16384;
            f32x16 p[2];
            score_tile_a(ka, qf, p);
            const int kvb = 64 * j + 8 * h;
            if (VAR == 3) {
                const bool diag = 64 * j + 63 >= t_first;
                float gt[2][2];
                if (diag) {
#pragma unroll
                    for (int blk = 0; blk < 2; ++blk)
#pragma unroll
                        for (int s = 0; s < 2; ++s) {
                            float run = 1.f;
#pragma unroll
                            for (int q = 7; q >= 0; --q) {
                                const float ez = fexp2(p[blk][8 * s + q]);
                                float w = __builtin_amdgcn_rcpf(1.f + ez);
                                float beta = 1.f - w;
                                const bool valid = kvb + 32 * blk + 16 * s + q < t;
                                w = valid ? w : 1.f; beta = valid ? beta : 0.f;
                                p[blk][8 * s + q] = beta * run;
                                run *= w;
                            }
                            gt[blk][s] = run;
                        }
                } else {
#pragma unroll
                    for (int blk = 0; blk < 2; ++blk)
#pragma unroll
                        for (int s = 0; s < 2; ++s) {
                            float run = 1.f;
#pragma unroll
                            for (int q = 7; q >= 0; --q) {
                                const float rn = run * __builtin_amdgcn_rcpf(1.f + fexp2(p[blk][8 * s + q]));
                                p[blk][8 * s + q] = run - rn;
                                run = rn;
                            }
                            gt[blk][s] = run;
                        }
                }
                float og[2][2], pt[2][2];
#pragma unroll
                for (int blk = 0; blk < 2; ++blk)
#pragma unroll
                    for (int s = 0; s < 2; ++s) { og[blk][s] = xhalf(gt[blk][s]); pt[blk][s] = gt[blk][s] * og[blk][s]; }
                float above = rest;
#pragma unroll
                for (int pi = 3; pi >= 0; --pi) {
                    const int blk = pi >> 1, s = pi & 1;
                    const float carry = above * (h == 0 ? og[blk][s] : 1.f);
#pragma unroll
                    for (int q = 0; q < 8; ++q) p[blk][8 * s + q] *= carry;
                    above *= pt[blk][s];
                }
                rest = above;
                wdone = __all(rest < SB_EPS) ? 1u : 0u;
            } else {
                const bool need_causal = 64 * j + 63 > t_first;
                const bool need_win = VAR == 1 && (64 * j + 512 <= t_first + 31);
                const bool lane_on = VAR != 0 || ((selbits >> j) & 1u);
                if (VAR == 2) {
#pragma unroll
                    for (int blk = 0; blk < 2; ++blk)
#pragma unroll
                        for (int s = 0; s < 2; ++s) {
                            const float4 b0 = *(const float4*)(bias2 + kvb + 32 * blk + 16 * s), b1 = *(const float4*)(bias2 + kvb + 32 * blk + 16 * s + 4);
                            p[blk][8 * s] += b0.x; p[blk][8 * s + 1] += b0.y; p[blk][8 * s + 2] += b0.z; p[blk][8 * s + 3] += b0.w;
                            p[blk][8 * s + 4] += b1.x; p[blk][8 * s + 5] += b1.y; p[blk][8 * s + 6] += b1.z; p[blk][8 * s + 7] += b1.w;
                        }
                }
                if (need_causal) {
#pragma unroll
                    for (int blk = 0; blk < 2; ++blk)
#pragma unroll
                        for (int q = 0; q < 16; ++q) { const int kv = kvb + 32 * blk + 16 * (q >> 3) + (q & 7); p[blk][q] = kv <= t ? p[blk][q] : NEG_INF; }
                }
                if (need_win) {
#pragma unroll
                    for (int blk = 0; blk < 2; ++blk)
#pragma unroll
                        for (int q = 0; q < 16; ++q) { const int kv = kvb + 32 * blk + 16 * (q >> 3) + (q & 7); p[blk][q] = kv + 512 > t ? p[blk][q] : NEG_INF; }
                }
                float tmax = p[0][0];
#pragma unroll
                for (int q = 1; q < 16; ++q) tmax = fmaxf(tmax, p[0][q]);
#pragma unroll
                for (int q = 0; q < 16; ++q) tmax = fmaxf(tmax, p[1][q]);
                tmax = lane_on ? tmax : NEG_INF;
                tmax = xhalf_max(tmax);
                const float mnew = fmaxf(mrun, tmax);
                const bool grew = mnew > mrun;
                const float alpha = fexp2(mrun - mnew);
                mrun = mnew;
                const float msub = lane_on ? mnew : __builtin_inff();
                const f32x2_t ms2 = {msub, msub};
                f32x2_t ls2 = {0.f, 0.f};
#pragma unroll
                for (int blk = 0; blk < 2; ++blk)
#pragma unroll
                    for (int q = 0; q < 16; q += 2) {
                        const f32x2_t d2 = (f32x2_t){p[blk][q], p[blk][q + 1]} - ms2;
                        f32x2_t e2; e2.x = fexp2(d2.x); e2.y = fexp2(d2.y);
                        p[blk][q] = e2.x; p[blk][q + 1] = e2.y; ls2 += e2;
                    }
                lrun = lrun * alpha + (ls2.x + ls2.y);
                if (VAR == 2) wdone = __all(qkb + bias2[j > 0 ? 64 * j - 1 : 0] <= mrun - 40.f) ? 1u : 0u;
                if (__any(grew)) {
#pragma unroll
                    for (int db = 0; db < 2; ++db)
#pragma unroll
                        for (int q = 0; q < 16; ++q) o[db][q] *= alpha;
                }
            }
            pv_tile_a(va, p, o);
        }
        if (jn >= 0) kv_store(lds + (stage ^ 1) * 16384, TIDX, rg);
        if (VAR >= 2 && lane == 0) sbf[(step & 1) * 4 + (TIDX >> 6)] = wdone;
        __syncthreads();
        if (jn < 0) break;
        if (VAR >= 2) {
            const unsigned* f4 = (const unsigned*)sbf + (step & 1) * 4;
            if ((f4[0] & f4[1] & f4[2] & f4[3]) != 0u) break;
            ++step;
        }
        {
            const int dlt = stage ? -16384 : 16384;
#pragma unroll
            for (int s = 0; s < 4; ++s) { ka[s] += dlt; va[s] += dlt; }
        }
        j = jn; stage ^= 1;
    }
    if (VAR != 3) {
        const float lt = xhalf_sum(lrun);
        const float inv = lt > 0.f ? 1.f / lt : 0.f;
#pragma unroll
        for (int db = 0; db < 2; ++db)
#pragma unroll
            for (int q = 0; q < 16; ++q) o[db][q] *= inv;
    }
}

DEV void head_norm_store(const f32x16 (&o)[2], const float* gam, bf16_t* dst, int h) {
    float ss = 0.f;
#pragma unroll
    for (int db = 0; db < 2; ++db)
#pragma unroll
        for (int q = 0; q < 16; ++q) ss += o[db][q] * o[db][q];
    ss += __shfl_xor(ss, 32);
    const float rinv = rsqrtf(ss * (1.f / 64.f) + EPS);
#pragma unroll
    for (int db = 0; db < 2; ++db)
#pragma unroll
        for (int g = 0; g < 4; ++g) {
            const int d = 32 * db + 8 * g + 4 * h;
            const float4 gg = *(const float4*)(gam + d);
            uint2 u;
            u.x = cvtpk(o[db][4 * g] * rinv * gg.x, o[db][4 * g + 1] * rinv * gg.y);
            u.y = cvtpk(o[db][4 * g + 2] * rinv * gg.z, o[db][4 * g + 3] * rinv * gg.w);
            *(uint2*)(dst + d) = u;
        }
}

template <int VAR>
DEV void mha_unit(const P& p, int l, int unit, unsigned char* lds) {
    const V v = make_views(p); const int TIDX = otid();
    const int lane = TIDX & 63, wave = TIDX >> 6, r = lane & 31, h = lane >> 5;
    const int qb = 15 - (unit >> 5), bh = unit & 31, b = bh >> 2, hh = bh & 3;
    const int t0 = qb * 128, tw = t0 + 32 * wave, t = tw + r, m = b * S + t;
    const int qcol = VAR == 2 ? C_QB : C_QC, kcol = VAR == 2 ? C_KB : C_KCC, vrow = VAR == 2 ? 256 : 512, ocol = VAR == 2 ? 512 : 768;
    bf16x8 qf[4];
#pragma unroll
    for (int s = 0; s < 4; ++s) qf[s] = scale_frag(*(const bf16x8*)(v.U + (size_t)m * NP + qcol + hh * 64 + 16 * s + 8 * h), C2);
    KVT src;
    src.k = v.U + (size_t)b * S * NP + kcol + hh * 64; src.ks = NP;
    src.v = (const bf16_t*)(p.ws + WS_VT) + (size_t)(b * 768 + vrow + hh * 64) * S; src.vs = S;
    const int last = (t0 + 127) >> 6;
    const unsigned tmask = last == 31 ? 0xffffffffu : ((1u << (last + 1)) - 1u);
    const float* bias2 = (const float*)(lds + 32768);
    if (VAR == 2) {
        float* cf = (float*)(lds + 32768);
        float* wt = (float*)(lds + 32768 + 8192);
        const float* lsf = (const float*)(p.ws + WS_LSF) + (size_t)(b * 4 + hh) * S;
        const int nel = t0 + 128;
        float x[8];
        if (8 * TIDX < nel) {
            const float4 a0 = *(const float4*)(lsf + 8 * TIDX), a1 = *(const float4*)(lsf + 8 * TIDX + 4);
            x[0] = a0.x; x[1] = x[0] + a0.y; x[2] = x[1] + a0.z; x[3] = x[2] + a0.w; x[4] = x[3] + a1.x; x[5] = x[4] + a1.y; x[6] = x[5] + a1.z; x[7] = x[6] + a1.w;
        } else {
#pragma unroll
            for (int q = 0; q < 8; ++q) x[q] = 0.f;
        }
        float inc = x[7];
#pragma unroll
        for (int o = 1; o < 64; o <<= 1) { const float tt = __shfl_up(inc, o); if (lane >= o) inc += tt; }
        __syncthreads();
        if (lane == 63) wt[wave] = inc;
        __syncthreads();
        float off = inc - x[7];
#pragma unroll
        for (int w = 0; w < 3; ++w) off += (w < wave) ? wt[w] : 0.f;
        if (8 * TIDX < nel) {
#pragma unroll
            for (int q = 0; q < 8; ++q) cf[8 * TIDX + q] = -(x[q] + off) * LOG2E;
        }
        __syncthreads();
    }
    f32x16 o[2];
    float qkb = 0.f;
    if (VAR == 2) {
        float qq = 0.f;
#pragma unroll
        for (int s = 0; s < 4; ++s) {
            const u32x4 u = __builtin_bit_cast(u32x4, qf[s]);
#pragma unroll
            for (int q = 0; q < 4; ++q) { const float lo = __uint_as_float(u[q] << 16), hi = __uint_as_float(u[q] & 0xffff0000u); qq += lo * lo + hi * hi; }
        }
        qq = xhalf_sum(qq);
        const float kn2 = __uint_as_float(__hip_atomic_load(v.ctl + CW_KN + (l * 8 + b) * 4 + hh, __ATOMIC_RELAXED, __HIP_MEMORY_SCOPE_AGENT));
        qkb = sqrtf(qq) * sqrtf(kn2) * 1.01f;
    }
    attn_branch<VAR>(lds, src, qf, tmask, (tw + 31) >> 6, t, tw, 0u, bias2, o, TIDX, qkb);
    head_norm_store(o, p.out_norm_g + (size_t)l * D + ocol + hh * 64, v.O + (size_t)m * D + ocol + hh * 64, h);
}

DEV void nsa_unit(const P& p, int l, int unit, unsigned char* lds) {
    const V v = make_views(p); const int TIDX = otid();
    const int lane = TIDX & 63, wave = TIDX >> 6, r = lane & 31, h = lane >> 5;
    const int qblk = 63 - (unit >> 4), bg = unit & 15, b = bg >> 1, g = bg & 1;
    const int t0 = qblk * 32, t = t0 + r, m = b * S + t, head = g * 4 + wave, cur = t0 >> 6;
    const float NEG_INF = -__builtin_inff();
    bf16x8 qf[4];
#pragma unroll
    for (int s = 0; s < 4; ++s) qf[s] = scale_frag(*(const bf16x8*)(v.U + (size_t)m * NP + C_QA + head * 64 + 16 * s + 8 * h), C2);
    const float g0 = sigmoidf_(v.gf[(size_t)m * 32 + head * 3]), g1 = sigmoidf_(v.gf[(size_t)m * 32 + head * 3 + 1]), g2 = sigmoidf_(v.gf[(size_t)m * 32 + head * 3 + 2]);
    f32x16 otot[2];
    float* PA = (float*)(lds + 32768);
    float* PB = (float*)(lds + 49152);
    float* SC = (float*)lds;
    unsigned* MASK = (unsigned*)(lds + 8192);
    {
        const bf16_t* ck = v.ck + (size_t)(b * 2 + g) * 128 * 64;
        const bf16_t* cvt = (const bf16_t*)(p.ws + WS_CVT) + (size_t)(b * 2 + g) * 64 * 128;
        const int c = TIDX & 7, r0 = TIDX >> 3;
        u32x4 rk[4], rv[4];
#pragma unroll
        for (int i = 0; i < 4; ++i) rk[i] = *(const u32x4*)(ck + (size_t)(r0 + 32 * i) * 64 + c * 8);
#pragma unroll
        for (int i = 0; i < 4; ++i) rv[i] = *(const u32x4*)(cvt + (size_t)(r0 + 32 * (i & 1)) * 128 + 64 * (i >> 1) + c * 8);
        __syncthreads();
#pragma unroll
        for (int i = 0; i < 4; ++i) *(u32x4*)(lds + tile_off(r0 + 32 * i, c)) = rk[i];
#pragma unroll
        for (int i = 0; i < 4; ++i) *(u32x4*)(lds + 16384 + 8192 * (i >> 1) + tile_off(r0 + 32 * (i & 1), c)) = rv[i];
        __syncthreads();
        f32x16 ps[2][2];
        score_tile(lds, qf, r, h, ps[0]);
        score_tile(lds + 8192, qf, r, h, ps[1]);
        const int nvalid = t >= 31 ? (t - 31) / 16 + 1 : 0;
        float mx = NEG_INF;
#pragma unroll
        for (int tt = 0; tt < 2; ++tt)
#pragma unroll
            for (int blk = 0; blk < 2; ++blk)
#pragma unroll
                for (int q = 0; q < 16; ++q) {
                    const int n = 64 * tt + 32 * blk + 16 * (q >> 3) + 8 * h + (q & 7);
                    const float x = n < nvalid ? ps[tt][blk][q] : NEG_INF;
                    ps[tt][blk][q] = x; mx = fmaxf(mx, x);
                }
        mx = fmaxf(mx, __shfl_xor(mx, 32));
        const float mxs = nvalid > 0 ? mx : 0.f;
        float ls = 0.f;
#pragma unroll
        for (int tt = 0; tt < 2; ++tt)
#pragma unroll
            for (int blk = 0; blk < 2; ++blk)
#pragma unroll
                for (int q = 0; q < 16; ++q) { const float e = fexp2(ps[tt][blk][q] - mxs); ps[tt][blk][q] = e; ls += e; }
        const float lt = ls + __shfl_xor(ls, 32);
        const float inv = lt > 0.f ? 1.f / lt : 0.f;
#pragma unroll
        for (int tt = 0; tt < 2; ++tt)
#pragma unroll
            for (int blk = 0; blk < 2; ++blk) {
#pragma unroll
                for (int q = 0; q < 16; ++q) ps[tt][blk][q] *= inv;
#pragma unroll
                for (int s = 0; s < 2; ++s) {
                    const int G0 = 16 * tt + 8 * blk + 4 * s + 2 * h;
                    const float a0 = (ps[tt][blk][8 * s] + ps[tt][blk][8 * s + 1]) + (ps[tt][blk][8 * s + 2] + ps[tt][blk][8 * s + 3]);
                    const float a1 = (ps[tt][blk][8 * s + 4] + ps[tt][blk][8 * s + 5]) + (ps[tt][blk][8 * s + 6] + ps[tt][blk][8 * s + 7]);
                    PA[(wave * 32 + G0) * 32 + r] = a0; PA[(wave * 32 + G0 + 1) * 32 + r] = a1;
                    PB[(wave * 32 + G0 + 1) * 32 + r] = ps[tt][blk][8 * s + 3];
                    if (G0 + 2 < 32) PB[(wave * 32 + G0 + 2) * 32 + r] = ps[tt][blk][8 * s + 7];
                }
            }
        f32x16 oc[2];
#pragma unroll
        for (int db = 0; db < 2; ++db)
#pragma unroll
            for (int q = 0; q < 16; ++q) oc[db][q] = 0.f;
        pv_tile(lds + 16384, ps[0], r, h, oc);
        pv_tile(lds + 24576, ps[1], r, h, oc);
#pragma unroll
        for (int db = 0; db < 2; ++db)
#pragma unroll
            for (int q = 0; q < 16; ++q) otot[db][q] = g0 * oc[db][q];
    }
    __syncthreads();
    const bool need_topk = cur > 15;
    if (need_topk) {
        const int q = TIDX & 31, j0 = (TIDX >> 5) * 4;
#pragma unroll
        for (int jj = 0; jj < 4; ++jj) {
            const int j = j0 + jj;
            float sc = 0.f;
#pragma unroll
            for (int w = 0; w < 4; ++w) sc += PA[(w * 32 + j) * 32 + q];
            if (j > 0) {
#pragma unroll
                for (int w = 0; w < 4; ++w) sc += PB[(w * 32 + j) * 32 + q];
            }
            const bool forced = (j == 0) || (j == cur) || (j == cur - 1);
            SC[q * 33 + j] = forced ? 1.0e4f : (j <= cur ? sc : -1.0f);
        }
        if (TIDX < 32) MASK[TIDX] = 0u;
        __syncthreads();
        unsigned bits = 0u;
#pragma unroll
        for (int jj = 0; jj < 4; ++jj) {
            const int j = j0 + jj;
            const float vj = SC[q * 33 + j];
            int rank = 0;
#pragma unroll
            for (int i = 0; i < 32; ++i) { const float vi = SC[q * 33 + i]; rank += (vi > vj || (vi == vj && i < j)) ? 1 : 0; }
            if (rank < 16) bits |= 1u << j;
        }
        atomicOr(&MASK[q], bits);
        __syncthreads();
    }
    const unsigned upto = (2u << cur) - 1u;
    unsigned mybits = upto, um = upto;
    if (need_topk) {
        mybits = MASK[r];
        um = 0u;
#pragma unroll
        for (int i = 0; i < 32; ++i) um |= MASK[i];
        um = (unsigned)__builtin_amdgcn_readfirstlane((int)um);
    }
    {
        KVT src; src.k = v.U + (size_t)b * S * NP + C_KS + g * 64; src.ks = NP;
        src.v = (const bf16_t*)(p.ws + WS_VT) + (size_t)(b * 768 + g * 64) * S; src.vs = S;
        f32x16 o[2];
        attn_branch<0>(lds, src, qf, um & upto, cur, t, t0, mybits, nullptr, o, TIDX);
#pragma unroll
        for (int db = 0; db < 2; ++db)
#pragma unroll
            for (int q = 0; q < 16; ++q) otot[db][q] += g1 * o[db][q];
    }
    {
        KVT src; src.k = v.U + (size_t)b * S * NP + C_KW + g * 64; src.ks = NP;
        src.v = (const bf16_t*)(p.ws + WS_VT) + (size_t)(b * 768 + 128 + g * 64) * S; src.vs = S;
        const int f = (t0 - 511 > 0 ? t0 - 511 : 0) >> 6;
        const unsigned wmask = upto & ~((1u << f) - 1u);
        f32x16 o[2];
        attn_branch<1>(lds, src, qf, wmask, cur, t, t0, 0u, nullptr, o, TIDX);
#pragma unroll
        for (int db = 0; db < 2; ++db)
#pragma unroll
            for (int q = 0; q < 16; ++q) otot[db][q] += g2 * o[db][q];
    }
    head_norm_store(otot, p.out_norm_g + (size_t)l * D + head * 64, v.O + (size_t)m * D + head * 64, h);
}

constexpr int CW_CMPK = 12288;
DEV bool cmp_unit(const P& p, int l, int unit, int kq, unsigned char* lds, volatile LAS unsigned* qslot) {
    const V v = make_views(p); const int TIDX = otid();
    const int lane = TIDX & 63, wave = TIDX >> 6, wm = wave >> 1, wn = wave & 1, r = lane & 31, h = lane >> 5;
    const int kv = unit & 1, bg = unit >> 1, b = bg >> 1, g = bg & 1, lk = l * 2 + kv;
    const int col = (kv ? C_VC : C_KC) + g * 64;
    const bf16_t* arow[4];
#pragma unroll
    for (int i = 0; i < 4; ++i) { const int n = (TIDX >> 3) + 32 * i; arow[i] = v.U + (size_t)(b * S + 16 * (n < 127 ? n : 126) + 8 * kq) * NP + col; }
    f32x16 acc[2][2];
    gemm128<false>(lds, arow, (const bf16_t*)(p.ws + WS_CW1) + (size_t)lk * 2048 * 128 + (size_t)kq * 512 * 128, 128, 512, acc, TIDX, NP);
    {
        const __amdgpu_buffer_rsrc_t prs = __builtin_amdgcn_make_buffer_rsrc((void*)v.OB, (short)0, 32 * 4 * 65536, 0x00020000);
        const unsigned pbase = (unsigned)(unit * 4 + kq) * 65536u + (unsigned)TIDX * 16u;
#pragma unroll
        for (int j = 0; j < 2; ++j)
#pragma unroll
            for (int i = 0; i < 2; ++i)
#pragma unroll
                for (int g4 = 0; g4 < 4; ++g4) {
                    const f32x4v a = {acc[j][i][4 * g4], acc[j][i][4 * g4 + 1], acc[j][i][4 * g4 + 2], acc[j][i][4 * g4 + 3]};
                    __builtin_amdgcn_raw_buffer_store_b128(__builtin_bit_cast(u32x4, a), prs, pbase + (unsigned)((j * 2 + i) * 4 + g4) * 4096u, 0,   16);
                }
        asm volatile("s_waitcnt vmcnt(0)" ::: "memory");
        __syncthreads();
        if (TIDX == 0) *qslot = __hip_atomic_fetch_add(v.ctl + CW_CMPK + l * 32 + unit, 1u, __ATOMIC_RELAXED, __HIP_MEMORY_SCOPE_AGENT);
        __syncthreads();
        if (*qslot != 3u) return false;
        if (TIDX == 0) { __builtin_amdgcn_fence(__ATOMIC_ACQUIRE, "agent"); asm volatile("s_waitcnt vmcnt(0)" ::: "memory"); }
        __syncthreads();
        const float* pp = v.OB + (size_t)unit * 4 * 16384 + TIDX * 4;
#pragma unroll
        for (int j = 0; j < 2; ++j)
#pragma unroll
            for (int i = 0; i < 2; ++i)
#pragma unroll
                for (int g4 = 0; g4 < 4; ++g4) {
                    const float* q0 = pp + ((j * 2 + i) * 4 + g4) * 1024;
                    f32x4v a = *(const f32x4v*)q0;
#pragma unroll
                    for (int k2 = 1; k2 < 4; ++k2) { const f32x4v b2 = *(const f32x4v*)(q0 + k2 * 16384); a += b2; }
                    acc[j][i][4 * g4] = a[0]; acc[j][i][4 * g4 + 1] = a[1]; acc[j][i][4 * g4 + 2] = a[2]; acc[j][i][4 * g4 + 3] = a[3];
                }
    }
    const float* pb = (const float*)(p.ws + WS_CPB) + lk * 8 * 128;
#pragma unroll
    for (int j = 0; j < 2; ++j)
#pragma unroll
        for (int i = 0; i < 2; ++i) {
            const int mrow = 64 * wm + 32 * i + r;
#pragma unroll
            for (int g4 = 0; g4 < 4; ++g4) {
                float4 bb = *(const float4*)(pb + 64 * wn + 32 * j + 8 * g4 + 4 * h);
#pragma unroll
                for (int c8 = 1; c8 < 8; ++c8) { const float4 b2 = *(const float4*)(pb + c8 * 128 + 64 * wn + 32 * j + 8 * g4 + 4 * h); bb.x += b2.x; bb.y += b2.y; bb.z += b2.z; bb.w += b2.w; }
                float x0 = acc[j][i][4 * g4] + bb.x, x1 = acc[j][i][4 * g4 + 1] + bb.y, x2 = acc[j][i][4 * g4 + 2] + bb.z, x3 = acc[j][i][4 * g4 + 3] + bb.w;
                x0 = x0 / (1.f + __expf(-x0)); x1 = x1 / (1.f + __expf(-x1)); x2 = x2 / (1.f + __expf(-x2)); x3 = x3 / (1.f + __expf(-x3));
                uint2 u; u.x = cvtpk(x0, x1); u.y = cvtpk(x2, x3);
                *(uint2*)(lds + wn * 16384 + tile_off(mrow, 4 * j + g4) + 8 * h) = u;
            }
        }
    {
        const bf16_t* w2 = (const bf16_t*)(p.ws + WS_CW2) + (size_t)lk * 64 * 128;
        const int c = TIDX & 7, r0 = TIDX >> 3;
#pragma unroll
        for (int i = 0; i < 4; ++i) {
            const int row = r0 + 32 * (i & 1), kt = i >> 1;
            *(u32x4*)(lds + 32768 + kt * 8192 + tile_off(row, c)) = *(const u32x4*)(w2 + (size_t)row * 128 + kt * 64 + c * 8);
        }
    }
    __syncthreads();
    f32x16 a2[2];
#pragma unroll
    for (int db = 0; db < 2; ++db)
#pragma unroll
        for (int q = 0; q < 16; ++q) a2[db][q] = 0.f;
#pragma unroll
    for (int kt = 0; kt < 2; ++kt)
#pragma unroll
        for (int s = 0; s < 4; ++s) {
            const bf16x8 hf = *(const bf16x8*)(lds + kt * 16384 + tile_off(32 * wave + r, 2 * s + h));
#pragma unroll
            for (int db = 0; db < 2; ++db) {
                const bf16x8 wf = *(const bf16x8*)(lds + 32768 + kt * 8192 + tile_off(32 * db + r, 2 * s + h));
                a2[db] = __builtin_amdgcn_mfma_f32_32x32x16_bf16(wf, hf, a2[db], 0, 0, 0);
            }
        }
    const int n = 32 * wave + r;
    if (kv == 0 && n < 127) {
        const int pos = 16 * n + 31;
#pragma unroll
        for (int q = 0; q < 4; ++q) {
            const float cs = v.rcos[pos * 8 + q + 4 * h], sn = v.rsin[pos * 8 + q + 4 * h];
            const float x1 = a2[0][q], x2 = a2[0][q + 4];
            a2[0][q] = x1 * cs - x2 * sn; a2[0][q + 4] = x2 * cs + x1 * sn;
        }
    }
    bf16_t* dst = (kv ? v.cv : v.ck) + ((size_t)bg * 128 + n) * 64;
    bf16_t* dt = (bf16_t*)(p.ws + WS_CVT) + (size_t)bg * 64 * 128 + n;
#pragma unroll
    for (int db = 0; db < 2; ++db)
#pragma unroll
        for (int g4 = 0; g4 < 4; ++g4) {
            const int d = 32 * db + 8 * g4 + 4 * h;
            float x0 = a2[db][4 * g4], x1 = a2[db][4 * g4 + 1], x2 = a2[db][4 * g4 + 2], x3 = a2[db][4 * g4 + 3];
            if (n >= 127) { x0 = 0.f; x1 = 0.f; x2 = 0.f; x3 = 0.f; }
            uint2 u; u.x = cvtpk(x0, x1); u.y = cvtpk(x2, x3);
            *(uint2*)(dst + d) = u;
            if (kv) { dt[(size_t)d * 128] = (bf16_t)(u.x & 0xffffu); dt[(size_t)(d + 1) * 128] = (bf16_t)(u.x >> 16); dt[(size_t)(d + 2) * 128] = (bf16_t)(u.y & 0xffffu); dt[(size_t)(d + 3) * 128] = (bf16_t)(u.y >> 16); }
        }
    __syncthreads();
    return true;
}

typedef float f32x4m __attribute__((ext_vector_type(4)));
DEV void ph_norm2_router_fast(const P& p, int l, unsigned char* lds) {
    const V v = make_views(p); const int TIDX = otid(), BIDX = obid();
    const int lane = TIDX & 63, wave = TIDX >> 6;
    const bf16_t* wr = (const bf16_t*)(p.ws + WS_WR) + (size_t)l * 2 * 64 * D;
    float* LG = (float*)(lds + 65536);
    for (int blk = BIDX; blk < T / 16; blk += gridDim.x) {
        const int m0 = blk * 16, b = m0 >> 11;
        const float* md = v.mod + (size_t)(l * 8 + b) * 6144;
        float4 xv[4][4]; float ssq[4];
#pragma unroll
        for (int rr = 0; rr < 4; ++rr)
#pragma unroll
            for (int j = 0; j < 4; ++j) xv[rr][j] = ld_bf4(v.XB + (size_t)(m0 + wave * 4 + rr) * D + 4 * lane + 256 * j);
#pragma unroll
        for (int rr = 0; rr < 4; ++rr) {
            ssq[rr] = 0.f;
#pragma unroll
            for (int j = 0; j < 4; ++j) ssq[rr] += xv[rr][j].x * xv[rr][j].x + xv[rr][j].y * xv[rr][j].y + xv[rr][j].z * xv[rr][j].z + xv[rr][j].w * xv[rr][j].w;
        }
#pragma unroll
        for (int o = 1; o < 64; o <<= 1) {
#pragma unroll
            for (int rr = 0; rr < 4; ++rr) ssq[rr] += __shfl_xor(ssq[rr], o);
        }
#pragma unroll
        for (int rr = 0; rr < 4; ++rr) {
            const int row = wave * 4 + rr, m = m0 + row;
            const float rs = rsqrtf(ssq[rr] * (1.f / D) + EPS);
#pragma unroll
            for (int j = 0; j < 4; ++j) {
                const int c = 4 * lane + 256 * j;
                const float4 g = *(const float4*)(p.norm2_g + l * D + c), sh = *(const float4*)(md + 3 * D + c), sc = *(const float4*)(md + 4 * D + c);
                const float h0 = xv[rr][j].x * rs * g.x * (1.f + sc.x) + sh.x, h1 = xv[rr][j].y * rs * g.y * (1.f + sc.y) + sh.y;
                const float h2 = xv[rr][j].z * rs * g.z * (1.f + sc.z) + sh.z, h3 = xv[rr][j].w * rs * g.w * (1.f + sc.w) + sh.w;
                uint2 hi; hi.x = cvtpk(h0, h1); hi.y = cvtpk(h2, h3);
                uint2 lo;
                lo.x = cvtpk(h0 - __uint_as_float(hi.x << 16), h1 - __uint_as_float(hi.x & 0xffff0000u));
                lo.y = cvtpk(h2 - __uint_as_float(hi.y << 16), h3 - __uint_as_float(hi.y & 0xffff0000u));
                *(uint2*)(v.H + (size_t)m * D + c) = hi;
                const int off = row * 2048 + ((((c >> 3) ^ row) & 127) << 4) + (c & 7) * 2;
                *(uint2*)(lds + off) = hi; *(uint2*)(lds + 32768 + off) = lo;
            }
        }
        __syncthreads();
        {
            const int r16 = lane & 15, kq = lane >> 4;
            f32x4m acc = {0.f, 0.f, 0.f, 0.f};
            const bf16_t* wh = wr + (size_t)(16 * wave + r16) * D + 8 * kq;
#pragma unroll 8
            for (int s = 0; s < 32; ++s) {
                const int off = r16 * 2048 + ((((4 * s + kq) ^ r16) & 127) << 4);
                const bf16x8 ah = *(const bf16x8*)(lds + off), al = *(const bf16x8*)(lds + 32768 + off);
                const bf16x8 bh = *(const bf16x8*)(wh + 32 * s), bl = *(const bf16x8*)(wh + 64 * D + 32 * s);
                acc = __builtin_amdgcn_mfma_f32_16x16x32_bf16(ah, bh, acc, 0, 0, 0);
                acc = __builtin_amdgcn_mfma_f32_16x16x32_bf16(al, bh, acc, 0, 0, 0);
                acc = __builtin_amdgcn_mfma_f32_16x16x32_bf16(ah, bl, acc, 0, 0, 0);
            }
#pragma unroll
            for (int q = 0; q < 4; ++q) LG[(4 * kq + q) * 64 + 16 * wave + r16] = acc[q];
        }
        __syncthreads();
        if (TIDX < 16) {
            const int m = m0 + TIDX;
            const float* lgp = LG + TIDX * 64;
            float lg[4], le[32];
#pragma unroll
            for (int i = 0; i < 4; ++i) lg[i] = lgp[i] + p.rg_b[l * 4 + i];
#pragma unroll
            for (int i = 0; i < 32; ++i) le[i] = lgp[4 + i] + p.re_b[l * 32 + i];
            int gi = 0; float gm = lg[0];
#pragma unroll
            for (int i = 1; i < 4; ++i) if (lg[i] > gm) { gm = lg[i]; gi = i; }
            float gs = 0.f;
#pragma unroll
            for (int i = 0; i < 4; ++i) gs += expf(lg[i] - gm);
            const float pg = 1.f / gs;
            float el[8];
#pragma unroll
            for (int i = 0; i < 8; ++i) el[i] = gi == 0 ? le[i] : (gi == 1 ? le[8 + i] : (gi == 2 ? le[16 + i] : le[24 + i]));
            int e1 = 0; float m1 = el[0];
#pragma unroll
            for (int i = 1; i < 8; ++i) if (el[i] > m1) { m1 = el[i]; e1 = i; }
            int e2 = -1; float m2 = -3.0e38f;
#pragma unroll
            for (int i = 0; i < 8; ++i) if (i != e1 && el[i] > m2) { m2 = el[i]; e2 = i; }
            const float p2 = expf(m2 - m1);
            const float w1 = pg / (1.f + p2), w2 = pg * p2 / (1.f + p2);
            const int ea = gi * 8 + e1, eb = gi * 8 + e2;
            const unsigned pa = atomicAdd(v.ctl + CW_CNT + (l * 32 + ea) * 64, 1u);
            const unsigned pb = atomicAdd(v.ctl + CW_CNT + (l * 32 + eb) * 64, 1u);
            v.list[(size_t)ea * T + pa] = 2 * m;
            v.list[(size_t)eb * T + pb] = 2 * m + 1;
            v.wts[2 * m] = w1; v.wts[2 * m + 1] = w2;
        }
        __syncthreads();
    }
}

constexpr int CW_MQ = 8192 + 512;
DEV void ph_mix(const P& p, int l, unsigned char* lds, volatile LAS unsigned* qslot, int rep) {
    const int TIDX = otid(), BIDX = obid();
    unsigned* ctl = (unsigned*)(p.ws + WS_CTL) + CW_MQ + l * 256;
    unsigned acq = 0u;
    int b = BIDX & 7;
    {
        for (;;) {
            unsigned* qc = ctl + b * 16;
            unsigned* done = ctl + 128 + b * 16;
            __syncthreads();
            if (TIDX == 0) {
                unsigned tk = atomicAdd(qc, 1u), nb = (unsigned)b;
                if (tk >= 272u) {
                    unsigned hd[8];
#pragma unroll
                    for (int q = 0; q < 8; ++q) hd[q] = __hip_atomic_load(ctl + ((b + q) & 7) * 16, __ATOMIC_RELAXED, __HIP_MEMORY_SCOPE_AGENT);
                    nb = 8u;
#pragma unroll
                    for (int q = 7; q >= 1; --q) if (hd[q] < 272u) nb = (unsigned)((b + q) & 7);
                }
                *qslot = tk | (nb << 16);
            }
            __syncthreads();
            const unsigned qv = *qslot;
            const int v = (int)(qv & 0xffffu);
            if (v >= 272) {
                const int nb = (int)(qv >> 16);
                if (nb >= 8) break;
                b = nb; continue;
            }
            if (v < 16) {
                if (cmp_unit(p, l, b * 4 + (v >> 2), v & 3, lds, qslot)) {
                    asm volatile("s_waitcnt vmcnt(0)" ::: "memory");
                    __syncthreads();
                    if (TIDX == 0) {
                        __builtin_amdgcn_fence(__ATOMIC_RELEASE, "agent");
                        asm volatile("s_waitcnt vmcnt(0)" ::: "memory");
                        __hip_atomic_fetch_add(done, 1u, __ATOMIC_RELAXED, __HIP_MEMORY_SCOPE_AGENT);
                    }
                }
                continue;
            }
            int slot = -1, nsa = -1;
            if (v < 48) slot = 2 * (v - 16);
            else if (v < 112) slot = 2 * (v - 48) + 1;
            else { const int w2 = v - 112, k = w2 % 5, i = w2 / 5; if (k < 4) nsa = 4 * i + k; else slot = 2 * (32 + i); }
            if (slot >= 0) {
                const int idx = slot >> 1, u = ((idx >> 2) << 5) | (b * 4 + (idx & 3));
                if (slot & 1) mha_unit<3>(p, l, u, lds); else mha_unit<2>(p, l, u, lds);
            } else {
                if (!((acq >> b) & 1u)) {
                    if (TIDX == 0) {
                        unsigned sp = 0;
                        while (__hip_atomic_load(done, __ATOMIC_RELAXED, __HIP_MEMORY_SCOPE_AGENT) < 4u) { __builtin_amdgcn_s_sleep(2); if (++sp > (1u << 22)) break; }
                        __builtin_amdgcn_fence(__ATOMIC_ACQUIRE, "agent");
                        asm volatile("s_waitcnt vmcnt(0)" ::: "memory");
                    }
                    __syncthreads();
                    acq |= 1u << b;
                }
                nsa_unit(p, l, ((nsa >> 1) << 4) | (b * 2 + (nsa & 1)), lds);
            }
        }
    }
}

#ifndef REP_PHASE
#define REP_PHASE 0
#endif
#ifndef REF_HEADS
#define REF_HEADS 0x0000u
#endif
__global__ void __launch_bounds__(256, 2) fwd_kernel(P p) {
    __shared__ __attribute__((aligned(16))) float lds[17408];
    __shared__ __attribute__((aligned(16))) unsigned lds_ctl[4];
    if (threadIdx.x < 4) lds_ctl[threadIdx.x] = 0u;
    __syncthreads();
    const XcdBarrier xb = xcd_barrier_post((unsigned*)(p.ws + WS_CTL), (volatile LAS unsigned*)lds_ctl);
#define GRID_BAR() do { xcd_barrier(xb); if (REP_PHASE == 7) xcd_barrier(xb); } while (0)
    volatile LAS unsigned* qslot = (volatile LAS unsigned*)(lds_ctl + 2);
    for (int rep = 0; rep < (REP_PHASE == 1 ? 2 : 1); ++rep) {
        ph_prologue(p, lds);
        ph_convert(p, lds);
        GRID_BAR();
    }
    for (int l = 0; l < DEPTH; ++l) {
        ph_convert_dense(p, l, 0);
        ph_norm1(p, l, l == 0 ? 0 : 1);
        GRID_BAR();
        for (int rep = 0; rep < (REP_PHASE == 2 ? 2 : 1); ++rep) {
            if (rep == 0) ph_convert_dense(p, l, 1);
            ph_inproj_fast(p, l, (unsigned char*)lds);
            GRID_BAR();
        }
        for (int rep = 0; rep < (REP_PHASE == 3 ? 2 : 1); ++rep) {
            ph_mix(p, l, (unsigned char*)lds, qslot, rep);
            GRID_BAR();
        }
        ph_outproj_fast(p, l, (unsigned char*)lds);
        GRID_BAR();
        if (blockIdx.x & 8) { ph_convert_experts(p, l); ph_norm2_router_fast(p, l, (unsigned char*)lds); }
        else { ph_norm2_router_fast(p, l, (unsigned char*)lds); ph_convert_experts(p, l); }
        GRID_BAR();
        for (int rep = 0; rep < (REP_PHASE == 5 ? 2 : 1); ++rep) {
            ph_moe_up_fast(p, l, (unsigned char*)lds);
            GRID_BAR();
        }
        for (int rep = 0; rep < (REP_PHASE == 6 ? 2 : 1); ++rep) {
            ph_moe_down_fast(p, l, (unsigned char*)lds);
            GRID_BAR();
        }
    }
    ph_norm1(p, DEPTH, 2);
}

extern "C" void kernel_launch(void* const* d_in, const int* in_sizes, int n_in,
                              void* d_out, int out_size, void* d_ws, size_t ws_size,
                              hipStream_t stream) {
    static int grid_blocks = 0;
    if (!grid_blocks) {
        int dev = 0, cus = 0, per_cu = 0;
        (void)hipGetDevice(&dev);
        (void)hipDeviceGetAttribute(&cus, hipDeviceAttributeMultiprocessorCount, dev);
        (void)hipOccupancyMaxActiveBlocksPerMultiprocessor(&per_cu, fwd_kernel, 256, 0);
        if (per_cu > 2) per_cu = 2;
        if (per_cu < 1) per_cu = 1;
        grid_blocks = cus * per_cu;
        if (n_in != 24 || ws_size < WS_END || out_size != T * D) { fprintf(stderr, "kernel_launch: unexpected shapes (n_in %d ws %zu out %d)\n", n_in, ws_size, out_size); grid_blocks = -1; }
    }
    if (grid_blocks < 0) return;
    (void)hipMemsetAsync(d_ws, 0, CTL_BYTES, stream);
    P p{};
    const float** pp = (const float**)&p;
    for (int i = 0; i < 24; ++i) pp[i] = (const float*)d_in[i];
    p.out = (float*)d_out; p.ws = (unsigned char*)d_ws;
    void* args[] = {&p};
    hipError_t e = hipLaunchCooperativeKernel((void*)fwd_kernel, dim3(grid_blocks), dim3(256), args, 0, stream);
    if (e != hipSuccess) fprintf(stderr, "cooperative launch failed: %s (grid %d)\n", hipGetErrorString(e), grid_blocks);
}
```

```cpp
#include <hip/hip_runtime.h>
#include <hip/hip_cooperative_groups.h>
#include <cstdio>
#include <cstdint>

#define LAS __attribute__((address_space(3)))
#define DEV __device__ __forceinline__

constexpr int T = 16384, S = 2048, NB = 8, D = 1024, DIN = 2844, NP = 2880, DEPTH = 4;
constexpr int NCMP = 127;
constexpr float EPS = 1e-6f;
constexpr float SCALE = 0.125f;
constexpr int C_QA = 0, C_KC = 512, C_VC = 640, C_KS = 768, C_VS = 896, C_KW = 1024, C_VW = 1152;
constexpr int C_QB = 1280, C_KB = 1536, C_VB = 1792, C_QC = 2048, C_KCC = 2304, C_VCC = 2560;

constexpr size_t MiB = 1u << 20;
constexpr size_t WS_CTL = 0, CTL_BYTES = 128 * 1024;
constexpr size_t WS_MOD = 1 * MiB, WS_ROPE = 2 * MiB, WS_CUMF = 3 * MiB, WS_CK = 4 * MiB, WS_CV = 5 * MiB, WS_IMP = 6 * MiB;
constexpr size_t WS_SEL = 10 * MiB, WS_EID = 11 * MiB, WS_WTS = 12 * MiB, WS_LIST = 13 * MiB, WS_GF = 16 * MiB;
constexpr size_t WS_H = 32 * MiB, WS_U = 64 * MiB, WS_O = 160 * MiB, WS_HID = 192 * MiB, WS_Y = 224 * MiB, WS_OB = 352 * MiB, WS_ORAW = 448 * MiB;
constexpr size_t WS_END = 973 * MiB;
constexpr size_t WS_VT = 936 * MiB;
constexpr size_t WS_CVT = 962 * MiB;
constexpr size_t WS_CUMF2 = 963 * MiB;
constexpr int CW_Q = 8192 + 256;
constexpr size_t WS_CW1 = 964 * MiB;
constexpr size_t WS_CW2 = 968 * MiB;
constexpr size_t WS_CPB = 969 * MiB;
constexpr size_t WS_LSF = 970 * MiB;
constexpr size_t WS_WR = 971 * MiB;
constexpr int CW_CNT = 16384;
constexpr int CW_KN = 12544;

typedef unsigned short bf16_t;
typedef float f32x4v __attribute__((ext_vector_type(4)));
DEV int vt_row(int n) { return n < 1024 ? n - 896 : (n < 1280 ? 128 + n - 1152 : (n < 2048 ? 256 + n - 1792 : 512 + n - 2560)); }
DEV bool is_vcol(int n) { return (n >= C_VS && n < C_KW) || (n >= C_VW && n < C_QB) || (n >= C_VB && n < C_QC) || (n >= C_VCC && n < 2816); }
DEV float bf2f(bf16_t v) { return __uint_as_float((unsigned)v << 16); }
DEV bf16_t f2bf(float f) { unsigned u = __float_as_uint(f); return (bf16_t)((u + 0x7fffu + ((u >> 16) & 1u)) >> 16); }
DEV float4 ld_bf4(const bf16_t* p) { const ushort4 u = *(const ushort4*)p; return make_float4(bf2f(u.x), bf2f(u.y), bf2f(u.z), bf2f(u.w)); }
typedef float f32x2_t __attribute__((ext_vector_type(2)));
typedef __bf16 bf16x2_t __attribute__((ext_vector_type(2)));
DEV unsigned cvtpk(float lo, float hi) { f32x2_t v = {lo, hi}; bf16x2_t b = __builtin_convertvector(v, bf16x2_t); return __builtin_bit_cast(unsigned, b); }
DEV float sigmoidf_(float x) { return 1.f / (1.f + expf(-x)); }
DEV float logsigmoidf_(float x) { return fminf(x, 0.f) - log1pf(expf(-fabsf(x))); }
DEV float wave_sum(float v) {
#pragma unroll
    for (int o = 1; o < 64; o <<= 1) v += __shfl_xor(v, o);
    return v;
}

#define XB_TMO      128
#define XB_XCNT(j)  (256  + 64 * (j))
#define XB_XSUB(j)  (1280 + 64 * (j))
#define XB_XGEN(j)  (2304 + 64 * (j))
#define XB_TOP      3328
#define XB_TOPGEN   3392
#define XCD_BAR_WORDS 3456
#define XB_SPIN_CAP (1u << 23)
DEV unsigned xb_ld(unsigned* p)              { return __hip_atomic_load(p, __ATOMIC_RELAXED, __HIP_MEMORY_SCOPE_AGENT); }
DEV unsigned xb_add(unsigned* p, unsigned v) { return __hip_atomic_fetch_add(p, v, __ATOMIC_RELAXED, __HIP_MEMORY_SCOPE_AGENT); }
DEV unsigned xb_xcc_id() { return (unsigned)__builtin_amdgcn_s_getreg((3 << 11) | 20) & 0xFu; }
#define XB_SPIN(cond, bar) do { unsigned _sp = 0; while (cond) { __builtin_amdgcn_s_sleep(1); \
    if ((++_sp & 255u) == 0u) { if (xb_ld(&(bar)[XB_TMO])) break; if (_sp > XB_SPIN_CAP) { atomicAdd(&(bar)[XB_TMO], 1u); break; } } } } while (0)
struct XcdBarrier { unsigned* bar; unsigned x; volatile LAS unsigned* st; };
DEV XcdBarrier xcd_barrier_post(unsigned* bar, volatile LAS unsigned* st) {
    XcdBarrier b; b.bar = bar; b.x = xb_xcc_id(); b.st = st;
    if (threadIdx.x == 0) (void)xb_add(&bar[XB_XCNT(b.x)], 1u);
    return b;
}
DEV void xcd_barrier_complete(unsigned* bar, unsigned x, unsigned& nloc, unsigned& nx) {
    const unsigned G = gridDim.x * gridDim.y * gridDim.z;
    unsigned sum, cnt, mine, sp = 0u;
    for (;;) {
        sum = 0u; cnt = 0u; mine = 0u;
#pragma unroll
        for (unsigned j = 0; j < 16; ++j) { const unsigned c = xb_ld(&bar[XB_XCNT(j)]); sum += c; cnt += (c > 0u) ? 1u : 0u; mine = (j == x) ? c : mine; }
        if (sum == G) break;
        __builtin_amdgcn_s_sleep(1);
        if ((++sp & 255u) == 0u) { if (xb_ld(&bar[XB_TMO])) break; if (sp > XB_SPIN_CAP) { atomicAdd(&bar[XB_TMO], 1u); break; } }
    }
    nloc = mine > 0u ? mine : 1u; nx = cnt > 0u ? cnt : 1u;
}
DEV void xcd_barrier(const XcdBarrier& b) {
    asm volatile("s_waitcnt vmcnt(0)" ::: "memory");
    __syncthreads();
    if (threadIdx.x == 0) {
        unsigned* bar = b.bar;
        __builtin_amdgcn_s_waitcnt(0);
        unsigned nloc = b.st[0], nx = b.st[1];
        if (nloc == 0u) { xcd_barrier_complete(bar, b.x, nloc, nx); b.st[0] = nloc; b.st[1] = nx; }
        const unsigned old = xb_add(&bar[XB_XSUB(b.x)], 1u);
        const unsigned gen = old / nloc;
        if (old + 1u == (gen + 1u) * nloc) {
            __builtin_amdgcn_fence(__ATOMIC_RELEASE, "agent");
            asm volatile("s_waitcnt vmcnt(0)" ::: "memory");
            const unsigned og = xb_add(&bar[XB_TOP], 1u);
            const unsigned tg = og / nx;
            if (og + 1u == (tg + 1u) * nx) xb_add(&bar[XB_TOPGEN], 1u);
            else XB_SPIN(xb_ld(&bar[XB_TOPGEN]) == tg, bar);
            __builtin_amdgcn_fence(__ATOMIC_ACQUIRE, "agent");
            xb_add(&bar[XB_XGEN(b.x)], 1u);
            asm volatile("s_waitcnt vmcnt(0)" ::: "memory");
        } else {
            XB_SPIN(xb_ld(&bar[XB_XGEN(b.x)]) == gen, bar);
            __builtin_amdgcn_fence(__ATOMIC_ACQUIRE, "agent");
            asm volatile("s_waitcnt vmcnt(0)" ::: "memory");
        }
    }
    __syncthreads();
}

struct P {
    const float *x, *c, *norm1_g, *norm2_g, *ada_w, *ada_b, *w_in, *b_forget, *cmp_pos_k, *cmp_w1_k, *cmp_w2_k,
        *cmp_pos_v, *cmp_w1_v, *cmp_w2_v, *out_norm_g, *w_out, *rg_w, *rg_b, *re_w, *re_b, *e_w1, *e_w3, *e_w2, *final_g;
    float* out; unsigned char* ws;
};
struct V {
    unsigned* ctl; float* mod; float* rcos; float* rsin; float* cumf; bf16_t* ck; bf16_t* cv; float* imp; unsigned* sel;
    int* eid; float* wts; int* list; float* gf; bf16_t* H; bf16_t* U; bf16_t* O; bf16_t* HID; bf16_t* Y; float* OB; float* ORAW; float* X; bf16_t* XB;
};
DEV int otid() { int t = threadIdx.x; asm volatile("" : "+v"(t)); return t; }
DEV int obid() { int t = blockIdx.x; asm volatile("" : "+s"(t)); return t; }
DEV V make_views(const P& p) {
    V v; size_t woff = 0; asm volatile("" : "+s"(woff)); unsigned char* w = p.ws + woff;
    v.ctl = (unsigned*)(w + WS_CTL); v.mod = (float*)(w + WS_MOD); v.rcos = (float*)(w + WS_ROPE); v.rsin = v.rcos + S * 8;
    v.cumf = (float*)(w + WS_CUMF); v.ck = (bf16_t*)(w + WS_CK); v.cv = (bf16_t*)(w + WS_CV); v.imp = (float*)(w + WS_IMP);
    v.sel = (unsigned*)(w + WS_SEL); v.eid = (int*)(w + WS_EID); v.wts = (float*)(w + WS_WTS); v.list = (int*)(w + WS_LIST);
    v.gf = (float*)(w + WS_GF); v.H = (bf16_t*)(w + WS_H); v.U = (bf16_t*)(w + WS_U); v.O = (bf16_t*)(w + WS_O);
    v.HID = (bf16_t*)(w + WS_HID); v.Y = (bf16_t*)(w + WS_Y); v.OB = (float*)(w + WS_OB); v.ORAW = (float*)(w + WS_ORAW); v.X = p.out; v.XB = (bf16_t*)(w + WS_ORAW);
    return v;
}

DEV void ph_prologue(const P& p, float* lds) {
    const V v = make_views(p); const int TIDX = otid(), BIDX = obid();
    const int tid = TIDX;
    for (int i = tid; i < NB * D; i += 256) { const float c = p.c[i]; lds[i] = c / (1.f + expf(-c)); }
    __syncthreads();
    float* red = lds + NB * D;
    const int c4 = tid & 15, ks = tid >> 4;
    for (int unit = BIDX; unit < DEPTH * 96; unit += gridDim.x) {
        const int l = unit / 96, n0 = (unit % 96) * 64;
        const float* W = p.ada_w + (size_t)l * D * 6144 + n0 + 4 * c4;
        float acc[8][4];
#pragma unroll
        for (int b = 0; b < 8; ++b)
#pragma unroll
            for (int q = 0; q < 4; ++q) acc[b][q] = 0.f;
#pragma unroll 1
        for (int i0 = 0; i0 < 64; i0 += 8) {
            f32x4v w[8];
#pragma unroll
            for (int i = 0; i < 8; ++i) w[i] = __builtin_nontemporal_load((const f32x4v*)(W + (size_t)(ks + 16 * (i0 + i)) * 6144));
#pragma unroll
            for (int i = 0; i < 8; ++i) {
                const int k = ks + 16 * (i0 + i);
#pragma unroll
                for (int b = 0; b < 8; ++b) {
                    const float cv = lds[b * D + k];
                    acc[b][0] += cv * w[i].x; acc[b][1] += cv * w[i].y; acc[b][2] += cv * w[i].z; acc[b][3] += cv * w[i].w;
                }
            }
        }
#pragma unroll
        for (int b = 0; b < 8; ++b) *(float4*)(red + (ks * 8 + b) * 64 + 4 * c4) = make_float4(acc[b][0], acc[b][1], acc[b][2], acc[b][3]);
        __syncthreads();
        for (int o = tid; o < 512; o += 256) {
            const int c2 = o & 63, b = o >> 6;
            float sm = p.ada_b[l * 6144 + n0 + c2];
#pragma unroll
            for (int q = 0; q < 16; ++q) sm += red[(q * 8 + b) * 64 + c2];
            v.mod[(size_t)(l * 8 + b) * 6144 + n0 + c2] = sm;
        }
        __syncthreads();
    }
    const float cst = -2.0f * 13.122363377404328f / 16.0f;
    for (int i = ((int)gridDim.x - 1 - BIDX) * 256 + tid; i < S * 8; i += gridDim.x * 256) {
        const int s = i >> 3, j = i & 7;
        const float inv = expf((float)j * cst);
        const float ang = (float)s * inv;
        v.rcos[i] = cosf(ang); v.rsin[i] = sinf(ang);
    }
}

DEV void ph_norm1(const P& p, int l, int mode) {
    const V v = make_views(p); const int TIDX = otid(), BIDX = obid();
    const int lane = TIDX & 63;
    const int gw = (BIDX * 256 + TIDX) >> 6, nw = gridDim.x * 4;
    for (int m0 = gw; m0 < T; m0 += 2 * nw) {
        float4 xv[2][4];
        if (mode == 0) {
#pragma unroll
            for (int rr = 0; rr < 2; ++rr)
#pragma unroll
                for (int j = 0; j < 4; ++j) xv[rr][j] = *(const float4*)(p.x + (size_t)(m0 + rr * nw) * D + 4 * lane + 256 * j);
        } else {
            ushort4 xa[2][4], ya[2][4], yb[2][4];
#pragma unroll
            for (int rr = 0; rr < 2; ++rr)
#pragma unroll
                for (int j = 0; j < 4; ++j) {
                    const int m = m0 + rr * nw, c = 4 * lane + 256 * j;
                    xa[rr][j] = *(const ushort4*)(v.XB + (size_t)m * D + c);
                    ya[rr][j] = *(const ushort4*)(v.Y + (size_t)(2 * m) * D + c); yb[rr][j] = *(const ushort4*)(v.Y + (size_t)(2 * m + 1) * D + c);
                }
#pragma unroll
            for (int rr = 0; rr < 2; ++rr) {
                const float* g2 = v.mod + (size_t)((l - 1) * 8 + ((m0 + rr * nw) >> 11)) * 6144 + 5 * D;
#pragma unroll
                for (int j = 0; j < 4; ++j) {
                    const float4 g = *(const float4*)(g2 + 4 * lane + 256 * j);
                    float4 a = make_float4(bf2f(xa[rr][j].x), bf2f(xa[rr][j].y), bf2f(xa[rr][j].z), bf2f(xa[rr][j].w));
                    a.x += g.x * (bf2f(ya[rr][j].x) + bf2f(yb[rr][j].x)); a.y += g.y * (bf2f(ya[rr][j].y) + bf2f(yb[rr][j].y));
                    a.z += g.z * (bf2f(ya[rr][j].z) + bf2f(yb[rr][j].z)); a.w += g.w * (bf2f(ya[rr][j].w) + bf2f(yb[rr][j].w));
                    xv[rr][j] = a;
                }
            }
        }
        float ss[2];
#pragma unroll
        for (int rr = 0; rr < 2; ++rr) {
            ss[rr] = 0.f;
#pragma unroll
            for (int j = 0; j < 4; ++j) ss[rr] += xv[rr][j].x * xv[rr][j].x + xv[rr][j].y * xv[rr][j].y + xv[rr][j].z * xv[rr][j].z + xv[rr][j].w * xv[rr][j].w;
        }
#pragma unroll
        for (int o = 1; o < 64; o <<= 1) { ss[0] += __shfl_xor(ss[0], o); ss[1] += __shfl_xor(ss[1], o); }
#pragma unroll
        for (int rr = 0; rr < 2; ++rr) {
            const int m = m0 + rr * nw, b = m >> 11;
            const float r = rsqrtf(ss[rr] * (1.f / D) + EPS);
            if (mode == 2) {
#pragma unroll
                for (int j = 0; j < 4; ++j) {
                    const int c = 4 * lane + 256 * j;
                    const float4 g = *(const float4*)(p.final_g + c);
                    float4 o; o.x = xv[rr][j].x * r * g.x; o.y = xv[rr][j].y * r * g.y; o.z = xv[rr][j].z * r * g.z; o.w = xv[rr][j].w * r * g.w;
                    *(float4*)(v.X + (size_t)m * D + c) = o;
                }
            } else {
                const float* md = v.mod + (size_t)(l * 8 + b) * 6144;
#pragma unroll
                for (int j = 0; j < 4; ++j) {
                    const int c = 4 * lane + 256 * j;
                    { uint2 xo; xo.x = cvtpk(xv[rr][j].x, xv[rr][j].y); xo.y = cvtpk(xv[rr][j].z, xv[rr][j].w); *(uint2*)(v.XB + (size_t)m * D + c) = xo; }
                    const float4 g = *(const float4*)(p.norm1_g + l * D + c), sh = *(const float4*)(md + c), sc = *(const float4*)(md + D + c);
                    uint2 o;
                    o.x = cvtpk(xv[rr][j].x * r * g.x * (1.f + sc.x) + sh.x, xv[rr][j].y * r * g.y * (1.f + sc.y) + sh.y);
                    o.y = cvtpk(xv[rr][j].z * r * g.z * (1.f + sc.z) + sh.z, xv[rr][j].w * r * g.w * (1.f + sc.w) + sh.w);
                    *(uint2*)(v.H + (size_t)m * D + c) = o;
                }
            }
        }
    }
}

typedef short bf16x8 __attribute__((ext_vector_type(8)));
typedef float f32x16 __attribute__((ext_vector_type(16)));
typedef unsigned u32x4 __attribute__((ext_vector_type(4)));
constexpr size_t WS_WIN = 512 * MiB, WS_WOT = 544 * MiB, WS_W13 = 552 * MiB, WS_W2 = 808 * MiB;
constexpr int NPW = 2944;
DEV int tile_off(int row, int chunk) { return row * 128 + ((chunk ^ ((row >> 1) & 7)) << 4); }
template <class RM>
DEV void conv_patch(const float* src, int N, int K, bf16_t* dst, int k0, int n0, RM rowmap, int lane) {
    const int kg = lane >> 3, n = n0 + 4 * (lane & 7);
    if (n >= N) return;
    const float* sp = src + (size_t)(k0 + 8 * kg) * N + n;
    f32x4v x[8];
#pragma unroll
    for (int j = 0; j < 8; ++j) x[j] = __builtin_nontemporal_load((const f32x4v*)(sp + (size_t)j * N));
    bf16_t* dp = dst + k0 + 8 * kg;
    u32x4 o;
    o.x = cvtpk(x[0].x, x[1].x); o.y = cvtpk(x[2].x, x[3].x); o.z = cvtpk(x[4].x, x[5].x); o.w = cvtpk(x[6].x, x[7].x);
    *(u32x4*)(dp + (size_t)rowmap(n) * K) = o;
    o.x = cvtpk(x[0].y, x[1].y); o.y = cvtpk(x[2].y, x[3].y); o.z = cvtpk(x[4].y, x[5].y); o.w = cvtpk(x[6].y, x[7].y);
    *(u32x4*)(dp + (size_t)rowmap(n + 1) * K) = o;
    o.x = cvtpk(x[0].z, x[1].z); o.y = cvtpk(x[2].z, x[3].z); o.z = cvtpk(x[4].z, x[5].z); o.w = cvtpk(x[6].z, x[7].z);
    *(u32x4*)(dp + (size_t)rowmap(n + 2) * K) = o;
    o.x = cvtpk(x[0].w, x[1].w); o.y = cvtpk(x[2].w, x[3].w); o.z = cvtpk(x[4].w, x[5].w); o.w = cvtpk(x[6].w, x[7].w);
    *(u32x4*)(dp + (size_t)rowmap(n + 3) * K) = o;
}

DEV void conv8(const float* s0, const float* s1, bf16_t* dst) {
    f32x4v a = {0.f, 0.f, 0.f, 0.f}, b = {0.f, 0.f, 0.f, 0.f};
    if (s0) a = __builtin_nontemporal_load((const f32x4v*)s0);
    if (s1) b = __builtin_nontemporal_load((const f32x4v*)s1);
    u32x4 o; o.x = cvtpk(a[0], a[1]); o.y = cvtpk(a[2], a[3]); o.z = cvtpk(b[0], b[1]); o.w = cvtpk(b[2], b[3]);
    *(u32x4*)dst = o;
}
DEV void ph_convert_dense(const P& p, int l, int which) {
    const int TIDX = otid(), BIDX = obid();
    size_t woff = 0; asm volatile("" : "+s"(woff)); unsigned char* w = p.ws + woff;
    const size_t gtid = (size_t)BIDX * 256 + TIDX, gsz = (size_t)gridDim.x * 256;
    if (which == 0) {
        bf16_t* win = (bf16_t*)(w + WS_WIN);
        for (size_t i = gtid; i < (size_t)D * 368; i += gsz) {
            const int g8 = (int)(i % 368); const size_t lk = (size_t)l * D + i / 368;
            const int n = g8 * 8;
            const float* row = p.w_in + lk * DIN;
            const float *s0, *s1;
            if (n < 2816) { const int oc = n + (n >= 2048 ? 28 : (n >= 1280 ? 24 : 0)); s0 = row + oc; s1 = row + oc + 4; }
            else if (n < 2840) { s0 = row + 1280 + (n - 2816); s1 = s0 + 4; }
            else if (n == 2840) { s0 = row + 2072; s1 = nullptr; }
            else { s0 = nullptr; s1 = nullptr; }
            conv8(s0, s1, win + lk * NPW + n);
        }
    } else {
        bf16_t* wot = (bf16_t*)(w + WS_WOT);
        const size_t oo = (size_t)l * D * D;
        for (size_t i = gtid; i < (size_t)D * D / 8; i += gsz) conv8(p.w_out + oo + i * 8, p.w_out + oo + i * 8 + 4, wot + oo + i * 8);
        for (size_t i = gtid; i < (size_t)2 * 2048 * 128 / 8; i += gsz) {
            const size_t per = (size_t)2048 * 128 / 8; const int kv = (int)(i / per), lk = l * 2 + kv; const size_t off = (i % per) * 8;
            const float* src = (kv ? p.cmp_w1_v : p.cmp_w1_k) + (size_t)l * 2048 * 128 + off;
            conv8(src, src + 4, (bf16_t*)(w + WS_CW1) + (size_t)lk * 2048 * 128 + off);
        }
    }
}
DEV void ph_convert_experts(const P& p, int l) {
    const int TIDX = otid(), BIDX = obid();
    size_t woff = 0; asm volatile("" : "+s"(woff)); unsigned char* w = p.ws + woff;
    bf16_t* w13 = (bf16_t*)(w + WS_W13); bf16_t* w2t = (bf16_t*)(w + WS_W2);
    const size_t gtid = (size_t)BIDX * 256 + TIDX, gsz = (size_t)gridDim.x * 256;
    {
        const size_t N13 = (size_t)32 * D * 128;
#pragma unroll 1
        for (size_t i0 = gtid; i0 < N13; i0 += 8 * gsz) {
            f32x4v a[8], b[8];
#pragma unroll
            for (int k = 0; k < 8; ++k) {
                const size_t i = i0 + (size_t)k * gsz;
                if (i < N13) {
                    const int g8 = (int)(i & 127); const size_t lek = (size_t)l * 32 * D + (i >> 7);
                    const int n = g8 * 8, which = (n >> 5) & 1, c = 32 * (n >> 6) + (n & 31);
                    const float* s = (which ? p.e_w3 : p.e_w1) + lek * 512 + c;
                    a[k] = __builtin_nontemporal_load((const f32x4v*)s); b[k] = __builtin_nontemporal_load((const f32x4v*)(s + 4));
                }
            }
#pragma unroll
            for (int k = 0; k < 8; ++k) {
                const size_t i = i0 + (size_t)k * gsz;
                if (i < N13) {
                    const int g8 = (int)(i & 127); const size_t lek = (size_t)l * 32 * D + (i >> 7);
                    u32x4 o; o.x = cvtpk(a[k][0], a[k][1]); o.y = cvtpk(a[k][2], a[k][3]); o.z = cvtpk(b[k][0], b[k][1]); o.w = cvtpk(b[k][2], b[k][3]);
                    *(u32x4*)(w13 + lek * 1024 + g8 * 8) = o;
                }
            }
        }
    }
    {
        const size_t o2 = (size_t)l * 32 * 512 * D, N2 = (size_t)32 * 512 * D / 8;
#pragma unroll 1
        for (size_t i0 = gtid; i0 < N2; i0 += 8 * gsz) {
            f32x4v a[8], b[8];
#pragma unroll
            for (int k = 0; k < 8; ++k) {
                const size_t i = i0 + (size_t)k * gsz;
                if (i < N2) { const float* s = p.e_w2 + o2 + i * 8; a[k] = __builtin_nontemporal_load((const f32x4v*)s); b[k] = __builtin_nontemporal_load((const f32x4v*)(s + 4)); }
            }
#pragma unroll
            for (int k = 0; k < 8; ++k) {
                const size_t i = i0 + (size_t)k * gsz;
                if (i < N2) {
                    u32x4 o; o.x = cvtpk(a[k][0], a[k][1]); o.y = cvtpk(a[k][2], a[k][3]); o.z = cvtpk(b[k][0], b[k][1]); o.w = cvtpk(b[k][2], b[k][3]);
                    *(u32x4*)(w2t + o2 + i * 8) = o;
                }
            }
        }
    }
}
DEV void ph_convert(const P& p, float* lds) {
    const int TIDX = otid(), BIDX = obid();
    size_t woff = 0; asm volatile("" : "+s"(woff)); unsigned char* w = p.ws + woff;
    const int lane = TIDX & 63;
    for (int unit = BIDX * 4 + (TIDX >> 6); unit < DEPTH * 2 * 4; unit += gridDim.x * 4) {
        const int lk = unit >> 2, t = unit & 3, l = lk >> 1, kv = lk & 1;
        conv_patch((kv ? p.cmp_w2_v : p.cmp_w2_k) + (size_t)l * 128 * 64, 64, 128, (bf16_t*)(w + WS_CW2) + (size_t)lk * 64 * 128, (t >> 1) * 64, (t & 1) * 32, [](int n) { return n; }, lane);
    }
    for (int o = BIDX * 256 + TIDX; o < DEPTH * 64 * D; o += gridDim.x * 256) {
        const int k = o & (D - 1), n = (o >> 10) & 63, l = o >> 16;
        const float val = n < 4 ? p.rg_w[((size_t)l * D + k) * 4 + n] : (n < 36 ? p.re_w[((size_t)l * D + k) * 32 + n - 4] : 0.f);
        const bf16_t hi = f2bf(val); const bf16_t lo = f2bf(val - bf2f(hi));
        bf16_t* wr = (bf16_t*)(w + WS_WR) + (size_t)l * 2 * 64 * D;
        wr[n * D + k] = hi; wr[64 * D + n * D + k] = lo;
    }
    int pu = (int)gridDim.x - 1 - BIDX - 64; if (pu < 0) pu += gridDim.x;
    for (int unit = pu; unit < DEPTH * 2 * 8; unit += gridDim.x) {
        const int lk = unit >> 3, ch = unit & 7, l = lk >> 1, kv = lk & 1, j = TIDX & 127, hf = TIDX >> 7;
        const float* pe = (kv ? p.cmp_pos_v : p.cmp_pos_k) + (size_t)l * 2048 + ch * 256 + hf * 128;
        const float* w1 = (kv ? p.cmp_w1_v : p.cmp_w1_k) + (size_t)l * 2048 * 128 + (size_t)(ch * 256 + hf * 128) * 128 + j;
        float a0 = 0.f, a1 = 0.f, a2 = 0.f, a3 = 0.f;
#pragma unroll 1
        for (int k0 = 0; k0 < 128; k0 += 32) {
            float wv[32];
#pragma unroll
            for (int k = 0; k < 32; ++k) wv[k] = w1[(size_t)(k0 + k) * 128];
#pragma unroll
            for (int k = 0; k < 32; k += 4) {
                a0 += pe[k0 + k] * wv[k]; a1 += pe[k0 + k + 1] * wv[k + 1];
                a2 += pe[k0 + k + 2] * wv[k + 2]; a3 += pe[k0 + k + 3] * wv[k + 3];
            }
        }
        const float a = (a0 + a1) + (a2 + a3);
        __syncthreads();
        if (hf) lds[j] = a;
        __syncthreads();
        if (!hf) ((float*)(w + WS_CPB))[(lk * 8 + ch) * 128 + j] = a + lds[j];
    }
}

typedef short v4i16_t __attribute__((ext_vector_type(4)));
DEV void gemm_issue0(unsigned char* lds, const bf16_t* const (&arow)[4], const bf16_t* Bsrc, const size_t ldb, const int TIDX) {
    const int lane = TIDX & 63, wave = TIDX >> 6;
    const int gsw = ((TIDX & 7) ^ ((TIDX >> 4) & 7)) * 8;
    const bf16_t* bg = Bsrc + (size_t)(4 * wave + (lane >> 4)) * ldb + ((lane & 15) ^ (((lane >> 4) << 2) | (wave & 3))) * 8;
    LAS unsigned char* l3 = (LAS unsigned char*)lds + __builtin_amdgcn_readfirstlane(wave) * 1024;
#pragma unroll
    for (int i = 0; i < 4; ++i) {
        __builtin_amdgcn_global_load_lds((const unsigned*)(arow[i] + gsw), (LAS unsigned*)(l3 + i * 4096), 16, 0, 0);
        __builtin_amdgcn_global_load_lds((const unsigned*)(bg + (size_t)(16 * i) * ldb), (LAS unsigned*)(l3 + 16384 + i * 4096), 16, 0, 0);
    }
}
template <bool SWAP, bool PRE = false>
DEV void gemm128(unsigned char* lds, const bf16_t* const (&arow)[4], const bf16_t* Bsrc, const size_t ldb, int K, f32x16 (&acc)[2][2], const int TIDX, const int astride = 64) {
    const int lane = TIDX & 63, wave = TIDX >> 6, wm = wave >> 1, wn = wave & 1, r = lane & 31, h = lane >> 5;
#pragma unroll
    for (int j = 0; j < 2; ++j)
#pragma unroll
        for (int i = 0; i < 2; ++i)
#pragma unroll
            for (int q = 0; q < 16; ++q) acc[j][i][q] = 0.f;
    const int gsw = ((TIDX & 7) ^ ((TIDX >> 4) & 7)) * 8;
    const bf16_t* ag[4];
#pragma unroll
    for (int i = 0; i < 4; ++i) ag[i] = arow[i] + gsw;
    const int brow = 4 * wave + (lane >> 4), bch = ((lane & 15) ^ (((lane >> 4) << 2) | (wave & 3))) * 8;
    const bf16_t* bg = Bsrc + (size_t)brow * ldb + bch;
    LAS unsigned char* l3 = (LAS unsigned char*)lds + __builtin_amdgcn_readfirstlane(wave) * 1024;
    LAS unsigned char* tb[2][2];
    {
        const int blk = (lane >> 4) & 1, q = (lane & 15) >> 2, pp = lane & 3;
#pragma unroll
        for (int j = 0; j < 2; ++j)
#pragma unroll
            for (int t = 0; t < 2; ++t) {
                const int row = 4 * t + 8 * h + q, ch = 4 * (2 * wn + j) + 2 * blk + (pp >> 1);
                tb[j][t] = (LAS unsigned char*)lds + 16384 + 256 * row + 16 * (ch ^ (((row & 3) << 2) | ((row >> 2) & 3))) + 8 * (pp & 1);
            }
    }
#define G_DMA(st_, kt_) do { _Pragma("unroll") for (int i = 0; i < 4; ++i) { \
        __builtin_amdgcn_global_load_lds((const unsigned*)(ag[i] + (size_t)(kt_) * astride), (LAS unsigned*)(l3 + (st_) + i * 4096), 16, 0, 0); \
        __builtin_amdgcn_global_load_lds((const unsigned*)(bg + ((size_t)(kt_) * 64 + 16 * i) * ldb), (LAS unsigned*)(l3 + (st_) + 16384 + i * 4096), 16, 0, 0); } } while (0)
    const int KT = K >> 6;
    if (!PRE) {
        __syncthreads();
        G_DMA(0, 0);
    }
    for (int kt = 0; kt < KT; ++kt) {
        asm volatile("s_waitcnt vmcnt(0) lgkmcnt(0)" ::: "memory");
        __builtin_amdgcn_s_barrier();
        asm volatile("" ::: "memory");
        if (kt + 1 < KT) G_DMA(((kt + 1) & 1) * 32768, kt + 1);
        const int so = (kt & 1) * 32768;
        const unsigned char* cur = lds + so;
#pragma unroll
        for (int kk = 0; kk < 4; ++kk) {
            bf16x8 af[2], wf[2];
#pragma unroll
            for (int i = 0; i < 2; ++i) af[i] = *(const bf16x8*)(cur + tile_off(64 * wm + 32 * i + r, 2 * kk + h));
#pragma unroll
            for (int j = 0; j < 2; ++j) {
                const v4i16_t lo = __builtin_amdgcn_ds_read_tr16_b64_v4i16((LAS v4i16_t*)(tb[j][0] + so + 4096 * kk));
                const v4i16_t hi = __builtin_amdgcn_ds_read_tr16_b64_v4i16((LAS v4i16_t*)(tb[j][1] + so + 4096 * kk));
                wf[j] = (bf16x8){lo[0], lo[1], lo[2], lo[3], hi[0], hi[1], hi[2], hi[3]};
            }
#pragma unroll
            for (int j = 0; j < 2; ++j)
#pragma unroll
                for (int i = 0; i < 2; ++i) acc[j][i] = SWAP ? __builtin_amdgcn_mfma_f32_32x32x16_bf16(af[i], wf[j], acc[j][i], 0, 0, 0)
                                                             : __builtin_amdgcn_mfma_f32_32x32x16_bf16(wf[j], af[i], acc[j][i], 0, 0, 0);
        }
    }
    __syncthreads();
#undef G_DMA
}

constexpr int CST = 272;
DEV void ctile_put(unsigned char* lds, int row, int col, float a, float b, float c, float d) {
    uint2 u; u.x = cvtpk(a, b); u.y = cvtpk(c, d);
    *(uint2*)(lds + row * CST + col * 2) = u;
}
template <int COLS, class RP>
DEV void ctile_flush(unsigned char* lds, const int TIDX, RP rowptr) {
    asm volatile("s_waitcnt lgkmcnt(0)" ::: "memory");
    __builtin_amdgcn_s_barrier();
    asm volatile("" ::: "memory");
    constexpr int CPR = COLS / 8, RPI = 256 / CPR;
#pragma unroll
    for (int it = 0; it < 128 / RPI; ++it) {
        const int row = it * RPI + TIDX / CPR, c16 = TIDX % CPR;
        bf16_t* dst = rowptr(row, it);
        const u32x4 val = *(const u32x4*)(lds + row * CST + c16 * 16);
        if (dst) *(u32x4*)(dst + c16 * 8) = val;
    }
}

DEV void ph_inproj_fast(const P& p, int l, unsigned char* lds) {
    const V v = make_views(p); const int TIDX = otid(), BIDX = obid();
    const bf16_t* W = (const bf16_t*)(p.ws + WS_WIN) + (size_t)l * D * NPW;
    const int lane = TIDX & 63, wave = TIDX >> 6, wm = wave >> 1, wn = wave & 1, r = lane & 31, h = lane >> 5;
    const bool xo = gridDim.x == 512;
    unsigned char* ct = lds + 32768;
    auto decode = [&](int it, int& mt, int& nt) -> int {
        if (xo) { if (it >= 6) return -1; const int lb = BIDX >> 3; nt = 8 * (it % 3) + (lb >> 3); mt = 16 * (BIDX & 7) + 8 * (it / 3) + (lb & 7); return nt < 23 ? 1 : 0; }
        const int unit = BIDX + it * (int)gridDim.x; if (unit >= 128 * 23) return -1; nt = unit / 128; mt = unit % 128; return 1;
    };
    auto issue = [&](int mt, int nt) {
        const bf16_t* ar[4];
#pragma unroll
        for (int i = 0; i < 4; ++i) ar[i] = v.H + (size_t)(mt * 128 + (TIDX >> 3) + 32 * i) * D;
        gemm_issue0(lds, ar, W + nt * 128, NPW, TIDX);
    };
    bool pre = false;
    for (int it = 0;; ++it) {
        int nt, mt;
        const int dv = decode(it, mt, nt);
        if (dv < 0) break;
        if (dv == 0) continue;
        const int m0 = mt * 128, n0 = nt * 128;
        const bf16_t* arow[4];
#pragma unroll
        for (int i = 0; i < 4; ++i) arow[i] = v.H + (size_t)(m0 + (TIDX >> 3) + 32 * i) * D;
        if (!pre) { __syncthreads(); issue(mt, nt); pre = true; }
        int itn = it + 1, mtn = 0, ntn = 0, dn;
        while ((dn = decode(itn, mtn, ntn)) == 0) ++itn;
        f32x16 acc[2][2];
        if (is_vcol(n0)) {
            gemm128<true, true>(lds, arow, W + n0, NPW, D, acc, TIDX);
            if (dn > 0) issue(mtn, ntn); else pre = false;
#pragma unroll
            for (int j = 0; j < 2; ++j)
#pragma unroll
                for (int i = 0; i < 2; ++i)
#pragma unroll
                    for (int g = 0; g < 4; ++g)
                        ctile_put(ct, 64 * wn + 32 * j + r, 64 * wm + 32 * i + 8 * g + 4 * h, acc[j][i][4 * g], acc[j][i][4 * g + 1], acc[j][i][4 * g + 2], acc[j][i][4 * g + 3]);
            bf16_t* vt = (bf16_t*)(p.ws + WS_VT) + ((size_t)(m0 >> 11) * 768 + vt_row(n0)) * S + (m0 & (S - 1));
            ctile_flush<128>(ct, TIDX, [&](int row, int) { return vt + (size_t)row * S; });
            continue;
        }
        const bool rope_tile = n0 < 512 || n0 == C_KS || n0 == C_KW;
        f32x4v rcs[2], rsn[2];
        if (rope_tile) {
#pragma unroll
            for (int i = 0; i < 2; ++i) {
                const int sp = (m0 + 64 * wm + 32 * i + r) & (S - 1);
                rcs[i] = *(const f32x4v*)(v.rcos + sp * 8 + 4 * h); rsn[i] = *(const f32x4v*)(v.rsin + sp * 8 + 4 * h);
            }
        }
        gemm128<false, true>(lds, arow, W + n0, NPW, D, acc, TIDX);
        if (dn > 0) issue(mtn, ntn); else pre = false;
        if (n0 == 2816) {
            if (wn == 0) {
#pragma unroll
                for (int i = 0; i < 2; ++i) {
                    const int m = m0 + 64 * wm + 32 * i + r;
#pragma unroll
                    for (int q = 0; q < 16; ++q) {
                        const int cc = (q & 3) + 8 * (q >> 2) + 4 * h;
                        if (cc < 24) v.gf[(size_t)m * 32 + cc] = acc[0][i][q];
                        else if (cc < 28) ((float*)(p.ws + WS_LSF))[(size_t)((m >> 11) * 4 + cc - 24) * S + (m & (S - 1))] = logsigmoidf_(acc[0][i][q] + p.b_forget[l * 4 + cc - 24]);
                    }
                }
            }
            continue;
        }
        if (n0 == C_KB || n0 == C_KB + 128) {
            float mx = 0.f;
#pragma unroll
            for (int i = 0; i < 2; ++i) {
                float s2 = 0.f;
#pragma unroll
                for (int j = 0; j < 2; ++j)
#pragma unroll
                    for (int q = 0; q < 16; ++q) s2 += acc[j][i][q] * acc[j][i][q];
                s2 += __shfl_xor(s2, 32);
                mx = fmaxf(mx, s2);
            }
#pragma unroll
            for (int o = 1; o < 32; o <<= 1) mx = fmaxf(mx, __shfl_xor(mx, o));
            if (lane == 0) atomicMax(v.ctl + CW_KN + (l * 8 + (m0 >> 11)) * 4 + ((n0 - C_KB) >> 6) + wn, __float_as_uint(mx));
        }
#pragma unroll
        for (int j = 0; j < 2; ++j) {
            const int nb = n0 + 64 * wn + 32 * j;
            const bool rope = ((nb & 63) == 0) && (nb < 512 || (nb >= C_KS && nb < C_VS) || (nb >= C_KW && nb < C_VW));
#pragma unroll
            for (int i = 0; i < 2; ++i) {
                f32x16 a = acc[j][i];
                if (rope) {
#pragma unroll
                    for (int q = 0; q < 4; ++q) { const float x1 = a[q], x2 = a[q + 4]; a[q] = x1 * rcs[i][q] - x2 * rsn[i][q]; a[q + 4] = x2 * rcs[i][q] + x1 * rsn[i][q]; }
                }
#pragma unroll
                for (int g = 0; g < 4; ++g) ctile_put(ct, 64 * wm + 32 * i + r, 64 * wn + 32 * j + 8 * g + 4 * h, a[4 * g], a[4 * g + 1], a[4 * g + 2], a[4 * g + 3]);
            }
        }
        bf16_t* ub = v.U + (size_t)m0 * NP + n0;
        ctile_flush<128>(ct, TIDX, [&](int row, int) { return ub + (size_t)row * NP; });
    }
}

DEV void ph_outproj_fast(const P& p, int l, unsigned char* lds) {
    const V v = make_views(p); const int TIDX = otid(), BIDX = obid();
    const bf16_t* W = (const bf16_t*)(p.ws + WS_WOT) + (size_t)l * D * D;
    const int lane = TIDX & 63, wave = TIDX >> 6, wm = wave >> 1, wn = wave & 1, r = lane & 31, h = lane >> 5;
    const bool xo = gridDim.x == 512;
    unsigned char* ct = lds + 32768;
    auto decode = [&](int it, int& mt, int& nt) -> bool {
        if (xo) { if (it >= 2) return false; const int lb = BIDX >> 3; nt = lb >> 3; mt = 16 * (BIDX & 7) + 8 * it + (lb & 7); return true; }
        const int unit = BIDX + it * (int)gridDim.x; if (unit >= 128 * 8) return false; nt = unit / 128; mt = unit % 128; return true;
    };
    auto issue = [&](int mt, int nt) {
        const bf16_t* ar[4];
#pragma unroll
        for (int i = 0; i < 4; ++i) ar[i] = v.O + (size_t)(mt * 128 + (TIDX >> 3) + 32 * i) * D;
        gemm_issue0(lds, ar, W + nt * 128, D, TIDX);
    };
    for (int it = 0;; ++it) {
        int nt, mt, ntn = 0, mtn = 0;
        if (!decode(it, mt, nt)) break;
        const bool hasn = decode(it + 1, mtn, ntn);
        const int m0 = mt * 128, n0 = nt * 128;
        const bf16_t* arow[4];
#pragma unroll
        for (int i = 0; i < 4; ++i) arow[i] = v.O + (size_t)(m0 + (TIDX >> 3) + 32 * i) * D;
        if (it == 0) { __syncthreads(); issue(mt, nt); }
        u32x4 xin[8];
#pragma unroll
        for (int it = 0; it < 8; ++it) xin[it] = *(const u32x4*)(v.XB + (size_t)(m0 + it * 16 + (TIDX >> 4)) * D + n0 + (TIDX & 15) * 8);
        f32x16 acc[2][2];
        gemm128<false, true>(lds, arow, W + n0, D, D, acc, TIDX);
        if (hasn) issue(mtn, ntn);
        const float* g1 = v.mod + (size_t)(l * 8 + (m0 >> 11)) * 6144 + 2 * D;
#pragma unroll
        for (int j = 0; j < 2; ++j)
#pragma unroll
            for (int i = 0; i < 2; ++i) {
                const int nb = n0 + 64 * wn + 32 * j + 4 * h;
#pragma unroll
                for (int g = 0; g < 4; ++g) {
                    const float4 gg = *(const float4*)(g1 + nb + 8 * g);
                    ctile_put(ct, 64 * wm + 32 * i + r, 64 * wn + 32 * j + 8 * g + 4 * h, gg.x * acc[j][i][4 * g], gg.y * acc[j][i][4 * g + 1], gg.z * acc[j][i][4 * g + 2], gg.w * acc[j][i][4 * g + 3]);
                }
            }
        asm volatile("s_waitcnt lgkmcnt(0)" ::: "memory");
        __builtin_amdgcn_s_barrier();
        asm volatile("" ::: "memory");
#pragma unroll
        for (int it = 0; it < 8; ++it) {
            const int row = it * 16 + (TIDX >> 4);
            const u32x4 uv = *(const u32x4*)(ct + row * CST + (TIDX & 15) * 16);
            u32x4 xn;
#pragma unroll
            for (int q = 0; q < 4; ++q)
                xn[q] = cvtpk(__uint_as_float(xin[it][q] << 16) + __uint_as_float(uv[q] << 16), __uint_as_float(xin[it][q] & 0xffff0000u) + __uint_as_float(uv[q] & 0xffff0000u));
            *(u32x4*)(v.XB + (size_t)(m0 + row) * D + n0 + (TIDX & 15) * 8) = xn;
        }
    }
}

DEV void ph_moe_up_fast(const P& p, int l, unsigned char* lds) {
    const V v = make_views(p); const int TIDX = otid(), BIDX = obid();
    const int lane = TIDX & 63, wave = TIDX >> 6, wm = wave >> 1, wn = wave & 1, r = lane & 31, h = lane >> 5;
    const unsigned* cnt = v.ctl + CW_CNT + l * 32 * 64;
    int* tp = (int*)(lds + 67584); int* rb = tp + 40;
    __syncthreads();
    if (TIDX < 64) {
        const int c = TIDX < 32 ? (int)cnt[TIDX * 64] : 0;
        int nu = ((c + 127) >> 7) * 8, cc = c;
#pragma unroll
        for (int o = 1; o < 32; o <<= 1) { const int a = __shfl_up(nu, o), b2 = __shfl_up(cc, o); if ((TIDX & 31) >= o) { nu += a; cc += b2; } }
        if (TIDX < 32) { tp[TIDX + 1] = nu; rb[TIDX + 1] = cc; if (TIDX == 0) { tp[0] = 0; rb[0] = 0; } }
    }
    __syncthreads();
    const int total = tp[32];
    unsigned char* ct = lds + 32768;
    struct UU { int e, base, nt, mt, nrow; const int* lst; const bf16_t* B; const bf16_t* ar[4]; };
    auto setup = [&](int unit, UU& u) {
        int e = 0;
#pragma unroll
        for (int st = 16; st > 0; st >>= 1) if (tp[e + st] <= unit) e += st;
        const int rem = unit - tp[e];
        u.e = e; u.base = rb[e]; u.nt = rem & 7; u.mt = rem >> 3;
        const int ce = rb[e + 1] - u.base;
        u.lst = v.list + (size_t)e * T + u.mt * 128;
        u.nrow = ce - u.mt * 128 < 128 ? ce - u.mt * 128 : 128;
        u.B = (const bf16_t*)(p.ws + WS_W13) + ((size_t)l * 32 + e) * 1024 * D + u.nt * 128;
#pragma unroll
        for (int i = 0; i < 4; ++i) { const int rr = (TIDX >> 3) + 32 * i; u.ar[i] = v.H + (size_t)(u.lst[rr < u.nrow ? rr : 0] >> 1) * D; }
    };
    int unit = BIDX;
    if (unit >= total) return;
    UU cu, nu;
    setup(unit, cu);
    __syncthreads();
    gemm_issue0(lds, cu.ar, cu.B, 1024, TIDX);
    for (;;) {
        const int un = unit + (int)gridDim.x;
        f32x16 acc[2][2];
        gemm128<false, true>(lds, cu.ar, cu.B, 1024, D, acc, TIDX);
        if (un < total) { setup(un, nu); gemm_issue0(lds, nu.ar, nu.B, 1024, TIDX); }
#pragma unroll
        for (int i = 0; i < 2; ++i)
#pragma unroll
            for (int g = 0; g < 4; ++g) {
                float o[4];
#pragma unroll
                for (int q = 0; q < 4; ++q) { const float a1 = acc[0][i][4 * g + q], a3 = acc[1][i][4 * g + q]; o[q] = a1 / (1.f + __expf(-a1)) * a3; }
                ctile_put(ct, 64 * wm + 32 * i + r, 32 * wn + 8 * g + 4 * h, o[0], o[1], o[2], o[3]);
            }
        bf16_t* hb = v.HID + (size_t)(cu.base + cu.mt * 128) * 512 + 64 * cu.nt;
        const int nrow = cu.nrow;
        ctile_flush<64>(ct, TIDX, [&](int row, int) { return row < nrow ? hb + (size_t)row * 512 : (bf16_t*)nullptr; });
        if (un >= total) break;
        unit = un; cu = nu;
    }
}
DEV void ph_moe_down_fast(const P& p, int l, unsigned char* lds) {
    const V v = make_views(p); const int TIDX = otid(), BIDX = obid();
    const int lane = TIDX & 63, wave = TIDX >> 6, wm = wave >> 1, wn = wave & 1, r = lane & 31, h = lane >> 5;
    const unsigned* cnt = v.ctl + CW_CNT + l * 32 * 64;
    int* tp = (int*)(lds + 67584); int* rb = tp + 40;
    __syncthreads();
    if (TIDX < 64) {
        const int c = TIDX < 32 ? (int)cnt[TIDX * 64] : 0;
        int nu = ((c + 127) >> 7) * 8, cc = c;
#pragma unroll
        for (int o = 1; o < 32; o <<= 1) { const int a = __shfl_up(nu, o), b2 = __shfl_up(cc, o); if ((TIDX & 31) >= o) { nu += a; cc += b2; } }
        if (TIDX < 32) { tp[TIDX + 1] = nu; rb[TIDX + 1] = cc; if (TIDX == 0) { tp[0] = 0; rb[0] = 0; } }
    }
    __syncthreads();
    const int total = tp[32];
    unsigned char* ct = lds + 32768;
    struct UD { int n0, nrow; const bf16_t* B; const bf16_t* ar[4]; float wrow[2]; int fslot[8]; };
    auto setup = [&](int unit, UD& u) {
        int e = 0;
#pragma unroll
        for (int st = 16; st > 0; st >>= 1) if (tp[e + st] <= unit) e += st;
        const int rem = unit - tp[e], base = rb[e];
        const int ce = rb[e + 1] - base, nt = rem & 7, mt = rem >> 3;
        const int* lst = v.list + (size_t)e * T + mt * 128;
        u.n0 = nt * 128;
        u.nrow = ce - mt * 128 < 128 ? ce - mt * 128 : 128;
        u.B = (const bf16_t*)(p.ws + WS_W2) + ((size_t)l * 32 + e) * 512 * D + u.n0;
#pragma unroll
        for (int i = 0; i < 4; ++i) { const int rr = (TIDX >> 3) + 32 * i; u.ar[i] = v.HID + (size_t)(base + mt * 128 + (rr < u.nrow ? rr : 0)) * 512; }
#pragma unroll
        for (int i = 0; i < 2; ++i) { const int mr = 64 * wm + 32 * i + r; u.wrow[i] = mr < u.nrow ? v.wts[lst[mr]] : 0.f; }
#pragma unroll
        for (int it = 0; it < 8; ++it) { const int row = it * 16 + (TIDX >> 4); u.fslot[it] = row < u.nrow ? lst[row] : -1; }
    };
    int unit = BIDX;
    if (unit >= total) return;
    UD cu, nu;
    setup(unit, cu);
    __syncthreads();
    gemm_issue0(lds, cu.ar, cu.B, D, TIDX);
    for (;;) {
        const int un = unit + (int)gridDim.x;
        f32x16 acc[2][2];
        gemm128<false, true>(lds, cu.ar, cu.B, D, 512, acc, TIDX);
        if (un < total) { setup(un, nu); gemm_issue0(lds, nu.ar, nu.B, D, TIDX); }
#pragma unroll
        for (int i = 0; i < 2; ++i) {
            const int mr = 64 * wm + 32 * i + r;
            const float w = cu.wrow[i];
#pragma unroll
            for (int j = 0; j < 2; ++j)
#pragma unroll
                for (int g = 0; g < 4; ++g)
                    ctile_put(ct, mr, 64 * wn + 32 * j + 8 * g + 4 * h, w * acc[j][i][4 * g], w * acc[j][i][4 * g + 1], w * acc[j][i][4 * g + 2], w * acc[j][i][4 * g + 3]);
        }
        const int n0 = cu.n0;
        ctile_flush<128>(ct, TIDX, [&](int, int it) { const int sl = cu.fslot[it]; return sl >= 0 ? v.Y + (size_t)sl * D + n0 : (bf16_t*)nullptr; });
        if (un >= total) break;
        unit = un; cu = nu;
    }
}

constexpr float SB_EPS = 1e-12f;
constexpr float LOG2E = 1.4426950408889634f, C2 = 0.125f * 1.4426950408889634f, LN2 = 0.6931471805599453f;
DEV float fexp2(float x) { return __builtin_amdgcn_exp2f(x); }
DEV float flog2(float x) { return __builtin_amdgcn_logf(x); }
DEV int swap23(int r) { return (r & ~12) | ((r & 4) << 1) | ((r & 8) >> 1); }

struct KVT { const bf16_t* k; int ks; const bf16_t* v; int vs; };
DEV void kv_load(const KVT& s, int kv0, const int TIDX, u32x4 (&rg)[4]) {
    const int c = TIDX & 7, r0 = TIDX >> 3;
    rg[0] = *(const u32x4*)(s.k + (size_t)(kv0 + r0) * s.ks + c * 8);
    rg[1] = *(const u32x4*)(s.k + (size_t)(kv0 + r0 + 32) * s.ks + c * 8);
    rg[2] = *(const u32x4*)(s.v + (size_t)r0 * s.vs + kv0 + c * 8);
    rg[3] = *(const u32x4*)(s.v + (size_t)(r0 + 32) * s.vs + kv0 + c * 8);
}
DEV void kv_store(unsigned char* st, const int TIDX, const u32x4 (&rg)[4]) {
    const int c = TIDX & 7, r0 = TIDX >> 3;
    *(u32x4*)(st + tile_off(r0, c)) = rg[0]; *(u32x4*)(st + tile_off(r0 + 32, c)) = rg[1];
    *(u32x4*)(st + 8192 + tile_off(r0, c)) = rg[2]; *(u32x4*)(st + 8192 + tile_off(r0 + 32, c)) = rg[3];
}
DEV bf16x8 scale_frag(bf16x8 v, float sc) {
    u32x4 u = __builtin_bit_cast(u32x4, v);
#pragma unroll
    for (int i = 0; i < 4; ++i) u[i] = cvtpk(__uint_as_float(u[i] << 16) * sc, __uint_as_float(u[i] & 0xffff0000u) * sc);
    return __builtin_bit_cast(bf16x8, u);
}
DEV float xhalf(float x) {
    const auto s = __builtin_amdgcn_permlane32_swap(__float_as_uint(x), __float_as_uint(x), false, false);
    return __uint_as_float((threadIdx.x & 32) ? s[0] : s[1]);
}
DEV float xhalf_max(float x) {
    const auto s = __builtin_amdgcn_permlane32_swap(__float_as_uint(x), __float_as_uint(x), false, false);
    return fmaxf(__uint_as_float(s[0]), __uint_as_float(s[1]));
}
DEV float xhalf_sum(float x) {
    const auto s = __builtin_amdgcn_permlane32_swap(__float_as_uint(x), __float_as_uint(x), false, false);
    return __uint_as_float(s[0]) + __uint_as_float(s[1]);
}
#define SB0() __builtin_amdgcn_sched_barrier(0)
DEV void score_tile(const unsigned char* Kt, const bf16x8 (&qf)[4], int r, int h, f32x16 (&p)[2]) {
    const int kr = swap23(r);
    const unsigned char* kb = Kt + tile_off(kr, h);
    auto ld = [&](int i) { const int blk = i & 1, s = i >> 1; return *(const bf16x8*)(Kt + tile_off(32 * blk + kr, 2 * s + h)); };
    (void)kb;
    f32x16 z;
#pragma unroll
    for (int q = 0; q < 16; ++q) z[q] = 0.f;
    bf16x8 f0 = ld(0), f1 = ld(1), f2 = ld(2), f3 = ld(3);
    SB0();
    p[0] = __builtin_amdgcn_mfma_f32_32x32x16_bf16(f0, qf[0], z, 0, 0, 0); f0 = ld(4); SB0();
    p[1] = __builtin_amdgcn_mfma_f32_32x32x16_bf16(f1, qf[0], z, 0, 0, 0); f1 = ld(5); SB0();
    p[0] = __builtin_amdgcn_mfma_f32_32x32x16_bf16(f2, qf[1], p[0], 0, 0, 0); f2 = ld(6); SB0();
    p[1] = __builtin_amdgcn_mfma_f32_32x32x16_bf16(f3, qf[1], p[1], 0, 0, 0); f3 = ld(7); SB0();
    p[0] = __builtin_amdgcn_mfma_f32_32x32x16_bf16(f0, qf[2], p[0], 0, 0, 0); SB0();
    p[1] = __builtin_amdgcn_mfma_f32_32x32x16_bf16(f1, qf[2], p[1], 0, 0, 0); SB0();
    p[0] = __builtin_amdgcn_mfma_f32_32x32x16_bf16(f2, qf[3], p[0], 0, 0, 0); SB0();
    p[1] = __builtin_amdgcn_mfma_f32_32x32x16_bf16(f3, qf[3], p[1], 0, 0, 0); SB0();
}
DEV void pv_tile(const unsigned char* Vt, const f32x16 (&p)[2], int r, int h, f32x16 (&o)[2]) {
    auto ld = [&](int i) { const int db = i & 1, pr = i >> 1; return *(const bf16x8*)(Vt + tile_off(32 * db + r, 2 * pr + h)); };
    auto pk = [&](int pr) {
        const int blk = pr >> 1, s = pr & 1;
        u32x4 w;
        w.x = cvtpk(p[blk][8 * s], p[blk][8 * s + 1]); w.y = cvtpk(p[blk][8 * s + 2], p[blk][8 * s + 3]);
        w.z = cvtpk(p[blk][8 * s + 4], p[blk][8 * s + 5]); w.w = cvtpk(p[blk][8 * s + 6], p[blk][8 * s + 7]);
        return __builtin_bit_cast(bf16x8, w);
    };
    bf16x8 f0 = ld(0), f1 = ld(1), f2 = ld(2), f3 = ld(3);
    SB0();
    bf16x8 pb = pk(0);
    SB0();
    o[0] = __builtin_amdgcn_mfma_f32_32x32x16_bf16(f0, pb, o[0], 0, 0, 0); f0 = ld(4); SB0();
    o[1] = __builtin_amdgcn_mfma_f32_32x32x16_bf16(f1, pb, o[1], 0, 0, 0); f1 = ld(5); pb = pk(1); SB0();
    o[0] = __builtin_amdgcn_mfma_f32_32x32x16_bf16(f2, pb, o[0], 0, 0, 0); f2 = ld(6); SB0();
    o[1] = __builtin_amdgcn_mfma_f32_32x32x16_bf16(f3, pb, o[1], 0, 0, 0); f3 = ld(7); pb = pk(2); SB0();
    o[0] = __builtin_amdgcn_mfma_f32_32x32x16_bf16(f0, pb, o[0], 0, 0, 0); SB0();
    o[1] = __builtin_amdgcn_mfma_f32_32x32x16_bf16(f1, pb, o[1], 0, 0, 0); pb = pk(3); SB0();
    o[0] = __builtin_amdgcn_mfma_f32_32x32x16_bf16(f2, pb, o[0], 0, 0, 0); SB0();
    o[1] = __builtin_amdgcn_mfma_f32_32x32x16_bf16(f3, pb, o[1], 0, 0, 0); SB0();
}

DEV void score_tile_a(LAS unsigned char* const (&ka)[4], const bf16x8 (&qf)[4], f32x16 (&p)[2]) {
    auto ld = [&](int i) { const int blk = i & 1, s = i >> 1; return *(const LAS bf16x8*)(ka[s] + 4096 * blk); };
    f32x16 z;
#pragma unroll
    for (int q = 0; q < 16; ++q) z[q] = 0.f;
    bf16x8 f0 = ld(0), f1 = ld(1), f2 = ld(2), f3 = ld(3);
    SB0();
    p[0] = __builtin_amdgcn_mfma_f32_32x32x16_bf16(f0, qf[0], z, 0, 0, 0); f0 = ld(4); SB0();
    p[1] = __builtin_amdgcn_mfma_f32_32x32x16_bf16(f1, qf[0], z, 0, 0, 0); f1 = ld(5); SB0();
    p[0] = __builtin_amdgcn_mfma_f32_32x32x16_bf16(f2, qf[1], p[0], 0, 0, 0); f2 = ld(6); SB0();
    p[1] = __builtin_amdgcn_mfma_f32_32x32x16_bf16(f3, qf[1], p[1], 0, 0, 0); f3 = ld(7); SB0();
    p[0] = __builtin_amdgcn_mfma_f32_32x32x16_bf16(f0, qf[2], p[0], 0, 0, 0); SB0();
    p[1] = __builtin_amdgcn_mfma_f32_32x32x16_bf16(f1, qf[2], p[1], 0, 0, 0); SB0();
    p[0] = __builtin_amdgcn_mfma_f32_32x32x16_bf16(f2, qf[3], p[0], 0, 0, 0); SB0();
    p[1] = __builtin_amdgcn_mfma_f32_32x32x16_bf16(f3, qf[3], p[1], 0, 0, 0); SB0();
}
DEV void pv_tile_a(LAS unsigned char* const (&va)[4], const f32x16 (&p)[2], f32x16 (&o)[2]) {
    auto ld = [&](int i) { const int db = i & 1, pr = i >> 1; return *(const LAS bf16x8*)(va[pr] + 4096 * db); };
    auto pk = [&](int pr) {
        const int blk = pr >> 1, s = pr & 1;
        u32x4 w;
        w.x = cvtpk(p[blk][8 * s], p[blk][8 * s + 1]); w.y = cvtpk(p[blk][8 * s + 2], p[blk][8 * s + 3]);
        w.z = cvtpk(p[blk][8 * s + 4], p[blk][8 * s + 5]); w.w = cvtpk(p[blk][8 * s + 6], p[blk][8 * s + 7]);
        return __builtin_bit_cast(bf16x8, w);
    };
    bf16x8 f0 = ld(0), f1 = ld(1), f2 = ld(2), f3 = ld(3);
    SB0();
    bf16x8 pb = pk(0);
    SB0();
    o[0] = __builtin_amdgcn_mfma_f32_32x32x16_bf16(f0, pb, o[0], 0, 0, 0); f0 = ld(4); SB0();
    o[1] = __builtin_amdgcn_mfma_f32_32x32x16_bf16(f1, pb, o[1], 0, 0, 0); f1 = ld(5); pb = pk(1); SB0();
    o[0] = __builtin_amdgcn_mfma_f32_32x32x16_bf16(f2, pb, o[0], 0, 0, 0); f2 = ld(6); SB0();
    o[1] = __builtin_amdgcn_mfma_f32_32x32x16_bf16(f3, pb, o[1], 0, 0, 0); f3 = ld(7); pb = pk(2); SB0();
    o[0] = __builtin_amdgcn_mfma_f32_32x32x16_bf16(f0, pb, o[0], 0, 0, 0); SB0();
    o[1] = __builtin_amdgcn_mfma_f32_32x32x16_bf16(f1, pb, o[1], 0, 0, 0); pb = pk(3); SB0();
    o[0] = __builtin_amdgcn_mfma_f32_32x32x16_bf16(f2, pb, o[0], 0, 0, 0); SB0();
    o[1] = __builtin_amdgcn_mfma_f32_32x32x16_bf16(f3, pb, o[1], 0, 0, 0); SB0();
}

template <int VAR>
DEV void attn_branch(unsigned char* lds, const KVT& src, const bf16x8 (&qf)[4], unsigned tmask, int wave_last, int t, int t_first,
                     unsigned selbits, const float* bias2, f32x16 (&o)[2], const int TIDX, const float qkb = 0.f) {
    const int lane = TIDX & 63, r = lane & 31, h = lane >> 5;
    const float NEG_INF = -__builtin_inff();
    float mrun = -1e30f, lrun = 0.f, rest = VAR == 3 ? 1.f : 0.f;
#pragma unroll
    for (int db = 0; db < 2; ++db)
#pragma unroll
        for (int q = 0; q < 16; ++q) o[db][q] = 0.f;
    u32x4 rg[4];
    LAS unsigned char* ka[4]; LAS unsigned char* va[4];
    {
        const int kr = swap23(r);
#pragma unroll
        for (int s = 0; s < 4; ++s) { ka[s] = (LAS unsigned char*)lds + tile_off(kr, 2 * s + h); va[s] = (LAS unsigned char*)lds + 8192 + tile_off(r, 2 * s + h); }
    }
    unsigned rem = tmask;
    unsigned wdone = 0u; int step = 0;
    volatile unsigned* sbf = (volatile unsigned*)(lds + 65536);
    int j = VAR >= 2 ? 31 - __builtin_clz(rem) : __builtin_ctz(rem);
    rem &= ~(1u << j);
    kv_load(src, 64 * j, TIDX, rg);
    __syncthreads();
    kv_store(lds, TIDX, rg);
    __syncthreads();
    int stage = 0;
    for (;;) {
        int jn = -1;
        if (rem) { jn = VAR >= 2 ? 31 - __builtin_clz(rem) : __builtin_ctz(rem); rem &= ~(1u << jn); kv_load(src, 64 * jn, TIDX, rg); }
        asm volatile("" ::: "memory"); __builtin_amdgcn_sched_barrier(0);
        if (j <= wave_last) {
            const unsigned char* Kt = lds + stage * 16384;
            f32x16 p[2];
            score_tile_a(ka, qf, p);
            const int kvb = 64 * j + 8 * h;
            if (VAR == 3) {
                const bool diag = 64 * j + 63 >= t_first;
                float gt[2][2];
                if (diag) {
#pragma unroll
                    for (int blk = 0; blk < 2; ++blk)
#pragma unroll
                        for (int s = 0; s < 2; ++s) {
                            float run = 1.f;
#pragma unroll
                            for (int q = 7; q >= 0; --q) {
                                const float ez = fexp2(p[blk][8 * s + q]);
                                float w = __builtin_amdgcn_rcpf(1.f + ez);
                                float beta = 1.f - w;
                                const bool valid = kvb + 32 * blk + 16 * s + q < t;
                                w = valid ? w : 1.f; beta = valid ? beta : 0.f;
                                p[blk][8 * s + q] = beta * run;
                                run *= w;
                            }
                            gt[blk][s] = run;
                        }
                } else {
#pragma unroll
                    for (int blk = 0; blk < 2; ++blk)
#pragma unroll
                        for (int s = 0; s < 2; ++s) {
                            float run = 1.f;
#pragma unroll
                            for (int q = 7; q >= 0; --q) {
                                const float rn = run * __builtin_amdgcn_rcpf(1.f + fexp2(p[blk][8 * s + q]));
                                p[blk][8 * s + q] = run - rn;
                                run = rn;
                            }
                            gt[blk][s] = run;
                        }
                }
                float og[2][2], pt[2][2];
#pragma unroll
                for (int blk = 0; blk < 2; ++blk)
#pragma unroll
                    for (int s = 0; s < 2; ++s) { og[blk][s] = xhalf(gt[blk][s]); pt[blk][s] = gt[blk][s] * og[blk][s]; }
                float above = rest;
#pragma unroll
                for (int pi = 3; pi >= 0; --pi) {
                    const int blk = pi >> 1, s = pi & 1;
                    const float carry = above * (h == 0 ? og[blk][s] : 1.f);
#pragma unroll
                    for (int q = 0; q < 8; ++q) p[blk][8 * s + q] *= carry;
                    above *= pt[blk][s];
                }
                rest = above;
                wdone = __all(rest < SB_EPS) ? 1u : 0u;
            } else {
                const bool need_causal = 64 * j + 63 > t_first;
                const bool need_win = VAR == 1 && (64 * j + 512 <= t_first + 31);
                const bool lane_on = VAR != 0 || ((selbits >> j) & 1u);
                if (VAR == 2) {
#pragma unroll
                    for (int blk = 0; blk < 2; ++blk)
#pragma unroll
                        for (int s = 0; s < 2; ++s) {
                            const float4 b0 = *(const float4*)(bias2 + kvb + 32 * blk + 16 * s), b1 = *(const float4*)(bias2 + kvb + 32 * blk + 16 * s + 4);
                            p[blk][8 * s] += b0.x; p[blk][8 * s + 1] += b0.y; p[blk][8 * s + 2] += b0.z; p[blk][8 * s + 3] += b0.w;
                            p[blk][8 * s + 4] += b1.x; p[blk][8 * s + 5] += b1.y; p[blk][8 * s + 6] += b1.z; p[blk][8 * s + 7] += b1.w;
                        }
                }
                if (need_causal) {
#pragma unroll
                    for (int blk = 0; blk < 2; ++blk)
#pragma unroll
                        for (int q = 0; q < 16; ++q) { const int kv = kvb + 32 * blk + 16 * (q >> 3) + (q & 7); p[blk][q] = kv <= t ? p[blk][q] : NEG_INF; }
                }
                if (need_win) {
#pragma unroll
                    for (int blk = 0; blk < 2; ++blk)
#pragma unroll
                        for (int q = 0; q < 16; ++q) { const int kv = kvb + 32 * blk + 16 * (q >> 3) + (q & 7); p[blk][q] = kv + 512 > t ? p[blk][q] : NEG_INF; }
                }
                float tmax = p[0][0];
#pragma unroll
                for (int q = 1; q < 16; ++q) tmax = fmaxf(tmax, p[0][q]);
#pragma unroll
                for (int q = 0; q < 16; ++q) tmax = fmaxf(tmax, p[1][q]);
                tmax = lane_on ? tmax : NEG_INF;
                tmax = xhalf_max(tmax);
                const float mnew = fmaxf(mrun, tmax);
                const bool grew = mnew > mrun;
                const float alpha = fexp2(mrun - mnew);
                mrun = mnew;
                const float msub = lane_on ? mnew : __builtin_inff();
                const f32x2_t ms2 = {msub, msub};
                f32x2_t ls2 = {0.f, 0.f};
#pragma unroll
                for (int blk = 0; blk < 2; ++blk)
#pragma unroll
                    for (int q = 0; q < 16; q += 2) {
                        const f32x2_t d2 = (f32x2_t){p[blk][q], p[blk][q + 1]} - ms2;
                        f32x2_t e2; e2.x = fexp2(d2.x); e2.y = fexp2(d2.y);
                        p[blk][q] = e2.x; p[blk][q + 1] = e2.y; ls2 += e2;
                    }
                lrun = lrun * alpha + (ls2.x + ls2.y);
                if (VAR == 2) wdone = __all(qkb + bias2[j > 0 ? 64 * j - 1 : 0] <= mrun - 40.f) ? 1u : 0u;
                if (__any(grew)) {
#pragma unroll
                    for (int db = 0; db < 2; ++db)
#pragma unroll
                        for (int q = 0; q < 16; ++q) o[db][q] *= alpha;
                }
            }
            pv_tile_a(va, p, o);
        }
        if (jn >= 0) kv_store(lds + (stage ^ 1) * 16384, TIDX, rg);
        if (VAR >= 2 && lane == 0) sbf[(step & 1) * 4 + (TIDX >> 6)] = wdone;
        __syncthreads();
        if (jn < 0) break;
        if (VAR >= 2) {
            const unsigned* f4 = (const unsigned*)sbf + (step & 1) * 4;
            if ((f4[0] & f4[1] & f4[2] & f4[3]) != 0u) break;
            ++step;
        }
        {
            const int dlt = stage ? -16384 : 16384;
#pragma unroll
            for (int s = 0; s < 4; ++s) { ka[s] += dlt; va[s] += dlt; }
        }
        j = jn; stage ^= 1;
    }
    if (VAR != 3) {
        const float lt = xhalf_sum(lrun);
        const float inv = lt > 0.f ? 1.f / lt : 0.f;
#pragma unroll
        for (int db = 0; db < 2; ++db)
#pragma unroll
            for (int q = 0; q < 16; ++q) o[db][q] *= inv;
    }
}

DEV void head_norm_store(const f32x16 (&o)[2], const float* gam, bf16_t* dst, int h) {
    float ss = 0.f;
#pragma unroll
    for (int db = 0; db < 2; ++db)
#pragma unroll
        for (int q = 0; q < 16; ++q) ss += o[db][q] * o[db][q];
    ss += __shfl_xor(ss, 32);
    const float rinv = rsqrtf(ss * (1.f / 64.f) + EPS);
#pragma unroll
    for (int db = 0; db < 2; ++db)
#pragma unroll
        for (int g = 0; g < 4; ++g) {
            const int d = 32 * db + 8 * g + 4 * h;
            const float4 gg = *(const float4*)(gam + d);
            uint2 u;
            u.x = cvtpk(o[db][4 * g] * rinv * gg.x, o[db][4 * g + 1] * rinv * gg.y);
            u.y = cvtpk(o[db][4 * g + 2] * rinv * gg.z, o[db][4 * g + 3] * rinv * gg.w);
            *(uint2*)(dst + d) = u;
        }
}

template <int VAR>
DEV void mha_unit(const P& p, int l, int unit, unsigned char* lds) {
    const V v = make_views(p); const int TIDX = otid();
    const int lane = TIDX & 63, wave = TIDX >> 6, r = lane & 31, h = lane >> 5;
    const int qb = 15 - (unit >> 5), bh = unit & 31, b = bh >> 2, hh = bh & 3;
    const int t0 = qb * 128, tw = t0 + 32 * wave, t = tw + r, m = b * S + t;
    const int qcol = VAR == 2 ? C_QB : C_QC, kcol = VAR == 2 ? C_KB : C_KCC, vrow = VAR == 2 ? 256 : 512, ocol = VAR == 2 ? 512 : 768;
    bf16x8 qf[4];
#pragma unroll
    for (int s = 0; s < 4; ++s) qf[s] = scale_frag(*(const bf16x8*)(v.U + (size_t)m * NP + qcol + hh * 64 + 16 * s + 8 * h), C2);
    KVT src;
    src.k = v.U + (size_t)b * S * NP + kcol + hh * 64; src.ks = NP;
    src.v = (const bf16_t*)(p.ws + WS_VT) + (size_t)(b * 768 + vrow + hh * 64) * S; src.vs = S;
    const int last = (t0 + 127) >> 6;
    const unsigned tmask = last == 31 ? 0xffffffffu : ((1u << (last + 1)) - 1u);
    const float* bias2 = (const float*)(lds + 32768);
    if (VAR == 2) {
        float* cf = (float*)(lds + 32768);
        float* wt = (float*)(lds + 32768 + 8192);
        const float* lsf = (const float*)(p.ws + WS_LSF) + (size_t)(b * 4 + hh) * S;
        const int nel = t0 + 128;
        float x[8];
        if (8 * TIDX < nel) {
            const float4 a0 = *(const float4*)(lsf + 8 * TIDX), a1 = *(const float4*)(lsf + 8 * TIDX + 4);
            x[0] = a0.x; x[1] = x[0] + a0.y; x[2] = x[1] + a0.z; x[3] = x[2] + a0.w; x[4] = x[3] + a1.x; x[5] = x[4] + a1.y; x[6] = x[5] + a1.z; x[7] = x[6] + a1.w;
        } else {
#pragma unroll
            for (int q = 0; q < 8; ++q) x[q] = 0.f;
        }
        float inc = x[7];
#pragma unroll
        for (int o = 1; o < 64; o <<= 1) { const float tt = __shfl_up(inc, o); if (lane >= o) inc += tt; }
        __syncthreads();
        if (lane == 63) wt[wave] = inc;
        __syncthreads();
        float off = inc - x[7];
#pragma unroll
        for (int w = 0; w < 3; ++w) off += (w < wave) ? wt[w] : 0.f;
        if (8 * TIDX < nel) {
#pragma unroll
            for (int q = 0; q < 8; ++q) cf[8 * TIDX + q] = -(x[q] + off) * LOG2E;
        }
        __syncthreads();
    }
    f32x16 o[2];
    float qkb = 0.f;
    if (VAR == 2) {
        float qq = 0.f;
#pragma unroll
        for (int s = 0; s < 4; ++s) {
            const u32x4 u = __builtin_bit_cast(u32x4, qf[s]);
#pragma unroll
            for (int q = 0; q < 4; ++q) { const float lo = __uint_as_float(u[q] << 16), hi = __uint_as_float(u[q] & 0xffff0000u); qq += lo * lo + hi * hi; }
        }
        qq = xhalf_sum(qq);
        const float kn2 = __uint_as_float(__hip_atomic_load(v.ctl + CW_KN + (l * 8 + b) * 4 + hh, __ATOMIC_RELAXED, __HIP_MEMORY_SCOPE_AGENT));
        qkb = sqrtf(qq) * sqrtf(kn2) * 1.01f;
    }
    attn_branch<VAR>(lds, src, qf, tmask, (tw + 31) >> 6, t, tw, 0u, bias2, o, TIDX, qkb);
    head_norm_store(o, p.out_norm_g + (size_t)l * D + ocol + hh * 64, v.O + (size_t)m * D + ocol + hh * 64, h);
}

DEV void nsa_unit(const P& p, int l, int unit, unsigned char* lds) {
    const V v = make_views(p); const int TIDX = otid();
    const int lane = TIDX & 63, wave = TIDX >> 6, r = lane & 31, h = lane >> 5;
    const int qblk = 63 - (unit >> 4), bg = unit & 15, b = bg >> 1, g = bg & 1;
    const int t0 = qblk * 32, t = t0 + r, m = b * S + t, head = g * 4 + wave, cur = t0 >> 6;
    const float NEG_INF = -__builtin_inff();
    bf16x8 qf[4];
#pragma unroll
    for (int s = 0; s < 4; ++s) qf[s] = scale_frag(*(const bf16x8*)(v.U + (size_t)m * NP + C_QA + head * 64 + 16 * s + 8 * h), C2);
    const float g0 = sigmoidf_(v.gf[(size_t)m * 32 + head * 3]), g1 = sigmoidf_(v.gf[(size_t)m * 32 + head * 3 + 1]), g2 = sigmoidf_(v.gf[(size_t)m * 32 + head * 3 + 2]);
    f32x16 otot[2];
    float* PA = (float*)(lds + 32768);
    float* PB = (float*)(lds + 49152);
    float* SC = (float*)lds;
    unsigned* MASK = (unsigned*)(lds + 8192);
    {
        const bf16_t* ck = v.ck + (size_t)(b * 2 + g) * 128 * 64;
        const bf16_t* cvt = (const bf16_t*)(p.ws + WS_CVT) + (size_t)(b * 2 + g) * 64 * 128;
        const int c = TIDX & 7, r0 = TIDX >> 3;
        u32x4 rk[4], rv[4];
#pragma unroll
        for (int i = 0; i < 4; ++i) rk[i] = *(const u32x4*)(ck + (size_t)(r0 + 32 * i) * 64 + c * 8);
#pragma unroll
        for (int i = 0; i < 4; ++i) rv[i] = *(const u32x4*)(cvt + (size_t)(r0 + 32 * (i & 1)) * 128 + 64 * (i >> 1) + c * 8);
        __syncthreads();
#pragma unroll
        for (int i = 0; i < 4; ++i) *(u32x4*)(lds + tile_off(r0 + 32 * i, c)) = rk[i];
#pragma unroll
        for (int i = 0; i < 4; ++i) *(u32x4*)(lds + 16384 + 8192 * (i >> 1) + tile_off(r0 + 32 * (i & 1), c)) = rv[i];
        __syncthreads();
        f32x16 ps[2][2];
        score_tile(lds, qf, r, h, ps[0]);
        score_tile(lds + 8192, qf, r, h, ps[1]);
        const int nvalid = t >= 31 ? (t - 31) / 16 + 1 : 0;
        float mx = NEG_INF;
#pragma unroll
        for (int tt = 0; tt < 2; ++tt)
#pragma unroll
            for (int blk = 0; blk < 2; ++blk)
#pragma unroll
                for (int q = 0; q < 16; ++q) {
                    const int n = 64 * tt + 32 * blk + 16 * (q >> 3) + 8 * h + (q & 7);
                    const float x = n < nvalid ? ps[tt][blk][q] : NEG_INF;
                    ps[tt][blk][q] = x; mx = fmaxf(mx, x);
                }
        mx = fmaxf(mx, __shfl_xor(mx, 32));
        const float mxs = nvalid > 0 ? mx : 0.f;
        float ls = 0.f;
#pragma unroll
        for (int tt = 0; tt < 2; ++tt)
#pragma unroll
            for (int blk = 0; blk < 2; ++blk)
#pragma unroll
                for (int q = 0; q < 16; ++q) { const float e = fexp2(ps[tt][blk][q] - mxs); ps[tt][blk][q] = e; ls += e; }
        const float lt = ls + __shfl_xor(ls, 32);
        const float inv = lt > 0.f ? 1.f / lt : 0.f;
#pragma unroll
        for (int tt = 0; tt < 2; ++tt)
#pragma unroll
            for (int blk = 0; blk < 2; ++blk) {
#pragma unroll
                for (int q = 0; q < 16; ++q) ps[tt][blk][q] *= inv;
#pragma unroll
                for (int s = 0; s < 2; ++s) {
                    const int G0 = 16 * tt + 8 * blk + 4 * s + 2 * h;
                    const float a0 = (ps[tt][blk][8 * s] + ps[tt][blk][8 * s + 1]) + (ps[tt][blk][8 * s + 2] + ps[tt][blk][8 * s + 3]);
                    const float a1 = (ps[tt][blk][8 * s + 4] + ps[tt][blk][8 * s + 5]) + (ps[tt][blk][8 * s + 6] + ps[tt][blk][8 * s + 7]);
                    PA[(wave * 32 + G0) * 32 + r] = a0; PA[(wave * 32 + G0 + 1) * 32 + r] = a1;
                    PB[(wave * 32 + G0 + 1) * 32 + r] = ps[tt][blk][8 * s + 3];
                    if (G0 + 2 < 32) PB[(wave * 32 + G0 + 2) * 32 + r] = ps[tt][blk][8 * s + 7];
                }
            }
        f32x16 oc[2];
#pragma unroll
        for (int db = 0; db < 2; ++db)
#pragma unroll
            for (int q = 0; q < 16; ++q) oc[db][q] = 0.f;
        pv_tile(lds + 16384, ps[0], r, h, oc);
        pv_tile(lds + 24576, ps[1], r, h, oc);
#pragma unroll
        for (int db = 0; db < 2; ++db)
#pragma unroll
            for (int q = 0; q < 16; ++q) otot[db][q] = g0 * oc[db][q];
    }
    __syncthreads();
    const bool need_topk = cur > 15;
    if (need_topk) {
        const int q = TIDX & 31, j0 = (TIDX >> 5) * 4;
#pragma unroll
        for (int jj = 0; jj < 4; ++jj) {
            const int j = j0 + jj;
            float sc = 0.f;
#pragma unroll
            for (int w = 0; w < 4; ++w) sc += PA[(w * 32 + j) * 32 + q];
            if (j > 0) {
#pragma unroll
                for (int w = 0; w < 4; ++w) sc += PB[(w * 32 + j) * 32 + q];
            }
            const bool forced = (j == 0) || (j == cur) || (j == cur - 1);
            SC[q * 33 + j] = forced ? 1.0e4f : (j <= cur ? sc : -1.0f);
        }
        if (TIDX < 32) MASK[TIDX] = 0u;
        __syncthreads();
        unsigned bits = 0u;
#pragma unroll
        for (int jj = 0; jj < 4; ++jj) {
            const int j = j0 + jj;
            const float vj = SC[q * 33 + j];
            int rank = 0;
#pragma unroll
            for (int i = 0; i < 32; ++i) { const float vi = SC[q * 33 + i]; rank += (vi > vj || (vi == vj && i < j)) ? 1 : 0; }
            if (rank < 16) bits |= 1u << j;
        }
        atomicOr(&MASK[q], bits);
        __syncthreads();
    }
    const unsigned upto = (2u << cur) - 1u;
    unsigned mybits = upto, um = upto;
    if (need_topk) {
        mybits = MASK[r];
        um = 0u;
#pragma unroll
        for (int i = 0; i < 32; ++i) um |= MASK[i];
        um = (unsigned)__builtin_amdgcn_readfirstlane((int)um);
    }
    {
        KVT src; src.k = v.U + (size_t)b * S * NP + C_KS + g * 64; src.ks = NP;
        src.v = (const bf16_t*)(p.ws + WS_VT) + (size_t)(b * 768 + g * 64) * S; src.vs = S;
        f32x16 o[2];
        attn_branch<0>(lds, src, qf, um & upto, cur, t, t0, mybits, nullptr, o, TIDX);
#pragma unroll
        for (int db = 0; db < 2; ++db)
#pragma unroll
            for (int q = 0; q < 16; ++q) otot[db][q] += g1 * o[db][q];
    }
    {
        KVT src; src.k = v.U + (size_t)b * S * NP + C_KW + g * 64; src.ks = NP;
        src.v = (const bf16_t*)(p.ws + WS_VT) + (size_t)(b * 768 + 128 + g * 64) * S; src.vs = S;
        const int f = (t0 - 511 > 0 ? t0 - 511 : 0) >> 6;
        const unsigned wmask = upto & ~((1u << f) - 1u);
        f32x16 o[2];
        attn_branch<1>(lds, src, qf, wmask, cur, t, t0, 0u, nullptr, o, TIDX);
#pragma unroll
        for (int db = 0; db < 2; ++db)
#pragma unroll
            for (int q = 0; q < 16; ++q) otot[db][q] += g2 * o[db][q];
    }
    head_norm_store(otot, p.out_norm_g + (size_t)l * D + head * 64, v.O + (size_t)m * D + head * 64, h);
}

constexpr int CW_CMPK = 12288;
DEV bool cmp_unit(const P& p, int l, int unit, int kq, unsigned char* lds, volatile LAS unsigned* qslot) {
    const V v = make_views(p); const int TIDX = otid();
    const int lane = TIDX & 63, wave = TIDX >> 6, wm = wave >> 1, wn = wave & 1, r = lane & 31, h = lane >> 5;
    const int kv = unit & 1, bg = unit >> 1, b = bg >> 1, g = bg & 1, lk = l * 2 + kv;
    const int col = (kv ? C_VC : C_KC) + g * 64;
    const bf16_t* arow[4];
#pragma unroll
    for (int i = 0; i < 4; ++i) { const int n = (TIDX >> 3) + 32 * i; arow[i] = v.U + (size_t)(b * S + 16 * (n < 127 ? n : 126) + 8 * kq) * NP + col; }
    f32x16 acc[2][2];
    gemm128<false>(lds, arow, (const bf16_t*)(p.ws + WS_CW1) + (size_t)lk * 2048 * 128 + (size_t)kq * 512 * 128, 128, 512, acc, TIDX, NP);
    {
        const __amdgpu_buffer_rsrc_t prs = __builtin_amdgcn_make_buffer_rsrc((void*)v.OB, (short)0, 32 * 4 * 65536, 0x00020000);
        const unsigned pbase = (unsigned)(unit * 4 + kq) * 65536u + (unsigned)TIDX * 16u;
#pragma unroll
        for (int j = 0; j < 2; ++j)
#pragma unroll
            for (int i = 0; i < 2; ++i)
#pragma unroll
                for (int g4 = 0; g4 < 4; ++g4) {
                    const f32x4v a = {acc[j][i][4 * g4], acc[j][i][4 * g4 + 1], acc[j][i][4 * g4 + 2], acc[j][i][4 * g4 + 3]};
                    __builtin_amdgcn_raw_buffer_store_b128(__builtin_bit_cast(u32x4, a), prs, pbase + (unsigned)((j * 2 + i) * 4 + g4) * 4096u, 0,   16);
                }
        asm volatile("s_waitcnt vmcnt(0)" ::: "memory");
        __syncthreads();
        if (TIDX == 0) *qslot = __hip_atomic_fetch_add(v.ctl + CW_CMPK + l * 32 + unit, 1u, __ATOMIC_RELAXED, __HIP_MEMORY_SCOPE_AGENT);
        __syncthreads();
        if (*qslot != 3u) return false;
        if (TIDX == 0) { __builtin_amdgcn_fence(__ATOMIC_ACQUIRE, "agent"); asm volatile("s_waitcnt vmcnt(0)" ::: "memory"); }
        __syncthreads();
        const float* pp = v.OB + (size_t)unit * 4 * 16384 + TIDX * 4;
#pragma unroll
        for (int j = 0; j < 2; ++j)
#pragma unroll
            for (int i = 0; i < 2; ++i)
#pragma unroll
                for (int g4 = 0; g4 < 4; ++g4) {
                    const float* q0 = pp + ((j * 2 + i) * 4 + g4) * 1024;
                    f32x4v a = *(const f32x4v*)q0;
#pragma unroll
                    for (int k2 = 1; k2 < 4; ++k2) { const f32x4v b2 = *(const f32x4v*)(q0 + k2 * 16384); a += b2; }
                    acc[j][i][4 * g4] = a[0]; acc[j][i][4 * g4 + 1] = a[1]; acc[j][i][4 * g4 + 2] = a[2]; acc[j][i][4 * g4 + 3] = a[3];
                }
    }
    const float* pb = (const float*)(p.ws + WS_CPB) + lk * 8 * 128;
#pragma unroll
    for (int j = 0; j < 2; ++j)
#pragma unroll
        for (int i = 0; i < 2; ++i) {
            const int mrow = 64 * wm + 32 * i + r;
#pragma unroll
            for (int g4 = 0; g4 < 4; ++g4) {
                float4 bb = *(const float4*)(pb + 64 * wn + 32 * j + 8 * g4 + 4 * h);
#pragma unroll
                for (int c8 = 1; c8 < 8; ++c8) { const float4 b2 = *(const float4*)(pb + c8 * 128 + 64 * wn + 32 * j + 8 * g4 + 4 * h); bb.x += b2.x; bb.y += b2.y; bb.z += b2.z; bb.w += b2.w; }
                float x0 = acc[j][i][4 * g4] + bb.x, x1 = acc[j][i][4 * g4 + 1] + bb.y, x2 = acc[j][i][4 * g4 + 2] + bb.z, x3 = acc[j][i][4 * g4 + 3] + bb.w;
                x0 = x0 / (1.f + __expf(-x0)); x1 = x1 / (1.f + __expf(-x1)); x2 = x2 / (1.f + __expf(-x2)); x3 = x3 / (1.f + __expf(-x3));
                uint2 u; u.x = cvtpk(x0, x1); u.y = cvtpk(x2, x3);
                *(uint2*)(lds + wn * 16384 + tile_off(mrow, 4 * j + g4) + 8 * h) = u;
            }
        }
    {
        const bf16_t* w2 = (const bf16_t*)(p.ws + WS_CW2) + (size_t)lk * 64 * 128;
        const int c = TIDX & 7, r0 = TIDX >> 3;
#pragma unroll
        for (int i = 0; i < 4; ++i) {
            const int row = r0 + 32 * (i & 1), kt = i >> 1;
            *(u32x4*)(lds + 32768 + kt * 8192 + tile_off(row, c)) = *(const u32x4*)(w2 + (size_t)row * 128 + kt * 64 + c * 8);
        }
    }
    __syncthreads();
    f32x16 a2[2];
#pragma unroll
    for (int db = 0; db < 2; ++db)
#pragma unroll
        for (int q = 0; q < 16; ++q) a2[db][q] = 0.f;
#pragma unroll
    for (int kt = 0; kt < 2; ++kt)
#pragma unroll
        for (int s = 0; s < 4; ++s) {
            const bf16x8 hf = *(const bf16x8*)(lds + kt * 16384 + tile_off(32 * wave + r, 2 * s + h));
#pragma unroll
            for (int db = 0; db < 2; ++db) {
                const bf16x8 wf = *(const bf16x8*)(lds + 32768 + kt * 8192 + tile_off(32 * db + r, 2 * s + h));
                a2[db] = __builtin_amdgcn_mfma_f32_32x32x16_bf16(wf, hf, a2[db], 0, 0, 0);
            }
        }
    const int n = 32 * wave + r;
    if (kv == 0 && n < 127) {
        const int pos = 16 * n + 31;
#pragma unroll
        for (int q = 0; q < 4; ++q) {
            const float cs = v.rcos[pos * 8 + q + 4 * h], sn = v.rsin[pos * 8 + q + 4 * h];
            const float x1 = a2[0][q], x2 = a2[0][q + 4];
            a2[0][q] = x1 * cs - x2 * sn; a2[0][q + 4] = x2 * cs + x1 * sn;
        }
    }
    bf16_t* dst = (kv ? v.cv : v.ck) + ((size_t)bg * 128 + n) * 64;
    bf16_t* dt = (bf16_t*)(p.ws + WS_CVT) + (size_t)bg * 64 * 128 + n;
#pragma unroll
    for (int db = 0; db < 2; ++db)
#pragma unroll
        for (int g4 = 0; g4 < 4; ++g4) {
            const int d = 32 * db + 8 * g4 + 4 * h;
            float x0 = a2[db][4 * g4], x1 = a2[db][4 * g4 + 1], x2 = a2[db][4 * g4 + 2], x3 = a2[db][4 * g4 + 3];
            if (n >= 127) { x0 = 0.f; x1 = 0.f; x2 = 0.f; x3 = 0.f; }
            uint2 u; u.x = cvtpk(x0, x1); u.y = cvtpk(x2, x3);
            *(uint2*)(dst + d) = u;
            if (kv) { dt[(size_t)d * 128] = (bf16_t)(u.x & 0xffffu); dt[(size_t)(d + 1) * 128] = (bf16_t)(u.x >> 16); dt[(size_t)(d + 2) * 128] = (bf16_t)(u.y & 0xffffu); dt[(size_t)(d + 3) * 128] = (bf16_t)(u.y >> 16); }
        }
    __syncthreads();
    return true;
}

typedef float f32x4m __attribute__((ext_vector_type(4)));
DEV void ph_norm2_router_fast(const P& p, int l, unsigned char* lds) {
    const V v = make_views(p); const int TIDX = otid(), BIDX = obid();
    const int lane = TIDX & 63, wave = TIDX >> 6;
    const bf16_t* wr = (const bf16_t*)(p.ws + WS_WR) + (size_t)l * 2 * 64 * D;
    float* LG = (float*)(lds + 65536);
    for (int blk = BIDX; blk < T / 16; blk += gridDim.x) {
        const int m0 = blk * 16, b = m0 >> 11;
        const float* md = v.mod + (size_t)(l * 8 + b) * 6144;
        float4 xv[4][4]; float ssq[4];
#pragma unroll
        for (int rr = 0; rr < 4; ++rr)
#pragma unroll
            for (int j = 0; j < 4; ++j) xv[rr][j] = ld_bf4(v.XB + (size_t)(m0 + wave * 4 + rr) * D + 4 * lane + 256 * j);
#pragma unroll
        for (int rr = 0; rr < 4; ++rr) {
            ssq[rr] = 0.f;
#pragma unroll
            for (int j = 0; j < 4; ++j) ssq[rr] += xv[rr][j].x * xv[rr][j].x + xv[rr][j].y * xv[rr][j].y + xv[rr][j].z * xv[rr][j].z + xv[rr][j].w * xv[rr][j].w;
        }
#pragma unroll
        for (int o = 1; o < 64; o <<= 1) {
#pragma unroll
            for (int rr = 0; rr < 4; ++rr) ssq[rr] += __shfl_xor(ssq[rr], o);
        }
#pragma unroll
        for (int rr = 0; rr < 4; ++rr) {
            const int row = wave * 4 + rr, m = m0 + row;
            const float rs = rsqrtf(ssq[rr] * (1.f / D) + EPS);
#pragma unroll
            for (int j = 0; j < 4; ++j) {
                const int c = 4 * lane + 256 * j;
                const float4 g = *(const float4*)(p.norm2_g + l * D + c), sh = *(const float4*)(md + 3 * D + c), sc = *(const float4*)(md + 4 * D + c);
                const float h0 = xv[rr][j].x * rs * g.x * (1.f + sc.x) + sh.x, h1 = xv[rr][j].y * rs * g.y * (1.f + sc.y) + sh.y;
                const float h2 = xv[rr][j].z * rs * g.z * (1.f + sc.z) + sh.z, h3 = xv[rr][j].w * rs * g.w * (1.f + sc.w) + sh.w;
                uint2 hi; hi.x = cvtpk(h0, h1); hi.y = cvtpk(h2, h3);
                uint2 lo;
                lo.x = cvtpk(h0 - __uint_as_float(hi.x << 16), h1 - __uint_as_float(hi.x & 0xffff0000u));
                lo.y = cvtpk(h2 - __uint_as_float(hi.y << 16), h3 - __uint_as_float(hi.y & 0xffff0000u));
                *(uint2*)(v.H + (size_t)m * D + c) = hi;
                const int off = row * 2048 + ((((c >> 3) ^ row) & 127) << 4) + (c & 7) * 2;
                *(uint2*)(lds + off) = hi; *(uint2*)(lds + 32768 + off) = lo;
            }
        }
        __syncthreads();
        {
            const int r16 = lane & 15, kq = lane >> 4;
            f32x4m acc = {0.f, 0.f, 0.f, 0.f};
            const bf16_t* wh = wr + (size_t)(16 * wave + r16) * D + 8 * kq;
            bf16x8 bh[8], bl[8];
#pragma unroll
            for (int bt = 0; bt < 4; ++bt) {
#pragma unroll
                for (int s = 0; s < 8; ++s) { bh[s] = *(const bf16x8*)(wh + 32 * (8 * bt + s)); bl[s] = *(const bf16x8*)(wh + 64 * D + 32 * (8 * bt + s)); }
                __builtin_amdgcn_sched_barrier(0);
#pragma unroll
                for (int s8 = 0; s8 < 8; ++s8) {
                    const int s = 8 * bt + s8;
                    const int off = r16 * 2048 + ((((4 * s + kq) ^ r16) & 127) << 4);
                    const bf16x8 ah = *(const bf16x8*)(lds + off), al = *(const bf16x8*)(lds + 32768 + off);
                    acc = __builtin_amdgcn_mfma_f32_16x16x32_bf16(ah, bh[s8], acc, 0, 0, 0);
                    acc = __builtin_amdgcn_mfma_f32_16x16x32_bf16(al, bh[s8], acc, 0, 0, 0);
                    acc = __builtin_amdgcn_mfma_f32_16x16x32_bf16(ah, bl[s8], acc, 0, 0, 0);
                }
                __builtin_amdgcn_sched_barrier(0);
            }
#pragma unroll
            for (int q = 0; q < 4; ++q) LG[(4 * kq + q) * 64 + 16 * wave + r16] = acc[q];
        }
        __syncthreads();
        if (TIDX < 16) {
            const int m = m0 + TIDX;
            const float* lgp = LG + TIDX * 64;
            float lg[4], le[32];
#pragma unroll
            for (int i = 0; i < 4; ++i) lg[i] = lgp[i] + p.rg_b[l * 4 + i];
#pragma unroll
            for (int i = 0; i < 32; ++i) le[i] = lgp[4 + i] + p.re_b[l * 32 + i];
            int gi = 0; float gm = lg[0];
#pragma unroll
            for (int i = 1; i < 4; ++i) if (lg[i] > gm) { gm = lg[i]; gi = i; }
            float gs = 0.f;
#pragma unroll
            for (int i = 0; i < 4; ++i) gs += expf(lg[i] - gm);
            const float pg = 1.f / gs;
            float el[8];
#pragma unroll
            for (int i = 0; i < 8; ++i) el[i] = gi == 0 ? le[i] : (gi == 1 ? le[8 + i] : (gi == 2 ? le[16 + i] : le[24 + i]));
            int e1 = 0; float m1 = el[0];
#pragma unroll
            for (int i = 1; i < 8; ++i) if (el[i] > m1) { m1 = el[i]; e1 = i; }
            int e2 = -1; float m2 = -3.0e38f;
#pragma unroll
            for (int i = 0; i < 8; ++i) if (i != e1 && el[i] > m2) { m2 = el[i]; e2 = i; }
            const float p2 = expf(m2 - m1);
            const float w1 = pg / (1.f + p2), w2 = pg * p2 / (1.f + p2);
            const int ea = gi * 8 + e1, eb = gi * 8 + e2;
            const unsigned pa = atomicAdd(v.ctl + CW_CNT + (l * 32 + ea) * 64, 1u);
            const unsigned pb = atomicAdd(v.ctl + CW_CNT + (l * 32 + eb) * 64, 1u);
            v.list[(size_t)ea * T + pa] = 2 * m;
            v.list[(size_t)eb * T + pb] = 2 * m + 1;
            v.wts[2 * m] = w1; v.wts[2 * m + 1] = w2;
        }
        __syncthreads();
    }
}

constexpr int CW_MQ = 8192 + 512;
DEV void ph_mix(const P& p, int l, unsigned char* lds, volatile LAS unsigned* qslot, int rep) {
    const int TIDX = otid(), BIDX = obid();
    unsigned* ctl = (unsigned*)(p.ws + WS_CTL) + CW_MQ + l * 256;
    unsigned acq = 0u;
    int b = BIDX & 7;
    {
        for (;;) {
            unsigned* qc = ctl + b * 16;
            unsigned* done = ctl + 128 + b * 16;
            __syncthreads();
            if (TIDX == 0) {
                unsigned tk = atomicAdd(qc, 1u), nb = (unsigned)b;
                if (tk >= 272u) {
                    unsigned hd[8];
#pragma unroll
                    for (int q = 0; q < 8; ++q) hd[q] = __hip_atomic_load(ctl + ((b + q) & 7) * 16, __ATOMIC_RELAXED, __HIP_MEMORY_SCOPE_AGENT);
                    nb = 8u;
#pragma unroll
                    for (int q = 7; q >= 1; --q) if (hd[q] < 272u) nb = (unsigned)((b + q) & 7);
                }
                *qslot = tk | (nb << 16);
            }
            __syncthreads();
            const unsigned qv = *qslot;
            const int v = (int)(qv & 0xffffu);
            if (v >= 272) {
                const int nb = (int)(qv >> 16);
                if (nb >= 8) break;
                b = nb; continue;
            }
            if (v < 16) {
                if (cmp_unit(p, l, b * 4 + (v >> 2), v & 3, lds, qslot)) {
                    asm volatile("s_waitcnt vmcnt(0)" ::: "memory");
                    __syncthreads();
                    if (TIDX == 0) {
                        __builtin_amdgcn_fence(__ATOMIC_RELEASE, "agent");
                        asm volatile("s_waitcnt vmcnt(0)" ::: "memory");
                        __hip_atomic_fetch_add(done, 1u, __ATOMIC_RELAXED, __HIP_MEMORY_SCOPE_AGENT);
                    }
                }
                continue;
            }
            int slot = -1, nsa = -1;
            if (v < 48) slot = 2 * (v - 16);
            else if (v < 112) slot = 2 * (v - 48) + 1;
            else { const int w2 = v - 112, k = w2 % 5, i = w2 / 5; if (k < 4) nsa = 4 * i + k; else slot = 2 * (32 + i); }
            if (slot >= 0) {
                const int idx = slot >> 1, u = ((idx >> 2) << 5) | (b * 4 + (idx & 3));
                if (slot & 1) mha_unit<3>(p, l, u, lds); else mha_unit<2>(p, l, u, lds);
            } else {
                if (!((acq >> b) & 1u)) {
                    if (TIDX == 0) {
                        unsigned sp = 0;
                        while (__hip_atomic_load(done, __ATOMIC_RELAXED, __HIP_MEMORY_SCOPE_AGENT) < 4u) { __builtin_amdgcn_s_sleep(2); if (++sp > (1u << 22)) break; }
                        __builtin_amdgcn_fence(__ATOMIC_ACQUIRE, "agent");
                        asm volatile("s_waitcnt vmcnt(0)" ::: "memory");
                    }
                    __syncthreads();
                    acq |= 1u << b;
                }
                nsa_unit(p, l, ((nsa >> 1) << 4) | (b * 2 + (nsa & 1)), lds);
            }
        }
    }
}

#ifndef REP_PHASE
#define REP_PHASE 0
#endif
#ifndef REF_HEADS
#define REF_HEADS 0x0000u
#endif
__global__ void __launch_bounds__(256, 2) fwd_kernel(P p) {
    __shared__ __attribute__((aligned(16))) float lds[17408];
    __shared__ __attribute__((aligned(16))) unsigned lds_ctl[4];
    if (threadIdx.x < 4) lds_ctl[threadIdx.x] = 0u;
    __syncthreads();
    const XcdBarrier xb = xcd_barrier_post((unsigned*)(p.ws + WS_CTL), (volatile LAS unsigned*)lds_ctl);
#define GRID_BAR() do { xcd_barrier(xb); if (REP_PHASE == 7) xcd_barrier(xb); } while (0)
    volatile LAS unsigned* qslot = (volatile LAS unsigned*)(lds_ctl + 2);
    for (int rep = 0; rep < (REP_PHASE == 1 ? 2 : 1); ++rep) {
        ph_prologue(p, lds);
        ph_convert(p, lds);
        GRID_BAR();
    }
    for (int l = 0; l < DEPTH; ++l) {
        ph_convert_dense(p, l, 0);
        ph_norm1(p, l, l == 0 ? 0 : 1);
        GRID_BAR();
        for (int rep = 0; rep < (REP_PHASE == 2 ? 2 : 1); ++rep) {
            if (rep == 0) ph_convert_dense(p, l, 1);
            ph_inproj_fast(p, l, (unsigned char*)lds);
            GRID_BAR();
        }
        for (int rep = 0; rep < (REP_PHASE == 3 ? 2 : 1); ++rep) {
            ph_mix(p, l, (unsigned char*)lds, qslot, rep);
            GRID_BAR();
        }
        ph_outproj_fast(p, l, (unsigned char*)lds);
        GRID_BAR();
        if (blockIdx.x & 8) { ph_convert_experts(p, l); ph_norm2_router_fast(p, l, (unsigned char*)lds); }
        else { ph_norm2_router_fast(p, l, (unsigned char*)lds); ph_convert_experts(p, l); }
        GRID_BAR();
        for (int rep = 0; rep < (REP_PHASE == 5 ? 2 : 1); ++rep) {
            ph_moe_up_fast(p, l, (unsigned char*)lds);
            GRID_BAR();
        }
        for (int rep = 0; rep < (REP_PHASE == 6 ? 2 : 1); ++rep) {
            ph_moe_down_fast(p, l, (unsigned char*)lds);
            GRID_BAR();
        }
    }
    ph_norm1(p, DEPTH, 2);
}

extern "C" void kernel_launch(void* const* d_in, const int* in_sizes, int n_in,
                              void* d_out, int out_size, void* d_ws, size_t ws_size,
                              hipStream_t stream) {
    static int grid_blocks = 0;
    if (!grid_blocks) {
        int dev = 0, cus = 0, per_cu = 0;
        (void)hipGetDevice(&dev);
        (void)hipDeviceGetAttribute(&cus, hipDeviceAttributeMultiprocessorCount, dev);
        (void)hipOccupancyMaxActiveBlocksPerMultiprocessor(&per_cu, fwd_kernel, 256, 0);
        if (per_cu > 2) per_cu = 2;
        if (per_cu < 1) per_cu = 1;
        grid_blocks = cus * per_cu;
        if (n_in != 24 || ws_size < WS_END || out_size != T * D) { fprintf(stderr, "kernel_launch: unexpected shapes (n_in %d ws %zu out %d)\n", n_in, ws_size, out_size); grid_blocks = -1; }
    }
    if (grid_blocks < 0) return;
    (void)hipMemsetAsync(d_ws, 0, CTL_BYTES, stream);
    P p{};
    const float** pp = (const float**)&p;
    for (int i = 0; i < 24; ++i) pp[i] = (const float*)d_in[i];
    p.out = (float*)d_out; p.ws = (unsigned char*)d_ws;
    void* args[] = {&p};
    hipError_t e = hipLaunchCooperativeKernel((void*)fwd_kernel, dim3(grid_blocks), dim3(256), args, 0, stream);
    if (e != hipSuccess) fprintf(stderr, "cooperative launch failed: %s (grid %d)\n", hipGetErrorString(e), grid_blocks);
}
```
